# Optimizing an MI355X kernel written in HIP

```python
import jax, jax.numpy as jnp
from jax import lax
import numpy as np

D_MODEL = 1024
BATCH = 2
SEQ = 8192
DEPTH = 2

HEAD_DIM = 64
GRID_W = 64
ROPE_THETA = 10000.0
NORM_EPS = 1e-6
ATTN_BLOCK = 128
A_Q_HEADS = 8
A_KV_HEADS = 2
B_Q_HEADS = 8
B_KV_HEADS = 2
B_HALF_WINDOW = 128
AB_IN = (A_Q_HEADS + 2 * A_KV_HEADS + B_Q_HEADS + 2 * B_KV_HEADS) * HEAD_DIM
AB_OUT = (A_Q_HEADS + B_Q_HEADS) * HEAD_DIM
C_PATTERNS = ((128, 1), (512, 4), (2048, 16))
C_Q_HEADS = 8
C_KV_HEADS = 2
C_GROUP_IN = (C_Q_HEADS + 2 * C_KV_HEADS) * HEAD_DIM
C_IN = len(C_PATTERNS) * C_GROUP_IN
C_OUT = C_Q_HEADS * HEAD_DIM
N_EXPERTS = 32
TOP_K = 4
D_EXPERT = 1024
SWIGLU_LIMIT = 7.0
SWIGLU_ALPHA = 1.702
MOE_BLOCK = 128
PLE_DIM = 256
N_EVEN = (DEPTH + 1) // 2
N_ODD = DEPTH // 2

kernel_name = "hybrid_axial_window_dilated_moe_encoder"


def rms_norm(x, gain):
    xf = x.astype(jnp.float32)
    y = xf * lax.rsqrt(jnp.mean(xf * xf, axis=-1, keepdims=True) + NORM_EPS)
    return (y * gain.astype(jnp.float32)).astype(x.dtype)


def rope_table(pos, dim):
    freqs = ROPE_THETA ** (-jnp.arange(0, dim, 2, dtype=jnp.float32) / dim)
    ang = pos.astype(jnp.float32)[:, None] * freqs[None, :]
    return jnp.cos(ang), jnp.sin(ang)


def apply_rope(x, cos, sin):
    xf = x.astype(jnp.float32)
    x1, x2 = jnp.split(xf, 2, axis=-1)
    c = cos[None, :, None, :]
    s = sin[None, :, None, :]
    return jnp.concatenate([x1 * c - x2 * s, x2 * c + x1 * s], axis=-1).astype(x.dtype)


def apply_axial_rope(x, rope_row, rope_col):
    half = HEAD_DIM // 2
    return jnp.concatenate([apply_rope(x[..., :half], *rope_row),
                            apply_rope(x[..., half:], *rope_col)], axis=-1)


def dense_attention(q, k, v):
    b, s, hq, d = q.shape
    hkv = k.shape[2]
    g = hq // hkv
    nblk = s // ATTN_BLOCK
    scale = d ** -0.5
    qb = q.reshape(b, nblk, ATTN_BLOCK, hkv, g, d).transpose(1, 0, 2, 3, 4, 5)

    def one_block(qi):
        sc = jnp.einsum('bqhgd,bkhd->bhgqk', qi, k, preferred_element_type=jnp.float32) * scale
        pr = jax.nn.softmax(sc, axis=-1)
        return jnp.einsum('bhgqk,bkhd->bqhgd', pr.astype(v.dtype), v)

    o = lax.map(one_block, qb)
    return o.transpose(1, 0, 2, 3, 4, 5).reshape(b, s, hq, d)


def banded_attention(q, k, v, half_window, sink=None):
    b, l, hq, d = q.shape
    hkv = k.shape[2]
    g = hq // hkv
    blk = half_window
    nb = -(-l // blk)
    lp = nb * blk
    scale = d ** -0.5
    qp = jnp.pad(q, ((0, 0), (0, lp - l), (0, 0), (0, 0))).reshape(b, nb, blk, hkv, g, d)
    pad_kv = ((0, 0), (blk, lp - l + blk), (0, 0), (0, 0))
    kp = jnp.pad(k, pad_kv).reshape(b, nb + 2, blk, hkv, d)
    vp = jnp.pad(v, pad_kv).reshape(b, nb + 2, blk, hkv, d)
    kb = jnp.concatenate([kp[:, :-2], kp[:, 1:-1], kp[:, 2:]], axis=2)
    vb = jnp.concatenate([vp[:, :-2], vp[:, 1:-1], vp[:, 2:]], axis=2)
    sc = jnp.einsum('bnqhgd,bnkhd->bnhgqk', qp, kb, preferred_element_type=jnp.float32) * scale
    qpos = jnp.arange(nb)[:, None] * blk + jnp.arange(blk)[None, :]
    kpos = (jnp.arange(nb)[:, None] - 1) * blk + jnp.arange(3 * blk)[None, :]
    valid = ((jnp.abs(qpos[:, :, None] - kpos[:, None, :]) <= half_window)
             & (kpos[:, None, :] >= 0) & (kpos[:, None, :] < l))
    sc = jnp.where(valid[None, :, None, None], sc, -jnp.inf)
    m = jnp.max(sc, axis=-1, keepdims=True)
    if sink is not None:
        sink_b = sink.astype(jnp.float32).reshape(hkv, g)[None, None, :, :, None, None]
        m = jnp.maximum(m, sink_b)
    e = jnp.exp(sc - m)
    den = jnp.sum(e, axis=-1, keepdims=True)
    if sink is not None:
        den = den + jnp.exp(sink_b - m)
    o = jnp.einsum('bnhgqk,bnkhd->bnqhgd', (e / den).astype(v.dtype), vb)
    lse = (m + jnp.log(den))[..., 0]
    o = o.reshape(b, lp, hq, d)[:, :l]
    lse = lse.transpose(0, 1, 4, 2, 3).reshape(b, lp, hq)[:, :l]
    return o, lse


def dilated_attention(q, k, v, window, dilation):
    b, s, hq, d = q.shape
    n_side = window // (2 * dilation)
    l = s // dilation

    def to_classes(z):
        h = z.shape[2]
        return z.reshape(b, l, dilation, h, d).transpose(0, 2, 1, 3, 4).reshape(b * dilation, l, h, d)

    o, lse = banded_attention(to_classes(q), to_classes(k), to_classes(v), n_side)
    o = o.reshape(b, dilation, l, hq, d).transpose(0, 2, 1, 3, 4).reshape(b, s, hq, d)
    lse = lse.reshape(b, dilation, l, hq).transpose(0, 2, 1, 3).reshape(b, s, hq)
    return o, lse


def mixer_ab(hn, w_in, q_gain, k_gain, sink, w_out, rope_1d, rope_row, rope_col):
    b, s, _ = hn.shape
    proj = hn @ w_in
    widths = [A_Q_HEADS, A_KV_HEADS, A_KV_HEADS, B_Q_HEADS, B_KV_HEADS, B_KV_HEADS]
    cuts = [int(c) * HEAD_DIM for c in np.cumsum(widths)[:-1]]
    qa, ka, va, qb, kb, vb = [z.reshape(b, s, -1, HEAD_DIM) for z in jnp.split(proj, cuts, axis=-1)]
    qa = apply_axial_rope(rms_norm(qa, q_gain), rope_row, rope_col)
    ka = apply_axial_rope(rms_norm(ka, k_gain), rope_row, rope_col)
    oa = dense_attention(qa, ka, va)
    qb = apply_rope(qb, *rope_1d)
    kb = apply_rope(kb, *rope_1d)
    ob, _ = banded_attention(qb, kb, vb, B_HALF_WINDOW, sink)
    o = jnp.concatenate([oa.reshape(b, s, -1), ob.reshape(b, s, -1)], axis=-1)
    return o @ w_out


def mixer_c(hn, w_in, w_out, rope_1d):
    b, s, _ = hn.shape
    proj = hn @ w_in
    cuts = [C_Q_HEADS * HEAD_DIM, (C_Q_HEADS + C_KV_HEADS) * HEAD_DIM]
    outs, lses = [], []
    for gi, (window, dilation) in enumerate(C_PATTERNS):
        grp = proj[..., gi * C_GROUP_IN:(gi + 1) * C_GROUP_IN]
        q, k, v = [z.reshape(b, s, -1, HEAD_DIM) for z in jnp.split(grp, cuts, axis=-1)]
        q = apply_rope(q, *rope_1d)
        k = apply_rope(k, *rope_1d)
        o, lse = dilated_attention(q, k, v, window, dilation)
        outs.append(o)
        lses.append(lse)
    wts = jax.nn.softmax(jnp.stack(lses, axis=0), axis=0)
    o = jnp.einsum('gbsh,gbshd->bshd', wts.astype(outs[0].dtype), jnp.stack(outs, axis=0))
    return o.reshape(b, s, C_OUT) @ w_out


def moe(hn, router_w, router_b, w_up, b_up, w_down, b_down):
    b, s, dm = hn.shape
    t = b * s
    x = hn.reshape(t, dm)
    logits = (x @ router_w + router_b).astype(jnp.float32)
    top_val, top_idx = lax.top_k(logits, TOP_K)
    gates = jax.nn.softmax(top_val, axis=-1)
    a = t * TOP_K
    flat_e = top_idx.reshape(a).astype(jnp.int32)
    flat_tok = jnp.repeat(jnp.arange(t, dtype=jnp.int32), TOP_K)
    flat_gate = gates.reshape(a)
    order = jnp.argsort(flat_e)
    e_sorted = flat_e[order]
    tok_sorted = flat_tok[order]
    gate_sorted = flat_gate[order]
    counts = jnp.bincount(flat_e, length=N_EXPERTS)
    starts = jnp.cumsum(counts) - counts
    padded = (counts + MOE_BLOCK - 1) // MOE_BLOCK * MOE_BLOCK
    pends = jnp.cumsum(padded)
    pstarts = pends - padded
    dest = pstarts[e_sorted] + jnp.arange(a, dtype=jnp.int32) - starts[e_sorted]
    n_blocks = -(-a // MOE_BLOCK) + N_EXPERTS
    n_slots = n_blocks * MOE_BLOCK
    slot_tok = jnp.full((n_slots,), t, jnp.int32).at[dest].set(tok_sorted)
    slot_gate = jnp.zeros((n_slots,), jnp.float32).at[dest].set(gate_sorted)
    block_e = jnp.minimum(jnp.searchsorted(pends, jnp.arange(n_blocks) * MOE_BLOCK, side='right'),
                          N_EXPERTS - 1)
    x_pad = jnp.concatenate([x, jnp.zeros((1, dm), x.dtype)], axis=0)
    xb = x_pad[slot_tok].reshape(n_blocks, MOE_BLOCK, dm)

    def expert_block(args):
        xi, e = args
        hu = xi @ w_up[e] + b_up[e]
        glu = jnp.minimum(hu[:, ::2], SWIGLU_LIMIT)
        lin = jnp.clip(hu[:, 1::2], -SWIGLU_LIMIT, SWIGLU_LIMIT)
        act = glu * jax.nn.sigmoid(SWIGLU_ALPHA * glu) * (lin + 1.0)
        return act @ w_down[e] + b_down[e]

    yb = lax.map(expert_block, (xb, block_e))
    y = yb.reshape(n_slots, dm) * slot_gate[:, None].astype(yb.dtype)
    out = jnp.zeros((t + 1, dm), yb.dtype).at[slot_tok].add(y)[:t]
    return out.reshape(b, s, dm)


def setup_inputs(seed: int = 0) -> dict:
    key = jax.random.key(seed)
    ks = jax.random.split(key, 24)
    f32 = jnp.float32

    def nrm(k, shape, fan_in):
        return jax.random.normal(k, shape, f32) * fan_in ** -0.5

    def gain(k, shape):
        return 1.0 + 0.05 * jax.random.normal(k, shape, f32)

    return {
        "x": jax.random.normal(ks[0], (BATCH, SEQ, D_MODEL), f32),
        "p": jax.random.normal(ks[1], (DEPTH, BATCH, SEQ, PLE_DIM), f32),
        "norm_mix": gain(ks[2], (DEPTH, D_MODEL)),
        "ab_w_in": nrm(ks[3], (N_EVEN, D_MODEL, AB_IN), D_MODEL),
        "ab_q_norm": gain(ks[4], (N_EVEN, HEAD_DIM)),
        "ab_k_norm": gain(ks[5], (N_EVEN, HEAD_DIM)),
        "ab_sink": 0.5 * jax.random.normal(ks[6], (N_EVEN, B_Q_HEADS), f32),
        "ab_w_out": nrm(ks[7], (N_EVEN, AB_OUT, D_MODEL), AB_OUT),
        "c_w_in": nrm(ks[8], (N_ODD, D_MODEL, C_IN), D_MODEL),
        "c_w_out": nrm(ks[9], (N_ODD, C_OUT, D_MODEL), C_OUT),
        "norm_ffn": gain(ks[10], (DEPTH, D_MODEL)),
        "router_w": nrm(ks[11], (DEPTH, D_MODEL, N_EXPERTS), D_MODEL),
        "router_b": 0.01 * jax.random.normal(ks[12], (DEPTH, N_EXPERTS), f32),
        "exp_w_up": nrm(ks[13], (DEPTH, N_EXPERTS, D_MODEL, 2 * D_EXPERT), D_MODEL),
        "exp_b_up": 0.01 * jax.random.normal(ks[14], (DEPTH, N_EXPERTS, 2 * D_EXPERT), f32),
        "exp_w_down": nrm(ks[15], (DEPTH, N_EXPERTS, D_EXPERT, D_MODEL), D_EXPERT),
        "exp_b_down": 0.01 * jax.random.normal(ks[16], (DEPTH, N_EXPERTS, D_MODEL), f32),
        "ple_w_proj": nrm(ks[17], (DEPTH, PLE_DIM, D_MODEL), PLE_DIM),
        "ple_w_gate": nrm(ks[18], (DEPTH, D_MODEL, D_MODEL), D_MODEL),
        "norm_final": gain(ks[19], (D_MODEL,)),
    }


def reference(x, p, norm_mix, ab_w_in, ab_q_norm, ab_k_norm, ab_sink, ab_w_out, c_w_in, c_w_out,
              norm_ffn, router_w, router_b, exp_w_up, exp_b_up, exp_w_down, exp_b_down,
              ple_w_proj, ple_w_gate, norm_final):
    b, s, _ = x.shape
    rows = s // GRID_W
    pos = jnp.arange(s)
    row_idx = jnp.repeat(jnp.arange(rows), GRID_W)
    col_idx = jnp.tile(jnp.arange(GRID_W), rows)
    rope_1d = rope_table(pos, HEAD_DIM)
    rope_row = rope_table(row_idx, HEAD_DIM // 2)
    rope_col = rope_table(col_idx, HEAD_DIM // 2)
    h = x
    for i in range(DEPTH):
        j = i // 2
        hn = rms_norm(h, norm_mix[i])
        if i % 2 == 0:
            mix = mixer_ab(hn, ab_w_in[j], ab_q_norm[j], ab_k_norm[j], ab_sink[j], ab_w_out[j],
                           rope_1d, rope_row, rope_col)
        else:
            mix = mixer_c(hn, c_w_in[j], c_w_out[j], rope_1d)
        h = h + mix
        h = h + moe(rms_norm(h, norm_ffn[i]), router_w[i], router_b[i], exp_w_up[i], exp_b_up[i],
                    exp_w_down[i], exp_b_down[i])
        gate = jax.nn.sigmoid(h @ ple_w_gate[i])
        h = h + (p[i] @ ple_w_proj[i]) * gate
    return rms_norm(h, norm_final)
```

```cpp
#include <hip/hip_runtime.h>
#include <hip/hip_bf16.h>
#include <cstdio>
#include <cstdint>
#include <cmath>
namespace pg8 {
#define PG8_LAS __attribute__((address_space(3)))
typedef unsigned short bf16_t;
typedef short bf16x8 __attribute__((ext_vector_type(8)));
typedef float f32x4 __attribute__((ext_vector_type(4)));
typedef unsigned u32x4 __attribute__((ext_vector_type(4)));
constexpr int BM = 256, BK = 64, HALF = 128, HTB = HALF * BK * 2  , STAGE_BYTES = 8 * HTB, NXCD = 8, WGM = 8;

__host__ __device__ __forceinline__ int lds_byte(int r, int c) { const int st = (r >> 4) * 2 + (c >> 5), rr = r & 15, cc = c & 31, ob = rr * 64 + cc * 2; return st * 1024 + (ob ^ (((ob >> 9) & 1) << 5)); }
__host__ __device__ __forceinline__ void stage_rc(int b, int& R, int& C) { const int st = b / 1024, sb = b % 1024, swz = sb ^ (((sb >> 9) & 1) << 5); R = (st >> 1) * 16 + swz / 64; C = (st & 1) * 32 + (swz % 64) / 2; }
__host__ __device__ __forceinline__ int perm32(int rho) { const int n = rho >> 4, i = rho & 15; return 8 * (i >> 2) + 4 * n + (i & 3); }

struct Unit { int pm, pn; };
struct Gemm { const bf16_t* A; const bf16_t* Bt; int M, N, K; };

struct StaticOrder {
    int nM, nN, nwg, G, c;
    __host__ __device__ void init(int M, int N, int G_, int c_) { nM = M / BM; nN = N / BM; nwg = nM * nN; G = G_; c = c_; }
    __host__ __device__ bool next(int i, Unit& u) const {
        const long L = (long)i * G + c; if (L >= nwg) return false;
        int wgid = (int)L; { const int q = nwg / NXCD, r = nwg % NXCD, xcd = wgid % NXCD, off = wgid / NXCD; wgid = (xcd < r ? xcd * (q + 1) : r * (q + 1) + (xcd - r) * q) + off; }
        const int nig = WGM * nN, gid = wgid / nig, fm = gid * WGM, gsz = (nM - fm) < WGM ? (nM - fm) : WGM;
        u.pm = fm + ((wgid % nig) % gsz); u.pn = (wgid % nig) / gsz; return true;
    }
    __device__ __forceinline__ void a_ready(const Unit&) const {}
    __device__ __forceinline__ void done(const Unit&) const {}
};

__device__ __forceinline__ unsigned cvt_pk_bf16(float lo, float hi) { unsigned r; asm volatile("v_cvt_pk_bf16_f32 %0, %1, %2" : "=v"(r) : "v"(lo), "v"(hi)); return r; }
typedef float f32x2 __attribute__((ext_vector_type(2)));
__device__ __forceinline__ f32x2 gelu_pk(f32x2 v) {
    const f32x2 av = __builtin_elementwise_abs(v), d = av * 0.2316418882f + 1.0f;
    f32x2 t; t.x = __builtin_amdgcn_rcpf(d.x); t.y = __builtin_amdgcn_rcpf(d.y);
    f32x2 q = t * 0.5307027145f + (-0.7265760135f); q = q * t + 0.7107068705f; q = q * t + (-0.142248368f); q = q * t + 0.127414796f; q = q * t;
    const f32x2 s = (v * v) * (-0.72134752044f);
    f32x2 e; e.x = __builtin_amdgcn_exp2f(s.x); e.y = __builtin_amdgcn_exp2f(s.y);
    const f32x2 m = v * (q * e), r = v - m;
    f32x2 o; o.x = v.x < 0.f ? m.x : r.x; o.y = v.y < 0.f ? m.y : r.y; return o;
}

template <int ACT  > struct EpiBf16 {
    static constexpr bool PERM = true, AFTER_DRAIN = false; static_assert(ACT == 0 || ACT == 1, "EpiBf16: ACT is 0 (none) or 1 (gelu_pk)");
    bf16_t* O; int ldc; const float* bias; int split_cols; size_t split_stride; float scale0;
    __device__ __forceinline__ void operator()(const f32x4 (&acc)[2][2][4][2], const Unit& u, int wr, int wc, int fr, int fq) const {
        const int row0 = u.pm * BM + wr * 64 + fr; int colt = u.pn * BM; bf16_t* base = O;
        float sc = 1.f; if (split_cols) { const int t = colt / split_cols; base += (size_t)t * split_stride; colt -= t * split_cols; if (t == 0) sc = scale0; }
        const int col0 = colt + wc * 32 + 8 * fq, bcol0 = u.pn * BM + wc * 32 + 8 * fq;
        f32x4 bv[2][2];
#pragma unroll
        for (int bj = 0; bj < 2; ++bj)
#pragma unroll
            for (int n = 0; n < 2; ++n) bv[bj][n] = bias ? *(const f32x4*)(bias + bcol0 + bj * HALF + 4 * n) : (f32x4){0.f, 0.f, 0.f, 0.f};
#pragma unroll
        for (int ai = 0; ai < 2; ++ai)
#pragma unroll
            for (int m = 0; m < 4; ++m) { bf16_t* rowp = base + (size_t)(row0 + ai * HALF + m * 16) * ldc + col0;
#pragma unroll
                for (int bj = 0; bj < 2; ++bj) { f32x4 v0 = acc[ai][bj][m][0] + bv[bj][0], v1 = acc[ai][bj][m][1] + bv[bj][1];
                    if (ACT == 1) { f32x2 a = gelu_pk((f32x2){v0[0], v0[1]}), b = gelu_pk((f32x2){v0[2], v0[3]}), c = gelu_pk((f32x2){v1[0], v1[1]}), d = gelu_pk((f32x2){v1[2], v1[3]});
                        v0 = (f32x4){a.x, a.y, b.x, b.y}; v1 = (f32x4){c.x, c.y, d.x, d.y}; }
                    v0 = v0 * sc; v1 = v1 * sc; u32x4 w; w.x = cvt_pk_bf16(v0[0], v0[1]); w.y = cvt_pk_bf16(v0[2], v0[3]); w.z = cvt_pk_bf16(v1[0], v1[1]); w.w = cvt_pk_bf16(v1[2], v1[3]);
                    *(u32x4*)(rowp + bj * HALF) = w; } }
    }
};
template <class Epi, class Sched, bool ALIGN_EPI = false, bool SP2 = false>
__device__ __forceinline__ void gemm_phase(PG8_LAS unsigned char* lds, const Gemm g, const Sched& S, const Epi& E) {
    int tid_ = threadIdx.x; asm volatile("" : "+v"(tid_));
    const int tid = tid_, wid = __builtin_amdgcn_readfirstlane(tid >> 6), lane = tid & 63, wr = wid >> 2, wc = wid & 3, fr = lane & 15, fq = lane >> 4;
    const int K = g.K, nt = K / BK;
    unsigned voffA[2], voffB[2];
#pragma unroll
    for (int i = 0; i < 2; ++i) { int R, C; stage_rc(tid * 16 + i * 8192, R, C); const int Rb = Epi::PERM ? ((R & ~31) + perm32(R & 31)) : R;
        voffA[i] = (unsigned)(R * K + C) * 2u; voffB[i] = (unsigned)(Rb * K + C) * 2u; }
    const size_t kstep = (size_t)(BK * 2);
    const size_t hstep = (size_t)HALF * K * 2;
    const size_t tstep = 2 * hstep;
    const unsigned ldsw = (unsigned)wid * 1024u;
    const int aoff = lds_byte(wr * 64 + fr, fq * 8), boff = lds_byte(wc * 32 + fr, fq * 8);
#define PG8_SA(b, h) (((b) * 2 + (h)) * HTB)
#define PG8_SB(b, h) ((4 + (b) * 2 + (h)) * HTB)
#define PG8_STAGE(bufoff, gbase, voff) do { _Pragma("unroll") for (int _i = 0; _i < 2; ++_i) \
        __builtin_amdgcn_global_load_lds((const unsigned*)((const char*)(gbase) + (voff)[_i]), (PG8_LAS unsigned*)(lds + (bufoff) + ldsw + _i * 8192), 16, 0, 0); } while (0)
#define PG8_LDA(dst, b, h) do { _Pragma("unroll") for (int m = 0; m < 4; ++m) _Pragma("unroll") for (int k = 0; k < 2; ++k) dst[m][k] = *(const PG8_LAS bf16x8*)(lds + PG8_SA(b, h) + aoff + m * 2048 + k * 1024); } while (0)
#define PG8_LDB(dst, b, h) do { _Pragma("unroll") for (int n = 0; n < 2; ++n) _Pragma("unroll") for (int k = 0; k < 2; ++k) dst[n][k] = *(const PG8_LAS bf16x8*)(lds + PG8_SB(b, h) + boff + n * 2048 + k * 1024); } while (0)
#define PG8_MMA(ai, bj, At, Bt) do { __builtin_amdgcn_s_setprio(1); _Pragma("unroll") for (int m = 0; m < 4; ++m) _Pragma("unroll") for (int n = 0; n < 2; ++n) _Pragma("unroll") for (int k = 0; k < 2; ++k) \
        acc[ai][bj][m][n] = __builtin_amdgcn_mfma_f32_16x16x32_bf16(Bt[n][k], At[m][k], acc[ai][bj][m][n], 0, 0, 0); __builtin_amdgcn_s_setprio(0); } while (0)
#define PG8_WAIT_V(n) asm volatile("s_waitcnt vmcnt(" #n ")" ::: "memory")
#define PG8_WAIT_L(n) asm volatile("s_waitcnt lgkmcnt(" #n ")" ::: "memory")
#define PG8_BAR __builtin_amdgcn_s_barrier()
#define PG8_SCHED __builtin_amdgcn_sched_barrier(0)
    Unit cur, nxt; int ui = 0;
    if (!S.next(0, cur)) return;
    f32x4 acc[2][2][4][2];
#pragma unroll
    for (int a = 0; a < 2; ++a)
#pragma unroll
        for (int b = 0; b < 2; ++b)
#pragma unroll
            for (int m = 0; m < 4; ++m)
#pragma unroll
                for (int n = 0; n < 2; ++n) acc[a][b][m][n] = (f32x4){0.f, 0.f, 0.f, 0.f};
    bf16x8 At[4][2], B0[2][2], B1[2][2];
    const char* cA = (const char*)g.A + (size_t)cur.pm * tstep; const char* cB = (const char*)g.Bt + (size_t)cur.pn * tstep;
    S.a_ready(cur);
    if constexpr (SP2) {
        PG8_STAGE(PG8_SB(0, 0), cB, voffB); PG8_STAGE(PG8_SB(0, 1), cB + hstep, voffB); PG8_STAGE(PG8_SA(0, 0), cA, voffA); PG8_STAGE(PG8_SA(0, 1), cA + hstep, voffA);
        if (wr == 1) PG8_BAR;
        PG8_WAIT_V(2); PG8_BAR;
        PG8_STAGE(PG8_SB(1, 0), cB + kstep, voffB); PG8_STAGE(PG8_SA(1, 0), cA + kstep, voffA); PG8_STAGE(PG8_SB(1, 1), cB + hstep + kstep, voffB);
        PG8_WAIT_V(6); PG8_BAR;
    } else {
        PG8_STAGE(PG8_SB(0, 0), cB, voffB); PG8_STAGE(PG8_SA(0, 0), cA, voffA); PG8_STAGE(PG8_SB(0, 1), cB + hstep, voffB); PG8_STAGE(PG8_SA(0, 1), cA + hstep, voffA);
        if (wr == 1) PG8_BAR;
        PG8_WAIT_V(4); PG8_BAR;
        PG8_STAGE(PG8_SB(1, 0), cB + kstep, voffB); PG8_STAGE(PG8_SA(1, 0), cA + kstep, voffA); PG8_STAGE(PG8_SB(1, 1), cB + hstep + kstep, voffB);
        PG8_WAIT_V(6); PG8_BAR;
    }
    for (;;) {
        const bool has_next = S.next(ui + 1, nxt);
        const char* nA = has_next ? (const char*)g.A + (size_t)nxt.pm * tstep : cA; const char* nB = has_next ? (const char*)g.Bt + (size_t)nxt.pn * tstep : cB;
        for (int t = 0; t < nt; t += 2) {
            const bool last = (t == nt - 2);
            const char* a1 = cA + (size_t)(t + 1) * kstep;
            const char* a2 = last ? nA : cA + (size_t)(t + 2) * kstep; const char* b2 = last ? nB : cB + (size_t)(t + 2) * kstep;
            const char* a3 = a2 + kstep; const char* b3 = b2 + kstep;
            if (last && has_next) S.a_ready(nxt);
            if constexpr (SP2) {
            PG8_LDB(B0, 0, 0); PG8_LDB(B1, 0, 1); PG8_SCHED; PG8_LDA(At, 0, 0); PG8_STAGE(PG8_SA(1, 1), a1 + hstep, voffA);
            PG8_WAIT_V(8); PG8_WAIT_L(0); PG8_BAR; PG8_MMA(0, 0, At, B0); PG8_MMA(0, 1, At, B1); PG8_BAR; PG8_SCHED;
            PG8_LDA(At, 0, 1); PG8_STAGE(PG8_SB(0, 0), b2, voffB); PG8_STAGE(PG8_SB(0, 1), b2 + hstep, voffB); PG8_STAGE(PG8_SA(0, 0), a2, voffA);
            PG8_WAIT_V(8); PG8_WAIT_L(0); PG8_BAR; PG8_MMA(1, 0, At, B0); PG8_MMA(1, 1, At, B1); PG8_BAR; PG8_SCHED;
            PG8_LDB(B0, 1, 0); PG8_LDB(B1, 1, 1); PG8_SCHED; PG8_LDA(At, 1, 0); PG8_STAGE(PG8_SA(0, 1), a2 + hstep, voffA);
            PG8_WAIT_V(8); PG8_WAIT_L(0); PG8_BAR; PG8_MMA(0, 0, At, B0); PG8_MMA(0, 1, At, B1); PG8_BAR; PG8_SCHED;
            PG8_LDA(At, 1, 1); PG8_STAGE(PG8_SB(1, 0), b3, voffB); PG8_STAGE(PG8_SB(1, 1), b3 + hstep, voffB); PG8_STAGE(PG8_SA(1, 0), a3, voffA);
            PG8_WAIT_V(8); PG8_WAIT_L(0); PG8_BAR; PG8_MMA(1, 0, At, B0); PG8_MMA(1, 1, At, B1); PG8_BAR; PG8_SCHED;
            } else {
            PG8_LDB(B0, 0, 0); PG8_SCHED; PG8_LDA(At, 0, 0); PG8_STAGE(PG8_SA(1, 1), a1 + hstep, voffA);
            PG8_WAIT_L(8); PG8_BAR; PG8_WAIT_L(0); PG8_MMA(0, 0, At, B0); PG8_BAR; PG8_SCHED;
            PG8_LDB(B1, 0, 1); PG8_STAGE(PG8_SB(0, 0), b2, voffB);
            PG8_BAR; PG8_WAIT_L(0); PG8_MMA(0, 1, At, B1); PG8_BAR;
            PG8_LDA(At, 0, 1); PG8_STAGE(PG8_SA(0, 0), a2, voffA);
            PG8_BAR; PG8_WAIT_L(0); PG8_MMA(1, 0, At, B0); PG8_BAR; PG8_SCHED;
            PG8_STAGE(PG8_SB(0, 1), b2 + hstep, voffB);
            PG8_WAIT_V(6); PG8_BAR; PG8_MMA(1, 1, At, B1); PG8_BAR;
            PG8_LDB(B0, 1, 0); PG8_SCHED; PG8_LDA(At, 1, 0); PG8_STAGE(PG8_SA(0, 1), a2 + hstep, voffA);
            PG8_WAIT_L(8); PG8_BAR; PG8_WAIT_L(0); PG8_MMA(0, 0, At, B0); PG8_BAR; PG8_SCHED;
            PG8_LDB(B1, 1, 1); PG8_STAGE(PG8_SB(1, 0), b3, voffB);
            PG8_BAR; PG8_WAIT_L(0); PG8_MMA(0, 1, At, B1); PG8_BAR;
            PG8_LDA(At, 1, 1); PG8_STAGE(PG8_SA(1, 0), a3, voffA);
            PG8_BAR; PG8_WAIT_L(0); PG8_MMA(1, 0, At, B0); PG8_BAR; PG8_SCHED;
            PG8_STAGE(PG8_SB(1, 1), b3 + hstep, voffB);
            PG8_WAIT_V(6); PG8_BAR; PG8_MMA(1, 1, At, B1); PG8_BAR;
            }
        }
        if constexpr (ALIGN_EPI) { if (wr == 0) PG8_BAR; }
        if constexpr (!Epi::AFTER_DRAIN) { E(acc, cur, wr, wc, fr, fq); S.done(cur); }
        if (!has_next) break;
#pragma unroll
        for (int a = 0; a < 2; ++a)
#pragma unroll
            for (int b = 0; b < 2; ++b)
#pragma unroll
                for (int m = 0; m < 4; ++m)
#pragma unroll
                    for (int n = 0; n < 2; ++n) acc[a][b][m][n] = (f32x4){0.f, 0.f, 0.f, 0.f};
        cur = nxt; cA = nA; cB = nB; ++ui;
        if constexpr (ALIGN_EPI) { if (wr == 1) PG8_BAR; }
    }
    PG8_WAIT_V(0);
    if constexpr (!ALIGN_EPI) { if (wr == 0) PG8_BAR; }
    PG8_BAR;
    if constexpr (Epi::AFTER_DRAIN) { E.fused(acc, cur, wr, wc, fr, fq, lds, wid, lane); S.done(cur); }
#undef PG8_SA
#undef PG8_SB
#undef PG8_STAGE
#undef PG8_LDA
#undef PG8_LDB
#undef PG8_MMA
#undef PG8_WAIT_V
#undef PG8_WAIT_L
#undef PG8_BAR
#undef PG8_SCHED
}
}

constexpr int NWAVES = 8;
constexpr int BATCH = 2, SEQ = 8192, T = BATCH * SEQ, D = 1024;
constexpr int AB_IN = 1536, C_IN = 2304, C_OUT = 512;
constexpr int NE = 32, DE = 1024, PLE = 256;
constexpr int NSLOT = 73728, NPANMAX = NSLOT / 256;
constexpr float NORM_EPS = 1e-6f;
constexpr float LOG2_THETA = 13.287712379549449f;

#define GAS __attribute__((address_space(1)))
#define LAS __attribute__((address_space(3)))
typedef unsigned short bf16;
typedef unsigned v4u __attribute__((ext_vector_type(4)));
typedef unsigned v2u __attribute__((ext_vector_type(2)));
typedef float f32x4 __attribute__((ext_vector_type(4)));
typedef GAS unsigned gu32;
#define RLX_AGENT __ATOMIC_RELAXED, __HIP_MEMORY_SCOPE_AGENT
#define LDS_WAIT() asm volatile("s_waitcnt lgkmcnt(0)" ::: "memory")
#define VM_WAIT() asm volatile("s_waitcnt vmcnt(0)" ::: "memory")

__device__ __forceinline__ unsigned f2bf(float f) { unsigned u = __builtin_bit_cast(unsigned, f); return (u + 0x7fffu + ((u >> 16) & 1u)) >> 16; }
__device__ __forceinline__ unsigned pk2(float lo, float hi) { return f2bf(lo) | (f2bf(hi) << 16); }
__device__ __forceinline__ float bf2f(unsigned short b) { return __builtin_bit_cast(float, (unsigned)b << 16); }
__device__ __forceinline__ float bflo(unsigned w) { return __builtin_bit_cast(float, w << 16); }
__device__ __forceinline__ float bfhi(unsigned w) { return __builtin_bit_cast(float, w & 0xffff0000u); }

constexpr size_t MiB = 1u << 20;
constexpr size_t al256(size_t x) { return (x + 255) & ~(size_t)255; }
constexpr size_t WS_CTL = 0, CTL_ZERO_BYTES = 1 * MiB;
constexpr size_t WS_WIN0T = 1 * MiB;
constexpr size_t WS_WOUT0T = WS_WIN0T + (size_t)AB_IN * D * 2;
constexpr size_t WS_WIN1T = WS_WOUT0T + (size_t)D * D * 2;
constexpr size_t WS_WOUT1T = WS_WIN1T + (size_t)C_IN * D * 2;
constexpr size_t WS_WGT = WS_WOUT1T + (size_t)D * C_OUT * 2;
constexpr size_t WS_WPT = WS_WGT + 2 * (size_t)D * D * 2;
constexpr size_t WS_WR = WS_WPT + 2 * (size_t)D * PLE * 2;
constexpr size_t WS_WUPT = al256(WS_WR + 2 * (size_t)NE * D * 4);
constexpr size_t WS_WDNT = WS_WUPT + 2 * (size_t)NE * 2 * DE * D * 2;
constexpr size_t WS_PBF = WS_WDNT + 2 * (size_t)NE * D * DE * 2;
constexpr size_t WS_PP = WS_PBF + 2 * (size_t)T * PLE * 2;
constexpr size_t WS_XN = WS_PP + 2 * (size_t)T * D * 2;
constexpr size_t WS_PROJ = WS_XN + (size_t)T * D * 2;
constexpr size_t WS_OCAT = WS_PROJ + (size_t)T * C_IN * 4;
constexpr size_t WS_OG = WS_OCAT + (size_t)T * D * 2;
constexpr size_t WS_LSE = WS_OG + 3 * (size_t)T * C_OUT * 4;
constexpr size_t WS_HM = WS_LSE + 3 * (size_t)T * 8 * 4;
constexpr size_t WS_H2 = WS_HM + (size_t)T * D * 4;
constexpr size_t WS_H3 = WS_H2 + (size_t)T * D * 4;
constexpr size_t WS_TOPE = WS_H3 + (size_t)T * D * 4;
constexpr size_t WS_TOPG = WS_TOPE + (size_t)T * 16;
constexpr size_t WS_TOPPOS = WS_TOPG + (size_t)T * 16;
constexpr size_t WS_RSTD = WS_TOPPOS + (size_t)T * 16;
constexpr size_t WS_TOKSLOT = WS_RSTD + (size_t)T * 4;
constexpr size_t WS_SLOTGATE = WS_TOKSLOT + (size_t)T * 16;
constexpr size_t WS_ULUP = al256(WS_SLOTGATE + (size_t)NSLOT * 4);
constexpr size_t WS_ULDN = WS_ULUP + 8 * 4096 * 8;
constexpr size_t WS_ULN = WS_ULDN + 8 * 4096 * 8;
constexpr size_t WS_XG = al256(WS_ULN + 256);
constexpr size_t WS_ACT = WS_XG + (size_t)NSLOT * D * 2;
constexpr size_t WS_Y = WS_ACT + (size_t)NSLOT * D * 2;
constexpr size_t WS_END = WS_Y + (size_t)NSLOT * D * 2;
constexpr int CW_TMO = 0;
constexpr int CW_CNT = 64;
constexpr int CW_BAR = 4096;

constexpr int RING_OFF = 0, RING_BYTES = 131072;
constexpr int LDSCTL_OFF = RING_BYTES, MISC_OFF = LDSCTL_OFF + 320;
constexpr int LDS_BYTES = 147456;

template <bool RESID> struct EpiF32 {
    static constexpr bool PERM = false, AFTER_DRAIN = false;
    float* C; int ldc; const float* resid;
    __device__ __forceinline__ void operator()(const pg8::f32x4 (&acc)[2][2][4][2], const pg8::Unit& u, int wr, int wc, int fr, int fq) const {
        const int row0 = u.pm * 256 + wr * 64 + fr, col0 = u.pn * 256 + wc * 32 + 4 * fq;
#pragma unroll
        for (int ai = 0; ai < 2; ++ai)
#pragma unroll
            for (int m = 0; m < 4; ++m) { const size_t ro = (size_t)(row0 + ai * 128 + m * 16) * ldc + col0; float* cp = C + ro; const float* rp = resid + ro;
#pragma unroll
                for (int bj = 0; bj < 2; ++bj)
#pragma unroll
                    for (int n = 0; n < 2; ++n) { pg8::f32x4 v = acc[ai][bj][m][n];
                        if (RESID) v += *(const pg8::f32x4*)(rp + bj * 128 + n * 16);
                        *(pg8::f32x4*)(cp + bj * 128 + n * 16) = v; }
                asm volatile("" ::: "memory"); }
    }
};
struct PPOrder {
    int G, c;
    __device__ __forceinline__ bool next(int i, pg8::Unit& u) const { const int L = i * G + c; if (L >= 512) return false; u.pm = L >> 2; u.pn = 4 * (u.pm >> 6) + (L & 3); return true; }
    __device__ __forceinline__ void a_ready(const pg8::Unit&) const {}
    __device__ __forceinline__ void done(const pg8::Unit&) const {}
};
struct EpiPP {
    static constexpr bool PERM = true, AFTER_DRAIN = false;
    bf16* O;
    __device__ __forceinline__ void operator()(const pg8::f32x4 (&acc)[2][2][4][2], const pg8::Unit& u, int wr, int wc, int fr, int fq) const {
        const int row0 = u.pm * 256 + wr * 64 + fr, col0 = (u.pn & 3) * 256 + wc * 32 + 8 * fq;
#pragma unroll
        for (int ai = 0; ai < 2; ++ai)
#pragma unroll
            for (int m = 0; m < 4; ++m) { bf16* rp = O + (size_t)(row0 + ai * 128 + m * 16) * D + col0;
#pragma unroll
                for (int bj = 0; bj < 2; ++bj) { const pg8::f32x4 v0 = acc[ai][bj][m][0], v1 = acc[ai][bj][m][1];
                    pg8::u32x4 w; w.x = pk2(v0[0], v0[1]); w.y = pk2(v0[2], v0[3]); w.z = pk2(v1[0], v1[1]); w.w = pk2(v1[2], v1[3]);
                    *(pg8::u32x4*)(rp + bj * 128) = w; } }
    }
};
__device__ __forceinline__ float sigmoidf_(float x) { return 1.0f / (1.0f + __expf(-x)); }
__device__ __forceinline__ float swiglu1(float g, float l) {
    g = fminf(g, 7.0f); l = fminf(fmaxf(l, -7.0f), 7.0f);
    return g * sigmoidf_(1.702f * g) * (l + 1.0f);
}
struct EpiSwiglu {
    static constexpr bool PERM = true, AFTER_DRAIN = false;
    bf16* ACT; const float* bup;
    __device__ __forceinline__ void operator()(const pg8::f32x4 (&acc)[2][2][4][2], const pg8::Unit& u, int wr, int wc, int fr, int fq) const {
        const int e = u.pn >> 3, j = u.pn & 7; const int row0 = u.pm * 256 + wr * 64 + fr, a0 = j * 128 + wc * 32 + 8 * fq;
        const float* bp = bup + (size_t)e * 2048 + 2 * a0; pg8::f32x4 b[4];
#pragma unroll
        for (int i = 0; i < 4; ++i) b[i] = *(const pg8::f32x4*)(bp + 4 * i);
#pragma unroll
        for (int ai = 0; ai < 2; ++ai)
#pragma unroll
            for (int m = 0; m < 4; ++m) { const size_t ro = (size_t)(row0 + ai * 128 + m * 16) * DE + a0;
                const pg8::f32x4 g0 = acc[ai][0][m][0], g1 = acc[ai][0][m][1], l0 = acc[ai][1][m][0], l1 = acc[ai][1][m][1];
                float o[8];
                o[0] = swiglu1(g0[0] + b[0][0], l0[0] + b[0][1]); o[1] = swiglu1(g0[1] + b[0][2], l0[1] + b[0][3]);
                o[2] = swiglu1(g0[2] + b[1][0], l0[2] + b[1][1]); o[3] = swiglu1(g0[3] + b[1][2], l0[3] + b[1][3]);
                o[4] = swiglu1(g1[0] + b[2][0], l1[0] + b[2][1]); o[5] = swiglu1(g1[1] + b[2][2], l1[1] + b[2][3]);
                o[6] = swiglu1(g1[2] + b[3][0], l1[2] + b[3][1]); o[7] = swiglu1(g1[3] + b[3][2], l1[3] + b[3][3]);
                pg8::u32x4 w; w.x = pk2(o[0], o[1]); w.y = pk2(o[2], o[3]); w.z = pk2(o[4], o[5]); w.w = pk2(o[6], o[7]);
                *(pg8::u32x4*)(ACT + ro) = w; }
    }
};
struct EpiDown {
    static constexpr bool PERM = true, AFTER_DRAIN = false;
    bf16* Y; const float* bdn; const float* gate;
    __device__ __forceinline__ void operator()(const pg8::f32x4 (&acc)[2][2][4][2], const pg8::Unit& u, int wr, int wc, int fr, int fq) const {
        const int e = u.pn >> 2, j = u.pn & 3; const int row0 = u.pm * 256 + wr * 64 + fr, col0 = j * 256 + wc * 32 + 8 * fq;
        pg8::f32x4 bv[2][2];
#pragma unroll
        for (int bj = 0; bj < 2; ++bj)
#pragma unroll
            for (int n = 0; n < 2; ++n) bv[bj][n] = *(const pg8::f32x4*)(bdn + (size_t)e * D + col0 + bj * 128 + 4 * n);
#pragma unroll
        for (int ai = 0; ai < 2; ++ai)
#pragma unroll
            for (int m = 0; m < 4; ++m) { const int r = row0 + ai * 128 + m * 16; const float gt = gate[r];
#pragma unroll
                for (int bj = 0; bj < 2; ++bj) { const pg8::f32x4 v0 = (acc[ai][bj][m][0] + bv[bj][0]) * gt, v1 = (acc[ai][bj][m][1] + bv[bj][1]) * gt;
                    pg8::u32x4 w; w.x = pk2(v0[0], v0[1]); w.y = pk2(v0[2], v0[3]); w.z = pk2(v1[0], v1[1]); w.w = pk2(v1[2], v1[3]);
                    *(pg8::u32x4*)(Y + (size_t)r * D + col0 + bj * 128) = w; } }
    }
};
struct EpiPle {
    static constexpr bool PERM = false, AFTER_DRAIN = false;
    const float* H2; const bf16* PP; float* H3;
    __device__ __forceinline__ void operator()(const pg8::f32x4 (&acc)[2][2][4][2], const pg8::Unit& u, int wr, int wc, int fr, int fq) const {
        const int row0 = u.pm * 256 + wr * 64 + fr, col0 = u.pn * 256 + wc * 32 + 4 * fq;
#pragma unroll
        for (int ai = 0; ai < 2; ++ai)
#pragma unroll
            for (int m = 0; m < 4; ++m) { const size_t ro = (size_t)(row0 + ai * 128 + m * 16) * D + col0;
#pragma unroll
                for (int bj = 0; bj < 2; ++bj)
#pragma unroll
                    for (int n = 0; n < 2; ++n) { const size_t o = ro + bj * 128 + n * 16; const pg8::f32x4 a = acc[ai][bj][m][n];
                        const pg8::f32x4 h = *(const pg8::f32x4*)(H2 + o); const v2u pw = *(const v2u*)(PP + o);
                        pg8::f32x4 r; r[0] = h[0] + bflo(pw.x) * sigmoidf_(a[0]); r[1] = h[1] + bfhi(pw.x) * sigmoidf_(a[1]);
                        r[2] = h[2] + bflo(pw.y) * sigmoidf_(a[2]); r[3] = h[3] + bfhi(pw.y) * sigmoidf_(a[3]);
                        *(pg8::f32x4*)(H3 + o) = r; } }
    }
};
struct ListOrder {
    const int2* list; int n, rank, stride;
    __device__ __forceinline__ bool next(int i, pg8::Unit& u) const { const int q = i * stride + rank; if (q >= n) return false; const int2 e = list[q]; u.pm = e.x; u.pn = e.y; return true; }
    __device__ __forceinline__ void a_ready(const pg8::Unit&) const {}
    __device__ __forceinline__ void done(const pg8::Unit&) const {}
};
#define XB_TMO      128
#define XB_XCNT(j)  (256  + 64 * (j))
#define XB_XSUB(j)  (1280 + 64 * (j))
#define XB_XGEN(j)  (2304 + 64 * (j))
#define XB_TOP      3328
#define XB_TOPGEN   3392
#define XCD_BAR_WORDS 3456
#define XB_SPIN_CAP (1u << 18)

__device__ __forceinline__ unsigned xb_ld(unsigned* p)              { return __hip_atomic_load(p, __ATOMIC_RELAXED, __HIP_MEMORY_SCOPE_AGENT); }
__device__ __forceinline__ unsigned xb_add(unsigned* p, unsigned v) { return __hip_atomic_fetch_add(p, v, __ATOMIC_RELAXED, __HIP_MEMORY_SCOPE_AGENT); }
__device__ __forceinline__ unsigned xb_xcc_id() { return (unsigned)__builtin_amdgcn_s_getreg((3 << 11) | 20) & 0xFu; }
#define XB_SPIN(cond, bar) do { unsigned _sp = 0; while (cond) { __builtin_amdgcn_s_sleep(1); \
    if ((++_sp & 255u) == 0u) { if (xb_ld(&(bar)[XB_TMO])) break; if (_sp > XB_SPIN_CAP) { atomicAdd(&(bar)[XB_TMO], 1u); break; } } } } while (0)

struct XcdBarrier {
    unsigned* bar; unsigned x;
    volatile LAS unsigned* st;
};

__device__ __forceinline__ XcdBarrier xcd_barrier_post(unsigned* bar, volatile LAS unsigned* st) {
    XcdBarrier b; b.bar = bar; b.x = xb_xcc_id(); b.st = st;
    if (threadIdx.x == 0) (void)xb_add(&bar[XB_XCNT(b.x)], 1u);
    return b;
}
__device__ __forceinline__ void xcd_barrier_complete(unsigned* bar, unsigned x, unsigned& nloc, unsigned& nx) {
    const unsigned G = gridDim.x * gridDim.y * gridDim.z;
    unsigned sum, cnt, mine, sp = 0u;
    for (;;) {
        sum = 0u; cnt = 0u; mine = 0u;
#pragma unroll
        for (unsigned j = 0; j < 16; ++j) { const unsigned c = xb_ld(&bar[XB_XCNT(j)]); sum += c; cnt += (c > 0u) ? 1u : 0u; mine = (j == x) ? c : mine; }
        if (sum == G) break;
        __builtin_amdgcn_s_sleep(1);
        if ((++sp & 255u) == 0u) { if (xb_ld(&bar[XB_TMO])) break; if (sp > XB_SPIN_CAP) { atomicAdd(&bar[XB_TMO], 1u); break; } }
    }
    nloc = mine > 0u ? mine : 1u; nx = cnt > 0u ? cnt : 1u;
}

__device__ __forceinline__ void xcd_barrier(const XcdBarrier& b) {
    asm volatile("s_waitcnt vmcnt(0)" ::: "memory");
    __syncthreads();
    if (threadIdx.x == 0) {
        unsigned* bar = b.bar;
        __builtin_amdgcn_s_waitcnt(0);
        unsigned nloc = b.st[0], nx = b.st[1];
        if (nloc == 0u) { xcd_barrier_complete(bar, b.x, nloc, nx); b.st[0] = nloc; b.st[1] = nx; }
        const unsigned old = xb_add(&bar[XB_XSUB(b.x)], 1u);
        const unsigned gen = old / nloc;
        if (old + 1u == (gen + 1u) * nloc) {
            __builtin_amdgcn_fence(__ATOMIC_RELEASE, "agent");
            asm volatile("s_waitcnt vmcnt(0)" ::: "memory");
            const unsigned og = xb_add(&bar[XB_TOP], 1u);
            const unsigned tg = og / nx;
            if (og + 1u == (tg + 1u) * nx) xb_add(&bar[XB_TOPGEN], 1u);
            else XB_SPIN(xb_ld(&bar[XB_TOPGEN]) == tg, bar);
            __builtin_amdgcn_fence(__ATOMIC_ACQUIRE, "agent");
            xb_add(&bar[XB_XGEN(b.x)], 1u);
            asm volatile("s_waitcnt vmcnt(0)" ::: "memory");
        } else {
            XB_SPIN(xb_ld(&bar[XB_XGEN(b.x)]) == gen, bar);
            __builtin_amdgcn_fence(__ATOMIC_ACQUIRE, "agent");
            asm volatile("s_waitcnt vmcnt(0)" ::: "memory");
        }
    }
    __syncthreads();
}

struct Frame {
    LAS unsigned char* lds;
    volatile LAS unsigned* MISC;
    gu32* ctl;
    int tid, lane, wave, vcu, G, bx;
    int gw, NGW;
};
__device__ __forceinline__ bool refresh(Frame& F) {
    int t = threadIdx.x; asm volatile("" : "+v"(t)); F.tid = t; F.lane = t & 63; F.wave = __builtin_amdgcn_readfirstlane(t >> 6);
    int bx = blockIdx.x, G = gridDim.x; asm volatile("" : "+s"(bx), "+s"(G)); F.bx = bx; F.G = G;
    F.vcu = (G % 8 == 0) ? (bx % 8) * (G / 8) + bx / 8 : bx; F.gw = F.vcu * NWAVES + F.wave; F.NGW = G * NWAVES; return true; }
__device__ __forceinline__ float wave_sum(float v) {
#pragma unroll
    for (int o = 1; o < 64; o <<= 1) v += __shfl_xor(v, o);
    return v;
}
template <int MAP> __device__ __forceinline__ int rowmap(int n) { if (MAP == 1) { const int f = n >> 1; return 256 * (f >> 7) + 128 * (n & 1) + (f & 127); } return n; }
template <int MAP> __device__ __forceinline__ void transpose_item(const float* W, int K, int N, bf16* WT, const float* gain, LAS float* scr, int item, int lane) {
    const int nblk = N / 32, kb = item / nblk, nb = item % nblk, k0 = 64 * kb, n0 = 32 * nb;
#pragma unroll 8
    for (int i = 0; i < 32; ++i) { const int kk = 2 * i + (lane >> 5); float v = W[(size_t)(k0 + kk) * N + n0 + (lane & 31)]; if (gain) v *= gain[k0 + kk]; scr[kk * 33 + (lane & 31)] = v; }
    LDS_WAIT(); asm volatile("" ::: "memory");
    const int c = lane & 7;
#pragma unroll
    for (int j = 0; j < 4; ++j) { const int n = (lane >> 3) + 8 * j; const LAS float* s = scr + (8 * c) * 33 + n;
        v4u o; o.x = pk2(s[0 * 33], s[1 * 33]); o.y = pk2(s[2 * 33], s[3 * 33]); o.z = pk2(s[4 * 33], s[5 * 33]); o.w = pk2(s[6 * 33], s[7 * 33]);
        *(GAS v4u*)(WT + (size_t)rowmap<MAP>(n0 + n) * K + k0 + 8 * c) = o; }
    LDS_WAIT(); asm volatile("" ::: "memory");
}
template <int MAP> __device__ __forceinline__ void transpose_all(Frame& F, const float* W, int K, int N, bf16* WT, const float* gain) {
    LAS float* scr = (LAS float*)(F.lds + RING_OFF + F.wave * 16384);
    const int nitems = (K / 64) * (N / 32);
    for (int it = F.gw; it < nitems; it += F.NGW) transpose_item<MAP>(W, K, N, WT, gain, scr, it, F.lane);
}
__device__ __forceinline__ float norm_row_to_bf16(const float* xrow, bf16* orow, int lane) {
    const GAS f32x4* xr = (const GAS f32x4*)xrow + lane;
    f32x4 v[4]; float s = 0.f;
#pragma unroll
    for (int j = 0; j < 4; ++j) { v[j] = xr[64 * j]; s += (v[j].x * v[j].x + v[j].y * v[j].y) + (v[j].z * v[j].z + v[j].w * v[j].w); }
    const float rstd = 1.f / sqrtf(wave_sum(s) * (1.f / D) + NORM_EPS);
    GAS unsigned long long* o8 = (GAS unsigned long long*)orow + lane;
#pragma unroll
    for (int j = 0; j < 4; ++j) o8[64 * j] = (unsigned long long)pk2(v[j].x * rstd, v[j].y * rstd) | ((unsigned long long)pk2(v[j].z * rstd, v[j].w * rstd) << 32);
    return rstd;
}

__device__ __forceinline__ float rope_freq(int i, int half_dim) { return exp2f(-(float)i / (float)half_dim * LOG2_THETA); }
__device__ __forceinline__ void rope_phase_l0(Frame& F, float* PROJ, const float* qg, const float* kg) {
    const int lane = F.lane;
    const float gq = qg[lane], gk = kg[lane];
    const int ll = lane & 31, ia = ll & 15, i1 = lane & 31;
    const float fa = rope_freq(ia, 16), f1 = rope_freq(i1, 32);
    for (int m = F.gw; m < T; m += F.NGW) {
        float* pr = PROJ + (size_t)m * AB_IN;
        const int pos = m % SEQ; const int pa = (lane >> 5) ? (pos & 63) : (pos >> 6);
        const float anga = (float)pa * fa, ang1 = (float)pos * f1;
        const float ca = cosf(anga), sa = sinf(anga), c1 = cosf(ang1), s1 = sinf(ang1);
#pragma unroll 1
        for (int h = 0; h < 10; ++h) {
            const float x = pr[h * 64 + lane]; const float ss = wave_sum(x * x);
            const float y = x * (1.f / sqrtf(ss * (1.f / 64.f) + NORM_EPS)) * (h < 8 ? gq : gk);
            const float pt = __shfl_xor(y, 16);
            pr[h * 64 + lane] = (ll < 16) ? (y * ca - pt * sa) : (y * ca + pt * sa);
        }
#pragma unroll 1
        for (int h = 12; h < 22; ++h) {
            const float y = pr[h * 64 + lane]; const float pt = __shfl_xor(y, 32);
            pr[h * 64 + lane] = (lane < 32) ? (y * c1 - pt * s1) : (y * c1 + pt * s1);
        }
    }
}
__device__ __forceinline__ void rope_phase_l1(Frame& F, float* PROJ) {
    const int lane = F.lane; const float f1 = rope_freq(lane & 31, 32);
    for (int m = F.gw; m < T; m += F.NGW) {
        float* pr = PROJ + (size_t)m * C_IN; const int pos = m % SEQ;
        const float ang1 = (float)pos * f1; const float c1 = cosf(ang1), s1 = sinf(ang1);
#pragma unroll 1
        for (int g = 0; g < 3; ++g)
#pragma unroll 1
            for (int h = 0; h < 10; ++h) { float* p = pr + g * 768 + h * 64 + lane; const float y = *p; const float pt = __shfl_xor(y, 32);
                *p = (lane < 32) ? (y * c1 - pt * s1) : (y * c1 + pt * s1); }
    }
}

__device__ __forceinline__ void attn_dense_naive(Frame& F, const float* PROJ, bf16* OCAT) {
    LAS float* Ks = (LAS float*)(F.lds + RING_OFF); LAS float* Vs = Ks + 64 * 64;
    const int nitems = BATCH * 8 * (SEQ / 512);
    for (int it = blockIdx.x; it < nitems; it += gridDim.x) {
        const int qb = it % (SEQ / 512), hq = (it / (SEQ / 512)) % 8, b = it / (8 * (SEQ / 512)); const int hkv = hq >> 2;
        const size_t qrow = (size_t)b * SEQ + qb * 512 + F.tid;
        float q[64], o[64];
        { const f32x4* qp = (const f32x4*)(PROJ + qrow * AB_IN + hq * 64);
#pragma unroll
          for (int i = 0; i < 16; ++i) { const f32x4 v = qp[i]; q[4 * i] = v.x * 0.125f; q[4 * i + 1] = v.y * 0.125f; q[4 * i + 2] = v.z * 0.125f; q[4 * i + 3] = v.w * 0.125f; } }
#pragma unroll
        for (int d = 0; d < 64; ++d) o[d] = 0.f;
        float mx = -INFINITY, l = 0.f;
        for (int kt = 0; kt < SEQ / 64; ++kt) {
            __syncthreads();
            { const size_t krow0 = (size_t)b * SEQ + kt * 64;
#pragma unroll
              for (int i = 0; i < 2; ++i) { const int idx = F.tid + 512 * i; const int r = idx >> 4, c4 = idx & 15;
                  const float* src = PROJ + (krow0 + r) * AB_IN;
                  *(LAS f32x4*)(Ks + r * 64 + c4 * 4) = *(const f32x4*)(src + 512 + hkv * 64 + c4 * 4);
                  *(LAS f32x4*)(Vs + r * 64 + c4 * 4) = *(const f32x4*)(src + 640 + hkv * 64 + c4 * 4); } }
            __syncthreads();
#pragma unroll 2
            for (int j = 0; j < 64; ++j) {
                float s = 0.f;
#pragma unroll
                for (int i = 0; i < 16; ++i) { const f32x4 kv = *(const LAS f32x4*)(Ks + j * 64 + 4 * i); s += q[4 * i] * kv.x + q[4 * i + 1] * kv.y + q[4 * i + 2] * kv.z + q[4 * i + 3] * kv.w; }
                if (s > mx) { const float c = __expf(mx - s); l *= c;
#pragma unroll
                    for (int d = 0; d < 64; ++d) o[d] *= c;
                    mx = s; }
                const float p = __expf(s - mx); l += p;
#pragma unroll
                for (int i = 0; i < 16; ++i) { const f32x4 vv = *(const LAS f32x4*)(Vs + j * 64 + 4 * i); o[4 * i] += p * vv.x; o[4 * i + 1] += p * vv.y; o[4 * i + 2] += p * vv.z; o[4 * i + 3] += p * vv.w; }
            }
        }
        const float il = 1.f / l; bf16* op = OCAT + qrow * D + hq * 64;
#pragma unroll
        for (int i = 0; i < 8; ++i) { v4u w; w.x = pk2(o[8 * i] * il, o[8 * i + 1] * il); w.y = pk2(o[8 * i + 2] * il, o[8 * i + 3] * il); w.z = pk2(o[8 * i + 4] * il, o[8 * i + 5] * il); w.w = pk2(o[8 * i + 6] * il, o[8 * i + 7] * il); *(v4u*)(op + 8 * i) = w; }
    }
}
template <int MODE> __device__ __forceinline__ void attn_band_naive(Frame& F, const float* PROJ, int pitch, int qoff, int koff, int voff, int nside, int dil, const float* sink, bf16* OCAT, float* OG, float* LSE) {
    const int total = 8 * T;
    for (int gi = F.gw * 64 + F.lane; gi < total; gi += F.NGW * 64) {
        const int tok = gi % T, h = gi / T, hkv = h >> 2; const int b = tok / SEQ, pos = tok % SEQ;
        float q[64], o[64];
        { const f32x4* qp = (const f32x4*)(PROJ + (size_t)tok * pitch + qoff + h * 64);
#pragma unroll
          for (int i = 0; i < 16; ++i) { const f32x4 v = qp[i]; q[4 * i] = v.x * 0.125f; q[4 * i + 1] = v.y * 0.125f; q[4 * i + 2] = v.z * 0.125f; q[4 * i + 3] = v.w * 0.125f; } }
#pragma unroll
        for (int d = 0; d < 64; ++d) o[d] = 0.f;
        float mx = -INFINITY, l = 0.f;
        for (int j = -nside; j <= nside; ++j) {
            const int kp = pos + j * dil; if (kp < 0 || kp >= SEQ) continue;
            const float* kr = PROJ + ((size_t)b * SEQ + kp) * pitch;
            float s = 0.f;
#pragma unroll
            for (int i = 0; i < 16; ++i) { const f32x4 kv = *(const f32x4*)(kr + koff + hkv * 64 + 4 * i); s += q[4 * i] * kv.x + q[4 * i + 1] * kv.y + q[4 * i + 2] * kv.z + q[4 * i + 3] * kv.w; }
            if (s > mx) { const float c = __expf(mx - s); l *= c;
#pragma unroll
                for (int d = 0; d < 64; ++d) o[d] *= c;
                mx = s; }
            const float p = __expf(s - mx); l += p;
#pragma unroll
            for (int i = 0; i < 16; ++i) { const f32x4 vv = *(const f32x4*)(kr + voff + hkv * 64 + 4 * i); o[4 * i] += p * vv.x; o[4 * i + 1] += p * vv.y; o[4 * i + 2] += p * vv.z; o[4 * i + 3] += p * vv.w; }
        }
        if (MODE == 0) {
            const float sk = sink[h]; const float m2 = fmaxf(mx, sk); const float c = __expf(mx - m2); l = l * c + __expf(sk - m2); const float il = c / l;
            bf16* op = OCAT + (size_t)tok * D + 512 + h * 64;
#pragma unroll
            for (int i = 0; i < 8; ++i) { v4u w; w.x = pk2(o[8 * i] * il, o[8 * i + 1] * il); w.y = pk2(o[8 * i + 2] * il, o[8 * i + 3] * il); w.z = pk2(o[8 * i + 4] * il, o[8 * i + 5] * il); w.w = pk2(o[8 * i + 6] * il, o[8 * i + 7] * il); *(v4u*)(op + 8 * i) = w; }
        } else {
            const float il = 1.f / l; float* op = OG + (size_t)tok * C_OUT + h * 64;
#pragma unroll
            for (int i = 0; i < 16; ++i) { f32x4 w; w.x = o[4 * i] * il; w.y = o[4 * i + 1] * il; w.z = o[4 * i + 2] * il; w.w = o[4 * i + 3] * il; *(f32x4*)(op + 4 * i) = w; }
            LSE[(size_t)tok * 8 + h] = mx + __logf(l);
        }
    }
}
__device__ __forceinline__ void merge_phase(Frame& F, const float* OG, const float* LSE, bf16* OCAT1) {
    for (int m = F.gw; m < T; m += F.NGW) {
        const int h = F.lane >> 3;
        const float l0 = LSE[(size_t)m * 8 + h], l1 = LSE[(size_t)T * 8 + (size_t)m * 8 + h], l2 = LSE[(size_t)2 * T * 8 + (size_t)m * 8 + h];
        const float mx = fmaxf(l0, fmaxf(l1, l2)); float w0 = __expf(l0 - mx), w1 = __expf(l1 - mx), w2 = __expf(l2 - mx); const float is = 1.f / (w0 + w1 + w2); w0 *= is; w1 *= is; w2 *= is;
        const size_t off = (size_t)m * C_OUT + F.lane * 8; float r[8];
#pragma unroll
        for (int i = 0; i < 2; ++i) { const f32x4 a = *(const f32x4*)(OG + off + 4 * i), b = *(const f32x4*)(OG + (size_t)T * C_OUT + off + 4 * i), c = *(const f32x4*)(OG + (size_t)2 * T * C_OUT + off + 4 * i);
            r[4 * i] = w0 * a.x + w1 * b.x + w2 * c.x; r[4 * i + 1] = w0 * a.y + w1 * b.y + w2 * c.y; r[4 * i + 2] = w0 * a.z + w1 * b.z + w2 * c.z; r[4 * i + 3] = w0 * a.w + w1 * b.w + w2 * c.w; }
        v4u w; w.x = pk2(r[0], r[1]); w.y = pk2(r[2], r[3]); w.z = pk2(r[4], r[5]); w.w = pk2(r[6], r[7]);
        *(v4u*)(OCAT1 + off) = w;
    }
}

__device__ __forceinline__ void route_phase(Frame& F, const float* H, const float* WR, const float* rb, gu32* cnt, int* TOPE, float* TOPG, int* TOPPOS, float* RSTD) {
    const int lane = F.lane;
    for (int m = F.gw; m < T; m += F.NGW) {
        const GAS f32x4* xr = (const GAS f32x4*)(H + (size_t)m * D) + lane;
        f32x4 v[4]; float s = 0.f;
#pragma unroll
        for (int j = 0; j < 4; ++j) { v[j] = xr[64 * j]; s += (v[j].x * v[j].x + v[j].y * v[j].y) + (v[j].z * v[j].z + v[j].w * v[j].w); }
        const float rstd = 1.f / sqrtf(wave_sum(s) * (1.f / D) + NORM_EPS);
        float lg[32];
#pragma unroll
        for (int e = 0; e < 32; ++e) { const GAS f32x4* wr = (const GAS f32x4*)(WR + (size_t)e * D) + lane; float a = 0.f;
#pragma unroll
            for (int j = 0; j < 4; ++j) { const f32x4 w = wr[64 * j]; a += (v[j].x * w.x + v[j].y * w.y) + (v[j].z * w.z + v[j].w * w.w); }
            lg[e] = wave_sum(a) * rstd + rb[e]; }
        unsigned used = 0u; float tv[4]; int ti[4];
#pragma unroll
        for (int k = 0; k < 4; ++k) { float best = -INFINITY; int bi = 0;
#pragma unroll
            for (int e = 0; e < 32; ++e) { const bool take = (lg[e] > best) && !((used >> e) & 1u); best = take ? lg[e] : best; bi = take ? e : bi; }
            used |= 1u << bi; tv[k] = best; ti[k] = bi; }
        const float e1 = __expf(tv[1] - tv[0]), e2 = __expf(tv[2] - tv[0]), e3 = __expf(tv[3] - tv[0]); const float is = 1.f / (1.f + e1 + e2 + e3);
        if (lane < 4) { const int e = lane == 0 ? ti[0] : lane == 1 ? ti[1] : lane == 2 ? ti[2] : ti[3]; const float g = (lane == 0 ? 1.f : lane == 1 ? e1 : lane == 2 ? e2 : e3) * is;
            const unsigned pos = __hip_atomic_fetch_add(cnt + e, 1u, RLX_AGENT);
            TOPE[m * 4 + lane] = e; TOPG[m * 4 + lane] = g; TOPPOS[m * 4 + lane] = (int)pos; }
        if (lane == 0) RSTD[m] = rstd;
    }
}
__device__ __forceinline__ void slot_phase(Frame& F, const float* H, gu32* cnt, const int* TOPE, const float* TOPG, const int* TOPPOS, const float* RSTD, int* TOKSLOT, float* SLOTGATE, bf16* XG, int2* ULUP, int2* ULDN, int* ULN) {
    LAS int* L = (LAS int*)(F.lds + RING_OFF);
    if (F.tid < 32) L[F.tid] = ((int)__hip_atomic_load(cnt + F.tid, RLX_AGENT) + 255) >> 8;
    __syncthreads();
    if (F.tid == 0) { int acc = 0; for (int e = 0; e < 32; ++e) { L[32 + e] = acc; acc += L[e] * 256; } }
    __syncthreads();
    if (blockIdx.x == 0) {
        if (F.tid == 0) {
            for (int x = 0; x < 8; ++x) L[96 + x] = 0;
            for (int e = 0; e < 32; ++e) L[64 + e] = -1;
            for (int it = 0; it < 32; ++it) { int be = 0, bn = -1; for (int e = 0; e < 32; ++e) if (L[64 + e] < 0 && L[e] > bn) { bn = L[e]; be = e; }
                int bx = 0, bl = 1 << 30; for (int x = 0; x < 8; ++x) if (L[96 + x] < bl) { bl = L[96 + x]; bx = x; }
                L[64 + be] = bx; L[96 + bx] += bn; L[104 + it] = be; }
        }
        __syncthreads();
        if (F.tid < 8) { const int x = F.tid; int nu = 0, nd = 0;
            for (int it = 0; it < 32; ++it) { const int e = L[104 + it]; if (L[64 + e] != x) continue; const int np = L[e], p0 = L[32 + e] >> 8;
                for (int pi = 0; pi < np; ++pi) { for (int j = 0; j < 8; ++j) ULUP[x * 4096 + nu++] = make_int2(p0 + pi, e * 8 + j); for (int j = 0; j < 4; ++j) ULDN[x * 4096 + nd++] = make_int2(p0 + pi, e * 4 + j); } }
            ULN[x] = nu; ULN[8 + x] = nd; }
    }
    const int lane = F.lane;
    for (int m = F.gw; m < T; m += F.NGW) {
        int slot = 0;
        if (lane < 4) { const int e = TOPE[m * 4 + lane]; slot = L[32 + e] + TOPPOS[m * 4 + lane]; TOKSLOT[m * 4 + lane] = slot; SLOTGATE[slot] = TOPG[m * 4 + lane]; }
        const int s0 = __shfl(slot, 0), s1 = __shfl(slot, 1), s2 = __shfl(slot, 2), s3 = __shfl(slot, 3);
        const float rstd = RSTD[m];
#pragma unroll
        for (int j = 0; j < 2; ++j) { const float* src = H + (size_t)m * D + j * 512 + lane * 8; const f32x4 a = *(const f32x4*)src, b = *(const f32x4*)(src + 4);
            v4u w; w.x = pk2(a.x * rstd, a.y * rstd); w.y = pk2(a.z * rstd, a.w * rstd); w.z = pk2(b.x * rstd, b.y * rstd); w.w = pk2(b.z * rstd, b.w * rstd);
            const size_t co = (size_t)j * 512 + lane * 8;
            *(v4u*)(XG + (size_t)s0 * D + co) = w; *(v4u*)(XG + (size_t)s1 * D + co) = w; *(v4u*)(XG + (size_t)s2 * D + co) = w; *(v4u*)(XG + (size_t)s3 * D + co) = w; }
    }
    __syncthreads();
}
__device__ __forceinline__ void combine_phase(Frame& F, const float* HM, const bf16* Y, const int* TOKSLOT, float* H2, bf16* XN2) {
    const int lane = F.lane;
    for (int m = F.gw; m < T; m += F.NGW) {
        const int s0 = TOKSLOT[m * 4], s1 = TOKSLOT[m * 4 + 1], s2 = TOKSLOT[m * 4 + 2], s3 = TOKSLOT[m * 4 + 3];
#pragma unroll
        for (int j = 0; j < 2; ++j) { const size_t co = (size_t)j * 512 + lane * 8; const float* src = HM + (size_t)m * D + co; f32x4 a = *(const f32x4*)src, b = *(const f32x4*)(src + 4);
            const v4u y0 = *(const v4u*)(Y + (size_t)s0 * D + co), y1 = *(const v4u*)(Y + (size_t)s1 * D + co), y2 = *(const v4u*)(Y + (size_t)s2 * D + co), y3 = *(const v4u*)(Y + (size_t)s3 * D + co);
            a.x += ((bflo(y0.x) + bflo(y1.x)) + bflo(y2.x)) + bflo(y3.x); a.y += ((bfhi(y0.x) + bfhi(y1.x)) + bfhi(y2.x)) + bfhi(y3.x);
            a.z += ((bflo(y0.y) + bflo(y1.y)) + bflo(y2.y)) + bflo(y3.y); a.w += ((bfhi(y0.y) + bfhi(y1.y)) + bfhi(y2.y)) + bfhi(y3.y);
            b.x += ((bflo(y0.z) + bflo(y1.z)) + bflo(y2.z)) + bflo(y3.z); b.y += ((bfhi(y0.z) + bfhi(y1.z)) + bfhi(y2.z)) + bfhi(y3.z);
            b.z += ((bflo(y0.w) + bflo(y1.w)) + bflo(y2.w)) + bflo(y3.w); b.w += ((bfhi(y0.w) + bfhi(y1.w)) + bfhi(y2.w)) + bfhi(y3.w);
            float* dst = H2 + (size_t)m * D + co; *(f32x4*)dst = a; *(f32x4*)(dst + 4) = b;
            v4u w; w.x = pk2(a.x, a.y); w.y = pk2(a.z, a.w); w.z = pk2(b.x, b.y); w.w = pk2(b.z, b.w); *(v4u*)(XN2 + (size_t)m * D + co) = w; }
    }
}
__device__ __forceinline__ void final_norm_phase(Frame& F, const float* H, const float* gain, float* out) {
    const int lane = F.lane;
    for (int m = F.gw; m < T; m += F.NGW) {
        const GAS f32x4* xr = (const GAS f32x4*)(H + (size_t)m * D) + lane; const f32x4* gr = (const f32x4*)gain + lane;
        f32x4 v[4]; float s = 0.f;
#pragma unroll
        for (int j = 0; j < 4; ++j) { v[j] = xr[64 * j]; s += (v[j].x * v[j].x + v[j].y * v[j].y) + (v[j].z * v[j].z + v[j].w * v[j].w); }
        const float rstd = 1.f / sqrtf(wave_sum(s) * (1.f / D) + NORM_EPS);
        f32x4* o = (f32x4*)(out + (size_t)m * D) + lane;
#pragma unroll
        for (int j = 0; j < 4; ++j) { const f32x4 g = gr[64 * j]; o[64 * j] = v[j] * rstd * g; }
    }
}

constexpr int N_PHASES = 26;
struct Args { const float* in[20]; float* out; unsigned char* ws; int ph_lo, ph_hi, li, pad; };
typedef const __attribute__((address_space(4))) Args* argp_t;
__device__ __forceinline__ argp_t opaque_args() { argp_t p = (argp_t)__builtin_amdgcn_kernarg_segment_ptr(); asm volatile("" : "+s"(p)); return p; }
#define AP (opaque_args())
__global__ void __launch_bounds__(NWAVES * 64, 2) fwd_kernel(Args args_unused) {
    extern __shared__ __attribute__((aligned(16))) unsigned char lds[];
    Frame F;
    F.lds = (LAS unsigned char*)lds;
    F.MISC = (volatile LAS unsigned*)(F.lds + MISC_OFF);
    refresh(F);
    F.ctl = (gu32*)(AP->ws + WS_CTL);
    for (int u = F.tid; u < (LDS_BYTES - LDSCTL_OFF) / 4; u += NWAVES * 64) ((LAS unsigned*)(F.lds + LDSCTL_OFF))[u] = 0u;
    __syncthreads();
    const bool one_phase = (AP->ph_hi - AP->ph_lo) == 1;
    XcdBarrier bar; bar.bar = (unsigned*)(F.ctl + CW_BAR); bar.x = 0; bar.st = nullptr;
    if (!one_phase) bar = xcd_barrier_post((unsigned*)(F.ctl + CW_BAR), F.MISC + 8);
    const int lo = AP->ph_lo, hi = AP->ph_hi;
#ifndef MK_MASK
#define MK_MASK 0x3fff
#endif
#define IN(k) (lo <= (k) && (k) < hi)
#define INL(j) (((MK_MASK >> (j)) & 1) && IN(pb + (j)) && refresh(F))
#define SEAM(k) do { if (IN((k) + 1)) xcd_barrier(bar); } while (0)
#define ws (AP->ws)
#define x_in ((const float*)AP->in[0])
#define p_in ((const float*)AP->in[1])
#define XN ((bf16*)(ws + WS_XN))
#define PROJ ((float*)(ws + WS_PROJ))
#define OCAT ((bf16*)(ws + WS_OCAT))
#define OG ((float*)(ws + WS_OG))
#define LSE ((float*)(ws + WS_LSE))
#define HM ((float*)(ws + WS_HM))
#define H2 ((float*)(ws + WS_H2))
#define H3 ((float*)(ws + WS_H3))
#define TOPE ((int*)(ws + WS_TOPE))
#define TOPG ((float*)(ws + WS_TOPG))
#define TOPPOS ((int*)(ws + WS_TOPPOS))
#define RSTD ((float*)(ws + WS_RSTD))
#define TOKSLOT ((int*)(ws + WS_TOKSLOT))
#define SLOTGATE ((float*)(ws + WS_SLOTGATE))
#define ULUP ((int2*)(ws + WS_ULUP))
#define ULDN ((int2*)(ws + WS_ULDN))
#define ULN ((int*)(ws + WS_ULN))
#define XG ((bf16*)(ws + WS_XG))
#define ACT ((bf16*)(ws + WS_ACT))
#define Y ((bf16*)(ws + WS_Y))
    if (((MK_MASK >> 12) & 1) && IN(0) && refresh(F)) {
        transpose_all<0>(F, AP->in[3], D, AB_IN, (bf16*)(ws + WS_WIN0T), AP->in[2]);
        transpose_all<0>(F, AP->in[7], D, D, (bf16*)(ws + WS_WOUT0T), nullptr);
        transpose_all<0>(F, AP->in[8], D, C_IN, (bf16*)(ws + WS_WIN1T), AP->in[2] + D);
        transpose_all<0>(F, AP->in[9], C_OUT, D, (bf16*)(ws + WS_WOUT1T), nullptr);
#pragma unroll 1
        for (int l = 0; l < 2; ++l) {
            transpose_all<0>(F, AP->in[18] + (size_t)l * D * D, D, D, (bf16*)(ws + WS_WGT) + (size_t)l * D * D, nullptr);
            transpose_all<0>(F, AP->in[17] + (size_t)l * PLE * D, PLE, D, (bf16*)(ws + WS_WPT) + (size_t)l * D * PLE, nullptr);
#pragma unroll 1
            for (int e = 0; e < NE; ++e) {
                transpose_all<1>(F, AP->in[13] + ((size_t)l * NE + e) * D * 2 * DE, D, 2 * DE, (bf16*)(ws + WS_WUPT) + ((size_t)l * NE + e) * 2 * DE * D, AP->in[10] + l * D);
                transpose_all<0>(F, AP->in[15] + ((size_t)l * NE + e) * DE * D, DE, D, (bf16*)(ws + WS_WDNT) + ((size_t)l * NE + e) * D * DE, nullptr);
            }
        }
        {
            float* WR = (float*)(ws + WS_WR);
            for (int i = F.gw * 64 + F.lane; i < 2 * NE * D; i += F.NGW * 64) { const int l = i / (NE * D), e = (i / D) % NE, k = i % D; WR[i] = AP->in[10][l * D + k] * AP->in[11][((size_t)l * D + k) * NE + e]; }
        }
        {
            bf16* PBF = (bf16*)(ws + WS_PBF); const size_t n8 = (size_t)2 * T * PLE / 8;
            for (size_t i = (size_t)F.gw * 64 + F.lane; i < n8; i += (size_t)F.NGW * 64) { const f32x4 a = *(const f32x4*)(p_in + i * 8), b = *(const f32x4*)(p_in + i * 8 + 4);
                v4u w; w.x = pk2(a.x, a.y); w.y = pk2(a.z, a.w); w.z = pk2(b.x, b.y); w.w = pk2(b.z, b.w); *(v4u*)(PBF + i * 8) = w; }
        }
        __syncthreads();
        SEAM(0);
    }
#pragma unroll 1
    for (int l = 0; l < 2; ++l) {
        const int pb = 1 + 12 * l;
        const float* hin = (l == 0) ? x_in : H3;
        if (INL(0)) { for (int m = F.gw; m < T; m += F.NGW) norm_row_to_bf16(hin + (size_t)m * D, XN + (size_t)m * D, F.lane);
            if (l == 0) { int Kp = PLE; asm volatile("" : "+s"(Kp)); pg8::Gemm g{(const bf16*)(ws + WS_PBF), (const bf16*)(ws + WS_WPT), 2 * T, 2 * D, Kp}; PPOrder S{(int)F.G, F.bx};
                  EpiPP E{(bf16*)(ws + WS_PP)};
                  pg8::gemm_phase<EpiPP, PPOrder, true, true>(F.lds + RING_OFF, g, S, E); }
            SEAM(pb + 0); }
        if (INL(1)) {
            { const int Nn = (l == 0) ? AB_IN : C_IN;
              pg8::Gemm g{XN, (const bf16*)(ws + (l == 0 ? WS_WIN0T : WS_WIN1T)), T, Nn, D}; pg8::StaticOrder S; S.init(T, Nn, F.G, F.bx); EpiF32<false> E{PROJ, Nn, nullptr};
              pg8::gemm_phase<EpiF32<false>, pg8::StaticOrder, true, true>(F.lds + RING_OFF, g, S, E); }
            SEAM(pb + 1);
        }
        if (INL(2)) { if (l == 0) rope_phase_l0(F, PROJ, AP->in[4], AP->in[5]); else rope_phase_l1(F, PROJ); SEAM(pb + 2); }
        if (INL(3)) {
            if (l == 0) { attn_dense_naive(F, PROJ, OCAT); attn_band_naive<0>(F, PROJ, AB_IN, 768, 1280, 1408, 128, 1, AP->in[6], OCAT, nullptr, nullptr); }
            else {
#pragma unroll 1
                for (int g = 0; g < 3; ++g) attn_band_naive<1>(F, PROJ, C_IN, g * 768, g * 768 + 512, g * 768 + 640, 64, g == 0 ? 1 : g == 1 ? 4 : 16, nullptr, nullptr, OG + (size_t)g * T * C_OUT, LSE + (size_t)g * T * 8);
            }
            __syncthreads();
            SEAM(pb + 3);
        }
        if (INL(4)) { if (l == 1) merge_phase(F, OG, LSE, OCAT); SEAM(pb + 4); }
        if (INL(5)) {
            { pg8::Gemm g{OCAT, (const bf16*)(ws + (l == 0 ? WS_WOUT0T : WS_WOUT1T)), T, D, (l == 0) ? D : C_OUT}; pg8::StaticOrder S; S.init(T, D, F.G, F.bx); EpiF32<true> E{HM, D, hin};
              pg8::gemm_phase<EpiF32<true>, pg8::StaticOrder, true, true>(F.lds + RING_OFF, g, S, E); }
            SEAM(pb + 5);
        }
        if (INL(6)) { route_phase(F, HM, (const float*)(ws + WS_WR) + (size_t)l * NE * D, AP->in[12] + l * NE, F.ctl + CW_CNT + l * NE, TOPE, TOPG, TOPPOS, RSTD); SEAM(pb + 6); }
        if (INL(7)) { slot_phase(F, HM, F.ctl + CW_CNT + l * NE, TOPE, TOPG, TOPPOS, RSTD, TOKSLOT, SLOTGATE, XG, ULUP, ULDN, ULN); SEAM(pb + 7); }
        if (INL(8)) {
            pg8::Gemm g{XG, (const bf16*)(ws + WS_WUPT) + (size_t)l * NE * 2 * DE * D, NSLOT, NE * 2 * DE, D};
            const int xq = F.bx & 7; ListOrder S{ULUP + xq * 4096, ULN[xq], F.bx >> 3, (int)F.G >> 3};
            EpiSwiglu E{ACT, AP->in[14] + (size_t)l * NE * 2 * DE};
            pg8::gemm_phase<EpiSwiglu, ListOrder, true, true>(F.lds + RING_OFF, g, S, E);
            SEAM(pb + 8);
        }
        if (INL(9)) {
            pg8::Gemm g{ACT, (const bf16*)(ws + WS_WDNT) + (size_t)l * NE * D * DE, NSLOT, NE * D, DE};
            const int xq = F.bx & 7; ListOrder S{ULDN + xq * 4096, ULN[8 + xq], F.bx >> 3, (int)F.G >> 3};
            EpiDown E{Y, AP->in[16] + (size_t)l * NE * D, SLOTGATE};
            pg8::gemm_phase<EpiDown, ListOrder, true, true>(F.lds + RING_OFF, g, S, E);
            SEAM(pb + 9);
        }
        if (INL(10)) { combine_phase(F, HM, Y, TOKSLOT, H2, XN); SEAM(pb + 10); }
        if (INL(11)) {
            pg8::Gemm g{XN, (const bf16*)(ws + WS_WGT) + (size_t)l * D * D, T, D, D}; pg8::StaticOrder S; S.init(T, D, F.G, F.bx);
            EpiPle E{H2, (const bf16*)(ws + WS_PP) + (size_t)l * T * D, H3};
            pg8::gemm_phase<EpiPle, pg8::StaticOrder, true, true>(F.lds + RING_OFF, g, S, E);
            SEAM(pb + 11);
        }
    }
    if (((MK_MASK >> 13) & 1) && IN(25) && refresh(F)) final_norm_phase(F, H3, AP->in[19], AP->out);
#undef IN
#undef SEAM
#undef x_in
#undef ws
#undef p_in
#undef XN
#undef PROJ
#undef OCAT
#undef OG
#undef LSE
#undef HM
#undef H2
#undef H3
#undef TOPE
#undef TOPG
#undef TOPPOS
#undef RSTD
#undef TOKSLOT
#undef SLOTGATE
#undef ULUP
#undef ULDN
#undef ULN
#undef XG
#undef ACT
#undef Y
}

#ifndef MK_ONE_LAUNCH
#define MK_ONE_LAUNCH 0
#endif
extern "C" void kernel_launch(void* const* d_in, const int* in_sizes, int n_in, void* d_out, int out_size, void* d_ws, size_t ws_size, hipStream_t stream) {
    static int grid = 0;
    if (grid == 0) {
        if (n_in != 20 || in_sizes[0] != T * D || out_size != T * D || ws_size < WS_END) { fprintf(stderr, "kernel_launch: unexpected shapes: n_in %d in0 %d out %d ws %zu (need %zu)\n", n_in, n_in > 0 ? in_sizes[0] : -1, out_size, ws_size, (size_t)WS_END); grid = -1; return; }
        int dev = 0, cus = 0, per_cu = 0;
        if (hipGetDevice(&dev) != hipSuccess || hipDeviceGetAttribute(&cus, hipDeviceAttributeMultiprocessorCount, dev) != hipSuccess) { grid = -1; return; }
        if (hipFuncSetAttribute((const void*)fwd_kernel, hipFuncAttributeMaxDynamicSharedMemorySize, LDS_BYTES) != hipSuccess) { fprintf(stderr, "kernel_launch: hipFuncSetAttribute failed\n"); grid = -1; return; }
        if (hipOccupancyMaxActiveBlocksPerMultiprocessor(&per_cu, (const void*)fwd_kernel, NWAVES * 64, LDS_BYTES) != hipSuccess || per_cu < 1) fprintf(stderr, "kernel_launch: occupancy query says %d\n", per_cu);
        (void)hipGetLastError();
        grid = cus;
        if (grid != 256) fprintf(stderr, "kernel_launch: %d CUs (built for 256)\n", grid);
    }
    if (grid < 0) return;
    if (hipMemsetAsync((char*)d_ws + WS_CTL, 0, CTL_ZERO_BYTES, stream) != hipSuccess) return;
    Args a{};
    for (int i = 0; i < 20; ++i) a.in[i] = (const float*)d_in[i];
    a.out = (float*)d_out; a.ws = (unsigned char*)d_ws;
#if MK_ONE_LAUNCH
    a.ph_lo = 0; a.ph_hi = N_PHASES; a.li = 0;
    hipLaunchKernelGGL(fwd_kernel, dim3(grid), dim3(NWAVES * 64), LDS_BYTES, stream, a);
#else
    for (int ph = 0; ph < N_PHASES; ++ph) {
        if (ph == 5) continue;
        a.ph_lo = ph; a.ph_hi = ph + 1; a.li = ph;
        hipLaunchKernelGGL(fwd_kernel, dim3(grid), dim3(NWAVES * 64), LDS_BYTES, stream, a);
    }
#endif
}
```

```cpp
#include <hip/hip_runtime.h>
#include <hip/hip_bf16.h>
#include <cstdio>
#include <cstdint>
#include <cmath>
namespace pg8 {
#define PG8_LAS __attribute__((address_space(3)))
typedef unsigned short bf16_t;
typedef short bf16x8 __attribute__((ext_vector_type(8)));
typedef float f32x4 __attribute__((ext_vector_type(4)));
typedef unsigned u32x4 __attribute__((ext_vector_type(4)));
constexpr int BM = 256, BK = 64, HALF = 128, HTB = HALF * BK * 2  , STAGE_BYTES = 8 * HTB, NXCD = 8, WGM = 8;

__host__ __device__ __forceinline__ int lds_byte(int r, int c) { const int st = (r >> 4) * 2 + (c >> 5), rr = r & 15, cc = c & 31, ob = rr * 64 + cc * 2; return st * 1024 + (ob ^ (((ob >> 9) & 1) << 5)); }
__host__ __device__ __forceinline__ void stage_rc(int b, int& R, int& C) { const int st = b / 1024, sb = b % 1024, swz = sb ^ (((sb >> 9) & 1) << 5); R = (st >> 1) * 16 + swz / 64; C = (st & 1) * 32 + (swz % 64) / 2; }
__host__ __device__ __forceinline__ int perm32(int rho) { const int n = rho >> 4, i = rho & 15; return 8 * (i >> 2) + 4 * n + (i & 3); }

struct Unit { int pm, pn; };
struct Gemm { const bf16_t* A; const bf16_t* Bt; int M, N, K; };

struct StaticOrder {
    int nM, nN, nwg, G, c;
    __host__ __device__ void init(int M, int N, int G_, int c_) { nM = M / BM; nN = N / BM; nwg = nM * nN; G = G_; c = c_; }
    __host__ __device__ bool next(int i, Unit& u) const {
        const long L = (long)i * G + c; if (L >= nwg) return false;
        int wgid = (int)L; { const int q = nwg / NXCD, r = nwg % NXCD, xcd = wgid % NXCD, off = wgid / NXCD; wgid = (xcd < r ? xcd * (q + 1) : r * (q + 1) + (xcd - r) * q) + off; }
        const int nig = WGM * nN, gid = wgid / nig, fm = gid * WGM, gsz = (nM - fm) < WGM ? (nM - fm) : WGM;
        u.pm = fm + ((wgid % nig) % gsz); u.pn = (wgid % nig) / gsz; return true;
    }
    __device__ __forceinline__ void a_ready(const Unit&) const {}
    __device__ __forceinline__ void done(const Unit&) const {}
};

__device__ __forceinline__ unsigned cvt_pk_bf16(float lo, float hi) { unsigned r; asm volatile("v_cvt_pk_bf16_f32 %0, %1, %2" : "=v"(r) : "v"(lo), "v"(hi)); return r; }
typedef float f32x2 __attribute__((ext_vector_type(2)));
__device__ __forceinline__ f32x2 gelu_pk(f32x2 v) {
    const f32x2 av = __builtin_elementwise_abs(v), d = av * 0.2316418882f + 1.0f;
    f32x2 t; t.x = __builtin_amdgcn_rcpf(d.x); t.y = __builtin_amdgcn_rcpf(d.y);
    f32x2 q = t * 0.5307027145f + (-0.7265760135f); q = q * t + 0.7107068705f; q = q * t + (-0.142248368f); q = q * t + 0.127414796f; q = q * t;
    const f32x2 s = (v * v) * (-0.72134752044f);
    f32x2 e; e.x = __builtin_amdgcn_exp2f(s.x); e.y = __builtin_amdgcn_exp2f(s.y);
    const f32x2 m = v * (q * e), r = v - m;
    f32x2 o; o.x = v.x < 0.f ? m.x : r.x; o.y = v.y < 0.f ? m.y : r.y; return o;
}

template <int ACT  > struct EpiBf16 {
    static constexpr bool PERM = true, AFTER_DRAIN = false; static_assert(ACT == 0 || ACT == 1, "EpiBf16: ACT is 0 (none) or 1 (gelu_pk)");
    bf16_t* O; int ldc; const float* bias; int split_cols; size_t split_stride; float scale0;
    __device__ __forceinline__ void operator()(const f32x4 (&acc)[2][2][4][2], const Unit& u, int wr, int wc, int fr, int fq) const {
        const int row0 = u.pm * BM + wr * 64 + fr; int colt = u.pn * BM; bf16_t* base = O;
        float sc = 1.f; if (split_cols) { const int t = colt / split_cols; base += (size_t)t * split_stride; colt -= t * split_cols; if (t == 0) sc = scale0; }
        const int col0 = colt + wc * 32 + 8 * fq, bcol0 = u.pn * BM + wc * 32 + 8 * fq;
        f32x4 bv[2][2];
#pragma unroll
        for (int bj = 0; bj < 2; ++bj)
#pragma unroll
            for (int n = 0; n < 2; ++n) bv[bj][n] = bias ? *(const f32x4*)(bias + bcol0 + bj * HALF + 4 * n) : (f32x4){0.f, 0.f, 0.f, 0.f};
#pragma unroll
        for (int ai = 0; ai < 2; ++ai)
#pragma unroll
            for (int m = 0; m < 4; ++m) { bf16_t* rowp = base + (size_t)(row0 + ai * HALF + m * 16) * ldc + col0;
#pragma unroll
                for (int bj = 0; bj < 2; ++bj) { f32x4 v0 = acc[ai][bj][m][0] + bv[bj][0], v1 = acc[ai][bj][m][1] + bv[bj][1];
                    if (ACT == 1) { f32x2 a = gelu_pk((f32x2){v0[0], v0[1]}), b = gelu_pk((f32x2){v0[2], v0[3]}), c = gelu_pk((f32x2){v1[0], v1[1]}), d = gelu_pk((f32x2){v1[2], v1[3]});
                        v0 = (f32x4){a.x, a.y, b.x, b.y}; v1 = (f32x4){c.x, c.y, d.x, d.y}; }
                    v0 = v0 * sc; v1 = v1 * sc; u32x4 w; w.x = cvt_pk_bf16(v0[0], v0[1]); w.y = cvt_pk_bf16(v0[2], v0[3]); w.z = cvt_pk_bf16(v1[0], v1[1]); w.w = cvt_pk_bf16(v1[2], v1[3]);
                    *(u32x4*)(rowp + bj * HALF) = w; } }
    }
};
template <class Epi, class Sched, bool ALIGN_EPI = false, bool SP2 = false>
__device__ __forceinline__ void gemm_phase(PG8_LAS unsigned char* lds, const Gemm g, const Sched& S, const Epi& E) {
    int tid_ = threadIdx.x; asm volatile("" : "+v"(tid_));
    const int tid = tid_, wid = __builtin_amdgcn_readfirstlane(tid >> 6), lane = tid & 63, wr = wid >> 2, wc = wid & 3, fr = lane & 15, fq = lane >> 4;
    const int K = g.K, nt = K / BK;
    unsigned voffA[2], voffB[2];
#pragma unroll
    for (int i = 0; i < 2; ++i) { int R, C; stage_rc(tid * 16 + i * 8192, R, C); const int Rb = Epi::PERM ? ((R & ~31) + perm32(R & 31)) : R;
        voffA[i] = (unsigned)(R * K + C) * 2u; voffB[i] = (unsigned)(Rb * K + C) * 2u; }
    const size_t kstep = (size_t)(BK * 2);
    const size_t hstep = (size_t)HALF * K * 2;
    const size_t tstep = 2 * hstep;
    const unsigned ldsw = (unsigned)wid * 1024u;
    const int aoff = lds_byte(wr * 64 + fr, fq * 8), boff = lds_byte(wc * 32 + fr, fq * 8);
#define PG8_SA(b, h) (((b) * 2 + (h)) * HTB)
#define PG8_SB(b, h) ((4 + (b) * 2 + (h)) * HTB)
#define PG8_STAGE(bufoff, gbase, voff) do { _Pragma("unroll") for (int _i = 0; _i < 2; ++_i) \
        __builtin_amdgcn_global_load_lds((const unsigned*)((const char*)(gbase) + (voff)[_i]), (PG8_LAS unsigned*)(lds + (bufoff) + ldsw + _i * 8192), 16, 0, 0); } while (0)
#define PG8_LDA(dst, b, h) do { _Pragma("unroll") for (int m = 0; m < 4; ++m) _Pragma("unroll") for (int k = 0; k < 2; ++k) dst[m][k] = *(const PG8_LAS bf16x8*)(lds + PG8_SA(b, h) + aoff + m * 2048 + k * 1024); } while (0)
#define PG8_LDB(dst, b, h) do { _Pragma("unroll") for (int n = 0; n < 2; ++n) _Pragma("unroll") for (int k = 0; k < 2; ++k) dst[n][k] = *(const PG8_LAS bf16x8*)(lds + PG8_SB(b, h) + boff + n * 2048 + k * 1024); } while (0)
#define PG8_MMA(ai, bj, At, Bt) do { __builtin_amdgcn_s_setprio(1); _Pragma("unroll") for (int m = 0; m < 4; ++m) _Pragma("unroll") for (int n = 0; n < 2; ++n) _Pragma("unroll") for (int k = 0; k < 2; ++k) \
        acc[ai][bj][m][n] = __builtin_amdgcn_mfma_f32_16x16x32_bf16(Bt[n][k], At[m][k], acc[ai][bj][m][n], 0, 0, 0); __builtin_amdgcn_s_setprio(0); } while (0)
#define PG8_WAIT_V(n) asm volatile("s_waitcnt vmcnt(" #n ")" ::: "memory")
#define PG8_WAIT_L(n) asm volatile("s_waitcnt lgkmcnt(" #n ")" ::: "memory")
#define PG8_BAR __builtin_amdgcn_s_barrier()
#define PG8_SCHED __builtin_amdgcn_sched_barrier(0)
    Unit cur, nxt; int ui = 0;
    if (!S.next(0, cur)) return;
    f32x4 acc[2][2][4][2];
#pragma unroll
    for (int a = 0; a < 2; ++a)
#pragma unroll
        for (int b = 0; b < 2; ++b)
#pragma unroll
            for (int m = 0; m < 4; ++m)
#pragma unroll
                for (int n = 0; n < 2; ++n) acc[a][b][m][n] = (f32x4){0.f, 0.f, 0.f, 0.f};
    bf16x8 At[4][2], B0[2][2], B1[2][2];
    const char* cA = (const char*)g.A + (size_t)cur.pm * tstep; const char* cB = (const char*)g.Bt + (size_t)cur.pn * tstep;
    S.a_ready(cur);
    if constexpr (SP2) {
        PG8_STAGE(PG8_SB(0, 0), cB, voffB); PG8_STAGE(PG8_SB(0, 1), cB + hstep, voffB); PG8_STAGE(PG8_SA(0, 0), cA, voffA); PG8_STAGE(PG8_SA(0, 1), cA + hstep, voffA);
        if (wr == 1) PG8_BAR;
        PG8_WAIT_V(2); PG8_BAR;
        PG8_STAGE(PG8_SB(1, 0), cB + kstep, voffB); PG8_STAGE(PG8_SA(1, 0), cA + kstep, voffA); PG8_STAGE(PG8_SB(1, 1), cB + hstep + kstep, voffB);
        PG8_WAIT_V(6); PG8_BAR;
    } else {
        PG8_STAGE(PG8_SB(0, 0), cB, voffB); PG8_STAGE(PG8_SA(0, 0), cA, voffA); PG8_STAGE(PG8_SB(0, 1), cB + hstep, voffB); PG8_STAGE(PG8_SA(0, 1), cA + hstep, voffA);
        if (wr == 1) PG8_BAR;
        PG8_WAIT_V(4); PG8_BAR;
        PG8_STAGE(PG8_SB(1, 0), cB + kstep, voffB); PG8_STAGE(PG8_SA(1, 0), cA + kstep, voffA); PG8_STAGE(PG8_SB(1, 1), cB + hstep + kstep, voffB);
        PG8_WAIT_V(6); PG8_BAR;
    }
    for (;;) {
        const bool has_next = S.next(ui + 1, nxt);
        const char* nA = has_next ? (const char*)g.A + (size_t)nxt.pm * tstep : cA; const char* nB = has_next ? (const char*)g.Bt + (size_t)nxt.pn * tstep : cB;
        for (int t = 0; t < nt; t += 2) {
            const bool last = (t == nt - 2);
            const char* a1 = cA + (size_t)(t + 1) * kstep;
            const char* a2 = last ? nA : cA + (size_t)(t + 2) * kstep; const char* b2 = last ? nB : cB + (size_t)(t + 2) * kstep;
            const char* a3 = a2 + kstep; const char* b3 = b2 + kstep;
            if (last && has_next) S.a_ready(nxt);
            if constexpr (SP2) {
            PG8_LDB(B0, 0, 0); PG8_LDB(B1, 0, 1); PG8_SCHED; PG8_LDA(At, 0, 0); PG8_STAGE(PG8_SA(1, 1), a1 + hstep, voffA);
            PG8_WAIT_V(8); PG8_WAIT_L(0); PG8_BAR; PG8_MMA(0, 0, At, B0); PG8_MMA(0, 1, At, B1); PG8_BAR; PG8_SCHED;
            PG8_LDA(At, 0, 1); PG8_STAGE(PG8_SB(0, 0), b2, voffB); PG8_STAGE(PG8_SB(0, 1), b2 + hstep, voffB); PG8_STAGE(PG8_SA(0, 0), a2, voffA);
            PG8_WAIT_V(8); PG8_WAIT_L(0); PG8_BAR; PG8_MMA(1, 0, At, B0); PG8_MMA(1, 1, At, B1); PG8_BAR; PG8_SCHED;
            PG8_LDB(B0, 1, 0); PG8_LDB(B1, 1, 1); PG8_SCHED; PG8_LDA(At, 1, 0); PG8_STAGE(PG8_SA(0, 1), a2 + hstep, voffA);
            PG8_WAIT_V(8); PG8_WAIT_L(0); PG8_BAR; PG8_MMA(0, 0, At, B0); PG8_MMA(0, 1, At, B1); PG8_BAR; PG8_SCHED;
            PG8_LDA(At, 1, 1); PG8_STAGE(PG8_SB(1, 0), b3, voffB); PG8_STAGE(PG8_SB(1, 1), b3 + hstep, voffB); PG8_STAGE(PG8_SA(1, 0), a3, voffA);
            PG8_WAIT_V(8); PG8_WAIT_L(0); PG8_BAR; PG8_MMA(1, 0, At, B0); PG8_MMA(1, 1, At, B1); PG8_BAR; PG8_SCHED;
            } else {
            PG8_LDB(B0, 0, 0); PG8_SCHED; PG8_LDA(At, 0, 0); PG8_STAGE(PG8_SA(1, 1), a1 + hstep, voffA);
            PG8_WAIT_L(8); PG8_BAR; PG8_WAIT_L(0); PG8_MMA(0, 0, At, B0); PG8_BAR; PG8_SCHED;
            PG8_LDB(B1, 0, 1); PG8_STAGE(PG8_SB(0, 0), b2, voffB);
            PG8_BAR; PG8_WAIT_L(0); PG8_MMA(0, 1, At, B1); PG8_BAR;
            PG8_LDA(At, 0, 1); PG8_STAGE(PG8_SA(0, 0), a2, voffA);
            PG8_BAR; PG8_WAIT_L(0); PG8_MMA(1, 0, At, B0); PG8_BAR; PG8_SCHED;
            PG8_STAGE(PG8_SB(0, 1), b2 + hstep, voffB);
            PG8_WAIT_V(6); PG8_BAR; PG8_MMA(1, 1, At, B1); PG8_BAR;
            PG8_LDB(B0, 1, 0); PG8_SCHED; PG8_LDA(At, 1, 0); PG8_STAGE(PG8_SA(0, 1), a2 + hstep, voffA);
            PG8_WAIT_L(8); PG8_BAR; PG8_WAIT_L(0); PG8_MMA(0, 0, At, B0); PG8_BAR; PG8_SCHED;
            PG8_LDB(B1, 1, 1); PG8_STAGE(PG8_SB(1, 0), b3, voffB);
            PG8_BAR; PG8_WAIT_L(0); PG8_MMA(0, 1, At, B1); PG8_BAR;
            PG8_LDA(At, 1, 1); PG8_STAGE(PG8_SA(1, 0), a3, voffA);
            PG8_BAR; PG8_WAIT_L(0); PG8_MMA(1, 0, At, B0); PG8_BAR; PG8_SCHED;
            PG8_STAGE(PG8_SB(1, 1), b3 + hstep, voffB);
            PG8_WAIT_V(6); PG8_BAR; PG8_MMA(1, 1, At, B1); PG8_BAR;
            }
        }
        if constexpr (ALIGN_EPI) { if (wr == 0) PG8_BAR; }
        if constexpr (!Epi::AFTER_DRAIN) { E(acc, cur, wr, wc, fr, fq); S.done(cur); }
        if (!has_next) break;
#pragma unroll
        for (int a = 0; a < 2; ++a)
#pragma unroll
            for (int b = 0; b < 2; ++b)
#pragma unroll
                for (int m = 0; m < 4; ++m)
#pragma unroll
                    for (int n = 0; n < 2; ++n) acc[a][b][m][n] = (f32x4){0.f, 0.f, 0.f, 0.f};
        cur = nxt; cA = nA; cB = nB; ++ui;
        if constexpr (ALIGN_EPI) { if (wr == 1) PG8_BAR; }
    }
    PG8_WAIT_V(0);
    if constexpr (!ALIGN_EPI) { if (wr == 0) PG8_BAR; }
    PG8_BAR;
    if constexpr (Epi::AFTER_DRAIN) { E.fused(acc, cur, wr, wc, fr, fq, lds, wid, lane); S.done(cur); }
#undef PG8_SA
#undef PG8_SB
#undef PG8_STAGE
#undef PG8_LDA
#undef PG8_LDB
#undef PG8_MMA
#undef PG8_WAIT_V
#undef PG8_WAIT_L
#undef PG8_BAR
#undef PG8_SCHED
}
}

constexpr int NWAVES = 8;
constexpr int BATCH = 2, SEQ = 8192, T = BATCH * SEQ, D = 1024;
constexpr int AB_IN = 1536, C_IN = 2304, C_OUT = 512;
constexpr int NE = 32, DE = 1024, PLE = 256;
constexpr int NSLOT = 73728, NPANMAX = NSLOT / 256;
constexpr float NORM_EPS = 1e-6f;
constexpr float LOG2_THETA = 13.287712379549449f;

#define GAS __attribute__((address_space(1)))
#define LAS __attribute__((address_space(3)))
typedef unsigned short bf16;
typedef unsigned v4u __attribute__((ext_vector_type(4)));
typedef unsigned v2u __attribute__((ext_vector_type(2)));
typedef float f32x4 __attribute__((ext_vector_type(4)));
typedef GAS unsigned gu32;
#define RLX_AGENT __ATOMIC_RELAXED, __HIP_MEMORY_SCOPE_AGENT
#define LDS_WAIT() asm volatile("s_waitcnt lgkmcnt(0)" ::: "memory")
#define VM_WAIT() asm volatile("s_waitcnt vmcnt(0)" ::: "memory")

__device__ __forceinline__ unsigned f2bf(float f) { unsigned u = __builtin_bit_cast(unsigned, f); return (u + 0x7fffu + ((u >> 16) & 1u)) >> 16; }
__device__ __forceinline__ unsigned pk2(float lo, float hi) { return f2bf(lo) | (f2bf(hi) << 16); }
__device__ __forceinline__ float bf2f(unsigned short b) { return __builtin_bit_cast(float, (unsigned)b << 16); }
__device__ __forceinline__ float bflo(unsigned w) { return __builtin_bit_cast(float, w << 16); }
__device__ __forceinline__ float bfhi(unsigned w) { return __builtin_bit_cast(float, w & 0xffff0000u); }

constexpr size_t MiB = 1u << 20;
constexpr size_t al256(size_t x) { return (x + 255) & ~(size_t)255; }
constexpr size_t WS_CTL = 0, CTL_ZERO_BYTES = 1 * MiB;
constexpr size_t WS_WIN0T = 1 * MiB;
constexpr size_t WS_WOUT0T = WS_WIN0T + (size_t)AB_IN * D * 2;
constexpr size_t WS_WIN1T = WS_WOUT0T + (size_t)D * D * 2;
constexpr size_t WS_WOUT1T = WS_WIN1T + (size_t)C_IN * D * 2;
constexpr size_t WS_WGT = WS_WOUT1T + (size_t)D * C_OUT * 2;
constexpr size_t WS_WPT = WS_WGT + 2 * (size_t)D * D * 2;
constexpr size_t WS_WR = WS_WPT + 2 * (size_t)D * PLE * 2;
constexpr size_t WS_WUPT = al256(WS_WR + 2 * (size_t)NE * D * 4);
constexpr size_t WS_WDNT = WS_WUPT + 2 * (size_t)NE * 2 * DE * D * 2;
constexpr size_t WS_PBF = WS_WDNT + 2 * (size_t)NE * D * DE * 2;
constexpr size_t WS_PP = WS_PBF + 2 * (size_t)T * PLE * 2;
constexpr size_t WS_XN = WS_PP + 2 * (size_t)T * D * 2;
constexpr size_t WS_PROJ = WS_XN + (size_t)T * D * 2;
constexpr size_t WS_OCAT = WS_PROJ + (size_t)T * C_IN * 4;
constexpr size_t WS_OG = WS_OCAT + (size_t)T * D * 2;
constexpr size_t WS_LSE = WS_OG + 3 * (size_t)T * C_OUT * 4;
constexpr size_t WS_HM = WS_LSE + 3 * (size_t)T * 8 * 4;
constexpr size_t WS_H2 = WS_HM + (size_t)T * D * 4;
constexpr size_t WS_H3 = WS_H2 + (size_t)T * D * 4;
constexpr size_t WS_TOPE = WS_H3 + (size_t)T * D * 4;
constexpr size_t WS_TOPG = WS_TOPE + (size_t)T * 16;
constexpr size_t WS_TOPPOS = WS_TOPG + (size_t)T * 16;
constexpr size_t WS_RSTD = WS_TOPPOS + (size_t)T * 16;
constexpr size_t WS_TOKSLOT = WS_RSTD + (size_t)T * 4;
constexpr size_t WS_SLOTGATE = WS_TOKSLOT + (size_t)T * 16;
constexpr size_t WS_ULUP = al256(WS_SLOTGATE + (size_t)NSLOT * 4);
constexpr size_t WS_ULDN = WS_ULUP + 8 * 4096 * 8;
constexpr size_t WS_ULN = WS_ULDN + 8 * 4096 * 8;
constexpr size_t WS_XG = al256(WS_ULN + 256);
constexpr size_t WS_ACT = WS_XG + (size_t)NSLOT * D * 2;
constexpr size_t WS_Y = WS_ACT + (size_t)NSLOT * D * 2;
constexpr size_t WS_END = WS_Y + (size_t)NSLOT * D * 2;
constexpr int CW_TMO = 0;
constexpr int CW_CNT = 64;
constexpr int CW_BAR = 4096;

constexpr int RING_OFF = 0, RING_BYTES = 131072;
constexpr int LDSCTL_OFF = RING_BYTES, MISC_OFF = LDSCTL_OFF + 320;
constexpr int LDS_BYTES = 147456;

template <bool RESID> struct EpiF32 {
    static constexpr bool PERM = false, AFTER_DRAIN = false;
    float* C; int ldc; const float* resid;
    __device__ __forceinline__ void operator()(const pg8::f32x4 (&acc)[2][2][4][2], const pg8::Unit& u, int wr, int wc, int fr, int fq) const {
        const int row0 = u.pm * 256 + wr * 64 + fr, col0 = u.pn * 256 + wc * 32 + 4 * fq;
#pragma unroll
        for (int ai = 0; ai < 2; ++ai)
#pragma unroll
            for (int m = 0; m < 4; ++m) { const size_t ro = (size_t)(row0 + ai * 128 + m * 16) * ldc + col0; float* cp = C + ro; const float* rp = resid + ro;
#pragma unroll
                for (int bj = 0; bj < 2; ++bj)
#pragma unroll
                    for (int n = 0; n < 2; ++n) { pg8::f32x4 v = acc[ai][bj][m][n];
                        if (RESID) v += *(const pg8::f32x4*)(rp + bj * 128 + n * 16);
                        *(pg8::f32x4*)(cp + bj * 128 + n * 16) = v; }
                asm volatile("" ::: "memory"); }
    }
};
struct PPOrder {
    int G, c;
    __device__ __forceinline__ bool next(int i, pg8::Unit& u) const { const int L = i * G + c; if (L >= 512) return false; u.pm = L >> 2; u.pn = 4 * (u.pm >> 6) + (L & 3); return true; }
    __device__ __forceinline__ void a_ready(const pg8::Unit&) const {}
    __device__ __forceinline__ void done(const pg8::Unit&) const {}
};
struct EpiPP {
    static constexpr bool PERM = true, AFTER_DRAIN = false;
    bf16* O;
    __device__ __forceinline__ void operator()(const pg8::f32x4 (&acc)[2][2][4][2], const pg8::Unit& u, int wr, int wc, int fr, int fq) const {
        const int row0 = u.pm * 256 + wr * 64 + fr, col0 = (u.pn & 3) * 256 + wc * 32 + 8 * fq;
#pragma unroll
        for (int ai = 0; ai < 2; ++ai)
#pragma unroll
            for (int m = 0; m < 4; ++m) { bf16* rp = O + (size_t)(row0 + ai * 128 + m * 16) * D + col0;
#pragma unroll
                for (int bj = 0; bj < 2; ++bj) { const pg8::f32x4 v0 = acc[ai][bj][m][0], v1 = acc[ai][bj][m][1];
                    pg8::u32x4 w; w.x = pk2(v0[0], v0[1]); w.y = pk2(v0[2], v0[3]); w.z = pk2(v1[0], v1[1]); w.w = pk2(v1[2], v1[3]);
                    *(pg8::u32x4*)(rp + bj * 128) = w; } }
    }
};
__device__ __forceinline__ float sigmoidf_(float x) { return 1.0f / (1.0f + __expf(-x)); }
__device__ __forceinline__ float swiglu1(float g, float l) {
    g = fminf(g, 7.0f); l = fminf(fmaxf(l, -7.0f), 7.0f);
    return g * sigmoidf_(1.702f * g) * (l + 1.0f);
}
struct EpiSwiglu {
    static constexpr bool PERM = true, AFTER_DRAIN = false;
    bf16* ACT; const float* bup;
    __device__ __forceinline__ void operator()(const pg8::f32x4 (&acc)[2][2][4][2], const pg8::Unit& u, int wr, int wc, int fr, int fq) const {
        const int e = u.pn >> 3, j = u.pn & 7; const int row0 = u.pm * 256 + wr * 64 + fr, a0 = j * 128 + wc * 32 + 8 * fq;
        const float* bp = bup + (size_t)e * 2048 + 2 * a0; pg8::f32x4 b[4];
#pragma unroll
        for (int i = 0; i < 4; ++i) b[i] = *(const pg8::f32x4*)(bp + 4 * i);
#pragma unroll
        for (int ai = 0; ai < 2; ++ai)
#pragma unroll
            for (int m = 0; m < 4; ++m) { const size_t ro = (size_t)(row0 + ai * 128 + m * 16) * DE + a0;
                const pg8::f32x4 g0 = acc[ai][0][m][0], g1 = acc[ai][0][m][1], l0 = acc[ai][1][m][0], l1 = acc[ai][1][m][1];
                float o[8];
                o[0] = swiglu1(g0[0] + b[0][0], l0[0] + b[0][1]); o[1] = swiglu1(g0[1] + b[0][2], l0[1] + b[0][3]);
                o[2] = swiglu1(g0[2] + b[1][0], l0[2] + b[1][1]); o[3] = swiglu1(g0[3] + b[1][2], l0[3] + b[1][3]);
                o[4] = swiglu1(g1[0] + b[2][0], l1[0] + b[2][1]); o[5] = swiglu1(g1[1] + b[2][2], l1[1] + b[2][3]);
                o[6] = swiglu1(g1[2] + b[3][0], l1[2] + b[3][1]); o[7] = swiglu1(g1[3] + b[3][2], l1[3] + b[3][3]);
                pg8::u32x4 w; w.x = pk2(o[0], o[1]); w.y = pk2(o[2], o[3]); w.z = pk2(o[4], o[5]); w.w = pk2(o[6], o[7]);
                *(pg8::u32x4*)(ACT + ro) = w; }
    }
};
struct EpiDown {
    static constexpr bool PERM = true, AFTER_DRAIN = false;
    bf16* Y; const float* bdn; const float* gate;
    __device__ __forceinline__ void operator()(const pg8::f32x4 (&acc)[2][2][4][2], const pg8::Unit& u, int wr, int wc, int fr, int fq) const {
        const int e = u.pn >> 2, j = u.pn & 3; const int row0 = u.pm * 256 + wr * 64 + fr, col0 = j * 256 + wc * 32 + 8 * fq;
        pg8::f32x4 bv[2][2];
#pragma unroll
        for (int bj = 0; bj < 2; ++bj)
#pragma unroll
            for (int n = 0; n < 2; ++n) bv[bj][n] = *(const pg8::f32x4*)(bdn + (size_t)e * D + col0 + bj * 128 + 4 * n);
#pragma unroll
        for (int ai = 0; ai < 2; ++ai)
#pragma unroll
            for (int m = 0; m < 4; ++m) { const int r = row0 + ai * 128 + m * 16; const float gt = gate[r];
#pragma unroll
                for (int bj = 0; bj < 2; ++bj) { const pg8::f32x4 v0 = (acc[ai][bj][m][0] + bv[bj][0]) * gt, v1 = (acc[ai][bj][m][1] + bv[bj][1]) * gt;
                    pg8::u32x4 w; w.x = pk2(v0[0], v0[1]); w.y = pk2(v0[2], v0[3]); w.z = pk2(v1[0], v1[1]); w.w = pk2(v1[2], v1[3]);
                    *(pg8::u32x4*)(Y + (size_t)r * D + col0 + bj * 128) = w; } }
    }
};
struct EpiPle {
    static constexpr bool PERM = false, AFTER_DRAIN = false;
    const float* H2; const bf16* PP; float* H3;
    __device__ __forceinline__ void operator()(const pg8::f32x4 (&acc)[2][2][4][2], const pg8::Unit& u, int wr, int wc, int fr, int fq) const {
        const int row0 = u.pm * 256 + wr * 64 + fr, col0 = u.pn * 256 + wc * 32 + 4 * fq;
#pragma unroll
        for (int ai = 0; ai < 2; ++ai)
#pragma unroll
            for (int m = 0; m < 4; ++m) { const size_t ro = (size_t)(row0 + ai * 128 + m * 16) * D + col0;
#pragma unroll
                for (int bj = 0; bj < 2; ++bj)
#pragma unroll
                    for (int n = 0; n < 2; ++n) { const size_t o = ro + bj * 128 + n * 16; const pg8::f32x4 a = acc[ai][bj][m][n];
                        const pg8::f32x4 h = *(const pg8::f32x4*)(H2 + o); const v2u pw = *(const v2u*)(PP + o);
                        pg8::f32x4 r; r[0] = h[0] + bflo(pw.x) * sigmoidf_(a[0]); r[1] = h[1] + bfhi(pw.x) * sigmoidf_(a[1]);
                        r[2] = h[2] + bflo(pw.y) * sigmoidf_(a[2]); r[3] = h[3] + bfhi(pw.y) * sigmoidf_(a[3]);
                        *(pg8::f32x4*)(H3 + o) = r; } }
    }
};
struct ListOrder {
    const int2* list; int n, rank, stride;
    __device__ __forceinline__ bool next(int i, pg8::Unit& u) const { const int q = i * stride + rank; if (q >= n) return false; const int2 e = list[q]; u.pm = e.x; u.pn = e.y; return true; }
    __device__ __forceinline__ void a_ready(const pg8::Unit&) const {}
    __device__ __forceinline__ void done(const pg8::Unit&) const {}
};
#define XB_TMO      128
#define XB_XCNT(j)  (256  + 64 * (j))
#define XB_XSUB(j)  (1280 + 64 * (j))
#define XB_XGEN(j)  (2304 + 64 * (j))
#define XB_TOP      3328
#define XB_TOPGEN   3392
#define XCD_BAR_WORDS 3456
#define XB_SPIN_CAP (1u << 18)

__device__ __forceinline__ unsigned xb_ld(unsigned* p)              { return __hip_atomic_load(p, __ATOMIC_RELAXED, __HIP_MEMORY_SCOPE_AGENT); }
__device__ __forceinline__ unsigned xb_add(unsigned* p, unsigned v) { return __hip_atomic_fetch_add(p, v, __ATOMIC_RELAXED, __HIP_MEMORY_SCOPE_AGENT); }
__device__ __forceinline__ unsigned xb_xcc_id() { return (unsigned)__builtin_amdgcn_s_getreg((3 << 11) | 20) & 0xFu; }
#define XB_SPIN(cond, bar) do { unsigned _sp = 0; while (cond) { __builtin_amdgcn_s_sleep(1); \
    if ((++_sp & 255u) == 0u) { if (xb_ld(&(bar)[XB_TMO])) break; if (_sp > XB_SPIN_CAP) { atomicAdd(&(bar)[XB_TMO], 1u); break; } } } } while (0)

struct XcdBarrier {
    unsigned* bar; unsigned x;
    volatile LAS unsigned* st;
};

__device__ __forceinline__ XcdBarrier xcd_barrier_post(unsigned* bar, volatile LAS unsigned* st) {
    XcdBarrier b; b.bar = bar; b.x = xb_xcc_id(); b.st = st;
    if (threadIdx.x == 0) (void)xb_add(&bar[XB_XCNT(b.x)], 1u);
    return b;
}
__device__ __forceinline__ void xcd_barrier_complete(unsigned* bar, unsigned x, unsigned& nloc, unsigned& nx) {
    const unsigned G = gridDim.x * gridDim.y * gridDim.z;
    unsigned sum, cnt, mine, sp = 0u;
    for (;;) {
        sum = 0u; cnt = 0u; mine = 0u;
#pragma unroll
        for (unsigned j = 0; j < 16; ++j) { const unsigned c = xb_ld(&bar[XB_XCNT(j)]); sum += c; cnt += (c > 0u) ? 1u : 0u; mine = (j == x) ? c : mine; }
        if (sum == G) break;
        __builtin_amdgcn_s_sleep(1);
        if ((++sp & 255u) == 0u) { if (xb_ld(&bar[XB_TMO])) break; if (sp > XB_SPIN_CAP) { atomicAdd(&bar[XB_TMO], 1u); break; } }
    }
    nloc = mine > 0u ? mine : 1u; nx = cnt > 0u ? cnt : 1u;
}

__device__ __forceinline__ void xcd_barrier(const XcdBarrier& b) {
    asm volatile("s_waitcnt vmcnt(0)" ::: "memory");
    __syncthreads();
    if (threadIdx.x == 0) {
        unsigned* bar = b.bar;
        __builtin_amdgcn_s_waitcnt(0);
        unsigned nloc = b.st[0], nx = b.st[1];
        if (nloc == 0u) { xcd_barrier_complete(bar, b.x, nloc, nx); b.st[0] = nloc; b.st[1] = nx; }
        const unsigned old = xb_add(&bar[XB_XSUB(b.x)], 1u);
        const unsigned gen = old / nloc;
        if (old + 1u == (gen + 1u) * nloc) {
            __builtin_amdgcn_fence(__ATOMIC_RELEASE, "agent");
            asm volatile("s_waitcnt vmcnt(0)" ::: "memory");
            const unsigned og = xb_add(&bar[XB_TOP], 1u);
            const unsigned tg = og / nx;
            if (og + 1u == (tg + 1u) * nx) xb_add(&bar[XB_TOPGEN], 1u);
            else XB_SPIN(xb_ld(&bar[XB_TOPGEN]) == tg, bar);
            __builtin_amdgcn_fence(__ATOMIC_ACQUIRE, "agent");
            xb_add(&bar[XB_XGEN(b.x)], 1u);
            asm volatile("s_waitcnt vmcnt(0)" ::: "memory");
        } else {
            XB_SPIN(xb_ld(&bar[XB_XGEN(b.x)]) == gen, bar);
            __builtin_amdgcn_fence(__ATOMIC_ACQUIRE, "agent");
            asm volatile("s_waitcnt vmcnt(0)" ::: "memory");
        }
    }
    __syncthreads();
}

struct Frame {
    LAS unsigned char* lds;
    volatile LAS unsigned* MISC;
    gu32* ctl;
    int tid, lane, wave, vcu, G, bx;
    int gw, NGW;
};
__device__ __forceinline__ bool refresh(Frame& F) {
    int t = threadIdx.x; asm volatile("" : "+v"(t)); F.tid = t; F.lane = t & 63; F.wave = __builtin_amdgcn_readfirstlane(t >> 6);
    int bx = blockIdx.x, G = gridDim.x; asm volatile("" : "+s"(bx), "+s"(G)); F.bx = bx; F.G = G;
    F.vcu = (G % 8 == 0) ? (bx % 8) * (G / 8) + bx / 8 : bx; F.gw = F.vcu * NWAVES + F.wave; F.NGW = G * NWAVES; return true; }
__device__ __forceinline__ float wave_sum(float v) {
#pragma unroll
    for (int o = 1; o < 64; o <<= 1) v += __shfl_xor(v, o);
    return v;
}
template <int MAP> __device__ __forceinline__ int rowmap(int n) { if (MAP == 1) { const int f = n >> 1; return 256 * (f >> 7) + 128 * (n & 1) + (f & 127); } return n; }
template <int MAP> __device__ __forceinline__ void transpose_item(const float* W, int K, int N, bf16* WT, const float* gain, LAS float* scr, int item, int lane) {
    const int nblk = N / 32, kb = item / nblk, nb = item % nblk, k0 = 64 * kb, n0 = 32 * nb;
#pragma unroll 8
    for (int i = 0; i < 32; ++i) { const int kk = 2 * i + (lane >> 5); float v = W[(size_t)(k0 + kk) * N + n0 + (lane & 31)]; if (gain) v *= gain[k0 + kk]; scr[kk * 33 + (lane & 31)] = v; }
    LDS_WAIT(); asm volatile("" ::: "memory");
    const int c = lane & 7;
#pragma unroll
    for (int j = 0; j < 4; ++j) { const int n = (lane >> 3) + 8 * j; const LAS float* s = scr + (8 * c) * 33 + n;
        v4u o; o.x = pk2(s[0 * 33], s[1 * 33]); o.y = pk2(s[2 * 33], s[3 * 33]); o.z = pk2(s[4 * 33], s[5 * 33]); o.w = pk2(s[6 * 33], s[7 * 33]);
        *(GAS v4u*)(WT + (size_t)rowmap<MAP>(n0 + n) * K + k0 + 8 * c) = o; }
    LDS_WAIT(); asm volatile("" ::: "memory");
}
template <int MAP> __device__ __forceinline__ void transpose_all(Frame& F, const float* W, int K, int N, bf16* WT, const float* gain) {
    LAS float* scr = (LAS float*)(F.lds + RING_OFF + F.wave * 16384);
    const int nitems = (K / 64) * (N / 32);
    for (int it = F.gw; it < nitems; it += F.NGW) transpose_item<MAP>(W, K, N, WT, gain, scr, it, F.lane);
}
__device__ __forceinline__ float norm_row_to_bf16(const float* xrow, bf16* orow, int lane) {
    const GAS f32x4* xr = (const GAS f32x4*)xrow + lane;
    f32x4 v[4]; float s = 0.f;
#pragma unroll
    for (int j = 0; j < 4; ++j) { v[j] = xr[64 * j]; s += (v[j].x * v[j].x + v[j].y * v[j].y) + (v[j].z * v[j].z + v[j].w * v[j].w); }
    const float rstd = 1.f / sqrtf(wave_sum(s) * (1.f / D) + NORM_EPS);
    GAS unsigned long long* o8 = (GAS unsigned long long*)orow + lane;
#pragma unroll
    for (int j = 0; j < 4; ++j) o8[64 * j] = (unsigned long long)pk2(v[j].x * rstd, v[j].y * rstd) | ((unsigned long long)pk2(v[j].z * rstd, v[j].w * rstd) << 32);
    return rstd;
}

__device__ __forceinline__ float rope_freq(int i, int half_dim) { return exp2f(-(float)i / (float)half_dim * LOG2_THETA); }
__device__ __forceinline__ void rope_phase_l0(Frame& F, float* PROJ, const float* qg, const float* kg) {
    const int lane = F.lane;
    const float gq = qg[lane], gk = kg[lane];
    const int ll = lane & 31, ia = ll & 15, i1 = lane & 31;
    const float fa = rope_freq(ia, 16), f1 = rope_freq(i1, 32);
    for (int m = F.gw; m < T; m += F.NGW) {
        float* pr = PROJ + (size_t)m * AB_IN;
        const int pos = m % SEQ; const int pa = (lane >> 5) ? (pos & 63) : (pos >> 6);
        const float anga = (float)pa * fa, ang1 = (float)pos * f1;
        const float ca = cosf(anga), sa = sinf(anga), c1 = cosf(ang1), s1 = sinf(ang1);
#pragma unroll 1
        for (int h = 0; h < 10; ++h) {
            const float x = pr[h * 64 + lane]; const float ss = wave_sum(x * x);
            const float y = x * (1.f / sqrtf(ss * (1.f / 64.f) + NORM_EPS)) * (h < 8 ? gq : gk);
            const float pt = __shfl_xor(y, 16);
            pr[h * 64 + lane] = (ll < 16) ? (y * ca - pt * sa) : (y * ca + pt * sa);
        }
#pragma unroll 1
        for (int h = 12; h < 22; ++h) {
            const float y = pr[h * 64 + lane]; const float pt = __shfl_xor(y, 32);
            pr[h * 64 + lane] = (lane < 32) ? (y * c1 - pt * s1) : (y * c1 + pt * s1);
        }
    }
}
__device__ __forceinline__ void rope_phase_l1(Frame& F, float* PROJ) {
    const int lane = F.lane; const float f1 = rope_freq(lane & 31, 32);
    for (int m = F.gw; m < T; m += F.NGW) {
        float* pr = PROJ + (size_t)m * C_IN; const int pos = m % SEQ;
        const float ang1 = (float)pos * f1; const float c1 = cosf(ang1), s1 = sinf(ang1);
#pragma unroll 1
        for (int g = 0; g < 3; ++g)
#pragma unroll 1
            for (int h = 0; h < 10; ++h) { float* p = pr + g * 768 + h * 64 + lane; const float y = *p; const float pt = __shfl_xor(y, 32);
                *p = (lane < 32) ? (y * c1 - pt * s1) : (y * c1 + pt * s1); }
    }
}

__device__ __forceinline__ void attn_dense_naive(Frame& F, const float* PROJ, bf16* OCAT) {
    LAS float* Ks = (LAS float*)(F.lds + RING_OFF); LAS float* Vs = Ks + 64 * 64;
    const int nitems = BATCH * 8 * (SEQ / 512);
    for (int it = blockIdx.x; it < nitems; it += gridDim.x) {
        const int qb = it % (SEQ / 512), hq = (it / (SEQ / 512)) % 8, b = it / (8 * (SEQ / 512)); const int hkv = hq >> 2;
        const size_t qrow = (size_t)b * SEQ + qb * 512 + F.tid;
        float q[64], o[64];
        { const f32x4* qp = (const f32x4*)(PROJ + qrow * AB_IN + hq * 64);
#pragma unroll
          for (int i = 0; i < 16; ++i) { const f32x4 v = qp[i]; q[4 * i] = v.x * 0.125f; q[4 * i + 1] = v.y * 0.125f; q[4 * i + 2] = v.z * 0.125f; q[4 * i + 3] = v.w * 0.125f; } }
#pragma unroll
        for (int d = 0; d < 64; ++d) o[d] = 0.f;
        float mx = -INFINITY, l = 0.f;
        for (int kt = 0; kt < SEQ / 64; ++kt) {
            __syncthreads();
            { const size_t krow0 = (size_t)b * SEQ + kt * 64;
#pragma unroll
              for (int i = 0; i < 2; ++i) { const int idx = F.tid + 512 * i; const int r = idx >> 4, c4 = idx & 15;
                  const float* src = PROJ + (krow0 + r) * AB_IN;
                  *(LAS f32x4*)(Ks + r * 64 + c4 * 4) = *(const f32x4*)(src + 512 + hkv * 64 + c4 * 4);
                  *(LAS f32x4*)(Vs + r * 64 + c4 * 4) = *(const f32x4*)(src + 640 + hkv * 64 + c4 * 4); } }
            __syncthreads();
#pragma unroll 2
            for (int j = 0; j < 64; ++j) {
                float s = 0.f;
#pragma unroll
                for (int i = 0; i < 16; ++i) { const f32x4 kv = *(const LAS f32x4*)(Ks + j * 64 + 4 * i); s += q[4 * i] * kv.x + q[4 * i + 1] * kv.y + q[4 * i + 2] * kv.z + q[4 * i + 3] * kv.w; }
                if (s > mx) { const float c = __expf(mx - s); l *= c;
#pragma unroll
                    for (int d = 0; d < 64; ++d) o[d] *= c;
                    mx = s; }
                const float p = __expf(s - mx); l += p;
#pragma unroll
                for (int i = 0; i < 16; ++i) { const f32x4 vv = *(const LAS f32x4*)(Vs + j * 64 + 4 * i); o[4 * i] += p * vv.x; o[4 * i + 1] += p * vv.y; o[4 * i + 2] += p * vv.z; o[4 * i + 3] += p * vv.w; }
            }
        }
        const float il = 1.f / l; bf16* op = OCAT + qrow * D + hq * 64;
#pragma unroll
        for (int i = 0; i < 8; ++i) { v4u w; w.x = pk2(o[8 * i] * il, o[8 * i + 1] * il); w.y = pk2(o[8 * i + 2] * il, o[8 * i + 3] * il); w.z = pk2(o[8 * i + 4] * il, o[8 * i + 5] * il); w.w = pk2(o[8 * i + 6] * il, o[8 * i + 7] * il); *(v4u*)(op + 8 * i) = w; }
    }
}
template <int MODE> __device__ __forceinline__ void attn_band_naive(Frame& F, const float* PROJ, int pitch, int qoff, int koff, int voff, int nside, int dil, const float* sink, bf16* OCAT, float* OG, float* LSE) {
    const int total = 8 * T;
    for (int gi = F.gw * 64 + F.lane; gi < total; gi += F.NGW * 64) {
        const int tok = gi % T, h = gi / T, hkv = h >> 2; const int b = tok / SEQ, pos = tok % SEQ;
        float q[64], o[64];
        { const f32x4* qp = (const f32x4*)(PROJ + (size_t)tok * pitch + qoff + h * 64);
#pragma unroll
          for (int i = 0; i < 16; ++i) { const f32x4 v = qp[i]; q[4 * i] = v.x * 0.125f; q[4 * i + 1] = v.y * 0.125f; q[4 * i + 2] = v.z * 0.125f; q[4 * i + 3] = v.w * 0.125f; } }
#pragma unroll
        for (int d = 0; d < 64; ++d) o[d] = 0.f;
        float mx = -INFINITY, l = 0.f;
        for (int j = -nside; j <= nside; ++j) {
            const int kp = pos + j * dil; if (kp < 0 || kp >= SEQ) continue;
            const float* kr = PROJ + ((size_t)b * SEQ + kp) * pitch;
            float s = 0.f;
#pragma unroll
            for (int i = 0; i < 16; ++i) { const f32x4 kv = *(const f32x4*)(kr + koff + hkv * 64 + 4 * i); s += q[4 * i] * kv.x + q[4 * i + 1] * kv.y + q[4 * i + 2] * kv.z + q[4 * i + 3] * kv.w; }
            if (s > mx) { const float c = __expf(mx - s); l *= c;
#pragma unroll
                for (int d = 0; d < 64; ++d) o[d] *= c;
                mx = s; }
            const float p = __expf(s - mx); l += p;
#pragma unroll
            for (int i = 0; i < 16; ++i) { const f32x4 vv = *(const f32x4*)(kr + voff + hkv * 64 + 4 * i); o[4 * i] += p * vv.x; o[4 * i + 1] += p * vv.y; o[4 * i + 2] += p * vv.z; o[4 * i + 3] += p * vv.w; }
        }
        if (MODE == 0) {
            const float sk = sink[h]; const float m2 = fmaxf(mx, sk); const float c = __expf(mx - m2); l = l * c + __expf(sk - m2); const float il = c / l;
            bf16* op = OCAT + (size_t)tok * D + 512 + h * 64;
#pragma unroll
            for (int i = 0; i < 8; ++i) { v4u w; w.x = pk2(o[8 * i] * il, o[8 * i + 1] * il); w.y = pk2(o[8 * i + 2] * il, o[8 * i + 3] * il); w.z = pk2(o[8 * i + 4] * il, o[8 * i + 5] * il); w.w = pk2(o[8 * i + 6] * il, o[8 * i + 7] * il); *(v4u*)(op + 8 * i) = w; }
        } else {
            const float il = 1.f / l; float* op = OG + (size_t)tok * C_OUT + h * 64;
#pragma unroll
            for (int i = 0; i < 16; ++i) { f32x4 w; w.x = o[4 * i] * il; w.y = o[4 * i + 1] * il; w.z = o[4 * i + 2] * il; w.w = o[4 * i + 3] * il; *(f32x4*)(op + 4 * i) = w; }
            LSE[(size_t)tok * 8 + h] = mx + __logf(l);
        }
    }
}
__device__ __forceinline__ void merge_phase(Frame& F, const float* OG, const float* LSE, bf16* OCAT1) {
    for (int m = F.gw; m < T; m += F.NGW) {
        const int h = F.lane >> 3;
        const float l0 = LSE[(size_t)m * 8 + h], l1 = LSE[(size_t)T * 8 + (size_t)m * 8 + h], l2 = LSE[(size_t)2 * T * 8 + (size_t)m * 8 + h];
        const float mx = fmaxf(l0, fmaxf(l1, l2)); float w0 = __expf(l0 - mx), w1 = __expf(l1 - mx), w2 = __expf(l2 - mx); const float is = 1.f / (w0 + w1 + w2); w0 *= is; w1 *= is; w2 *= is;
        const size_t off = (size_t)m * C_OUT + F.lane * 8; float r[8];
#pragma unroll
        for (int i = 0; i < 2; ++i) { const f32x4 a = *(const f32x4*)(OG + off + 4 * i), b = *(const f32x4*)(OG + (size_t)T * C_OUT + off + 4 * i), c = *(const f32x4*)(OG + (size_t)2 * T * C_OUT + off + 4 * i);
            r[4 * i] = w0 * a.x + w1 * b.x + w2 * c.x; r[4 * i + 1] = w0 * a.y + w1 * b.y + w2 * c.y; r[4 * i + 2] = w0 * a.z + w1 * b.z + w2 * c.z; r[4 * i + 3] = w0 * a.w + w1 * b.w + w2 * c.w; }
        v4u w; w.x = pk2(r[0], r[1]); w.y = pk2(r[2], r[3]); w.z = pk2(r[4], r[5]); w.w = pk2(r[6], r[7]);
        *(v4u*)(OCAT1 + off) = w;
    }
}

__device__ __forceinline__ void route_phase(Frame& F, const float* H, const float* WR, const float* rb, gu32* cnt, int* TOPE, float* TOPG, int* TOPPOS, float* RSTD) {
    const int lane = F.lane;
    for (int m = F.gw; m < T; m += F.NGW) {
        const GAS f32x4* xr = (const GAS f32x4*)(H + (size_t)m * D) + lane;
        f32x4 v[4]; float s = 0.f;
#pragma unroll
        for (int j = 0; j < 4; ++j) { v[j] = xr[64 * j]; s += (v[j].x * v[j].x + v[j].y * v[j].y) + (v[j].z * v[j].z + v[j].w * v[j].w); }
        const float rstd = 1.f / sqrtf(wave_sum(s) * (1.f / D) + NORM_EPS);
        float lg[32];
#pragma unroll
        for (int e = 0; e < 32; ++e) { const GAS f32x4* wr = (const GAS f32x4*)(WR + (size_t)e * D) + lane; float a = 0.f;
#pragma unroll
            for (int j = 0; j < 4; ++j) { const f32x4 w = wr[64 * j]; a += (v[j].x * w.x + v[j].y * w.y) + (v[j].z * w.z + v[j].w * w.w); }
            lg[e] = wave_sum(a) * rstd + rb[e]; }
        unsigned used = 0u; float tv[4]; int ti[4];
#pragma unroll
        for (int k = 0; k < 4; ++k) { float best = -INFINITY; int bi = 0;
#pragma unroll
            for (int e = 0; e < 32; ++e) { const bool take = (lg[e] > best) && !((used >> e) & 1u); best = take ? lg[e] : best; bi = take ? e : bi; }
            used |= 1u << bi; tv[k] = best; ti[k] = bi; }
        const float e1 = __expf(tv[1] - tv[0]), e2 = __expf(tv[2] - tv[0]), e3 = __expf(tv[3] - tv[0]); const float is = 1.f / (1.f + e1 + e2 + e3);
        if (lane < 4) { const int e = lane == 0 ? ti[0] : lane == 1 ? ti[1] : lane == 2 ? ti[2] : ti[3]; const float g = (lane == 0 ? 1.f : lane == 1 ? e1 : lane == 2 ? e2 : e3) * is;
            const unsigned pos = __hip_atomic_fetch_add(cnt + e, 1u, RLX_AGENT);
            TOPE[m * 4 + lane] = e; TOPG[m * 4 + lane] = g; TOPPOS[m * 4 + lane] = (int)pos; }
        if (lane == 0) RSTD[m] = rstd;
    }
}
__device__ __forceinline__ void slot_phase(Frame& F, const float* H, gu32* cnt, const int* TOPE, const float* TOPG, const int* TOPPOS, const float* RSTD, int* TOKSLOT, float* SLOTGATE, bf16* XG, int2* ULUP, int2* ULDN, int* ULN) {
    LAS int* L = (LAS int*)(F.lds + RING_OFF);
    if (F.tid < 32) L[F.tid] = ((int)__hip_atomic_load(cnt + F.tid, RLX_AGENT) + 255) >> 8;
    __syncthreads();
    if (F.tid == 0) { int acc = 0; for (int e = 0; e < 32; ++e) { L[32 + e] = acc; acc += L[e] * 256; } }
    __syncthreads();
    if (blockIdx.x == 0) {
        if (F.tid == 0) {
            for (int x = 0; x < 8; ++x) L[96 + x] = 0;
            for (int e = 0; e < 32; ++e) L[64 + e] = -1;
            for (int it = 0; it < 32; ++it) { int be = 0, bn = -1; for (int e = 0; e < 32; ++e) if (L[64 + e] < 0 && L[e] > bn) { bn = L[e]; be = e; }
                int bx = 0, bl = 1 << 30; for (int x = 0; x < 8; ++x) if (L[96 + x] < bl) { bl = L[96 + x]; bx = x; }
                L[64 + be] = bx; L[96 + bx] += bn; L[104 + it] = be; }
        }
        __syncthreads();
        if (F.tid < 8) { const int x = F.tid; int nu = 0, nd = 0;
            for (int it = 0; it < 32; ++it) { const int e = L[104 + it]; if (L[64 + e] != x) continue; const int np = L[e], p0 = L[32 + e] >> 8;
                for (int pi = 0; pi < np; ++pi) { for (int j = 0; j < 8; ++j) ULUP[x * 4096 + nu++] = make_int2(p0 + pi, e * 8 + j); for (int j = 0; j < 4; ++j) ULDN[x * 4096 + nd++] = make_int2(p0 + pi, e * 4 + j); } }
            ULN[x] = nu; ULN[8 + x] = nd; }
    }
    const int lane = F.lane;
    for (int m = F.gw; m < T; m += F.NGW) {
        int slot = 0;
        if (lane < 4) { const int e = TOPE[m * 4 + lane]; slot = L[32 + e] + TOPPOS[m * 4 + lane]; TOKSLOT[m * 4 + lane] = slot; SLOTGATE[slot] = TOPG[m * 4 + lane]; }
        const int s0 = __shfl(slot, 0), s1 = __shfl(slot, 1), s2 = __shfl(slot, 2), s3 = __shfl(slot, 3);
        const float rstd = RSTD[m];
#pragma unroll
        for (int j = 0; j < 2; ++j) { const float* src = H + (size_t)m * D + j * 512 + lane * 8; const f32x4 a = *(const f32x4*)src, b = *(const f32x4*)(src + 4);
            v4u w; w.x = pk2(a.x * rstd, a.y * rstd); w.y = pk2(a.z * rstd, a.w * rstd); w.z = pk2(b.x * rstd, b.y * rstd); w.w = pk2(b.z * rstd, b.w * rstd);
            const size_t co = (size_t)j * 512 + lane * 8;
            *(v4u*)(XG + (size_t)s0 * D + co) = w; *(v4u*)(XG + (size_t)s1 * D + co) = w; *(v4u*)(XG + (size_t)s2 * D + co) = w; *(v4u*)(XG + (size_t)s3 * D + co) = w; }
    }
    __syncthreads();
}
__device__ __forceinline__ void combine_phase(Frame& F, const float* HM, const bf16* Y, const int* TOKSLOT, float* H2, bf16* XN2) {
    const int lane = F.lane;
    for (int m = F.gw; m < T; m += F.NGW) {
        const int s0 = TOKSLOT[m * 4], s1 = TOKSLOT[m * 4 + 1], s2 = TOKSLOT[m * 4 + 2], s3 = TOKSLOT[m * 4 + 3];
#pragma unroll
        for (int j = 0; j < 2; ++j) { const size_t co = (size_t)j * 512 + lane * 8; const float* src = HM + (size_t)m * D + co; f32x4 a = *(const f32x4*)src, b = *(const f32x4*)(src + 4);
            const v4u y0 = *(const v4u*)(Y + (size_t)s0 * D + co), y1 = *(const v4u*)(Y + (size_t)s1 * D + co), y2 = *(const v4u*)(Y + (size_t)s2 * D + co), y3 = *(const v4u*)(Y + (size_t)s3 * D + co);
            a.x += ((bflo(y0.x) + bflo(y1.x)) + bflo(y2.x)) + bflo(y3.x); a.y += ((bfhi(y0.x) + bfhi(y1.x)) + bfhi(y2.x)) + bfhi(y3.x);
            a.z += ((bflo(y0.y) + bflo(y1.y)) + bflo(y2.y)) + bflo(y3.y); a.w += ((bfhi(y0.y) + bfhi(y1.y)) + bfhi(y2.y)) + bfhi(y3.y);
            b.x += ((bflo(y0.z) + bflo(y1.z)) + bflo(y2.z)) + bflo(y3.z); b.y += ((bfhi(y0.z) + bfhi(y1.z)) + bfhi(y2.z)) + bfhi(y3.z);
            b.z += ((bflo(y0.w) + bflo(y1.w)) + bflo(y2.w)) + bflo(y3.w); b.w += ((bfhi(y0.w) + bfhi(y1.w)) + bfhi(y2.w)) + bfhi(y3.w);
            float* dst = H2 + (size_t)m * D + co; *(f32x4*)dst = a; *(f32x4*)(dst + 4) = b;
            v4u w; w.x = pk2(a.x, a.y); w.y = pk2(a.z, a.w); w.z = pk2(b.x, b.y); w.w = pk2(b.z, b.w); *(v4u*)(XN2 + (size_t)m * D + co) = w; }
    }
}
__device__ __forceinline__ void final_norm_phase(Frame& F, const float* H, const float* gain, float* out) {
    const int lane = F.lane;
    for (int m = F.gw; m < T; m += F.NGW) {
        const GAS f32x4* xr = (const GAS f32x4*)(H + (size_t)m * D) + lane; const f32x4* gr = (const f32x4*)gain + lane;
        f32x4 v[4]; float s = 0.f;
#pragma unroll
        for (int j = 0; j < 4; ++j) { v[j] = xr[64 * j]; s += (v[j].x * v[j].x + v[j].y * v[j].y) + (v[j].z * v[j].z + v[j].w * v[j].w); }
        const float rstd = 1.f / sqrtf(wave_sum(s) * (1.f / D) + NORM_EPS);
        f32x4* o = (f32x4*)(out + (size_t)m * D) + lane;
#pragma unroll
        for (int j = 0; j < 4; ++j) { const f32x4 g = gr[64 * j]; o[64 * j] = v[j] * rstd * g; }
    }
}

constexpr int N_PHASES = 26;
struct Args { const float* in[20]; float* out; unsigned char* ws; int ph_lo, ph_hi, li, pad; };
typedef const __attribute__((address_space(4))) Args* argp_t;
__device__ __forceinline__ argp_t opaque_args() { argp_t p = (argp_t)__builtin_amdgcn_kernarg_segment_ptr(); asm volatile("" : "+s"(p)); return p; }
#define AP (opaque_args())
__global__ void __launch_bounds__(NWAVES * 64, 2) fwd_kernel(Args args_unused) {
    extern __shared__ __attribute__((aligned(16))) unsigned char lds[];
    Frame F;
    F.lds = (LAS unsigned char*)lds;
    F.MISC = (volatile LAS unsigned*)(F.lds + MISC_OFF);
    refresh(F);
    F.ctl = (gu32*)(AP->ws + WS_CTL);
    for (int u = F.tid; u < (LDS_BYTES - LDSCTL_OFF) / 4; u += NWAVES * 64) ((LAS unsigned*)(F.lds + LDSCTL_OFF))[u] = 0u;
    __syncthreads();
    const bool one_phase = (AP->ph_hi - AP->ph_lo) == 1;
    XcdBarrier bar; bar.bar = (unsigned*)(F.ctl + CW_BAR); bar.x = 0; bar.st = nullptr;
    if (!one_phase) bar = xcd_barrier_post((unsigned*)(F.ctl + CW_BAR), F.MISC + 8);
    const int lo = AP->ph_lo, hi = AP->ph_hi;
#ifndef MK_MASK
#define MK_MASK 0x3fff
#endif
#define IN(k) (lo <= (k) && (k) < hi)
#define INL(j) (((MK_MASK >> (j)) & 1) && IN(pb + (j)) && refresh(F))
#define SEAM(k) do { if (IN((k) + 1)) xcd_barrier(bar); } while (0)
#define ws (AP->ws)
#define x_in ((const float*)AP->in[0])
#define p_in ((const float*)AP->in[1])
#define XN ((bf16*)(ws + WS_XN))
#define PROJ ((float*)(ws + WS_PROJ))
#define OCAT ((bf16*)(ws + WS_OCAT))
#define OG ((float*)(ws + WS_OG))
#define LSE ((float*)(ws + WS_LSE))
#define HM ((float*)(ws + WS_HM))
#define H2 ((float*)(ws + WS_H2))
#define H3 ((float*)(ws + WS_H3))
#define TOPE ((int*)(ws + WS_TOPE))
#define TOPG ((float*)(ws + WS_TOPG))
#define TOPPOS ((int*)(ws + WS_TOPPOS))
#define RSTD ((float*)(ws + WS_RSTD))
#define TOKSLOT ((int*)(ws + WS_TOKSLOT))
#define SLOTGATE ((float*)(ws + WS_SLOTGATE))
#define ULUP ((int2*)(ws + WS_ULUP))
#define ULDN ((int2*)(ws + WS_ULDN))
#define ULN ((int*)(ws + WS_ULN))
#define XG ((bf16*)(ws + WS_XG))
#define ACT ((bf16*)(ws + WS_ACT))
#define Y ((bf16*)(ws + WS_Y))
    if (((MK_MASK >> 12) & 1) && IN(0) && refresh(F)) {
        transpose_all<0>(F, AP->in[3], D, AB_IN, (bf16*)(ws + WS_WIN0T), AP->in[2]);
        transpose_all<0>(F, AP->in[7], D, D, (bf16*)(ws + WS_WOUT0T), nullptr);
        transpose_all<0>(F, AP->in[8], D, C_IN, (bf16*)(ws + WS_WIN1T), AP->in[2] + D);
        transpose_all<0>(F, AP->in[9], C_OUT, D, (bf16*)(ws + WS_WOUT1T), nullptr);
#pragma unroll 1
        for (int l = 0; l < 2; ++l) {
            transpose_all<0>(F, AP->in[18] + (size_t)l * D * D, D, D, (bf16*)(ws + WS_WGT) + (size_t)l * D * D, nullptr);
            transpose_all<0>(F, AP->in[17] + (size_t)l * PLE * D, PLE, D, (bf16*)(ws + WS_WPT) + (size_t)l * D * PLE, nullptr);
#pragma unroll 1
            for (int e = 0; e < NE; ++e) {
                transpose_all<1>(F, AP->in[13] + ((size_t)l * NE + e) * D * 2 * DE, D, 2 * DE, (bf16*)(ws + WS_WUPT) + ((size_t)l * NE + e) * 2 * DE * D, AP->in[10] + l * D);
                transpose_all<0>(F, AP->in[15] + ((size_t)l * NE + e) * DE * D, DE, D, (bf16*)(ws + WS_WDNT) + ((size_t)l * NE + e) * D * DE, nullptr);
            }
        }
        {
            float* WR = (float*)(ws + WS_WR);
            for (int i = F.gw * 64 + F.lane; i < 2 * NE * D; i += F.NGW * 64) { const int l = i / (NE * D), e = (i / D) % NE, k = i % D; WR[i] = AP->in[10][l * D + k] * AP->in[11][((size_t)l * D + k) * NE + e]; }
        }
        {
            bf16* PBF = (bf16*)(ws + WS_PBF); const size_t n8 = (size_t)2 * T * PLE / 8;
            for (size_t i = (size_t)F.gw * 64 + F.lane; i < n8; i += (size_t)F.NGW * 64) { const f32x4 a = *(const f32x4*)(p_in + i * 8), b = *(const f32x4*)(p_in + i * 8 + 4);
                v4u w; w.x = pk2(a.x, a.y); w.y = pk2(a.z, a.w); w.z = pk2(b.x, b.y); w.w = pk2(b.z, b.w); *(v4u*)(PBF + i * 8) = w; }
        }
        __syncthreads();
        SEAM(0);
    }
#pragma unroll 1
    for (int l = 0; l < 2; ++l) {
        const int pb = 1 + 12 * l;
        const float* hin = (l == 0) ? x_in : H3;
        if (INL(0)) { for (int m = F.gw; m < T; m += F.NGW) norm_row_to_bf16(hin + (size_t)m * D, XN + (size_t)m * D, F.lane);
            if (l == 0) { int Kp = PLE; asm volatile("" : "+s"(Kp)); pg8::Gemm g{(const bf16*)(ws + WS_PBF), (const bf16*)(ws + WS_WPT), 2 * T, 2 * D, Kp}; PPOrder S{(int)F.G, F.bx};
                  EpiPP E{(bf16*)(ws + WS_PP)};
                  pg8::gemm_phase<EpiPP, PPOrder, true, true>(F.lds + RING_OFF, g, S, E); }
            SEAM(pb + 0); }
        if (INL(1)) {
            { const int Nn = (l == 0) ? AB_IN : C_IN;
              pg8::Gemm g{XN, (const bf16*)(ws + (l == 0 ? WS_WIN0T : WS_WIN1T)), T, Nn, D}; pg8::StaticOrder S; S.init(T, Nn, F.G, F.bx); EpiF32<false> E{PROJ, Nn, nullptr};
              pg8::gemm_phase<EpiF32<false>, pg8::StaticOrder, true, true>(F.lds + RING_OFF, g, S, E); }
            SEAM(pb + 1);
        }
        if (INL(2)) { if (l == 0) rope_phase_l0(F, PROJ, AP->in[4], AP->in[5]); else rope_phase_l1(F, PROJ); SEAM(pb + 2); }
        if (INL(3)) {
            if (l == 0) { attn_dense_naive(F, PROJ, OCAT); attn_band_naive<0>(F, PROJ, AB_IN, 768, 1280, 1408, 128, 1, AP->in[6], OCAT, nullptr, nullptr); }
            else {
#pragma unroll 1
                for (int g = 0; g < 3; ++g) attn_band_naive<1>(F, PROJ, C_IN, g * 768, g * 768 + 512, g * 768 + 640, 64, g == 0 ? 1 : g == 1 ? 4 : 16, nullptr, nullptr, OG + (size_t)g * T * C_OUT, LSE + (size_t)g * T * 8);
            }
            __syncthreads();
            SEAM(pb + 3);
        }
        if (INL(4)) { if (l == 1) merge_phase(F, OG, LSE, OCAT); SEAM(pb + 4); }
        if (INL(5)) {
            { pg8::Gemm g{OCAT, (const bf16*)(ws + (l == 0 ? WS_WOUT0T : WS_WOUT1T)), T, D, (l == 0) ? D : C_OUT}; pg8::StaticOrder S; S.init(T, D, F.G, F.bx); EpiF32<true> E{HM, D, hin};
              pg8::gemm_phase<EpiF32<true>, pg8::StaticOrder, true, true>(F.lds + RING_OFF, g, S, E); }
            SEAM(pb + 5);
        }
        if (INL(6)) { route_phase(F, HM, (const float*)(ws + WS_WR) + (size_t)l * NE * D, AP->in[12] + l * NE, F.ctl + CW_CNT + l * NE, TOPE, TOPG, TOPPOS, RSTD); SEAM(pb + 6); }
        if (INL(7)) { slot_phase(F, HM, F.ctl + CW_CNT + l * NE, TOPE, TOPG, TOPPOS, RSTD, TOKSLOT, SLOTGATE, XG, ULUP, ULDN, ULN); SEAM(pb + 7); }
        if (INL(8)) {
            pg8::Gemm g{XG, (const bf16*)(ws + WS_WUPT) + (size_t)l * NE * 2 * DE * D, NSLOT, NE * 2 * DE, D};
            const int xq = F.bx & 7; ListOrder S{ULUP + xq * 4096, ULN[xq], F.bx >> 3, (int)F.G >> 3};
            EpiSwiglu E{ACT, AP->in[14] + (size_t)l * NE * 2 * DE};
            pg8::gemm_phase<EpiSwiglu, ListOrder, true, true>(F.lds + RING_OFF, g, S, E);
            SEAM(pb + 8);
        }
        if (INL(9)) {
            pg8::Gemm g{ACT, (const bf16*)(ws + WS_WDNT) + (size_t)l * NE * D * DE, NSLOT, NE * D, DE};
            const int xq = F.bx & 7; ListOrder S{ULDN + xq * 4096, ULN[8 + xq], F.bx >> 3, (int)F.G >> 3};
            EpiDown E{Y, AP->in[16] + (size_t)l * NE * D, SLOTGATE};
            pg8::gemm_phase<EpiDown, ListOrder, true, true>(F.lds + RING_OFF, g, S, E);
            SEAM(pb + 9);
        }
        if (INL(10)) { combine_phase(F, HM, Y, TOKSLOT, H2, XN); SEAM(pb + 10); }
        if (INL(11)) {
            pg8::Gemm g{XN, (const bf16*)(ws + WS_WGT) + (size_t)l * D * D, T, D, D}; pg8::StaticOrder S; S.init(T, D, F.G, F.bx);
            EpiPle E{H2, (const bf16*)(ws + WS_PP) + (size_t)l * T * D, H3};
            pg8::gemm_phase<EpiPle, pg8::StaticOrder, true, true>(F.lds + RING_OFF, g, S, E);
            SEAM(pb + 11);
        }
    }
    if (((MK_MASK >> 13) & 1) && IN(25) && refresh(F)) final_norm_phase(F, H3, AP->in[19], AP->out);
#undef IN
#undef SEAM
#undef x_in
#undef ws
#undef p_in
#undef XN
#undef PROJ
#undef OCAT
#undef OG
#undef LSE
#undef HM
#undef H2
#undef H3
#undef TOPE
#undef TOPG
#undef TOPPOS
#undef RSTD
#undef TOKSLOT
#undef SLOTGATE
#undef ULUP
#undef ULDN
#undef ULN
#undef XG
#undef ACT
#undef Y
}

#ifndef MK_ONE_LAUNCH
#define MK_ONE_LAUNCH 1
#endif
extern "C" void kernel_launch(void* const* d_in, const int* in_sizes, int n_in, void* d_out, int out_size, void* d_ws, size_t ws_size, hipStream_t stream) {
    static int grid = 0;
    if (grid == 0) {
        if (n_in != 20 || in_sizes[0] != T * D || out_size != T * D || ws_size < WS_END) { fprintf(stderr, "kernel_launch: unexpected shapes: n_in %d in0 %d out %d ws %zu (need %zu)\n", n_in, n_in > 0 ? in_sizes[0] : -1, out_size, ws_size, (size_t)WS_END); grid = -1; return; }
        int dev = 0, cus = 0, per_cu = 0;
        if (hipGetDevice(&dev) != hipSuccess || hipDeviceGetAttribute(&cus, hipDeviceAttributeMultiprocessorCount, dev) != hipSuccess) { grid = -1; return; }
        if (hipFuncSetAttribute((const void*)fwd_kernel, hipFuncAttributeMaxDynamicSharedMemorySize, LDS_BYTES) != hipSuccess) { fprintf(stderr, "kernel_launch: hipFuncSetAttribute failed\n"); grid = -1; return; }
        if (hipOccupancyMaxActiveBlocksPerMultiprocessor(&per_cu, (const void*)fwd_kernel, NWAVES * 64, LDS_BYTES) != hipSuccess || per_cu < 1) fprintf(stderr, "kernel_launch: occupancy query says %d\n", per_cu);
        (void)hipGetLastError();
        grid = cus;
        if (grid != 256) fprintf(stderr, "kernel_launch: %d CUs (built for 256)\n", grid);
    }
    if (grid < 0) return;
    if (hipMemsetAsync((char*)d_ws + WS_CTL, 0, CTL_ZERO_BYTES, stream) != hipSuccess) return;
    Args a{};
    for (int i = 0; i < 20; ++i) a.in[i] = (const float*)d_in[i];
    a.out = (float*)d_out; a.ws = (unsigned char*)d_ws;
#if MK_ONE_LAUNCH
    a.ph_lo = 0; a.ph_hi = N_PHASES; a.li = 0;
    hipLaunchKernelGGL(fwd_kernel, dim3(grid), dim3(NWAVES * 64), LDS_BYTES, stream, a);
#else
    for (int ph = 0; ph < N_PHASES; ++ph) {
        if (ph == 5) continue;
        a.ph_lo = ph; a.ph_hi = ph + 1; a.li = ph;
        hipLaunchKernelGGL(fwd_kernel, dim3(grid), dim3(NWAVES * 64), LDS_BYTES, stream, a);
    }
#endif
}
```

```cpp
#include <hip/hip_runtime.h>
#include <hip/hip_bf16.h>
#include <cstdio>
#include <cstdint>
#include <cmath>
namespace pg8 {
#define PG8_LAS __attribute__((address_space(3)))
typedef unsigned short bf16_t;
typedef short bf16x8 __attribute__((ext_vector_type(8)));
typedef float f32x4 __attribute__((ext_vector_type(4)));
typedef unsigned u32x4 __attribute__((ext_vector_type(4)));
constexpr int BM = 256, BK = 64, HALF = 128, HTB = HALF * BK * 2  , STAGE_BYTES = 8 * HTB, NXCD = 8, WGM = 8;

__host__ __device__ __forceinline__ int lds_byte(int r, int c) { const int st = (r >> 4) * 2 + (c >> 5), rr = r & 15, cc = c & 31, ob = rr * 64 + cc * 2; return st * 1024 + (ob ^ (((ob >> 9) & 1) << 5)); }
__host__ __device__ __forceinline__ void stage_rc(int b, int& R, int& C) { const int st = b / 1024, sb = b % 1024, swz = sb ^ (((sb >> 9) & 1) << 5); R = (st >> 1) * 16 + swz / 64; C = (st & 1) * 32 + (swz % 64) / 2; }
__host__ __device__ __forceinline__ int perm32(int rho) { const int n = rho >> 4, i = rho & 15; return 8 * (i >> 2) + 4 * n + (i & 3); }

struct Unit { int pm, pn; };
struct Gemm { const bf16_t* A; const bf16_t* Bt; int M, N, K; };

struct StaticOrder {
    int nM, nN, nwg, G, c;
    __host__ __device__ void init(int M, int N, int G_, int c_) { nM = M / BM; nN = N / BM; nwg = nM * nN; G = G_; c = c_; }
    __host__ __device__ bool next(int i, Unit& u) const {
        const long L = (long)i * G + c; if (L >= nwg) return false;
        int wgid = (int)L; { const int q = nwg / NXCD, r = nwg % NXCD, xcd = wgid % NXCD, off = wgid / NXCD; wgid = (xcd < r ? xcd * (q + 1) : r * (q + 1) + (xcd - r) * q) + off; }
        const int nig = WGM * nN, gid = wgid / nig, fm = gid * WGM, gsz = (nM - fm) < WGM ? (nM - fm) : WGM;
        u.pm = fm + ((wgid % nig) % gsz); u.pn = (wgid % nig) / gsz; return true;
    }
    __device__ __forceinline__ void a_ready(const Unit&) const {}
    __device__ __forceinline__ void done(const Unit&) const {}
};

__device__ __forceinline__ unsigned cvt_pk_bf16(float lo, float hi) { unsigned r; asm volatile("v_cvt_pk_bf16_f32 %0, %1, %2" : "=v"(r) : "v"(lo), "v"(hi)); return r; }
typedef float f32x2 __attribute__((ext_vector_type(2)));
__device__ __forceinline__ f32x2 gelu_pk(f32x2 v) {
    const f32x2 av = __builtin_elementwise_abs(v), d = av * 0.2316418882f + 1.0f;
    f32x2 t; t.x = __builtin_amdgcn_rcpf(d.x); t.y = __builtin_amdgcn_rcpf(d.y);
    f32x2 q = t * 0.5307027145f + (-0.7265760135f); q = q * t + 0.7107068705f; q = q * t + (-0.142248368f); q = q * t + 0.127414796f; q = q * t;
    const f32x2 s = (v * v) * (-0.72134752044f);
    f32x2 e; e.x = __builtin_amdgcn_exp2f(s.x); e.y = __builtin_amdgcn_exp2f(s.y);
    const f32x2 m = v * (q * e), r = v - m;
    f32x2 o; o.x = v.x < 0.f ? m.x : r.x; o.y = v.y < 0.f ? m.y : r.y; return o;
}

template <int ACT  > struct EpiBf16 {
    static constexpr bool PERM = true, AFTER_DRAIN = false; static_assert(ACT == 0 || ACT == 1, "EpiBf16: ACT is 0 (none) or 1 (gelu_pk)");
    bf16_t* O; int ldc; const float* bias; int split_cols; size_t split_stride; float scale0;
    __device__ __forceinline__ void operator()(const f32x4 (&acc)[2][2][4][2], const Unit& u, int wr, int wc, int fr, int fq) const {
        const int row0 = u.pm * BM + wr * 64 + fr; int colt = u.pn * BM; bf16_t* base = O;
        float sc = 1.f; if (split_cols) { const int t = colt / split_cols; base += (size_t)t * split_stride; colt -= t * split_cols; if (t == 0) sc = scale0; }
        const int col0 = colt + wc * 32 + 8 * fq, bcol0 = u.pn * BM + wc * 32 + 8 * fq;
        f32x4 bv[2][2];
#pragma unroll
        for (int bj = 0; bj < 2; ++bj)
#pragma unroll
            for (int n = 0; n < 2; ++n) bv[bj][n] = bias ? *(const f32x4*)(bias + bcol0 + bj * HALF + 4 * n) : (f32x4){0.f, 0.f, 0.f, 0.f};
#pragma unroll
        for (int ai = 0; ai < 2; ++ai)
#pragma unroll
            for (int m = 0; m < 4; ++m) { bf16_t* rowp = base + (size_t)(row0 + ai * HALF + m * 16) * ldc + col0;
#pragma unroll
                for (int bj = 0; bj < 2; ++bj) { f32x4 v0 = acc[ai][bj][m][0] + bv[bj][0], v1 = acc[ai][bj][m][1] + bv[bj][1];
                    if (ACT == 1) { f32x2 a = gelu_pk((f32x2){v0[0], v0[1]}), b = gelu_pk((f32x2){v0[2], v0[3]}), c = gelu_pk((f32x2){v1[0], v1[1]}), d = gelu_pk((f32x2){v1[2], v1[3]});
                        v0 = (f32x4){a.x, a.y, b.x, b.y}; v1 = (f32x4){c.x, c.y, d.x, d.y}; }
                    v0 = v0 * sc; v1 = v1 * sc; u32x4 w; w.x = cvt_pk_bf16(v0[0], v0[1]); w.y = cvt_pk_bf16(v0[2], v0[3]); w.z = cvt_pk_bf16(v1[0], v1[1]); w.w = cvt_pk_bf16(v1[2], v1[3]);
                    *(u32x4*)(rowp + bj * HALF) = w; } }
    }
};
template <class Epi, class Sched, bool ALIGN_EPI = false, bool SP2 = false>
__device__ __forceinline__ void gemm_phase(PG8_LAS unsigned char* lds, const Gemm g, const Sched& S, const Epi& E) {
    int tid_ = threadIdx.x; asm volatile("" : "+v"(tid_));
    const int tid = tid_, wid = __builtin_amdgcn_readfirstlane(tid >> 6), lane = tid & 63, wr = wid >> 2, wc = wid & 3, fr = lane & 15, fq = lane >> 4;
    const int K = g.K, nt = K / BK;
    unsigned voffA[2], voffB[2];
#pragma unroll
    for (int i = 0; i < 2; ++i) { int R, C; stage_rc(tid * 16 + i * 8192, R, C); const int Rb = Epi::PERM ? ((R & ~31) + perm32(R & 31)) : R;
        voffA[i] = (unsigned)(R * K + C) * 2u; voffB[i] = (unsigned)(Rb * K + C) * 2u; }
    const size_t kstep = (size_t)(BK * 2);
    const size_t hstep = (size_t)HALF * K * 2;
    const size_t tstep = 2 * hstep;
    const unsigned ldsw = (unsigned)wid * 1024u;
    const int aoff = lds_byte(wr * 64 + fr, fq * 8), boff = lds_byte(wc * 32 + fr, fq * 8);
#define PG8_SA(b, h) (((b) * 2 + (h)) * HTB)
#define PG8_SB(b, h) ((4 + (b) * 2 + (h)) * HTB)
#define PG8_STAGE(bufoff, gbase, voff) do { _Pragma("unroll") for (int _i = 0; _i < 2; ++_i) \
        __builtin_amdgcn_global_load_lds((const unsigned*)((const char*)(gbase) + (voff)[_i]), (PG8_LAS unsigned*)(lds + (bufoff) + ldsw + _i * 8192), 16, 0, 0); } while (0)
#define PG8_LDA(dst, b, h) do { _Pragma("unroll") for (int m = 0; m < 4; ++m) _Pragma("unroll") for (int k = 0; k < 2; ++k) dst[m][k] = *(const PG8_LAS bf16x8*)(lds + PG8_SA(b, h) + aoff + m * 2048 + k * 1024); } while (0)
#define PG8_LDB(dst, b, h) do { _Pragma("unroll") for (int n = 0; n < 2; ++n) _Pragma("unroll") for (int k = 0; k < 2; ++k) dst[n][k] = *(const PG8_LAS bf16x8*)(lds + PG8_SB(b, h) + boff + n * 2048 + k * 1024); } while (0)
#define PG8_MMA(ai, bj, At, Bt) do { __builtin_amdgcn_s_setprio(1); _Pragma("unroll") for (int m = 0; m < 4; ++m) _Pragma("unroll") for (int n = 0; n < 2; ++n) _Pragma("unroll") for (int k = 0; k < 2; ++k) \
        acc[ai][bj][m][n] = __builtin_amdgcn_mfma_f32_16x16x32_bf16(Bt[n][k], At[m][k], acc[ai][bj][m][n], 0, 0, 0); __builtin_amdgcn_s_setprio(0); } while (0)
#define PG8_WAIT_V(n) asm volatile("s_waitcnt vmcnt(" #n ")" ::: "memory")
#define PG8_WAIT_L(n) asm volatile("s_waitcnt lgkmcnt(" #n ")" ::: "memory")
#define PG8_BAR __builtin_amdgcn_s_barrier()
#define PG8_SCHED __builtin_amdgcn_sched_barrier(0)
    Unit cur, nxt; int ui = 0;
    if (!S.next(0, cur)) return;
    f32x4 acc[2][2][4][2];
#pragma unroll
    for (int a = 0; a < 2; ++a)
#pragma unroll
        for (int b = 0; b < 2; ++b)
#pragma unroll
            for (int m = 0; m < 4; ++m)
#pragma unroll
                for (int n = 0; n < 2; ++n) acc[a][b][m][n] = (f32x4){0.f, 0.f, 0.f, 0.f};
    bf16x8 At[4][2], B0[2][2], B1[2][2];
    const char* cA = (const char*)g.A + (size_t)cur.pm * tstep; const char* cB = (const char*)g.Bt + (size_t)cur.pn * tstep;
    S.a_ready(cur);
    if constexpr (SP2) {
        PG8_STAGE(PG8_SB(0, 0), cB, voffB); PG8_STAGE(PG8_SB(0, 1), cB + hstep, voffB); PG8_STAGE(PG8_SA(0, 0), cA, voffA); PG8_STAGE(PG8_SA(0, 1), cA + hstep, voffA);
        if (wr == 1) PG8_BAR;
        PG8_WAIT_V(2); PG8_BAR;
        PG8_STAGE(PG8_SB(1, 0), cB + kstep, voffB); PG8_STAGE(PG8_SA(1, 0), cA + kstep, voffA); PG8_STAGE(PG8_SB(1, 1), cB + hstep + kstep, voffB);
        PG8_WAIT_V(6); PG8_BAR;
    } else {
        PG8_STAGE(PG8_SB(0, 0), cB, voffB); PG8_STAGE(PG8_SA(0, 0), cA, voffA); PG8_STAGE(PG8_SB(0, 1), cB + hstep, voffB); PG8_STAGE(PG8_SA(0, 1), cA + hstep, voffA);
        if (wr == 1) PG8_BAR;
        PG8_WAIT_V(4); PG8_BAR;
        PG8_STAGE(PG8_SB(1, 0), cB + kstep, voffB); PG8_STAGE(PG8_SA(1, 0), cA + kstep, voffA); PG8_STAGE(PG8_SB(1, 1), cB + hstep + kstep, voffB);
        PG8_WAIT_V(6); PG8_BAR;
    }
    for (;;) {
        const bool has_next = S.next(ui + 1, nxt);
        const char* nA = has_next ? (const char*)g.A + (size_t)nxt.pm * tstep : cA; const char* nB = has_next ? (const char*)g.Bt + (size_t)nxt.pn * tstep : cB;
        for (int t = 0; t < nt; t += 2) {
            const bool last = (t == nt - 2);
            const char* a1 = cA + (size_t)(t + 1) * kstep;
            const char* a2 = last ? nA : cA + (size_t)(t + 2) * kstep; const char* b2 = last ? nB : cB + (size_t)(t + 2) * kstep;
            const char* a3 = a2 + kstep; const char* b3 = b2 + kstep;
            if (last && has_next) S.a_ready(nxt);
            if constexpr (SP2) {
            PG8_LDB(B0, 0, 0); PG8_LDB(B1, 0, 1); PG8_SCHED; PG8_LDA(At, 0, 0); PG8_STAGE(PG8_SA(1, 1), a1 + hstep, voffA);
            PG8_WAIT_V(8); PG8_WAIT_L(0); PG8_BAR; PG8_MMA(0, 0, At, B0); PG8_MMA(0, 1, At, B1); PG8_BAR; PG8_SCHED;
            PG8_LDA(At, 0, 1); PG8_STAGE(PG8_SB(0, 0), b2, voffB); PG8_STAGE(PG8_SB(0, 1), b2 + hstep, voffB); PG8_STAGE(PG8_SA(0, 0), a2, voffA);
            PG8_WAIT_V(8); PG8_WAIT_L(0); PG8_BAR; PG8_MMA(1, 0, At, B0); PG8_MMA(1, 1, At, B1); PG8_BAR; PG8_SCHED;
            PG8_LDB(B0, 1, 0); PG8_LDB(B1, 1, 1); PG8_SCHED; PG8_LDA(At, 1, 0); PG8_STAGE(PG8_SA(0, 1), a2 + hstep, voffA);
            PG8_WAIT_V(8); PG8_WAIT_L(0); PG8_BAR; PG8_MMA(0, 0, At, B0); PG8_MMA(0, 1, At, B1); PG8_BAR; PG8_SCHED;
            PG8_LDA(At, 1, 1); PG8_STAGE(PG8_SB(1, 0), b3, voffB); PG8_STAGE(PG8_SB(1, 1), b3 + hstep, voffB); PG8_STAGE(PG8_SA(1, 0), a3, voffA);
            PG8_WAIT_V(8); PG8_WAIT_L(0); PG8_BAR; PG8_MMA(1, 0, At, B0); PG8_MMA(1, 1, At, B1); PG8_BAR; PG8_SCHED;
            } else {
            PG8_LDB(B0, 0, 0); PG8_SCHED; PG8_LDA(At, 0, 0); PG8_STAGE(PG8_SA(1, 1), a1 + hstep, voffA);
            PG8_WAIT_L(8); PG8_BAR; PG8_WAIT_L(0); PG8_MMA(0, 0, At, B0); PG8_BAR; PG8_SCHED;
            PG8_LDB(B1, 0, 1); PG8_STAGE(PG8_SB(0, 0), b2, voffB);
            PG8_BAR; PG8_WAIT_L(0); PG8_MMA(0, 1, At, B1); PG8_BAR;
            PG8_LDA(At, 0, 1); PG8_STAGE(PG8_SA(0, 0), a2, voffA);
            PG8_BAR; PG8_WAIT_L(0); PG8_MMA(1, 0, At, B0); PG8_BAR; PG8_SCHED;
            PG8_STAGE(PG8_SB(0, 1), b2 + hstep, voffB);
            PG8_WAIT_V(6); PG8_BAR; PG8_MMA(1, 1, At, B1); PG8_BAR;
            PG8_LDB(B0, 1, 0); PG8_SCHED; PG8_LDA(At, 1, 0); PG8_STAGE(PG8_SA(0, 1), a2 + hstep, voffA);
            PG8_WAIT_L(8); PG8_BAR; PG8_WAIT_L(0); PG8_MMA(0, 0, At, B0); PG8_BAR; PG8_SCHED;
            PG8_LDB(B1, 1, 1); PG8_STAGE(PG8_SB(1, 0), b3, voffB);
            PG8_BAR; PG8_WAIT_L(0); PG8_MMA(0, 1, At, B1); PG8_BAR;
            PG8_LDA(At, 1, 1); PG8_STAGE(PG8_SA(1, 0), a3, voffA);
            PG8_BAR; PG8_WAIT_L(0); PG8_MMA(1, 0, At, B0); PG8_BAR; PG8_SCHED;
            PG8_STAGE(PG8_SB(1, 1), b3 + hstep, voffB);
            PG8_WAIT_V(6); PG8_BAR; PG8_MMA(1, 1, At, B1); PG8_BAR;
            }
        }
        if constexpr (ALIGN_EPI) { if (wr == 0) PG8_BAR; }
        if constexpr (!Epi::AFTER_DRAIN) { E(acc, cur, wr, wc, fr, fq); S.done(cur); }
        if (!has_next) break;
#pragma unroll
        for (int a = 0; a < 2; ++a)
#pragma unroll
            for (int b = 0; b < 2; ++b)
#pragma unroll
                for (int m = 0; m < 4; ++m)
#pragma unroll
                    for (int n = 0; n < 2; ++n) acc[a][b][m][n] = (f32x4){0.f, 0.f, 0.f, 0.f};
        cur = nxt; cA = nA; cB = nB; ++ui;
        if constexpr (ALIGN_EPI) { if (wr == 1) PG8_BAR; }
    }
    PG8_WAIT_V(0);
    if constexpr (!ALIGN_EPI) { if (wr == 0) PG8_BAR; }
    PG8_BAR;
    if constexpr (Epi::AFTER_DRAIN) { E.fused(acc, cur, wr, wc, fr, fq, lds, wid, lane); S.done(cur); }
#undef PG8_SA
#undef PG8_SB
#undef PG8_STAGE
#undef PG8_LDA
#undef PG8_LDB
#undef PG8_MMA
#undef PG8_WAIT_V
#undef PG8_WAIT_L
#undef PG8_BAR
#undef PG8_SCHED
}
}

constexpr int NWAVES = 8;
constexpr int BATCH = 2, SEQ = 8192, T = BATCH * SEQ, D = 1024;
constexpr int AB_IN = 1536, C_IN = 2304, C_OUT = 512;
constexpr int NE = 32, DE = 1024, PLE = 256;
constexpr int NSLOT = 73728;
constexpr float NORM_EPS = 1e-6f;
constexpr float LOG2_THETA = 13.287712379549449f;
constexpr float ATT_C2 = 0.125f * 1.4426950408889634f;

#define GAS __attribute__((address_space(1)))
#define LAS __attribute__((address_space(3)))
typedef unsigned short bf16;
typedef unsigned v4u __attribute__((ext_vector_type(4)));
typedef unsigned v2u __attribute__((ext_vector_type(2)));
typedef float f32x4 __attribute__((ext_vector_type(4)));
typedef GAS unsigned gu32;
#define RLX_AGENT __ATOMIC_RELAXED, __HIP_MEMORY_SCOPE_AGENT
#define LDS_WAIT() asm volatile("s_waitcnt lgkmcnt(0)" ::: "memory")
#define VM_WAIT() asm volatile("s_waitcnt vmcnt(0)" ::: "memory")

typedef float f32x2_ __attribute__((ext_vector_type(2))); typedef __bf16 bf16x2_ __attribute__((ext_vector_type(2)));
__device__ __forceinline__ unsigned pk2(float lo, float hi) { f32x2_ v = {lo, hi}; bf16x2_ b = __builtin_convertvector(v, bf16x2_); return __builtin_bit_cast(unsigned, b); }
__device__ __forceinline__ float bflo(unsigned w) { return __builtin_bit_cast(float, w << 16); }
__device__ __forceinline__ float bfhi(unsigned w) { return __builtin_bit_cast(float, w & 0xffff0000u); }
__device__ __forceinline__ float rnd_bf(float x) { return bflo(pk2(x, 0.f)); }
__device__ __forceinline__ float ssp_sum(const float* p) { const f32x4 a = *(const f32x4*)p, b = *(const f32x4*)(p + 4), c = *(const f32x4*)(p + 8), d = *(const f32x4*)(p + 12);
    return (((a.x + a.y) + (a.z + a.w)) + ((b.x + b.y) + (b.z + b.w))) + (((c.x + c.y) + (c.z + c.w)) + ((d.x + d.y) + (d.z + d.w))); }

constexpr size_t MiB = 1u << 20;
constexpr size_t al256(size_t x) { return (x + 255) & ~(size_t)255; }
constexpr size_t WS_CTL = 0, CTL_ZERO_BYTES = 1 * MiB;
constexpr size_t WS_WIN0T = 1 * MiB;
constexpr size_t WS_WOUT0T = WS_WIN0T + (size_t)AB_IN * D * 2;
constexpr size_t WS_WIN1T = WS_WOUT0T + (size_t)D * D * 2;
constexpr size_t WS_WOUT1T = WS_WIN1T + (size_t)C_IN * D * 2;
constexpr size_t WS_WGT = WS_WOUT1T + (size_t)D * C_OUT * 2;
constexpr size_t WS_WPT = WS_WGT + 2 * (size_t)D * D * 2;
constexpr size_t WS_WR = WS_WPT + 2 * (size_t)D * PLE * 2;
constexpr size_t WS_ROPE1 = al256(WS_WR + 2 * (size_t)NE * D * 4);
constexpr size_t WS_ROPEA = WS_ROPE1 + (size_t)SEQ * 32 * 8;
constexpr size_t WS_WUPT = WS_ROPEA + (size_t)SEQ * 32 * 8;
constexpr size_t WS_WDNT = WS_WUPT + 2 * (size_t)NE * 2 * DE * D * 2;
constexpr size_t WS_PBF = WS_WDNT + 2 * (size_t)NE * D * DE * 2;
constexpr size_t WS_PP = WS_PBF + 2 * (size_t)T * PLE * 2;
constexpr size_t WS_X0 = WS_PP + 2 * (size_t)T * D * 2;
constexpr size_t WS_HM = WS_X0 + (size_t)T * D * 2;
constexpr size_t WS_H2 = WS_HM + (size_t)T * D * 2;
constexpr size_t WS_H3 = WS_H2 + (size_t)T * D * 2;
constexpr size_t WS_OCAT = WS_H3 + (size_t)T * D * 2;
constexpr size_t WS_SSP = WS_OCAT + (size_t)T * D * 2;
constexpr size_t WS_LSE = WS_SSP + 3 * (size_t)T * 16 * 4;
constexpr size_t WS_TOPE = WS_LSE + 3 * (size_t)T * 8 * 4;
constexpr size_t WS_TOPG = WS_TOPE + (size_t)T * 16;
constexpr size_t WS_TOPPOS = WS_TOPG + (size_t)T * 16;
constexpr size_t WS_RSTD = WS_TOPPOS + (size_t)T * 16;
constexpr size_t WS_TOKSLOT = WS_RSTD + (size_t)T * 4;
constexpr size_t WS_SLOTGATE = WS_TOKSLOT + (size_t)T * 16;
constexpr size_t WS_SLOTRS = WS_SLOTGATE + (size_t)NSLOT * 4;
constexpr size_t WS_XTAB = al256(WS_SLOTRS + (size_t)NSLOT * 4);
constexpr size_t WS_XG = al256(WS_XTAB + 8 * 136 * 4);
constexpr size_t WS_ACT = WS_XG + (size_t)NSLOT * D * 2;
constexpr size_t WS_Y = WS_ACT + (size_t)NSLOT * D * 2;
constexpr size_t WS_Q3 = WS_Y + (size_t)NSLOT * D * 2;
constexpr size_t WS_K3 = WS_Q3 + 3 * (size_t)T * 512 * 2;
constexpr size_t WS_V3 = WS_K3 + 3 * (size_t)T * 128 * 2;
constexpr size_t WS_OGB = WS_V3 + 3 * (size_t)T * 128 * 2;
constexpr size_t WS_END = WS_OGB + 3 * (size_t)T * 512 * 2;
constexpr int CW_TMO = 0;
constexpr int CW_CNT = 64;
constexpr int CW_BAR = 4096;

constexpr int LDSCTL_OFF = 0, MISC_OFF = 64;
constexpr int RING_OFF = 512, RING_BYTES = 131072;
constexpr int LDS_BYTES = 147456;

struct PPOrder {
    int G, c;
    __device__ __forceinline__ bool next(int i, pg8::Unit& u) const { const int L = i * G + c; if (L >= 512) return false; u.pm = L >> 2; u.pn = 4 * (u.pm >> 6) + (L & 3); return true; }
    __device__ __forceinline__ void a_ready(const pg8::Unit&) const {}
    __device__ __forceinline__ void done(const pg8::Unit&) const {}
};
struct EpiPP {
    static constexpr bool PERM = true, AFTER_DRAIN = false;
    bf16* O;
    __device__ __forceinline__ void operator()(const pg8::f32x4 (&acc)[2][2][4][2], const pg8::Unit& u, int wr, int wc, int fr, int fq) const {
        const int row0 = u.pm * 256 + wr * 64 + fr, col0 = (u.pn & 3) * 256 + wc * 32 + 8 * fq;
#pragma unroll
        for (int ai = 0; ai < 2; ++ai)
#pragma unroll
            for (int m = 0; m < 4; ++m) { bf16* rp = O + (size_t)(row0 + ai * 128 + m * 16) * D + col0;
#pragma unroll
                for (int bj = 0; bj < 2; ++bj) { const pg8::f32x4 v0 = acc[ai][bj][m][0], v1 = acc[ai][bj][m][1];
                    pg8::u32x4 w; w.x = pk2(v0[0], v0[1]); w.y = pk2(v0[2], v0[3]); w.z = pk2(v1[0], v1[1]); w.w = pk2(v1[2], v1[3]);
                    *(pg8::u32x4*)(rp + bj * 128) = w; } }
    }
};
template <int LAYER> struct EpiQKV {
    static constexpr bool PERM = true, AFTER_DRAIN = false;
    const float* SS; const float* qg; const float* kg; const float* rope1; const float* ropea; bf16* Q3; bf16* K3; bf16* V3;
    __device__ __forceinline__ void operator()(const pg8::f32x4 (&acc)[2][2][4][2], const pg8::Unit& u, int wr, int wc, int fr, int fq) const {
        int kind, hd, grp;
        bool axial;
        if (LAYER == 0) { const int t3 = u.pn % 3; grp = u.pn / 3; axial = (grp == 0);
            if (t3 < 2) { kind = 0; hd = 4 * t3 + wc; } else if (wc < 2) { kind = 1; hd = wc; } else { kind = 2; hd = wc - 2; } }
        else { const int t3 = u.pn % 3; grp = u.pn / 3; axial = false;
            if (t3 < 2) { kind = 0; hd = 4 * t3 + wc; } else if (wc < 2) { kind = 1; hd = wc; } else { kind = 2; hd = wc - 2; } }
        const bool norm = axial && kind < 2, rope = kind < 2;
        float ga[8], gb[8];
        if (norm) { const float* g = (kind == 0) ? qg : kg;
#pragma unroll
            for (int t = 0; t < 8; ++t) { const int j = 8 * fq + t; const int d0 = (j < 16) ? j : j + 16; ga[t] = g[d0]; gb[t] = g[d0 + 16]; } }
        else {
#pragma unroll
            for (int t = 0; t < 8; ++t) { ga[t] = 1.f; gb[t] = 1.f; } }
        const float qs = (kind == 0) ? ATT_C2 : 1.f;
        const float* rtab = axial ? ropea : rope1;
        bf16* dst; int pitch;
        if (kind == 0) { dst = Q3 + (size_t)grp * T * 512 + hd * 64; pitch = 512; } else if (kind == 1) { dst = K3 + (size_t)grp * T * 128 + hd * 64; pitch = 128; } else { dst = V3 + (size_t)grp * T * 128 + hd * 64; pitch = 128; }
        const int row0 = u.pm * 256 + wr * 64 + fr;
#pragma unroll
        for (int ai = 0; ai < 2; ++ai)
#pragma unroll
            for (int m = 0; m < 4; ++m) {
                const int r = row0 + ai * 128 + m * 16; const int pos = r & (SEQ - 1);
                const float rs = 1.f / sqrtf(ssp_sum(SS + (size_t)r * 16) * (1.f / D) + NORM_EPS);
                float a[8], b[8];
#pragma unroll
                for (int n = 0; n < 2; ++n)
#pragma unroll
                    for (int i = 0; i < 4; ++i) { a[4 * n + i] = acc[ai][0][m][n][i] * rs; b[4 * n + i] = acc[ai][1][m][n][i] * rs; }
                if (norm) { float ss = 0.f;
#pragma unroll
                    for (int t = 0; t < 8; ++t) ss += a[t] * a[t] + b[t] * b[t];
                    ss += __shfl_xor(ss, 16); ss += __shfl_xor(ss, 32);
                    const float rh = 1.f / sqrtf(ss * (1.f / 64.f) + NORM_EPS);
#pragma unroll
                    for (int t = 0; t < 8; ++t) { a[t] *= rh * ga[t]; b[t] *= rh * gb[t]; } }
                if (rope) { const f32x4* cs = (const f32x4*)(rtab + ((size_t)pos * 32 + 8 * fq) * 2);
#pragma unroll
                    for (int t2 = 0; t2 < 4; ++t2) { const f32x4 v = cs[t2];
                        { const float x1 = a[2 * t2], x2 = b[2 * t2]; a[2 * t2] = x1 * v.x - x2 * v.y; b[2 * t2] = x2 * v.x + x1 * v.y; }
                        { const float x1 = a[2 * t2 + 1], x2 = b[2 * t2 + 1]; a[2 * t2 + 1] = x1 * v.z - x2 * v.w; b[2 * t2 + 1] = x2 * v.z + x1 * v.w; } } }
                size_t drow = r;
                if (LAYER == 1) { const int sh = 2 * grp, bb = r >> 13; drow = (size_t)bb * SEQ + (size_t)(pos & ((1 << sh) - 1)) * (SEQ >> sh) + (pos >> sh); }
                bf16* dp = dst + drow * pitch + 8 * fq;
                pg8::u32x4 w0, w1;
                w0.x = pk2(a[0] * qs, a[1] * qs); w0.y = pk2(a[2] * qs, a[3] * qs); w0.z = pk2(a[4] * qs, a[5] * qs); w0.w = pk2(a[6] * qs, a[7] * qs);
                w1.x = pk2(b[0] * qs, b[1] * qs); w1.y = pk2(b[2] * qs, b[3] * qs); w1.z = pk2(b[4] * qs, b[5] * qs); w1.w = pk2(b[6] * qs, b[7] * qs);
                *(pg8::u32x4*)dp = w0; *(pg8::u32x4*)(dp + 32) = w1;
                asm volatile("" ::: "memory");
            }
    }
};
struct EpiResBf16 {
    static constexpr bool PERM = true, AFTER_DRAIN = false;
    const bf16* R; bf16* O;
    __device__ __forceinline__ void operator()(const pg8::f32x4 (&acc)[2][2][4][2], const pg8::Unit& u, int wr, int wc, int fr, int fq) const {
        const int row0 = u.pm * 256 + wr * 64 + fr, col0 = u.pn * 256 + wc * 32 + 8 * fq;
#pragma unroll
        for (int ai = 0; ai < 2; ++ai)
#pragma unroll
            for (int m = 0; m < 4; ++m) { const size_t ro = (size_t)(row0 + ai * 128 + m * 16) * D + col0;
#pragma unroll
                for (int bj = 0; bj < 2; ++bj) { const pg8::f32x4 v0 = acc[ai][bj][m][0], v1 = acc[ai][bj][m][1]; const v4u rr = *(const v4u*)(R + ro + bj * 128);
                    pg8::u32x4 w; w.x = pk2(v0[0] + bflo(rr.x), v0[1] + bfhi(rr.x)); w.y = pk2(v0[2] + bflo(rr.y), v0[3] + bfhi(rr.y)); w.z = pk2(v1[0] + bflo(rr.z), v1[1] + bfhi(rr.z)); w.w = pk2(v1[2] + bflo(rr.w), v1[3] + bfhi(rr.w));
                    *(pg8::u32x4*)(O + ro + bj * 128) = w; }
                asm volatile("" ::: "memory"); }
    }
};
__device__ __forceinline__ float sigmoidf_(float x) { return 1.0f / (1.0f + __expf(-x)); }
__device__ __forceinline__ float swiglu1(float g, float l) {
    g = fminf(g, 7.0f); l = fminf(fmaxf(l, -7.0f), 7.0f);
    return g * sigmoidf_(1.702f * g) * (l + 1.0f);
}
struct EpiSwiglu {
    static constexpr bool PERM = true, AFTER_DRAIN = false;
    bf16* ACT; const float* bup; const float* rsl;
    __device__ __forceinline__ void operator()(const pg8::f32x4 (&acc)[2][2][4][2], const pg8::Unit& u, int wr, int wc, int fr, int fq) const {
        const int e = u.pn >> 3, j = u.pn & 7; const int row0 = u.pm * 256 + wr * 64 + fr, a0 = j * 128 + wc * 32 + 8 * fq;
        const float* bp = bup + (size_t)e * 2048 + 2 * a0; pg8::f32x4 b[4];
#pragma unroll
        for (int i = 0; i < 4; ++i) b[i] = *(const pg8::f32x4*)(bp + 4 * i);
#pragma unroll
        for (int ai = 0; ai < 2; ++ai)
#pragma unroll
            for (int m = 0; m < 4; ++m) { const int r = row0 + ai * 128 + m * 16; const float rs = rsl[r];
                const pg8::f32x4 g0 = acc[ai][0][m][0] * rs, g1 = acc[ai][0][m][1] * rs, l0 = acc[ai][1][m][0] * rs, l1 = acc[ai][1][m][1] * rs;
                float o[8];
                o[0] = swiglu1(g0[0] + b[0][0], l0[0] + b[0][1]); o[1] = swiglu1(g0[1] + b[0][2], l0[1] + b[0][3]);
                o[2] = swiglu1(g0[2] + b[1][0], l0[2] + b[1][1]); o[3] = swiglu1(g0[3] + b[1][2], l0[3] + b[1][3]);
                o[4] = swiglu1(g1[0] + b[2][0], l1[0] + b[2][1]); o[5] = swiglu1(g1[1] + b[2][2], l1[1] + b[2][3]);
                o[6] = swiglu1(g1[2] + b[3][0], l1[2] + b[3][1]); o[7] = swiglu1(g1[3] + b[3][2], l1[3] + b[3][3]);
                pg8::u32x4 w; w.x = pk2(o[0], o[1]); w.y = pk2(o[2], o[3]); w.z = pk2(o[4], o[5]); w.w = pk2(o[6], o[7]);
                *(pg8::u32x4*)(ACT + (size_t)r * DE + a0) = w; }
    }
};
struct EpiDown {
    static constexpr bool PERM = true, AFTER_DRAIN = false;
    bf16* Y; const float* bdn; const float* gate;
    __device__ __forceinline__ void operator()(const pg8::f32x4 (&acc)[2][2][4][2], const pg8::Unit& u, int wr, int wc, int fr, int fq) const {
        const int e = u.pn >> 2, j = u.pn & 3; const int row0 = u.pm * 256 + wr * 64 + fr, col0 = j * 256 + wc * 32 + 8 * fq;
        pg8::f32x4 bv[2][2];
#pragma unroll
        for (int bj = 0; bj < 2; ++bj)
#pragma unroll
            for (int n = 0; n < 2; ++n) bv[bj][n] = *(const pg8::f32x4*)(bdn + (size_t)e * D + col0 + bj * 128 + 4 * n);
#pragma unroll
        for (int ai = 0; ai < 2; ++ai)
#pragma unroll
            for (int m = 0; m < 4; ++m) { const int r = row0 + ai * 128 + m * 16; const float gt = gate[r];
#pragma unroll
                for (int bj = 0; bj < 2; ++bj) { const pg8::f32x4 v0 = (acc[ai][bj][m][0] + bv[bj][0]) * gt, v1 = (acc[ai][bj][m][1] + bv[bj][1]) * gt;
                    pg8::u32x4 w; w.x = pk2(v0[0], v0[1]); w.y = pk2(v0[2], v0[3]); w.z = pk2(v1[0], v1[1]); w.w = pk2(v1[2], v1[3]);
                    *(pg8::u32x4*)(Y + (size_t)r * D + col0 + bj * 128) = w; } }
    }
};
struct EpiPle {
    static constexpr bool PERM = true, AFTER_DRAIN = false;
    const bf16* H2; const bf16* PP; bf16* H3; float* SS;
    __device__ __forceinline__ void operator()(const pg8::f32x4 (&acc)[2][2][4][2], const pg8::Unit& u, int wr, int wc, int fr, int fq) const {
        const int row0 = u.pm * 256 + wr * 64 + fr, col0 = u.pn * 256 + wc * 32 + 8 * fq;
#pragma unroll
        for (int ai = 0; ai < 2; ++ai)
#pragma unroll
            for (int m = 0; m < 4; ++m) { const int r = row0 + ai * 128 + m * 16; const size_t ro = (size_t)r * D + col0; float ss = 0.f;
#pragma unroll
                for (int bj = 0; bj < 2; ++bj) { const pg8::f32x4 a0 = acc[ai][bj][m][0], a1 = acc[ai][bj][m][1]; const v4u h = *(const v4u*)(H2 + ro + bj * 128), p = *(const v4u*)(PP + ro + bj * 128);
                    pg8::u32x4 w;
                    w.x = pk2(bflo(h.x) + bflo(p.x) * sigmoidf_(a0[0]), bfhi(h.x) + bfhi(p.x) * sigmoidf_(a0[1])); w.y = pk2(bflo(h.y) + bflo(p.y) * sigmoidf_(a0[2]), bfhi(h.y) + bfhi(p.y) * sigmoidf_(a0[3]));
                    w.z = pk2(bflo(h.z) + bflo(p.z) * sigmoidf_(a1[0]), bfhi(h.z) + bfhi(p.z) * sigmoidf_(a1[1])); w.w = pk2(bflo(h.w) + bflo(p.w) * sigmoidf_(a1[2]), bfhi(h.w) + bfhi(p.w) * sigmoidf_(a1[3]));
                    *(pg8::u32x4*)(H3 + ro + bj * 128) = w;
                    ss += (bflo(w.x) * bflo(w.x) + bfhi(w.x) * bfhi(w.x)) + (bflo(w.y) * bflo(w.y) + bfhi(w.y) * bfhi(w.y)) + (bflo(w.z) * bflo(w.z) + bfhi(w.z) * bfhi(w.z)) + (bflo(w.w) * bflo(w.w) + bfhi(w.w) * bfhi(w.w)); }
                ss += __shfl_xor(ss, 16); ss += __shfl_xor(ss, 32);
                if (fq == 0) SS[(size_t)r * 16 + u.pn * 4 + wc] = ss;
                asm volatile("" ::: "memory"); }
    }
};
template <int LJ> struct XcdOrder {
    const int* tab; int rank, stride;
    __device__ __forceinline__ bool next(int i, pg8::Unit& u) const {
        const int q = i * stride + rank, p = q >> LJ, j = q & ((1 << LJ) - 1); const int ne = tab[0], tot = tab[1]; if (p >= tot) return false;
        int s = 0; while (s + 1 < ne && tab[4 + 4 * (s + 1) + 3] <= p) ++s;
        u.pm = tab[4 + 4 * s + 1] + (p - tab[4 + 4 * s + 3]); u.pn = (tab[4 + 4 * s] << LJ) + j; return true; }
    __device__ __forceinline__ void a_ready(const pg8::Unit&) const {}
    __device__ __forceinline__ void done(const pg8::Unit&) const {}
};
#include <hip/hip_bf16.h>
#include <cmath>
namespace attn_body {
using bf16=__hip_bfloat16;
using bf16x8=__attribute__((ext_vector_type(8)))short;
using s16x4=__attribute__((ext_vector_type(4)))short;
using f32x16=__attribute__((ext_vector_type(16)))float;
using u32x4=__attribute__((ext_vector_type(4)))unsigned;
constexpr int D=64,QP=512,KVP=128;
constexpr int NW=8,QBLK=32,QB=QBLK*NW,KVBLK=64;
constexpr int ATTN_UNIT_ROWS=QB;
__device__ __forceinline__ int crow(int r,int hi){return (r&3)+8*(r>>2)+4*hi;}
#define SBAR() __builtin_amdgcn_sched_barrier(0)
__device__ __forceinline__ void cmask(f32x16&p0,f32x16&p1,int jb,int qrel,int hi){
  const float NEG=-INFINITY; int kb=64*jb+4*hi;
  #pragma unroll
  for(int r=0;r<16;++r){int kv=kb+(r&3)+8*(r>>2); if(kv>qrel)p0[r]=NEG; if(kv+32>qrel)p1[r]=NEG;}
}

__device__ __forceinline__ void bmask(f32x16&p0,f32x16&p1,int t,int dqb,int W){
  const float NEG=-INFINITY; const int kb=64*t+dqb;
  #pragma unroll
  for(int r=0;r<16;++r){const int d=kb+(r&3)+8*(r>>2); if(d>W||d<-W)p0[r]=NEG; if(d+32>W||d+32<-W)p1[r]=NEG;}
}
constexpr int NSLOT=3, SLOTB=8192;
constexpr int LDS_K=0, LDS_V=NSLOT*SLOTB, LDS_WS=2*NSLOT*SLOTB, LDS_OST=LDS_WS+NW*64*4, LDS_BYTES=LDS_OST+NW*4096;
constexpr float C2=0.125f*1.4426950408889634f;
__device__ __forceinline__ void glds16(const void*gsrc,unsigned lds_dst){unsigned keep;
  asm volatile("s_mov_b32 %0, m0\n\ts_mov_b32 m0, %2\n\ts_nop 0\n\tglobal_load_lds_dwordx4 %1, off\n\ts_mov_b32 m0, %0":"=&s"(keep):"v"(gsrc),"s"(lds_dst):"memory");}
__device__ __forceinline__ float max3f(float a,float b,float c){float r;asm("v_max3_f32 %0, %1, %2, %3":"=v"(r):"v"(a),"v"(b),"v"(c));return r;}
__device__ __forceinline__ float max2f(float a,float b){float r;asm("v_max_f32_e32 %0, %1, %2":"=v"(r):"v"(a),"v"(b));return r;}
__device__ __forceinline__ float fadd_s(float a,float b){float r;asm("v_add_f32_e32 %0, %1, %2":"=v"(r):"v"(a),"v"(b));return r;}
__device__ __forceinline__ float fsub_s(float a,float b){float r;asm("v_sub_f32_e32 %0, %1, %2":"=v"(r):"v"(a),"v"(b));return r;}
typedef float f32x2_t __attribute__((ext_vector_type(2))); typedef __bf16 bf16x2_t __attribute__((ext_vector_type(2)));
__device__ __forceinline__ unsigned cvtpk_s(float lo,float hi){f32x2_t v={lo,hi};bf16x2_t b=__builtin_convertvector(v,bf16x2_t);return __builtin_bit_cast(unsigned,b);}
#define WAIT_BAR(N) asm volatile("s_waitcnt vmcnt(" #N ") lgkmcnt(0)\n\ts_barrier":::"memory")

__device__ __forceinline__ void qkt(f32x16&p0,f32x16&p1,const char*Kslot,const bf16x8*qr,const f32x16&negm,int r32,int hi){
  const char*kb=Kslot+hi*1024+r32*16;
  #pragma unroll
  for(int d0=0;d0<4;++d0){
    const bf16x8 b0=*reinterpret_cast<const bf16x8*>(kb+d0*2048);
    const bf16x8 b1=*reinterpret_cast<const bf16x8*>(kb+d0*2048+512);
    if(d0==0){p0=__builtin_amdgcn_mfma_f32_32x32x16_bf16(b0,qr[0],negm,0,0,0);p1=__builtin_amdgcn_mfma_f32_32x32x16_bf16(b1,qr[0],negm,0,0,0);}
    else{p0=__builtin_amdgcn_mfma_f32_32x32x16_bf16(b0,qr[d0],p0,0,0,0);p1=__builtin_amdgcn_mfma_f32_32x32x16_bf16(b1,qr[d0],p1,0,0,0);}}
}
typedef __attribute__((address_space(3))) const char* lds_cptr;
typedef short v4i16_t __attribute__((ext_vector_type(4)));
__device__ __forceinline__ void kload8(bf16x8*kf,lds_cptr kp){
  kf[0]=*(const __attribute__((address_space(3))) bf16x8*)(kp);      kf[1]=*(const __attribute__((address_space(3))) bf16x8*)(kp+512);
  kf[2]=*(const __attribute__((address_space(3))) bf16x8*)(kp+2048); kf[3]=*(const __attribute__((address_space(3))) bf16x8*)(kp+2560);
  kf[4]=*(const __attribute__((address_space(3))) bf16x8*)(kp+4096); kf[5]=*(const __attribute__((address_space(3))) bf16x8*)(kp+4608);
  kf[6]=*(const __attribute__((address_space(3))) bf16x8*)(kp+6144); kf[7]=*(const __attribute__((address_space(3))) bf16x8*)(kp+6656);
}
__device__ __forceinline__ void kload2(bf16x8*kf,lds_cptr kp,int j){ kf[2*j]=*(const __attribute__((address_space(3))) bf16x8*)(kp+j*2048); kf[2*j+1]=*(const __attribute__((address_space(3))) bf16x8*)(kp+j*2048+512); }
__device__ __forceinline__ s16x4 vtr(lds_cptr p){ return __builtin_bit_cast(s16x4,__builtin_amdgcn_ds_read_tr16_b64_v4i16((__attribute__((address_space(3))) v4i16_t*)p)); }
__device__ __forceinline__ float rowmax(const f32x16&p0,const f32x16&p1){
  float a=max3f(p0[0],p0[1],p1[0]),b=max3f(p0[2],p0[3],p1[1]);a=max3f(a,p1[2],p1[3]);
  #pragma unroll
  for(int r=4;r<16;r+=4){a=max3f(a,p0[r],p0[r+1]);b=max3f(b,p0[r+2],p0[r+3]);a=max3f(a,p1[r],p1[r+1]);b=max3f(b,p1[r+2],p1[r+3]);}
  const float m=max2f(a,b);
  auto rr=__builtin_amdgcn_permlane32_swap(__float_as_uint(m),__float_as_uint(m),false,false);
  return max2f(__uint_as_float(rr[0]),__uint_as_float(rr[1]));
}
__device__ __forceinline__ void pv(f32x16*o,int vb,bf16x8 pa0,bf16x8 pa1,bf16x8 pa2,bf16x8 pa3){
  #pragma unroll
  for(int d0=0;d0<2;++d0){s16x4 lo[4],hi[4];
    #pragma unroll
    for(int ks=0;ks<4;++ks){
      asm volatile("ds_read_b64_tr_b16 %0,%1 offset:%c2":"=&v"(lo[ks]):"v"(vb),"i"(d0*4096+ks*1024):"memory");
      asm volatile("ds_read_b64_tr_b16 %0,%1 offset:%c2":"=&v"(hi[ks]):"v"(vb),"i"(d0*4096+ks*1024+512):"memory");}
    asm volatile("s_waitcnt lgkmcnt(0)":::"memory");SBAR();
    #define PK(k) (bf16x8){lo[k][0],lo[k][1],lo[k][2],lo[k][3],hi[k][0],hi[k][1],hi[k][2],hi[k][3]}
    o[d0]=__builtin_amdgcn_mfma_f32_32x32x16_bf16(pa0,PK(0),o[d0],0,0,0);
    o[d0]=__builtin_amdgcn_mfma_f32_32x32x16_bf16(pa1,PK(1),o[d0],0,0,0);
    o[d0]=__builtin_amdgcn_mfma_f32_32x32x16_bf16(pa2,PK(2),o[d0],0,0,0);
    o[d0]=__builtin_amdgcn_mfma_f32_32x32x16_bf16(pa3,PK(3),o[d0],0,0,0);
    #undef PK
  }
}

#ifndef ATTN_STORE16
#define ATTN_STORE16(p,v) (*(u32x4*)(p)=(v))
#endif
template<int MODE,int OP,int THRL> __device__ __forceinline__ void attn_unit(const bf16*Qu,const bf16*__restrict__ Ku,const bf16*__restrict__ Vu,bf16*Ou,int NT,int dq0,int W,float sinkl2,bool has_sink,float*lse,char*shm){
  int tid_=threadIdx.x; asm volatile("":"+v"(tid_));
  const int tid=tid_,lane=tid&63,r32=lane&31,hi=lane>>5; const int wid=__builtin_amdgcn_readfirstlane(tid>>6);
  const bf16*Qw=Qu+(long)(wid*QBLK)*QP;
  const unsigned lds0=(unsigned)(uintptr_t)shm;
  float*wsf=(float*)(shm+LDS_WS)+wid*64;
  const bf16*ksrc=Ku+(long)lane*KVP+wid*8;
  const bf16*vsrc=Vu+(long)(16*(wid&3)+(lane>>2))*KVP+(wid>>2)*32+(lane&3)*8;
  const unsigned kdst=lds0+LDS_K+wid*1024, vdst=lds0+LDS_V+wid*1024;
  #define DMA_K(t,slot) glds16(ksrc+(long)(t)*KVBLK*KVP,(unsigned)__builtin_amdgcn_readfirstlane(kdst+(slot)))
  #define DMA_V(t,slot) glds16(vsrc+(long)(t)*KVBLK*KVP,(unsigned)__builtin_amdgcn_readfirstlane(vdst+(slot)))
  const int vb0=(int)(lds0+LDS_V)+((lane>>4)&1)*32+(lane&3)*8+(4*hi+((lane&15)>>2))*64;
  const char*Kbase=shm+LDS_K; bf16x8 kf[8];
  const lds_cptr shm3=(lds_cptr)shm; const lds_cptr kp0=shm3+LDS_K+hi*1024+r32*16; const lds_cptr vp0=shm3+LDS_V+((lane>>4)&1)*32+(lane&3)*8+(4*hi+((lane&15)>>2))*64;
  DMA_K(0,0);DMA_V(0,0);DMA_K(1,SLOTB);
  bf16x8 qr[4];
  #pragma unroll
  for(int d0=0;d0<4;++d0)qr[d0]=*reinterpret_cast<const bf16x8*>(&Qw[(long)r32*QP+d0*16+hi*8]);
  float mhat=0.f,l_reg=0.f;f32x16 o[2];o[0]=f32x16{};o[1]=f32x16{};f32x16 negm=f32x16{};asm volatile("":"+v"(negm));
  const int dqb=dq0-(wid*QBLK+r32)+4*hi;
  #define CMASK(P0,P1,t) do{ if(MODE==1) bmask(P0,P1,(t),dqb,W); }while(0)
  bool resc=false;
  #define START(P0,P1) do{ float rm=rowmax(P0,P1); if(MODE==1) rm=fmaxf(rm,-60.f); resc=false; \
    { const float dl=rm; mhat=fadd_s(mhat,dl); \
      _Pragma("unroll") for(int r=0;r<16;++r){P0[r]=fsub_s(P0[r],dl);P1[r]=fsub_s(P1[r],dl);} \
      _Pragma("unroll") for(int r=0;r<16;++r)negm[r]=-mhat; asm volatile("":"+v"(negm)); } \
    _Pragma("unroll") for(int r=0;r<16;++r)P0[r]=__builtin_amdgcn_exp2f(P0[r]); }while(0)
  #define RESC() do{ if(resc){ asm volatile("s_waitcnt lgkmcnt(0)":::"memory"); \
      _Pragma("unroll") for(int d_=0;d_<2;++d_) _Pragma("unroll") for(int r=0;r<16;++r)o[d_][r]*=wsf[crow(r,hi)]; } }while(0)
  f32x16 pA0,pA1,pB0,pB1;
  int sl_prev=0,sl_cur=0,sl_next=SLOTB;
  #define ROT() do{sl_prev=sl_cur;sl_cur=sl_next;sl_next=(sl_next==(NSLOT-1)*SLOTB)?0:sl_next+SLOTB;}while(0)
  DMA_K(2,2*SLOTB);
  WAIT_BAR(3);
  qkt(pA0,pA1,Kbase,qr,negm,r32,hi);asm volatile("s_nop 15\n\ts_nop 7":"+v"(pA0),"+v"(pA1));CMASK(pA0,pA1,0);
  START(pA0,pA1);
  _Pragma("unroll") for(int r=0;r<16;++r)pA1[r]=__builtin_amdgcn_exp2f(pA1[r]);
  WAIT_BAR(0);
  DMA_K(3,0);DMA_V(1,SLOTB);
  ROT();
  kload8(kf,kp0+sl_cur);
  WAIT_BAR(2);
  s16x4 vlo[8],vhi[8]; u32x4 pw0,pw1,pw2,pw3;
  #define PKW(P,B) cvtpk_s(P[B],P[B+1])
  #define PAF(k) __builtin_bit_cast(bf16x8,pw##k)
  #define VFR(i) (bf16x8){vlo[i][0],vlo[i][1],vlo[i][2],vlo[i][3],vhi[i][0],vhi[i][1],vhi[i][2],vhi[i][3]}
  #define PIN(x) asm volatile("":"+v"(x))
  #define MX3(a,b,c) __builtin_fmaxf(__builtin_fmaxf((a),(b)),(c))
  #define GAPA(MF,A0,A1,A2,A3,W0,W1,PW) do{ MF; sacc+=A0; sacc+=A1; sacc+=A2; sacc+=A3; PIN(sacc); W0; W1; PIN(PW); SBAR(); }while(0)
  #define EX(v) __builtin_amdgcn_exp2f(v)
  #define GAPB(MF,X,B) do{ MF; X[B]=EX(X[B]); X[B+1]=EX(X[B+1]); X[B+2]=EX(X[B+2]); X[B+3]=EX(X[B+3]); PIN(X); SBAR(); }while(0)
  #define VRD(i) do{ vlo[i]=vtr(vp_+(((i)>>2)*4096+((i)&3)*1024)); vhi[i]=vtr(vp_+(((i)>>2)*4096+((i)&3)*1024+512)); }while(0)
  #define KRD(G,j) do{ if(G){ kload2(kf,kp0+sl_next,j); SBAR(); } }while(0)
  #define STEP(C0,C1,P0,P1,t,GK,GV,GL) do{ SBAR(); \
    const lds_cptr vp_=vp0+sl_prev; \
    VRD(0); SBAR(); float sacc=(P0[0]+P0[1]); \
    GAPA(C0=__builtin_amdgcn_mfma_f32_32x32x16_bf16(kf[0],qr[0],negm,0,0,0), P0[2],P0[3],P0[4],P0[5],     pw0[0]=PKW(P0,0), pw0[1]=PKW(P0,2), pw0); \
    VRD(4); SBAR(); GAPA(C1=__builtin_amdgcn_mfma_f32_32x32x16_bf16(kf[1],qr[0],negm,0,0,0), P0[6],P0[7],P0[8],P0[9],     pw0[2]=PKW(P0,4), pw0[3]=PKW(P0,6), pw0); \
    VRD(1); SBAR(); GAPA(C0=__builtin_amdgcn_mfma_f32_32x32x16_bf16(kf[2],qr[1],C0,0,0,0),   P0[10],P0[11],P0[12],P0[13], pw1[0]=PKW(P0,8), pw1[1]=PKW(P0,10), pw1); \
    VRD(5); SBAR(); GAPA(C1=__builtin_amdgcn_mfma_f32_32x32x16_bf16(kf[3],qr[1],C1,0,0,0),   P0[14],P0[15],P1[0],P1[1],   pw1[2]=PKW(P0,12),pw1[3]=PKW(P0,14), pw1); \
    VRD(2); SBAR(); GAPA(C0=__builtin_amdgcn_mfma_f32_32x32x16_bf16(kf[4],qr[2],C0,0,0,0),   P1[2],P1[3],P1[4],P1[5],     pw2[0]=PKW(P1,0), pw2[1]=PKW(P1,2), pw2); \
    VRD(6); SBAR(); GAPA(C1=__builtin_amdgcn_mfma_f32_32x32x16_bf16(kf[5],qr[2],C1,0,0,0),   P1[6],P1[7],P1[8],P1[9],     pw2[2]=PKW(P1,4), pw2[3]=PKW(P1,6), pw2); \
    VRD(3); SBAR(); GAPA(C0=__builtin_amdgcn_mfma_f32_32x32x16_bf16(kf[6],qr[3],C0,0,0,0),   P1[10],P1[11],P1[12],P1[13], pw3[0]=PKW(P1,8), pw3[1]=PKW(P1,10), pw3); \
    VRD(7); SBAR(); GAPA(C1=__builtin_amdgcn_mfma_f32_32x32x16_bf16(kf[7],qr[3],C1,0,0,0),   P1[14],P1[15],0.f,0.f,       pw3[2]=PKW(P1,12),pw3[3]=PKW(P1,14), pw3); \
    l_reg+=sacc; \
    if(GK){DMA_K((t)+3,sl_cur);} if(GV){DMA_V((t)+1,sl_next);} \
    CMASK(C0,C1,t); \
    { float a=MX3(C0[0],C0[1],C1[0]),b=MX3(C0[2],C0[3],C1[1]); a=MX3(a,C1[2],C1[3]); \
      _Pragma("unroll") for(int r=4;r<16;r+=4){a=MX3(a,C0[r],C0[r+1]);b=MX3(b,C0[r+2],C0[r+3]);a=MX3(a,C1[r],C1[r+1]);b=MX3(b,C1[r+2],C1[r+3]);} \
      float rm=__builtin_fmaxf(a,b); { auto rr=__builtin_amdgcn_permlane32_swap(__float_as_uint(rm),__float_as_uint(rm),false,false); rm=__builtin_fmaxf(__uint_as_float(rr[0]),__uint_as_float(rr[1])); } \
      resc=false; \
      if(__builtin_expect(__any(rm>(float)THRL),0)){ const float dl=__builtin_fmaxf(rm,0.f); mhat+=dl; \
        _Pragma("unroll") for(int r=0;r<16;++r){C0[r]-=dl;C1[r]-=dl;} \
        _Pragma("unroll") for(int r=0;r<16;++r)negm[r]=-mhat; asm volatile("":"+v"(negm)); \
        const float f=__builtin_amdgcn_exp2f(-dl); l_reg*=f; if(hi==0)wsf[r32]=f; resc=true; } } \
    SBAR(); \
    GAPB(o[0]=__builtin_amdgcn_mfma_f32_32x32x16_bf16(PAF(0),VFR(0),o[0],0,0,0), C0,0); \
    GAPB(o[1]=__builtin_amdgcn_mfma_f32_32x32x16_bf16(PAF(0),VFR(4),o[1],0,0,0), C0,4); \
    KRD(GL,0); GAPB(o[0]=__builtin_amdgcn_mfma_f32_32x32x16_bf16(PAF(1),VFR(1),o[0],0,0,0), C0,8); \
    KRD(GL,1); GAPB(o[1]=__builtin_amdgcn_mfma_f32_32x32x16_bf16(PAF(1),VFR(5),o[1],0,0,0), C0,12); \
    KRD(GL,2); GAPB(o[0]=__builtin_amdgcn_mfma_f32_32x32x16_bf16(PAF(2),VFR(2),o[0],0,0,0), C1,0); \
    KRD(GL,3); GAPB(o[1]=__builtin_amdgcn_mfma_f32_32x32x16_bf16(PAF(2),VFR(6),o[1],0,0,0), C1,4); \
    GAPB(o[0]=__builtin_amdgcn_mfma_f32_32x32x16_bf16(PAF(3),VFR(3),o[0],0,0,0), C1,8); \
    GAPB(o[1]=__builtin_amdgcn_mfma_f32_32x32x16_bf16(PAF(3),VFR(7),o[1],0,0,0), C1,12); \
    }while(0)
  int t=1;
  for(;t+5<NT;t+=2){
    STEP(pB0,pB1,pA0,pA1,t,true,true,true);     WAIT_BAR(2); RESC(); ROT();
    STEP(pA0,pA1,pB0,pB1,t+1,true,true,true);   WAIT_BAR(2); RESC(); ROT();
  }
  #define ENDW(tt) do{ if((tt)+3<NT){WAIT_BAR(2);} else if((tt)+2<NT){WAIT_BAR(1);} else {WAIT_BAR(0);} }while(0)
  for(;t+1<NT;t+=2){
    STEP(pB0,pB1,pA0,pA1,t,(t+3<NT),(t+1<NT),(t+1<NT));       ENDW(t);   RESC(); ROT();
    STEP(pA0,pA1,pB0,pB1,t+1,(t+4<NT),(t+2<NT),(t+2<NT));     ENDW(t+1); RESC(); ROT();
  }
  STEP(pB0,pB1,pA0,pA1,NT-1,false,false,false); RESC();
  { float sacc=pB0[0]+pB0[1]; _Pragma("unroll") for(int r=2;r<16;++r)sacc+=pB0[r]; _Pragma("unroll") for(int r=0;r<16;++r)sacc+=pB1[r]; l_reg+=sacc;
    pw0=(u32x4){PKW(pB0,0),PKW(pB0,2),PKW(pB0,4),PKW(pB0,6)};pw1=(u32x4){PKW(pB0,8),PKW(pB0,10),PKW(pB0,12),PKW(pB0,14)};pw2=(u32x4){PKW(pB1,0),PKW(pB1,2),PKW(pB1,4),PKW(pB1,6)};pw3=(u32x4){PKW(pB1,8),PKW(pB1,10),PKW(pB1,12),PKW(pB1,14)};
    SBAR(); pv(o,vb0+sl_cur,PAF(0),PAF(1),PAF(2),PAF(3)); }
  #undef PKW
  #undef PAF
  #undef VFR
  #undef PIN
  #undef MX3
  #undef GAPA
  #undef GAPB
  #undef EX
  #undef VRD
  #undef KRD
  #undef STEP
  #undef ENDW
  {auto rr=__builtin_amdgcn_permlane32_swap(__float_as_uint(l_reg),__float_as_uint(l_reg),false,false);l_reg=__uint_as_float(rr[0])+__uint_as_float(rr[1]);}
  if(MODE==1){ if(has_sink) l_reg+=__builtin_amdgcn_exp2f(sinkl2-mhat); if(lse!=nullptr&&hi==0) lse[(long)(wid*QBLK+r32)*8]=0.6931471805599453f*(mhat+__builtin_amdgcn_logf(l_reg)); }
  if(hi==0)wsf[32+r32]=l_reg;asm volatile("s_waitcnt lgkmcnt(0)":::"memory");
  float rli[16];
  #pragma unroll
  for(int r=0;r<16;++r)rli[r]=__builtin_amdgcn_rcpf(wsf[32+crow(r,hi)]);
  bf16*Ow=Ou+(long)(wid*QBLK)*OP;
  { bf16*stg=(bf16*)(shm+LDS_OST)+wid*2048;
    #pragma unroll
    for(int r=0;r<16;++r){const int orow=crow(r,hi);
      #pragma unroll
      for(int d0=0;d0<2;++d0)stg[orow*64+d0*32+r32]=__float2bfloat16(o[d0][r]*rli[r]);}
    asm volatile("s_waitcnt lgkmcnt(0)":::"memory");
    #pragma unroll
    for(int i=0;i<4;++i){const int row=i*8+(lane>>3),ch=lane&7; const u32x4 v=*(const u32x4*)(stg+row*64+ch*8); ATTN_STORE16(Ow+(long)row*OP+ch*8,v);} }
  asm volatile("s_waitcnt lgkmcnt(0)\n\ts_barrier":::"memory");
  #undef DMA_K
  #undef DMA_V
  #undef CMASK
  #undef START
  #undef RESC
  #undef ROT
}
constexpr int ATTN_LDS_BYTES=LDS_BYTES;
#undef SBAR
#undef WAIT_BAR
}
#define XB_TMO      128
#define XB_XCNT(j)  (256  + 64 * (j))
#define XB_XSUB(j)  (1280 + 64 * (j))
#define XB_XGEN(j)  (2304 + 64 * (j))
#define XB_TOP      3328
#define XB_TOPGEN   3392
#define XCD_BAR_WORDS 3456
#define XB_SPIN_CAP (1u << 18)

__device__ __forceinline__ unsigned xb_ld(unsigned* p)              { return __hip_atomic_load(p, __ATOMIC_RELAXED, __HIP_MEMORY_SCOPE_AGENT); }
__device__ __forceinline__ unsigned xb_add(unsigned* p, unsigned v) { return __hip_atomic_fetch_add(p, v, __ATOMIC_RELAXED, __HIP_MEMORY_SCOPE_AGENT); }
__device__ __forceinline__ unsigned xb_xcc_id() { return (unsigned)__builtin_amdgcn_s_getreg((3 << 11) | 20) & 0xFu; }
#define XB_SPIN(cond, bar) do { unsigned _sp = 0; while (cond) { __builtin_amdgcn_s_sleep(1); \
    if ((++_sp & 255u) == 0u) { if (xb_ld(&(bar)[XB_TMO])) break; if (_sp > XB_SPIN_CAP) { atomicAdd(&(bar)[XB_TMO], 1u); break; } } } } while (0)

struct XcdBarrier {
    unsigned* bar; unsigned x;
    volatile LAS unsigned* st;
};

__device__ __forceinline__ XcdBarrier xcd_barrier_post(unsigned* bar, volatile LAS unsigned* st) {
    XcdBarrier b; b.bar = bar; b.x = xb_xcc_id(); b.st = st;
    if (threadIdx.x == 0) (void)xb_add(&bar[XB_XCNT(b.x)], 1u);
    return b;
}
__device__ __forceinline__ void xcd_barrier_complete(unsigned* bar, unsigned x, unsigned& nloc, unsigned& nx) {
    const unsigned G = gridDim.x * gridDim.y * gridDim.z;
    unsigned sum, cnt, mine, sp = 0u;
    for (;;) {
        sum = 0u; cnt = 0u; mine = 0u;
#pragma unroll
        for (unsigned j = 0; j < 16; ++j) { const unsigned c = xb_ld(&bar[XB_XCNT(j)]); sum += c; cnt += (c > 0u) ? 1u : 0u; mine = (j == x) ? c : mine; }
        if (sum == G) break;
        __builtin_amdgcn_s_sleep(1);
        if ((++sp & 255u) == 0u) { if (xb_ld(&bar[XB_TMO])) break; if (sp > XB_SPIN_CAP) { atomicAdd(&bar[XB_TMO], 1u); break; } }
    }
    nloc = mine > 0u ? mine : 1u; nx = cnt > 0u ? cnt : 1u;
}

__device__ __forceinline__ void xcd_barrier(const XcdBarrier& b) {
    asm volatile("s_waitcnt vmcnt(0)" ::: "memory");
    __syncthreads();
    if (threadIdx.x == 0) {
        unsigned* bar = b.bar;
        __builtin_amdgcn_s_waitcnt(0);
        unsigned nloc = b.st[0], nx = b.st[1];
        if (nloc == 0u) { xcd_barrier_complete(bar, b.x, nloc, nx); b.st[0] = nloc; b.st[1] = nx; }
        const unsigned old = xb_add(&bar[XB_XSUB(b.x)], 1u);
        const unsigned gen = old / nloc;
        if (old + 1u == (gen + 1u) * nloc) {
            __builtin_amdgcn_fence(__ATOMIC_RELEASE, "agent");
            asm volatile("s_waitcnt vmcnt(0)" ::: "memory");
            const unsigned og = xb_add(&bar[XB_TOP], 1u);
            const unsigned tg = og / nx;
            if (og + 1u == (tg + 1u) * nx) xb_add(&bar[XB_TOPGEN], 1u);
            else XB_SPIN(xb_ld(&bar[XB_TOPGEN]) == tg, bar);
            __builtin_amdgcn_fence(__ATOMIC_ACQUIRE, "agent");
            xb_add(&bar[XB_XGEN(b.x)], 1u);
            asm volatile("s_waitcnt vmcnt(0)" ::: "memory");
        } else {
            XB_SPIN(xb_ld(&bar[XB_XGEN(b.x)]) == gen, bar);
            __builtin_amdgcn_fence(__ATOMIC_ACQUIRE, "agent");
            asm volatile("s_waitcnt vmcnt(0)" ::: "memory");
        }
    }
    __syncthreads();
}

struct Frame {
    LAS unsigned char* lds;
    volatile LAS unsigned* MISC;
    gu32* ctl;
    int tid, lane, wave, vcu, G, bx;
    int gw, NGW;
};
__device__ __forceinline__ bool refresh(Frame& F) {
    int t = threadIdx.x; asm volatile("" : "+v"(t)); F.tid = t; F.lane = t & 63; F.wave = __builtin_amdgcn_readfirstlane(t >> 6);
    int bx = blockIdx.x, G = gridDim.x; asm volatile("" : "+s"(bx), "+s"(G)); F.bx = bx; F.G = G;
    F.vcu = (G % 8 == 0) ? (bx % 8) * (G / 8) + bx / 8 : bx; F.gw = F.vcu * NWAVES + F.wave; F.NGW = G * NWAVES; return true; }
__device__ __forceinline__ float wave_sum(float v) {
#pragma unroll
    for (int o = 1; o < 64; o <<= 1) v += __shfl_xor(v, o);
    return v;
}
template <int MAP> __device__ __forceinline__ int rowmap(int n) {
    if (MAP == 1) { const int f = n >> 1; return 256 * (f >> 7) + 128 * (n & 1) + (f & 127); }
    if (MAP == 2 || MAP == 3) { const int tl = n >> 8, hh = (n >> 6) & 3, d = n & 63; int bj, j;
        const bool axial = (MAP == 2) && (tl < 2 || (tl == 2 && hh < 2));
        if (axial) { bj = (d >> 4) & 1; j = (d & 15) + ((d >> 5) << 4); } else { bj = d >> 5; j = d & 31; }
        return 256 * tl + 128 * bj + 32 * hh + j; }
    return n; }
struct TrTile { const float* W; bf16* WT; const float* gain; int K, N, k0, n0; };
__device__ __forceinline__ void tr_load(const TrTile& t, f32x4 (&v)[16], int lane) {
    const float* src = t.W + (size_t)(t.k0 + (lane >> 4)) * t.N + t.n0 + 4 * (lane & 15);
#pragma unroll
    for (int i = 0; i < 16; ++i) v[i] = *(const f32x4*)(src + (size_t)(4 * i) * t.N);
}
template <int MAP> __device__ __forceinline__ void tr_store(const TrTile& t, f32x4 (&v)[16], LAS float* scr, int lane) {
    const int lr = lane >> 4, lc = lane & 15;
    if (t.gain) {
#pragma unroll
        for (int i = 0; i < 16; ++i) v[i] *= t.gain[t.k0 + 4 * i + lr]; }
#pragma unroll
    for (int i = 0; i < 16; ++i) { LAS float* p = scr + (4 * i + lr) * 65 + 4 * lc; p[0] = v[i].x; p[1] = v[i].y; p[2] = v[i].z; p[3] = v[i].w; }
    LDS_WAIT(); asm volatile("" ::: "memory");
    const int c = lane & 7;
#pragma unroll
    for (int j = 0; j < 8; ++j) { const int n = 8 * j + (lane >> 3); const LAS float* s = scr + (8 * c) * 65 + n;
        v4u o; o.x = pk2(s[0 * 65], s[1 * 65]); o.y = pk2(s[2 * 65], s[3 * 65]); o.z = pk2(s[4 * 65], s[5 * 65]); o.w = pk2(s[6 * 65], s[7 * 65]);
        *(GAS v4u*)(t.WT + (size_t)rowmap<MAP>(t.n0 + n) * t.K + t.k0 + 8 * c) = o; }
    LDS_WAIT(); asm volatile("" ::: "memory");
}
template <int MAP> __device__ __forceinline__ void transpose_family(Frame& F, const float* W, size_t sW, bf16* WT, size_t sWT, const float* gain, int sG, int K, int N, int nmat, int gdiv) {
    LAS float* scr = (LAS float*)(F.lds + RING_OFF) + F.wave * (64 * 65);
    const int nb = N / 64, per = (K / 64) * nb, total = per * nmat;
    f32x4 va[16], vb[16];
    int it = F.gw; if (it >= total) return;
    TrTile ta, tb;
#define TR_SETUP(tt, item) do { const int mi = (item) / per, r = (item) % per; tt.W = W + (size_t)mi * sW; tt.WT = WT + (size_t)mi * sWT; tt.gain = gain ? gain + (size_t)(mi / gdiv) * sG : nullptr; tt.K = K; tt.N = N; tt.k0 = 64 * (r / nb); tt.n0 = 64 * (r % nb); } while (0)
    TR_SETUP(ta, it); tr_load(ta, va, F.lane);
    for (;;) {
        const int it2 = it + F.NGW; const bool h2 = it2 < total;
        if (h2) { TR_SETUP(tb, it2); tr_load(tb, vb, F.lane); }
        tr_store<MAP>(ta, va, scr, F.lane);
        if (!h2) break;
        const int it3 = it2 + F.NGW; const bool h3 = it3 < total;
        if (h3) { TR_SETUP(ta, it3); tr_load(ta, va, F.lane); }
        tr_store<MAP>(tb, vb, scr, F.lane);
        if (!h3) break;
        it = it3;
    }
#undef TR_SETUP
}
__device__ __forceinline__ float rope_freq(int i, int half_dim) { return exp2f(-(float)i / (float)half_dim * LOG2_THETA); }

__device__ __forceinline__ void attn_phase_l0(Frame& F, const bf16* Q3, const bf16* K3, const bf16* V3, bf16* OCAT, const float* sink) {
    char* shm = (char*)(F.lds + RING_OFF);
    const int upc = (512 + F.G - 1) / F.G;
    for (int i = 0; i < upc; ++i) { const int u = F.vcu * upc + i; if (u >= 512) break;
        const int bhk = u >> 7, b = bhk >> 1, hkv = bhk & 1, hq = hkv * 4 + ((u & 127) >> 5), qb = u & 31; const size_t r0 = (size_t)b * SEQ + qb * 256;
        attn_body::attn_unit<0, 1024, 8>((const attn_body::bf16*)(Q3 + r0 * 512 + hq * 64), (const attn_body::bf16*)(K3 + (size_t)b * SEQ * 128 + hkv * 64), (const attn_body::bf16*)(V3 + (size_t)b * SEQ * 128 + hkv * 64),
                                        (attn_body::bf16*)(OCAT + r0 * D + hq * 64), SEQ / 64, 0, 0, 0.f, false, nullptr, shm); }
    const bf16* Qb = Q3 + (size_t)T * 512; const bf16* Kb = K3 + (size_t)T * 128; const bf16* Vb = V3 + (size_t)T * 128;
    for (int i = 0; i < upc; ++i) { const int u = F.vcu * upc + i; if (u >= 512) break;
        const int bhk = u >> 7, b = bhk >> 1, hkv = bhk & 1, hq = hkv * 4 + ((u & 127) >> 5), qb = u & 31; const size_t r0 = (size_t)b * SEQ + qb * 256;
        const int tl = max(qb * 4 - 2, 0), th = min(qb * 4 + 6, SEQ / 64); const size_t k0 = (size_t)b * SEQ + tl * 64;
        attn_body::attn_unit<1, 1024, 8>((const attn_body::bf16*)(Qb + r0 * 512 + hq * 64), (const attn_body::bf16*)(Kb + k0 * 128 + hkv * 64), (const attn_body::bf16*)(Vb + k0 * 128 + hkv * 64),
                                        (attn_body::bf16*)(OCAT + r0 * D + 512 + hq * 64), th - tl, tl * 64 - qb * 256, 128, sink[hq] * 1.4426950408889634f, true, nullptr, shm); }
}
__device__ __forceinline__ void attn_phase_l1(Frame& F, const bf16* Q3, const bf16* K3, const bf16* V3, bf16* OGB, float* LSE) {
    char* shm = (char*)(F.lds + RING_OFF);
    const int upc = (512 + F.G - 1) / F.G;
#pragma unroll 1
    for (int g = 0; g < 3; ++g) { const int Lc = SEQ >> (2 * g);
        for (int i = 0; i < upc; ++i) { const int u = F.vcu * upc + i; if (u >= 512) break;
            const int bhk = u >> 7, b = bhk >> 1, hkv = bhk & 1, hq = hkv * 4 + ((u & 127) >> 5), qb = u & 31; const size_t r0 = (size_t)b * SEQ + qb * 256;
            const int q0 = qb * 256, cbase = q0 & ~(Lc - 1), lq0 = q0 & (Lc - 1); const int tl = min(max(lq0 / 64 - 1, 0), Lc / 64 - 6); const size_t k0 = (size_t)b * SEQ + cbase + tl * 64;
            attn_body::attn_unit<1, 512, 8>((const attn_body::bf16*)(Q3 + (size_t)g * T * 512 + r0 * 512 + hq * 64), (const attn_body::bf16*)(K3 + (size_t)g * T * 128 + k0 * 128 + hkv * 64), (const attn_body::bf16*)(V3 + (size_t)g * T * 128 + k0 * 128 + hkv * 64),
                                           (attn_body::bf16*)(OGB + (size_t)g * T * 512 + r0 * 512 + hq * 64), 6, cbase + tl * 64 - q0, 64, 0.f, false, LSE + (size_t)g * T * 8 + r0 * 8 + hq, shm); }
    }
}
__device__ __forceinline__ void merge_phase(Frame& F, const bf16* OGB, const float* LSE, bf16* OCAT1) {
    for (int m = F.gw; m < T; m += F.NGW) {
        const int h = F.lane >> 3; const int b = m / SEQ, pos = m % SEQ;
        const size_t r0 = m, r1 = (size_t)b * SEQ + (size_t)(pos & 3) * (SEQ / 4) + (pos >> 2), r2 = (size_t)b * SEQ + (size_t)(pos & 15) * (SEQ / 16) + (pos >> 4);
        const float l0 = LSE[r0 * 8 + h], l1 = LSE[(size_t)T * 8 + r1 * 8 + h], l2 = LSE[(size_t)2 * T * 8 + r2 * 8 + h];
        const float mx = fmaxf(l0, fmaxf(l1, l2)); float w0 = __expf(l0 - mx), w1 = __expf(l1 - mx), w2 = __expf(l2 - mx); const float is = 1.f / (w0 + w1 + w2); w0 *= is; w1 *= is; w2 *= is;
        const v4u a = *(const v4u*)(OGB + r0 * 512 + F.lane * 8), bb = *(const v4u*)(OGB + (size_t)T * 512 + r1 * 512 + F.lane * 8), c = *(const v4u*)(OGB + (size_t)2 * T * 512 + r2 * 512 + F.lane * 8);
        v4u w;
        w.x = pk2(w0 * bflo(a.x) + w1 * bflo(bb.x) + w2 * bflo(c.x), w0 * bfhi(a.x) + w1 * bfhi(bb.x) + w2 * bfhi(c.x));
        w.y = pk2(w0 * bflo(a.y) + w1 * bflo(bb.y) + w2 * bflo(c.y), w0 * bfhi(a.y) + w1 * bfhi(bb.y) + w2 * bfhi(c.y));
        w.z = pk2(w0 * bflo(a.z) + w1 * bflo(bb.z) + w2 * bflo(c.z), w0 * bfhi(a.z) + w1 * bfhi(bb.z) + w2 * bfhi(c.z));
        w.w = pk2(w0 * bflo(a.w) + w1 * bflo(bb.w) + w2 * bflo(c.w), w0 * bfhi(a.w) + w1 * bfhi(bb.w) + w2 * bfhi(c.w));
        *(v4u*)(OCAT1 + (size_t)m * C_OUT + F.lane * 8) = w;
    }
}

typedef float f32x4m __attribute__((ext_vector_type(4)));
__device__ __forceinline__ void top4_merge(float (&v)[4], int (&ix)[4], int mask) {
    float ov[4]; int oi[4];
#pragma unroll
    for (int k = 0; k < 4; ++k) { ov[k] = __shfl_xor(v[k], mask); oi[k] = __shfl_xor(ix[k], mask); }
    float cv[8]; int ci[8];
#pragma unroll
    for (int k = 0; k < 4; ++k) { cv[k] = v[k]; ci[k] = ix[k]; cv[4 + k] = ov[k]; ci[4 + k] = oi[k]; }
    unsigned used = 0u;
#pragma unroll
    for (int k = 0; k < 4; ++k) { float best = -INFINITY; int bi = 1 << 30, bp = 0;
#pragma unroll
        for (int c = 0; c < 8; ++c) { const bool take = !((used >> c) & 1u) && (cv[c] > best || (cv[c] == best && ci[c] < bi)); best = take ? cv[c] : best; bi = take ? ci[c] : bi; bp = take ? c : bp; }
        used |= 1u << bp; v[k] = best; ix[k] = bi; }
}
__device__ __forceinline__ void route_phase(Frame& F, const bf16* H, const float* WR, const float* rb, gu32* cnt, int* TOPE, float* TOPG, int* TOPPOS, float* RSTD) {
    LAS float* WL = (LAS float*)(F.lds + RING_OFF);
    for (int i = F.tid; i < NE * D / 4; i += NWAVES * 64) { const int e = i >> 8, k4 = i & 255; *(LAS f32x4*)(WL + e * 1028 + 4 * k4) = *(const f32x4*)(WR + (size_t)e * D + 4 * k4); }
    __syncthreads();
    const int lane = F.lane, c = lane & 15, q = lane >> 4;
    for (int task = F.wave * F.G + F.vcu; task < T / 16; task += F.NGW) {
        const bf16* xr = H + (size_t)(task * 16 + c) * D + 8 * q;
        const LAS float* w0 = WL + c * 1028 + 8 * q; const LAS float* w1 = w0 + 16 * 1028;
        f32x4m a0 = {0.f, 0.f, 0.f, 0.f}, a1 = {0.f, 0.f, 0.f, 0.f}; float ssq = 0.f;
#pragma unroll 4
        for (int ch = 0; ch < 32; ++ch) {
            const v4u xv = *(const v4u*)(xr + 32 * ch);
            float xf[8]; xf[0] = bflo(xv.x); xf[1] = bfhi(xv.x); xf[2] = bflo(xv.y); xf[3] = bfhi(xv.y); xf[4] = bflo(xv.z); xf[5] = bfhi(xv.z); xf[6] = bflo(xv.w); xf[7] = bfhi(xv.w);
            const f32x4 wa0 = *(const LAS f32x4*)(w0 + 32 * ch), wa1 = *(const LAS f32x4*)(w0 + 32 * ch + 4), wb0 = *(const LAS f32x4*)(w1 + 32 * ch), wb1 = *(const LAS f32x4*)(w1 + 32 * ch + 4);
#pragma unroll
            for (int t = 0; t < 8; ++t) ssq += xf[t] * xf[t];
            a0 = __builtin_amdgcn_mfma_f32_16x16x4f32(wa0.x, xf[0], a0, 0, 0, 0); a1 = __builtin_amdgcn_mfma_f32_16x16x4f32(wb0.x, xf[0], a1, 0, 0, 0);
            a0 = __builtin_amdgcn_mfma_f32_16x16x4f32(wa0.y, xf[1], a0, 0, 0, 0); a1 = __builtin_amdgcn_mfma_f32_16x16x4f32(wb0.y, xf[1], a1, 0, 0, 0);
            a0 = __builtin_amdgcn_mfma_f32_16x16x4f32(wa0.z, xf[2], a0, 0, 0, 0); a1 = __builtin_amdgcn_mfma_f32_16x16x4f32(wb0.z, xf[2], a1, 0, 0, 0);
            a0 = __builtin_amdgcn_mfma_f32_16x16x4f32(wa0.w, xf[3], a0, 0, 0, 0); a1 = __builtin_amdgcn_mfma_f32_16x16x4f32(wb0.w, xf[3], a1, 0, 0, 0);
            a0 = __builtin_amdgcn_mfma_f32_16x16x4f32(wa1.x, xf[4], a0, 0, 0, 0); a1 = __builtin_amdgcn_mfma_f32_16x16x4f32(wb1.x, xf[4], a1, 0, 0, 0);
            a0 = __builtin_amdgcn_mfma_f32_16x16x4f32(wa1.y, xf[5], a0, 0, 0, 0); a1 = __builtin_amdgcn_mfma_f32_16x16x4f32(wb1.y, xf[5], a1, 0, 0, 0);
            a0 = __builtin_amdgcn_mfma_f32_16x16x4f32(wa1.z, xf[6], a0, 0, 0, 0); a1 = __builtin_amdgcn_mfma_f32_16x16x4f32(wb1.z, xf[6], a1, 0, 0, 0);
            a0 = __builtin_amdgcn_mfma_f32_16x16x4f32(wa1.w, xf[7], a0, 0, 0, 0); a1 = __builtin_amdgcn_mfma_f32_16x16x4f32(wb1.w, xf[7], a1, 0, 0, 0);
        }
        ssq += __shfl_xor(ssq, 16); ssq += __shfl_xor(ssq, 32);
        const float rstd = 1.f / sqrtf(ssq * (1.f / D) + NORM_EPS);
        float cv[8]; int ci[8];
#pragma unroll
        for (int r = 0; r < 4; ++r) { ci[r] = 4 * q + r; ci[4 + r] = 16 + 4 * q + r; cv[r] = a0[r] * rstd + rb[4 * q + r]; cv[4 + r] = a1[r] * rstd + rb[16 + 4 * q + r]; }
        float tv[4]; int ti[4]; unsigned used = 0u;
#pragma unroll
        for (int k = 0; k < 4; ++k) { float best = -INFINITY; int bi = 0, bp = 0;
#pragma unroll
            for (int j = 0; j < 8; ++j) { const bool take = !((used >> j) & 1u) && (cv[j] > best); best = take ? cv[j] : best; bi = take ? ci[j] : bi; bp = take ? j : bp; }
            used |= 1u << bp; tv[k] = best; ti[k] = bi; }
        top4_merge(tv, ti, 16); top4_merge(tv, ti, 32);
        const float e1 = __expf(tv[1] - tv[0]), e2 = __expf(tv[2] - tv[0]), e3 = __expf(tv[3] - tv[0]); const float is = 1.f / (1.f + e1 + e2 + e3);
        const int m = task * 16 + c;
        { const int e = q == 0 ? ti[0] : q == 1 ? ti[1] : q == 2 ? ti[2] : ti[3]; const float g = (q == 0 ? 1.f : q == 1 ? e1 : q == 2 ? e2 : e3) * is;
            const unsigned pos = __hip_atomic_fetch_add(cnt + e, 1u, RLX_AGENT);
            TOPE[m * 4 + q] = e; TOPG[m * 4 + q] = g; TOPPOS[m * 4 + q] = (int)pos; }
        if (q == 0) RSTD[m] = rstd;
    }
    __syncthreads();
}
__device__ __forceinline__ void slot_phase(Frame& F, const bf16* H, gu32* cnt, const int* TOPE, const float* TOPG, const int* TOPPOS, const float* RSTD, int* TOKSLOT, float* SLOTGATE, float* SLOTRS, bf16* XG, int* XTAB) {
    LAS int* L = (LAS int*)(F.lds + RING_OFF);
    const int lane = F.lane;
    if (F.wave == 0) {
        const int np = (lane < 32) ? (((int)__hip_atomic_load(cnt + (lane & 31), RLX_AGENT) + 255) >> 8) : 0;
        int pre = np;
#pragma unroll
        for (int o = 1; o < 32; o <<= 1) { const int t = __shfl_up(pre, o); if (lane >= o) pre += t; }
        const int p0 = pre - np;
        if (lane < 32) { L[lane] = np; L[32 + lane] = p0 * 256; }
        if (F.bx == 0) {
            int load = 0, ne = 0, cump = 0; bool done = (lane >= 32);
            for (int it = 0; it < 32; ++it) {
                int key = done ? -1 : (np * 64 + (31 - lane));
#pragma unroll
                for (int o = 1; o < 64; o <<= 1) key = max(key, __shfl_xor(key, o));
                const int be = 31 - (key & 63), bn = key >> 6;
                int lk = (lane < 8) ? (load * 8 + lane) : (1 << 30);
#pragma unroll
                for (int o = 1; o < 64; o <<= 1) lk = min(lk, __shfl_xor(lk, o));
                const int bx = lk & 7;
                const int bp0 = __shfl(p0, be);
                if (lane == bx) { int* tb = XTAB + bx * 136 + 4 + 4 * ne; tb[0] = be; tb[1] = bp0; tb[2] = bn; tb[3] = cump; cump += bn; load += bn; ++ne; }
                if (lane == be) done = true;
            }
            if (lane < 8) { XTAB[lane * 136] = ne; XTAB[lane * 136 + 1] = cump; }
        }
    }
    __syncthreads();
    for (int m = F.gw; m < T; m += F.NGW) {
        int slot = 0;
        if (lane < 4) { const int e = TOPE[m * 4 + lane]; slot = L[32 + e] + TOPPOS[m * 4 + lane]; TOKSLOT[m * 4 + lane] = slot; SLOTGATE[slot] = TOPG[m * 4 + lane]; SLOTRS[slot] = RSTD[m]; }
        const int s0 = __shfl(slot, 0), s1 = __shfl(slot, 1), s2 = __shfl(slot, 2), s3 = __shfl(slot, 3);
        const bf16* src = H + (size_t)m * D + lane * 8; const v4u a = *(const v4u*)src, b = *(const v4u*)(src + 512);
        const size_t co = (size_t)lane * 8;
        *(v4u*)(XG + (size_t)s0 * D + co) = a; *(v4u*)(XG + (size_t)s0 * D + co + 512) = b;
        *(v4u*)(XG + (size_t)s1 * D + co) = a; *(v4u*)(XG + (size_t)s1 * D + co + 512) = b;
        *(v4u*)(XG + (size_t)s2 * D + co) = a; *(v4u*)(XG + (size_t)s2 * D + co + 512) = b;
        *(v4u*)(XG + (size_t)s3 * D + co) = a; *(v4u*)(XG + (size_t)s3 * D + co + 512) = b;
    }
    __syncthreads();
}
__device__ __forceinline__ void combine_phase(Frame& F, const bf16* HM, const bf16* Y, const int* TOKSLOT, bf16* H2) {
    const int lane = F.lane;
    for (int m = F.gw; m < T; m += F.NGW) {
        const int s0 = TOKSLOT[m * 4], s1 = TOKSLOT[m * 4 + 1], s2 = TOKSLOT[m * 4 + 2], s3 = TOKSLOT[m * 4 + 3];
#pragma unroll
        for (int j = 0; j < 2; ++j) { const size_t co = (size_t)j * 512 + lane * 8; const v4u h = *(const v4u*)(HM + (size_t)m * D + co);
            const v4u y0 = *(const v4u*)(Y + (size_t)s0 * D + co), y1 = *(const v4u*)(Y + (size_t)s1 * D + co), y2 = *(const v4u*)(Y + (size_t)s2 * D + co), y3 = *(const v4u*)(Y + (size_t)s3 * D + co);
            v4u w;
            w.x = pk2(bflo(h.x) + (((bflo(y0.x) + bflo(y1.x)) + bflo(y2.x)) + bflo(y3.x)), bfhi(h.x) + (((bfhi(y0.x) + bfhi(y1.x)) + bfhi(y2.x)) + bfhi(y3.x)));
            w.y = pk2(bflo(h.y) + (((bflo(y0.y) + bflo(y1.y)) + bflo(y2.y)) + bflo(y3.y)), bfhi(h.y) + (((bfhi(y0.y) + bfhi(y1.y)) + bfhi(y2.y)) + bfhi(y3.y)));
            w.z = pk2(bflo(h.z) + (((bflo(y0.z) + bflo(y1.z)) + bflo(y2.z)) + bflo(y3.z)), bfhi(h.z) + (((bfhi(y0.z) + bfhi(y1.z)) + bfhi(y2.z)) + bfhi(y3.z)));
            w.w = pk2(bflo(h.w) + (((bflo(y0.w) + bflo(y1.w)) + bflo(y2.w)) + bflo(y3.w)), bfhi(h.w) + (((bfhi(y0.w) + bfhi(y1.w)) + bfhi(y2.w)) + bfhi(y3.w)));
            *(v4u*)(H2 + (size_t)m * D + co) = w; }
    }
}
__device__ __forceinline__ void final_norm_phase(Frame& F, const bf16* H, const float* SS, const float* gain, float* out) {
    const int lane = F.lane;
    for (int m = F.gw; m < T; m += F.NGW) {
        const float rstd = 1.f / sqrtf(ssp_sum(SS + (size_t)m * 16) * (1.f / D) + NORM_EPS);
#pragma unroll
        for (int j = 0; j < 2; ++j) { const size_t co = (size_t)j * 512 + lane * 8; const v4u h = *(const v4u*)(H + (size_t)m * D + co); const f32x4 g0 = *(const f32x4*)(gain + co), g1 = *(const f32x4*)(gain + co + 4);
            f32x4 o0, o1; o0.x = bflo(h.x) * rstd * g0.x; o0.y = bfhi(h.x) * rstd * g0.y; o0.z = bflo(h.y) * rstd * g0.z; o0.w = bfhi(h.y) * rstd * g0.w;
            o1.x = bflo(h.z) * rstd * g1.x; o1.y = bfhi(h.z) * rstd * g1.y; o1.z = bflo(h.w) * rstd * g1.z; o1.w = bfhi(h.w) * rstd * g1.w;
            float* dst = out + (size_t)m * D + co; *(f32x4*)dst = o0; *(f32x4*)(dst + 4) = o1; }
    }
}

constexpr int N_PHASES = 22;
struct Args { const float* in[20]; float* out; unsigned char* ws; int ph_lo, ph_hi, li, pad; };
typedef const __attribute__((address_space(4))) Args* argp_t;
__device__ __forceinline__ argp_t opaque_args() { argp_t p = (argp_t)__builtin_amdgcn_kernarg_segment_ptr(); asm volatile("" : "+s"(p)); return p; }
#define AP (opaque_args())
__global__ void __launch_bounds__(NWAVES * 64, 2) fwd_kernel(Args args_unused) {
    extern __shared__ __attribute__((aligned(16))) unsigned char lds[];
    Frame F;
    F.lds = (LAS unsigned char*)lds;
    F.MISC = (volatile LAS unsigned*)(F.lds + MISC_OFF);
    refresh(F);
    F.ctl = (gu32*)(AP->ws + WS_CTL);
    if (F.tid < 128) ((LAS unsigned*)(F.lds + LDSCTL_OFF))[F.tid] = 0u;
    __syncthreads();
    const bool one_phase = (AP->ph_hi - AP->ph_lo) == 1;
    XcdBarrier bar; bar.bar = (unsigned*)(F.ctl + CW_BAR); bar.x = 0; bar.st = nullptr;
    if (!one_phase) bar = xcd_barrier_post((unsigned*)(F.ctl + CW_BAR), F.MISC + 8);
    const int lo = AP->ph_lo, hi = AP->ph_hi;
#ifndef MK_MASK
#define MK_MASK 0x3fff
#endif
#ifndef PROBE_MASK
#define PROBE_MASK 0
#endif
#define IN(k) (lo <= (k) && (k) < hi)
#define INL(j) (((MK_MASK >> (j)) & 1) && IN(pb + (j)) && refresh(F))
#define REP(j) _Pragma("unroll") for (int rep_ = 0; rep_ < (((PROBE_MASK >> (j)) & 1) ? 2 : 1); ++rep_)
#define SEAM(k) do { if (IN((k) + 1)) xcd_barrier(bar); } while (0)
#define ws (AP->ws)
#define WSP(type, off) ((type*)(ws + (off)))
    if (((MK_MASK >> 12) & 1) && IN(0) && refresh(F)) REP(12) {
        transpose_family<1>(F, AP->in[13], (size_t)D * 2 * DE, WSP(bf16, WS_WUPT), (size_t)2 * DE * D, AP->in[10], D, D, 2 * DE, 2 * NE, NE);
        transpose_family<0>(F, AP->in[15], (size_t)DE * D, WSP(bf16, WS_WDNT), (size_t)D * DE, nullptr, 0, DE, D, 2 * NE, 1);
        transpose_family<2>(F, AP->in[3], 0, WSP(bf16, WS_WIN0T), 0, AP->in[2], 0, D, AB_IN, 1, 1);
        transpose_family<3>(F, AP->in[8], 0, WSP(bf16, WS_WIN1T), 0, AP->in[2] + D, 0, D, C_IN, 1, 1);
        transpose_family<0>(F, AP->in[7], 0, WSP(bf16, WS_WOUT0T), 0, nullptr, 0, D, D, 1, 1);
        transpose_family<0>(F, AP->in[9], 0, WSP(bf16, WS_WOUT1T), 0, nullptr, 0, C_OUT, D, 1, 1);
        transpose_family<0>(F, AP->in[18], (size_t)D * D, WSP(bf16, WS_WGT), (size_t)D * D, nullptr, 0, D, D, 2, 1);
        transpose_family<0>(F, AP->in[17], (size_t)PLE * D, WSP(bf16, WS_WPT), (size_t)D * PLE, nullptr, 0, PLE, D, 2, 1);
        {
            float* WR = WSP(float, WS_WR); const float* nf = AP->in[10]; const float* rw = AP->in[11];
            for (int i = F.gw * 64 + F.lane; i < 2 * NE * D; i += F.NGW * 64) { const int l = i / (NE * D), e = (i / D) % NE, k = i % D; WR[i] = nf[l * D + k] * rw[((size_t)l * D + k) * NE + e]; }
        }
        {
            float* R1 = WSP(float, WS_ROPE1); float* RA = WSP(float, WS_ROPEA);
            for (int i = F.gw * 64 + F.lane; i < SEQ * 32; i += F.NGW * 64) { const int pos = i >> 5, j = i & 31;
                const float a1 = (float)pos * rope_freq(j, 32); R1[2 * i] = cosf(a1); R1[2 * i + 1] = sinf(a1);
                const float aa = (float)((j < 16) ? (pos >> 6) : (pos & 63)) * rope_freq(j & 15, 16); RA[2 * i] = cosf(aa); RA[2 * i + 1] = sinf(aa); }
        }
        {
            bf16* PBF = WSP(bf16, WS_PBF); const float* p_in = AP->in[1]; const size_t n8 = (size_t)2 * T * PLE / 8;
            for (size_t i = (size_t)F.gw * 64 + F.lane; i < n8; i += (size_t)F.NGW * 64) { const f32x4 a = *(const f32x4*)(p_in + i * 8), b = *(const f32x4*)(p_in + i * 8 + 4);
                v4u w; w.x = pk2(a.x, a.y); w.y = pk2(a.z, a.w); w.z = pk2(b.x, b.y); w.w = pk2(b.z, b.w); *(v4u*)(PBF + i * 8) = w; }
        }
        {
            bf16* X0 = WSP(bf16, WS_X0); float* SS0 = WSP(float, WS_SSP); const float* x_in = AP->in[0];
            for (int m = F.gw; m < T; m += F.NGW) { float s = 0.f;
#pragma unroll
                for (int j = 0; j < 2; ++j) { const size_t co = (size_t)m * D + j * 512 + F.lane * 8; const f32x4 a = *(const f32x4*)(x_in + co), b = *(const f32x4*)(x_in + co + 4);
                    v4u w; w.x = pk2(a.x, a.y); w.y = pk2(a.z, a.w); w.z = pk2(b.x, b.y); w.w = pk2(b.z, b.w); *(v4u*)(X0 + co) = w;
                    s += (bflo(w.x) * bflo(w.x) + bfhi(w.x) * bfhi(w.x)) + (bflo(w.y) * bflo(w.y) + bfhi(w.y) * bfhi(w.y)) + (bflo(w.z) * bflo(w.z) + bfhi(w.z) * bfhi(w.z)) + (bflo(w.w) * bflo(w.w) + bfhi(w.w) * bfhi(w.w)); }
                s = wave_sum(s); if (F.lane < 16) SS0[(size_t)m * 16 + F.lane] = (F.lane == 0) ? s : 0.f; }
        }
        __syncthreads();
        SEAM(0);
    }
#pragma unroll 1
    for (int l = 0; l < 2; ++l) {
        const int pb = 1 + 10 * l;
        if (INL(0)) REP(0) {
            const bf16* hin = (l == 0) ? WSP(bf16, WS_X0) : WSP(bf16, WS_H3);
            const float* ssin = WSP(float, WS_SSP) + (size_t)l * T * 16;
            if (l == 0) { pg8::Gemm g{hin, WSP(bf16, WS_WIN0T), T, AB_IN, D}; pg8::StaticOrder S; S.init(T, AB_IN, F.G, F.bx);
                EpiQKV<0> E{ssin, AP->in[4], AP->in[5], WSP(float, WS_ROPE1), WSP(float, WS_ROPEA), WSP(bf16, WS_Q3), WSP(bf16, WS_K3), WSP(bf16, WS_V3)};
                pg8::gemm_phase<EpiQKV<0>, pg8::StaticOrder, true, true>(F.lds + RING_OFF, g, S, E); }
            else { pg8::Gemm g{hin, WSP(bf16, WS_WIN1T), T, C_IN, D}; pg8::StaticOrder S; S.init(T, C_IN, F.G, F.bx);
                EpiQKV<1> E{ssin, nullptr, nullptr, WSP(float, WS_ROPE1), WSP(float, WS_ROPEA), WSP(bf16, WS_Q3), WSP(bf16, WS_K3), WSP(bf16, WS_V3)};
                pg8::gemm_phase<EpiQKV<1>, pg8::StaticOrder, true, true>(F.lds + RING_OFF, g, S, E); }
            if (l == 0) { int Kp = PLE; asm volatile("" : "+s"(Kp)); pg8::Gemm g{WSP(bf16, WS_PBF), WSP(bf16, WS_WPT), 2 * T, 2 * D, Kp}; PPOrder S{(int)F.G, F.bx};
                EpiPP E{WSP(bf16, WS_PP)};
                pg8::gemm_phase<EpiPP, PPOrder, true, true>(F.lds + RING_OFF, g, S, E); }
            SEAM(pb + 0);
        }
        if (INL(1)) REP(1) {
            if (l == 0) attn_phase_l0(F, WSP(bf16, WS_Q3), WSP(bf16, WS_K3), WSP(bf16, WS_V3), WSP(bf16, WS_OCAT), AP->in[6]);
            else attn_phase_l1(F, WSP(bf16, WS_Q3), WSP(bf16, WS_K3), WSP(bf16, WS_V3), WSP(bf16, WS_OGB), WSP(float, WS_LSE));
            SEAM(pb + 1);
        }
        if (INL(2)) REP(2) { if (l == 1) merge_phase(F, WSP(bf16, WS_OGB), WSP(float, WS_LSE), WSP(bf16, WS_OCAT)); SEAM(pb + 2); }
        if (INL(3)) REP(3) {
            const bf16* hin = (l == 0) ? WSP(bf16, WS_X0) : WSP(bf16, WS_H3);
            pg8::Gemm g{WSP(bf16, WS_OCAT), (const bf16*)(ws + (l == 0 ? WS_WOUT0T : WS_WOUT1T)), T, D, (l == 0) ? D : C_OUT}; pg8::StaticOrder S; S.init(T, D, F.G, F.bx); EpiResBf16 E{hin, WSP(bf16, WS_HM)};
            pg8::gemm_phase<EpiResBf16, pg8::StaticOrder, true, true>(F.lds + RING_OFF, g, S, E);
            SEAM(pb + 3);
        }
        if (INL(4)) REP(4) { route_phase(F, WSP(bf16, WS_HM), WSP(float, WS_WR) + (size_t)l * NE * D, AP->in[12] + l * NE, F.ctl + CW_CNT + l * NE, WSP(int, WS_TOPE), WSP(float, WS_TOPG), WSP(int, WS_TOPPOS), WSP(float, WS_RSTD)); SEAM(pb + 4); }
        if (INL(5)) REP(5) { slot_phase(F, WSP(bf16, WS_HM), F.ctl + CW_CNT + l * NE, WSP(int, WS_TOPE), WSP(float, WS_TOPG), WSP(int, WS_TOPPOS), WSP(float, WS_RSTD), WSP(int, WS_TOKSLOT), WSP(float, WS_SLOTGATE), WSP(float, WS_SLOTRS), WSP(bf16, WS_XG), WSP(int, WS_XTAB)); SEAM(pb + 5); }
        if (INL(6)) REP(6) {
            pg8::Gemm g{WSP(bf16, WS_XG), WSP(bf16, WS_WUPT) + (size_t)l * NE * 2 * DE * D, NSLOT, NE * 2 * DE, D};
            XcdOrder<3> S{WSP(int, WS_XTAB) + (F.bx & 7) * 136, F.bx >> 3, (int)F.G >> 3};
            EpiSwiglu E{WSP(bf16, WS_ACT), AP->in[14] + (size_t)l * NE * 2 * DE, WSP(float, WS_SLOTRS)};
            pg8::gemm_phase<EpiSwiglu, XcdOrder<3>, true, true>(F.lds + RING_OFF, g, S, E);
            SEAM(pb + 6);
        }
        if (INL(7)) REP(7) {
            pg8::Gemm g{WSP(bf16, WS_ACT), WSP(bf16, WS_WDNT) + (size_t)l * NE * D * DE, NSLOT, NE * D, DE};
            XcdOrder<2> S{WSP(int, WS_XTAB) + (F.bx & 7) * 136, F.bx >> 3, (int)F.G >> 3};
            EpiDown E{WSP(bf16, WS_Y), AP->in[16] + (size_t)l * NE * D, WSP(float, WS_SLOTGATE)};
            pg8::gemm_phase<EpiDown, XcdOrder<2>, true, true>(F.lds + RING_OFF, g, S, E);
            SEAM(pb + 7);
        }
        if (INL(8)) REP(8) { combine_phase(F, WSP(bf16, WS_HM), WSP(bf16, WS_Y), WSP(int, WS_TOKSLOT), WSP(bf16, WS_H2)); SEAM(pb + 8); }
        if (INL(9)) REP(9) {
            pg8::Gemm g{WSP(bf16, WS_H2), WSP(bf16, WS_WGT) + (size_t)l * D * D, T, D, D}; pg8::StaticOrder S; S.init(T, D, F.G, F.bx);
            EpiPle E{WSP(bf16, WS_H2), WSP(bf16, WS_PP) + (size_t)l * T * D, WSP(bf16, WS_H3), WSP(float, WS_SSP) + (size_t)(l + 1) * T * 16};
            pg8::gemm_phase<EpiPle, pg8::StaticOrder, true, true>(F.lds + RING_OFF, g, S, E);
            SEAM(pb + 9);
        }
    }
    if (((MK_MASK >> 13) & 1) && IN(21) && refresh(F)) final_norm_phase(F, WSP(bf16, WS_H3), WSP(float, WS_SSP) + (size_t)2 * T * 16, AP->in[19], AP->out);
#undef IN
#undef INL
#undef REP
#undef SEAM
#undef ws
#undef WSP
}

#ifndef MK_ONE_LAUNCH
#define MK_ONE_LAUNCH 1
#endif
extern "C" void kernel_launch(void* const* d_in, const int* in_sizes, int n_in, void* d_out, int out_size, void* d_ws, size_t ws_size, hipStream_t stream) {
    static int grid = 0;
    if (grid == 0) {
        if (n_in != 20 || in_sizes[0] != T * D || out_size != T * D || ws_size < WS_END) { fprintf(stderr, "kernel_launch: unexpected shapes: n_in %d in0 %d out %d ws %zu (need %zu)\n", n_in, n_in > 0 ? in_sizes[0] : -1, out_size, ws_size, (size_t)WS_END); grid = -1; return; }
        int dev = 0, cus = 0, per_cu = 0;
        if (hipGetDevice(&dev) != hipSuccess || hipDeviceGetAttribute(&cus, hipDeviceAttributeMultiprocessorCount, dev) != hipSuccess) { grid = -1; return; }
        if (hipFuncSetAttribute((const void*)fwd_kernel, hipFuncAttributeMaxDynamicSharedMemorySize, LDS_BYTES) != hipSuccess) { fprintf(stderr, "kernel_launch: hipFuncSetAttribute failed\n"); grid = -1; return; }
        if (hipOccupancyMaxActiveBlocksPerMultiprocessor(&per_cu, (const void*)fwd_kernel, NWAVES * 64, LDS_BYTES) != hipSuccess || per_cu < 1) fprintf(stderr, "kernel_launch: occupancy query says %d\n", per_cu);
        (void)hipGetLastError();
        grid = cus;
        if (grid != 256) fprintf(stderr, "kernel_launch: %d CUs (built for 256)\n", grid);
    }
    if (grid < 0) return;
    if (hipMemsetAsync((char*)d_ws + WS_CTL, 0, CTL_ZERO_BYTES, stream) != hipSuccess) return;
    Args a{};
    for (int i = 0; i < 20; ++i) a.in[i] = (const float*)d_in[i];
    a.out = (float*)d_out; a.ws = (unsigned char*)d_ws;
#if MK_ONE_LAUNCH
    a.ph_lo = 0; a.ph_hi = N_PHASES; a.li = 0;
    hipLaunchKernelGGL(fwd_kernel, dim3(grid), dim3(NWAVES * 64), LDS_BYTES, stream, a);
#else
    for (int ph = 0; ph < N_PHASES; ++ph) {
        if (ph == 3) continue;
        a.ph_lo = ph; a.ph_hi = ph + 1; a.li = ph;
        hipLaunchKernelGGL(fwd_kernel, dim3(grid), dim3(NWAVES * 64), LDS_BYTES, stream, a);
    }
#endif
}
```

```cpp
#define MOE_FP8_MASK 3
#include <hip/hip_runtime.h>
#include <hip/hip_bf16.h>
#include <cstdio>
#include <cstdint>
#include <cmath>
namespace pg8 {
#define PG8_LAS __attribute__((address_space(3)))
typedef unsigned short bf16_t;
typedef short bf16x8 __attribute__((ext_vector_type(8)));
typedef float f32x4 __attribute__((ext_vector_type(4)));
typedef unsigned u32x4 __attribute__((ext_vector_type(4)));
typedef int pg8_v4i __attribute__((ext_vector_type(4)));
typedef long pg8_v2l __attribute__((ext_vector_type(2)));
constexpr int BM = 256, BK = 64, HALF = 128, HTB = HALF * BK * 2  , STAGE_BYTES = 8 * HTB, NXCD = 8, WGM = 8;

__host__ __device__ __forceinline__ int lds_byte(int r, int c) { const int st = (r >> 4) * 2 + (c >> 5), rr = r & 15, cc = c & 31, ob = rr * 64 + cc * 2; return st * 1024 + (ob ^ (((ob >> 9) & 1) << 5)); }
__host__ __device__ __forceinline__ void stage_rc(int b, int& R, int& C) { const int st = b / 1024, sb = b % 1024, swz = sb ^ (((sb >> 9) & 1) << 5); R = (st >> 1) * 16 + swz / 64; C = (st & 1) * 32 + (swz % 64) / 2; }
__host__ __device__ __forceinline__ int perm32(int rho) { const int n = rho >> 4, i = rho & 15; return 8 * (i >> 2) + 4 * n + (i & 3); }

struct Unit { int pm, pn; };
struct Gemm { const bf16_t* A; const bf16_t* Bt; int M, N, K; };

struct StaticOrder {
    int nM, nN, nwg, G, c;
    __host__ __device__ void init(int M, int N, int G_, int c_) { nM = M / BM; nN = N / BM; nwg = nM * nN; G = G_; c = c_; }
    __host__ __device__ bool next(int i, Unit& u) const {
        const long L = (long)i * G + c; if (L >= nwg) return false;
        int wgid = (int)L; { const int q = nwg / NXCD, r = nwg % NXCD, xcd = wgid % NXCD, off = wgid / NXCD; wgid = (xcd < r ? xcd * (q + 1) : r * (q + 1) + (xcd - r) * q) + off; }
        const int nig = WGM * nN, gid = wgid / nig, fm = gid * WGM, gsz = (nM - fm) < WGM ? (nM - fm) : WGM;
        u.pm = fm + ((wgid % nig) % gsz); u.pn = (wgid % nig) / gsz; return true;
    }
    __device__ __forceinline__ void a_ready(const Unit&) const {}
    __device__ __forceinline__ void done(const Unit&) const {}
};

__device__ __forceinline__ unsigned cvt_pk_bf16(float lo, float hi) { unsigned r; asm volatile("v_cvt_pk_bf16_f32 %0, %1, %2" : "=v"(r) : "v"(lo), "v"(hi)); return r; }
typedef float f32x2 __attribute__((ext_vector_type(2)));
__device__ __forceinline__ f32x2 gelu_pk(f32x2 v) {
    const f32x2 av = __builtin_elementwise_abs(v), d = av * 0.2316418882f + 1.0f;
    f32x2 t; t.x = __builtin_amdgcn_rcpf(d.x); t.y = __builtin_amdgcn_rcpf(d.y);
    f32x2 q = t * 0.5307027145f + (-0.7265760135f); q = q * t + 0.7107068705f; q = q * t + (-0.142248368f); q = q * t + 0.127414796f; q = q * t;
    const f32x2 s = (v * v) * (-0.72134752044f);
    f32x2 e; e.x = __builtin_amdgcn_exp2f(s.x); e.y = __builtin_amdgcn_exp2f(s.y);
    const f32x2 m = v * (q * e), r = v - m;
    f32x2 o; o.x = v.x < 0.f ? m.x : r.x; o.y = v.y < 0.f ? m.y : r.y; return o;
}

template <int ACT  > struct EpiBf16 {
    static constexpr bool PERM = true, AFTER_DRAIN = false; static_assert(ACT == 0 || ACT == 1, "EpiBf16: ACT is 0 (none) or 1 (gelu_pk)");
    bf16_t* O; int ldc; const float* bias; int split_cols; size_t split_stride; float scale0;
    __device__ __forceinline__ void operator()(const f32x4 (&acc)[2][2][4][2], const Unit& u, int wr, int wc, int fr, int fq) const {
        const int row0 = u.pm * BM + wr * 64 + fr; int colt = u.pn * BM; bf16_t* base = O;
        float sc = 1.f; if (split_cols) { const int t = colt / split_cols; base += (size_t)t * split_stride; colt -= t * split_cols; if (t == 0) sc = scale0; }
        const int col0 = colt + wc * 32 + 8 * fq, bcol0 = u.pn * BM + wc * 32 + 8 * fq;
        f32x4 bv[2][2];
#pragma unroll
        for (int bj = 0; bj < 2; ++bj)
#pragma unroll
            for (int n = 0; n < 2; ++n) bv[bj][n] = bias ? *(const f32x4*)(bias + bcol0 + bj * HALF + 4 * n) : (f32x4){0.f, 0.f, 0.f, 0.f};
#pragma unroll
        for (int ai = 0; ai < 2; ++ai)
#pragma unroll
            for (int m = 0; m < 4; ++m) { bf16_t* rowp = base + (size_t)(row0 + ai * HALF + m * 16) * ldc + col0;
#pragma unroll
                for (int bj = 0; bj < 2; ++bj) { f32x4 v0 = acc[ai][bj][m][0] + bv[bj][0], v1 = acc[ai][bj][m][1] + bv[bj][1];
                    if (ACT == 1) { f32x2 a = gelu_pk((f32x2){v0[0], v0[1]}), b = gelu_pk((f32x2){v0[2], v0[3]}), c = gelu_pk((f32x2){v1[0], v1[1]}), d = gelu_pk((f32x2){v1[2], v1[3]});
                        v0 = (f32x4){a.x, a.y, b.x, b.y}; v1 = (f32x4){c.x, c.y, d.x, d.y}; }
                    v0 = v0 * sc; v1 = v1 * sc; u32x4 w; w.x = cvt_pk_bf16(v0[0], v0[1]); w.y = cvt_pk_bf16(v0[2], v0[3]); w.z = cvt_pk_bf16(v1[0], v1[1]); w.w = cvt_pk_bf16(v1[2], v1[3]);
                    *(u32x4*)(rowp + bj * HALF) = w; } }
    }
};
template <class Epi, class Sched, bool ALIGN_EPI = false, bool SP2 = false, int FP8SC = -1>
__device__ __forceinline__ void gemm_phase(PG8_LAS unsigned char* lds, const Gemm g, const Sched& S, const Epi& E) {
    int tid_ = threadIdx.x; asm volatile("" : "+v"(tid_));
    const int tid = tid_, wid = __builtin_amdgcn_readfirstlane(tid >> 6), lane = tid & 63, wr = wid >> 2, wc = wid & 3, fr = lane & 15, fq = lane >> 4;
    const int K = g.K, nt = K / BK;
    unsigned voffA[2], voffB[2];
#pragma unroll
    for (int i = 0; i < 2; ++i) { int R, C; stage_rc(tid * 16 + i * 8192, R, C); const int Rb = Epi::PERM ? ((R & ~31) + perm32(R & 31)) : R;
        voffA[i] = (unsigned)(R * K + C) * 2u; voffB[i] = (unsigned)(Rb * K + C) * 2u; }
    const size_t kstep = (size_t)(BK * 2);
    const size_t hstep = (size_t)HALF * K * 2;
    const size_t tstep = 2 * hstep;
    const unsigned ldsw = (unsigned)wid * 1024u;
    const int aoff = lds_byte(wr * 64 + fr, fq * 8), boff = lds_byte(wc * 32 + fr, fq * 8);
#define PG8_SA(b, h) (((b) * 2 + (h)) * HTB)
#define PG8_SB(b, h) ((4 + (b) * 2 + (h)) * HTB)
#define PG8_STAGE(bufoff, gbase, voff) do { _Pragma("unroll") for (int _i = 0; _i < 2; ++_i) \
        __builtin_amdgcn_global_load_lds((const unsigned*)((const char*)(gbase) + (voff)[_i]), (PG8_LAS unsigned*)(lds + (bufoff) + ldsw + _i * 8192), 16, 0, 0); } while (0)
#define PG8_LDA(dst, b, h) do { _Pragma("unroll") for (int m = 0; m < 4; ++m) _Pragma("unroll") for (int k = 0; k < 2; ++k) dst[m][k] = *(const PG8_LAS bf16x8*)(lds + PG8_SA(b, h) + aoff + m * 2048 + k * 1024); } while (0)
#define PG8_LDB(dst, b, h) do { _Pragma("unroll") for (int n = 0; n < 2; ++n) _Pragma("unroll") for (int k = 0; k < 2; ++k) dst[n][k] = *(const PG8_LAS bf16x8*)(lds + PG8_SB(b, h) + boff + n * 2048 + k * 1024); } while (0)
#define PG8_CAT8(x0, x1) __builtin_shufflevector(__builtin_bit_cast(pg8_v4i, x0), __builtin_bit_cast(pg8_v4i, x1), 0, 1, 2, 3, 4, 5, 6, 7)
#define PG8_MMA(ai, bj, At, Bt) do { __builtin_amdgcn_s_setprio(1); \
        if constexpr (FP8SC < 0) { _Pragma("unroll") for (int m = 0; m < 4; ++m) _Pragma("unroll") for (int n = 0; n < 2; ++n) _Pragma("unroll") for (int k = 0; k < 2; ++k) \
            acc[ai][bj][m][n] = __builtin_amdgcn_mfma_f32_16x16x32_bf16(Bt[n][k], At[m][k], acc[ai][bj][m][n], 0, 0, 0); } \
        else if constexpr (FP8SC >= 1000) { _Pragma("unroll") for (int m = 0; m < 4; ++m) _Pragma("unroll") for (int n = 0; n < 2; ++n) _Pragma("unroll") for (int k = 0; k < 2; ++k) { \
            const pg8_v2l bq = __builtin_bit_cast(pg8_v2l, Bt[n][k]), aq = __builtin_bit_cast(pg8_v2l, At[m][k]); \
            acc[ai][bj][m][n] = __builtin_amdgcn_mfma_f32_16x16x32_fp8_fp8(bq[0], aq[0], acc[ai][bj][m][n], 0, 0, 0); acc[ai][bj][m][n] = __builtin_amdgcn_mfma_f32_16x16x32_fp8_fp8(bq[1], aq[1], acc[ai][bj][m][n], 0, 0, 0); } } \
        else { _Pragma("unroll") for (int m = 0; m < 4; ++m) _Pragma("unroll") for (int n = 0; n < 2; ++n) \
            acc[ai][bj][m][n] = __builtin_amdgcn_mfma_scale_f32_16x16x128_f8f6f4(PG8_CAT8(Bt[n][0], Bt[n][1]), PG8_CAT8(At[m][0], At[m][1]), acc[ai][bj][m][n], 0, 0, 0, (FP8SC < 0 ? 127 : FP8SC) * 0x01010101, 0, 0x7f7f7f7f); \
            _Pragma("unroll") for (int m = 0; m < 4; ++m) _Pragma("unroll") for (int n = 0; n < 2; ++n) asm volatile("" : "+v"(acc[ai][bj][m][n])); }     \
        __builtin_amdgcn_s_setprio(0); } while (0)
#define PG8_WAIT_V(n) asm volatile("s_waitcnt vmcnt(" #n ")" ::: "memory")
#define PG8_WAIT_L(n) asm volatile("s_waitcnt lgkmcnt(" #n ")" ::: "memory")
#define PG8_BAR __builtin_amdgcn_s_barrier()
#define PG8_SCHED __builtin_amdgcn_sched_barrier(0)
    Unit cur, nxt; int ui = 0;
    if (!S.next(0, cur)) return;
    f32x4 acc[2][2][4][2];
#pragma unroll
    for (int a = 0; a < 2; ++a)
#pragma unroll
        for (int b = 0; b < 2; ++b)
#pragma unroll
            for (int m = 0; m < 4; ++m)
#pragma unroll
                for (int n = 0; n < 2; ++n) acc[a][b][m][n] = (f32x4){0.f, 0.f, 0.f, 0.f};
    bf16x8 At[4][2], B0[2][2], B1[2][2];
    const char* cA = (const char*)g.A + (size_t)cur.pm * tstep; const char* cB = (const char*)g.Bt + (size_t)cur.pn * tstep;
    S.a_ready(cur);
    if constexpr (SP2) {
        PG8_STAGE(PG8_SB(0, 0), cB, voffB); PG8_STAGE(PG8_SB(0, 1), cB + hstep, voffB); PG8_STAGE(PG8_SA(0, 0), cA, voffA); PG8_STAGE(PG8_SA(0, 1), cA + hstep, voffA);
        if (wr == 1) PG8_BAR;
        PG8_WAIT_V(2); PG8_BAR;
        PG8_STAGE(PG8_SB(1, 0), cB + kstep, voffB); PG8_STAGE(PG8_SA(1, 0), cA + kstep, voffA); PG8_STAGE(PG8_SB(1, 1), cB + hstep + kstep, voffB);
        PG8_WAIT_V(6); PG8_BAR;
    } else {
        PG8_STAGE(PG8_SB(0, 0), cB, voffB); PG8_STAGE(PG8_SA(0, 0), cA, voffA); PG8_STAGE(PG8_SB(0, 1), cB + hstep, voffB); PG8_STAGE(PG8_SA(0, 1), cA + hstep, voffA);
        if (wr == 1) PG8_BAR;
        PG8_WAIT_V(4); PG8_BAR;
        PG8_STAGE(PG8_SB(1, 0), cB + kstep, voffB); PG8_STAGE(PG8_SA(1, 0), cA + kstep, voffA); PG8_STAGE(PG8_SB(1, 1), cB + hstep + kstep, voffB);
        PG8_WAIT_V(6); PG8_BAR;
    }
    for (;;) {
        const bool has_next = S.next(ui + 1, nxt);
        const char* nA = has_next ? (const char*)g.A + (size_t)nxt.pm * tstep : cA; const char* nB = has_next ? (const char*)g.Bt + (size_t)nxt.pn * tstep : cB;
        for (int t = 0; t < nt; t += 2) {
            const bool last = (t == nt - 2);
            const char* a1 = cA + (size_t)(t + 1) * kstep;
            const char* a2 = last ? nA : cA + (size_t)(t + 2) * kstep; const char* b2 = last ? nB : cB + (size_t)(t + 2) * kstep;
            const char* a3 = a2 + kstep; const char* b3 = b2 + kstep;
            if (last && has_next) S.a_ready(nxt);
            if constexpr (SP2) {
            PG8_LDB(B0, 0, 0); PG8_LDB(B1, 0, 1); PG8_SCHED; PG8_LDA(At, 0, 0); PG8_STAGE(PG8_SA(1, 1), a1 + hstep, voffA);
            PG8_WAIT_V(8); PG8_WAIT_L(0); PG8_BAR; PG8_MMA(0, 0, At, B0); PG8_MMA(0, 1, At, B1); PG8_BAR; PG8_SCHED;
            PG8_LDA(At, 0, 1); PG8_STAGE(PG8_SB(0, 0), b2, voffB); PG8_STAGE(PG8_SB(0, 1), b2 + hstep, voffB); PG8_STAGE(PG8_SA(0, 0), a2, voffA);
            PG8_WAIT_V(8); PG8_WAIT_L(0); PG8_BAR; PG8_MMA(1, 0, At, B0); PG8_MMA(1, 1, At, B1); PG8_BAR; PG8_SCHED;
            PG8_LDB(B0, 1, 0); PG8_LDB(B1, 1, 1); PG8_SCHED; PG8_LDA(At, 1, 0); PG8_STAGE(PG8_SA(0, 1), a2 + hstep, voffA);
            PG8_WAIT_V(8); PG8_WAIT_L(0); PG8_BAR; PG8_MMA(0, 0, At, B0); PG8_MMA(0, 1, At, B1); PG8_BAR; PG8_SCHED;
            PG8_LDA(At, 1, 1); PG8_STAGE(PG8_SB(1, 0), b3, voffB); PG8_STAGE(PG8_SB(1, 1), b3 + hstep, voffB); PG8_STAGE(PG8_SA(1, 0), a3, voffA);
            PG8_WAIT_V(8); PG8_WAIT_L(0); PG8_BAR; PG8_MMA(1, 0, At, B0); PG8_MMA(1, 1, At, B1); PG8_BAR; PG8_SCHED;
            } else {
            PG8_LDB(B0, 0, 0); PG8_SCHED; PG8_LDA(At, 0, 0); PG8_STAGE(PG8_SA(1, 1), a1 + hstep, voffA);
            PG8_WAIT_L(8); PG8_BAR; PG8_WAIT_L(0); PG8_MMA(0, 0, At, B0); PG8_BAR; PG8_SCHED;
            PG8_LDB(B1, 0, 1); PG8_STAGE(PG8_SB(0, 0), b2, voffB);
            PG8_BAR; PG8_WAIT_L(0); PG8_MMA(0, 1, At, B1); PG8_BAR;
            PG8_LDA(At, 0, 1); PG8_STAGE(PG8_SA(0, 0), a2, voffA);
            PG8_BAR; PG8_WAIT_L(0); PG8_MMA(1, 0, At, B0); PG8_BAR; PG8_SCHED;
            PG8_STAGE(PG8_SB(0, 1), b2 + hstep, voffB);
            PG8_WAIT_V(6); PG8_BAR; PG8_MMA(1, 1, At, B1); PG8_BAR;
            PG8_LDB(B0, 1, 0); PG8_SCHED; PG8_LDA(At, 1, 0); PG8_STAGE(PG8_SA(0, 1), a2 + hstep, voffA);
            PG8_WAIT_L(8); PG8_BAR; PG8_WAIT_L(0); PG8_MMA(0, 0, At, B0); PG8_BAR; PG8_SCHED;
            PG8_LDB(B1, 1, 1); PG8_STAGE(PG8_SB(1, 0), b3, voffB);
            PG8_BAR; PG8_WAIT_L(0); PG8_MMA(0, 1, At, B1); PG8_BAR;
            PG8_LDA(At, 1, 1); PG8_STAGE(PG8_SA(1, 0), a3, voffA);
            PG8_BAR; PG8_WAIT_L(0); PG8_MMA(1, 0, At, B0); PG8_BAR; PG8_SCHED;
            PG8_STAGE(PG8_SB(1, 1), b3 + hstep, voffB);
            PG8_WAIT_V(6); PG8_BAR; PG8_MMA(1, 1, At, B1); PG8_BAR;
            }
        }
        if constexpr (ALIGN_EPI) { if (wr == 0) PG8_BAR; }
        if constexpr (!Epi::AFTER_DRAIN) { E(acc, cur, wr, wc, fr, fq); S.done(cur); }
        if (!has_next) break;
#pragma unroll
        for (int a = 0; a < 2; ++a)
#pragma unroll
            for (int b = 0; b < 2; ++b)
#pragma unroll
                for (int m = 0; m < 4; ++m)
#pragma unroll
                    for (int n = 0; n < 2; ++n) acc[a][b][m][n] = (f32x4){0.f, 0.f, 0.f, 0.f};
        cur = nxt; cA = nA; cB = nB; ++ui;
        if constexpr (ALIGN_EPI) { if (wr == 1) PG8_BAR; }
    }
    PG8_WAIT_V(0);
    if constexpr (!ALIGN_EPI) { if (wr == 0) PG8_BAR; }
    PG8_BAR;
    if constexpr (Epi::AFTER_DRAIN) { E.fused(acc, cur, wr, wc, fr, fq, lds, wid, lane); S.done(cur); }
#undef PG8_SA
#undef PG8_SB
#undef PG8_STAGE
#undef PG8_LDA
#undef PG8_LDB
#undef PG8_MMA
#undef PG8_CAT8
#undef PG8_WAIT_V
#undef PG8_WAIT_L
#undef PG8_BAR
#undef PG8_SCHED
}
}

constexpr int NWAVES = 8;
constexpr int BATCH = 2, SEQ = 8192, T = BATCH * SEQ, D = 1024;
constexpr int AB_IN = 1536, C_IN = 2304, C_OUT = 512;
constexpr int NE = 32, DE = 1024, PLE = 256;
constexpr int NSLOT = 73728;
constexpr float NORM_EPS = 1e-6f;
constexpr float LOG2_THETA = 13.287712379549449f;
constexpr float ATT_C2 = 0.125f * 1.4426950408889634f;

#define GAS __attribute__((address_space(1)))
#define LAS __attribute__((address_space(3)))
typedef unsigned short bf16;
typedef unsigned v4u __attribute__((ext_vector_type(4)));
typedef unsigned v2u __attribute__((ext_vector_type(2)));
typedef float f32x4 __attribute__((ext_vector_type(4)));
typedef GAS unsigned gu32;
#define RLX_AGENT __ATOMIC_RELAXED, __HIP_MEMORY_SCOPE_AGENT
#define LDS_WAIT() asm volatile("s_waitcnt lgkmcnt(0)" ::: "memory")
#define VM_WAIT() asm volatile("s_waitcnt vmcnt(0)" ::: "memory")

typedef float f32x2_ __attribute__((ext_vector_type(2))); typedef __bf16 bf16x2_ __attribute__((ext_vector_type(2)));
__device__ __forceinline__ unsigned pk2(float lo, float hi) { f32x2_ v = {lo, hi}; bf16x2_ b = __builtin_convertvector(v, bf16x2_); return __builtin_bit_cast(unsigned, b); }
__device__ __forceinline__ float bflo(unsigned w) { return __builtin_bit_cast(float, w << 16); }
__device__ __forceinline__ float bfhi(unsigned w) { return __builtin_bit_cast(float, w & 0xffff0000u); }
#ifndef MOE_FP8_MASK
#define MOE_FP8_MASK 3
#endif
#ifndef F8_DIAG
#define F8_DIAG 0
#endif
constexpr float F8_EPI_SC = F8_DIAG ? (1.f / 64.f) : 1.f;
constexpr int F8_WSC = 6;
__device__ __forceinline__ unsigned pk4_fp8(float a, float b, float c, float d) { int w = 0; w = __builtin_amdgcn_cvt_pk_fp8_f32(a, b, w, false); w = __builtin_amdgcn_cvt_pk_fp8_f32(c, d, w, true); return (unsigned)w; }
__device__ __forceinline__ float clamp448(float x) { return fminf(fmaxf(x, -448.f), 448.f); }
__device__ __forceinline__ float rnd_bf(float x) { return bflo(pk2(x, 0.f)); }
__device__ __forceinline__ float ssp_sum(const float* p) { const f32x4 a = *(const f32x4*)p, b = *(const f32x4*)(p + 4), c = *(const f32x4*)(p + 8), d = *(const f32x4*)(p + 12);
    return (((a.x + a.y) + (a.z + a.w)) + ((b.x + b.y) + (b.z + b.w))) + (((c.x + c.y) + (c.z + c.w)) + ((d.x + d.y) + (d.z + d.w))); }

constexpr size_t MiB = 1u << 20;
constexpr size_t al256(size_t x) { return (x + 255) & ~(size_t)255; }
constexpr size_t WS_CTL = 0, CTL_ZERO_BYTES = 1 * MiB;
constexpr size_t WS_WIN0T = 1 * MiB;
constexpr size_t WS_WOUT0T = WS_WIN0T + (size_t)AB_IN * D * 2;
constexpr size_t WS_WIN1T = WS_WOUT0T + (size_t)D * D * 2;
constexpr size_t WS_WOUT1T = WS_WIN1T + (size_t)C_IN * D * 2;
constexpr size_t WS_WGT = WS_WOUT1T + (size_t)D * C_OUT * 2;
constexpr size_t WS_WPT = WS_WGT + 2 * (size_t)D * D * 2;
constexpr size_t WS_WR = WS_WPT + 2 * (size_t)D * PLE * 2;
constexpr size_t WS_ROPE1 = al256(WS_WR + 2 * (size_t)NE * D * 4);
constexpr size_t WS_ROPEA = WS_ROPE1 + (size_t)SEQ * 32 * 8;
constexpr size_t WS_WUPT = WS_ROPEA + (size_t)SEQ * 32 * 8;
constexpr size_t WS_WDNT = WS_WUPT + 2 * (size_t)NE * 2 * DE * D * 2;
constexpr size_t WS_PBF = WS_WDNT + 2 * (size_t)NE * D * DE * 2;
constexpr size_t WS_PP = WS_PBF + 2 * (size_t)T * PLE * 2;
constexpr size_t WS_X0 = WS_PP + 2 * (size_t)T * D * 2;
constexpr size_t WS_HM = WS_X0 + (size_t)T * D * 2;
constexpr size_t WS_H2 = WS_HM + (size_t)T * D * 2;
constexpr size_t WS_H3 = WS_H2 + (size_t)T * D * 2;
constexpr size_t WS_OCAT = WS_H3 + (size_t)T * D * 2;
constexpr size_t WS_SSP = WS_OCAT + (size_t)T * D * 2;
constexpr size_t WS_LSE = WS_SSP + 3 * (size_t)T * 16 * 4;
constexpr size_t WS_TOPE = WS_LSE + 3 * (size_t)T * 8 * 4;
constexpr size_t WS_TOPG = WS_TOPE + (size_t)T * 16;
constexpr size_t WS_TOPPOS = WS_TOPG + (size_t)T * 16;
constexpr size_t WS_RSTD = WS_TOPPOS + (size_t)T * 16;
constexpr size_t WS_TOKSLOT = WS_RSTD + (size_t)T * 4;
constexpr size_t WS_SLOTGATE = WS_TOKSLOT + (size_t)T * 16;
constexpr size_t WS_SLOTRS = WS_SLOTGATE + (size_t)NSLOT * 4;
constexpr size_t WS_XTAB = al256(WS_SLOTRS + (size_t)NSLOT * 4);
constexpr size_t WS_XG = al256(WS_XTAB + 8 * 136 * 4);
constexpr size_t WS_ACT = WS_XG + (size_t)NSLOT * D * 2;
constexpr size_t WS_Y = WS_ACT + (size_t)NSLOT * D * 2;
constexpr size_t WS_Q3 = WS_Y + (size_t)NSLOT * D * 2;
constexpr size_t WS_K3 = WS_Q3 + 3 * (size_t)T * 512 * 2;
constexpr size_t WS_V3 = WS_K3 + 3 * (size_t)T * 128 * 2;
constexpr size_t WS_OGB = WS_V3 + 3 * (size_t)T * 128 * 2;
constexpr size_t WS_END = WS_OGB + 3 * (size_t)T * 512 * 2;
constexpr int CW_TMO = 0;
constexpr int CW_CNT = 64;
constexpr int CW_BAR = 4096;

constexpr int LDSCTL_OFF = 0, MISC_OFF = 64;
constexpr int RING_OFF = 512, RING_BYTES = 131072;
constexpr int LDS_BYTES = 147456;

struct PPOrder {
    int G, c;
    __device__ __forceinline__ bool next(int i, pg8::Unit& u) const { const int L = i * G + c; if (L >= 512) return false; u.pm = L >> 2; u.pn = 4 * (u.pm >> 6) + (L & 3); return true; }
    __device__ __forceinline__ void a_ready(const pg8::Unit&) const {}
    __device__ __forceinline__ void done(const pg8::Unit&) const {}
};
struct EpiPP {
    static constexpr bool PERM = true, AFTER_DRAIN = false;
    bf16* O;
    __device__ __forceinline__ void operator()(const pg8::f32x4 (&acc)[2][2][4][2], const pg8::Unit& u, int wr, int wc, int fr, int fq) const {
        const int row0 = u.pm * 256 + wr * 64 + fr, col0 = (u.pn & 3) * 256 + wc * 32 + 8 * fq;
#pragma unroll
        for (int ai = 0; ai < 2; ++ai)
#pragma unroll
            for (int m = 0; m < 4; ++m) { bf16* rp = O + (size_t)(row0 + ai * 128 + m * 16) * D + col0;
#pragma unroll
                for (int bj = 0; bj < 2; ++bj) { const pg8::f32x4 v0 = acc[ai][bj][m][0], v1 = acc[ai][bj][m][1];
                    pg8::u32x4 w; w.x = pk2(v0[0], v0[1]); w.y = pk2(v0[2], v0[3]); w.z = pk2(v1[0], v1[1]); w.w = pk2(v1[2], v1[3]);
                    *(pg8::u32x4*)(rp + bj * 128) = w; } }
    }
};
template <int LAYER> struct EpiQKV {
    static constexpr bool PERM = true, AFTER_DRAIN = false;
    const float* SS; const float* qg; const float* kg; const float* rope1; const float* ropea; bf16* Q3; bf16* K3; bf16* V3;
    __device__ __forceinline__ void operator()(const pg8::f32x4 (&acc)[2][2][4][2], const pg8::Unit& u, int wr, int wc, int fr, int fq) const {
        int kind, hd, grp;
        bool axial;
        if (LAYER == 0) { const int t3 = u.pn % 3; grp = u.pn / 3; axial = (grp == 0);
            if (t3 < 2) { kind = 0; hd = 4 * t3 + wc; } else if (wc < 2) { kind = 1; hd = wc; } else { kind = 2; hd = wc - 2; } }
        else { const int t3 = u.pn % 3; grp = u.pn / 3; axial = false;
            if (t3 < 2) { kind = 0; hd = 4 * t3 + wc; } else if (wc < 2) { kind = 1; hd = wc; } else { kind = 2; hd = wc - 2; } }
        const bool norm = axial && kind < 2, rope = kind < 2;
        float ga[8], gb[8];
        if (norm) { const float* g = (kind == 0) ? qg : kg;
#pragma unroll
            for (int t = 0; t < 8; ++t) { const int j = 8 * fq + t; const int d0 = (j < 16) ? j : j + 16; ga[t] = g[d0]; gb[t] = g[d0 + 16]; } }
        else {
#pragma unroll
            for (int t = 0; t < 8; ++t) { ga[t] = 1.f; gb[t] = 1.f; } }
        const float qs = (kind == 0) ? ATT_C2 : 1.f;
        const float* rtab = axial ? ropea : rope1;
        bf16* dst; int pitch;
        if (kind == 0) { dst = Q3 + (size_t)grp * T * 512 + hd * 64; pitch = 512; } else if (kind == 1) { dst = K3 + (size_t)grp * T * 128 + hd * 64; pitch = 128; } else { dst = V3 + (size_t)grp * T * 128 + hd * 64; pitch = 128; }
        const int row0 = u.pm * 256 + wr * 64 + fr;
#pragma unroll
        for (int ai = 0; ai < 2; ++ai)
#pragma unroll
            for (int m = 0; m < 4; ++m) {
                const int r = row0 + ai * 128 + m * 16; const int pos = r & (SEQ - 1);
                const float rs = 1.f / sqrtf(ssp_sum(SS + (size_t)r * 16) * (1.f / D) + NORM_EPS);
                float a[8], b[8];
#pragma unroll
                for (int n = 0; n < 2; ++n)
#pragma unroll
                    for (int i = 0; i < 4; ++i) { a[4 * n + i] = acc[ai][0][m][n][i] * rs; b[4 * n + i] = acc[ai][1][m][n][i] * rs; }
                if (norm) { float ss = 0.f;
#pragma unroll
                    for (int t = 0; t < 8; ++t) ss += a[t] * a[t] + b[t] * b[t];
                    ss += __shfl_xor(ss, 16); ss += __shfl_xor(ss, 32);
                    const float rh = 1.f / sqrtf(ss * (1.f / 64.f) + NORM_EPS);
#pragma unroll
                    for (int t = 0; t < 8; ++t) { a[t] *= rh * ga[t]; b[t] *= rh * gb[t]; } }
                if (rope) { const f32x4* cs = (const f32x4*)(rtab + ((size_t)pos * 32 + 8 * fq) * 2);
#pragma unroll
                    for (int t2 = 0; t2 < 4; ++t2) { const f32x4 v = cs[t2];
                        { const float x1 = a[2 * t2], x2 = b[2 * t2]; a[2 * t2] = x1 * v.x - x2 * v.y; b[2 * t2] = x2 * v.x + x1 * v.y; }
                        { const float x1 = a[2 * t2 + 1], x2 = b[2 * t2 + 1]; a[2 * t2 + 1] = x1 * v.z - x2 * v.w; b[2 * t2 + 1] = x2 * v.z + x1 * v.w; } } }
                size_t drow = r;
                if (LAYER == 1) { const int sh = 2 * grp, bb = r >> 13; drow = (size_t)bb * SEQ + (size_t)(pos & ((1 << sh) - 1)) * (SEQ >> sh) + (pos >> sh); }
                bf16* dp = dst + drow * pitch + 8 * fq;
                pg8::u32x4 w0, w1;
                w0.x = pk2(a[0] * qs, a[1] * qs); w0.y = pk2(a[2] * qs, a[3] * qs); w0.z = pk2(a[4] * qs, a[5] * qs); w0.w = pk2(a[6] * qs, a[7] * qs);
                w1.x = pk2(b[0] * qs, b[1] * qs); w1.y = pk2(b[2] * qs, b[3] * qs); w1.z = pk2(b[4] * qs, b[5] * qs); w1.w = pk2(b[6] * qs, b[7] * qs);
                *(pg8::u32x4*)dp = w0; *(pg8::u32x4*)(dp + 32) = w1;
                asm volatile("" ::: "memory");
            }
    }
};
struct EpiResBf16 {
    static constexpr bool PERM = true, AFTER_DRAIN = false;
    const bf16* R; bf16* O;
    __device__ __forceinline__ void operator()(const pg8::f32x4 (&acc)[2][2][4][2], const pg8::Unit& u, int wr, int wc, int fr, int fq) const {
        const int row0 = u.pm * 256 + wr * 64 + fr, col0 = u.pn * 256 + wc * 32 + 8 * fq;
#pragma unroll
        for (int ai = 0; ai < 2; ++ai)
#pragma unroll
            for (int m = 0; m < 4; ++m) { const size_t ro = (size_t)(row0 + ai * 128 + m * 16) * D + col0;
#pragma unroll
                for (int bj = 0; bj < 2; ++bj) { const pg8::f32x4 v0 = acc[ai][bj][m][0], v1 = acc[ai][bj][m][1]; const v4u rr = *(const v4u*)(R + ro + bj * 128);
                    pg8::u32x4 w; w.x = pk2(v0[0] + bflo(rr.x), v0[1] + bfhi(rr.x)); w.y = pk2(v0[2] + bflo(rr.y), v0[3] + bfhi(rr.y)); w.z = pk2(v1[0] + bflo(rr.z), v1[1] + bfhi(rr.z)); w.w = pk2(v1[2] + bflo(rr.w), v1[3] + bfhi(rr.w));
                    *(pg8::u32x4*)(O + ro + bj * 128) = w; }
                asm volatile("" ::: "memory"); }
    }
};
__device__ __forceinline__ float sigmoidf_(float x) { return 1.0f / (1.0f + __expf(-x)); }
__device__ __forceinline__ float swiglu1(float g, float l) {
    g = fminf(g, 7.0f); l = fminf(fmaxf(l, -7.0f), 7.0f);
    return g * sigmoidf_(1.702f * g) * (l + 1.0f);
}
template <bool F8> struct EpiSwiglu {
    static constexpr bool PERM = true, AFTER_DRAIN = false;
    void* ACT; const float* bup; const float* rsl;
    __device__ __forceinline__ void operator()(const pg8::f32x4 (&acc)[2][2][4][2], const pg8::Unit& u, int wr, int wc, int fr, int fq) const {
        const int e = u.pn >> 3, j = u.pn & 7; const int row0 = u.pm * 256 + wr * 64 + fr, a0 = j * 128 + wc * 32 + 8 * fq;
        const float* bp = bup + (size_t)e * 2048 + 2 * a0; pg8::f32x4 b[4];
#pragma unroll
        for (int i = 0; i < 4; ++i) b[i] = *(const pg8::f32x4*)(bp + 4 * i);
#pragma unroll
        for (int ai = 0; ai < 2; ++ai)
#pragma unroll
            for (int m = 0; m < 4; ++m) { const int r = row0 + ai * 128 + m * 16; const float rs = F8 ? F8_EPI_SC : rsl[r];
                const pg8::f32x4 g0 = acc[ai][0][m][0] * rs, g1 = acc[ai][0][m][1] * rs, l0 = acc[ai][1][m][0] * rs, l1 = acc[ai][1][m][1] * rs;
                float o[8];
                o[0] = swiglu1(g0[0] + b[0][0], l0[0] + b[0][1]); o[1] = swiglu1(g0[1] + b[0][2], l0[1] + b[0][3]);
                o[2] = swiglu1(g0[2] + b[1][0], l0[2] + b[1][1]); o[3] = swiglu1(g0[3] + b[1][2], l0[3] + b[1][3]);
                o[4] = swiglu1(g1[0] + b[2][0], l1[0] + b[2][1]); o[5] = swiglu1(g1[1] + b[2][2], l1[1] + b[2][3]);
                o[6] = swiglu1(g1[2] + b[3][0], l1[2] + b[3][1]); o[7] = swiglu1(g1[3] + b[3][2], l1[3] + b[3][3]);
                if (F8) { v2u w; w.x = pk4_fp8(o[0], o[1], o[2], o[3]); w.y = pk4_fp8(o[4], o[5], o[6], o[7]); *(v2u*)((unsigned char*)ACT + (size_t)r * DE + a0) = w; }
                else { pg8::u32x4 w; w.x = pk2(o[0], o[1]); w.y = pk2(o[2], o[3]); w.z = pk2(o[4], o[5]); w.w = pk2(o[6], o[7]); *(pg8::u32x4*)((bf16*)ACT + (size_t)r * DE + a0) = w; } }
    }
};
struct EpiDown {
    static constexpr bool PERM = true, AFTER_DRAIN = false;
    bf16* Y; const float* bdn; const float* gate; float asc;
    __device__ __forceinline__ void operator()(const pg8::f32x4 (&acc)[2][2][4][2], const pg8::Unit& u, int wr, int wc, int fr, int fq) const {
        const int e = u.pn >> 2, j = u.pn & 3; const int row0 = u.pm * 256 + wr * 64 + fr, col0 = j * 256 + wc * 32 + 8 * fq;
        pg8::f32x4 bv[2][2];
#pragma unroll
        for (int bj = 0; bj < 2; ++bj)
#pragma unroll
            for (int n = 0; n < 2; ++n) bv[bj][n] = *(const pg8::f32x4*)(bdn + (size_t)e * D + col0 + bj * 128 + 4 * n);
#pragma unroll
        for (int ai = 0; ai < 2; ++ai)
#pragma unroll
            for (int m = 0; m < 4; ++m) { const int r = row0 + ai * 128 + m * 16; const float gt = gate[r];
#pragma unroll
                for (int bj = 0; bj < 2; ++bj) { const pg8::f32x4 v0 = (acc[ai][bj][m][0] * asc + bv[bj][0]) * gt, v1 = (acc[ai][bj][m][1] * asc + bv[bj][1]) * gt;
                    pg8::u32x4 w; w.x = pk2(v0[0], v0[1]); w.y = pk2(v0[2], v0[3]); w.z = pk2(v1[0], v1[1]); w.w = pk2(v1[2], v1[3]);
                    *(pg8::u32x4*)(Y + (size_t)r * D + col0 + bj * 128) = w; } }
    }
};
struct EpiPle {
    static constexpr bool PERM = true, AFTER_DRAIN = false;
    const bf16* H2; const bf16* PP; bf16* H3; float* SS;
    __device__ __forceinline__ void operator()(const pg8::f32x4 (&acc)[2][2][4][2], const pg8::Unit& u, int wr, int wc, int fr, int fq) const {
        const int row0 = u.pm * 256 + wr * 64 + fr, col0 = u.pn * 256 + wc * 32 + 8 * fq;
#pragma unroll
        for (int ai = 0; ai < 2; ++ai)
#pragma unroll
            for (int m = 0; m < 4; ++m) { const int r = row0 + ai * 128 + m * 16; const size_t ro = (size_t)r * D + col0; float ss = 0.f;
#pragma unroll
                for (int bj = 0; bj < 2; ++bj) { const pg8::f32x4 a0 = acc[ai][bj][m][0], a1 = acc[ai][bj][m][1]; const v4u h = *(const v4u*)(H2 + ro + bj * 128), p = *(const v4u*)(PP + ro + bj * 128);
                    pg8::u32x4 w;
                    w.x = pk2(bflo(h.x) + bflo(p.x) * sigmoidf_(a0[0]), bfhi(h.x) + bfhi(p.x) * sigmoidf_(a0[1])); w.y = pk2(bflo(h.y) + bflo(p.y) * sigmoidf_(a0[2]), bfhi(h.y) + bfhi(p.y) * sigmoidf_(a0[3]));
                    w.z = pk2(bflo(h.z) + bflo(p.z) * sigmoidf_(a1[0]), bfhi(h.z) + bfhi(p.z) * sigmoidf_(a1[1])); w.w = pk2(bflo(h.w) + bflo(p.w) * sigmoidf_(a1[2]), bfhi(h.w) + bfhi(p.w) * sigmoidf_(a1[3]));
                    *(pg8::u32x4*)(H3 + ro + bj * 128) = w;
                    ss += (bflo(w.x) * bflo(w.x) + bfhi(w.x) * bfhi(w.x)) + (bflo(w.y) * bflo(w.y) + bfhi(w.y) * bfhi(w.y)) + (bflo(w.z) * bflo(w.z) + bfhi(w.z) * bfhi(w.z)) + (bflo(w.w) * bflo(w.w) + bfhi(w.w) * bfhi(w.w)); }
                ss += __shfl_xor(ss, 16); ss += __shfl_xor(ss, 32);
                if (fq == 0) SS[(size_t)r * 16 + u.pn * 4 + wc] = ss;
                asm volatile("" ::: "memory"); }
    }
};
template <int LJ> struct XcdOrder {
    const int* tab; int rank, stride;
    __device__ __forceinline__ bool next(int i, pg8::Unit& u) const {
        const int q = i * stride + rank, p = q >> LJ, j = q & ((1 << LJ) - 1); const int ne = tab[0], tot = tab[1]; if (p >= tot) return false;
        int s = 0; while (s + 1 < ne && tab[4 + 4 * (s + 1) + 3] <= p) ++s;
        u.pm = tab[4 + 4 * s + 1] + (p - tab[4 + 4 * s + 3]); u.pn = (tab[4 + 4 * s] << LJ) + j; return true; }
    __device__ __forceinline__ void a_ready(const pg8::Unit&) const {}
    __device__ __forceinline__ void done(const pg8::Unit&) const {}
};
#include <hip/hip_bf16.h>
#include <cmath>
namespace attn_body {
using bf16=__hip_bfloat16;
using bf16x8=__attribute__((ext_vector_type(8)))short;
using s16x4=__attribute__((ext_vector_type(4)))short;
using f32x16=__attribute__((ext_vector_type(16)))float;
using u32x4=__attribute__((ext_vector_type(4)))unsigned;
constexpr int D=64,QP=512,KVP=128;
constexpr int NW=8,QBLK=32,QB=QBLK*NW,KVBLK=64;
constexpr int ATTN_UNIT_ROWS=QB;
__device__ __forceinline__ int crow(int r,int hi){return (r&3)+8*(r>>2)+4*hi;}
#define SBAR() __builtin_amdgcn_sched_barrier(0)
__device__ __forceinline__ void cmask(f32x16&p0,f32x16&p1,int jb,int qrel,int hi){
  const float NEG=-INFINITY; int kb=64*jb+4*hi;
  #pragma unroll
  for(int r=0;r<16;++r){int kv=kb+(r&3)+8*(r>>2); if(kv>qrel)p0[r]=NEG; if(kv+32>qrel)p1[r]=NEG;}
}

__device__ __forceinline__ void bmask(f32x16&p0,f32x16&p1,int t,int dqb,int W){
  const float NEG=-INFINITY; const int kb=64*t+dqb;
  #pragma unroll
  for(int r=0;r<16;++r){const int d=kb+(r&3)+8*(r>>2); if(d>W||d<-W)p0[r]=NEG; if(d+32>W||d+32<-W)p1[r]=NEG;}
}
constexpr int NSLOT=3, SLOTB=8192;
constexpr int LDS_K=0, LDS_V=NSLOT*SLOTB, LDS_WS=2*NSLOT*SLOTB, LDS_OST=LDS_WS+NW*64*4, LDS_BYTES=LDS_OST+NW*4096;
constexpr float C2=0.125f*1.4426950408889634f;
__device__ __forceinline__ void glds16(const void*gsrc,unsigned lds_dst){unsigned keep;
  asm volatile("s_mov_b32 %0, m0\n\ts_mov_b32 m0, %2\n\ts_nop 0\n\tglobal_load_lds_dwordx4 %1, off\n\ts_mov_b32 m0, %0":"=&s"(keep):"v"(gsrc),"s"(lds_dst):"memory");}
__device__ __forceinline__ float max3f(float a,float b,float c){float r;asm("v_max3_f32 %0, %1, %2, %3":"=v"(r):"v"(a),"v"(b),"v"(c));return r;}
__device__ __forceinline__ float max2f(float a,float b){float r;asm("v_max_f32_e32 %0, %1, %2":"=v"(r):"v"(a),"v"(b));return r;}
__device__ __forceinline__ float fadd_s(float a,float b){float r;asm("v_add_f32_e32 %0, %1, %2":"=v"(r):"v"(a),"v"(b));return r;}
__device__ __forceinline__ float fsub_s(float a,float b){float r;asm("v_sub_f32_e32 %0, %1, %2":"=v"(r):"v"(a),"v"(b));return r;}
typedef float f32x2_t __attribute__((ext_vector_type(2))); typedef __bf16 bf16x2_t __attribute__((ext_vector_type(2)));
__device__ __forceinline__ unsigned cvtpk_s(float lo,float hi){f32x2_t v={lo,hi};bf16x2_t b=__builtin_convertvector(v,bf16x2_t);return __builtin_bit_cast(unsigned,b);}
#define WAIT_BAR(N) asm volatile("s_waitcnt vmcnt(" #N ") lgkmcnt(0)\n\ts_barrier":::"memory")

__device__ __forceinline__ void qkt(f32x16&p0,f32x16&p1,const char*Kslot,const bf16x8*qr,const f32x16&negm,int r32,int hi){
  const char*kb=Kslot+hi*1024+r32*16;
  #pragma unroll
  for(int d0=0;d0<4;++d0){
    const bf16x8 b0=*reinterpret_cast<const bf16x8*>(kb+d0*2048);
    const bf16x8 b1=*reinterpret_cast<const bf16x8*>(kb+d0*2048+512);
    if(d0==0){p0=__builtin_amdgcn_mfma_f32_32x32x16_bf16(b0,qr[0],negm,0,0,0);p1=__builtin_amdgcn_mfma_f32_32x32x16_bf16(b1,qr[0],negm,0,0,0);}
    else{p0=__builtin_amdgcn_mfma_f32_32x32x16_bf16(b0,qr[d0],p0,0,0,0);p1=__builtin_amdgcn_mfma_f32_32x32x16_bf16(b1,qr[d0],p1,0,0,0);}}
}
typedef __attribute__((address_space(3))) const char* lds_cptr;
typedef short v4i16_t __attribute__((ext_vector_type(4)));
__device__ __forceinline__ void kload8(bf16x8*kf,lds_cptr kp){
  kf[0]=*(const __attribute__((address_space(3))) bf16x8*)(kp);      kf[1]=*(const __attribute__((address_space(3))) bf16x8*)(kp+512);
  kf[2]=*(const __attribute__((address_space(3))) bf16x8*)(kp+2048); kf[3]=*(const __attribute__((address_space(3))) bf16x8*)(kp+2560);
  kf[4]=*(const __attribute__((address_space(3))) bf16x8*)(kp+4096); kf[5]=*(const __attribute__((address_space(3))) bf16x8*)(kp+4608);
  kf[6]=*(const __attribute__((address_space(3))) bf16x8*)(kp+6144); kf[7]=*(const __attribute__((address_space(3))) bf16x8*)(kp+6656);
}
__device__ __forceinline__ void kload2(bf16x8*kf,lds_cptr kp,int j){ kf[2*j]=*(const __attribute__((address_space(3))) bf16x8*)(kp+j*2048); kf[2*j+1]=*(const __attribute__((address_space(3))) bf16x8*)(kp+j*2048+512); }
__device__ __forceinline__ s16x4 vtr(lds_cptr p){ return __builtin_bit_cast(s16x4,__builtin_amdgcn_ds_read_tr16_b64_v4i16((__attribute__((address_space(3))) v4i16_t*)p)); }
__device__ __forceinline__ float rowmax(const f32x16&p0,const f32x16&p1){
  float a=max3f(p0[0],p0[1],p1[0]),b=max3f(p0[2],p0[3],p1[1]);a=max3f(a,p1[2],p1[3]);
  #pragma unroll
  for(int r=4;r<16;r+=4){a=max3f(a,p0[r],p0[r+1]);b=max3f(b,p0[r+2],p0[r+3]);a=max3f(a,p1[r],p1[r+1]);b=max3f(b,p1[r+2],p1[r+3]);}
  const float m=max2f(a,b);
  auto rr=__builtin_amdgcn_permlane32_swap(__float_as_uint(m),__float_as_uint(m),false,false);
  return max2f(__uint_as_float(rr[0]),__uint_as_float(rr[1]));
}
__device__ __forceinline__ void pv(f32x16*o,int vb,bf16x8 pa0,bf16x8 pa1,bf16x8 pa2,bf16x8 pa3){
  #pragma unroll
  for(int d0=0;d0<2;++d0){s16x4 lo[4],hi[4];
    #pragma unroll
    for(int ks=0;ks<4;++ks){
      asm volatile("ds_read_b64_tr_b16 %0,%1 offset:%c2":"=&v"(lo[ks]):"v"(vb),"i"(d0*4096+ks*1024):"memory");
      asm volatile("ds_read_b64_tr_b16 %0,%1 offset:%c2":"=&v"(hi[ks]):"v"(vb),"i"(d0*4096+ks*1024+512):"memory");}
    asm volatile("s_waitcnt lgkmcnt(0)":::"memory");SBAR();
    #define PK(k) (bf16x8){lo[k][0],lo[k][1],lo[k][2],lo[k][3],hi[k][0],hi[k][1],hi[k][2],hi[k][3]}
    o[d0]=__builtin_amdgcn_mfma_f32_32x32x16_bf16(pa0,PK(0),o[d0],0,0,0);
    o[d0]=__builtin_amdgcn_mfma_f32_32x32x16_bf16(pa1,PK(1),o[d0],0,0,0);
    o[d0]=__builtin_amdgcn_mfma_f32_32x32x16_bf16(pa2,PK(2),o[d0],0,0,0);
    o[d0]=__builtin_amdgcn_mfma_f32_32x32x16_bf16(pa3,PK(3),o[d0],0,0,0);
    #undef PK
  }
}

#ifndef ATTN_STORE16
#define ATTN_STORE16(p,v) (*(u32x4*)(p)=(v))
#endif
template<int MODE,int OP,int THRL> __device__ __forceinline__ void attn_unit(const bf16*Qu,const bf16*__restrict__ Ku,const bf16*__restrict__ Vu,bf16*Ou,int NT,int dq0,int W,float sinkl2,bool has_sink,float*lse,char*shm){
  int tid_=threadIdx.x; asm volatile("":"+v"(tid_));
  const int tid=tid_,lane=tid&63,r32=lane&31,hi=lane>>5; const int wid=__builtin_amdgcn_readfirstlane(tid>>6);
  const bf16*Qw=Qu+(long)(wid*QBLK)*QP;
  const unsigned lds0=(unsigned)(uintptr_t)shm;
  float*wsf=(float*)(shm+LDS_WS)+wid*64;
  const bf16*ksrc=Ku+(long)lane*KVP+wid*8;
  const bf16*vsrc=Vu+(long)(16*(wid&3)+(lane>>2))*KVP+(wid>>2)*32+(lane&3)*8;
  const unsigned kdst=lds0+LDS_K+wid*1024, vdst=lds0+LDS_V+wid*1024;
  #define DMA_K(t,slot) glds16(ksrc+(long)(t)*KVBLK*KVP,(unsigned)__builtin_amdgcn_readfirstlane(kdst+(slot)))
  #define DMA_V(t,slot) glds16(vsrc+(long)(t)*KVBLK*KVP,(unsigned)__builtin_amdgcn_readfirstlane(vdst+(slot)))
  const int vb0=(int)(lds0+LDS_V)+((lane>>4)&1)*32+(lane&3)*8+(4*hi+((lane&15)>>2))*64;
  const char*Kbase=shm+LDS_K; bf16x8 kf[8];
  const lds_cptr shm3=(lds_cptr)shm; const lds_cptr kp0=shm3+LDS_K+hi*1024+r32*16; const lds_cptr vp0=shm3+LDS_V+((lane>>4)&1)*32+(lane&3)*8+(4*hi+((lane&15)>>2))*64;
  DMA_K(0,0);DMA_V(0,0);DMA_K(1,SLOTB);
  bf16x8 qr[4];
  #pragma unroll
  for(int d0=0;d0<4;++d0)qr[d0]=*reinterpret_cast<const bf16x8*>(&Qw[(long)r32*QP+d0*16+hi*8]);
  float mhat=0.f,l_reg=0.f;f32x16 o[2];o[0]=f32x16{};o[1]=f32x16{};f32x16 negm=f32x16{};asm volatile("":"+v"(negm));
  const int dqb=dq0-(wid*QBLK+r32)+4*hi;
  #define CMASK(P0,P1,t) do{ if(MODE==1) bmask(P0,P1,(t),dqb,W); }while(0)
  bool resc=false;
  #define START(P0,P1) do{ float rm=rowmax(P0,P1); if(MODE==1) rm=fmaxf(rm,-60.f); resc=false; \
    { const float dl=rm; mhat=fadd_s(mhat,dl); \
      _Pragma("unroll") for(int r=0;r<16;++r){P0[r]=fsub_s(P0[r],dl);P1[r]=fsub_s(P1[r],dl);} \
      _Pragma("unroll") for(int r=0;r<16;++r)negm[r]=-mhat; asm volatile("":"+v"(negm)); } \
    _Pragma("unroll") for(int r=0;r<16;++r)P0[r]=__builtin_amdgcn_exp2f(P0[r]); }while(0)
  #define RESC() do{ if(resc){ asm volatile("s_waitcnt lgkmcnt(0)":::"memory"); \
      _Pragma("unroll") for(int d_=0;d_<2;++d_) _Pragma("unroll") for(int r=0;r<16;++r)o[d_][r]*=wsf[crow(r,hi)]; } }while(0)
  f32x16 pA0,pA1,pB0,pB1;
  int sl_prev=0,sl_cur=0,sl_next=SLOTB;
  #define ROT() do{sl_prev=sl_cur;sl_cur=sl_next;sl_next=(sl_next==(NSLOT-1)*SLOTB)?0:sl_next+SLOTB;}while(0)
  DMA_K(2,2*SLOTB);
  WAIT_BAR(3);
  qkt(pA0,pA1,Kbase,qr,negm,r32,hi);asm volatile("s_nop 15\n\ts_nop 7":"+v"(pA0),"+v"(pA1));CMASK(pA0,pA1,0);
  START(pA0,pA1);
  _Pragma("unroll") for(int r=0;r<16;++r)pA1[r]=__builtin_amdgcn_exp2f(pA1[r]);
  WAIT_BAR(0);
  DMA_K(3,0);DMA_V(1,SLOTB);
  ROT();
  kload8(kf,kp0+sl_cur);
  WAIT_BAR(2);
  s16x4 vlo[8],vhi[8]; u32x4 pw0,pw1,pw2,pw3;
  #define PKW(P,B) cvtpk_s(P[B],P[B+1])
  #define PAF(k) __builtin_bit_cast(bf16x8,pw##k)
  #define VFR(i) (bf16x8){vlo[i][0],vlo[i][1],vlo[i][2],vlo[i][3],vhi[i][0],vhi[i][1],vhi[i][2],vhi[i][3]}
  #define PIN(x) asm volatile("":"+v"(x))
  #define MX3(a,b,c) __builtin_fmaxf(__builtin_fmaxf((a),(b)),(c))
  #define GAPA(MF,A0,A1,A2,A3,W0,W1,PW) do{ MF; sacc+=A0; sacc+=A1; sacc+=A2; sacc+=A3; PIN(sacc); W0; W1; PIN(PW); SBAR(); }while(0)
  #define EX(v) __builtin_amdgcn_exp2f(v)
  #define GAPB(MF,X,B) do{ MF; X[B]=EX(X[B]); X[B+1]=EX(X[B+1]); X[B+2]=EX(X[B+2]); X[B+3]=EX(X[B+3]); PIN(X); SBAR(); }while(0)
  #define VRD(i) do{ vlo[i]=vtr(vp_+(((i)>>2)*4096+((i)&3)*1024)); vhi[i]=vtr(vp_+(((i)>>2)*4096+((i)&3)*1024+512)); }while(0)
  #define KRD(G,j) do{ if(G){ kload2(kf,kp0+sl_next,j); SBAR(); } }while(0)
  #define STEP(C0,C1,P0,P1,t,GK,GV,GL) do{ SBAR(); \
    const lds_cptr vp_=vp0+sl_prev; \
    VRD(0); SBAR(); float sacc=(P0[0]+P0[1]); \
    GAPA(C0=__builtin_amdgcn_mfma_f32_32x32x16_bf16(kf[0],qr[0],negm,0,0,0), P0[2],P0[3],P0[4],P0[5],     pw0[0]=PKW(P0,0), pw0[1]=PKW(P0,2), pw0); \
    VRD(4); SBAR(); GAPA(C1=__builtin_amdgcn_mfma_f32_32x32x16_bf16(kf[1],qr[0],negm,0,0,0), P0[6],P0[7],P0[8],P0[9],     pw0[2]=PKW(P0,4), pw0[3]=PKW(P0,6), pw0); \
    VRD(1); SBAR(); GAPA(C0=__builtin_amdgcn_mfma_f32_32x32x16_bf16(kf[2],qr[1],C0,0,0,0),   P0[10],P0[11],P0[12],P0[13], pw1[0]=PKW(P0,8), pw1[1]=PKW(P0,10), pw1); \
    VRD(5); SBAR(); GAPA(C1=__builtin_amdgcn_mfma_f32_32x32x16_bf16(kf[3],qr[1],C1,0,0,0),   P0[14],P0[15],P1[0],P1[1],   pw1[2]=PKW(P0,12),pw1[3]=PKW(P0,14), pw1); \
    VRD(2); SBAR(); GAPA(C0=__builtin_amdgcn_mfma_f32_32x32x16_bf16(kf[4],qr[2],C0,0,0,0),   P1[2],P1[3],P1[4],P1[5],     pw2[0]=PKW(P1,0), pw2[1]=PKW(P1,2), pw2); \
    VRD(6); SBAR(); GAPA(C1=__builtin_amdgcn_mfma_f32_32x32x16_bf16(kf[5],qr[2],C1,0,0,0),   P1[6],P1[7],P1[8],P1[9],     pw2[2]=PKW(P1,4), pw2[3]=PKW(P1,6), pw2); \
    VRD(3); SBAR(); GAPA(C0=__builtin_amdgcn_mfma_f32_32x32x16_bf16(kf[6],qr[3],C0,0,0,0),   P1[10],P1[11],P1[12],P1[13], pw3[0]=PKW(P1,8), pw3[1]=PKW(P1,10), pw3); \
    VRD(7); SBAR(); GAPA(C1=__builtin_amdgcn_mfma_f32_32x32x16_bf16(kf[7],qr[3],C1,0,0,0),   P1[14],P1[15],0.f,0.f,       pw3[2]=PKW(P1,12),pw3[3]=PKW(P1,14), pw3); \
    l_reg+=sacc; \
    if(GK){DMA_K((t)+3,sl_cur);} if(GV){DMA_V((t)+1,sl_next);} \
    CMASK(C0,C1,t); \
    { float a=MX3(C0[0],C0[1],C1[0]),b=MX3(C0[2],C0[3],C1[1]); a=MX3(a,C1[2],C1[3]); \
      _Pragma("unroll") for(int r=4;r<16;r+=4){a=MX3(a,C0[r],C0[r+1]);b=MX3(b,C0[r+2],C0[r+3]);a=MX3(a,C1[r],C1[r+1]);b=MX3(b,C1[r+2],C1[r+3]);} \
      float rm=__builtin_fmaxf(a,b); { auto rr=__builtin_amdgcn_permlane32_swap(__float_as_uint(rm),__float_as_uint(rm),false,false); rm=__builtin_fmaxf(__uint_as_float(rr[0]),__uint_as_float(rr[1])); } \
      resc=false; \
      if(__builtin_expect(__any(rm>(float)THRL),0)){ const float dl=__builtin_fmaxf(rm,0.f); mhat+=dl; \
        _Pragma("unroll") for(int r=0;r<16;++r){C0[r]-=dl;C1[r]-=dl;} \
        _Pragma("unroll") for(int r=0;r<16;++r)negm[r]=-mhat; asm volatile("":"+v"(negm)); \
        const float f=__builtin_amdgcn_exp2f(-dl); l_reg*=f; if(hi==0)wsf[r32]=f; resc=true; } } \
    SBAR(); \
    GAPB(o[0]=__builtin_amdgcn_mfma_f32_32x32x16_bf16(PAF(0),VFR(0),o[0],0,0,0), C0,0); \
    GAPB(o[1]=__builtin_amdgcn_mfma_f32_32x32x16_bf16(PAF(0),VFR(4),o[1],0,0,0), C0,4); \
    KRD(GL,0); GAPB(o[0]=__builtin_amdgcn_mfma_f32_32x32x16_bf16(PAF(1),VFR(1),o[0],0,0,0), C0,8); \
    KRD(GL,1); GAPB(o[1]=__builtin_amdgcn_mfma_f32_32x32x16_bf16(PAF(1),VFR(5),o[1],0,0,0), C0,12); \
    KRD(GL,2); GAPB(o[0]=__builtin_amdgcn_mfma_f32_32x32x16_bf16(PAF(2),VFR(2),o[0],0,0,0), C1,0); \
    KRD(GL,3); GAPB(o[1]=__builtin_amdgcn_mfma_f32_32x32x16_bf16(PAF(2),VFR(6),o[1],0,0,0), C1,4); \
    GAPB(o[0]=__builtin_amdgcn_mfma_f32_32x32x16_bf16(PAF(3),VFR(3),o[0],0,0,0), C1,8); \
    GAPB(o[1]=__builtin_amdgcn_mfma_f32_32x32x16_bf16(PAF(3),VFR(7),o[1],0,0,0), C1,12); \
    }while(0)
  int t=1;
  for(;t+5<NT;t+=2){
    STEP(pB0,pB1,pA0,pA1,t,true,true,true);     WAIT_BAR(2); RESC(); ROT();
    STEP(pA0,pA1,pB0,pB1,t+1,true,true,true);   WAIT_BAR(2); RESC(); ROT();
  }
  #define ENDW(tt) do{ if((tt)+3<NT){WAIT_BAR(2);} else if((tt)+2<NT){WAIT_BAR(1);} else {WAIT_BAR(0);} }while(0)
  for(;t+1<NT;t+=2){
    STEP(pB0,pB1,pA0,pA1,t,(t+3<NT),(t+1<NT),(t+1<NT));       ENDW(t);   RESC(); ROT();
    STEP(pA0,pA1,pB0,pB1,t+1,(t+4<NT),(t+2<NT),(t+2<NT));     ENDW(t+1); RESC(); ROT();
  }
  STEP(pB0,pB1,pA0,pA1,NT-1,false,false,false); RESC();
  { float sacc=pB0[0]+pB0[1]; _Pragma("unroll") for(int r=2;r<16;++r)sacc+=pB0[r]; _Pragma("unroll") for(int r=0;r<16;++r)sacc+=pB1[r]; l_reg+=sacc;
    pw0=(u32x4){PKW(pB0,0),PKW(pB0,2),PKW(pB0,4),PKW(pB0,6)};pw1=(u32x4){PKW(pB0,8),PKW(pB0,10),PKW(pB0,12),PKW(pB0,14)};pw2=(u32x4){PKW(pB1,0),PKW(pB1,2),PKW(pB1,4),PKW(pB1,6)};pw3=(u32x4){PKW(pB1,8),PKW(pB1,10),PKW(pB1,12),PKW(pB1,14)};
    SBAR(); pv(o,vb0+sl_cur,PAF(0),PAF(1),PAF(2),PAF(3)); }
  #undef PKW
  #undef PAF
  #undef VFR
  #undef PIN
  #undef MX3
  #undef GAPA
  #undef GAPB
  #undef EX
  #undef VRD
  #undef KRD
  #undef STEP
  #undef ENDW
  {auto rr=__builtin_amdgcn_permlane32_swap(__float_as_uint(l_reg),__float_as_uint(l_reg),false,false);l_reg=__uint_as_float(rr[0])+__uint_as_float(rr[1]);}
  if(MODE==1){ if(has_sink) l_reg+=__builtin_amdgcn_exp2f(sinkl2-mhat); if(lse!=nullptr&&hi==0) lse[(long)(wid*QBLK+r32)*8]=0.6931471805599453f*(mhat+__builtin_amdgcn_logf(l_reg)); }
  if(hi==0)wsf[32+r32]=l_reg;asm volatile("s_waitcnt lgkmcnt(0)":::"memory");
  float rli[16];
  #pragma unroll
  for(int r=0;r<16;++r)rli[r]=__builtin_amdgcn_rcpf(wsf[32+crow(r,hi)]);
  bf16*Ow=Ou+(long)(wid*QBLK)*OP;
  { bf16*stg=(bf16*)(shm+LDS_OST)+wid*2048;
    #pragma unroll
    for(int r=0;r<16;++r){const int orow=crow(r,hi);
      #pragma unroll
      for(int d0=0;d0<2;++d0)stg[orow*64+d0*32+r32]=__float2bfloat16(o[d0][r]*rli[r]);}
    asm volatile("s_waitcnt lgkmcnt(0)":::"memory");
    #pragma unroll
    for(int i=0;i<4;++i){const int row=i*8+(lane>>3),ch=lane&7; const u32x4 v=*(const u32x4*)(stg+row*64+ch*8); ATTN_STORE16(Ow+(long)row*OP+ch*8,v);} }
  asm volatile("s_waitcnt lgkmcnt(0)\n\ts_barrier":::"memory");
  #undef DMA_K
  #undef DMA_V
  #undef CMASK
  #undef START
  #undef RESC
  #undef ROT
}
constexpr int ATTN_LDS_BYTES=LDS_BYTES;
#undef SBAR
#undef WAIT_BAR
}
#define XB_TMO      128
#define XB_XCNT(j)  (256  + 64 * (j))
#define XB_XSUB(j)  (1280 + 64 * (j))
#define XB_XGEN(j)  (2304 + 64 * (j))
#define XB_TOP      3328
#define XB_TOPGEN   3392
#define XCD_BAR_WORDS 3456
#define XB_SPIN_CAP (1u << 18)

__device__ __forceinline__ unsigned xb_ld(unsigned* p)              { return __hip_atomic_load(p, __ATOMIC_RELAXED, __HIP_MEMORY_SCOPE_AGENT); }
__device__ __forceinline__ unsigned xb_add(unsigned* p, unsigned v) { return __hip_atomic_fetch_add(p, v, __ATOMIC_RELAXED, __HIP_MEMORY_SCOPE_AGENT); }
__device__ __forceinline__ unsigned xb_xcc_id() { return (unsigned)__builtin_amdgcn_s_getreg((3 << 11) | 20) & 0xFu; }
#define XB_SPIN(cond, bar) do { unsigned _sp = 0; while (cond) { __builtin_amdgcn_s_sleep(1); \
    if ((++_sp & 255u) == 0u) { if (xb_ld(&(bar)[XB_TMO])) break; if (_sp > XB_SPIN_CAP) { atomicAdd(&(bar)[XB_TMO], 1u); break; } } } } while (0)

struct XcdBarrier {
    unsigned* bar; unsigned x;
    volatile LAS unsigned* st;
};

__device__ __forceinline__ XcdBarrier xcd_barrier_post(unsigned* bar, volatile LAS unsigned* st) {
    XcdBarrier b; b.bar = bar; b.x = xb_xcc_id(); b.st = st;
    if (threadIdx.x == 0) (void)xb_add(&bar[XB_XCNT(b.x)], 1u);
    return b;
}
__device__ __forceinline__ void xcd_barrier_complete(unsigned* bar, unsigned x, unsigned& nloc, unsigned& nx) {
    const unsigned G = gridDim.x * gridDim.y * gridDim.z;
    unsigned sum, cnt, mine, sp = 0u;
    for (;;) {
        sum = 0u; cnt = 0u; mine = 0u;
#pragma unroll
        for (unsigned j = 0; j < 16; ++j) { const unsigned c = xb_ld(&bar[XB_XCNT(j)]); sum += c; cnt += (c > 0u) ? 1u : 0u; mine = (j == x) ? c : mine; }
        if (sum == G) break;
        __builtin_amdgcn_s_sleep(1);
        if ((++sp & 255u) == 0u) { if (xb_ld(&bar[XB_TMO])) break; if (sp > XB_SPIN_CAP) { atomicAdd(&bar[XB_TMO], 1u); break; } }
    }
    nloc = mine > 0u ? mine : 1u; nx = cnt > 0u ? cnt : 1u;
}

__device__ __forceinline__ void xcd_barrier(const XcdBarrier& b) {
    asm volatile("s_waitcnt vmcnt(0)" ::: "memory");
    __syncthreads();
    if (threadIdx.x == 0) {
        unsigned* bar = b.bar;
        __builtin_amdgcn_s_waitcnt(0);
        unsigned nloc = b.st[0], nx = b.st[1];
        if (nloc == 0u) { xcd_barrier_complete(bar, b.x, nloc, nx); b.st[0] = nloc; b.st[1] = nx; }
        const unsigned old = xb_add(&bar[XB_XSUB(b.x)], 1u);
        const unsigned gen = old / nloc;
        if (old + 1u == (gen + 1u) * nloc) {
            __builtin_amdgcn_fence(__ATOMIC_RELEASE, "agent");
            asm volatile("s_waitcnt vmcnt(0)" ::: "memory");
            const unsigned og = xb_add(&bar[XB_TOP], 1u);
            const unsigned tg = og / nx;
            if (og + 1u == (tg + 1u) * nx) xb_add(&bar[XB_TOPGEN], 1u);
            else XB_SPIN(xb_ld(&bar[XB_TOPGEN]) == tg, bar);
            __builtin_amdgcn_fence(__ATOMIC_ACQUIRE, "agent");
            xb_add(&bar[XB_XGEN(b.x)], 1u);
            asm volatile("s_waitcnt vmcnt(0)" ::: "memory");
        } else {
            XB_SPIN(xb_ld(&bar[XB_XGEN(b.x)]) == gen, bar);
            __builtin_amdgcn_fence(__ATOMIC_ACQUIRE, "agent");
            asm volatile("s_waitcnt vmcnt(0)" ::: "memory");
        }
    }
    __syncthreads();
}

struct Frame {
    LAS unsigned char* lds;
    volatile LAS unsigned* MISC;
    gu32* ctl;
    int tid, lane, wave, vcu, G, bx;
    int gw, NGW;
};
__device__ __forceinline__ bool refresh(Frame& F) {
    int t = threadIdx.x; asm volatile("" : "+v"(t)); F.tid = t; F.lane = t & 63; F.wave = __builtin_amdgcn_readfirstlane(t >> 6);
    int bx = blockIdx.x, G = gridDim.x; asm volatile("" : "+s"(bx), "+s"(G)); F.bx = bx; F.G = G;
    F.vcu = (G % 8 == 0) ? (bx % 8) * (G / 8) + bx / 8 : bx; F.gw = F.vcu * NWAVES + F.wave; F.NGW = G * NWAVES; return true; }
__device__ __forceinline__ float wave_sum(float v) {
#pragma unroll
    for (int o = 1; o < 64; o <<= 1) v += __shfl_xor(v, o);
    return v;
}
template <int MAP> __device__ __forceinline__ int rowmap(int n) {
    if (MAP == 1) { const int f = n >> 1; return 256 * (f >> 7) + 128 * (n & 1) + (f & 127); }
    if (MAP == 2 || MAP == 3) { const int tl = n >> 8, hh = (n >> 6) & 3, d = n & 63; int bj, j;
        const bool axial = (MAP == 2) && (tl < 2 || (tl == 2 && hh < 2));
        if (axial) { bj = (d >> 4) & 1; j = (d & 15) + ((d >> 5) << 4); } else { bj = d >> 5; j = d & 31; }
        return 256 * tl + 128 * bj + 32 * hh + j; }
    return n; }
struct TrTile { const float* W; bf16* WT; const float* gain; int K, N, k0, n0; };
__device__ __forceinline__ void tr_load(const TrTile& t, f32x4 (&v)[16], int lane) {
    const float* src = t.W + (size_t)(t.k0 + (lane >> 4)) * t.N + t.n0 + 4 * (lane & 15);
#pragma unroll
    for (int i = 0; i < 16; ++i) v[i] = *(const f32x4*)(src + (size_t)(4 * i) * t.N);
}
template <int MAP> __device__ __forceinline__ void tr_store(const TrTile& t, f32x4 (&v)[16], LAS float* scr, int lane) {
    const int lr = lane >> 4, lc = lane & 15;
    if (t.gain) {
#pragma unroll
        for (int i = 0; i < 16; ++i) v[i] *= t.gain[t.k0 + 4 * i + lr]; }
#pragma unroll
    for (int i = 0; i < 16; ++i) { LAS float* p = scr + (4 * i + lr) * 65 + 4 * lc; p[0] = v[i].x; p[1] = v[i].y; p[2] = v[i].z; p[3] = v[i].w; }
    LDS_WAIT(); asm volatile("" ::: "memory");
    const int c = lane & 7;
#pragma unroll
    for (int j = 0; j < 8; ++j) { const int n = 8 * j + (lane >> 3); const LAS float* s = scr + (8 * c) * 65 + n;
        v4u o; o.x = pk2(s[0 * 65], s[1 * 65]); o.y = pk2(s[2 * 65], s[3 * 65]); o.z = pk2(s[4 * 65], s[5 * 65]); o.w = pk2(s[6 * 65], s[7 * 65]);
        *(GAS v4u*)(t.WT + (size_t)rowmap<MAP>(t.n0 + n) * t.K + t.k0 + 8 * c) = o; }
    LDS_WAIT(); asm volatile("" ::: "memory");
}
template <int MAP> __device__ __forceinline__ void transpose_family(Frame& F, const float* W, size_t sW, bf16* WT, size_t sWT, const float* gain, int sG, int K, int N, int nmat, int gdiv) {
    LAS float* scr = (LAS float*)(F.lds + RING_OFF) + F.wave * (128 * 33);
    const int nb = N / 64, per = (K / 64) * nb, total = per * nmat;
    f32x4 va[16], vb[16];
    int it = F.gw; if (it >= total) return;
    TrTile ta, tb;
#define TR_SETUP(tt, item) do { const int mi = (item) / per, r = (item) % per; tt.W = W + (size_t)mi * sW; tt.WT = WT + (size_t)mi * sWT; tt.gain = gain ? gain + (size_t)(mi / gdiv) * sG : nullptr; tt.K = K; tt.N = N; tt.k0 = 64 * (r / nb); tt.n0 = 64 * (r % nb); } while (0)
    TR_SETUP(ta, it); tr_load(ta, va, F.lane);
    for (;;) {
        const int it2 = it + F.NGW; const bool h2 = it2 < total;
        if (h2) { TR_SETUP(tb, it2); tr_load(tb, vb, F.lane); }
        tr_store<MAP>(ta, va, scr, F.lane);
        if (!h2) break;
        const int it3 = it2 + F.NGW; const bool h3 = it3 < total;
        if (h3) { TR_SETUP(ta, it3); tr_load(ta, va, F.lane); }
        tr_store<MAP>(tb, vb, scr, F.lane);
        if (!h3) break;
        it = it3;
    }
#undef TR_SETUP
}
__device__ __forceinline__ void tr8_load(const TrTile& t, f32x4 (&v)[16], int lane) {
    const float* src = t.W + (size_t)(t.k0 + (lane >> 3)) * t.N + t.n0 + 4 * (lane & 7);
#pragma unroll
    for (int i = 0; i < 16; ++i) v[i] = *(const f32x4*)(src + (size_t)(8 * i) * t.N);
}
template <int MAP> __device__ __forceinline__ void tr8_store(const TrTile& t, f32x4 (&v)[16], LAS float* scr, int lane) {
    const int lr = lane >> 3, lc = lane & 7; const float sc = (float)(1 << F8_WSC);
#pragma unroll
    for (int i = 0; i < 16; ++i) { const float g = t.gain ? t.gain[t.k0 + 8 * i + lr] * sc : sc; LAS float* p = scr + (8 * i + lr) * 33 + 4 * lc; p[0] = v[i].x * g; p[1] = v[i].y * g; p[2] = v[i].z * g; p[3] = v[i].w * g; }
    LDS_WAIT(); asm volatile("" ::: "memory");
    const int c = lane & 7;
#pragma unroll
    for (int j = 0; j < 4; ++j) { const int n = 8 * j + (lane >> 3); const LAS float* s = scr + (16 * c) * 33 + n;
        v4u o; o.x = pk4_fp8(s[0 * 33], s[1 * 33], s[2 * 33], s[3 * 33]); o.y = pk4_fp8(s[4 * 33], s[5 * 33], s[6 * 33], s[7 * 33]); o.z = pk4_fp8(s[8 * 33], s[9 * 33], s[10 * 33], s[11 * 33]); o.w = pk4_fp8(s[12 * 33], s[13 * 33], s[14 * 33], s[15 * 33]);
        *(GAS v4u*)((unsigned char*)t.WT + (size_t)rowmap<MAP>(t.n0 + n) * t.K + t.k0 + 16 * c) = o; }
    LDS_WAIT(); asm volatile("" ::: "memory");
}
template <int MAP> __device__ __forceinline__ void transpose_family_f8(Frame& F, const float* W, size_t sW, unsigned char* WT, size_t sWT, const float* gain, int sG, int K, int N, int nmat, int gdiv) {
    LAS float* scr = (LAS float*)(F.lds + RING_OFF) + F.wave * (128 * 33);
    const int nb = N / 32, per = (K / 128) * nb, total = per * nmat;
    f32x4 va[16], vb[16];
    int it = F.gw; if (it >= total) return;
    TrTile ta, tb;
#define TR_SETUP(tt, item) do { const int mi = (item) / per, r = (item) % per; tt.W = W + (size_t)mi * sW; tt.WT = (bf16*)(WT + (size_t)mi * sWT); tt.gain = gain ? gain + (size_t)(mi / gdiv) * sG : nullptr; tt.K = K; tt.N = N; tt.k0 = 128 * (r / nb); tt.n0 = 32 * (r % nb); } while (0)
    TR_SETUP(ta, it); tr8_load(ta, va, F.lane);
    for (;;) {
        const int it2 = it + F.NGW; const bool h2 = it2 < total;
        if (h2) { TR_SETUP(tb, it2); tr8_load(tb, vb, F.lane); }
        tr8_store<MAP>(ta, va, scr, F.lane);
        if (!h2) break;
        const int it3 = it2 + F.NGW; const bool h3 = it3 < total;
        if (h3) { TR_SETUP(ta, it3); tr8_load(ta, va, F.lane); }
        tr8_store<MAP>(tb, vb, scr, F.lane);
        if (!h3) break;
        it = it3;
    }
#undef TR_SETUP
}
__device__ __forceinline__ float rope_freq(int i, int half_dim) { return exp2f(-(float)i / (float)half_dim * LOG2_THETA); }

__device__ __forceinline__ void attn_phase_l0(Frame& F, const bf16* Q3, const bf16* K3, const bf16* V3, bf16* OCAT, const float* sink) {
    char* shm = (char*)(F.lds + RING_OFF);
    const int upc = (512 + F.G - 1) / F.G;
    for (int i = 0; i < upc; ++i) { const int u = F.vcu * upc + i; if (u >= 512) break;
        const int bhk = u >> 7, b = bhk >> 1, hkv = bhk & 1, hq = hkv * 4 + ((u & 127) >> 5), qb = u & 31; const size_t r0 = (size_t)b * SEQ + qb * 256;
        attn_body::attn_unit<0, 1024, 8>((const attn_body::bf16*)(Q3 + r0 * 512 + hq * 64), (const attn_body::bf16*)(K3 + (size_t)b * SEQ * 128 + hkv * 64), (const attn_body::bf16*)(V3 + (size_t)b * SEQ * 128 + hkv * 64),
                                        (attn_body::bf16*)(OCAT + r0 * D + hq * 64), SEQ / 64, 0, 0, 0.f, false, nullptr, shm); }
    const bf16* Qb = Q3 + (size_t)T * 512; const bf16* Kb = K3 + (size_t)T * 128; const bf16* Vb = V3 + (size_t)T * 128;
    for (int i = 0; i < upc; ++i) { const int u = F.vcu * upc + i; if (u >= 512) break;
        const int bhk = u >> 7, b = bhk >> 1, hkv = bhk & 1, hq = hkv * 4 + ((u & 127) >> 5), qb = u & 31; const size_t r0 = (size_t)b * SEQ + qb * 256;
        const int tl = max(qb * 4 - 2, 0), th = min(qb * 4 + 6, SEQ / 64); const size_t k0 = (size_t)b * SEQ + tl * 64;
        attn_body::attn_unit<1, 1024, 8>((const attn_body::bf16*)(Qb + r0 * 512 + hq * 64), (const attn_body::bf16*)(Kb + k0 * 128 + hkv * 64), (const attn_body::bf16*)(Vb + k0 * 128 + hkv * 64),
                                        (attn_body::bf16*)(OCAT + r0 * D + 512 + hq * 64), th - tl, tl * 64 - qb * 256, 128, sink[hq] * 1.4426950408889634f, true, nullptr, shm); }
}
__device__ __forceinline__ void attn_phase_l1(Frame& F, const bf16* Q3, const bf16* K3, const bf16* V3, bf16* OGB, float* LSE) {
    char* shm = (char*)(F.lds + RING_OFF);
    const int upc = (512 + F.G - 1) / F.G;
#pragma unroll 1
    for (int g = 0; g < 3; ++g) { const int Lc = SEQ >> (2 * g);
        for (int i = 0; i < upc; ++i) { const int u = F.vcu * upc + i; if (u >= 512) break;
            const int bhk = u >> 7, b = bhk >> 1, hkv = bhk & 1, hq = hkv * 4 + ((u & 127) >> 5), qb = u & 31; const size_t r0 = (size_t)b * SEQ + qb * 256;
            const int q0 = qb * 256, cbase = q0 & ~(Lc - 1), lq0 = q0 & (Lc - 1); const int tl = min(max(lq0 / 64 - 1, 0), Lc / 64 - 6); const size_t k0 = (size_t)b * SEQ + cbase + tl * 64;
            attn_body::attn_unit<1, 512, 8>((const attn_body::bf16*)(Q3 + (size_t)g * T * 512 + r0 * 512 + hq * 64), (const attn_body::bf16*)(K3 + (size_t)g * T * 128 + k0 * 128 + hkv * 64), (const attn_body::bf16*)(V3 + (size_t)g * T * 128 + k0 * 128 + hkv * 64),
                                           (attn_body::bf16*)(OGB + (size_t)g * T * 512 + r0 * 512 + hq * 64), 6, cbase + tl * 64 - q0, 64, 0.f, false, LSE + (size_t)g * T * 8 + r0 * 8 + hq, shm); }
    }
}
__device__ __forceinline__ void merge_phase(Frame& F, const bf16* OGB, const float* LSE, bf16* OCAT1) {
    for (int m = F.gw; m < T; m += F.NGW) {
        const int h = F.lane >> 3; const int b = m / SEQ, pos = m % SEQ;
        const size_t r0 = m, r1 = (size_t)b * SEQ + (size_t)(pos & 3) * (SEQ / 4) + (pos >> 2), r2 = (size_t)b * SEQ + (size_t)(pos & 15) * (SEQ / 16) + (pos >> 4);
        const float l0 = LSE[r0 * 8 + h], l1 = LSE[(size_t)T * 8 + r1 * 8 + h], l2 = LSE[(size_t)2 * T * 8 + r2 * 8 + h];
        const float mx = fmaxf(l0, fmaxf(l1, l2)); float w0 = __expf(l0 - mx), w1 = __expf(l1 - mx), w2 = __expf(l2 - mx); const float is = 1.f / (w0 + w1 + w2); w0 *= is; w1 *= is; w2 *= is;
        const v4u a = *(const v4u*)(OGB + r0 * 512 + F.lane * 8), bb = *(const v4u*)(OGB + (size_t)T * 512 + r1 * 512 + F.lane * 8), c = *(const v4u*)(OGB + (size_t)2 * T * 512 + r2 * 512 + F.lane * 8);
        v4u w;
        w.x = pk2(w0 * bflo(a.x) + w1 * bflo(bb.x) + w2 * bflo(c.x), w0 * bfhi(a.x) + w1 * bfhi(bb.x) + w2 * bfhi(c.x));
        w.y = pk2(w0 * bflo(a.y) + w1 * bflo(bb.y) + w2 * bflo(c.y), w0 * bfhi(a.y) + w1 * bfhi(bb.y) + w2 * bfhi(c.y));
        w.z = pk2(w0 * bflo(a.z) + w1 * bflo(bb.z) + w2 * bflo(c.z), w0 * bfhi(a.z) + w1 * bfhi(bb.z) + w2 * bfhi(c.z));
        w.w = pk2(w0 * bflo(a.w) + w1 * bflo(bb.w) + w2 * bflo(c.w), w0 * bfhi(a.w) + w1 * bfhi(bb.w) + w2 * bfhi(c.w));
        *(v4u*)(OCAT1 + (size_t)m * C_OUT + F.lane * 8) = w;
    }
}

typedef float f32x4m __attribute__((ext_vector_type(4)));
__device__ __forceinline__ void top4_merge(float (&v)[4], int (&ix)[4], int mask) {
    float ov[4]; int oi[4];
#pragma unroll
    for (int k = 0; k < 4; ++k) { ov[k] = __shfl_xor(v[k], mask); oi[k] = __shfl_xor(ix[k], mask); }
    float cv[8]; int ci[8];
#pragma unroll
    for (int k = 0; k < 4; ++k) { cv[k] = v[k]; ci[k] = ix[k]; cv[4 + k] = ov[k]; ci[4 + k] = oi[k]; }
    unsigned used = 0u;
#pragma unroll
    for (int k = 0; k < 4; ++k) { float best = -INFINITY; int bi = 1 << 30, bp = 0;
#pragma unroll
        for (int c = 0; c < 8; ++c) { const bool take = !((used >> c) & 1u) && (cv[c] > best || (cv[c] == best && ci[c] < bi)); best = take ? cv[c] : best; bi = take ? ci[c] : bi; bp = take ? c : bp; }
        used |= 1u << bp; v[k] = best; ix[k] = bi; }
}
__device__ __forceinline__ void route_phase(Frame& F, const bf16* H, const float* WR, const float* rb, gu32* cnt, int* TOPE, float* TOPG, int* TOPPOS, float* RSTD) {
    LAS float* WL = (LAS float*)(F.lds + RING_OFF);
    for (int i = F.tid; i < NE * D / 4; i += NWAVES * 64) { const int e = i >> 8, k4 = i & 255; *(LAS f32x4*)(WL + e * 1028 + 4 * k4) = *(const f32x4*)(WR + (size_t)e * D + 4 * k4); }
    __syncthreads();
    const int lane = F.lane, c = lane & 15, q = lane >> 4;
    for (int task = F.wave * F.G + F.vcu; task < T / 16; task += F.NGW) {
        const bf16* xr = H + (size_t)(task * 16 + c) * D + 8 * q;
        const LAS float* w0 = WL + c * 1028 + 8 * q; const LAS float* w1 = w0 + 16 * 1028;
        f32x4m a0 = {0.f, 0.f, 0.f, 0.f}, a1 = {0.f, 0.f, 0.f, 0.f}; float ssq = 0.f;
#pragma unroll 4
        for (int ch = 0; ch < 32; ++ch) {
            const v4u xv = *(const v4u*)(xr + 32 * ch);
            float xf[8]; xf[0] = bflo(xv.x); xf[1] = bfhi(xv.x); xf[2] = bflo(xv.y); xf[3] = bfhi(xv.y); xf[4] = bflo(xv.z); xf[5] = bfhi(xv.z); xf[6] = bflo(xv.w); xf[7] = bfhi(xv.w);
            const f32x4 wa0 = *(const LAS f32x4*)(w0 + 32 * ch), wa1 = *(const LAS f32x4*)(w0 + 32 * ch + 4), wb0 = *(const LAS f32x4*)(w1 + 32 * ch), wb1 = *(const LAS f32x4*)(w1 + 32 * ch + 4);
#pragma unroll
            for (int t = 0; t < 8; ++t) ssq += xf[t] * xf[t];
            a0 = __builtin_amdgcn_mfma_f32_16x16x4f32(wa0.x, xf[0], a0, 0, 0, 0); a1 = __builtin_amdgcn_mfma_f32_16x16x4f32(wb0.x, xf[0], a1, 0, 0, 0);
            a0 = __builtin_amdgcn_mfma_f32_16x16x4f32(wa0.y, xf[1], a0, 0, 0, 0); a1 = __builtin_amdgcn_mfma_f32_16x16x4f32(wb0.y, xf[1], a1, 0, 0, 0);
            a0 = __builtin_amdgcn_mfma_f32_16x16x4f32(wa0.z, xf[2], a0, 0, 0, 0); a1 = __builtin_amdgcn_mfma_f32_16x16x4f32(wb0.z, xf[2], a1, 0, 0, 0);
            a0 = __builtin_amdgcn_mfma_f32_16x16x4f32(wa0.w, xf[3], a0, 0, 0, 0); a1 = __builtin_amdgcn_mfma_f32_16x16x4f32(wb0.w, xf[3], a1, 0, 0, 0);
            a0 = __builtin_amdgcn_mfma_f32_16x16x4f32(wa1.x, xf[4], a0, 0, 0, 0); a1 = __builtin_amdgcn_mfma_f32_16x16x4f32(wb1.x, xf[4], a1, 0, 0, 0);
            a0 = __builtin_amdgcn_mfma_f32_16x16x4f32(wa1.y, xf[5], a0, 0, 0, 0); a1 = __builtin_amdgcn_mfma_f32_16x16x4f32(wb1.y, xf[5], a1, 0, 0, 0);
            a0 = __builtin_amdgcn_mfma_f32_16x16x4f32(wa1.z, xf[6], a0, 0, 0, 0); a1 = __builtin_amdgcn_mfma_f32_16x16x4f32(wb1.z, xf[6], a1, 0, 0, 0);
            a0 = __builtin_amdgcn_mfma_f32_16x16x4f32(wa1.w, xf[7], a0, 0, 0, 0); a1 = __builtin_amdgcn_mfma_f32_16x16x4f32(wb1.w, xf[7], a1, 0, 0, 0);
        }
        ssq += __shfl_xor(ssq, 16); ssq += __shfl_xor(ssq, 32);
        const float rstd = 1.f / sqrtf(ssq * (1.f / D) + NORM_EPS);
        float cv[8]; int ci[8];
#pragma unroll
        for (int r = 0; r < 4; ++r) { ci[r] = 4 * q + r; ci[4 + r] = 16 + 4 * q + r; cv[r] = a0[r] * rstd + rb[4 * q + r]; cv[4 + r] = a1[r] * rstd + rb[16 + 4 * q + r]; }
        float tv[4]; int ti[4]; unsigned used = 0u;
#pragma unroll
        for (int k = 0; k < 4; ++k) { float best = -INFINITY; int bi = 0, bp = 0;
#pragma unroll
            for (int j = 0; j < 8; ++j) { const bool take = !((used >> j) & 1u) && (cv[j] > best); best = take ? cv[j] : best; bi = take ? ci[j] : bi; bp = take ? j : bp; }
            used |= 1u << bp; tv[k] = best; ti[k] = bi; }
        top4_merge(tv, ti, 16); top4_merge(tv, ti, 32);
        const float e1 = __expf(tv[1] - tv[0]), e2 = __expf(tv[2] - tv[0]), e3 = __expf(tv[3] - tv[0]); const float is = 1.f / (1.f + e1 + e2 + e3);
        const int m = task * 16 + c;
        { const int e = q == 0 ? ti[0] : q == 1 ? ti[1] : q == 2 ? ti[2] : ti[3]; const float g = (q == 0 ? 1.f : q == 1 ? e1 : q == 2 ? e2 : e3) * is;
            const unsigned pos = __hip_atomic_fetch_add(cnt + e, 1u, RLX_AGENT);
            TOPE[m * 4 + q] = e; TOPG[m * 4 + q] = g; TOPPOS[m * 4 + q] = (int)pos; }
        if (q == 0) RSTD[m] = rstd;
    }
    __syncthreads();
}
__device__ __forceinline__ void slot_phase(Frame& F, const bf16* H, gu32* cnt, const int* TOPE, const float* TOPG, const int* TOPPOS, const float* RSTD, int* TOKSLOT, float* SLOTGATE, float* SLOTRS, bf16* XG, int* XTAB, bool f8) {
    LAS int* L = (LAS int*)(F.lds + RING_OFF);
    const int lane = F.lane;
    if (F.wave == 0) {
        const int np = (lane < 32) ? (((int)__hip_atomic_load(cnt + (lane & 31), RLX_AGENT) + 255) >> 8) : 0;
        int pre = np;
#pragma unroll
        for (int o = 1; o < 32; o <<= 1) { const int t = __shfl_up(pre, o); if (lane >= o) pre += t; }
        const int p0 = pre - np;
        if (lane < 32) { L[lane] = np; L[32 + lane] = p0 * 256; }
        if (F.bx == 0) {
            int load = 0, ne = 0, cump = 0; bool done = (lane >= 32);
            for (int it = 0; it < 32; ++it) {
                int key = done ? -1 : (np * 64 + (31 - lane));
#pragma unroll
                for (int o = 1; o < 64; o <<= 1) key = max(key, __shfl_xor(key, o));
                const int be = 31 - (key & 63), bn = key >> 6;
                int lk = (lane < 8) ? (load * 8 + lane) : (1 << 30);
#pragma unroll
                for (int o = 1; o < 64; o <<= 1) lk = min(lk, __shfl_xor(lk, o));
                const int bx = lk & 7;
                const int bp0 = __shfl(p0, be);
                if (lane == bx) { int* tb = XTAB + bx * 136 + 4 + 4 * ne; tb[0] = be; tb[1] = bp0; tb[2] = bn; tb[3] = cump; cump += bn; load += bn; ++ne; }
                if (lane == be) done = true;
            }
            if (lane < 8) { XTAB[lane * 136] = ne; XTAB[lane * 136 + 1] = cump; }
        }
    }
    __syncthreads();
    for (int m = F.gw; m < T; m += F.NGW) {
        int slot = 0;
        if (lane < 4) { const int e = TOPE[m * 4 + lane]; slot = L[32 + e] + TOPPOS[m * 4 + lane]; TOKSLOT[m * 4 + lane] = slot; SLOTGATE[slot] = TOPG[m * 4 + lane]; SLOTRS[slot] = RSTD[m]; }
        const int s0 = __shfl(slot, 0), s1 = __shfl(slot, 1), s2 = __shfl(slot, 2), s3 = __shfl(slot, 3);
        if (f8) {
            const bf16* src = H + (size_t)m * D + lane * 16; const v4u a = *(const v4u*)src, b = *(const v4u*)(src + 8); const float rs = RSTD[m];
            v4u w; w.x = pk4_fp8(clamp448(bflo(a.x) * rs), clamp448(bfhi(a.x) * rs), clamp448(bflo(a.y) * rs), clamp448(bfhi(a.y) * rs)); w.y = pk4_fp8(clamp448(bflo(a.z) * rs), clamp448(bfhi(a.z) * rs), clamp448(bflo(a.w) * rs), clamp448(bfhi(a.w) * rs));
            w.z = pk4_fp8(clamp448(bflo(b.x) * rs), clamp448(bfhi(b.x) * rs), clamp448(bflo(b.y) * rs), clamp448(bfhi(b.y) * rs)); w.w = pk4_fp8(clamp448(bflo(b.z) * rs), clamp448(bfhi(b.z) * rs), clamp448(bflo(b.w) * rs), clamp448(bfhi(b.w) * rs));
            unsigned char* X8 = (unsigned char*)XG; const size_t co = (size_t)lane * 16;
            *(v4u*)(X8 + (size_t)s0 * D + co) = w; *(v4u*)(X8 + (size_t)s1 * D + co) = w; *(v4u*)(X8 + (size_t)s2 * D + co) = w; *(v4u*)(X8 + (size_t)s3 * D + co) = w;
        } else {
        const bf16* src = H + (size_t)m * D + lane * 8; const v4u a = *(const v4u*)src, b = *(const v4u*)(src + 512);
        const size_t co = (size_t)lane * 8;
        *(v4u*)(XG + (size_t)s0 * D + co) = a; *(v4u*)(XG + (size_t)s0 * D + co + 512) = b;
        *(v4u*)(XG + (size_t)s1 * D + co) = a; *(v4u*)(XG + (size_t)s1 * D + co + 512) = b;
        *(v4u*)(XG + (size_t)s2 * D + co) = a; *(v4u*)(XG + (size_t)s2 * D + co + 512) = b;
        *(v4u*)(XG + (size_t)s3 * D + co) = a; *(v4u*)(XG + (size_t)s3 * D + co + 512) = b;
        }
    }
    __syncthreads();
}
__device__ __forceinline__ void combine_phase(Frame& F, const bf16* HM, const bf16* Y, const int* TOKSLOT, bf16* H2) {
    const int lane = F.lane;
    for (int m = F.gw; m < T; m += F.NGW) {
        const int s0 = TOKSLOT[m * 4], s1 = TOKSLOT[m * 4 + 1], s2 = TOKSLOT[m * 4 + 2], s3 = TOKSLOT[m * 4 + 3];
#pragma unroll
        for (int j = 0; j < 2; ++j) { const size_t co = (size_t)j * 512 + lane * 8; const v4u h = *(const v4u*)(HM + (size_t)m * D + co);
            const v4u y0 = *(const v4u*)(Y + (size_t)s0 * D + co), y1 = *(const v4u*)(Y + (size_t)s1 * D + co), y2 = *(const v4u*)(Y + (size_t)s2 * D + co), y3 = *(const v4u*)(Y + (size_t)s3 * D + co);
            v4u w;
            w.x = pk2(bflo(h.x) + (((bflo(y0.x) + bflo(y1.x)) + bflo(y2.x)) + bflo(y3.x)), bfhi(h.x) + (((bfhi(y0.x) + bfhi(y1.x)) + bfhi(y2.x)) + bfhi(y3.x)));
            w.y = pk2(bflo(h.y) + (((bflo(y0.y) + bflo(y1.y)) + bflo(y2.y)) + bflo(y3.y)), bfhi(h.y) + (((bfhi(y0.y) + bfhi(y1.y)) + bfhi(y2.y)) + bfhi(y3.y)));
            w.z = pk2(bflo(h.z) + (((bflo(y0.z) + bflo(y1.z)) + bflo(y2.z)) + bflo(y3.z)), bfhi(h.z) + (((bfhi(y0.z) + bfhi(y1.z)) + bfhi(y2.z)) + bfhi(y3.z)));
            w.w = pk2(bflo(h.w) + (((bflo(y0.w) + bflo(y1.w)) + bflo(y2.w)) + bflo(y3.w)), bfhi(h.w) + (((bfhi(y0.w) + bfhi(y1.w)) + bfhi(y2.w)) + bfhi(y3.w)));
            *(v4u*)(H2 + (size_t)m * D + co) = w; }
    }
}
__device__ __forceinline__ void final_norm_phase(Frame& F, const bf16* H, const float* SS, const float* gain, float* out) {
    const int lane = F.lane;
    for (int m = F.gw; m < T; m += F.NGW) {
        const float rstd = 1.f / sqrtf(ssp_sum(SS + (size_t)m * 16) * (1.f / D) + NORM_EPS);
#pragma unroll
        for (int j = 0; j < 2; ++j) { const size_t co = (size_t)j * 512 + lane * 8; const v4u h = *(const v4u*)(H + (size_t)m * D + co); const f32x4 g0 = *(const f32x4*)(gain + co), g1 = *(const f32x4*)(gain + co + 4);
            f32x4 o0, o1; o0.x = bflo(h.x) * rstd * g0.x; o0.y = bfhi(h.x) * rstd * g0.y; o0.z = bflo(h.y) * rstd * g0.z; o0.w = bfhi(h.y) * rstd * g0.w;
            o1.x = bflo(h.z) * rstd * g1.x; o1.y = bfhi(h.z) * rstd * g1.y; o1.z = bflo(h.w) * rstd * g1.z; o1.w = bfhi(h.w) * rstd * g1.w;
            float* dst = out + (size_t)m * D + co; *(f32x4*)dst = o0; *(f32x4*)(dst + 4) = o1; }
    }
}

constexpr int N_PHASES = 22;
struct Args { const float* in[20]; float* out; unsigned char* ws; int ph_lo, ph_hi, li, pad; };
typedef const __attribute__((address_space(4))) Args* argp_t;
__device__ __forceinline__ argp_t opaque_args() { argp_t p = (argp_t)__builtin_amdgcn_kernarg_segment_ptr(); asm volatile("" : "+s"(p)); return p; }
#define AP (opaque_args())
__global__ void __launch_bounds__(NWAVES * 64, 2) fwd_kernel(Args args_unused) {
    extern __shared__ __attribute__((aligned(16))) unsigned char lds[];
    Frame F;
    F.lds = (LAS unsigned char*)lds;
    F.MISC = (volatile LAS unsigned*)(F.lds + MISC_OFF);
    refresh(F);
    F.ctl = (gu32*)(AP->ws + WS_CTL);
    if (F.tid < 128) ((LAS unsigned*)(F.lds + LDSCTL_OFF))[F.tid] = 0u;
    __syncthreads();
    const bool one_phase = (AP->ph_hi - AP->ph_lo) == 1;
    XcdBarrier bar; bar.bar = (unsigned*)(F.ctl + CW_BAR); bar.x = 0; bar.st = nullptr;
    if (!one_phase) bar = xcd_barrier_post((unsigned*)(F.ctl + CW_BAR), F.MISC + 8);
    const int lo = AP->ph_lo, hi = AP->ph_hi;
#ifndef MK_MASK
#define MK_MASK 0x3fff
#endif
#ifndef PROBE_MASK
#define PROBE_MASK 0
#endif
#define IN(k) (lo <= (k) && (k) < hi)
#define INL(j) (((MK_MASK >> (j)) & 1) && IN(pb + (j)) && refresh(F))
#define REP(j) _Pragma("unroll") for (int rep_ = 0; rep_ < (((PROBE_MASK >> (j)) & 1) ? 2 : 1); ++rep_)
#define SEAM(k) do { if (IN((k) + 1)) xcd_barrier(bar); } while (0)
#define ws (AP->ws)
#define WSP(type, off) ((type*)(ws + (off)))
    if (((MK_MASK >> 12) & 1) && IN(0) && refresh(F)) REP(12) {
#pragma unroll 1
        for (int ll = 0; ll < 2; ++ll) {
            const float* wu = AP->in[13] + (size_t)ll * NE * D * 2 * DE; const float* wd = AP->in[15] + (size_t)ll * NE * DE * D; const float* gf = AP->in[10] + ll * D;
            unsigned char* du = ws + WS_WUPT + (size_t)ll * NE * 2 * DE * D * 2; unsigned char* dd = ws + WS_WDNT + (size_t)ll * NE * D * DE * 2;
#if MOE_FP8_MASK != 0
            if ((MOE_FP8_MASK >> ll) & 1) {
                transpose_family_f8<1>(F, wu, (size_t)D * 2 * DE, du, (size_t)2 * DE * D, gf, 0, D, 2 * DE, NE, 1);
                transpose_family_f8<0>(F, wd, (size_t)DE * D, dd, (size_t)D * DE, nullptr, 0, DE, D, NE, 1);
            }
#endif
#if MOE_FP8_MASK != 3
            if (!((MOE_FP8_MASK >> ll) & 1)) {
                transpose_family<1>(F, wu, (size_t)D * 2 * DE, (bf16*)du, (size_t)2 * DE * D, gf, 0, D, 2 * DE, NE, 1);
                transpose_family<0>(F, wd, (size_t)DE * D, (bf16*)dd, (size_t)D * DE, nullptr, 0, DE, D, NE, 1);
            }
#endif
        }
        transpose_family<2>(F, AP->in[3], 0, WSP(bf16, WS_WIN0T), 0, AP->in[2], 0, D, AB_IN, 1, 1);
        transpose_family<3>(F, AP->in[8], 0, WSP(bf16, WS_WIN1T), 0, AP->in[2] + D, 0, D, C_IN, 1, 1);
        transpose_family<0>(F, AP->in[7], 0, WSP(bf16, WS_WOUT0T), 0, nullptr, 0, D, D, 1, 1);
        transpose_family<0>(F, AP->in[9], 0, WSP(bf16, WS_WOUT1T), 0, nullptr, 0, C_OUT, D, 1, 1);
        transpose_family<0>(F, AP->in[18], (size_t)D * D, WSP(bf16, WS_WGT), (size_t)D * D, nullptr, 0, D, D, 2, 1);
        transpose_family<0>(F, AP->in[17], (size_t)PLE * D, WSP(bf16, WS_WPT), (size_t)D * PLE, nullptr, 0, PLE, D, 2, 1);
        {
            float* WR = WSP(float, WS_WR); const float* nf = AP->in[10]; const float* rw = AP->in[11];
            for (int i = F.gw * 64 + F.lane; i < 2 * NE * D; i += F.NGW * 64) { const int l = i / (NE * D), e = (i / D) % NE, k = i % D; WR[i] = nf[l * D + k] * rw[((size_t)l * D + k) * NE + e]; }
        }
        {
            float* R1 = WSP(float, WS_ROPE1); float* RA = WSP(float, WS_ROPEA);
            for (int i = F.gw * 64 + F.lane; i < SEQ * 32; i += F.NGW * 64) { const int pos = i >> 5, j = i & 31;
                const float a1 = (float)pos * rope_freq(j, 32); R1[2 * i] = cosf(a1); R1[2 * i + 1] = sinf(a1);
                const float aa = (float)((j < 16) ? (pos >> 6) : (pos & 63)) * rope_freq(j & 15, 16); RA[2 * i] = cosf(aa); RA[2 * i + 1] = sinf(aa); }
        }
        {
            bf16* PBF = WSP(bf16, WS_PBF); const float* p_in = AP->in[1]; const size_t n8 = (size_t)2 * T * PLE / 8;
            for (size_t i = (size_t)F.gw * 64 + F.lane; i < n8; i += (size_t)F.NGW * 64) { const f32x4 a = *(const f32x4*)(p_in + i * 8), b = *(const f32x4*)(p_in + i * 8 + 4);
                v4u w; w.x = pk2(a.x, a.y); w.y = pk2(a.z, a.w); w.z = pk2(b.x, b.y); w.w = pk2(b.z, b.w); *(v4u*)(PBF + i * 8) = w; }
        }
        {
            bf16* X0 = WSP(bf16, WS_X0); float* SS0 = WSP(float, WS_SSP); const float* x_in = AP->in[0];
            for (int m = F.gw; m < T; m += F.NGW) { float s = 0.f;
#pragma unroll
                for (int j = 0; j < 2; ++j) { const size_t co = (size_t)m * D + j * 512 + F.lane * 8; const f32x4 a = *(const f32x4*)(x_in + co), b = *(const f32x4*)(x_in + co + 4);
                    v4u w; w.x = pk2(a.x, a.y); w.y = pk2(a.z, a.w); w.z = pk2(b.x, b.y); w.w = pk2(b.z, b.w); *(v4u*)(X0 + co) = w;
                    s += (bflo(w.x) * bflo(w.x) + bfhi(w.x) * bfhi(w.x)) + (bflo(w.y) * bflo(w.y) + bfhi(w.y) * bfhi(w.y)) + (bflo(w.z) * bflo(w.z) + bfhi(w.z) * bfhi(w.z)) + (bflo(w.w) * bflo(w.w) + bfhi(w.w) * bfhi(w.w)); }
                s = wave_sum(s); if (F.lane < 16) SS0[(size_t)m * 16 + F.lane] = (F.lane == 0) ? s : 0.f; }
        }
        __syncthreads();
        SEAM(0);
    }
#pragma unroll 1
    for (int l = 0; l < 2; ++l) {
        const int pb = 1 + 10 * l;
        if (INL(0)) REP(0) {
            const bf16* hin = (l == 0) ? WSP(bf16, WS_X0) : WSP(bf16, WS_H3);
            const float* ssin = WSP(float, WS_SSP) + (size_t)l * T * 16;
            if (l == 0) { pg8::Gemm g{hin, WSP(bf16, WS_WIN0T), T, AB_IN, D}; pg8::StaticOrder S; S.init(T, AB_IN, F.G, F.bx);
                EpiQKV<0> E{ssin, AP->in[4], AP->in[5], WSP(float, WS_ROPE1), WSP(float, WS_ROPEA), WSP(bf16, WS_Q3), WSP(bf16, WS_K3), WSP(bf16, WS_V3)};
                pg8::gemm_phase<EpiQKV<0>, pg8::StaticOrder, true, true>(F.lds + RING_OFF, g, S, E); }
            else { pg8::Gemm g{hin, WSP(bf16, WS_WIN1T), T, C_IN, D}; pg8::StaticOrder S; S.init(T, C_IN, F.G, F.bx);
                EpiQKV<1> E{ssin, nullptr, nullptr, WSP(float, WS_ROPE1), WSP(float, WS_ROPEA), WSP(bf16, WS_Q3), WSP(bf16, WS_K3), WSP(bf16, WS_V3)};
                pg8::gemm_phase<EpiQKV<1>, pg8::StaticOrder, true, true>(F.lds + RING_OFF, g, S, E); }
            if (l == 0) { int Kp = PLE; asm volatile("" : "+s"(Kp)); pg8::Gemm g{WSP(bf16, WS_PBF), WSP(bf16, WS_WPT), 2 * T, 2 * D, Kp}; PPOrder S{(int)F.G, F.bx};
                EpiPP E{WSP(bf16, WS_PP)};
                pg8::gemm_phase<EpiPP, PPOrder, true, true>(F.lds + RING_OFF, g, S, E); }
            SEAM(pb + 0);
        }
        if (INL(1)) REP(1) {
            if (l == 0) attn_phase_l0(F, WSP(bf16, WS_Q3), WSP(bf16, WS_K3), WSP(bf16, WS_V3), WSP(bf16, WS_OCAT), AP->in[6]);
            else attn_phase_l1(F, WSP(bf16, WS_Q3), WSP(bf16, WS_K3), WSP(bf16, WS_V3), WSP(bf16, WS_OGB), WSP(float, WS_LSE));
            SEAM(pb + 1);
        }
        if (INL(2)) REP(2) { if (l == 1) merge_phase(F, WSP(bf16, WS_OGB), WSP(float, WS_LSE), WSP(bf16, WS_OCAT)); SEAM(pb + 2); }
        if (INL(3)) REP(3) {
            const bf16* hin = (l == 0) ? WSP(bf16, WS_X0) : WSP(bf16, WS_H3);
            pg8::Gemm g{WSP(bf16, WS_OCAT), (const bf16*)(ws + (l == 0 ? WS_WOUT0T : WS_WOUT1T)), T, D, (l == 0) ? D : C_OUT}; pg8::StaticOrder S; S.init(T, D, F.G, F.bx); EpiResBf16 E{hin, WSP(bf16, WS_HM)};
            pg8::gemm_phase<EpiResBf16, pg8::StaticOrder, true, true>(F.lds + RING_OFF, g, S, E);
            SEAM(pb + 3);
        }
        if (INL(4)) REP(4) { route_phase(F, WSP(bf16, WS_HM), WSP(float, WS_WR) + (size_t)l * NE * D, AP->in[12] + l * NE, F.ctl + CW_CNT + l * NE, WSP(int, WS_TOPE), WSP(float, WS_TOPG), WSP(int, WS_TOPPOS), WSP(float, WS_RSTD)); SEAM(pb + 4); }
        if (INL(5)) REP(5) { slot_phase(F, WSP(bf16, WS_HM), F.ctl + CW_CNT + l * NE, WSP(int, WS_TOPE), WSP(float, WS_TOPG), WSP(int, WS_TOPPOS), WSP(float, WS_RSTD), WSP(int, WS_TOKSLOT), WSP(float, WS_SLOTGATE), WSP(float, WS_SLOTRS), WSP(bf16, WS_XG), WSP(int, WS_XTAB), ((MOE_FP8_MASK >> l) & 1) != 0); SEAM(pb + 5); }
        if (INL(6)) REP(6) {
            XcdOrder<3> S{WSP(int, WS_XTAB) + (F.bx & 7) * 136, F.bx >> 3, (int)F.G >> 3};
#if MOE_FP8_MASK != 0
            if ((MOE_FP8_MASK >> l) & 1) { pg8::Gemm g{WSP(bf16, WS_XG), WSP(bf16, WS_WUPT) + (size_t)l * NE * 2 * DE * D, NSLOT, NE * 2 * DE, D / 2};
                EpiSwiglu<true> E{WSP(void, WS_ACT), AP->in[14] + (size_t)l * NE * 2 * DE, nullptr};
                pg8::gemm_phase<EpiSwiglu<true>, XcdOrder<3>, true, true, F8_DIAG ? 1000 : 127 - F8_WSC>(F.lds + RING_OFF, g, S, E); }
#endif
#if MOE_FP8_MASK != 3
            if (!((MOE_FP8_MASK >> l) & 1)) { pg8::Gemm g{WSP(bf16, WS_XG), WSP(bf16, WS_WUPT) + (size_t)l * NE * 2 * DE * D, NSLOT, NE * 2 * DE, D};
                EpiSwiglu<false> E{WSP(void, WS_ACT), AP->in[14] + (size_t)l * NE * 2 * DE, WSP(float, WS_SLOTRS)};
                pg8::gemm_phase<EpiSwiglu<false>, XcdOrder<3>, true, true>(F.lds + RING_OFF, g, S, E); }
#endif
            SEAM(pb + 6);
        }
        if (INL(7)) REP(7) {
            XcdOrder<2> S{WSP(int, WS_XTAB) + (F.bx & 7) * 136, F.bx >> 3, (int)F.G >> 3};
            EpiDown E{WSP(bf16, WS_Y), AP->in[16] + (size_t)l * NE * D, WSP(float, WS_SLOTGATE), ((MOE_FP8_MASK >> l) & 1) ? F8_EPI_SC : 1.f};
#if MOE_FP8_MASK != 0
            if ((MOE_FP8_MASK >> l) & 1) { pg8::Gemm g{WSP(bf16, WS_ACT), WSP(bf16, WS_WDNT) + (size_t)l * NE * D * DE, NSLOT, NE * D, DE / 2};
                pg8::gemm_phase<EpiDown, XcdOrder<2>, true, true, F8_DIAG ? 1000 : 127 - F8_WSC>(F.lds + RING_OFF, g, S, E); }
#endif
#if MOE_FP8_MASK != 3
            if (!((MOE_FP8_MASK >> l) & 1)) { pg8::Gemm g{WSP(bf16, WS_ACT), WSP(bf16, WS_WDNT) + (size_t)l * NE * D * DE, NSLOT, NE * D, DE};
                pg8::gemm_phase<EpiDown, XcdOrder<2>, true, true>(F.lds + RING_OFF, g, S, E); }
#endif
            SEAM(pb + 7);
        }
        if (INL(8)) REP(8) { combine_phase(F, WSP(bf16, WS_HM), WSP(bf16, WS_Y), WSP(int, WS_TOKSLOT), WSP(bf16, WS_H2)); SEAM(pb + 8); }
        if (INL(9)) REP(9) {
            pg8::Gemm g{WSP(bf16, WS_H2), WSP(bf16, WS_WGT) + (size_t)l * D * D, T, D, D}; pg8::StaticOrder S; S.init(T, D, F.G, F.bx);
            EpiPle E{WSP(bf16, WS_H2), WSP(bf16, WS_PP) + (size_t)l * T * D, WSP(bf16, WS_H3), WSP(float, WS_SSP) + (size_t)(l + 1) * T * 16};
            pg8::gemm_phase<EpiPle, pg8::StaticOrder, true, true>(F.lds + RING_OFF, g, S, E);
            SEAM(pb + 9);
        }
    }
    if (((MK_MASK >> 13) & 1) && IN(21) && refresh(F)) final_norm_phase(F, WSP(bf16, WS_H3), WSP(float, WS_SSP) + (size_t)2 * T * 16, AP->in[19], AP->out);
#undef IN
#undef INL
#undef REP
#undef SEAM
#undef ws
#undef WSP
}

#ifndef MK_ONE_LAUNCH
#define MK_ONE_LAUNCH 1
#endif
extern "C" void kernel_launch(void* const* d_in, const int* in_sizes, int n_in, void* d_out, int out_size, void* d_ws, size_t ws_size, hipStream_t stream) {
    static int grid = 0;
    if (grid == 0) {
        if (n_in != 20 || in_sizes[0] != T * D || out_size != T * D || ws_size < WS_END) { fprintf(stderr, "kernel_launch: unexpected shapes: n_in %d in0 %d out %d ws %zu (need %zu)\n", n_in, n_in > 0 ? in_sizes[0] : -1, out_size, ws_size, (size_t)WS_END); grid = -1; return; }
        int dev = 0, cus = 0, per_cu = 0;
        if (hipGetDevice(&dev) != hipSuccess || hipDeviceGetAttribute(&cus, hipDeviceAttributeMultiprocessorCount, dev) != hipSuccess) { grid = -1; return; }
        if (hipFuncSetAttribute((const void*)fwd_kernel, hipFuncAttributeMaxDynamicSharedMemorySize, LDS_BYTES) != hipSuccess) { fprintf(stderr, "kernel_launch: hipFuncSetAttribute failed\n"); grid = -1; return; }
        if (hipOccupancyMaxActiveBlocksPerMultiprocessor(&per_cu, (const void*)fwd_kernel, NWAVES * 64, LDS_BYTES) != hipSuccess || per_cu < 1) fprintf(stderr, "kernel_launch: occupancy query says %d\n", per_cu);
        (void)hipGetLastError();
        grid = cus;
        if (grid != 256) fprintf(stderr, "kernel_launch: %d CUs (built for 256)\n", grid);
    }
    if (grid < 0) return;
    if (hipMemsetAsync((char*)d_ws + WS_CTL, 0, CTL_ZERO_BYTES, stream) != hipSuccess) return;
    Args a{};
    for (int i = 0; i < 20; ++i) a.in[i] = (const float*)d_in[i];
    a.out = (float*)d_out; a.ws = (unsigned char*)d_ws;
#if MK_ONE_LAUNCH
    a.ph_lo = 0; a.ph_hi = N_PHASES; a.li = 0;
    hipLaunchKernelGGL(fwd_kernel, dim3(grid), dim3(NWAVES * 64), LDS_BYTES, stream, a);
#else
    for (int ph = 0; ph < N_PHASES; ++ph) {
        if (ph == 3) continue;
        a.ph_lo = ph; a.ph_hi = ph + 1; a.li = ph;
        hipLaunchKernelGGL(fwd_kernel, dim3(grid), dim3(NWAVES * 64), LDS_BYTES, stream, a);
    }
#endif
}
```

```cpp
#define MOE_FP8_MASK 3
#include <hip/hip_runtime.h>
#include <hip/hip_bf16.h>
#include <cstdio>
#include <cstdint>
#include <cmath>
namespace pg8 {
#define PG8_LAS __attribute__((address_space(3)))
typedef unsigned short bf16_t;
typedef short bf16x8 __attribute__((ext_vector_type(8)));
typedef float f32x4 __attribute__((ext_vector_type(4)));
typedef unsigned u32x4 __attribute__((ext_vector_type(4)));
typedef int pg8_v4i __attribute__((ext_vector_type(4)));
typedef long pg8_v2l __attribute__((ext_vector_type(2)));
constexpr int BM = 256, BK = 64, HALF = 128, HTB = HALF * BK * 2  , STAGE_BYTES = 8 * HTB, NXCD = 8, WGM = 8;

__host__ __device__ __forceinline__ int lds_byte(int r, int c) { const int st = (r >> 4) * 2 + (c >> 5), rr = r & 15, cc = c & 31, ob = rr * 64 + cc * 2; return st * 1024 + (ob ^ (((ob >> 9) & 1) << 5)); }
__host__ __device__ __forceinline__ void stage_rc(int b, int& R, int& C) { const int st = b / 1024, sb = b % 1024, swz = sb ^ (((sb >> 9) & 1) << 5); R = (st >> 1) * 16 + swz / 64; C = (st & 1) * 32 + (swz % 64) / 2; }
__host__ __device__ __forceinline__ int perm32(int rho) { const int n = rho >> 4, i = rho & 15; return 8 * (i >> 2) + 4 * n + (i & 3); }

struct Unit { int pm, pn; };
struct Gemm { const bf16_t* A; const bf16_t* Bt; int M, N, K; };

struct StaticOrder {
    int nM, nN, nwg, G, c;
    __host__ __device__ void init(int M, int N, int G_, int c_) { nM = M / BM; nN = N / BM; nwg = nM * nN; G = G_; c = c_; }
    __host__ __device__ bool next(int i, Unit& u) const {
        const long L = (long)i * G + c; if (L >= nwg) return false;
        int wgid = (int)L; { const int q = nwg / NXCD, r = nwg % NXCD, xcd = wgid % NXCD, off = wgid / NXCD; wgid = (xcd < r ? xcd * (q + 1) : r * (q + 1) + (xcd - r) * q) + off; }
        const int nig = WGM * nN, gid = wgid / nig, fm = gid * WGM, gsz = (nM - fm) < WGM ? (nM - fm) : WGM;
        u.pm = fm + ((wgid % nig) % gsz); u.pn = (wgid % nig) / gsz; return true;
    }
    __device__ __forceinline__ void a_ready(const Unit&) const {}
    __device__ __forceinline__ void done(const Unit&) const {}
};

__device__ __forceinline__ unsigned cvt_pk_bf16(float lo, float hi) { unsigned r; asm volatile("v_cvt_pk_bf16_f32 %0, %1, %2" : "=v"(r) : "v"(lo), "v"(hi)); return r; }
typedef float f32x2 __attribute__((ext_vector_type(2)));
__device__ __forceinline__ f32x2 gelu_pk(f32x2 v) {
    const f32x2 av = __builtin_elementwise_abs(v), d = av * 0.2316418882f + 1.0f;
    f32x2 t; t.x = __builtin_amdgcn_rcpf(d.x); t.y = __builtin_amdgcn_rcpf(d.y);
    f32x2 q = t * 0.5307027145f + (-0.7265760135f); q = q * t + 0.7107068705f; q = q * t + (-0.142248368f); q = q * t + 0.127414796f; q = q * t;
    const f32x2 s = (v * v) * (-0.72134752044f);
    f32x2 e; e.x = __builtin_amdgcn_exp2f(s.x); e.y = __builtin_amdgcn_exp2f(s.y);
    const f32x2 m = v * (q * e), r = v - m;
    f32x2 o; o.x = v.x < 0.f ? m.x : r.x; o.y = v.y < 0.f ? m.y : r.y; return o;
}

template <int ACT  > struct EpiBf16 {
    static constexpr bool PERM = true, AFTER_DRAIN = false; static_assert(ACT == 0 || ACT == 1, "EpiBf16: ACT is 0 (none) or 1 (gelu_pk)");
    bf16_t* O; int ldc; const float* bias; int split_cols; size_t split_stride; float scale0;
    __device__ __forceinline__ void operator()(const f32x4 (&acc)[2][2][4][2], const Unit& u, int wr, int wc, int fr, int fq) const {
        const int row0 = u.pm * BM + wr * 64 + fr; int colt = u.pn * BM; bf16_t* base = O;
        float sc = 1.f; if (split_cols) { const int t = colt / split_cols; base += (size_t)t * split_stride; colt -= t * split_cols; if (t == 0) sc = scale0; }
        const int col0 = colt + wc * 32 + 8 * fq, bcol0 = u.pn * BM + wc * 32 + 8 * fq;
        f32x4 bv[2][2];
#pragma unroll
        for (int bj = 0; bj < 2; ++bj)
#pragma unroll
            for (int n = 0; n < 2; ++n) bv[bj][n] = bias ? *(const f32x4*)(bias + bcol0 + bj * HALF + 4 * n) : (f32x4){0.f, 0.f, 0.f, 0.f};
#pragma unroll
        for (int ai = 0; ai < 2; ++ai)
#pragma unroll
            for (int m = 0; m < 4; ++m) { bf16_t* rowp = base + (size_t)(row0 + ai * HALF + m * 16) * ldc + col0;
#pragma unroll
                for (int bj = 0; bj < 2; ++bj) { f32x4 v0 = acc[ai][bj][m][0] + bv[bj][0], v1 = acc[ai][bj][m][1] + bv[bj][1];
                    if (ACT == 1) { f32x2 a = gelu_pk((f32x2){v0[0], v0[1]}), b = gelu_pk((f32x2){v0[2], v0[3]}), c = gelu_pk((f32x2){v1[0], v1[1]}), d = gelu_pk((f32x2){v1[2], v1[3]});
                        v0 = (f32x4){a.x, a.y, b.x, b.y}; v1 = (f32x4){c.x, c.y, d.x, d.y}; }
                    v0 = v0 * sc; v1 = v1 * sc; u32x4 w; w.x = cvt_pk_bf16(v0[0], v0[1]); w.y = cvt_pk_bf16(v0[2], v0[3]); w.z = cvt_pk_bf16(v1[0], v1[1]); w.w = cvt_pk_bf16(v1[2], v1[3]);
                    *(u32x4*)(rowp + bj * HALF) = w; } }
    }
};
template <class Epi, class Sched, bool ALIGN_EPI = false, bool SP2 = false, int FP8SC = -1>
__device__ __forceinline__ void gemm_phase(PG8_LAS unsigned char* lds, const Gemm g, const Sched& S, const Epi& E) {
    int tid_ = threadIdx.x; asm volatile("" : "+v"(tid_));
    const int tid = tid_, wid = __builtin_amdgcn_readfirstlane(tid >> 6), lane = tid & 63, wr = wid >> 2, wc = wid & 3, fr = lane & 15, fq = lane >> 4;
    const int K = g.K, nt = K / BK;
    unsigned voffA[2], voffB[2];
#pragma unroll
    for (int i = 0; i < 2; ++i) { int R, C; stage_rc(tid * 16 + i * 8192, R, C); const int Rb = Epi::PERM ? ((R & ~31) + perm32(R & 31)) : R;
        voffA[i] = (unsigned)(R * K + C) * 2u; voffB[i] = (unsigned)(Rb * K + C) * 2u; }
    const size_t kstep = (size_t)(BK * 2);
    const size_t hstep = (size_t)HALF * K * 2;
    const size_t tstep = 2 * hstep;
    const unsigned ldsw = (unsigned)wid * 1024u;
    const int aoff = lds_byte(wr * 64 + fr, fq * 8), boff = lds_byte(wc * 32 + fr, fq * 8);
#define PG8_SA(b, h) (((b) * 2 + (h)) * HTB)
#define PG8_SB(b, h) ((4 + (b) * 2 + (h)) * HTB)
#define PG8_STAGE(bufoff, gbase, voff) do { _Pragma("unroll") for (int _i = 0; _i < 2; ++_i) \
        __builtin_amdgcn_global_load_lds((const unsigned*)((const char*)(gbase) + (voff)[_i]), (PG8_LAS unsigned*)(lds + (bufoff) + ldsw + _i * 8192), 16, 0, 0); } while (0)
#define PG8_LDA(dst, b, h) do { _Pragma("unroll") for (int m = 0; m < 4; ++m) _Pragma("unroll") for (int k = 0; k < 2; ++k) dst[m][k] = *(const PG8_LAS bf16x8*)(lds + PG8_SA(b, h) + aoff + m * 2048 + k * 1024); } while (0)
#define PG8_LDB(dst, b, h) do { _Pragma("unroll") for (int n = 0; n < 2; ++n) _Pragma("unroll") for (int k = 0; k < 2; ++k) dst[n][k] = *(const PG8_LAS bf16x8*)(lds + PG8_SB(b, h) + boff + n * 2048 + k * 1024); } while (0)
#define PG8_CAT8(x0, x1) __builtin_shufflevector(__builtin_bit_cast(pg8_v4i, x0), __builtin_bit_cast(pg8_v4i, x1), 0, 1, 2, 3, 4, 5, 6, 7)
#define PG8_MMA(ai, bj, At, Bt) do { __builtin_amdgcn_s_setprio(1); \
        if constexpr (FP8SC < 0) { _Pragma("unroll") for (int m = 0; m < 4; ++m) _Pragma("unroll") for (int n = 0; n < 2; ++n) _Pragma("unroll") for (int k = 0; k < 2; ++k) \
            acc[ai][bj][m][n] = __builtin_amdgcn_mfma_f32_16x16x32_bf16(Bt[n][k], At[m][k], acc[ai][bj][m][n], 0, 0, 0); } \
        else if constexpr (FP8SC >= 1000) { _Pragma("unroll") for (int m = 0; m < 4; ++m) _Pragma("unroll") for (int n = 0; n < 2; ++n) _Pragma("unroll") for (int k = 0; k < 2; ++k) { \
            const pg8_v2l bq = __builtin_bit_cast(pg8_v2l, Bt[n][k]), aq = __builtin_bit_cast(pg8_v2l, At[m][k]); \
            acc[ai][bj][m][n] = __builtin_amdgcn_mfma_f32_16x16x32_fp8_fp8(bq[0], aq[0], acc[ai][bj][m][n], 0, 0, 0); acc[ai][bj][m][n] = __builtin_amdgcn_mfma_f32_16x16x32_fp8_fp8(bq[1], aq[1], acc[ai][bj][m][n], 0, 0, 0); } } \
        else { _Pragma("unroll") for (int m = 0; m < 4; ++m) _Pragma("unroll") for (int n = 0; n < 2; ++n) \
            acc[ai][bj][m][n] = __builtin_amdgcn_mfma_scale_f32_16x16x128_f8f6f4(PG8_CAT8(Bt[n][0], Bt[n][1]), PG8_CAT8(At[m][0], At[m][1]), acc[ai][bj][m][n], 0, 0, 0, (FP8SC < 0 ? 127 : FP8SC) * 0x01010101, 0, 0x7f7f7f7f); \
            _Pragma("unroll") for (int m = 0; m < 4; ++m) _Pragma("unroll") for (int n = 0; n < 2; ++n) asm volatile("" : "+v"(acc[ai][bj][m][n])); }     \
        __builtin_amdgcn_s_setprio(0); } while (0)
#define PG8_WAIT_V(n) asm volatile("s_waitcnt vmcnt(" #n ")" ::: "memory")
#define PG8_WAIT_L(n) asm volatile("s_waitcnt lgkmcnt(" #n ")" ::: "memory")
#define PG8_BAR __builtin_amdgcn_s_barrier()
#define PG8_SCHED __builtin_amdgcn_sched_barrier(0)
    Unit cur, nxt; int ui = 0;
    if (!S.next(0, cur)) return;
    f32x4 acc[2][2][4][2];
#pragma unroll
    for (int a = 0; a < 2; ++a)
#pragma unroll
        for (int b = 0; b < 2; ++b)
#pragma unroll
            for (int m = 0; m < 4; ++m)
#pragma unroll
                for (int n = 0; n < 2; ++n) acc[a][b][m][n] = (f32x4){0.f, 0.f, 0.f, 0.f};
    bf16x8 At[4][2], B0[2][2], B1[2][2];
    const char* cA = (const char*)g.A + (size_t)cur.pm * tstep; const char* cB = (const char*)g.Bt + (size_t)cur.pn * tstep;
    S.a_ready(cur);
    if constexpr (SP2) {
        PG8_STAGE(PG8_SB(0, 0), cB, voffB); PG8_STAGE(PG8_SB(0, 1), cB + hstep, voffB); PG8_STAGE(PG8_SA(0, 0), cA, voffA); PG8_STAGE(PG8_SA(0, 1), cA + hstep, voffA);
        if (wr == 1) PG8_BAR;
        PG8_WAIT_V(2); PG8_BAR;
        PG8_STAGE(PG8_SB(1, 0), cB + kstep, voffB); PG8_STAGE(PG8_SA(1, 0), cA + kstep, voffA); PG8_STAGE(PG8_SB(1, 1), cB + hstep + kstep, voffB);
        PG8_WAIT_V(6); PG8_BAR;
    } else {
        PG8_STAGE(PG8_SB(0, 0), cB, voffB); PG8_STAGE(PG8_SA(0, 0), cA, voffA); PG8_STAGE(PG8_SB(0, 1), cB + hstep, voffB); PG8_STAGE(PG8_SA(0, 1), cA + hstep, voffA);
        if (wr == 1) PG8_BAR;
        PG8_WAIT_V(4); PG8_BAR;
        PG8_STAGE(PG8_SB(1, 0), cB + kstep, voffB); PG8_STAGE(PG8_SA(1, 0), cA + kstep, voffA); PG8_STAGE(PG8_SB(1, 1), cB + hstep + kstep, voffB);
        PG8_WAIT_V(6); PG8_BAR;
    }
    for (;;) {
        const bool has_next = S.next(ui + 1, nxt);
        const char* nA = has_next ? (const char*)g.A + (size_t)nxt.pm * tstep : cA; const char* nB = has_next ? (const char*)g.Bt + (size_t)nxt.pn * tstep : cB;
        for (int t = 0; t < nt; t += 2) {
            const bool last = (t == nt - 2);
            const char* a1 = cA + (size_t)(t + 1) * kstep;
            const char* a2 = last ? nA : cA + (size_t)(t + 2) * kstep; const char* b2 = last ? nB : cB + (size_t)(t + 2) * kstep;
            const char* a3 = a2 + kstep; const char* b3 = b2 + kstep;
            if (last && has_next) S.a_ready(nxt);
            if constexpr (SP2) {
            PG8_LDB(B0, 0, 0); PG8_LDB(B1, 0, 1); PG8_SCHED; PG8_LDA(At, 0, 0); PG8_STAGE(PG8_SA(1, 1), a1 + hstep, voffA);
            PG8_WAIT_V(8); PG8_WAIT_L(0); PG8_BAR; PG8_MMA(0, 0, At, B0); PG8_MMA(0, 1, At, B1); PG8_BAR; PG8_SCHED;
            PG8_LDA(At, 0, 1); PG8_STAGE(PG8_SB(0, 0), b2, voffB); PG8_STAGE(PG8_SB(0, 1), b2 + hstep, voffB); PG8_STAGE(PG8_SA(0, 0), a2, voffA);
            PG8_WAIT_V(8); PG8_WAIT_L(0); PG8_BAR; PG8_MMA(1, 0, At, B0); PG8_MMA(1, 1, At, B1); PG8_BAR; PG8_SCHED;
            PG8_LDB(B0, 1, 0); PG8_LDB(B1, 1, 1); PG8_SCHED; PG8_LDA(At, 1, 0); PG8_STAGE(PG8_SA(0, 1), a2 + hstep, voffA);
            PG8_WAIT_V(8); PG8_WAIT_L(0); PG8_BAR; PG8_MMA(0, 0, At, B0); PG8_MMA(0, 1, At, B1); PG8_BAR; PG8_SCHED;
            PG8_LDA(At, 1, 1); PG8_STAGE(PG8_SB(1, 0), b3, voffB); PG8_STAGE(PG8_SB(1, 1), b3 + hstep, voffB); PG8_STAGE(PG8_SA(1, 0), a3, voffA);
            PG8_WAIT_V(8); PG8_WAIT_L(0); PG8_BAR; PG8_MMA(1, 0, At, B0); PG8_MMA(1, 1, At, B1); PG8_BAR; PG8_SCHED;
            } else {
            PG8_LDB(B0, 0, 0); PG8_SCHED; PG8_LDA(At, 0, 0); PG8_STAGE(PG8_SA(1, 1), a1 + hstep, voffA);
            PG8_WAIT_L(8); PG8_BAR; PG8_WAIT_L(0); PG8_MMA(0, 0, At, B0); PG8_BAR; PG8_SCHED;
            PG8_LDB(B1, 0, 1); PG8_STAGE(PG8_SB(0, 0), b2, voffB);
            PG8_BAR; PG8_WAIT_L(0); PG8_MMA(0, 1, At, B1); PG8_BAR;
            PG8_LDA(At, 0, 1); PG8_STAGE(PG8_SA(0, 0), a2, voffA);
            PG8_BAR; PG8_WAIT_L(0); PG8_MMA(1, 0, At, B0); PG8_BAR; PG8_SCHED;
            PG8_STAGE(PG8_SB(0, 1), b2 + hstep, voffB);
            PG8_WAIT_V(6); PG8_BAR; PG8_MMA(1, 1, At, B1); PG8_BAR;
            PG8_LDB(B0, 1, 0); PG8_SCHED; PG8_LDA(At, 1, 0); PG8_STAGE(PG8_SA(0, 1), a2 + hstep, voffA);
            PG8_WAIT_L(8); PG8_BAR; PG8_WAIT_L(0); PG8_MMA(0, 0, At, B0); PG8_BAR; PG8_SCHED;
            PG8_LDB(B1, 1, 1); PG8_STAGE(PG8_SB(1, 0), b3, voffB);
            PG8_BAR; PG8_WAIT_L(0); PG8_MMA(0, 1, At, B1); PG8_BAR;
            PG8_LDA(At, 1, 1); PG8_STAGE(PG8_SA(1, 0), a3, voffA);
            PG8_BAR; PG8_WAIT_L(0); PG8_MMA(1, 0, At, B0); PG8_BAR; PG8_SCHED;
            PG8_STAGE(PG8_SB(1, 1), b3 + hstep, voffB);
            PG8_WAIT_V(6); PG8_BAR; PG8_MMA(1, 1, At, B1); PG8_BAR;
            }
        }
        if constexpr (ALIGN_EPI) { if (wr == 0) PG8_BAR; }
        if constexpr (!Epi::AFTER_DRAIN) { E(acc, cur, wr, wc, fr, fq); S.done(cur); }
        if (!has_next) break;
#pragma unroll
        for (int a = 0; a < 2; ++a)
#pragma unroll
            for (int b = 0; b < 2; ++b)
#pragma unroll
                for (int m = 0; m < 4; ++m)
#pragma unroll
                    for (int n = 0; n < 2; ++n) acc[a][b][m][n] = (f32x4){0.f, 0.f, 0.f, 0.f};
        cur = nxt; cA = nA; cB = nB; ++ui;
        if constexpr (ALIGN_EPI) { if (wr == 1) PG8_BAR; }
    }
    PG8_WAIT_V(0);
    if constexpr (!ALIGN_EPI) { if (wr == 0) PG8_BAR; }
    PG8_BAR;
    if constexpr (Epi::AFTER_DRAIN) { E.fused(acc, cur, wr, wc, fr, fq, lds, wid, lane); S.done(cur); }
#undef PG8_SA
#undef PG8_SB
#undef PG8_STAGE
#undef PG8_LDA
#undef PG8_LDB
#undef PG8_MMA
#undef PG8_CAT8
#undef PG8_WAIT_V
#undef PG8_WAIT_L
#undef PG8_BAR
#undef PG8_SCHED
}
}

constexpr int NWAVES = 8;
constexpr int BATCH = 2, SEQ = 8192, T = BATCH * SEQ, D = 1024;
constexpr int AB_IN = 1536, C_IN = 2304, C_OUT = 512;
constexpr int NE = 32, DE = 1024, PLE = 256;
constexpr int NSLOT = 73728;
constexpr float NORM_EPS = 1e-6f;
constexpr float LOG2_THETA = 13.287712379549449f;
constexpr float ATT_C2 = 0.125f * 1.4426950408889634f;

#define GAS __attribute__((address_space(1)))
#define LAS __attribute__((address_space(3)))
typedef unsigned short bf16;
typedef unsigned v4u __attribute__((ext_vector_type(4)));
typedef unsigned v2u __attribute__((ext_vector_type(2)));
typedef float f32x4 __attribute__((ext_vector_type(4)));
typedef GAS unsigned gu32;
#define RLX_AGENT __ATOMIC_RELAXED, __HIP_MEMORY_SCOPE_AGENT
#define LDS_WAIT() asm volatile("s_waitcnt lgkmcnt(0)" ::: "memory")
#define VM_WAIT() asm volatile("s_waitcnt vmcnt(0)" ::: "memory")

typedef float f32x2_ __attribute__((ext_vector_type(2))); typedef __bf16 bf16x2_ __attribute__((ext_vector_type(2)));
__device__ __forceinline__ unsigned pk2(float lo, float hi) { f32x2_ v = {lo, hi}; bf16x2_ b = __builtin_convertvector(v, bf16x2_); return __builtin_bit_cast(unsigned, b); }
__device__ __forceinline__ float bflo(unsigned w) { return __builtin_bit_cast(float, w << 16); }
__device__ __forceinline__ float bfhi(unsigned w) { return __builtin_bit_cast(float, w & 0xffff0000u); }
#ifndef MOE_FP8_MASK
#define MOE_FP8_MASK 3
#endif
#ifndef F8_DIAG
#define F8_DIAG 0
#endif
constexpr float F8_EPI_SC = F8_DIAG ? (1.f / 64.f) : 1.f;
constexpr int F8_WSC = 6;
__device__ __forceinline__ unsigned pk4_fp8(float a, float b, float c, float d) { int w = 0; w = __builtin_amdgcn_cvt_pk_fp8_f32(a, b, w, false); w = __builtin_amdgcn_cvt_pk_fp8_f32(c, d, w, true); return (unsigned)w; }
__device__ __forceinline__ float clamp448(float x) { return fminf(fmaxf(x, -448.f), 448.f); }
__device__ __forceinline__ float rnd_bf(float x) { return bflo(pk2(x, 0.f)); }
__device__ __forceinline__ float ssp_sum(const float* p) { const f32x4 a = *(const f32x4*)p, b = *(const f32x4*)(p + 4), c = *(const f32x4*)(p + 8), d = *(const f32x4*)(p + 12);
    return (((a.x + a.y) + (a.z + a.w)) + ((b.x + b.y) + (b.z + b.w))) + (((c.x + c.y) + (c.z + c.w)) + ((d.x + d.y) + (d.z + d.w))); }

constexpr size_t MiB = 1u << 20;
constexpr size_t al256(size_t x) { return (x + 255) & ~(size_t)255; }
constexpr size_t WS_CTL = 0, CTL_ZERO_BYTES = 1 * MiB;
constexpr size_t WS_WIN0T = 1 * MiB;
constexpr size_t WS_WOUT0T = WS_WIN0T + (size_t)AB_IN * D * 2;
constexpr size_t WS_WIN1T = WS_WOUT0T + (size_t)D * D * 2;
constexpr size_t WS_WOUT1T = WS_WIN1T + (size_t)C_IN * D * 2;
constexpr size_t WS_WGT = WS_WOUT1T + (size_t)D * C_OUT * 2;
constexpr size_t WS_WPT = WS_WGT + 2 * (size_t)D * D * 2;
constexpr size_t WS_WR = WS_WPT + 2 * (size_t)D * PLE * 2;
constexpr size_t WS_ROPE1 = al256(WS_WR + 2 * (size_t)NE * D * 4);
constexpr size_t WS_ROPEA = WS_ROPE1 + (size_t)SEQ * 32 * 8;
constexpr size_t WS_WUPT = WS_ROPEA + (size_t)SEQ * 32 * 8;
constexpr size_t WS_WDNT = WS_WUPT + 2 * (size_t)NE * 2 * DE * D * 2;
constexpr size_t WS_PBF = WS_WDNT + 2 * (size_t)NE * D * DE * 2;
constexpr size_t WS_PP = WS_PBF + 2 * (size_t)T * PLE * 2;
constexpr size_t WS_X0 = WS_PP + 2 * (size_t)T * D * 2;
constexpr size_t WS_HM = WS_X0 + (size_t)T * D * 2;
constexpr size_t WS_H2 = WS_HM + (size_t)T * D * 2;
constexpr size_t WS_H3 = WS_H2 + (size_t)T * D * 2;
constexpr size_t WS_OCAT = WS_H3 + (size_t)T * D * 2;
constexpr size_t WS_SSP = WS_OCAT + (size_t)T * D * 2;
constexpr size_t WS_LSE = WS_SSP + 3 * (size_t)T * 16 * 4;
constexpr size_t WS_TOPE = WS_LSE + 3 * (size_t)T * 8 * 4;
constexpr size_t WS_TOPG = WS_TOPE + (size_t)T * 16;
constexpr size_t WS_TOPPOS = WS_TOPG + (size_t)T * 16;
constexpr size_t WS_RSTD = WS_TOPPOS + (size_t)T * 16;
constexpr size_t WS_TOKSLOT = WS_RSTD + (size_t)T * 4;
constexpr size_t WS_SLOTGATE = WS_TOKSLOT + (size_t)T * 16;
constexpr size_t WS_SLOTRS = WS_SLOTGATE + (size_t)NSLOT * 4;
constexpr size_t WS_XTAB = al256(WS_SLOTRS + (size_t)NSLOT * 4);
constexpr size_t WS_CNTTAB = al256(WS_XTAB + 8 * 136 * 4);
constexpr size_t WS_XG = al256(WS_CNTTAB + 256 * 32 * 4);
constexpr size_t WS_ACT = WS_XG + (size_t)NSLOT * D * 2;
constexpr size_t WS_Y = WS_ACT + (size_t)NSLOT * D * 2;
constexpr size_t WS_Q3 = WS_Y + (size_t)NSLOT * D * 2;
constexpr size_t WS_K3 = WS_Q3 + 3 * (size_t)T * 512 * 2;
constexpr size_t WS_V3 = WS_K3 + 3 * (size_t)T * 128 * 2;
constexpr size_t WS_OGB = WS_V3 + 3 * (size_t)T * 128 * 2;
constexpr size_t WS_END = WS_OGB + 3 * (size_t)T * 512 * 2;
constexpr int CW_TMO = 0;
constexpr int CW_CNT = 64;
constexpr int CW_BAR = 4096;

constexpr int LDSCTL_OFF = 0, MISC_OFF = 64;
constexpr int RING_OFF = 512, RING_BYTES = 131072;
constexpr int LDS_BYTES = 147456;

struct PPOrder {
    int G, c;
    __device__ __forceinline__ bool next(int i, pg8::Unit& u) const { const int L = i * G + c; if (L >= 512) return false; u.pm = L >> 2; u.pn = 4 * (u.pm >> 6) + (L & 3); return true; }
    __device__ __forceinline__ void a_ready(const pg8::Unit&) const {}
    __device__ __forceinline__ void done(const pg8::Unit&) const {}
};
struct EpiPP {
    static constexpr bool PERM = true, AFTER_DRAIN = false;
    bf16* O;
    __device__ __forceinline__ void operator()(const pg8::f32x4 (&acc)[2][2][4][2], const pg8::Unit& u, int wr, int wc, int fr, int fq) const {
        const int row0 = u.pm * 256 + wr * 64 + fr, col0 = (u.pn & 3) * 256 + wc * 32 + 8 * fq;
#pragma unroll
        for (int ai = 0; ai < 2; ++ai)
#pragma unroll
            for (int m = 0; m < 4; ++m) { bf16* rp = O + (size_t)(row0 + ai * 128 + m * 16) * D + col0;
#pragma unroll
                for (int bj = 0; bj < 2; ++bj) { const pg8::f32x4 v0 = acc[ai][bj][m][0], v1 = acc[ai][bj][m][1];
                    pg8::u32x4 w; w.x = pk2(v0[0], v0[1]); w.y = pk2(v0[2], v0[3]); w.z = pk2(v1[0], v1[1]); w.w = pk2(v1[2], v1[3]);
                    *(pg8::u32x4*)(rp + bj * 128) = w; } }
    }
};
template <int LAYER> struct EpiQKV {
    static constexpr bool PERM = true, AFTER_DRAIN = false;
    const float* SS; const float* qg; const float* kg; const float* rope1; const float* ropea; bf16* Q3; bf16* K3; bf16* V3;
    __device__ __forceinline__ void operator()(const pg8::f32x4 (&acc)[2][2][4][2], const pg8::Unit& u, int wr, int wc, int fr, int fq) const {
        int kind, hd, grp;
        bool axial;
        if (LAYER == 0) { const int t3 = u.pn % 3; grp = u.pn / 3; axial = (grp == 0);
            if (t3 < 2) { kind = 0; hd = 4 * t3 + wc; } else if (wc < 2) { kind = 1; hd = wc; } else { kind = 2; hd = wc - 2; } }
        else { const int t3 = u.pn % 3; grp = u.pn / 3; axial = false;
            if (t3 < 2) { kind = 0; hd = 4 * t3 + wc; } else if (wc < 2) { kind = 1; hd = wc; } else { kind = 2; hd = wc - 2; } }
        const bool norm = axial && kind < 2, rope = kind < 2;
        float ga[8], gb[8];
        if (norm) { const float* g = (kind == 0) ? qg : kg;
#pragma unroll
            for (int t = 0; t < 8; ++t) { const int j = 8 * fq + t; const int d0 = (j < 16) ? j : j + 16; ga[t] = g[d0]; gb[t] = g[d0 + 16]; } }
        else {
#pragma unroll
            for (int t = 0; t < 8; ++t) { ga[t] = 1.f; gb[t] = 1.f; } }
        const float qs = (kind == 0) ? ATT_C2 : 1.f;
        const float* rtab = axial ? ropea : rope1;
        bf16* dst; int pitch;
        if (kind == 0) { dst = Q3 + (size_t)grp * T * 512 + hd * 64; pitch = 512; } else if (kind == 1) { dst = K3 + (size_t)grp * T * 128 + hd * 64; pitch = 128; } else { dst = V3 + (size_t)grp * T * 128 + hd * 64; pitch = 128; }
        const int row0 = u.pm * 256 + wr * 64 + fr;
#pragma unroll
        for (int ai = 0; ai < 2; ++ai)
#pragma unroll
            for (int m = 0; m < 4; ++m) {
                const int r = row0 + ai * 128 + m * 16; const int pos = r & (SEQ - 1);
                const float rs = 1.f / sqrtf(ssp_sum(SS + (size_t)r * 16) * (1.f / D) + NORM_EPS);
                float a[8], b[8];
#pragma unroll
                for (int n = 0; n < 2; ++n)
#pragma unroll
                    for (int i = 0; i < 4; ++i) { a[4 * n + i] = acc[ai][0][m][n][i] * rs; b[4 * n + i] = acc[ai][1][m][n][i] * rs; }
                if (norm) { float ss = 0.f;
#pragma unroll
                    for (int t = 0; t < 8; ++t) ss += a[t] * a[t] + b[t] * b[t];
                    ss += __shfl_xor(ss, 16); ss += __shfl_xor(ss, 32);
                    const float rh = 1.f / sqrtf(ss * (1.f / 64.f) + NORM_EPS);
#pragma unroll
                    for (int t = 0; t < 8; ++t) { a[t] *= rh * ga[t]; b[t] *= rh * gb[t]; } }
                if (rope) { const f32x4* cs = (const f32x4*)(rtab + ((size_t)pos * 32 + 8 * fq) * 2);
#pragma unroll
                    for (int t2 = 0; t2 < 4; ++t2) { const f32x4 v = cs[t2];
                        { const float x1 = a[2 * t2], x2 = b[2 * t2]; a[2 * t2] = x1 * v.x - x2 * v.y; b[2 * t2] = x2 * v.x + x1 * v.y; }
                        { const float x1 = a[2 * t2 + 1], x2 = b[2 * t2 + 1]; a[2 * t2 + 1] = x1 * v.z - x2 * v.w; b[2 * t2 + 1] = x2 * v.z + x1 * v.w; } } }
                size_t drow = r;
                if (LAYER == 1) { const int sh = 2 * grp, bb = r >> 13; drow = (size_t)bb * SEQ + (size_t)(pos & ((1 << sh) - 1)) * (SEQ >> sh) + (pos >> sh); }
                bf16* dp = dst + drow * pitch + 8 * fq;
                pg8::u32x4 w0, w1;
                w0.x = pk2(a[0] * qs, a[1] * qs); w0.y = pk2(a[2] * qs, a[3] * qs); w0.z = pk2(a[4] * qs, a[5] * qs); w0.w = pk2(a[6] * qs, a[7] * qs);
                w1.x = pk2(b[0] * qs, b[1] * qs); w1.y = pk2(b[2] * qs, b[3] * qs); w1.z = pk2(b[4] * qs, b[5] * qs); w1.w = pk2(b[6] * qs, b[7] * qs);
                *(pg8::u32x4*)dp = w0; *(pg8::u32x4*)(dp + 32) = w1;
                asm volatile("" ::: "memory");
            }
    }
};
struct EpiResBf16 {
    static constexpr bool PERM = true, AFTER_DRAIN = false;
    const bf16* R; bf16* O;
    __device__ __forceinline__ void operator()(const pg8::f32x4 (&acc)[2][2][4][2], const pg8::Unit& u, int wr, int wc, int fr, int fq) const {
        const int row0 = u.pm * 256 + wr * 64 + fr, col0 = u.pn * 256 + wc * 32 + 8 * fq;
#pragma unroll
        for (int ai = 0; ai < 2; ++ai)
#pragma unroll
            for (int m = 0; m < 4; ++m) { const size_t ro = (size_t)(row0 + ai * 128 + m * 16) * D + col0;
#pragma unroll
                for (int bj = 0; bj < 2; ++bj) { const pg8::f32x4 v0 = acc[ai][bj][m][0], v1 = acc[ai][bj][m][1]; const v4u rr = *(const v4u*)(R + ro + bj * 128);
                    pg8::u32x4 w; w.x = pk2(v0[0] + bflo(rr.x), v0[1] + bfhi(rr.x)); w.y = pk2(v0[2] + bflo(rr.y), v0[3] + bfhi(rr.y)); w.z = pk2(v1[0] + bflo(rr.z), v1[1] + bfhi(rr.z)); w.w = pk2(v1[2] + bflo(rr.w), v1[3] + bfhi(rr.w));
                    *(pg8::u32x4*)(O + ro + bj * 128) = w; }
                asm volatile("" ::: "memory"); }
    }
};
__device__ __forceinline__ float sigmoidf_(float x) { return 1.0f / (1.0f + __expf(-x)); }
__device__ __forceinline__ float swiglu1(float g, float l) {
    g = fminf(g, 7.0f); l = fminf(fmaxf(l, -7.0f), 7.0f);
    return g * sigmoidf_(1.702f * g) * (l + 1.0f);
}
template <bool F8> struct EpiSwiglu {
    static constexpr bool PERM = true, AFTER_DRAIN = false;
    void* ACT; const float* bup; const float* rsl;
    __device__ __forceinline__ void operator()(const pg8::f32x4 (&acc)[2][2][4][2], const pg8::Unit& u, int wr, int wc, int fr, int fq) const {
        const int e = u.pn >> 3, j = u.pn & 7; const int row0 = u.pm * 256 + wr * 64 + fr, a0 = j * 128 + wc * 32 + 8 * fq;
        const float* bp = bup + (size_t)e * 2048 + 2 * a0; pg8::f32x4 b[4];
#pragma unroll
        for (int i = 0; i < 4; ++i) b[i] = *(const pg8::f32x4*)(bp + 4 * i);
#pragma unroll
        for (int ai = 0; ai < 2; ++ai)
#pragma unroll
            for (int m = 0; m < 4; ++m) { const int r = row0 + ai * 128 + m * 16; const float rs = F8 ? F8_EPI_SC : rsl[r];
                const pg8::f32x4 g0 = acc[ai][0][m][0] * rs, g1 = acc[ai][0][m][1] * rs, l0 = acc[ai][1][m][0] * rs, l1 = acc[ai][1][m][1] * rs;
                float o[8];
                o[0] = swiglu1(g0[0] + b[0][0], l0[0] + b[0][1]); o[1] = swiglu1(g0[1] + b[0][2], l0[1] + b[0][3]);
                o[2] = swiglu1(g0[2] + b[1][0], l0[2] + b[1][1]); o[3] = swiglu1(g0[3] + b[1][2], l0[3] + b[1][3]);
                o[4] = swiglu1(g1[0] + b[2][0], l1[0] + b[2][1]); o[5] = swiglu1(g1[1] + b[2][2], l1[1] + b[2][3]);
                o[6] = swiglu1(g1[2] + b[3][0], l1[2] + b[3][1]); o[7] = swiglu1(g1[3] + b[3][2], l1[3] + b[3][3]);
                if (F8) { v2u w; w.x = pk4_fp8(o[0], o[1], o[2], o[3]); w.y = pk4_fp8(o[4], o[5], o[6], o[7]); *(v2u*)((unsigned char*)ACT + (size_t)r * DE + a0) = w; }
                else { pg8::u32x4 w; w.x = pk2(o[0], o[1]); w.y = pk2(o[2], o[3]); w.z = pk2(o[4], o[5]); w.w = pk2(o[6], o[7]); *(pg8::u32x4*)((bf16*)ACT + (size_t)r * DE + a0) = w; } }
    }
};
struct EpiDown {
    static constexpr bool PERM = true, AFTER_DRAIN = false;
    bf16* Y; const float* bdn; const float* gate; float asc;
    __device__ __forceinline__ void operator()(const pg8::f32x4 (&acc)[2][2][4][2], const pg8::Unit& u, int wr, int wc, int fr, int fq) const {
        const int e = u.pn >> 2, j = u.pn & 3; const int row0 = u.pm * 256 + wr * 64 + fr, col0 = j * 256 + wc * 32 + 8 * fq;
        pg8::f32x4 bv[2][2];
#pragma unroll
        for (int bj = 0; bj < 2; ++bj)
#pragma unroll
            for (int n = 0; n < 2; ++n) bv[bj][n] = *(const pg8::f32x4*)(bdn + (size_t)e * D + col0 + bj * 128 + 4 * n);
#pragma unroll
        for (int ai = 0; ai < 2; ++ai)
#pragma unroll
            for (int m = 0; m < 4; ++m) { const int r = row0 + ai * 128 + m * 16; const float gt = gate[r];
#pragma unroll
                for (int bj = 0; bj < 2; ++bj) { const pg8::f32x4 v0 = (acc[ai][bj][m][0] * asc + bv[bj][0]) * gt, v1 = (acc[ai][bj][m][1] * asc + bv[bj][1]) * gt;
                    pg8::u32x4 w; w.x = pk2(v0[0], v0[1]); w.y = pk2(v0[2], v0[3]); w.z = pk2(v1[0], v1[1]); w.w = pk2(v1[2], v1[3]);
                    *(pg8::u32x4*)(Y + (size_t)r * D + col0 + bj * 128) = w; } }
    }
};
struct EpiPle {
    static constexpr bool PERM = true, AFTER_DRAIN = false;
    const bf16* H2; const bf16* PP; bf16* H3; float* SS;
    __device__ __forceinline__ void operator()(const pg8::f32x4 (&acc)[2][2][4][2], const pg8::Unit& u, int wr, int wc, int fr, int fq) const {
        const int row0 = u.pm * 256 + wr * 64 + fr, col0 = u.pn * 256 + wc * 32 + 8 * fq;
#pragma unroll
        for (int ai = 0; ai < 2; ++ai)
#pragma unroll
            for (int m = 0; m < 4; ++m) { const int r = row0 + ai * 128 + m * 16; const size_t ro = (size_t)r * D + col0; float ss = 0.f;
#pragma unroll
                for (int bj = 0; bj < 2; ++bj) { const pg8::f32x4 a0 = acc[ai][bj][m][0], a1 = acc[ai][bj][m][1]; const v4u h = *(const v4u*)(H2 + ro + bj * 128), p = *(const v4u*)(PP + ro + bj * 128);
                    pg8::u32x4 w;
                    w.x = pk2(bflo(h.x) + bflo(p.x) * sigmoidf_(a0[0]), bfhi(h.x) + bfhi(p.x) * sigmoidf_(a0[1])); w.y = pk2(bflo(h.y) + bflo(p.y) * sigmoidf_(a0[2]), bfhi(h.y) + bfhi(p.y) * sigmoidf_(a0[3]));
                    w.z = pk2(bflo(h.z) + bflo(p.z) * sigmoidf_(a1[0]), bfhi(h.z) + bfhi(p.z) * sigmoidf_(a1[1])); w.w = pk2(bflo(h.w) + bflo(p.w) * sigmoidf_(a1[2]), bfhi(h.w) + bfhi(p.w) * sigmoidf_(a1[3]));
                    *(pg8::u32x4*)(H3 + ro + bj * 128) = w;
                    ss += (bflo(w.x) * bflo(w.x) + bfhi(w.x) * bfhi(w.x)) + (bflo(w.y) * bflo(w.y) + bfhi(w.y) * bfhi(w.y)) + (bflo(w.z) * bflo(w.z) + bfhi(w.z) * bfhi(w.z)) + (bflo(w.w) * bflo(w.w) + bfhi(w.w) * bfhi(w.w)); }
                ss += __shfl_xor(ss, 16); ss += __shfl_xor(ss, 32);
                if (fq == 0) SS[(size_t)r * 16 + u.pn * 4 + wc] = ss;
                asm volatile("" ::: "memory"); }
    }
};
template <int LJ> struct XcdOrder {
    const int* tab; int rank, stride;
    __device__ __forceinline__ bool next(int i, pg8::Unit& u) const {
        const int q = i * stride + rank, p = q >> LJ, j = q & ((1 << LJ) - 1); const int ne = tab[0], tot = tab[1]; if (p >= tot) return false;
        int s = 0; while (s + 1 < ne && tab[4 + 4 * (s + 1) + 3] <= p) ++s;
        u.pm = tab[4 + 4 * s + 1] + (p - tab[4 + 4 * s + 3]); u.pn = (tab[4 + 4 * s] << LJ) + j; return true; }
    __device__ __forceinline__ void a_ready(const pg8::Unit&) const {}
    __device__ __forceinline__ void done(const pg8::Unit&) const {}
};
#include <hip/hip_bf16.h>
#include <cmath>
namespace attn_body {
using bf16=__hip_bfloat16;
using bf16x8=__attribute__((ext_vector_type(8)))short;
using s16x4=__attribute__((ext_vector_type(4)))short;
using f32x16=__attribute__((ext_vector_type(16)))float;
using u32x4=__attribute__((ext_vector_type(4)))unsigned;
constexpr int D=64,QP=512,KVP=128;
constexpr int NW=8,QBLK=32,QB=QBLK*NW,KVBLK=64;
constexpr int ATTN_UNIT_ROWS=QB;
__device__ __forceinline__ int crow(int r,int hi){return (r&3)+8*(r>>2)+4*hi;}
#define SBAR() __builtin_amdgcn_sched_barrier(0)
__device__ __forceinline__ void cmask(f32x16&p0,f32x16&p1,int jb,int qrel,int hi){
  const float NEG=-INFINITY; int kb=64*jb+4*hi;
  #pragma unroll
  for(int r=0;r<16;++r){int kv=kb+(r&3)+8*(r>>2); if(kv>qrel)p0[r]=NEG; if(kv+32>qrel)p1[r]=NEG;}
}

__device__ __forceinline__ void bmask(f32x16&p0,f32x16&p1,int t,int dqb,int W){
  const float NEG=-INFINITY; const int kb=64*t+dqb;
  #pragma unroll
  for(int r=0;r<16;++r){const int d=kb+(r&3)+8*(r>>2); if(d>W||d<-W)p0[r]=NEG; if(d+32>W||d+32<-W)p1[r]=NEG;}
}
constexpr int NSLOT=3, SLOTB=8192;
constexpr int LDS_K=0, LDS_V=NSLOT*SLOTB, LDS_WS=2*NSLOT*SLOTB, LDS_OST=LDS_WS+NW*64*4, LDS_BYTES=LDS_OST+NW*4096;
constexpr float C2=0.125f*1.4426950408889634f;
__device__ __forceinline__ void glds16(const void*gsrc,unsigned lds_dst){unsigned keep;
  asm volatile("s_mov_b32 %0, m0\n\ts_mov_b32 m0, %2\n\ts_nop 0\n\tglobal_load_lds_dwordx4 %1, off\n\ts_mov_b32 m0, %0":"=&s"(keep):"v"(gsrc),"s"(lds_dst):"memory");}
__device__ __forceinline__ float max3f(float a,float b,float c){float r;asm("v_max3_f32 %0, %1, %2, %3":"=v"(r):"v"(a),"v"(b),"v"(c));return r;}
__device__ __forceinline__ float max2f(float a,float b){float r;asm("v_max_f32_e32 %0, %1, %2":"=v"(r):"v"(a),"v"(b));return r;}
__device__ __forceinline__ float fadd_s(float a,float b){float r;asm("v_add_f32_e32 %0, %1, %2":"=v"(r):"v"(a),"v"(b));return r;}
__device__ __forceinline__ float fsub_s(float a,float b){float r;asm("v_sub_f32_e32 %0, %1, %2":"=v"(r):"v"(a),"v"(b));return r;}
typedef float f32x2_t __attribute__((ext_vector_type(2))); typedef __bf16 bf16x2_t __attribute__((ext_vector_type(2)));
__device__ __forceinline__ unsigned cvtpk_s(float lo,float hi){f32x2_t v={lo,hi};bf16x2_t b=__builtin_convertvector(v,bf16x2_t);return __builtin_bit_cast(unsigned,b);}
#define WAIT_BAR(N) asm volatile("s_waitcnt vmcnt(" #N ") lgkmcnt(0)\n\ts_barrier":::"memory")

__device__ __forceinline__ void qkt(f32x16&p0,f32x16&p1,const char*Kslot,const bf16x8*qr,const f32x16&negm,int r32,int hi){
  const char*kb=Kslot+hi*1024+r32*16;
  #pragma unroll
  for(int d0=0;d0<4;++d0){
    const bf16x8 b0=*reinterpret_cast<const bf16x8*>(kb+d0*2048);
    const bf16x8 b1=*reinterpret_cast<const bf16x8*>(kb+d0*2048+512);
    if(d0==0){p0=__builtin_amdgcn_mfma_f32_32x32x16_bf16(b0,qr[0],negm,0,0,0);p1=__builtin_amdgcn_mfma_f32_32x32x16_bf16(b1,qr[0],negm,0,0,0);}
    else{p0=__builtin_amdgcn_mfma_f32_32x32x16_bf16(b0,qr[d0],p0,0,0,0);p1=__builtin_amdgcn_mfma_f32_32x32x16_bf16(b1,qr[d0],p1,0,0,0);}}
}
typedef __attribute__((address_space(3))) const char* lds_cptr;
typedef short v4i16_t __attribute__((ext_vector_type(4)));
__device__ __forceinline__ void kload8(bf16x8*kf,lds_cptr kp){
  kf[0]=*(const __attribute__((address_space(3))) bf16x8*)(kp);      kf[1]=*(const __attribute__((address_space(3))) bf16x8*)(kp+512);
  kf[2]=*(const __attribute__((address_space(3))) bf16x8*)(kp+2048); kf[3]=*(const __attribute__((address_space(3))) bf16x8*)(kp+2560);
  kf[4]=*(const __attribute__((address_space(3))) bf16x8*)(kp+4096); kf[5]=*(const __attribute__((address_space(3))) bf16x8*)(kp+4608);
  kf[6]=*(const __attribute__((address_space(3))) bf16x8*)(kp+6144); kf[7]=*(const __attribute__((address_space(3))) bf16x8*)(kp+6656);
}
__device__ __forceinline__ void kload2(bf16x8*kf,lds_cptr kp,int j){ kf[2*j]=*(const __attribute__((address_space(3))) bf16x8*)(kp+j*2048); kf[2*j+1]=*(const __attribute__((address_space(3))) bf16x8*)(kp+j*2048+512); }
__device__ __forceinline__ s16x4 vtr(lds_cptr p){ return __builtin_bit_cast(s16x4,__builtin_amdgcn_ds_read_tr16_b64_v4i16((__attribute__((address_space(3))) v4i16_t*)p)); }
__device__ __forceinline__ float rowmax(const f32x16&p0,const f32x16&p1){
  float a=max3f(p0[0],p0[1],p1[0]),b=max3f(p0[2],p0[3],p1[1]);a=max3f(a,p1[2],p1[3]);
  #pragma unroll
  for(int r=4;r<16;r+=4){a=max3f(a,p0[r],p0[r+1]);b=max3f(b,p0[r+2],p0[r+3]);a=max3f(a,p1[r],p1[r+1]);b=max3f(b,p1[r+2],p1[r+3]);}
  const float m=max2f(a,b);
  auto rr=__builtin_amdgcn_permlane32_swap(__float_as_uint(m),__float_as_uint(m),false,false);
  return max2f(__uint_as_float(rr[0]),__uint_as_float(rr[1]));
}
__device__ __forceinline__ void pv(f32x16*o,int vb,bf16x8 pa0,bf16x8 pa1,bf16x8 pa2,bf16x8 pa3){
  #pragma unroll
  for(int d0=0;d0<2;++d0){s16x4 lo[4],hi[4];
    #pragma unroll
    for(int ks=0;ks<4;++ks){
      asm volatile("ds_read_b64_tr_b16 %0,%1 offset:%c2":"=&v"(lo[ks]):"v"(vb),"i"(d0*4096+ks*1024):"memory");
      asm volatile("ds_read_b64_tr_b16 %0,%1 offset:%c2":"=&v"(hi[ks]):"v"(vb),"i"(d0*4096+ks*1024+512):"memory");}
    asm volatile("s_waitcnt lgkmcnt(0)":::"memory");SBAR();
    #define PK(k) (bf16x8){lo[k][0],lo[k][1],lo[k][2],lo[k][3],hi[k][0],hi[k][1],hi[k][2],hi[k][3]}
    o[d0]=__builtin_amdgcn_mfma_f32_32x32x16_bf16(pa0,PK(0),o[d0],0,0,0);
    o[d0]=__builtin_amdgcn_mfma_f32_32x32x16_bf16(pa1,PK(1),o[d0],0,0,0);
    o[d0]=__builtin_amdgcn_mfma_f32_32x32x16_bf16(pa2,PK(2),o[d0],0,0,0);
    o[d0]=__builtin_amdgcn_mfma_f32_32x32x16_bf16(pa3,PK(3),o[d0],0,0,0);
    #undef PK
  }
}

#ifndef ATTN_STORE16
#define ATTN_STORE16(p,v) (*(u32x4*)(p)=(v))
#endif
template<int MODE,int OP,int THRL> __device__ __forceinline__ void attn_unit(const bf16*Qu,const bf16*__restrict__ Ku,const bf16*__restrict__ Vu,bf16*Ou,int NT,int dq0,int W,float sinkl2,bool has_sink,float*lse,char*shm){
  int tid_=threadIdx.x; asm volatile("":"+v"(tid_));
  const int tid=tid_,lane=tid&63,r32=lane&31,hi=lane>>5; const int wid=__builtin_amdgcn_readfirstlane(tid>>6);
  const bf16*Qw=Qu+(long)(wid*QBLK)*QP;
  const unsigned lds0=(unsigned)(uintptr_t)shm;
  float*wsf=(float*)(shm+LDS_WS)+wid*64;
  const bf16*ksrc=Ku+(long)lane*KVP+wid*8;
  const bf16*vsrc=Vu+(long)(16*(wid&3)+(lane>>2))*KVP+(wid>>2)*32+(lane&3)*8;
  const unsigned kdst=lds0+LDS_K+wid*1024, vdst=lds0+LDS_V+wid*1024;
  #define DMA_K(t,slot) glds16(ksrc+(long)(t)*KVBLK*KVP,(unsigned)__builtin_amdgcn_readfirstlane(kdst+(slot)))
  #define DMA_V(t,slot) glds16(vsrc+(long)(t)*KVBLK*KVP,(unsigned)__builtin_amdgcn_readfirstlane(vdst+(slot)))
  const int vb0=(int)(lds0+LDS_V)+((lane>>4)&1)*32+(lane&3)*8+(4*hi+((lane&15)>>2))*64;
  const char*Kbase=shm+LDS_K; bf16x8 kf[8];
  const lds_cptr shm3=(lds_cptr)shm; const lds_cptr kp0=shm3+LDS_K+hi*1024+r32*16; const lds_cptr vp0=shm3+LDS_V+((lane>>4)&1)*32+(lane&3)*8+(4*hi+((lane&15)>>2))*64;
  DMA_K(0,0);DMA_V(0,0);DMA_K(1,SLOTB);
  bf16x8 qr[4];
  #pragma unroll
  for(int d0=0;d0<4;++d0)qr[d0]=*reinterpret_cast<const bf16x8*>(&Qw[(long)r32*QP+d0*16+hi*8]);
  float mhat=0.f,l_reg=0.f;f32x16 o[2];o[0]=f32x16{};o[1]=f32x16{};f32x16 negm=f32x16{};asm volatile("":"+v"(negm));
  const int dqb=dq0-(wid*QBLK+r32)+4*hi;
  #define CMASK(P0,P1,t) do{ if(MODE==1) bmask(P0,P1,(t),dqb,W); }while(0)
  bool resc=false;
  #define START(P0,P1) do{ float rm=rowmax(P0,P1); if(MODE==1) rm=fmaxf(rm,-60.f); resc=false; \
    { const float dl=rm; mhat=fadd_s(mhat,dl); \
      _Pragma("unroll") for(int r=0;r<16;++r){P0[r]=fsub_s(P0[r],dl);P1[r]=fsub_s(P1[r],dl);} \
      _Pragma("unroll") for(int r=0;r<16;++r)negm[r]=-mhat; asm volatile("":"+v"(negm)); } \
    _Pragma("unroll") for(int r=0;r<16;++r)P0[r]=__builtin_amdgcn_exp2f(P0[r]); }while(0)
  #define RESC() do{ if(resc){ asm volatile("s_waitcnt lgkmcnt(0)":::"memory"); \
      _Pragma("unroll") for(int d_=0;d_<2;++d_) _Pragma("unroll") for(int r=0;r<16;++r)o[d_][r]*=wsf[crow(r,hi)]; } }while(0)
  f32x16 pA0,pA1,pB0,pB1;
  int sl_prev=0,sl_cur=0,sl_next=SLOTB;
  #define ROT() do{sl_prev=sl_cur;sl_cur=sl_next;sl_next=(sl_next==(NSLOT-1)*SLOTB)?0:sl_next+SLOTB;}while(0)
  DMA_K(2,2*SLOTB);
  WAIT_BAR(3);
  qkt(pA0,pA1,Kbase,qr,negm,r32,hi);asm volatile("s_nop 15\n\ts_nop 7":"+v"(pA0),"+v"(pA1));CMASK(pA0,pA1,0);
  START(pA0,pA1);
  _Pragma("unroll") for(int r=0;r<16;++r)pA1[r]=__builtin_amdgcn_exp2f(pA1[r]);
  WAIT_BAR(0);
  DMA_K(3,0);DMA_V(1,SLOTB);
  ROT();
  kload8(kf,kp0+sl_cur);
  WAIT_BAR(2);
  s16x4 vlo[8],vhi[8]; u32x4 pw0,pw1,pw2,pw3;
  #define PKW(P,B) cvtpk_s(P[B],P[B+1])
  #define PAF(k) __builtin_bit_cast(bf16x8,pw##k)
  #define VFR(i) (bf16x8){vlo[i][0],vlo[i][1],vlo[i][2],vlo[i][3],vhi[i][0],vhi[i][1],vhi[i][2],vhi[i][3]}
  #define PIN(x) asm volatile("":"+v"(x))
  #define MX3(a,b,c) __builtin_fmaxf(__builtin_fmaxf((a),(b)),(c))
  #define GAPA(MF,A0,A1,A2,A3,W0,W1,PW) do{ MF; sacc+=A0; sacc+=A1; sacc+=A2; sacc+=A3; PIN(sacc); W0; W1; PIN(PW); SBAR(); }while(0)
  #define EX(v) __builtin_amdgcn_exp2f(v)
  #define GAPB(MF,X,B) do{ MF; X[B]=EX(X[B]); X[B+1]=EX(X[B+1]); X[B+2]=EX(X[B+2]); X[B+3]=EX(X[B+3]); PIN(X); SBAR(); }while(0)
  #define VRD(i) do{ vlo[i]=vtr(vp_+(((i)>>2)*4096+((i)&3)*1024)); vhi[i]=vtr(vp_+(((i)>>2)*4096+((i)&3)*1024+512)); }while(0)
  #define KRD(G,j) do{ if(G){ kload2(kf,kp0+sl_next,j); SBAR(); } }while(0)
  #define STEP(C0,C1,P0,P1,t,GK,GV,GL) do{ SBAR(); \
    const lds_cptr vp_=vp0+sl_prev; \
    VRD(0); SBAR(); float sacc=(P0[0]+P0[1]); \
    GAPA(C0=__builtin_amdgcn_mfma_f32_32x32x16_bf16(kf[0],qr[0],negm,0,0,0), P0[2],P0[3],P0[4],P0[5],     pw0[0]=PKW(P0,0), pw0[1]=PKW(P0,2), pw0); \
    VRD(4); SBAR(); GAPA(C1=__builtin_amdgcn_mfma_f32_32x32x16_bf16(kf[1],qr[0],negm,0,0,0), P0[6],P0[7],P0[8],P0[9],     pw0[2]=PKW(P0,4), pw0[3]=PKW(P0,6), pw0); \
    VRD(1); SBAR(); GAPA(C0=__builtin_amdgcn_mfma_f32_32x32x16_bf16(kf[2],qr[1],C0,0,0,0),   P0[10],P0[11],P0[12],P0[13], pw1[0]=PKW(P0,8), pw1[1]=PKW(P0,10), pw1); \
    VRD(5); SBAR(); GAPA(C1=__builtin_amdgcn_mfma_f32_32x32x16_bf16(kf[3],qr[1],C1,0,0,0),   P0[14],P0[15],P1[0],P1[1],   pw1[2]=PKW(P0,12),pw1[3]=PKW(P0,14), pw1); \
    VRD(2); SBAR(); GAPA(C0=__builtin_amdgcn_mfma_f32_32x32x16_bf16(kf[4],qr[2],C0,0,0,0),   P1[2],P1[3],P1[4],P1[5],     pw2[0]=PKW(P1,0), pw2[1]=PKW(P1,2), pw2); \
    VRD(6); SBAR(); GAPA(C1=__builtin_amdgcn_mfma_f32_32x32x16_bf16(kf[5],qr[2],C1,0,0,0),   P1[6],P1[7],P1[8],P1[9],     pw2[2]=PKW(P1,4), pw2[3]=PKW(P1,6), pw2); \
    VRD(3); SBAR(); GAPA(C0=__builtin_amdgcn_mfma_f32_32x32x16_bf16(kf[6],qr[3],C0,0,0,0),   P1[10],P1[11],P1[12],P1[13], pw3[0]=PKW(P1,8), pw3[1]=PKW(P1,10), pw3); \
    VRD(7); SBAR(); GAPA(C1=__builtin_amdgcn_mfma_f32_32x32x16_bf16(kf[7],qr[3],C1,0,0,0),   P1[14],P1[15],0.f,0.f,       pw3[2]=PKW(P1,12),pw3[3]=PKW(P1,14), pw3); \
    l_reg+=sacc; \
    if(GK){DMA_K((t)+3,sl_cur);} if(GV){DMA_V((t)+1,sl_next);} \
    CMASK(C0,C1,t); \
    { float a=MX3(C0[0],C0[1],C1[0]),b=MX3(C0[2],C0[3],C1[1]); a=MX3(a,C1[2],C1[3]); \
      _Pragma("unroll") for(int r=4;r<16;r+=4){a=MX3(a,C0[r],C0[r+1]);b=MX3(b,C0[r+2],C0[r+3]);a=MX3(a,C1[r],C1[r+1]);b=MX3(b,C1[r+2],C1[r+3]);} \
      float rm=__builtin_fmaxf(a,b); { auto rr=__builtin_amdgcn_permlane32_swap(__float_as_uint(rm),__float_as_uint(rm),false,false); rm=__builtin_fmaxf(__uint_as_float(rr[0]),__uint_as_float(rr[1])); } \
      resc=false; \
      if(__builtin_expect(__any(rm>(float)THRL),0)){ const float dl=__builtin_fmaxf(rm,0.f); mhat+=dl; \
        _Pragma("unroll") for(int r=0;r<16;++r){C0[r]-=dl;C1[r]-=dl;} \
        _Pragma("unroll") for(int r=0;r<16;++r)negm[r]=-mhat; asm volatile("":"+v"(negm)); \
        const float f=__builtin_amdgcn_exp2f(-dl); l_reg*=f; if(hi==0)wsf[r32]=f; resc=true; } } \
    SBAR(); \
    GAPB(o[0]=__builtin_amdgcn_mfma_f32_32x32x16_bf16(PAF(0),VFR(0),o[0],0,0,0), C0,0); \
    GAPB(o[1]=__builtin_amdgcn_mfma_f32_32x32x16_bf16(PAF(0),VFR(4),o[1],0,0,0), C0,4); \
    KRD(GL,0); GAPB(o[0]=__builtin_amdgcn_mfma_f32_32x32x16_bf16(PAF(1),VFR(1),o[0],0,0,0), C0,8); \
    KRD(GL,1); GAPB(o[1]=__builtin_amdgcn_mfma_f32_32x32x16_bf16(PAF(1),VFR(5),o[1],0,0,0), C0,12); \
    KRD(GL,2); GAPB(o[0]=__builtin_amdgcn_mfma_f32_32x32x16_bf16(PAF(2),VFR(2),o[0],0,0,0), C1,0); \
    KRD(GL,3); GAPB(o[1]=__builtin_amdgcn_mfma_f32_32x32x16_bf16(PAF(2),VFR(6),o[1],0,0,0), C1,4); \
    GAPB(o[0]=__builtin_amdgcn_mfma_f32_32x32x16_bf16(PAF(3),VFR(3),o[0],0,0,0), C1,8); \
    GAPB(o[1]=__builtin_amdgcn_mfma_f32_32x32x16_bf16(PAF(3),VFR(7),o[1],0,0,0), C1,12); \
    }while(0)
  int t=1;
  for(;t+5<NT;t+=2){
    STEP(pB0,pB1,pA0,pA1,t,true,true,true);     WAIT_BAR(2); RESC(); ROT();
    STEP(pA0,pA1,pB0,pB1,t+1,true,true,true);   WAIT_BAR(2); RESC(); ROT();
  }
  #define ENDW(tt) do{ if((tt)+3<NT){WAIT_BAR(2);} else if((tt)+2<NT){WAIT_BAR(1);} else {WAIT_BAR(0);} }while(0)
  for(;t+1<NT;t+=2){
    STEP(pB0,pB1,pA0,pA1,t,(t+3<NT),(t+1<NT),(t+1<NT));       ENDW(t);   RESC(); ROT();
    STEP(pA0,pA1,pB0,pB1,t+1,(t+4<NT),(t+2<NT),(t+2<NT));     ENDW(t+1); RESC(); ROT();
  }
  STEP(pB0,pB1,pA0,pA1,NT-1,false,false,false); RESC();
  { float sacc=pB0[0]+pB0[1]; _Pragma("unroll") for(int r=2;r<16;++r)sacc+=pB0[r]; _Pragma("unroll") for(int r=0;r<16;++r)sacc+=pB1[r]; l_reg+=sacc;
    pw0=(u32x4){PKW(pB0,0),PKW(pB0,2),PKW(pB0,4),PKW(pB0,6)};pw1=(u32x4){PKW(pB0,8),PKW(pB0,10),PKW(pB0,12),PKW(pB0,14)};pw2=(u32x4){PKW(pB1,0),PKW(pB1,2),PKW(pB1,4),PKW(pB1,6)};pw3=(u32x4){PKW(pB1,8),PKW(pB1,10),PKW(pB1,12),PKW(pB1,14)};
    SBAR(); pv(o,vb0+sl_cur,PAF(0),PAF(1),PAF(2),PAF(3)); }
  #undef PKW
  #undef PAF
  #undef VFR
  #undef PIN
  #undef MX3
  #undef GAPA
  #undef GAPB
  #undef EX
  #undef VRD
  #undef KRD
  #undef STEP
  #undef ENDW
  {auto rr=__builtin_amdgcn_permlane32_swap(__float_as_uint(l_reg),__float_as_uint(l_reg),false,false);l_reg=__uint_as_float(rr[0])+__uint_as_float(rr[1]);}
  if(MODE==1){ if(has_sink) l_reg+=__builtin_amdgcn_exp2f(sinkl2-mhat); if(lse!=nullptr&&hi==0) lse[(long)(wid*QBLK+r32)*8]=0.6931471805599453f*(mhat+__builtin_amdgcn_logf(l_reg)); }
  if(hi==0)wsf[32+r32]=l_reg;asm volatile("s_waitcnt lgkmcnt(0)":::"memory");
  float rli[16];
  #pragma unroll
  for(int r=0;r<16;++r)rli[r]=__builtin_amdgcn_rcpf(wsf[32+crow(r,hi)]);
  bf16*Ow=Ou+(long)(wid*QBLK)*OP;
  { bf16*stg=(bf16*)(shm+LDS_OST)+wid*2048;
    #pragma unroll
    for(int r=0;r<16;++r){const int orow=crow(r,hi);
      #pragma unroll
      for(int d0=0;d0<2;++d0)stg[orow*64+d0*32+r32]=__float2bfloat16(o[d0][r]*rli[r]);}
    asm volatile("s_waitcnt lgkmcnt(0)":::"memory");
    #pragma unroll
    for(int i=0;i<4;++i){const int row=i*8+(lane>>3),ch=lane&7; const u32x4 v=*(const u32x4*)(stg+row*64+ch*8); ATTN_STORE16(Ow+(long)row*OP+ch*8,v);} }
  asm volatile("s_waitcnt lgkmcnt(0)\n\ts_barrier":::"memory");
  #undef DMA_K
  #undef DMA_V
  #undef CMASK
  #undef START
  #undef RESC
  #undef ROT
}
constexpr int ATTN_LDS_BYTES=LDS_BYTES;
#undef SBAR
#undef WAIT_BAR
}
#define XB_TMO      128
#define XB_XCNT(j)  (256  + 64 * (j))
#define XB_XSUB(j)  (1280 + 64 * (j))
#define XB_XGEN(j)  (2304 + 64 * (j))
#define XB_TOP      3328
#define XB_TOPGEN   3392
#define XCD_BAR_WORDS 3456
#define XB_SPIN_CAP (1u << 18)

__device__ __forceinline__ unsigned xb_ld(unsigned* p)              { return __hip_atomic_load(p, __ATOMIC_RELAXED, __HIP_MEMORY_SCOPE_AGENT); }
__device__ __forceinline__ unsigned xb_add(unsigned* p, unsigned v) { return __hip_atomic_fetch_add(p, v, __ATOMIC_RELAXED, __HIP_MEMORY_SCOPE_AGENT); }
__device__ __forceinline__ unsigned xb_xcc_id() { return (unsigned)__builtin_amdgcn_s_getreg((3 << 11) | 20) & 0xFu; }
#define XB_SPIN(cond, bar) do { unsigned _sp = 0; while (cond) { __builtin_amdgcn_s_sleep(1); \
    if ((++_sp & 255u) == 0u) { if (xb_ld(&(bar)[XB_TMO])) break; if (_sp > XB_SPIN_CAP) { atomicAdd(&(bar)[XB_TMO], 1u); break; } } } } while (0)

struct XcdBarrier {
    unsigned* bar; unsigned x;
    volatile LAS unsigned* st;
};

__device__ __forceinline__ XcdBarrier xcd_barrier_post(unsigned* bar, volatile LAS unsigned* st) {
    XcdBarrier b; b.bar = bar; b.x = xb_xcc_id(); b.st = st;
    if (threadIdx.x == 0) (void)xb_add(&bar[XB_XCNT(b.x)], 1u);
    return b;
}
__device__ __forceinline__ void xcd_barrier_complete(unsigned* bar, unsigned x, unsigned& nloc, unsigned& nx) {
    const unsigned G = gridDim.x * gridDim.y * gridDim.z;
    unsigned sum, cnt, mine, sp = 0u;
    for (;;) {
        sum = 0u; cnt = 0u; mine = 0u;
#pragma unroll
        for (unsigned j = 0; j < 16; ++j) { const unsigned c = xb_ld(&bar[XB_XCNT(j)]); sum += c; cnt += (c > 0u) ? 1u : 0u; mine = (j == x) ? c : mine; }
        if (sum == G) break;
        __builtin_amdgcn_s_sleep(1);
        if ((++sp & 255u) == 0u) { if (xb_ld(&bar[XB_TMO])) break; if (sp > XB_SPIN_CAP) { atomicAdd(&bar[XB_TMO], 1u); break; } }
    }
    nloc = mine > 0u ? mine : 1u; nx = cnt > 0u ? cnt : 1u;
}

__device__ __forceinline__ void xcd_barrier(const XcdBarrier& b) {
    asm volatile("s_waitcnt vmcnt(0)" ::: "memory");
    __syncthreads();
    if (threadIdx.x == 0) {
        unsigned* bar = b.bar;
        __builtin_amdgcn_s_waitcnt(0);
        unsigned nloc = b.st[0], nx = b.st[1];
        if (nloc == 0u) { xcd_barrier_complete(bar, b.x, nloc, nx); b.st[0] = nloc; b.st[1] = nx; }
        const unsigned old = xb_add(&bar[XB_XSUB(b.x)], 1u);
        const unsigned gen = old / nloc;
        if (old + 1u == (gen + 1u) * nloc) {
            __builtin_amdgcn_fence(__ATOMIC_RELEASE, "agent");
            asm volatile("s_waitcnt vmcnt(0)" ::: "memory");
            const unsigned og = xb_add(&bar[XB_TOP], 1u);
            const unsigned tg = og / nx;
            if (og + 1u == (tg + 1u) * nx) xb_add(&bar[XB_TOPGEN], 1u);
            else XB_SPIN(xb_ld(&bar[XB_TOPGEN]) == tg, bar);
            __builtin_amdgcn_fence(__ATOMIC_ACQUIRE, "agent");
            xb_add(&bar[XB_XGEN(b.x)], 1u);
            asm volatile("s_waitcnt vmcnt(0)" ::: "memory");
        } else {
            XB_SPIN(xb_ld(&bar[XB_XGEN(b.x)]) == gen, bar);
            __builtin_amdgcn_fence(__ATOMIC_ACQUIRE, "agent");
            asm volatile("s_waitcnt vmcnt(0)" ::: "memory");
        }
    }
    __syncthreads();
}

struct Frame {
    LAS unsigned char* lds;
    volatile LAS unsigned* MISC;
    gu32* ctl;
    int tid, lane, wave, vcu, G, bx;
    int gw, NGW;
};
__device__ __forceinline__ bool refresh(Frame& F) {
    int t = threadIdx.x; asm volatile("" : "+v"(t)); F.tid = t; F.lane = t & 63; F.wave = __builtin_amdgcn_readfirstlane(t >> 6);
    int bx = blockIdx.x, G = gridDim.x; asm volatile("" : "+s"(bx), "+s"(G)); F.bx = bx; F.G = G;
    F.vcu = (G % 8 == 0) ? (bx % 8) * (G / 8) + bx / 8 : bx; F.gw = F.vcu * NWAVES + F.wave; F.NGW = G * NWAVES; return true; }
__device__ __forceinline__ float wave_sum(float v) {
#pragma unroll
    for (int o = 1; o < 64; o <<= 1) v += __shfl_xor(v, o);
    return v;
}
template <int MAP> __device__ __forceinline__ int rowmap(int n) {
    if (MAP == 1) { const int f = n >> 1; return 256 * (f >> 7) + 128 * (n & 1) + (f & 127); }
    if (MAP == 2 || MAP == 3) { const int tl = n >> 8, hh = (n >> 6) & 3, d = n & 63; int bj, j;
        const bool axial = (MAP == 2) && (tl < 2 || (tl == 2 && hh < 2));
        if (axial) { bj = (d >> 4) & 1; j = (d & 15) + ((d >> 5) << 4); } else { bj = d >> 5; j = d & 31; }
        return 256 * tl + 128 * bj + 32 * hh + j; }
    return n; }
struct TrTile { const float* W; bf16* WT; const float* gain; int K, N, k0, n0; };
__device__ __forceinline__ void tr_load(const TrTile& t, f32x4 (&v)[16], int lane) {
    const float* src = t.W + (size_t)(t.k0 + (lane >> 4)) * t.N + t.n0 + 4 * (lane & 15);
#pragma unroll
    for (int i = 0; i < 16; ++i) v[i] = *(const f32x4*)(src + (size_t)(4 * i) * t.N);
}
template <int MAP> __device__ __forceinline__ void tr_store(const TrTile& t, f32x4 (&v)[16], LAS float* scr, int lane) {
    const int lr = lane >> 4, lc = lane & 15;
    if (t.gain) {
#pragma unroll
        for (int i = 0; i < 16; ++i) v[i] *= t.gain[t.k0 + 4 * i + lr]; }
#pragma unroll
    for (int i = 0; i < 16; ++i) { LAS float* p = scr + (4 * i + lr) * 65 + 4 * lc; p[0] = v[i].x; p[1] = v[i].y; p[2] = v[i].z; p[3] = v[i].w; }
    LDS_WAIT(); asm volatile("" ::: "memory");
    const int c = lane & 7;
#pragma unroll
    for (int j = 0; j < 8; ++j) { const int n = 8 * j + (lane >> 3); const LAS float* s = scr + (8 * c) * 65 + n;
        v4u o; o.x = pk2(s[0 * 65], s[1 * 65]); o.y = pk2(s[2 * 65], s[3 * 65]); o.z = pk2(s[4 * 65], s[5 * 65]); o.w = pk2(s[6 * 65], s[7 * 65]);
        *(GAS v4u*)(t.WT + (size_t)rowmap<MAP>(t.n0 + n) * t.K + t.k0 + 8 * c) = o; }
    LDS_WAIT(); asm volatile("" ::: "memory");
}
template <int MAP> __device__ __forceinline__ void transpose_family(Frame& F, const float* W, size_t sW, bf16* WT, size_t sWT, const float* gain, int sG, int K, int N, int nmat, int gdiv) {
    LAS float* scr = (LAS float*)(F.lds + RING_OFF) + F.wave * (128 * 33);
    const int nb = N / 64, per = (K / 64) * nb, total = per * nmat;
    f32x4 va[16], vb[16];
    int it = F.gw; if (it >= total) return;
    TrTile ta, tb;
#define TR_SETUP(tt, item) do { const int mi = (item) / per, r = (item) % per; tt.W = W + (size_t)mi * sW; tt.WT = WT + (size_t)mi * sWT; tt.gain = gain ? gain + (size_t)(mi / gdiv) * sG : nullptr; tt.K = K; tt.N = N; tt.k0 = 64 * (r / nb); tt.n0 = 64 * (r % nb); } while (0)
    TR_SETUP(ta, it); tr_load(ta, va, F.lane);
    for (;;) {
        const int it2 = it + F.NGW; const bool h2 = it2 < total;
        if (h2) { TR_SETUP(tb, it2); tr_load(tb, vb, F.lane); }
        tr_store<MAP>(ta, va, scr, F.lane);
        if (!h2) break;
        const int it3 = it2 + F.NGW; const bool h3 = it3 < total;
        if (h3) { TR_SETUP(ta, it3); tr_load(ta, va, F.lane); }
        tr_store<MAP>(tb, vb, scr, F.lane);
        if (!h3) break;
        it = it3;
    }
#undef TR_SETUP
}
__device__ __forceinline__ void tr8_load(const TrTile& t, f32x4 (&v)[16], int lane) {
    const float* src = t.W + (size_t)(t.k0 + (lane >> 3)) * t.N + t.n0 + 4 * (lane & 7);
#pragma unroll
    for (int i = 0; i < 16; ++i) v[i] = *(const f32x4*)(src + (size_t)(8 * i) * t.N);
}
template <int MAP> __device__ __forceinline__ void tr8_store(const TrTile& t, f32x4 (&v)[16], LAS float* scr, int lane) {
    const int lr = lane >> 3, lc = lane & 7; const float sc = (float)(1 << F8_WSC);
#pragma unroll
    for (int i = 0; i < 16; ++i) { const float g = t.gain ? t.gain[t.k0 + 8 * i + lr] * sc : sc; LAS float* p = scr + (8 * i + lr) * 33 + 4 * lc; p[0] = v[i].x * g; p[1] = v[i].y * g; p[2] = v[i].z * g; p[3] = v[i].w * g; }
    LDS_WAIT(); asm volatile("" ::: "memory");
    const int c = lane & 7;
#pragma unroll
    for (int j = 0; j < 4; ++j) { const int n = 8 * j + (lane >> 3); const LAS float* s = scr + (16 * c) * 33 + n;
        v4u o; o.x = pk4_fp8(s[0 * 33], s[1 * 33], s[2 * 33], s[3 * 33]); o.y = pk4_fp8(s[4 * 33], s[5 * 33], s[6 * 33], s[7 * 33]); o.z = pk4_fp8(s[8 * 33], s[9 * 33], s[10 * 33], s[11 * 33]); o.w = pk4_fp8(s[12 * 33], s[13 * 33], s[14 * 33], s[15 * 33]);
        *(GAS v4u*)((unsigned char*)t.WT + (size_t)rowmap<MAP>(t.n0 + n) * t.K + t.k0 + 16 * c) = o; }
    LDS_WAIT(); asm volatile("" ::: "memory");
}
template <int MAP> __device__ __forceinline__ void transpose_family_f8(Frame& F, const float* W, size_t sW, unsigned char* WT, size_t sWT, const float* gain, int sG, int K, int N, int nmat, int gdiv) {
    LAS float* scr = (LAS float*)(F.lds + RING_OFF) + F.wave * (128 * 33);
    const int nb = N / 32, per = (K / 128) * nb, total = per * nmat;
    f32x4 va[16], vb[16];
    int it = F.gw; if (it >= total) return;
    TrTile ta, tb;
#define TR_SETUP(tt, item) do { const int mi = (item) / per, r = (item) % per; tt.W = W + (size_t)mi * sW; tt.WT = (bf16*)(WT + (size_t)mi * sWT); tt.gain = gain ? gain + (size_t)(mi / gdiv) * sG : nullptr; tt.K = K; tt.N = N; tt.k0 = 128 * (r / nb); tt.n0 = 32 * (r % nb); } while (0)
    TR_SETUP(ta, it); tr8_load(ta, va, F.lane);
    for (;;) {
        const int it2 = it + F.NGW; const bool h2 = it2 < total;
        if (h2) { TR_SETUP(tb, it2); tr8_load(tb, vb, F.lane); }
        tr8_store<MAP>(ta, va, scr, F.lane);
        if (!h2) break;
        const int it3 = it2 + F.NGW; const bool h3 = it3 < total;
        if (h3) { TR_SETUP(ta, it3); tr8_load(ta, va, F.lane); }
        tr8_store<MAP>(tb, vb, scr, F.lane);
        if (!h3) break;
        it = it3;
    }
#undef TR_SETUP
}
__device__ __forceinline__ float rope_freq(int i, int half_dim) { return exp2f(-(float)i / (float)half_dim * LOG2_THETA); }

__device__ __forceinline__ void attn_phase_l0(Frame& F, const bf16* Q3, const bf16* K3, const bf16* V3, bf16* OCAT, const float* sink) {
    char* shm = (char*)(F.lds + RING_OFF);
    const int upc = (512 + F.G - 1) / F.G;
    for (int i = 0; i < upc; ++i) { const int u = F.vcu * upc + i; if (u >= 512) break;
        const int bhk = u >> 7, b = bhk >> 1, hkv = bhk & 1, hq = hkv * 4 + ((u & 127) >> 5), qb = u & 31; const size_t r0 = (size_t)b * SEQ + qb * 256;
        attn_body::attn_unit<0, 1024, 8>((const attn_body::bf16*)(Q3 + r0 * 512 + hq * 64), (const attn_body::bf16*)(K3 + (size_t)b * SEQ * 128 + hkv * 64), (const attn_body::bf16*)(V3 + (size_t)b * SEQ * 128 + hkv * 64),
                                        (attn_body::bf16*)(OCAT + r0 * D + hq * 64), SEQ / 64, 0, 0, 0.f, false, nullptr, shm); }
    const bf16* Qb = Q3 + (size_t)T * 512; const bf16* Kb = K3 + (size_t)T * 128; const bf16* Vb = V3 + (size_t)T * 128;
    for (int i = 0; i < upc; ++i) { const int u = F.vcu * upc + i; if (u >= 512) break;
        const int bhk = u >> 7, b = bhk >> 1, hkv = bhk & 1, hq = hkv * 4 + ((u & 127) >> 5), qb = u & 31; const size_t r0 = (size_t)b * SEQ + qb * 256;
        const int tl = max(qb * 4 - 2, 0), th = min(qb * 4 + 6, SEQ / 64); const size_t k0 = (size_t)b * SEQ + tl * 64;
        attn_body::attn_unit<1, 1024, 8>((const attn_body::bf16*)(Qb + r0 * 512 + hq * 64), (const attn_body::bf16*)(Kb + k0 * 128 + hkv * 64), (const attn_body::bf16*)(Vb + k0 * 128 + hkv * 64),
                                        (attn_body::bf16*)(OCAT + r0 * D + 512 + hq * 64), th - tl, tl * 64 - qb * 256, 128, sink[hq] * 1.4426950408889634f, true, nullptr, shm); }
}
__device__ __forceinline__ void attn_phase_l1(Frame& F, const bf16* Q3, const bf16* K3, const bf16* V3, bf16* OGB, float* LSE) {
    char* shm = (char*)(F.lds + RING_OFF);
    const int upc = (512 + F.G - 1) / F.G;
#pragma unroll 1
    for (int g = 0; g < 3; ++g) { const int Lc = SEQ >> (2 * g);
        for (int i = 0; i < upc; ++i) { const int u = F.vcu * upc + i; if (u >= 512) break;
            const int bhk = u >> 7, b = bhk >> 1, hkv = bhk & 1, hq = hkv * 4 + ((u & 127) >> 5), qb = u & 31; const size_t r0 = (size_t)b * SEQ + qb * 256;
            const int q0 = qb * 256, cbase = q0 & ~(Lc - 1), lq0 = q0 & (Lc - 1); const int tl = min(max(lq0 / 64 - 1, 0), Lc / 64 - 6); const size_t k0 = (size_t)b * SEQ + cbase + tl * 64;
            attn_body::attn_unit<1, 512, 8>((const attn_body::bf16*)(Q3 + (size_t)g * T * 512 + r0 * 512 + hq * 64), (const attn_body::bf16*)(K3 + (size_t)g * T * 128 + k0 * 128 + hkv * 64), (const attn_body::bf16*)(V3 + (size_t)g * T * 128 + k0 * 128 + hkv * 64),
                                           (attn_body::bf16*)(OGB + (size_t)g * T * 512 + r0 * 512 + hq * 64), 6, cbase + tl * 64 - q0, 64, 0.f, false, LSE + (size_t)g * T * 8 + r0 * 8 + hq, shm); }
    }
}
__device__ __forceinline__ void merge_phase(Frame& F, const bf16* OGB, const float* LSE, bf16* OCAT1) {
    for (int m = F.gw; m < T; m += F.NGW) {
        const int h = F.lane >> 3; const int b = m / SEQ, pos = m % SEQ;
        const size_t r0 = m, r1 = (size_t)b * SEQ + (size_t)(pos & 3) * (SEQ / 4) + (pos >> 2), r2 = (size_t)b * SEQ + (size_t)(pos & 15) * (SEQ / 16) + (pos >> 4);
        const float l0 = LSE[r0 * 8 + h], l1 = LSE[(size_t)T * 8 + r1 * 8 + h], l2 = LSE[(size_t)2 * T * 8 + r2 * 8 + h];
        const float mx = fmaxf(l0, fmaxf(l1, l2)); float w0 = __expf(l0 - mx), w1 = __expf(l1 - mx), w2 = __expf(l2 - mx); const float is = 1.f / (w0 + w1 + w2); w0 *= is; w1 *= is; w2 *= is;
        const v4u a = *(const v4u*)(OGB + r0 * 512 + F.lane * 8), bb = *(const v4u*)(OGB + (size_t)T * 512 + r1 * 512 + F.lane * 8), c = *(const v4u*)(OGB + (size_t)2 * T * 512 + r2 * 512 + F.lane * 8);
        v4u w;
        w.x = pk2(w0 * bflo(a.x) + w1 * bflo(bb.x) + w2 * bflo(c.x), w0 * bfhi(a.x) + w1 * bfhi(bb.x) + w2 * bfhi(c.x));
        w.y = pk2(w0 * bflo(a.y) + w1 * bflo(bb.y) + w2 * bflo(c.y), w0 * bfhi(a.y) + w1 * bfhi(bb.y) + w2 * bfhi(c.y));
        w.z = pk2(w0 * bflo(a.z) + w1 * bflo(bb.z) + w2 * bflo(c.z), w0 * bfhi(a.z) + w1 * bfhi(bb.z) + w2 * bfhi(c.z));
        w.w = pk2(w0 * bflo(a.w) + w1 * bflo(bb.w) + w2 * bflo(c.w), w0 * bfhi(a.w) + w1 * bfhi(bb.w) + w2 * bfhi(c.w));
        *(v4u*)(OCAT1 + (size_t)m * C_OUT + F.lane * 8) = w;
    }
}

typedef float f32x4m __attribute__((ext_vector_type(4)));
__device__ __forceinline__ void top4_merge(float (&v)[4], int (&ix)[4], int mask) {
    float ov[4]; int oi[4];
#pragma unroll
    for (int k = 0; k < 4; ++k) { ov[k] = __shfl_xor(v[k], mask); oi[k] = __shfl_xor(ix[k], mask); }
    float cv[8]; int ci[8];
#pragma unroll
    for (int k = 0; k < 4; ++k) { cv[k] = v[k]; ci[k] = ix[k]; cv[4 + k] = ov[k]; ci[4 + k] = oi[k]; }
    unsigned used = 0u;
#pragma unroll
    for (int k = 0; k < 4; ++k) { float best = -INFINITY; int bi = 1 << 30, bp = 0;
#pragma unroll
        for (int c = 0; c < 8; ++c) { const bool take = !((used >> c) & 1u) && (cv[c] > best || (cv[c] == best && ci[c] < bi)); best = take ? cv[c] : best; bi = take ? ci[c] : bi; bp = take ? c : bp; }
        used |= 1u << bp; v[k] = best; ix[k] = bi; }
}
__device__ __forceinline__ void route_phase(Frame& F, const bf16* H, const float* WR, const float* rb, int* CNTTAB, int* TOPE, float* TOPG, int* TOPPOS, float* RSTD) {
    LAS float* WL = (LAS float*)(F.lds + RING_OFF);
    LAS unsigned* LC = (LAS unsigned*)(F.lds + RING_OFF + NE * 1028 * 4);
    if (F.tid < NE) LC[F.tid] = 0u;
    for (int i = F.tid; i < NE * D / 4; i += NWAVES * 64) { const int e = i >> 8, k4 = i & 255; *(LAS f32x4*)(WL + e * 1028 + 4 * k4) = *(const f32x4*)(WR + (size_t)e * D + 4 * k4); }
    __syncthreads();
    const int lane = F.lane, c = lane & 15, q = lane >> 4;
    for (int task = F.wave * F.G + F.vcu; task < T / 16; task += F.NGW) {
        const bf16* xr = H + (size_t)(task * 16 + c) * D + 8 * q;
        const LAS float* w0 = WL + c * 1028 + 8 * q; const LAS float* w1 = w0 + 16 * 1028;
        f32x4m a0 = {0.f, 0.f, 0.f, 0.f}, a1 = {0.f, 0.f, 0.f, 0.f}; float ssq = 0.f;
#pragma unroll 4
        for (int ch = 0; ch < 32; ++ch) {
            const v4u xv = *(const v4u*)(xr + 32 * ch);
            float xf[8]; xf[0] = bflo(xv.x); xf[1] = bfhi(xv.x); xf[2] = bflo(xv.y); xf[3] = bfhi(xv.y); xf[4] = bflo(xv.z); xf[5] = bfhi(xv.z); xf[6] = bflo(xv.w); xf[7] = bfhi(xv.w);
            const f32x4 wa0 = *(const LAS f32x4*)(w0 + 32 * ch), wa1 = *(const LAS f32x4*)(w0 + 32 * ch + 4), wb0 = *(const LAS f32x4*)(w1 + 32 * ch), wb1 = *(const LAS f32x4*)(w1 + 32 * ch + 4);
#pragma unroll
            for (int t = 0; t < 8; ++t) ssq += xf[t] * xf[t];
            a0 = __builtin_amdgcn_mfma_f32_16x16x4f32(wa0.x, xf[0], a0, 0, 0, 0); a1 = __builtin_amdgcn_mfma_f32_16x16x4f32(wb0.x, xf[0], a1, 0, 0, 0);
            a0 = __builtin_amdgcn_mfma_f32_16x16x4f32(wa0.y, xf[1], a0, 0, 0, 0); a1 = __builtin_amdgcn_mfma_f32_16x16x4f32(wb0.y, xf[1], a1, 0, 0, 0);
            a0 = __builtin_amdgcn_mfma_f32_16x16x4f32(wa0.z, xf[2], a0, 0, 0, 0); a1 = __builtin_amdgcn_mfma_f32_16x16x4f32(wb0.z, xf[2], a1, 0, 0, 0);
            a0 = __builtin_amdgcn_mfma_f32_16x16x4f32(wa0.w, xf[3], a0, 0, 0, 0); a1 = __builtin_amdgcn_mfma_f32_16x16x4f32(wb0.w, xf[3], a1, 0, 0, 0);
            a0 = __builtin_amdgcn_mfma_f32_16x16x4f32(wa1.x, xf[4], a0, 0, 0, 0); a1 = __builtin_amdgcn_mfma_f32_16x16x4f32(wb1.x, xf[4], a1, 0, 0, 0);
            a0 = __builtin_amdgcn_mfma_f32_16x16x4f32(wa1.y, xf[5], a0, 0, 0, 0); a1 = __builtin_amdgcn_mfma_f32_16x16x4f32(wb1.y, xf[5], a1, 0, 0, 0);
            a0 = __builtin_amdgcn_mfma_f32_16x16x4f32(wa1.z, xf[6], a0, 0, 0, 0); a1 = __builtin_amdgcn_mfma_f32_16x16x4f32(wb1.z, xf[6], a1, 0, 0, 0);
            a0 = __builtin_amdgcn_mfma_f32_16x16x4f32(wa1.w, xf[7], a0, 0, 0, 0); a1 = __builtin_amdgcn_mfma_f32_16x16x4f32(wb1.w, xf[7], a1, 0, 0, 0);
        }
        ssq += __shfl_xor(ssq, 16); ssq += __shfl_xor(ssq, 32);
        const float rstd = 1.f / sqrtf(ssq * (1.f / D) + NORM_EPS);
        float cv[8]; int ci[8];
#pragma unroll
        for (int r = 0; r < 4; ++r) { ci[r] = 4 * q + r; ci[4 + r] = 16 + 4 * q + r; cv[r] = a0[r] * rstd + rb[4 * q + r]; cv[4 + r] = a1[r] * rstd + rb[16 + 4 * q + r]; }
        float tv[4]; int ti[4]; unsigned used = 0u;
#pragma unroll
        for (int k = 0; k < 4; ++k) { float best = -INFINITY; int bi = 0, bp = 0;
#pragma unroll
            for (int j = 0; j < 8; ++j) { const bool take = !((used >> j) & 1u) && (cv[j] > best); best = take ? cv[j] : best; bi = take ? ci[j] : bi; bp = take ? j : bp; }
            used |= 1u << bp; tv[k] = best; ti[k] = bi; }
        top4_merge(tv, ti, 16); top4_merge(tv, ti, 32);
        const float e1 = __expf(tv[1] - tv[0]), e2 = __expf(tv[2] - tv[0]), e3 = __expf(tv[3] - tv[0]); const float is = 1.f / (1.f + e1 + e2 + e3);
        const int m = task * 16 + c;
        { const int e = q == 0 ? ti[0] : q == 1 ? ti[1] : q == 2 ? ti[2] : ti[3]; const float g = (q == 0 ? 1.f : q == 1 ? e1 : q == 2 ? e2 : e3) * is;
            const unsigned pos = __hip_atomic_fetch_add(LC + e, 1u, __ATOMIC_RELAXED, __HIP_MEMORY_SCOPE_WORKGROUP);
            TOPE[m * 4 + q] = e; TOPG[m * 4 + q] = g; TOPPOS[m * 4 + q] = (int)pos; }
        if (q == 0) RSTD[m] = rstd;
    }
    __syncthreads();
    if (F.tid < NE) CNTTAB[F.vcu * NE + F.tid] = (int)LC[F.tid];
    __syncthreads();
}
__device__ __forceinline__ void slot_phase(Frame& F, const bf16* H, const int* CNTTAB, const int* TOPE, const float* TOPG, const int* TOPPOS, const float* RSTD, int* TOKSLOT, float* SLOTGATE, float* SLOTRS, bf16* XG, int* XTAB, bool f8) {
    LAS int* L = (LAS int*)(F.lds + RING_OFF);
    LAS int* P = L + 128;
    const int lane = F.lane;
    {
#pragma unroll 1
        for (int ee = 0; ee < 4; ++ee) { const int e = F.wave * 4 + ee;
            int s0 = 0, s1 = 0, s2 = 0, s3 = 0; const int g0 = 4 * lane;
            if (g0 < F.G) s0 = CNTTAB[g0 * NE + e]; if (g0 + 1 < F.G) s1 = CNTTAB[(g0 + 1) * NE + e]; if (g0 + 2 < F.G) s2 = CNTTAB[(g0 + 2) * NE + e]; if (g0 + 3 < F.G) s3 = CNTTAB[(g0 + 3) * NE + e];
            const int t = s0 + s1 + s2 + s3; int inc = t;
#pragma unroll
            for (int o = 1; o < 64; o <<= 1) { const int u = __shfl_up(inc, o); if (lane >= o) inc += u; }
            const int base = inc - t;
            P[g0 * NE + e] = base; P[(g0 + 1) * NE + e] = base + s0; P[(g0 + 2) * NE + e] = base + s0 + s1; P[(g0 + 3) * NE + e] = base + s0 + s1 + s2;
            if (lane == 63) L[64 + e] = inc; }
    }
    __syncthreads();
    if (F.wave == 0) {
        const int np = (lane < 32) ? ((L[64 + (lane & 31)] + 255) >> 8) : 0;
        int pre = np;
#pragma unroll
        for (int o = 1; o < 32; o <<= 1) { const int t = __shfl_up(pre, o); if (lane >= o) pre += t; }
        const int p0 = pre - np;
        if (lane < 32) { L[lane] = np; L[32 + lane] = p0 * 256; }
        if (F.bx == 0) {
            int load = 0, ne = 0, cump = 0; bool done = (lane >= 32);
            for (int it = 0; it < 32; ++it) {
                int key = done ? -1 : (np * 64 + (31 - lane));
#pragma unroll
                for (int o = 1; o < 64; o <<= 1) key = max(key, __shfl_xor(key, o));
                const int be = 31 - (key & 63), bn = key >> 6;
                int lk = (lane < 8) ? (load * 8 + lane) : (1 << 30);
#pragma unroll
                for (int o = 1; o < 64; o <<= 1) lk = min(lk, __shfl_xor(lk, o));
                const int bx = lk & 7;
                const int bp0 = __shfl(p0, be);
                if (lane == bx) { int* tb = XTAB + bx * 136 + 4 + 4 * ne; tb[0] = be; tb[1] = bp0; tb[2] = bn; tb[3] = cump; cump += bn; load += bn; ++ne; }
                if (lane == be) done = true;
            }
            if (lane < 8) { XTAB[lane * 136] = ne; XTAB[lane * 136 + 1] = cump; }
        }
    }
    __syncthreads();
    for (int m = F.gw; m < T; m += F.NGW) {
        int slot = 0;
        if (lane < 4) { const int e = TOPE[m * 4 + lane]; const int wg = (m >> 4) % F.G; slot = L[32 + e] + P[wg * NE + e] + TOPPOS[m * 4 + lane]; TOKSLOT[m * 4 + lane] = slot; SLOTGATE[slot] = TOPG[m * 4 + lane]; SLOTRS[slot] = RSTD[m]; }
        const int s0 = __shfl(slot, 0), s1 = __shfl(slot, 1), s2 = __shfl(slot, 2), s3 = __shfl(slot, 3);
        if (f8) {
            const bf16* src = H + (size_t)m * D + lane * 16; const v4u a = *(const v4u*)src, b = *(const v4u*)(src + 8); const float rs = RSTD[m];
            v4u w; w.x = pk4_fp8(clamp448(bflo(a.x) * rs), clamp448(bfhi(a.x) * rs), clamp448(bflo(a.y) * rs), clamp448(bfhi(a.y) * rs)); w.y = pk4_fp8(clamp448(bflo(a.z) * rs), clamp448(bfhi(a.z) * rs), clamp448(bflo(a.w) * rs), clamp448(bfhi(a.w) * rs));
            w.z = pk4_fp8(clamp448(bflo(b.x) * rs), clamp448(bfhi(b.x) * rs), clamp448(bflo(b.y) * rs), clamp448(bfhi(b.y) * rs)); w.w = pk4_fp8(clamp448(bflo(b.z) * rs), clamp448(bfhi(b.z) * rs), clamp448(bflo(b.w) * rs), clamp448(bfhi(b.w) * rs));
            unsigned char* X8 = (unsigned char*)XG; const size_t co = (size_t)lane * 16;
            *(v4u*)(X8 + (size_t)s0 * D + co) = w; *(v4u*)(X8 + (size_t)s1 * D + co) = w; *(v4u*)(X8 + (size_t)s2 * D + co) = w; *(v4u*)(X8 + (size_t)s3 * D + co) = w;
        } else {
        const bf16* src = H + (size_t)m * D + lane * 8; const v4u a = *(const v4u*)src, b = *(const v4u*)(src + 512);
        const size_t co = (size_t)lane * 8;
        *(v4u*)(XG + (size_t)s0 * D + co) = a; *(v4u*)(XG + (size_t)s0 * D + co + 512) = b;
        *(v4u*)(XG + (size_t)s1 * D + co) = a; *(v4u*)(XG + (size_t)s1 * D + co + 512) = b;
        *(v4u*)(XG + (size_t)s2 * D + co) = a; *(v4u*)(XG + (size_t)s2 * D + co + 512) = b;
        *(v4u*)(XG + (size_t)s3 * D + co) = a; *(v4u*)(XG + (size_t)s3 * D + co + 512) = b;
        }
    }
    __syncthreads();
}
__device__ __forceinline__ void combine_phase(Frame& F, const bf16* HM, const bf16* Y, const int* TOKSLOT, bf16* H2) {
    const int lane = F.lane;
    for (int m = F.gw; m < T; m += F.NGW) {
        const int s0 = TOKSLOT[m * 4], s1 = TOKSLOT[m * 4 + 1], s2 = TOKSLOT[m * 4 + 2], s3 = TOKSLOT[m * 4 + 3];
#pragma unroll
        for (int j = 0; j < 2; ++j) { const size_t co = (size_t)j * 512 + lane * 8; const v4u h = *(const v4u*)(HM + (size_t)m * D + co);
            const v4u y0 = *(const v4u*)(Y + (size_t)s0 * D + co), y1 = *(const v4u*)(Y + (size_t)s1 * D + co), y2 = *(const v4u*)(Y + (size_t)s2 * D + co), y3 = *(const v4u*)(Y + (size_t)s3 * D + co);
            v4u w;
            w.x = pk2(bflo(h.x) + (((bflo(y0.x) + bflo(y1.x)) + bflo(y2.x)) + bflo(y3.x)), bfhi(h.x) + (((bfhi(y0.x) + bfhi(y1.x)) + bfhi(y2.x)) + bfhi(y3.x)));
            w.y = pk2(bflo(h.y) + (((bflo(y0.y) + bflo(y1.y)) + bflo(y2.y)) + bflo(y3.y)), bfhi(h.y) + (((bfhi(y0.y) + bfhi(y1.y)) + bfhi(y2.y)) + bfhi(y3.y)));
            w.z = pk2(bflo(h.z) + (((bflo(y0.z) + bflo(y1.z)) + bflo(y2.z)) + bflo(y3.z)), bfhi(h.z) + (((bfhi(y0.z) + bfhi(y1.z)) + bfhi(y2.z)) + bfhi(y3.z)));
            w.w = pk2(bflo(h.w) + (((bflo(y0.w) + bflo(y1.w)) + bflo(y2.w)) + bflo(y3.w)), bfhi(h.w) + (((bfhi(y0.w) + bfhi(y1.w)) + bfhi(y2.w)) + bfhi(y3.w)));
            *(v4u*)(H2 + (size_t)m * D + co) = w; }
    }
}
__device__ __forceinline__ void final_norm_phase(Frame& F, const bf16* H, const float* SS, const float* gain, float* out) {
    const int lane = F.lane;
    for (int m = F.gw; m < T; m += F.NGW) {
        const float rstd = 1.f / sqrtf(ssp_sum(SS + (size_t)m * 16) * (1.f / D) + NORM_EPS);
#pragma unroll
        for (int j = 0; j < 2; ++j) { const size_t co = (size_t)j * 512 + lane * 8; const v4u h = *(const v4u*)(H + (size_t)m * D + co); const f32x4 g0 = *(const f32x4*)(gain + co), g1 = *(const f32x4*)(gain + co + 4);
            f32x4 o0, o1; o0.x = bflo(h.x) * rstd * g0.x; o0.y = bfhi(h.x) * rstd * g0.y; o0.z = bflo(h.y) * rstd * g0.z; o0.w = bfhi(h.y) * rstd * g0.w;
            o1.x = bflo(h.z) * rstd * g1.x; o1.y = bfhi(h.z) * rstd * g1.y; o1.z = bflo(h.w) * rstd * g1.z; o1.w = bfhi(h.w) * rstd * g1.w;
            float* dst = out + (size_t)m * D + co; *(f32x4*)dst = o0; *(f32x4*)(dst + 4) = o1; }
    }
}

constexpr int N_PHASES = 22;
struct Args { const float* in[20]; float* out; unsigned char* ws; int ph_lo, ph_hi, li, pad; };
typedef const __attribute__((address_space(4))) Args* argp_t;
__device__ __forceinline__ argp_t opaque_args() { argp_t p = (argp_t)__builtin_amdgcn_kernarg_segment_ptr(); asm volatile("" : "+s"(p)); return p; }
#define AP (opaque_args())
__global__ void __launch_bounds__(NWAVES * 64, 2) fwd_kernel(Args args_unused) {
    extern __shared__ __attribute__((aligned(16))) unsigned char lds[];
    Frame F;
    F.lds = (LAS unsigned char*)lds;
    F.MISC = (volatile LAS unsigned*)(F.lds + MISC_OFF);
    refresh(F);
    F.ctl = (gu32*)(AP->ws + WS_CTL);
    if (F.tid < 128) ((LAS unsigned*)(F.lds + LDSCTL_OFF))[F.tid] = 0u;
    __syncthreads();
    const bool one_phase = (AP->ph_hi - AP->ph_lo) == 1;
    XcdBarrier bar; bar.bar = (unsigned*)(F.ctl + CW_BAR); bar.x = 0; bar.st = nullptr;
    if (!one_phase) bar = xcd_barrier_post((unsigned*)(F.ctl + CW_BAR), F.MISC + 8);
    const int lo = AP->ph_lo, hi = AP->ph_hi;
#ifndef MK_MASK
#define MK_MASK 0x3fff
#endif
#ifndef PROBE_MASK
#define PROBE_MASK 0
#endif
#define IN(k) (lo <= (k) && (k) < hi)
#define INL(j) (((MK_MASK >> (j)) & 1) && IN(pb + (j)) && refresh(F))
#define REP(j) _Pragma("unroll") for (int rep_ = 0; rep_ < (((PROBE_MASK >> (j)) & 1) ? 2 : 1); ++rep_)
#define SEAM(k) do { if (IN((k) + 1)) xcd_barrier(bar); } while (0)
#define ws (AP->ws)
#define WSP(type, off) ((type*)(ws + (off)))
    if (((MK_MASK >> 12) & 1) && IN(0) && refresh(F)) REP(12) {
#pragma unroll 1
        for (int ll = 0; ll < 2; ++ll) {
            const float* wu = AP->in[13] + (size_t)ll * NE * D * 2 * DE; const float* wd = AP->in[15] + (size_t)ll * NE * DE * D; const float* gf = AP->in[10] + ll * D;
            unsigned char* du = ws + WS_WUPT + (size_t)ll * NE * 2 * DE * D * 2; unsigned char* dd = ws + WS_WDNT + (size_t)ll * NE * D * DE * 2;
#if MOE_FP8_MASK != 0
            if ((MOE_FP8_MASK >> ll) & 1) {
                transpose_family_f8<1>(F, wu, (size_t)D * 2 * DE, du, (size_t)2 * DE * D, gf, 0, D, 2 * DE, NE, 1);
                transpose_family_f8<0>(F, wd, (size_t)DE * D, dd, (size_t)D * DE, nullptr, 0, DE, D, NE, 1);
            }
#endif
#if MOE_FP8_MASK != 3
            if (!((MOE_FP8_MASK >> ll) & 1)) {
                transpose_family<1>(F, wu, (size_t)D * 2 * DE, (bf16*)du, (size_t)2 * DE * D, gf, 0, D, 2 * DE, NE, 1);
                transpose_family<0>(F, wd, (size_t)DE * D, (bf16*)dd, (size_t)D * DE, nullptr, 0, DE, D, NE, 1);
            }
#endif
        }
        transpose_family<2>(F, AP->in[3], 0, WSP(bf16, WS_WIN0T), 0, AP->in[2], 0, D, AB_IN, 1, 1);
        transpose_family<3>(F, AP->in[8], 0, WSP(bf16, WS_WIN1T), 0, AP->in[2] + D, 0, D, C_IN, 1, 1);
        transpose_family<0>(F, AP->in[7], 0, WSP(bf16, WS_WOUT0T), 0, nullptr, 0, D, D, 1, 1);
        transpose_family<0>(F, AP->in[9], 0, WSP(bf16, WS_WOUT1T), 0, nullptr, 0, C_OUT, D, 1, 1);
        transpose_family<0>(F, AP->in[18], (size_t)D * D, WSP(bf16, WS_WGT), (size_t)D * D, nullptr, 0, D, D, 2, 1);
        transpose_family<0>(F, AP->in[17], (size_t)PLE * D, WSP(bf16, WS_WPT), (size_t)D * PLE, nullptr, 0, PLE, D, 2, 1);
        {
            float* WR = WSP(float, WS_WR); const float* nf = AP->in[10]; const float* rw = AP->in[11];
            for (int i = F.gw * 64 + F.lane; i < 2 * NE * D; i += F.NGW * 64) { const int l = i / (NE * D), e = (i / D) % NE, k = i % D; WR[i] = nf[l * D + k] * rw[((size_t)l * D + k) * NE + e]; }
        }
        {
            float* R1 = WSP(float, WS_ROPE1); float* RA = WSP(float, WS_ROPEA);
            for (int i = F.gw * 64 + F.lane; i < SEQ * 32; i += F.NGW * 64) { const int pos = i >> 5, j = i & 31;
                const float a1 = (float)pos * rope_freq(j, 32); R1[2 * i] = cosf(a1); R1[2 * i + 1] = sinf(a1);
                const float aa = (float)((j < 16) ? (pos >> 6) : (pos & 63)) * rope_freq(j & 15, 16); RA[2 * i] = cosf(aa); RA[2 * i + 1] = sinf(aa); }
        }
        {
            bf16* PBF = WSP(bf16, WS_PBF); const float* p_in = AP->in[1]; const size_t n8 = (size_t)2 * T * PLE / 8;
            for (size_t i = (size_t)F.gw * 64 + F.lane; i < n8; i += (size_t)F.NGW * 64) { const f32x4 a = *(const f32x4*)(p_in + i * 8), b = *(const f32x4*)(p_in + i * 8 + 4);
                v4u w; w.x = pk2(a.x, a.y); w.y = pk2(a.z, a.w); w.z = pk2(b.x, b.y); w.w = pk2(b.z, b.w); *(v4u*)(PBF + i * 8) = w; }
        }
        {
            bf16* X0 = WSP(bf16, WS_X0); float* SS0 = WSP(float, WS_SSP); const float* x_in = AP->in[0];
            for (int m = F.gw; m < T; m += F.NGW) { float s = 0.f;
#pragma unroll
                for (int j = 0; j < 2; ++j) { const size_t co = (size_t)m * D + j * 512 + F.lane * 8; const f32x4 a = *(const f32x4*)(x_in + co), b = *(const f32x4*)(x_in + co + 4);
                    v4u w; w.x = pk2(a.x, a.y); w.y = pk2(a.z, a.w); w.z = pk2(b.x, b.y); w.w = pk2(b.z, b.w); *(v4u*)(X0 + co) = w;
                    s += (bflo(w.x) * bflo(w.x) + bfhi(w.x) * bfhi(w.x)) + (bflo(w.y) * bflo(w.y) + bfhi(w.y) * bfhi(w.y)) + (bflo(w.z) * bflo(w.z) + bfhi(w.z) * bfhi(w.z)) + (bflo(w.w) * bflo(w.w) + bfhi(w.w) * bfhi(w.w)); }
                s = wave_sum(s); if (F.lane < 16) SS0[(size_t)m * 16 + F.lane] = (F.lane == 0) ? s : 0.f; }
        }
        __syncthreads();
        SEAM(0);
    }
#pragma unroll 1
    for (int l = 0; l < 2; ++l) {
        const int pb = 1 + 10 * l;
        if (INL(0)) REP(0) {
            const bf16* hin = (l == 0) ? WSP(bf16, WS_X0) : WSP(bf16, WS_H3);
            const float* ssin = WSP(float, WS_SSP) + (size_t)l * T * 16;
            if (l == 0) { pg8::Gemm g{hin, WSP(bf16, WS_WIN0T), T, AB_IN, D}; pg8::StaticOrder S; S.init(T, AB_IN, F.G, F.bx);
                EpiQKV<0> E{ssin, AP->in[4], AP->in[5], WSP(float, WS_ROPE1), WSP(float, WS_ROPEA), WSP(bf16, WS_Q3), WSP(bf16, WS_K3), WSP(bf16, WS_V3)};
                pg8::gemm_phase<EpiQKV<0>, pg8::StaticOrder, true, true>(F.lds + RING_OFF, g, S, E); }
            else { pg8::Gemm g{hin, WSP(bf16, WS_WIN1T), T, C_IN, D}; pg8::StaticOrder S; S.init(T, C_IN, F.G, F.bx);
                EpiQKV<1> E{ssin, nullptr, nullptr, WSP(float, WS_ROPE1), WSP(float, WS_ROPEA), WSP(bf16, WS_Q3), WSP(bf16, WS_K3), WSP(bf16, WS_V3)};
                pg8::gemm_phase<EpiQKV<1>, pg8::StaticOrder, true, true>(F.lds + RING_OFF, g, S, E); }
            if (l == 0) { int Kp = PLE; asm volatile("" : "+s"(Kp)); pg8::Gemm g{WSP(bf16, WS_PBF), WSP(bf16, WS_WPT), 2 * T, 2 * D, Kp}; PPOrder S{(int)F.G, F.bx};
                EpiPP E{WSP(bf16, WS_PP)};
                pg8::gemm_phase<EpiPP, PPOrder, true, true>(F.lds + RING_OFF, g, S, E); }
            SEAM(pb + 0);
        }
        if (INL(1)) REP(1) {
            if (l == 0) attn_phase_l0(F, WSP(bf16, WS_Q3), WSP(bf16, WS_K3), WSP(bf16, WS_V3), WSP(bf16, WS_OCAT), AP->in[6]);
            else attn_phase_l1(F, WSP(bf16, WS_Q3), WSP(bf16, WS_K3), WSP(bf16, WS_V3), WSP(bf16, WS_OGB), WSP(float, WS_LSE));
            SEAM(pb + 1);
        }
        if (INL(2)) REP(2) { if (l == 1) merge_phase(F, WSP(bf16, WS_OGB), WSP(float, WS_LSE), WSP(bf16, WS_OCAT)); SEAM(pb + 2); }
        if (INL(3)) REP(3) {
            const bf16* hin = (l == 0) ? WSP(bf16, WS_X0) : WSP(bf16, WS_H3);
            pg8::Gemm g{WSP(bf16, WS_OCAT), (const bf16*)(ws + (l == 0 ? WS_WOUT0T : WS_WOUT1T)), T, D, (l == 0) ? D : C_OUT}; pg8::StaticOrder S; S.init(T, D, F.G, F.bx); EpiResBf16 E{hin, WSP(bf16, WS_HM)};
            pg8::gemm_phase<EpiResBf16, pg8::StaticOrder, true, true>(F.lds + RING_OFF, g, S, E);
            SEAM(pb + 3);
        }
        if (INL(4)) REP(4) { route_phase(F, WSP(bf16, WS_HM), WSP(float, WS_WR) + (size_t)l * NE * D, AP->in[12] + l * NE, WSP(int, WS_CNTTAB), WSP(int, WS_TOPE), WSP(float, WS_TOPG), WSP(int, WS_TOPPOS), WSP(float, WS_RSTD));
#ifdef PROBE_ROUTE
            route_phase(F, WSP(bf16, WS_HM), WSP(float, WS_WR) + (size_t)l * NE * D, AP->in[12] + l * NE, WSP(int, WS_OGB) + 16 * T, WSP(int, WS_OGB), WSP(float, WS_OGB) + 4 * T, WSP(int, WS_OGB) + 8 * T, WSP(float, WS_OGB) + 12 * T);
#endif
            SEAM(pb + 4); }
        if (INL(5)) REP(5) { slot_phase(F, WSP(bf16, WS_HM), WSP(int, WS_CNTTAB), WSP(int, WS_TOPE), WSP(float, WS_TOPG), WSP(int, WS_TOPPOS), WSP(float, WS_RSTD), WSP(int, WS_TOKSLOT), WSP(float, WS_SLOTGATE), WSP(float, WS_SLOTRS), WSP(bf16, WS_XG), WSP(int, WS_XTAB), ((MOE_FP8_MASK >> l) & 1) != 0); SEAM(pb + 5); }
        if (INL(6)) REP(6) {
            XcdOrder<3> S{WSP(int, WS_XTAB) + (F.bx & 7) * 136, F.bx >> 3, (int)F.G >> 3};
#if MOE_FP8_MASK != 0
            if ((MOE_FP8_MASK >> l) & 1) { pg8::Gemm g{WSP(bf16, WS_XG), WSP(bf16, WS_WUPT) + (size_t)l * NE * 2 * DE * D, NSLOT, NE * 2 * DE, D / 2};
                EpiSwiglu<true> E{WSP(void, WS_ACT), AP->in[14] + (size_t)l * NE * 2 * DE, nullptr};
                pg8::gemm_phase<EpiSwiglu<true>, XcdOrder<3>, true, true, F8_DIAG ? 1000 : 127 - F8_WSC>(F.lds + RING_OFF, g, S, E); }
#endif
#if MOE_FP8_MASK != 3
            if (!((MOE_FP8_MASK >> l) & 1)) { pg8::Gemm g{WSP(bf16, WS_XG), WSP(bf16, WS_WUPT) + (size_t)l * NE * 2 * DE * D, NSLOT, NE * 2 * DE, D};
                EpiSwiglu<false> E{WSP(void, WS_ACT), AP->in[14] + (size_t)l * NE * 2 * DE, WSP(float, WS_SLOTRS)};
                pg8::gemm_phase<EpiSwiglu<false>, XcdOrder<3>, true, true>(F.lds + RING_OFF, g, S, E); }
#endif
            SEAM(pb + 6);
        }
        if (INL(7)) REP(7) {
            XcdOrder<2> S{WSP(int, WS_XTAB) + (F.bx & 7) * 136, F.bx >> 3, (int)F.G >> 3};
            EpiDown E{WSP(bf16, WS_Y), AP->in[16] + (size_t)l * NE * D, WSP(float, WS_SLOTGATE), ((MOE_FP8_MASK >> l) & 1) ? F8_EPI_SC : 1.f};
#if MOE_FP8_MASK != 0
            if ((MOE_FP8_MASK >> l) & 1) { pg8::Gemm g{WSP(bf16, WS_ACT), WSP(bf16, WS_WDNT) + (size_t)l * NE * D * DE, NSLOT, NE * D, DE / 2};
                pg8::gemm_phase<EpiDown, XcdOrder<2>, true, true, F8_DIAG ? 1000 : 127 - F8_WSC>(F.lds + RING_OFF, g, S, E); }
#endif
#if MOE_FP8_MASK != 3
            if (!((MOE_FP8_MASK >> l) & 1)) { pg8::Gemm g{WSP(bf16, WS_ACT), WSP(bf16, WS_WDNT) + (size_t)l * NE * D * DE, NSLOT, NE * D, DE};
                pg8::gemm_phase<EpiDown, XcdOrder<2>, true, true>(F.lds + RING_OFF, g, S, E); }
#endif
            SEAM(pb + 7);
        }
        if (INL(8)) REP(8) { combine_phase(F, WSP(bf16, WS_HM), WSP(bf16, WS_Y), WSP(int, WS_TOKSLOT), WSP(bf16, WS_H2)); SEAM(pb + 8); }
        if (INL(9)) REP(9) {
            pg8::Gemm g{WSP(bf16, WS_H2), WSP(bf16, WS_WGT) + (size_t)l * D * D, T, D, D}; pg8::StaticOrder S; S.init(T, D, F.G, F.bx);
            EpiPle E{WSP(bf16, WS_H2), WSP(bf16, WS_PP) + (size_t)l * T * D, WSP(bf16, WS_H3), WSP(float, WS_SSP) + (size_t)(l + 1) * T * 16};
            pg8::gemm_phase<EpiPle, pg8::StaticOrder, true, true>(F.lds + RING_OFF, g, S, E);
            SEAM(pb + 9);
        }
    }
    if (((MK_MASK >> 13) & 1) && IN(21) && refresh(F)) final_norm_phase(F, WSP(bf16, WS_H3), WSP(float, WS_SSP) + (size_t)2 * T * 16, AP->in[19], AP->out);
#undef IN
#undef INL
#undef REP
#undef SEAM
#undef ws
#undef WSP
}

#ifndef MK_ONE_LAUNCH
#define MK_ONE_LAUNCH 1
#endif
extern "C" void kernel_launch(void* const* d_in, const int* in_sizes, int n_in, void* d_out, int out_size, void* d_ws, size_t ws_size, hipStream_t stream) {
    static int grid = 0;
    if (grid == 0) {
        if (n_in != 20 || in_sizes[0] != T * D || out_size != T * D || ws_size < WS_END) { fprintf(stderr, "kernel_launch: unexpected shapes: n_in %d in0 %d out %d ws %zu (need %zu)\n", n_in, n_in > 0 ? in_sizes[0] : -1, out_size, ws_size, (size_t)WS_END); grid = -1; return; }
        int dev = 0, cus = 0, per_cu = 0;
        if (hipGetDevice(&dev) != hipSuccess || hipDeviceGetAttribute(&cus, hipDeviceAttributeMultiprocessorCount, dev) != hipSuccess) { grid = -1; return; }
        if (hipFuncSetAttribute((const void*)fwd_kernel, hipFuncAttributeMaxDynamicSharedMemorySize, LDS_BYTES) != hipSuccess) { fprintf(stderr, "kernel_launch: hipFuncSetAttribute failed\n"); grid = -1; return; }
        if (hipOccupancyMaxActiveBlocksPerMultiprocessor(&per_cu, (const void*)fwd_kernel, NWAVES * 64, LDS_BYTES) != hipSuccess || per_cu < 1) fprintf(stderr, "kernel_launch: occupancy query says %d\n", per_cu);
        (void)hipGetLastError();
        grid = cus;
        if (grid != 256) fprintf(stderr, "kernel_launch: %d CUs (built for 256)\n", grid);
    }
    if (grid < 0) return;
    if (hipMemsetAsync((char*)d_ws + WS_CTL, 0, CTL_ZERO_BYTES, stream) != hipSuccess) return;
    Args a{};
    for (int i = 0; i < 20; ++i) a.in[i] = (const float*)d_in[i];
    a.out = (float*)d_out; a.ws = (unsigned char*)d_ws;
#if MK_ONE_LAUNCH
    a.ph_lo = 0; a.ph_hi = N_PHASES; a.li = 0;
    hipLaunchKernelGGL(fwd_kernel, dim3(grid), dim3(NWAVES * 64), LDS_BYTES, stream, a);
#else
    for (int ph = 0; ph < N_PHASES; ++ph) {
        if (ph == 3) continue;
        a.ph_lo = ph; a.ph_hi = ph + 1; a.li = ph;
        hipLaunchKernelGGL(fwd_kernel, dim3(grid), dim3(NWAVES * 64), LDS_BYTES, stream, a);
    }
#endif
}
```

```cpp
#include <hip/hip_runtime.h>
#include <hip/hip_bf16.h>
#include <cstdio>
#include <cstdint>
#include <cmath>
namespace pg8 {
#define PG8_LAS __attribute__((address_space(3)))
typedef unsigned short bf16_t;
typedef short bf16x8 __attribute__((ext_vector_type(8)));
typedef float f32x4 __attribute__((ext_vector_type(4)));
typedef unsigned u32x4 __attribute__((ext_vector_type(4)));
typedef int pg8_v4i __attribute__((ext_vector_type(4)));
typedef long pg8_v2l __attribute__((ext_vector_type(2)));
constexpr int BM = 256, BK = 64, HALF = 128, HTB = HALF * BK * 2  , STAGE_BYTES = 8 * HTB, NXCD = 8, WGM = 8;

__host__ __device__ __forceinline__ int lds_byte(int r, int c) { const int st = (r >> 4) * 2 + (c >> 5), rr = r & 15, cc = c & 31, ob = rr * 64 + cc * 2; return st * 1024 + (ob ^ (((ob >> 9) & 1) << 5)); }
__host__ __device__ __forceinline__ void stage_rc(int b, int& R, int& C) { const int st = b / 1024, sb = b % 1024, swz = sb ^ (((sb >> 9) & 1) << 5); R = (st >> 1) * 16 + swz / 64; C = (st & 1) * 32 + (swz % 64) / 2; }
__host__ __device__ __forceinline__ int perm32(int rho) { const int n = rho >> 4, i = rho & 15; return 8 * (i >> 2) + 4 * n + (i & 3); }

struct Unit { int pm, pn; };
struct Gemm { const bf16_t* A; const bf16_t* Bt; int M, N, K; };

struct StaticOrder {
    int nM, nN, nwg, G, c;
    __host__ __device__ void init(int M, int N, int G_, int c_) { nM = M / BM; nN = N / BM; nwg = nM * nN; G = G_; c = c_; }
    __host__ __device__ bool next(int i, Unit& u) const {
        const long L = (long)i * G + c; if (L >= nwg) return false;
        int wgid = (int)L; { const int q = nwg / NXCD, r = nwg % NXCD, xcd = wgid % NXCD, off = wgid / NXCD; wgid = (xcd < r ? xcd * (q + 1) : r * (q + 1) + (xcd - r) * q) + off; }
        const int nig = WGM * nN, gid = wgid / nig, fm = gid * WGM, gsz = (nM - fm) < WGM ? (nM - fm) : WGM;
        u.pm = fm + ((wgid % nig) % gsz); u.pn = (wgid % nig) / gsz; return true;
    }
    __device__ __forceinline__ void a_ready(const Unit&) const {}
    __device__ __forceinline__ void done(const Unit&) const {}
};

__device__ __forceinline__ unsigned cvt_pk_bf16(float lo, float hi) { unsigned r; asm volatile("v_cvt_pk_bf16_f32 %0, %1, %2" : "=v"(r) : "v"(lo), "v"(hi)); return r; }
typedef float f32x2 __attribute__((ext_vector_type(2)));
__device__ __forceinline__ f32x2 gelu_pk(f32x2 v) {
    const f32x2 av = __builtin_elementwise_abs(v), d = av * 0.2316418882f + 1.0f;
    f32x2 t; t.x = __builtin_amdgcn_rcpf(d.x); t.y = __builtin_amdgcn_rcpf(d.y);
    f32x2 q = t * 0.5307027145f + (-0.7265760135f); q = q * t + 0.7107068705f; q = q * t + (-0.142248368f); q = q * t + 0.127414796f; q = q * t;
    const f32x2 s = (v * v) * (-0.72134752044f);
    f32x2 e; e.x = __builtin_amdgcn_exp2f(s.x); e.y = __builtin_amdgcn_exp2f(s.y);
    const f32x2 m = v * (q * e), r = v - m;
    f32x2 o; o.x = v.x < 0.f ? m.x : r.x; o.y = v.y < 0.f ? m.y : r.y; return o;
}

template <int ACT  > struct EpiBf16 {
    static constexpr bool PERM = true, AFTER_DRAIN = false; static_assert(ACT == 0 || ACT == 1, "EpiBf16: ACT is 0 (none) or 1 (gelu_pk)");
    bf16_t* O; int ldc; const float* bias; int split_cols; size_t split_stride; float scale0;
    __device__ __forceinline__ void operator()(const f32x4 (&acc)[2][2][4][2], const Unit& u, int wr, int wc, int fr, int fq) const {
        const int row0 = u.pm * BM + wr * 64 + fr; int colt = u.pn * BM; bf16_t* base = O;
        float sc = 1.f; if (split_cols) { const int t = colt / split_cols; base += (size_t)t * split_stride; colt -= t * split_cols; if (t == 0) sc = scale0; }
        const int col0 = colt + wc * 32 + 8 * fq, bcol0 = u.pn * BM + wc * 32 + 8 * fq;
        f32x4 bv[2][2];
#pragma unroll
        for (int bj = 0; bj < 2; ++bj)
#pragma unroll
            for (int n = 0; n < 2; ++n) bv[bj][n] = bias ? *(const f32x4*)(bias + bcol0 + bj * HALF + 4 * n) : (f32x4){0.f, 0.f, 0.f, 0.f};
#pragma unroll
        for (int ai = 0; ai < 2; ++ai)
#pragma unroll
            for (int m = 0; m < 4; ++m) { bf16_t* rowp = base + (size_t)(row0 + ai * HALF + m * 16) * ldc + col0;
#pragma unroll
                for (int bj = 0; bj < 2; ++bj) { f32x4 v0 = acc[ai][bj][m][0] + bv[bj][0], v1 = acc[ai][bj][m][1] + bv[bj][1];
                    if (ACT == 1) { f32x2 a = gelu_pk((f32x2){v0[0], v0[1]}), b = gelu_pk((f32x2){v0[2], v0[3]}), c = gelu_pk((f32x2){v1[0], v1[1]}), d = gelu_pk((f32x2){v1[2], v1[3]});
                        v0 = (f32x4){a.x, a.y, b.x, b.y}; v1 = (f32x4){c.x, c.y, d.x, d.y}; }
                    v0 = v0 * sc; v1 = v1 * sc; u32x4 w; w.x = cvt_pk_bf16(v0[0], v0[1]); w.y = cvt_pk_bf16(v0[2], v0[3]); w.z = cvt_pk_bf16(v1[0], v1[1]); w.w = cvt_pk_bf16(v1[2], v1[3]);
                    *(u32x4*)(rowp + bj * HALF) = w; } }
    }
};
template <class Epi, class Sched, bool ALIGN_EPI = false, bool SP2 = false, int FP8SC = -1>
__device__ __forceinline__ void gemm_phase(PG8_LAS unsigned char* lds, const Gemm g, const Sched& S, const Epi& E) {
    int tid_ = threadIdx.x; asm volatile("" : "+v"(tid_));
    const int tid = tid_, wid = __builtin_amdgcn_readfirstlane(tid >> 6), lane = tid & 63, wr = wid >> 2, wc = wid & 3, fr = lane & 15, fq = lane >> 4;
    const int K = g.K, nt = K / BK;
    unsigned voffA[2], voffB[2];
#pragma unroll
    for (int i = 0; i < 2; ++i) { int R, C; stage_rc(tid * 16 + i * 8192, R, C); const int Rb = Epi::PERM ? ((R & ~31) + perm32(R & 31)) : R;
        voffA[i] = (unsigned)(R * K + C) * 2u; voffB[i] = (unsigned)(Rb * K + C) * 2u; }
    const size_t kstep = (size_t)(BK * 2);
    const size_t hstep = (size_t)HALF * K * 2;
    const size_t tstep = 2 * hstep;
    const unsigned ldsw = (unsigned)wid * 1024u;
    const int aoff = lds_byte(wr * 64 + fr, fq * 8), boff = lds_byte(wc * 32 + fr, fq * 8);
#define PG8_SA(b, h) (((b) * 2 + (h)) * HTB)
#define PG8_SB(b, h) ((4 + (b) * 2 + (h)) * HTB)
#define PG8_STAGE(bufoff, gbase, voff) do { _Pragma("unroll") for (int _i = 0; _i < 2; ++_i) \
        __builtin_amdgcn_global_load_lds((const unsigned*)((const char*)(gbase) + (voff)[_i]), (PG8_LAS unsigned*)(lds + (bufoff) + ldsw + _i * 8192), 16, 0, 0); } while (0)
#define PG8_LDA(dst, b, h) do { _Pragma("unroll") for (int m = 0; m < 4; ++m) _Pragma("unroll") for (int k = 0; k < 2; ++k) dst[m][k] = *(const PG8_LAS bf16x8*)(lds + PG8_SA(b, h) + aoff + m * 2048 + k * 1024); } while (0)
#define PG8_LDB(dst, b, h) do { _Pragma("unroll") for (int n = 0; n < 2; ++n) _Pragma("unroll") for (int k = 0; k < 2; ++k) dst[n][k] = *(const PG8_LAS bf16x8*)(lds + PG8_SB(b, h) + boff + n * 2048 + k * 1024); } while (0)
#define PG8_CAT8(x0, x1) __builtin_shufflevector(__builtin_bit_cast(pg8_v4i, x0), __builtin_bit_cast(pg8_v4i, x1), 0, 1, 2, 3, 4, 5, 6, 7)
#define PG8_MMA(ai, bj, At, Bt) do { __builtin_amdgcn_s_setprio(1); \
        if constexpr (FP8SC < 0) { _Pragma("unroll") for (int m = 0; m < 4; ++m) _Pragma("unroll") for (int n = 0; n < 2; ++n) _Pragma("unroll") for (int k = 0; k < 2; ++k) \
            acc[ai][bj][m][n] = __builtin_amdgcn_mfma_f32_16x16x32_bf16(Bt[n][k], At[m][k], acc[ai][bj][m][n], 0, 0, 0); } \
        else if constexpr (FP8SC >= 1000) { _Pragma("unroll") for (int m = 0; m < 4; ++m) _Pragma("unroll") for (int n = 0; n < 2; ++n) _Pragma("unroll") for (int k = 0; k < 2; ++k) { \
            const pg8_v2l bq = __builtin_bit_cast(pg8_v2l, Bt[n][k]), aq = __builtin_bit_cast(pg8_v2l, At[m][k]); \
            acc[ai][bj][m][n] = __builtin_amdgcn_mfma_f32_16x16x32_fp8_fp8(bq[0], aq[0], acc[ai][bj][m][n], 0, 0, 0); acc[ai][bj][m][n] = __builtin_amdgcn_mfma_f32_16x16x32_fp8_fp8(bq[1], aq[1], acc[ai][bj][m][n], 0, 0, 0); } } \
        else { _Pragma("unroll") for (int m = 0; m < 4; ++m) _Pragma("unroll") for (int n = 0; n < 2; ++n) \
            acc[ai][bj][m][n] = __builtin_amdgcn_mfma_scale_f32_16x16x128_f8f6f4(PG8_CAT8(Bt[n][0], Bt[n][1]), PG8_CAT8(At[m][0], At[m][1]), acc[ai][bj][m][n], 0, 0, 0, (FP8SC < 0 ? 127 : FP8SC) * 0x01010101, 0, 0x7f7f7f7f); \
            _Pragma("unroll") for (int m = 0; m < 4; ++m) _Pragma("unroll") for (int n = 0; n < 2; ++n) asm volatile("" : "+v"(acc[ai][bj][m][n])); }     \
        __builtin_amdgcn_s_setprio(0); } while (0)
#define PG8_WAIT_V(n) asm volatile("s_waitcnt vmcnt(" #n ")" ::: "memory")
#define PG8_WAIT_L(n) asm volatile("s_waitcnt lgkmcnt(" #n ")" ::: "memory")
#define PG8_BAR __builtin_amdgcn_s_barrier()
#define PG8_SCHED __builtin_amdgcn_sched_barrier(0)
    Unit cur, nxt; int ui = 0;
    if (!S.next(0, cur)) return;
    f32x4 acc[2][2][4][2];
#pragma unroll
    for (int a = 0; a < 2; ++a)
#pragma unroll
        for (int b = 0; b < 2; ++b)
#pragma unroll
            for (int m = 0; m < 4; ++m)
#pragma unroll
                for (int n = 0; n < 2; ++n) acc[a][b][m][n] = (f32x4){0.f, 0.f, 0.f, 0.f};
    bf16x8 At[4][2], B0[2][2], B1[2][2];
    const char* cA = (const char*)g.A + (size_t)cur.pm * tstep; const char* cB = (const char*)g.Bt + (size_t)cur.pn * tstep;
    S.a_ready(cur);
    if constexpr (SP2) {
        PG8_STAGE(PG8_SB(0, 0), cB, voffB); PG8_STAGE(PG8_SB(0, 1), cB + hstep, voffB); PG8_STAGE(PG8_SA(0, 0), cA, voffA); PG8_STAGE(PG8_SA(0, 1), cA + hstep, voffA);
        if (wr == 1) PG8_BAR;
        PG8_WAIT_V(2); PG8_BAR;
        PG8_STAGE(PG8_SB(1, 0), cB + kstep, voffB); PG8_STAGE(PG8_SA(1, 0), cA + kstep, voffA); PG8_STAGE(PG8_SB(1, 1), cB + hstep + kstep, voffB);
        PG8_WAIT_V(6); PG8_BAR;
    } else {
        PG8_STAGE(PG8_SB(0, 0), cB, voffB); PG8_STAGE(PG8_SA(0, 0), cA, voffA); PG8_STAGE(PG8_SB(0, 1), cB + hstep, voffB); PG8_STAGE(PG8_SA(0, 1), cA + hstep, voffA);
        if (wr == 1) PG8_BAR;
        PG8_WAIT_V(4); PG8_BAR;
        PG8_STAGE(PG8_SB(1, 0), cB + kstep, voffB); PG8_STAGE(PG8_SA(1, 0), cA + kstep, voffA); PG8_STAGE(PG8_SB(1, 1), cB + hstep + kstep, voffB);
        PG8_WAIT_V(6); PG8_BAR;
    }
    for (;;) {
        const bool has_next = S.next(ui + 1, nxt);
        const char* nA = has_next ? (const char*)g.A + (size_t)nxt.pm * tstep : cA; const char* nB = has_next ? (const char*)g.Bt + (size_t)nxt.pn * tstep : cB;
        for (int t = 0; t < nt; t += 2) {
            const bool last = (t == nt - 2);
            const char* a1 = cA + (size_t)(t + 1) * kstep;
            const char* a2 = last ? nA : cA + (size_t)(t + 2) * kstep; const char* b2 = last ? nB : cB + (size_t)(t + 2) * kstep;
            const char* a3 = a2 + kstep; const char* b3 = b2 + kstep;
            if (last && has_next) S.a_ready(nxt);
            if constexpr (SP2) {
            PG8_LDB(B0, 0, 0); PG8_LDB(B1, 0, 1); PG8_SCHED; PG8_LDA(At, 0, 0); PG8_STAGE(PG8_SA(1, 1), a1 + hstep, voffA);
            PG8_WAIT_V(8); PG8_WAIT_L(0); PG8_BAR; PG8_MMA(0, 0, At, B0); PG8_MMA(0, 1, At, B1); PG8_BAR; PG8_SCHED;
            PG8_LDA(At, 0, 1); PG8_STAGE(PG8_SB(0, 0), b2, voffB); PG8_STAGE(PG8_SB(0, 1), b2 + hstep, voffB); PG8_STAGE(PG8_SA(0, 0), a2, voffA);
            PG8_WAIT_V(8); PG8_WAIT_L(0); PG8_BAR; PG8_MMA(1, 0, At, B0); PG8_MMA(1, 1, At, B1); PG8_BAR; PG8_SCHED;
            PG8_LDB(B0, 1, 0); PG8_LDB(B1, 1, 1); PG8_SCHED; PG8_LDA(At, 1, 0); PG8_STAGE(PG8_SA(0, 1), a2 + hstep, voffA);
            PG8_WAIT_V(8); PG8_WAIT_L(0); PG8_BAR; PG8_MMA(0, 0, At, B0); PG8_MMA(0, 1, At, B1); PG8_BAR; PG8_SCHED;
            PG8_LDA(At, 1, 1); PG8_STAGE(PG8_SB(1, 0), b3, voffB); PG8_STAGE(PG8_SB(1, 1), b3 + hstep, voffB); PG8_STAGE(PG8_SA(1, 0), a3, voffA);
            PG8_WAIT_V(8); PG8_WAIT_L(0); PG8_BAR; PG8_MMA(1, 0, At, B0); PG8_MMA(1, 1, At, B1); PG8_BAR; PG8_SCHED;
            } else {
            PG8_LDB(B0, 0, 0); PG8_SCHED; PG8_LDA(At, 0, 0); PG8_STAGE(PG8_SA(1, 1), a1 + hstep, voffA);
            PG8_WAIT_L(8); PG8_BAR; PG8_WAIT_L(0); PG8_MMA(0, 0, At, B0); PG8_BAR; PG8_SCHED;
            PG8_LDB(B1, 0, 1); PG8_STAGE(PG8_SB(0, 0), b2, voffB);
            PG8_BAR; PG8_WAIT_L(0); PG8_MMA(0, 1, At, B1); PG8_BAR;
            PG8_LDA(At, 0, 1); PG8_STAGE(PG8_SA(0, 0), a2, voffA);
            PG8_BAR; PG8_WAIT_L(0); PG8_MMA(1, 0, At, B0); PG8_BAR; PG8_SCHED;
            PG8_STAGE(PG8_SB(0, 1), b2 + hstep, voffB);
            PG8_WAIT_V(6); PG8_BAR; PG8_MMA(1, 1, At, B1); PG8_BAR;
            PG8_LDB(B0, 1, 0); PG8_SCHED; PG8_LDA(At, 1, 0); PG8_STAGE(PG8_SA(0, 1), a2 + hstep, voffA);
            PG8_WAIT_L(8); PG8_BAR; PG8_WAIT_L(0); PG8_MMA(0, 0, At, B0); PG8_BAR; PG8_SCHED;
            PG8_LDB(B1, 1, 1); PG8_STAGE(PG8_SB(1, 0), b3, voffB);
            PG8_BAR; PG8_WAIT_L(0); PG8_MMA(0, 1, At, B1); PG8_BAR;
            PG8_LDA(At, 1, 1); PG8_STAGE(PG8_SA(1, 0), a3, voffA);
            PG8_BAR; PG8_WAIT_L(0); PG8_MMA(1, 0, At, B0); PG8_BAR; PG8_SCHED;
            PG8_STAGE(PG8_SB(1, 1), b3 + hstep, voffB);
            PG8_WAIT_V(6); PG8_BAR; PG8_MMA(1, 1, At, B1); PG8_BAR;
            }
        }
        if constexpr (ALIGN_EPI) { if (wr == 0) PG8_BAR; }
        if constexpr (!Epi::AFTER_DRAIN) { E(acc, cur, wr, wc, fr, fq); S.done(cur); }
        if (!has_next) break;
#pragma unroll
        for (int a = 0; a < 2; ++a)
#pragma unroll
            for (int b = 0; b < 2; ++b)
#pragma unroll
                for (int m = 0; m < 4; ++m)
#pragma unroll
                    for (int n = 0; n < 2; ++n) acc[a][b][m][n] = (f32x4){0.f, 0.f, 0.f, 0.f};
        cur = nxt; cA = nA; cB = nB; ++ui;
        if constexpr (ALIGN_EPI) { if (wr == 1) PG8_BAR; }
    }
    PG8_WAIT_V(0);
    if constexpr (!ALIGN_EPI) { if (wr == 0) PG8_BAR; }
    PG8_BAR;
    if constexpr (Epi::AFTER_DRAIN) { E.fused(acc, cur, wr, wc, fr, fq, lds, wid, lane); S.done(cur); }
#undef PG8_SA
#undef PG8_SB
#undef PG8_STAGE
#undef PG8_LDA
#undef PG8_LDB
#undef PG8_MMA
#undef PG8_CAT8
#undef PG8_WAIT_V
#undef PG8_WAIT_L
#undef PG8_BAR
#undef PG8_SCHED
}
}

constexpr int NWAVES = 8;
constexpr int BATCH = 2, SEQ = 8192, T = BATCH * SEQ, D = 1024;
constexpr int AB_IN = 1536, C_IN = 2304, C_OUT = 512;
constexpr int NE = 32, DE = 1024, PLE = 256;
constexpr int NSLOT = 73728;
constexpr float NORM_EPS = 1e-6f;
constexpr float LOG2_THETA = 13.287712379549449f;
constexpr float ATT_C2 = 0.125f * 1.4426950408889634f;

#define GAS __attribute__((address_space(1)))
#define LAS __attribute__((address_space(3)))
typedef unsigned short bf16;
typedef unsigned v4u __attribute__((ext_vector_type(4)));
typedef unsigned v2u __attribute__((ext_vector_type(2)));
typedef float f32x4 __attribute__((ext_vector_type(4)));
typedef GAS unsigned gu32;
#define RLX_AGENT __ATOMIC_RELAXED, __HIP_MEMORY_SCOPE_AGENT
#define LDS_WAIT() asm volatile("s_waitcnt lgkmcnt(0)" ::: "memory")
#define VM_WAIT() asm volatile("s_waitcnt vmcnt(0)" ::: "memory")

typedef float f32x2_ __attribute__((ext_vector_type(2))); typedef __bf16 bf16x2_ __attribute__((ext_vector_type(2)));
__device__ __forceinline__ unsigned pk2(float lo, float hi) { f32x2_ v = {lo, hi}; bf16x2_ b = __builtin_convertvector(v, bf16x2_); return __builtin_bit_cast(unsigned, b); }
__device__ __forceinline__ float bflo(unsigned w) { return __builtin_bit_cast(float, w << 16); }
__device__ __forceinline__ float bfhi(unsigned w) { return __builtin_bit_cast(float, w & 0xffff0000u); }
#ifndef MOE_FP8_MASK
#define MOE_FP8_MASK 3
#endif
#ifndef F8_DIAG
#define F8_DIAG 0
#endif
constexpr float F8_EPI_SC = F8_DIAG ? (1.f / 64.f) : 1.f;
#ifndef Y_FP8
#define Y_FP8 1
#endif
#ifndef PLE_FP8
#define PLE_FP8 0
#endif
constexpr float Y_SC = 32.f;
constexpr int F8_WSC = 6;
__device__ __forceinline__ unsigned pk4_fp8(float a, float b, float c, float d) { int w = 0; w = __builtin_amdgcn_cvt_pk_fp8_f32(a, b, w, false); w = __builtin_amdgcn_cvt_pk_fp8_f32(c, d, w, true); return (unsigned)w; }
__device__ __forceinline__ float clamp448(float x) { return fminf(fmaxf(x, -448.f), 448.f); }
__device__ __forceinline__ float rnd_bf(float x) { return bflo(pk2(x, 0.f)); }
__device__ __forceinline__ float ssp_sum(const float* p) { const f32x4 a = *(const f32x4*)p, b = *(const f32x4*)(p + 4), c = *(const f32x4*)(p + 8), d = *(const f32x4*)(p + 12);
    return (((a.x + a.y) + (a.z + a.w)) + ((b.x + b.y) + (b.z + b.w))) + (((c.x + c.y) + (c.z + c.w)) + ((d.x + d.y) + (d.z + d.w))); }

constexpr size_t MiB = 1u << 20;
constexpr size_t al256(size_t x) { return (x + 255) & ~(size_t)255; }
constexpr size_t WS_CTL = 0, CTL_ZERO_BYTES = 1 * MiB;
constexpr size_t WS_WIN0T = 1 * MiB;
constexpr size_t WS_WOUT0T = WS_WIN0T + (size_t)AB_IN * D * 2;
constexpr size_t WS_WIN1T = WS_WOUT0T + (size_t)D * D * 2;
constexpr size_t WS_WOUT1T = WS_WIN1T + (size_t)C_IN * D * 2;
constexpr size_t WS_WGT = WS_WOUT1T + (size_t)D * C_OUT * 2;
constexpr size_t WS_WPT = WS_WGT + 2 * (size_t)D * D * 2;
constexpr size_t WS_WR = WS_WPT + 2 * (size_t)D * PLE * 2;
constexpr size_t WS_ROPE1 = al256(WS_WR + 2 * (size_t)NE * D * 4);
constexpr size_t WS_ROPEA = WS_ROPE1 + (size_t)SEQ * 32 * 8;
constexpr size_t WS_WUPT = WS_ROPEA + (size_t)SEQ * 32 * 8;
constexpr size_t WS_WDNT = WS_WUPT + 2 * (size_t)NE * 2 * DE * D * 2;
constexpr size_t WS_PBF = WS_WDNT + 2 * (size_t)NE * D * DE * 2;
constexpr size_t WS_PP = WS_PBF + 2 * (size_t)T * PLE * 2;
constexpr size_t WS_X0 = WS_PP + 2 * (size_t)T * D * 2;
constexpr size_t WS_HM = WS_X0 + (size_t)T * D * 2;
constexpr size_t WS_H2 = WS_HM + (size_t)T * D * 2;
constexpr size_t WS_H3 = WS_H2 + (size_t)T * D * 2;
constexpr size_t WS_OCAT = WS_H3 + (size_t)T * D * 2;
constexpr size_t WS_SSP = WS_OCAT + (size_t)T * D * 2;
constexpr size_t WS_LSE = WS_SSP + 3 * (size_t)T * 16 * 4;
constexpr size_t WS_TOPE = WS_LSE + 3 * (size_t)T * 8 * 4;
constexpr size_t WS_TOPG = WS_TOPE + (size_t)T * 16;
constexpr size_t WS_TOPPOS = WS_TOPG + (size_t)T * 16;
constexpr size_t WS_RSTD = WS_TOPPOS + (size_t)T * 16;
constexpr size_t WS_TOKSLOT = WS_RSTD + (size_t)T * 4;
constexpr size_t WS_SLOTGATE = WS_TOKSLOT + (size_t)T * 16;
constexpr size_t WS_SLOTRS = WS_SLOTGATE + (size_t)NSLOT * 4;
constexpr size_t WS_XTAB = al256(WS_SLOTRS + (size_t)NSLOT * 4);
constexpr size_t WS_CNTTAB = al256(WS_XTAB + 8 * 136 * 4);
constexpr size_t WS_XG = al256(WS_CNTTAB + 256 * 32 * 4);
constexpr size_t WS_ACT = WS_XG + (size_t)NSLOT * D * 2;
constexpr size_t WS_Y = WS_ACT + (size_t)NSLOT * D * 2;
constexpr size_t WS_Q3 = WS_Y + (size_t)NSLOT * D * 2;
constexpr size_t WS_K3 = WS_Q3 + 3 * (size_t)T * 512 * 2;
constexpr size_t WS_V3 = WS_K3 + 3 * (size_t)T * 128 * 2;
constexpr size_t WS_OGB = WS_V3 + 3 * (size_t)T * 128 * 2;
constexpr size_t WS_H2F8 = WS_OGB + 3 * (size_t)T * 512 * 2;
constexpr size_t WS_END = WS_H2F8 + (size_t)T * D;
constexpr int CW_TMO = 0;
constexpr int CW_CNT = 64;
constexpr int CW_BAR = 4096;

constexpr int LDSCTL_OFF = 0, MISC_OFF = 64;
constexpr int RING_OFF = 512, RING_BYTES = 131072;
constexpr int LDS_BYTES = 147456;

struct PPOrder {
    int G, c;
    __device__ __forceinline__ bool next(int i, pg8::Unit& u) const {
        int L; if (G == 256) { if (c < 128 || i >= 4) return false; L = (c - 128) * 4 + i; } else { L = i * G + c; if (L >= 512) return false; }
        u.pm = L >> 2; u.pn = 4 * (u.pm >> 6) + (L & 3); return true; }
    __device__ __forceinline__ void a_ready(const pg8::Unit&) const {}
    __device__ __forceinline__ void done(const pg8::Unit&) const {}
};
struct EpiPP {
    static constexpr bool PERM = true, AFTER_DRAIN = false;
    bf16* O;
    __device__ __forceinline__ void operator()(const pg8::f32x4 (&acc)[2][2][4][2], const pg8::Unit& u, int wr, int wc, int fr, int fq) const {
        const int row0 = u.pm * 256 + wr * 64 + fr, col0 = (u.pn & 3) * 256 + wc * 32 + 8 * fq;
#pragma unroll
        for (int ai = 0; ai < 2; ++ai)
#pragma unroll
            for (int m = 0; m < 4; ++m) { bf16* rp = O + (size_t)(row0 + ai * 128 + m * 16) * D + col0;
#pragma unroll
                for (int bj = 0; bj < 2; ++bj) { const pg8::f32x4 v0 = acc[ai][bj][m][0], v1 = acc[ai][bj][m][1];
                    pg8::u32x4 w; w.x = pk2(v0[0], v0[1]); w.y = pk2(v0[2], v0[3]); w.z = pk2(v1[0], v1[1]); w.w = pk2(v1[2], v1[3]);
                    *(pg8::u32x4*)(rp + bj * 128) = w; } }
    }
};
template <int LAYER> struct EpiQKV {
    static constexpr bool PERM = true, AFTER_DRAIN = false;
    const float* SS; const float* qg; const float* kg; const float* rope1; const float* ropea; bf16* Q3; bf16* K3; bf16* V3;
    __device__ __forceinline__ void operator()(const pg8::f32x4 (&acc)[2][2][4][2], const pg8::Unit& u, int wr, int wc, int fr, int fq) const {
        int kind, hd, grp;
        bool axial;
        if (LAYER == 0) { const int t3 = u.pn % 3; grp = u.pn / 3; axial = (grp == 0);
            if (t3 < 2) { kind = 0; hd = 4 * t3 + wc; } else if (wc < 2) { kind = 1; hd = wc; } else { kind = 2; hd = wc - 2; } }
        else { const int t3 = u.pn % 3; grp = u.pn / 3; axial = false;
            if (t3 < 2) { kind = 0; hd = 4 * t3 + wc; } else if (wc < 2) { kind = 1; hd = wc; } else { kind = 2; hd = wc - 2; } }
        const bool norm = axial && kind < 2, rope = kind < 2;
        float ga[8], gb[8];
        if (norm) { const float* g = (kind == 0) ? qg : kg;
#pragma unroll
            for (int t = 0; t < 8; ++t) { const int j = 8 * fq + t; const int d0 = (j < 16) ? j : j + 16; ga[t] = g[d0]; gb[t] = g[d0 + 16]; } }
        else {
#pragma unroll
            for (int t = 0; t < 8; ++t) { ga[t] = 1.f; gb[t] = 1.f; } }
        const float qs = (kind == 0) ? ATT_C2 : 1.f;
        const float* rtab = axial ? ropea : rope1;
        bf16* dst; int pitch;
        if (kind == 0) { dst = Q3 + (size_t)grp * T * 512 + hd * 64; pitch = 512; } else if (kind == 1) { dst = K3 + (size_t)grp * T * 128 + hd * 64; pitch = 128; } else { dst = V3 + (size_t)grp * T * 128 + hd * 64; pitch = 128; }
        const int row0 = u.pm * 256 + wr * 64 + fr;
#pragma unroll
        for (int ai = 0; ai < 2; ++ai)
#pragma unroll
            for (int m = 0; m < 4; ++m) {
                const int r = row0 + ai * 128 + m * 16; const int pos = r & (SEQ - 1);
                const float rs = __builtin_amdgcn_rsqf(ssp_sum(SS + (size_t)r * 16) * (1.f / D) + NORM_EPS);
                float a[8], b[8];
#pragma unroll
                for (int n = 0; n < 2; ++n)
#pragma unroll
                    for (int i = 0; i < 4; ++i) { a[4 * n + i] = acc[ai][0][m][n][i] * rs; b[4 * n + i] = acc[ai][1][m][n][i] * rs; }
                if (norm) { float ss = 0.f;
#pragma unroll
                    for (int t = 0; t < 8; ++t) ss += a[t] * a[t] + b[t] * b[t];
                    ss += __shfl_xor(ss, 16); ss += __shfl_xor(ss, 32);
                    const float rh = __builtin_amdgcn_rsqf(ss * (1.f / 64.f) + NORM_EPS);
#pragma unroll
                    for (int t = 0; t < 8; ++t) { a[t] *= rh * ga[t]; b[t] *= rh * gb[t]; } }
                if (rope) { const f32x4* cs = (const f32x4*)(rtab + ((size_t)pos * 32 + 8 * fq) * 2);
#pragma unroll
                    for (int t2 = 0; t2 < 4; ++t2) { const f32x4 v = cs[t2];
                        { const float x1 = a[2 * t2], x2 = b[2 * t2]; a[2 * t2] = x1 * v.x - x2 * v.y; b[2 * t2] = x2 * v.x + x1 * v.y; }
                        { const float x1 = a[2 * t2 + 1], x2 = b[2 * t2 + 1]; a[2 * t2 + 1] = x1 * v.z - x2 * v.w; b[2 * t2 + 1] = x2 * v.z + x1 * v.w; } } }
                size_t drow = r;
                if (LAYER == 1) { const int sh = 2 * grp, bb = r >> 13; drow = (size_t)bb * SEQ + (size_t)(pos & ((1 << sh) - 1)) * (SEQ >> sh) + (pos >> sh); }
                bf16* dp = dst + drow * pitch + 8 * fq;
                pg8::u32x4 w0, w1;
                w0.x = pk2(a[0] * qs, a[1] * qs); w0.y = pk2(a[2] * qs, a[3] * qs); w0.z = pk2(a[4] * qs, a[5] * qs); w0.w = pk2(a[6] * qs, a[7] * qs);
                w1.x = pk2(b[0] * qs, b[1] * qs); w1.y = pk2(b[2] * qs, b[3] * qs); w1.z = pk2(b[4] * qs, b[5] * qs); w1.w = pk2(b[6] * qs, b[7] * qs);
                *(pg8::u32x4*)dp = w0; *(pg8::u32x4*)(dp + 32) = w1;
                asm volatile("" ::: "memory");
            }
    }
};
struct EpiResBf16 {
    static constexpr bool PERM = true, AFTER_DRAIN = false;
    const bf16* R; bf16* O;
    __device__ __forceinline__ void operator()(const pg8::f32x4 (&acc)[2][2][4][2], const pg8::Unit& u, int wr, int wc, int fr, int fq) const {
        const int row0 = u.pm * 256 + wr * 64 + fr, col0 = u.pn * 256 + wc * 32 + 8 * fq;
#pragma unroll
        for (int ai = 0; ai < 2; ++ai)
#pragma unroll
            for (int m = 0; m < 4; ++m) { const size_t ro = (size_t)(row0 + ai * 128 + m * 16) * D + col0;
#pragma unroll
                for (int bj = 0; bj < 2; ++bj) { const pg8::f32x4 v0 = acc[ai][bj][m][0], v1 = acc[ai][bj][m][1]; const v4u rr = *(const v4u*)(R + ro + bj * 128);
                    pg8::u32x4 w; w.x = pk2(v0[0] + bflo(rr.x), v0[1] + bfhi(rr.x)); w.y = pk2(v0[2] + bflo(rr.y), v0[3] + bfhi(rr.y)); w.z = pk2(v1[0] + bflo(rr.z), v1[1] + bfhi(rr.z)); w.w = pk2(v1[2] + bflo(rr.w), v1[3] + bfhi(rr.w));
                    *(pg8::u32x4*)(O + ro + bj * 128) = w; }
                asm volatile("" ::: "memory"); }
    }
};
__device__ __forceinline__ float sigmoidf_(float x) { return __builtin_amdgcn_rcpf(1.0f + __builtin_amdgcn_exp2f(-1.4426950408889634f * x)); }
__device__ __forceinline__ float swiglu1(float g, float l) {
    g = fminf(g, 7.0f); l = fminf(fmaxf(l, -7.0f), 7.0f);
    return g * sigmoidf_(1.702f * g) * (l + 1.0f);
}
__device__ __forceinline__ f32x2_ swiglu2(f32x2_ g, f32x2_ l) {
    g = __builtin_elementwise_min(g, (f32x2_){7.0f, 7.0f}); l = __builtin_elementwise_min(__builtin_elementwise_max(l, (f32x2_){-7.0f, -7.0f}), (f32x2_){7.0f, 7.0f});
    const f32x2_ t = g * (-1.702f * 1.4426950408889634f); f32x2_ e; e.x = __builtin_amdgcn_exp2f(t.x); e.y = __builtin_amdgcn_exp2f(t.y);
    const f32x2_ d = e + 1.0f; f32x2_ s; s.x = __builtin_amdgcn_rcpf(d.x); s.y = __builtin_amdgcn_rcpf(d.y);
    return (g * s) * (l + 1.0f);
}
template <bool F8> struct EpiSwiglu {
    static constexpr bool PERM = true, AFTER_DRAIN = false;
    void* ACT; const float* bup; const float* rsl;
    __device__ __forceinline__ void operator()(const pg8::f32x4 (&acc)[2][2][4][2], const pg8::Unit& u, int wr, int wc, int fr, int fq) const {
        const int e = u.pn >> 3, j = u.pn & 7; const int row0 = u.pm * 256 + wr * 64 + fr, a0 = j * 128 + wc * 32 + 8 * fq;
        const float* bp = bup + (size_t)e * 2048 + 2 * a0; pg8::f32x4 b[4];
#pragma unroll
        for (int i = 0; i < 4; ++i) b[i] = *(const pg8::f32x4*)(bp + 4 * i);
#pragma unroll
        for (int ai = 0; ai < 2; ++ai)
#pragma unroll
            for (int m = 0; m < 4; ++m) { const int r = row0 + ai * 128 + m * 16; const float rs = F8 ? F8_EPI_SC : rsl[r];
                const pg8::f32x4 g0 = acc[ai][0][m][0] * rs, g1 = acc[ai][0][m][1] * rs, l0 = acc[ai][1][m][0] * rs, l1 = acc[ai][1][m][1] * rs;
                float o[8];
                { const f32x2_ r0 = swiglu2((f32x2_){g0[0] + b[0][0], g0[1] + b[0][2]}, (f32x2_){l0[0] + b[0][1], l0[1] + b[0][3]}), r1 = swiglu2((f32x2_){g0[2] + b[1][0], g0[3] + b[1][2]}, (f32x2_){l0[2] + b[1][1], l0[3] + b[1][3]});
                  const f32x2_ r2 = swiglu2((f32x2_){g1[0] + b[2][0], g1[1] + b[2][2]}, (f32x2_){l1[0] + b[2][1], l1[1] + b[2][3]}), r3 = swiglu2((f32x2_){g1[2] + b[3][0], g1[3] + b[3][2]}, (f32x2_){l1[2] + b[3][1], l1[3] + b[3][3]});
                  o[0] = r0.x; o[1] = r0.y; o[2] = r1.x; o[3] = r1.y; o[4] = r2.x; o[5] = r2.y; o[6] = r3.x; o[7] = r3.y; }
                if (F8) { v2u w; w.x = pk4_fp8(o[0], o[1], o[2], o[3]); w.y = pk4_fp8(o[4], o[5], o[6], o[7]); *(v2u*)((unsigned char*)ACT + (size_t)r * DE + a0) = w; }
                else { pg8::u32x4 w; w.x = pk2(o[0], o[1]); w.y = pk2(o[2], o[3]); w.z = pk2(o[4], o[5]); w.w = pk2(o[6], o[7]); *(pg8::u32x4*)((bf16*)ACT + (size_t)r * DE + a0) = w; } }
    }
};
struct EpiNull {
    static constexpr bool PERM = true, AFTER_DRAIN = false;
    float* O;
    __device__ __forceinline__ void operator()(const pg8::f32x4 (&acc)[2][2][4][2], const pg8::Unit& u, int wr, int wc, int fr, int fq) const {
        pg8::f32x4 s = {0.f, 0.f, 0.f, 0.f};
#pragma unroll
        for (int ai = 0; ai < 2; ++ai)
#pragma unroll
            for (int bj = 0; bj < 2; ++bj)
#pragma unroll
                for (int m = 0; m < 4; ++m)
#pragma unroll
                    for (int n = 0; n < 2; ++n) s += acc[ai][bj][m][n];
        *(pg8::f32x4*)(O + (size_t)(threadIdx.x + 512 * (u.pm & 63)) * 4) = s;
    }
};
template <bool Y8> struct EpiDown {
    static constexpr bool PERM = true, AFTER_DRAIN = false;
    void* Y; const float* bdn; const float* gate; float asc;
    __device__ __forceinline__ void operator()(const pg8::f32x4 (&acc)[2][2][4][2], const pg8::Unit& u, int wr, int wc, int fr, int fq) const {
        const int e = u.pn >> 2, j = u.pn & 3; const int row0 = u.pm * 256 + wr * 64 + fr, col0 = j * 256 + wc * 32 + 8 * fq;
        pg8::f32x4 bv[2][2];
#pragma unroll
        for (int bj = 0; bj < 2; ++bj)
#pragma unroll
            for (int n = 0; n < 2; ++n) bv[bj][n] = *(const pg8::f32x4*)(bdn + (size_t)e * D + col0 + bj * 128 + 4 * n);
#pragma unroll
        for (int ai = 0; ai < 2; ++ai)
#pragma unroll
            for (int m = 0; m < 4; ++m) { const int r = row0 + ai * 128 + m * 16; const float gt = gate[r] * (Y8 ? Y_SC : 1.f);
#pragma unroll
                for (int bj = 0; bj < 2; ++bj) { const pg8::f32x4 v0 = (acc[ai][bj][m][0] * asc + bv[bj][0]) * gt, v1 = (acc[ai][bj][m][1] * asc + bv[bj][1]) * gt;
                    if (Y8) { v2u w; w.x = pk4_fp8(clamp448(v0[0]), clamp448(v0[1]), clamp448(v0[2]), clamp448(v0[3])); w.y = pk4_fp8(clamp448(v1[0]), clamp448(v1[1]), clamp448(v1[2]), clamp448(v1[3])); *(v2u*)((unsigned char*)Y + (size_t)r * D + col0 + bj * 128) = w; }
                    else { pg8::u32x4 w; w.x = pk2(v0[0], v0[1]); w.y = pk2(v0[2], v0[3]); w.z = pk2(v1[0], v1[1]); w.w = pk2(v1[2], v1[3]); *(pg8::u32x4*)((bf16*)Y + (size_t)r * D + col0 + bj * 128) = w; } } }
    }
};
struct EpiPle {
    static constexpr bool PERM = true, AFTER_DRAIN = false;
    const bf16* H2; const bf16* PP; bf16* H3; float* SS;
    __device__ __forceinline__ void operator()(const pg8::f32x4 (&acc)[2][2][4][2], const pg8::Unit& u, int wr, int wc, int fr, int fq) const {
        const int row0 = u.pm * 256 + wr * 64 + fr, col0 = u.pn * 256 + wc * 32 + 8 * fq;
#pragma unroll
        for (int ai = 0; ai < 2; ++ai)
#pragma unroll
            for (int m = 0; m < 4; ++m) { const int r = row0 + ai * 128 + m * 16; const size_t ro = (size_t)r * D + col0; float ss = 0.f;
#pragma unroll
                for (int bj = 0; bj < 2; ++bj) { const pg8::f32x4 a0 = acc[ai][bj][m][0], a1 = acc[ai][bj][m][1]; const v4u h = *(const v4u*)(H2 + ro + bj * 128), p = *(const v4u*)(PP + ro + bj * 128);
                    pg8::u32x4 w;
                    w.x = pk2(bflo(h.x) + bflo(p.x) * sigmoidf_(a0[0]), bfhi(h.x) + bfhi(p.x) * sigmoidf_(a0[1])); w.y = pk2(bflo(h.y) + bflo(p.y) * sigmoidf_(a0[2]), bfhi(h.y) + bfhi(p.y) * sigmoidf_(a0[3]));
                    w.z = pk2(bflo(h.z) + bflo(p.z) * sigmoidf_(a1[0]), bfhi(h.z) + bfhi(p.z) * sigmoidf_(a1[1])); w.w = pk2(bflo(h.w) + bflo(p.w) * sigmoidf_(a1[2]), bfhi(h.w) + bfhi(p.w) * sigmoidf_(a1[3]));
                    *(pg8::u32x4*)(H3 + ro + bj * 128) = w;
                    ss += (bflo(w.x) * bflo(w.x) + bfhi(w.x) * bfhi(w.x)) + (bflo(w.y) * bflo(w.y) + bfhi(w.y) * bfhi(w.y)) + (bflo(w.z) * bflo(w.z) + bfhi(w.z) * bfhi(w.z)) + (bflo(w.w) * bflo(w.w) + bfhi(w.w) * bfhi(w.w)); }
                ss += __shfl_xor(ss, 16); ss += __shfl_xor(ss, 32);
                if (fq == 0) SS[(size_t)r * 16 + u.pn * 4 + wc] = ss;
                asm volatile("" ::: "memory"); }
    }
};
template <int LJ> struct XcdOrder {
    const int* tab; int rank, stride;
    __device__ __forceinline__ bool next(int i, pg8::Unit& u) const {
        const int q = i * stride + rank, p = q >> LJ, j = q & ((1 << LJ) - 1); const int ne = tab[0], tot = tab[1]; if (p >= tot) return false;
        int s = 0; while (s + 1 < ne && tab[4 + 4 * (s + 1) + 3] <= p) ++s;
        u.pm = tab[4 + 4 * s + 1] + (p - tab[4 + 4 * s + 3]); u.pn = (tab[4 + 4 * s] << LJ) + j; return true; }
    __device__ __forceinline__ void a_ready(const pg8::Unit&) const {}
    __device__ __forceinline__ void done(const pg8::Unit&) const {}
};
#include <hip/hip_bf16.h>
#include <cmath>
namespace attn_body {
using bf16=__hip_bfloat16;
using bf16x8=__attribute__((ext_vector_type(8)))short;
using s16x4=__attribute__((ext_vector_type(4)))short;
using f32x16=__attribute__((ext_vector_type(16)))float;
using u32x4=__attribute__((ext_vector_type(4)))unsigned;
constexpr int D=64,QP=512,KVP=128;
constexpr int NW=8,QBLK=32,QB=QBLK*NW,KVBLK=64;
constexpr int ATTN_UNIT_ROWS=QB;
__device__ __forceinline__ int crow(int r,int hi){return (r&3)+8*(r>>2)+4*hi;}
#define SBAR() __builtin_amdgcn_sched_barrier(0)
__device__ __forceinline__ void cmask(f32x16&p0,f32x16&p1,int jb,int qrel,int hi){
  const float NEG=-INFINITY; int kb=64*jb+4*hi;
  #pragma unroll
  for(int r=0;r<16;++r){int kv=kb+(r&3)+8*(r>>2); if(kv>qrel)p0[r]=NEG; if(kv+32>qrel)p1[r]=NEG;}
}

__device__ __forceinline__ void bmask(f32x16&p0,f32x16&p1,int t,int dqb,int W){
  const float NEG=-INFINITY; const int kb=64*t+dqb;
  #pragma unroll
  for(int r=0;r<16;++r){const int d=kb+(r&3)+8*(r>>2); if(d>W||d<-W)p0[r]=NEG; if(d+32>W||d+32<-W)p1[r]=NEG;}
}
constexpr int NSLOT=3, SLOTB=8192;
constexpr int LDS_K=0, LDS_V=NSLOT*SLOTB, LDS_WS=2*NSLOT*SLOTB, LDS_OST=LDS_WS+NW*64*4, LDS_BYTES=LDS_OST+NW*4096;
constexpr float C2=0.125f*1.4426950408889634f;
__device__ __forceinline__ void glds16(const void*gsrc,unsigned lds_dst){unsigned keep;
  asm volatile("s_mov_b32 %0, m0\n\ts_mov_b32 m0, %2\n\ts_nop 0\n\tglobal_load_lds_dwordx4 %1, off\n\ts_mov_b32 m0, %0":"=&s"(keep):"v"(gsrc),"s"(lds_dst):"memory");}
__device__ __forceinline__ float max3f(float a,float b,float c){float r;asm("v_max3_f32 %0, %1, %2, %3":"=v"(r):"v"(a),"v"(b),"v"(c));return r;}
__device__ __forceinline__ float max2f(float a,float b){float r;asm("v_max_f32_e32 %0, %1, %2":"=v"(r):"v"(a),"v"(b));return r;}
__device__ __forceinline__ float fadd_s(float a,float b){float r;asm("v_add_f32_e32 %0, %1, %2":"=v"(r):"v"(a),"v"(b));return r;}
__device__ __forceinline__ float fsub_s(float a,float b){float r;asm("v_sub_f32_e32 %0, %1, %2":"=v"(r):"v"(a),"v"(b));return r;}
typedef float f32x2_t __attribute__((ext_vector_type(2))); typedef __bf16 bf16x2_t __attribute__((ext_vector_type(2)));
__device__ __forceinline__ unsigned cvtpk_s(float lo,float hi){f32x2_t v={lo,hi};bf16x2_t b=__builtin_convertvector(v,bf16x2_t);return __builtin_bit_cast(unsigned,b);}
#define WAIT_BAR(N) asm volatile("s_waitcnt vmcnt(" #N ") lgkmcnt(0)\n\ts_barrier":::"memory")

__device__ __forceinline__ void qkt(f32x16&p0,f32x16&p1,const char*Kslot,const bf16x8*qr,const f32x16&negm,int r32,int hi){
  const char*kb=Kslot+hi*1024+r32*16;
  #pragma unroll
  for(int d0=0;d0<4;++d0){
    const bf16x8 b0=*reinterpret_cast<const bf16x8*>(kb+d0*2048);
    const bf16x8 b1=*reinterpret_cast<const bf16x8*>(kb+d0*2048+512);
    if(d0==0){p0=__builtin_amdgcn_mfma_f32_32x32x16_bf16(b0,qr[0],negm,0,0,0);p1=__builtin_amdgcn_mfma_f32_32x32x16_bf16(b1,qr[0],negm,0,0,0);}
    else{p0=__builtin_amdgcn_mfma_f32_32x32x16_bf16(b0,qr[d0],p0,0,0,0);p1=__builtin_amdgcn_mfma_f32_32x32x16_bf16(b1,qr[d0],p1,0,0,0);}}
}
typedef __attribute__((address_space(3))) const char* lds_cptr;
typedef short v4i16_t __attribute__((ext_vector_type(4)));
__device__ __forceinline__ void kload8(bf16x8*kf,lds_cptr kp){
  kf[0]=*(const __attribute__((address_space(3))) bf16x8*)(kp);      kf[1]=*(const __attribute__((address_space(3))) bf16x8*)(kp+512);
  kf[2]=*(const __attribute__((address_space(3))) bf16x8*)(kp+2048); kf[3]=*(const __attribute__((address_space(3))) bf16x8*)(kp+2560);
  kf[4]=*(const __attribute__((address_space(3))) bf16x8*)(kp+4096); kf[5]=*(const __attribute__((address_space(3))) bf16x8*)(kp+4608);
  kf[6]=*(const __attribute__((address_space(3))) bf16x8*)(kp+6144); kf[7]=*(const __attribute__((address_space(3))) bf16x8*)(kp+6656);
}
__device__ __forceinline__ void kload2(bf16x8*kf,lds_cptr kp,int j){ kf[2*j]=*(const __attribute__((address_space(3))) bf16x8*)(kp+j*2048); kf[2*j+1]=*(const __attribute__((address_space(3))) bf16x8*)(kp+j*2048+512); }
__device__ __forceinline__ s16x4 vtr(lds_cptr p){ return __builtin_bit_cast(s16x4,__builtin_amdgcn_ds_read_tr16_b64_v4i16((__attribute__((address_space(3))) v4i16_t*)p)); }
__device__ __forceinline__ float rowmax(const f32x16&p0,const f32x16&p1){
  float a=max3f(p0[0],p0[1],p1[0]),b=max3f(p0[2],p0[3],p1[1]);a=max3f(a,p1[2],p1[3]);
  #pragma unroll
  for(int r=4;r<16;r+=4){a=max3f(a,p0[r],p0[r+1]);b=max3f(b,p0[r+2],p0[r+3]);a=max3f(a,p1[r],p1[r+1]);b=max3f(b,p1[r+2],p1[r+3]);}
  const float m=max2f(a,b);
  auto rr=__builtin_amdgcn_permlane32_swap(__float_as_uint(m),__float_as_uint(m),false,false);
  return max2f(__uint_as_float(rr[0]),__uint_as_float(rr[1]));
}
__device__ __forceinline__ void pv(f32x16*o,int vb,bf16x8 pa0,bf16x8 pa1,bf16x8 pa2,bf16x8 pa3){
  #pragma unroll
  for(int d0=0;d0<2;++d0){s16x4 lo[4],hi[4];
    #pragma unroll
    for(int ks=0;ks<4;++ks){
      asm volatile("ds_read_b64_tr_b16 %0,%1 offset:%c2":"=&v"(lo[ks]):"v"(vb),"i"(d0*4096+ks*1024):"memory");
      asm volatile("ds_read_b64_tr_b16 %0,%1 offset:%c2":"=&v"(hi[ks]):"v"(vb),"i"(d0*4096+ks*1024+512):"memory");}
    asm volatile("s_waitcnt lgkmcnt(0)":::"memory");SBAR();
    #define PK(k) (bf16x8){lo[k][0],lo[k][1],lo[k][2],lo[k][3],hi[k][0],hi[k][1],hi[k][2],hi[k][3]}
    o[d0]=__builtin_amdgcn_mfma_f32_32x32x16_bf16(pa0,PK(0),o[d0],0,0,0);
    o[d0]=__builtin_amdgcn_mfma_f32_32x32x16_bf16(pa1,PK(1),o[d0],0,0,0);
    o[d0]=__builtin_amdgcn_mfma_f32_32x32x16_bf16(pa2,PK(2),o[d0],0,0,0);
    o[d0]=__builtin_amdgcn_mfma_f32_32x32x16_bf16(pa3,PK(3),o[d0],0,0,0);
    #undef PK
  }
}

#ifndef ATTN_STORE16
#define ATTN_STORE16(p,v) (*(u32x4*)(p)=(v))
#endif
template<int MODE,int OP,int THRL> __device__ __forceinline__ void attn_unit(const bf16*Qu,const bf16*__restrict__ Ku,const bf16*__restrict__ Vu,bf16*Ou,int NT,int dq0,int W,float sinkl2,bool has_sink,float*lse,char*shm){
  int tid_=threadIdx.x; asm volatile("":"+v"(tid_));
  const int tid=tid_,lane=tid&63,r32=lane&31,hi=lane>>5; const int wid=__builtin_amdgcn_readfirstlane(tid>>6);
  const bf16*Qw=Qu+(long)(wid*QBLK)*QP;
  const unsigned lds0=(unsigned)(uintptr_t)shm;
  float*wsf=(float*)(shm+LDS_WS)+wid*64;
  const bf16*ksrc=Ku+(long)lane*KVP+wid*8;
  const bf16*vsrc=Vu+(long)(16*(wid&3)+(lane>>2))*KVP+(wid>>2)*32+(lane&3)*8;
  const unsigned kdst=lds0+LDS_K+wid*1024, vdst=lds0+LDS_V+wid*1024;
  #define DMA_K(t,slot) glds16(ksrc+(long)(t)*KVBLK*KVP,(unsigned)__builtin_amdgcn_readfirstlane(kdst+(slot)))
  #define DMA_V(t,slot) glds16(vsrc+(long)(t)*KVBLK*KVP,(unsigned)__builtin_amdgcn_readfirstlane(vdst+(slot)))
  const int vb0=(int)(lds0+LDS_V)+((lane>>4)&1)*32+(lane&3)*8+(4*hi+((lane&15)>>2))*64;
  const char*Kbase=shm+LDS_K; bf16x8 kf[8];
  const lds_cptr shm3=(lds_cptr)shm; const lds_cptr kp0=shm3+LDS_K+hi*1024+r32*16; const lds_cptr vp0=shm3+LDS_V+((lane>>4)&1)*32+(lane&3)*8+(4*hi+((lane&15)>>2))*64;
  DMA_K(0,0);DMA_V(0,0);DMA_K(1,SLOTB);
  bf16x8 qr[4];
  #pragma unroll
  for(int d0=0;d0<4;++d0)qr[d0]=*reinterpret_cast<const bf16x8*>(&Qw[(long)r32*QP+d0*16+hi*8]);
  float mhat=0.f,l_reg=0.f;f32x16 o[2];o[0]=f32x16{};o[1]=f32x16{};f32x16 negm=f32x16{};asm volatile("":"+v"(negm));
  const int dqb=dq0-(wid*QBLK+r32)+4*hi;
  #define CMASK(P0,P1,t) do{ if(MODE==1) bmask(P0,P1,(t),dqb,W); }while(0)
  bool resc=false;
  #define START(P0,P1) do{ float rm=rowmax(P0,P1); if(MODE==1) rm=fmaxf(rm,-60.f); resc=false; \
    { const float dl=rm; mhat=fadd_s(mhat,dl); \
      _Pragma("unroll") for(int r=0;r<16;++r){P0[r]=fsub_s(P0[r],dl);P1[r]=fsub_s(P1[r],dl);} \
      _Pragma("unroll") for(int r=0;r<16;++r)negm[r]=-mhat; asm volatile("":"+v"(negm)); } \
    _Pragma("unroll") for(int r=0;r<16;++r)P0[r]=__builtin_amdgcn_exp2f(P0[r]); }while(0)
  #define RESC() do{ if(resc){ asm volatile("s_waitcnt lgkmcnt(0)":::"memory"); \
      _Pragma("unroll") for(int d_=0;d_<2;++d_) _Pragma("unroll") for(int r=0;r<16;++r)o[d_][r]*=wsf[crow(r,hi)]; } }while(0)
  f32x16 pA0,pA1,pB0,pB1;
  int sl_prev=0,sl_cur=0,sl_next=SLOTB;
  #define ROT() do{sl_prev=sl_cur;sl_cur=sl_next;sl_next=(sl_next==(NSLOT-1)*SLOTB)?0:sl_next+SLOTB;}while(0)
  DMA_K(2,2*SLOTB);
  WAIT_BAR(3);
  qkt(pA0,pA1,Kbase,qr,negm,r32,hi);asm volatile("s_nop 15\n\ts_nop 7":"+v"(pA0),"+v"(pA1));CMASK(pA0,pA1,0);
  START(pA0,pA1);
  _Pragma("unroll") for(int r=0;r<16;++r)pA1[r]=__builtin_amdgcn_exp2f(pA1[r]);
  WAIT_BAR(0);
  DMA_K(3,0);DMA_V(1,SLOTB);
  ROT();
  kload8(kf,kp0+sl_cur);
  WAIT_BAR(2);
  s16x4 vlo[8],vhi[8]; u32x4 pw0,pw1,pw2,pw3;
  #define PKW(P,B) cvtpk_s(P[B],P[B+1])
  #define PAF(k) __builtin_bit_cast(bf16x8,pw##k)
  #define VFR(i) (bf16x8){vlo[i][0],vlo[i][1],vlo[i][2],vlo[i][3],vhi[i][0],vhi[i][1],vhi[i][2],vhi[i][3]}
  #define PIN(x) asm volatile("":"+v"(x))
  #define MX3(a,b,c) __builtin_fmaxf(__builtin_fmaxf((a),(b)),(c))
  #define GAPA(MF,A0,A1,A2,A3,W0,W1,PW) do{ MF; sacc+=A0; sacc+=A1; sacc+=A2; sacc+=A3; PIN(sacc); W0; W1; PIN(PW); SBAR(); }while(0)
  #define EX(v) __builtin_amdgcn_exp2f(v)
  #define GAPB(MF,X,B) do{ MF; X[B]=EX(X[B]); X[B+1]=EX(X[B+1]); X[B+2]=EX(X[B+2]); X[B+3]=EX(X[B+3]); PIN(X); SBAR(); }while(0)
  #define VRD(i) do{ vlo[i]=vtr(vp_+(((i)>>2)*4096+((i)&3)*1024)); vhi[i]=vtr(vp_+(((i)>>2)*4096+((i)&3)*1024+512)); }while(0)
  #define KRD(G,j) do{ if(G){ kload2(kf,kp0+sl_next,j); SBAR(); } }while(0)
  #define STEP(C0,C1,P0,P1,t,GK,GV,GL) do{ SBAR(); \
    const lds_cptr vp_=vp0+sl_prev; \
    VRD(0); SBAR(); float sacc=(P0[0]+P0[1]); \
    GAPA(C0=__builtin_amdgcn_mfma_f32_32x32x16_bf16(kf[0],qr[0],negm,0,0,0), P0[2],P0[3],P0[4],P0[5],     pw0[0]=PKW(P0,0), pw0[1]=PKW(P0,2), pw0); \
    VRD(4); SBAR(); GAPA(C1=__builtin_amdgcn_mfma_f32_32x32x16_bf16(kf[1],qr[0],negm,0,0,0), P0[6],P0[7],P0[8],P0[9],     pw0[2]=PKW(P0,4), pw0[3]=PKW(P0,6), pw0); \
    VRD(1); SBAR(); GAPA(C0=__builtin_amdgcn_mfma_f32_32x32x16_bf16(kf[2],qr[1],C0,0,0,0),   P0[10],P0[11],P0[12],P0[13], pw1[0]=PKW(P0,8), pw1[1]=PKW(P0,10), pw1); \
    VRD(5); SBAR(); GAPA(C1=__builtin_amdgcn_mfma_f32_32x32x16_bf16(kf[3],qr[1],C1,0,0,0),   P0[14],P0[15],P1[0],P1[1],   pw1[2]=PKW(P0,12),pw1[3]=PKW(P0,14), pw1); \
    VRD(2); SBAR(); GAPA(C0=__builtin_amdgcn_mfma_f32_32x32x16_bf16(kf[4],qr[2],C0,0,0,0),   P1[2],P1[3],P1[4],P1[5],     pw2[0]=PKW(P1,0), pw2[1]=PKW(P1,2), pw2); \
    VRD(6); SBAR(); GAPA(C1=__builtin_amdgcn_mfma_f32_32x32x16_bf16(kf[5],qr[2],C1,0,0,0),   P1[6],P1[7],P1[8],P1[9],     pw2[2]=PKW(P1,4), pw2[3]=PKW(P1,6), pw2); \
    VRD(3); SBAR(); GAPA(C0=__builtin_amdgcn_mfma_f32_32x32x16_bf16(kf[6],qr[3],C0,0,0,0),   P1[10],P1[11],P1[12],P1[13], pw3[0]=PKW(P1,8), pw3[1]=PKW(P1,10), pw3); \
    VRD(7); SBAR(); GAPA(C1=__builtin_amdgcn_mfma_f32_32x32x16_bf16(kf[7],qr[3],C1,0,0,0),   P1[14],P1[15],0.f,0.f,       pw3[2]=PKW(P1,12),pw3[3]=PKW(P1,14), pw3); \
    l_reg+=sacc; \
    if(GK){DMA_K((t)+3,sl_cur);} if(GV){DMA_V((t)+1,sl_next);} \
    CMASK(C0,C1,t); \
    { float a=MX3(C0[0],C0[1],C1[0]),b=MX3(C0[2],C0[3],C1[1]); a=MX3(a,C1[2],C1[3]); \
      _Pragma("unroll") for(int r=4;r<16;r+=4){a=MX3(a,C0[r],C0[r+1]);b=MX3(b,C0[r+2],C0[r+3]);a=MX3(a,C1[r],C1[r+1]);b=MX3(b,C1[r+2],C1[r+3]);} \
      float rm=__builtin_fmaxf(a,b); { auto rr=__builtin_amdgcn_permlane32_swap(__float_as_uint(rm),__float_as_uint(rm),false,false); rm=__builtin_fmaxf(__uint_as_float(rr[0]),__uint_as_float(rr[1])); } \
      resc=false; \
      if(__builtin_expect(__any(rm>(float)THRL),0)){ const float dl=__builtin_fmaxf(rm,0.f); mhat+=dl; \
        _Pragma("unroll") for(int r=0;r<16;++r){C0[r]-=dl;C1[r]-=dl;} \
        _Pragma("unroll") for(int r=0;r<16;++r)negm[r]=-mhat; asm volatile("":"+v"(negm)); \
        const float f=__builtin_amdgcn_exp2f(-dl); l_reg*=f; if(hi==0)wsf[r32]=f; resc=true; } } \
    SBAR(); \
    GAPB(o[0]=__builtin_amdgcn_mfma_f32_32x32x16_bf16(PAF(0),VFR(0),o[0],0,0,0), C0,0); \
    GAPB(o[1]=__builtin_amdgcn_mfma_f32_32x32x16_bf16(PAF(0),VFR(4),o[1],0,0,0), C0,4); \
    KRD(GL,0); GAPB(o[0]=__builtin_amdgcn_mfma_f32_32x32x16_bf16(PAF(1),VFR(1),o[0],0,0,0), C0,8); \
    KRD(GL,1); GAPB(o[1]=__builtin_amdgcn_mfma_f32_32x32x16_bf16(PAF(1),VFR(5),o[1],0,0,0), C0,12); \
    KRD(GL,2); GAPB(o[0]=__builtin_amdgcn_mfma_f32_32x32x16_bf16(PAF(2),VFR(2),o[0],0,0,0), C1,0); \
    KRD(GL,3); GAPB(o[1]=__builtin_amdgcn_mfma_f32_32x32x16_bf16(PAF(2),VFR(6),o[1],0,0,0), C1,4); \
    GAPB(o[0]=__builtin_amdgcn_mfma_f32_32x32x16_bf16(PAF(3),VFR(3),o[0],0,0,0), C1,8); \
    GAPB(o[1]=__builtin_amdgcn_mfma_f32_32x32x16_bf16(PAF(3),VFR(7),o[1],0,0,0), C1,12); \
    }while(0)
  int t=1;
  for(;t+5<NT;t+=2){
    STEP(pB0,pB1,pA0,pA1,t,true,true,true);     WAIT_BAR(2); RESC(); ROT();
    STEP(pA0,pA1,pB0,pB1,t+1,true,true,true);   WAIT_BAR(2); RESC(); ROT();
  }
  #define ENDW(tt) do{ if((tt)+3<NT){WAIT_BAR(2);} else if((tt)+2<NT){WAIT_BAR(1);} else {WAIT_BAR(0);} }while(0)
  for(;t+1<NT;t+=2){
    STEP(pB0,pB1,pA0,pA1,t,(t+3<NT),(t+1<NT),(t+1<NT));       ENDW(t);   RESC(); ROT();
    STEP(pA0,pA1,pB0,pB1,t+1,(t+4<NT),(t+2<NT),(t+2<NT));     ENDW(t+1); RESC(); ROT();
  }
  STEP(pB0,pB1,pA0,pA1,NT-1,false,false,false); RESC();
  { float sacc=pB0[0]+pB0[1]; _Pragma("unroll") for(int r=2;r<16;++r)sacc+=pB0[r]; _Pragma("unroll") for(int r=0;r<16;++r)sacc+=pB1[r]; l_reg+=sacc;
    pw0=(u32x4){PKW(pB0,0),PKW(pB0,2),PKW(pB0,4),PKW(pB0,6)};pw1=(u32x4){PKW(pB0,8),PKW(pB0,10),PKW(pB0,12),PKW(pB0,14)};pw2=(u32x4){PKW(pB1,0),PKW(pB1,2),PKW(pB1,4),PKW(pB1,6)};pw3=(u32x4){PKW(pB1,8),PKW(pB1,10),PKW(pB1,12),PKW(pB1,14)};
    SBAR(); pv(o,vb0+sl_cur,PAF(0),PAF(1),PAF(2),PAF(3)); }
  #undef PKW
  #undef PAF
  #undef VFR
  #undef PIN
  #undef MX3
  #undef GAPA
  #undef GAPB
  #undef EX
  #undef VRD
  #undef KRD
  #undef STEP
  #undef ENDW
  {auto rr=__builtin_amdgcn_permlane32_swap(__float_as_uint(l_reg),__float_as_uint(l_reg),false,false);l_reg=__uint_as_float(rr[0])+__uint_as_float(rr[1]);}
  if(MODE==1){ if(has_sink) l_reg+=__builtin_amdgcn_exp2f(sinkl2-mhat); if(lse!=nullptr&&hi==0) lse[(long)(wid*QBLK+r32)*8]=0.6931471805599453f*(mhat+__builtin_amdgcn_logf(l_reg)); }
  if(hi==0)wsf[32+r32]=l_reg;asm volatile("s_waitcnt lgkmcnt(0)":::"memory");
  float rli[16];
  #pragma unroll
  for(int r=0;r<16;++r)rli[r]=__builtin_amdgcn_rcpf(wsf[32+crow(r,hi)]);
  bf16*Ow=Ou+(long)(wid*QBLK)*OP;
  { bf16*stg=(bf16*)(shm+LDS_OST)+wid*2048;
    #pragma unroll
    for(int r=0;r<16;++r){const int orow=crow(r,hi);
      #pragma unroll
      for(int d0=0;d0<2;++d0)stg[orow*64+d0*32+r32]=__float2bfloat16(o[d0][r]*rli[r]);}
    asm volatile("s_waitcnt lgkmcnt(0)":::"memory");
    #pragma unroll
    for(int i=0;i<4;++i){const int row=i*8+(lane>>3),ch=lane&7; const u32x4 v=*(const u32x4*)(stg+row*64+ch*8); ATTN_STORE16(Ow+(long)row*OP+ch*8,v);} }
  asm volatile("s_waitcnt lgkmcnt(0)\n\ts_barrier":::"memory");
  #undef DMA_K
  #undef DMA_V
  #undef CMASK
  #undef START
  #undef RESC
  #undef ROT
}
constexpr int ATTN_LDS_BYTES=LDS_BYTES;
#undef SBAR
#undef WAIT_BAR
}
#define XB_TMO      128
#define XB_XCNT(j)  (256  + 64 * (j))
#define XB_XSUB(j)  (1280 + 64 * (j))
#define XB_XGEN(j)  (2304 + 64 * (j))
#define XB_TOP      3328
#define XB_TOPGEN   3392
#define XCD_BAR_WORDS 3456
#define XB_SPIN_CAP (1u << 18)

__device__ __forceinline__ unsigned xb_ld(unsigned* p)              { return __hip_atomic_load(p, __ATOMIC_RELAXED, __HIP_MEMORY_SCOPE_AGENT); }
__device__ __forceinline__ unsigned xb_add(unsigned* p, unsigned v) { return __hip_atomic_fetch_add(p, v, __ATOMIC_RELAXED, __HIP_MEMORY_SCOPE_AGENT); }
__device__ __forceinline__ unsigned xb_xcc_id() { return (unsigned)__builtin_amdgcn_s_getreg((3 << 11) | 20) & 0xFu; }
#define XB_SPIN(cond, bar) do { unsigned _sp = 0; while (cond) { __builtin_amdgcn_s_sleep(1); \
    if ((++_sp & 255u) == 0u) { if (xb_ld(&(bar)[XB_TMO])) break; if (_sp > XB_SPIN_CAP) { atomicAdd(&(bar)[XB_TMO], 1u); break; } } } } while (0)

struct XcdBarrier {
    unsigned* bar; unsigned x;
    volatile LAS unsigned* st;
};

__device__ __forceinline__ XcdBarrier xcd_barrier_post(unsigned* bar, volatile LAS unsigned* st) {
    XcdBarrier b; b.bar = bar; b.x = xb_xcc_id(); b.st = st;
    if (threadIdx.x == 0) (void)xb_add(&bar[XB_XCNT(b.x)], 1u);
    return b;
}
__device__ __forceinline__ void xcd_barrier_complete(unsigned* bar, unsigned x, unsigned& nloc, unsigned& nx) {
    const unsigned G = gridDim.x * gridDim.y * gridDim.z;
    unsigned sum, cnt, mine, sp = 0u;
    for (;;) {
        sum = 0u; cnt = 0u; mine = 0u;
#pragma unroll
        for (unsigned j = 0; j < 16; ++j) { const unsigned c = xb_ld(&bar[XB_XCNT(j)]); sum += c; cnt += (c > 0u) ? 1u : 0u; mine = (j == x) ? c : mine; }
        if (sum == G) break;
        __builtin_amdgcn_s_sleep(1);
        if ((++sp & 255u) == 0u) { if (xb_ld(&bar[XB_TMO])) break; if (sp > XB_SPIN_CAP) { atomicAdd(&bar[XB_TMO], 1u); break; } }
    }
    nloc = mine > 0u ? mine : 1u; nx = cnt > 0u ? cnt : 1u;
}

__device__ __forceinline__ void xcd_barrier(const XcdBarrier& b) {
    asm volatile("s_waitcnt vmcnt(0)" ::: "memory");
    __syncthreads();
    if (threadIdx.x == 0) {
        unsigned* bar = b.bar;
        __builtin_amdgcn_s_waitcnt(0);
        unsigned nloc = b.st[0], nx = b.st[1];
        if (nloc == 0u) { xcd_barrier_complete(bar, b.x, nloc, nx); b.st[0] = nloc; b.st[1] = nx; }
        const unsigned old = xb_add(&bar[XB_XSUB(b.x)], 1u);
        const unsigned gen = old / nloc;
        if (old + 1u == (gen + 1u) * nloc) {
            __builtin_amdgcn_fence(__ATOMIC_RELEASE, "agent");
            asm volatile("s_waitcnt vmcnt(0)" ::: "memory");
            const unsigned og = xb_add(&bar[XB_TOP], 1u);
            const unsigned tg = og / nx;
            if (og + 1u == (tg + 1u) * nx) xb_add(&bar[XB_TOPGEN], 1u);
            else XB_SPIN(xb_ld(&bar[XB_TOPGEN]) == tg, bar);
            __builtin_amdgcn_fence(__ATOMIC_ACQUIRE, "agent");
            xb_add(&bar[XB_XGEN(b.x)], 1u);
            asm volatile("s_waitcnt vmcnt(0)" ::: "memory");
        } else {
            XB_SPIN(xb_ld(&bar[XB_XGEN(b.x)]) == gen, bar);
            __builtin_amdgcn_fence(__ATOMIC_ACQUIRE, "agent");
            asm volatile("s_waitcnt vmcnt(0)" ::: "memory");
        }
    }
    __syncthreads();
}

struct Frame {
    LAS unsigned char* lds;
    volatile LAS unsigned* MISC;
    gu32* ctl;
    int tid, lane, wave, vcu, G, bx;
    int gw, NGW;
};
__device__ __forceinline__ bool refresh(Frame& F) {
    int t = threadIdx.x; asm volatile("" : "+v"(t)); F.tid = t; F.lane = t & 63; F.wave = __builtin_amdgcn_readfirstlane(t >> 6);
    int bx = blockIdx.x, G = gridDim.x; asm volatile("" : "+s"(bx), "+s"(G)); F.bx = bx; F.G = G;
    F.vcu = (G % 8 == 0) ? (bx % 8) * (G / 8) + bx / 8 : bx; F.gw = F.vcu * NWAVES + F.wave; F.NGW = G * NWAVES; return true; }
__device__ __forceinline__ float wave_sum(float v) {
#pragma unroll
    for (int o = 1; o < 64; o <<= 1) v += __shfl_xor(v, o);
    return v;
}
template <int MAP> __device__ __forceinline__ int rowmap(int n) {
    if (MAP == 1) { const int f = n >> 1; return 256 * (f >> 7) + 128 * (n & 1) + (f & 127); }
    if (MAP == 2 || MAP == 3) { const int tl = n >> 8, hh = (n >> 6) & 3, d = n & 63; int bj, j;
        const bool axial = (MAP == 2) && (tl < 2 || (tl == 2 && hh < 2));
        if (axial) { bj = (d >> 4) & 1; j = (d & 15) + ((d >> 5) << 4); } else { bj = d >> 5; j = d & 31; }
        return 256 * tl + 128 * bj + 32 * hh + j; }
    return n; }
struct TrTile { const float* W; bf16* WT; const float* gain; int K, N, k0, n0; };
__device__ __forceinline__ void tr_load(const TrTile& t, f32x4 (&v)[16], int lane) {
    const float* src = t.W + (size_t)(t.k0 + (lane >> 4)) * t.N + t.n0 + 4 * (lane & 15);
#pragma unroll
    for (int i = 0; i < 16; ++i) v[i] = *(const f32x4*)(src + (size_t)(4 * i) * t.N);
}
template <int MAP> __device__ __forceinline__ void tr_store(const TrTile& t, f32x4 (&v)[16], LAS float* scr, int lane) {
    const int lr = lane >> 4, lc = lane & 15;
    if (t.gain) {
#pragma unroll
        for (int i = 0; i < 16; ++i) v[i] *= t.gain[t.k0 + 4 * i + lr]; }
#pragma unroll
    for (int i = 0; i < 16; ++i) { LAS float* p = scr + (4 * i + lr) * 65 + 4 * lc; p[0] = v[i].x; p[1] = v[i].y; p[2] = v[i].z; p[3] = v[i].w; }
    LDS_WAIT(); asm volatile("" ::: "memory");
    const int c = lane & 7;
#pragma unroll
    for (int j = 0; j < 8; ++j) { const int n = 8 * j + (lane >> 3); const LAS float* s = scr + (8 * c) * 65 + n;
        v4u o; o.x = pk2(s[0 * 65], s[1 * 65]); o.y = pk2(s[2 * 65], s[3 * 65]); o.z = pk2(s[4 * 65], s[5 * 65]); o.w = pk2(s[6 * 65], s[7 * 65]);
        *(GAS v4u*)(t.WT + (size_t)rowmap<MAP>(t.n0 + n) * t.K + t.k0 + 8 * c) = o; }
    LDS_WAIT(); asm volatile("" ::: "memory");
}
template <int MAP> __device__ __forceinline__ void transpose_family(Frame& F, const float* W, size_t sW, bf16* WT, size_t sWT, const float* gain, int sG, int K, int N, int nmat, int gdiv) {
    LAS float* scr = (LAS float*)(F.lds + RING_OFF) + F.wave * (128 * 33);
    const int nb = N / 64, per = (K / 64) * nb, total = per * nmat;
    f32x4 va[16], vb[16];
    int it = F.gw; if (it >= total) return;
    TrTile ta, tb;
#define TR_SETUP(tt, item) do { const int mi = (item) / per, r = (item) % per; tt.W = W + (size_t)mi * sW; tt.WT = WT + (size_t)mi * sWT; tt.gain = gain ? gain + (size_t)(mi / gdiv) * sG : nullptr; tt.K = K; tt.N = N; tt.k0 = 64 * (r / nb); tt.n0 = 64 * (r % nb); } while (0)
    TR_SETUP(ta, it); tr_load(ta, va, F.lane);
    for (;;) {
        const int it2 = it + F.NGW; const bool h2 = it2 < total;
        if (h2) { TR_SETUP(tb, it2); tr_load(tb, vb, F.lane); }
        tr_store<MAP>(ta, va, scr, F.lane);
        if (!h2) break;
        const int it3 = it2 + F.NGW; const bool h3 = it3 < total;
        if (h3) { TR_SETUP(ta, it3); tr_load(ta, va, F.lane); }
        tr_store<MAP>(tb, vb, scr, F.lane);
        if (!h3) break;
        it = it3;
    }
#undef TR_SETUP
}
__device__ __forceinline__ void tr8_load(const TrTile& t, f32x4 (&v)[16], int lane) {
    const float* src = t.W + (size_t)(t.k0 + (lane >> 3)) * t.N + t.n0 + 4 * (lane & 7);
#pragma unroll
    for (int i = 0; i < 16; ++i) v[i] = *(const f32x4*)(src + (size_t)(8 * i) * t.N);
}
template <int MAP> __device__ __forceinline__ void tr8_store(const TrTile& t, f32x4 (&v)[16], LAS float* scr, int lane) {
    const int lr = lane >> 3, lc = lane & 7; const float sc = (float)(1 << F8_WSC);
#pragma unroll
    for (int i = 0; i < 16; ++i) { const float g = t.gain ? t.gain[t.k0 + 8 * i + lr] * sc : sc; LAS float* p = scr + (8 * i + lr) * 33 + 4 * lc; p[0] = v[i].x * g; p[1] = v[i].y * g; p[2] = v[i].z * g; p[3] = v[i].w * g; }
    LDS_WAIT(); asm volatile("" ::: "memory");
    const int c = lane & 7;
#pragma unroll
    for (int j = 0; j < 4; ++j) { const int n = 8 * j + (lane >> 3); const LAS float* s = scr + (16 * c) * 33 + n;
        v4u o; o.x = pk4_fp8(s[0 * 33], s[1 * 33], s[2 * 33], s[3 * 33]); o.y = pk4_fp8(s[4 * 33], s[5 * 33], s[6 * 33], s[7 * 33]); o.z = pk4_fp8(s[8 * 33], s[9 * 33], s[10 * 33], s[11 * 33]); o.w = pk4_fp8(s[12 * 33], s[13 * 33], s[14 * 33], s[15 * 33]);
        *(GAS v4u*)((unsigned char*)t.WT + (size_t)rowmap<MAP>(t.n0 + n) * t.K + t.k0 + 16 * c) = o; }
    LDS_WAIT(); asm volatile("" ::: "memory");
}
template <int MAP> __device__ __forceinline__ void transpose_family_f8(Frame& F, const float* W, size_t sW, unsigned char* WT, size_t sWT, const float* gain, int sG, int K, int N, int nmat, int gdiv) {
    LAS float* scr = (LAS float*)(F.lds + RING_OFF) + F.wave * (128 * 33);
    const int nb = N / 32, per = (K / 128) * nb, total = per * nmat;
    f32x4 va[16], vb[16];
    int it = F.gw; if (it >= total) return;
    TrTile ta, tb;
#define TR_SETUP(tt, item) do { const int mi = (item) / per, r = (item) % per; tt.W = W + (size_t)mi * sW; tt.WT = (bf16*)(WT + (size_t)mi * sWT); tt.gain = gain ? gain + (size_t)(mi / gdiv) * sG : nullptr; tt.K = K; tt.N = N; tt.k0 = 128 * (r / nb); tt.n0 = 32 * (r % nb); } while (0)
    TR_SETUP(ta, it); tr8_load(ta, va, F.lane);
    for (;;) {
        const int it2 = it + F.NGW; const bool h2 = it2 < total;
        if (h2) { TR_SETUP(tb, it2); tr8_load(tb, vb, F.lane); }
        tr8_store<MAP>(ta, va, scr, F.lane);
        if (!h2) break;
        const int it3 = it2 + F.NGW; const bool h3 = it3 < total;
        if (h3) { TR_SETUP(ta, it3); tr8_load(ta, va, F.lane); }
        tr8_store<MAP>(tb, vb, scr, F.lane);
        if (!h3) break;
        it = it3;
    }
#undef TR_SETUP
}
__device__ __forceinline__ float rope_freq(int i, int half_dim) { return exp2f(-(float)i / (float)half_dim * LOG2_THETA); }

__device__ __forceinline__ void attn_phase_l0(Frame& F, const bf16* Q3, const bf16* K3, const bf16* V3, bf16* OCAT, const float* sink) {
    char* shm = (char*)(F.lds + RING_OFF);
    const int upc = (512 + F.G - 1) / F.G;
    for (int i = 0; i < upc; ++i) { const int u = F.vcu * upc + i; if (u >= 512) break;
        const int bhk = u >> 7, b = bhk >> 1, hkv = bhk & 1, hq = hkv * 4 + ((u & 127) >> 5), qb = u & 31; const size_t r0 = (size_t)b * SEQ + qb * 256;
        attn_body::attn_unit<0, 1024, 8>((const attn_body::bf16*)(Q3 + r0 * 512 + hq * 64), (const attn_body::bf16*)(K3 + (size_t)b * SEQ * 128 + hkv * 64), (const attn_body::bf16*)(V3 + (size_t)b * SEQ * 128 + hkv * 64),
                                        (attn_body::bf16*)(OCAT + r0 * D + hq * 64), SEQ / 64, 0, 0, 0.f, false, nullptr, shm); }
    const bf16* Qb = Q3 + (size_t)T * 512; const bf16* Kb = K3 + (size_t)T * 128; const bf16* Vb = V3 + (size_t)T * 128;
    for (int i = 0; i < upc; ++i) { const int u = F.vcu * upc + i; if (u >= 512) break;
        const int bhk = u >> 7, b = bhk >> 1, hkv = bhk & 1, hq = hkv * 4 + ((u & 127) >> 5), qb = u & 31; const size_t r0 = (size_t)b * SEQ + qb * 256;
        const int tl = max(qb * 4 - 2, 0), th = min(qb * 4 + 6, SEQ / 64); const size_t k0 = (size_t)b * SEQ + tl * 64;
        attn_body::attn_unit<1, 1024, 8>((const attn_body::bf16*)(Qb + r0 * 512 + hq * 64), (const attn_body::bf16*)(Kb + k0 * 128 + hkv * 64), (const attn_body::bf16*)(Vb + k0 * 128 + hkv * 64),
                                        (attn_body::bf16*)(OCAT + r0 * D + 512 + hq * 64), th - tl, tl * 64 - qb * 256, 128, sink[hq] * 1.4426950408889634f, true, nullptr, shm); }
}
__device__ __forceinline__ void attn_phase_l1(Frame& F, const bf16* Q3, const bf16* K3, const bf16* V3, bf16* OGB, float* LSE) {
    char* shm = (char*)(F.lds + RING_OFF);
    const int upc = (512 + F.G - 1) / F.G;
#pragma unroll 1
    for (int g = 0; g < 3; ++g) { const int Lc = SEQ >> (2 * g);
        for (int i = 0; i < upc; ++i) { const int u = F.vcu * upc + i; if (u >= 512) break;
            const int bhk = u >> 7, b = bhk >> 1, hkv = bhk & 1, hq = hkv * 4 + ((u & 127) >> 5), qb = u & 31; const size_t r0 = (size_t)b * SEQ + qb * 256;
            const int q0 = qb * 256, cbase = q0 & ~(Lc - 1), lq0 = q0 & (Lc - 1); const int tl = min(max(lq0 / 64 - 1, 0), Lc / 64 - 6); const size_t k0 = (size_t)b * SEQ + cbase + tl * 64;
            attn_body::attn_unit<1, 512, 8>((const attn_body::bf16*)(Q3 + (size_t)g * T * 512 + r0 * 512 + hq * 64), (const attn_body::bf16*)(K3 + (size_t)g * T * 128 + k0 * 128 + hkv * 64), (const attn_body::bf16*)(V3 + (size_t)g * T * 128 + k0 * 128 + hkv * 64),
                                           (attn_body::bf16*)(OGB + (size_t)g * T * 512 + r0 * 512 + hq * 64), 6, cbase + tl * 64 - q0, 64, 0.f, false, LSE + (size_t)g * T * 8 + r0 * 8 + hq, shm); }
    }
}
__device__ __forceinline__ void merge_phase(Frame& F, const bf16* OGB, const float* LSE, bf16* OCAT1) {
    for (int m = F.gw; m < T; m += F.NGW) {
        const int h = F.lane >> 3; const int b = m / SEQ, pos = m % SEQ;
        const size_t r0 = m, r1 = (size_t)b * SEQ + (size_t)(pos & 3) * (SEQ / 4) + (pos >> 2), r2 = (size_t)b * SEQ + (size_t)(pos & 15) * (SEQ / 16) + (pos >> 4);
        const float l0 = LSE[r0 * 8 + h], l1 = LSE[(size_t)T * 8 + r1 * 8 + h], l2 = LSE[(size_t)2 * T * 8 + r2 * 8 + h];
        const float mx = fmaxf(l0, fmaxf(l1, l2)); float w0 = __expf(l0 - mx), w1 = __expf(l1 - mx), w2 = __expf(l2 - mx); const float is = 1.f / (w0 + w1 + w2); w0 *= is; w1 *= is; w2 *= is;
        const v4u a = *(const v4u*)(OGB + r0 * 512 + F.lane * 8), bb = *(const v4u*)(OGB + (size_t)T * 512 + r1 * 512 + F.lane * 8), c = *(const v4u*)(OGB + (size_t)2 * T * 512 + r2 * 512 + F.lane * 8);
        v4u w;
        w.x = pk2(w0 * bflo(a.x) + w1 * bflo(bb.x) + w2 * bflo(c.x), w0 * bfhi(a.x) + w1 * bfhi(bb.x) + w2 * bfhi(c.x));
        w.y = pk2(w0 * bflo(a.y) + w1 * bflo(bb.y) + w2 * bflo(c.y), w0 * bfhi(a.y) + w1 * bfhi(bb.y) + w2 * bfhi(c.y));
        w.z = pk2(w0 * bflo(a.z) + w1 * bflo(bb.z) + w2 * bflo(c.z), w0 * bfhi(a.z) + w1 * bfhi(bb.z) + w2 * bfhi(c.z));
        w.w = pk2(w0 * bflo(a.w) + w1 * bflo(bb.w) + w2 * bflo(c.w), w0 * bfhi(a.w) + w1 * bfhi(bb.w) + w2 * bfhi(c.w));
        *(v4u*)(OCAT1 + (size_t)m * C_OUT + F.lane * 8) = w;
    }
}

typedef float f32x4m __attribute__((ext_vector_type(4)));
__device__ __forceinline__ void top4_merge(float (&v)[4], int (&ix)[4], int mask) {
    float ov[4]; int oi[4];
#pragma unroll
    for (int k = 0; k < 4; ++k) { ov[k] = __shfl_xor(v[k], mask); oi[k] = __shfl_xor(ix[k], mask); }
    float cv[8]; int ci[8];
#pragma unroll
    for (int k = 0; k < 4; ++k) { cv[k] = v[k]; ci[k] = ix[k]; cv[4 + k] = ov[k]; ci[4 + k] = oi[k]; }
    unsigned used = 0u;
#pragma unroll
    for (int k = 0; k < 4; ++k) { float best = -INFINITY; int bi = 1 << 30, bp = 0;
#pragma unroll
        for (int c = 0; c < 8; ++c) { const bool take = !((used >> c) & 1u) && (cv[c] > best || (cv[c] == best && ci[c] < bi)); best = take ? cv[c] : best; bi = take ? ci[c] : bi; bp = take ? c : bp; }
        used |= 1u << bp; v[k] = best; ix[k] = bi; }
}
__device__ __forceinline__ void route_phase(Frame& F, const bf16* H, const float* WR, const float* rb, int* CNTTAB, int* TOPE, float* TOPG, int* TOPPOS, float* RSTD) {
    LAS float* WL = (LAS float*)(F.lds + RING_OFF);
    LAS unsigned* LC = (LAS unsigned*)(F.lds + RING_OFF + NE * 1028 * 4);
    if (F.tid < NE) LC[F.tid] = 0u;
    for (int i = F.tid; i < NE * D / 4; i += NWAVES * 64) { const int e = i >> 8, k4 = i & 255; *(LAS f32x4*)(WL + e * 1028 + 4 * k4) = *(const f32x4*)(WR + (size_t)e * D + 4 * k4); }
    __syncthreads();
    const int lane = F.lane, c = lane & 15, q = lane >> 4;
    for (int task = F.wave * F.G + F.vcu; task < T / 16; task += F.NGW) {
        const bf16* xr = H + (size_t)(task * 16 + c) * D + 8 * q;
        const LAS float* w0 = WL + c * 1028 + 8 * q; const LAS float* w1 = w0 + 16 * 1028;
        f32x4m a0 = {0.f, 0.f, 0.f, 0.f}, a1 = {0.f, 0.f, 0.f, 0.f}; float ssq = 0.f;
#pragma unroll 4
        for (int ch = 0; ch < 32; ++ch) {
            const v4u xv = *(const v4u*)(xr + 32 * ch);
            float xf[8]; xf[0] = bflo(xv.x); xf[1] = bfhi(xv.x); xf[2] = bflo(xv.y); xf[3] = bfhi(xv.y); xf[4] = bflo(xv.z); xf[5] = bfhi(xv.z); xf[6] = bflo(xv.w); xf[7] = bfhi(xv.w);
            const f32x4 wa0 = *(const LAS f32x4*)(w0 + 32 * ch), wa1 = *(const LAS f32x4*)(w0 + 32 * ch + 4), wb0 = *(const LAS f32x4*)(w1 + 32 * ch), wb1 = *(const LAS f32x4*)(w1 + 32 * ch + 4);
#pragma unroll
            for (int t = 0; t < 8; ++t) ssq += xf[t] * xf[t];
            a0 = __builtin_amdgcn_mfma_f32_16x16x4f32(wa0.x, xf[0], a0, 0, 0, 0); a1 = __builtin_amdgcn_mfma_f32_16x16x4f32(wb0.x, xf[0], a1, 0, 0, 0);
            a0 = __builtin_amdgcn_mfma_f32_16x16x4f32(wa0.y, xf[1], a0, 0, 0, 0); a1 = __builtin_amdgcn_mfma_f32_16x16x4f32(wb0.y, xf[1], a1, 0, 0, 0);
            a0 = __builtin_amdgcn_mfma_f32_16x16x4f32(wa0.z, xf[2], a0, 0, 0, 0); a1 = __builtin_amdgcn_mfma_f32_16x16x4f32(wb0.z, xf[2], a1, 0, 0, 0);
            a0 = __builtin_amdgcn_mfma_f32_16x16x4f32(wa0.w, xf[3], a0, 0, 0, 0); a1 = __builtin_amdgcn_mfma_f32_16x16x4f32(wb0.w, xf[3], a1, 0, 0, 0);
            a0 = __builtin_amdgcn_mfma_f32_16x16x4f32(wa1.x, xf[4], a0, 0, 0, 0); a1 = __builtin_amdgcn_mfma_f32_16x16x4f32(wb1.x, xf[4], a1, 0, 0, 0);
            a0 = __builtin_amdgcn_mfma_f32_16x16x4f32(wa1.y, xf[5], a0, 0, 0, 0); a1 = __builtin_amdgcn_mfma_f32_16x16x4f32(wb1.y, xf[5], a1, 0, 0, 0);
            a0 = __builtin_amdgcn_mfma_f32_16x16x4f32(wa1.z, xf[6], a0, 0, 0, 0); a1 = __builtin_amdgcn_mfma_f32_16x16x4f32(wb1.z, xf[6], a1, 0, 0, 0);
            a0 = __builtin_amdgcn_mfma_f32_16x16x4f32(wa1.w, xf[7], a0, 0, 0, 0); a1 = __builtin_amdgcn_mfma_f32_16x16x4f32(wb1.w, xf[7], a1, 0, 0, 0);
        }
        ssq += __shfl_xor(ssq, 16); ssq += __shfl_xor(ssq, 32);
        const float rstd = 1.f / sqrtf(ssq * (1.f / D) + NORM_EPS);
        float cv[8]; int ci[8];
#pragma unroll
        for (int r = 0; r < 4; ++r) { ci[r] = 4 * q + r; ci[4 + r] = 16 + 4 * q + r; cv[r] = a0[r] * rstd + rb[4 * q + r]; cv[4 + r] = a1[r] * rstd + rb[16 + 4 * q + r]; }
        float tv[4]; int ti[4]; unsigned used = 0u;
#pragma unroll
        for (int k = 0; k < 4; ++k) { float best = -INFINITY; int bi = 0, bp = 0;
#pragma unroll
            for (int j = 0; j < 8; ++j) { const bool take = !((used >> j) & 1u) && (cv[j] > best); best = take ? cv[j] : best; bi = take ? ci[j] : bi; bp = take ? j : bp; }
            used |= 1u << bp; tv[k] = best; ti[k] = bi; }
        top4_merge(tv, ti, 16); top4_merge(tv, ti, 32);
        const float e1 = __expf(tv[1] - tv[0]), e2 = __expf(tv[2] - tv[0]), e3 = __expf(tv[3] - tv[0]); const float is = 1.f / (1.f + e1 + e2 + e3);
        const int m = task * 16 + c;
        { const int e = q == 0 ? ti[0] : q == 1 ? ti[1] : q == 2 ? ti[2] : ti[3]; const float g = (q == 0 ? 1.f : q == 1 ? e1 : q == 2 ? e2 : e3) * is;
            const unsigned pos = __hip_atomic_fetch_add(LC + e, 1u, __ATOMIC_RELAXED, __HIP_MEMORY_SCOPE_WORKGROUP);
            TOPE[m * 4 + q] = e; TOPG[m * 4 + q] = g; TOPPOS[m * 4 + q] = (int)pos; }
        if (q == 0) RSTD[m] = rstd;
    }
    __syncthreads();
    if (F.tid < NE) CNTTAB[F.vcu * NE + F.tid] = (int)LC[F.tid];
    __syncthreads();
}
__device__ __forceinline__ void slot_phase(Frame& F, const bf16* H, const int* CNTTAB, const int* TOPE, const float* TOPG, const int* TOPPOS, const float* RSTD, int* TOKSLOT, float* SLOTGATE, float* SLOTRS, bf16* XG, int* XTAB, bool f8) {
    LAS int* L = (LAS int*)(F.lds + RING_OFF);
    LAS int* P = L + 128;
    const int lane = F.lane;
    {
#pragma unroll 1
        for (int ee = 0; ee < 4; ++ee) { const int e = F.wave * 4 + ee;
            int s0 = 0, s1 = 0, s2 = 0, s3 = 0; const int g0 = 4 * lane;
            if (g0 < F.G) s0 = CNTTAB[g0 * NE + e]; if (g0 + 1 < F.G) s1 = CNTTAB[(g0 + 1) * NE + e]; if (g0 + 2 < F.G) s2 = CNTTAB[(g0 + 2) * NE + e]; if (g0 + 3 < F.G) s3 = CNTTAB[(g0 + 3) * NE + e];
            const int t = s0 + s1 + s2 + s3; int inc = t;
#pragma unroll
            for (int o = 1; o < 64; o <<= 1) { const int u = __shfl_up(inc, o); if (lane >= o) inc += u; }
            const int base = inc - t;
            P[g0 * NE + e] = base; P[(g0 + 1) * NE + e] = base + s0; P[(g0 + 2) * NE + e] = base + s0 + s1; P[(g0 + 3) * NE + e] = base + s0 + s1 + s2;
            if (lane == 63) L[64 + e] = inc; }
    }
    __syncthreads();
    if (F.wave == 0) {
        const int np = (lane < 32) ? ((L[64 + (lane & 31)] + 255) >> 8) : 0;
        int pre = np;
#pragma unroll
        for (int o = 1; o < 32; o <<= 1) { const int t = __shfl_up(pre, o); if (lane >= o) pre += t; }
        const int p0 = pre - np;
        if (lane < 32) { L[lane] = np; L[32 + lane] = p0 * 256; }
        if (F.bx == 0) {
            int load = 0, ne = 0, cump = 0; bool done = (lane >= 32);
            for (int it = 0; it < 32; ++it) {
                int key = done ? -1 : (np * 64 + (31 - lane));
#pragma unroll
                for (int o = 1; o < 64; o <<= 1) key = max(key, __shfl_xor(key, o));
                const int be = 31 - (key & 63), bn = key >> 6;
                int lk = (lane < 8) ? (load * 8 + lane) : (1 << 30);
#pragma unroll
                for (int o = 1; o < 64; o <<= 1) lk = min(lk, __shfl_xor(lk, o));
                const int bx = lk & 7;
                const int bp0 = __shfl(p0, be);
                if (lane == bx) { int* tb = XTAB + bx * 136 + 4 + 4 * ne; tb[0] = be; tb[1] = bp0; tb[2] = bn; tb[3] = cump; cump += bn; load += bn; ++ne; }
                if (lane == be) done = true;
            }
            if (lane < 8) { XTAB[lane * 136] = ne; XTAB[lane * 136 + 1] = cump; }
        }
    }
    __syncthreads();
    for (int m = F.gw; m < T; m += F.NGW) {
        int slot = 0;
        if (lane < 4) { const int e = TOPE[m * 4 + lane]; const int wg = (m >> 4) % F.G; slot = L[32 + e] + P[wg * NE + e] + TOPPOS[m * 4 + lane]; TOKSLOT[m * 4 + lane] = slot; SLOTGATE[slot] = TOPG[m * 4 + lane]; SLOTRS[slot] = RSTD[m]; }
        const int s0 = __shfl(slot, 0), s1 = __shfl(slot, 1), s2 = __shfl(slot, 2), s3 = __shfl(slot, 3);
        if (f8) {
            const bf16* src = H + (size_t)m * D + lane * 16; const v4u a = *(const v4u*)src, b = *(const v4u*)(src + 8); const float rs = RSTD[m];
            v4u w; w.x = pk4_fp8(clamp448(bflo(a.x) * rs), clamp448(bfhi(a.x) * rs), clamp448(bflo(a.y) * rs), clamp448(bfhi(a.y) * rs)); w.y = pk4_fp8(clamp448(bflo(a.z) * rs), clamp448(bfhi(a.z) * rs), clamp448(bflo(a.w) * rs), clamp448(bfhi(a.w) * rs));
            w.z = pk4_fp8(clamp448(bflo(b.x) * rs), clamp448(bfhi(b.x) * rs), clamp448(bflo(b.y) * rs), clamp448(bfhi(b.y) * rs)); w.w = pk4_fp8(clamp448(bflo(b.z) * rs), clamp448(bfhi(b.z) * rs), clamp448(bflo(b.w) * rs), clamp448(bfhi(b.w) * rs));
            unsigned char* X8 = (unsigned char*)XG; const size_t co = (size_t)lane * 16;
            *(v4u*)(X8 + (size_t)s0 * D + co) = w; *(v4u*)(X8 + (size_t)s1 * D + co) = w; *(v4u*)(X8 + (size_t)s2 * D + co) = w; *(v4u*)(X8 + (size_t)s3 * D + co) = w;
        } else {
        const bf16* src = H + (size_t)m * D + lane * 8; const v4u a = *(const v4u*)src, b = *(const v4u*)(src + 512);
        const size_t co = (size_t)lane * 8;
        *(v4u*)(XG + (size_t)s0 * D + co) = a; *(v4u*)(XG + (size_t)s0 * D + co + 512) = b;
        *(v4u*)(XG + (size_t)s1 * D + co) = a; *(v4u*)(XG + (size_t)s1 * D + co + 512) = b;
        *(v4u*)(XG + (size_t)s2 * D + co) = a; *(v4u*)(XG + (size_t)s2 * D + co + 512) = b;
        *(v4u*)(XG + (size_t)s3 * D + co) = a; *(v4u*)(XG + (size_t)s3 * D + co + 512) = b;
        }
    }
    __syncthreads();
}
__device__ __forceinline__ void y_add16(float (&a)[16], const void* Yp, size_t row, int lane) {
    if (Y_FP8) { const v4u y = *(const v4u*)((const unsigned char*)Yp + row * D + lane * 16); const float is = 1.f / Y_SC;
        const unsigned w[4] = {y.x, y.y, y.z, y.w};
#pragma unroll
        for (int i = 0; i < 4; ++i) { const f32x2_ lo = __builtin_amdgcn_cvt_pk_f32_fp8((int)w[i], false), hi = __builtin_amdgcn_cvt_pk_f32_fp8((int)w[i], true); a[4 * i] += lo.x * is; a[4 * i + 1] += lo.y * is; a[4 * i + 2] += hi.x * is; a[4 * i + 3] += hi.y * is; } }
    else { const bf16* yp = (const bf16*)Yp + row * D + lane * 16; const v4u y0 = *(const v4u*)yp, y1 = *(const v4u*)(yp + 8);
        a[0] += bflo(y0.x); a[1] += bfhi(y0.x); a[2] += bflo(y0.y); a[3] += bfhi(y0.y); a[4] += bflo(y0.z); a[5] += bfhi(y0.z); a[6] += bflo(y0.w); a[7] += bfhi(y0.w);
        a[8] += bflo(y1.x); a[9] += bfhi(y1.x); a[10] += bflo(y1.y); a[11] += bfhi(y1.y); a[12] += bflo(y1.z); a[13] += bfhi(y1.z); a[14] += bflo(y1.w); a[15] += bfhi(y1.w); }
}
__device__ __forceinline__ void combine_phase(Frame& F, const bf16* HM, const void* Y, const int* TOKSLOT, bf16* H2, unsigned char* H2F8) {
    const int lane = F.lane;
    for (int m = F.gw; m < T; m += F.NGW) {
        const int s0 = TOKSLOT[m * 4], s1 = TOKSLOT[m * 4 + 1], s2 = TOKSLOT[m * 4 + 2], s3 = TOKSLOT[m * 4 + 3];
        float a[16];
#pragma unroll
        for (int i = 0; i < 16; ++i) a[i] = 0.f;
        y_add16(a, Y, (size_t)s0, lane); y_add16(a, Y, (size_t)s1, lane); y_add16(a, Y, (size_t)s2, lane); y_add16(a, Y, (size_t)s3, lane);
        const bf16* hp = HM + (size_t)m * D + lane * 16; const v4u h0 = *(const v4u*)hp, h1 = *(const v4u*)(hp + 8);
        a[0] += bflo(h0.x); a[1] += bfhi(h0.x); a[2] += bflo(h0.y); a[3] += bfhi(h0.y); a[4] += bflo(h0.z); a[5] += bfhi(h0.z); a[6] += bflo(h0.w); a[7] += bfhi(h0.w);
        a[8] += bflo(h1.x); a[9] += bfhi(h1.x); a[10] += bflo(h1.y); a[11] += bfhi(h1.y); a[12] += bflo(h1.z); a[13] += bfhi(h1.z); a[14] += bflo(h1.w); a[15] += bfhi(h1.w);
        v4u w0, w1; w0.x = pk2(a[0], a[1]); w0.y = pk2(a[2], a[3]); w0.z = pk2(a[4], a[5]); w0.w = pk2(a[6], a[7]); w1.x = pk2(a[8], a[9]); w1.y = pk2(a[10], a[11]); w1.z = pk2(a[12], a[13]); w1.w = pk2(a[14], a[15]);
        bf16* op = H2 + (size_t)m * D + lane * 16; *(v4u*)op = w0; *(v4u*)(op + 8) = w1;
        if (PLE_FP8) { v4u q; q.x = pk4_fp8(clamp448(a[0]), clamp448(a[1]), clamp448(a[2]), clamp448(a[3])); q.y = pk4_fp8(clamp448(a[4]), clamp448(a[5]), clamp448(a[6]), clamp448(a[7]));
            q.z = pk4_fp8(clamp448(a[8]), clamp448(a[9]), clamp448(a[10]), clamp448(a[11])); q.w = pk4_fp8(clamp448(a[12]), clamp448(a[13]), clamp448(a[14]), clamp448(a[15])); *(v4u*)(H2F8 + (size_t)m * D + lane * 16) = q; }
    }
}
__device__ __forceinline__ void final_norm_phase(Frame& F, const bf16* H, const float* SS, const float* gain, float* out) {
    const int lane = F.lane;
    for (int m = F.gw; m < T; m += F.NGW) {
        const float rstd = 1.f / sqrtf(ssp_sum(SS + (size_t)m * 16) * (1.f / D) + NORM_EPS);
#pragma unroll
        for (int j = 0; j < 2; ++j) { const size_t co = (size_t)j * 512 + lane * 8; const v4u h = *(const v4u*)(H + (size_t)m * D + co); const f32x4 g0 = *(const f32x4*)(gain + co), g1 = *(const f32x4*)(gain + co + 4);
            f32x4 o0, o1; o0.x = bflo(h.x) * rstd * g0.x; o0.y = bfhi(h.x) * rstd * g0.y; o0.z = bflo(h.y) * rstd * g0.z; o0.w = bfhi(h.y) * rstd * g0.w;
            o1.x = bflo(h.z) * rstd * g1.x; o1.y = bfhi(h.z) * rstd * g1.y; o1.z = bflo(h.w) * rstd * g1.z; o1.w = bfhi(h.w) * rstd * g1.w;
            float* dst = out + (size_t)m * D + co; *(f32x4*)dst = o0; *(f32x4*)(dst + 4) = o1; }
    }
}

constexpr int N_PHASES = 22;
struct Args { const float* in[20]; float* out; unsigned char* ws; int ph_lo, ph_hi, li, pad; };
typedef const __attribute__((address_space(4))) Args* argp_t;
__device__ __forceinline__ argp_t opaque_args() { argp_t p = (argp_t)__builtin_amdgcn_kernarg_segment_ptr(); asm volatile("" : "+s"(p)); return p; }
#define AP (opaque_args())
__global__ void __launch_bounds__(NWAVES * 64, 2) fwd_kernel(Args args_unused) {
    extern __shared__ __attribute__((aligned(16))) unsigned char lds[];
    Frame F;
    F.lds = (LAS unsigned char*)lds;
    F.MISC = (volatile LAS unsigned*)(F.lds + MISC_OFF);
    refresh(F);
    F.ctl = (gu32*)(AP->ws + WS_CTL);
    if (F.tid < 128) ((LAS unsigned*)(F.lds + LDSCTL_OFF))[F.tid] = 0u;
    __syncthreads();
    const bool one_phase = (AP->ph_hi - AP->ph_lo) == 1;
    XcdBarrier bar; bar.bar = (unsigned*)(F.ctl + CW_BAR); bar.x = 0; bar.st = nullptr;
    if (!one_phase) bar = xcd_barrier_post((unsigned*)(F.ctl + CW_BAR), F.MISC + 8);
    const int lo = AP->ph_lo, hi = AP->ph_hi;
#ifndef MK_MASK
#define MK_MASK 0x3fff
#endif
#ifndef PROBE_MASK
#define PROBE_MASK 0
#endif
#define IN(k) (lo <= (k) && (k) < hi)
#define INL(j) (((MK_MASK >> (j)) & 1) && IN(pb + (j)) && refresh(F))
#define REP(j) _Pragma("unroll") for (int rep_ = 0; rep_ < (((PROBE_MASK >> (j)) & 1) ? 2 : 1); ++rep_)
#define SEAM(k) do { if (IN((k) + 1)) xcd_barrier(bar); } while (0)
#define ws (AP->ws)
#define WSP(type, off) ((type*)(ws + (off)))
    if (((MK_MASK >> 12) & 1) && IN(0) && refresh(F)) REP(12) {
#pragma unroll 1
        for (int ll = 0; ll < 2; ++ll) {
            const float* wu = AP->in[13] + (size_t)ll * NE * D * 2 * DE; const float* wd = AP->in[15] + (size_t)ll * NE * DE * D; const float* gf = AP->in[10] + ll * D;
            unsigned char* du = ws + WS_WUPT + (size_t)ll * NE * 2 * DE * D * 2; unsigned char* dd = ws + WS_WDNT + (size_t)ll * NE * D * DE * 2;
#if MOE_FP8_MASK != 0
            if ((MOE_FP8_MASK >> ll) & 1) {
                transpose_family_f8<1>(F, wu, (size_t)D * 2 * DE, du, (size_t)2 * DE * D, gf, 0, D, 2 * DE, NE, 1);
                transpose_family_f8<0>(F, wd, (size_t)DE * D, dd, (size_t)D * DE, nullptr, 0, DE, D, NE, 1);
            }
#endif
#if MOE_FP8_MASK != 3
            if (!((MOE_FP8_MASK >> ll) & 1)) {
                transpose_family<1>(F, wu, (size_t)D * 2 * DE, (bf16*)du, (size_t)2 * DE * D, gf, 0, D, 2 * DE, NE, 1);
                transpose_family<0>(F, wd, (size_t)DE * D, (bf16*)dd, (size_t)D * DE, nullptr, 0, DE, D, NE, 1);
            }
#endif
        }
        transpose_family<2>(F, AP->in[3], 0, WSP(bf16, WS_WIN0T), 0, AP->in[2], 0, D, AB_IN, 1, 1);
        transpose_family<3>(F, AP->in[8], 0, WSP(bf16, WS_WIN1T), 0, AP->in[2] + D, 0, D, C_IN, 1, 1);
        transpose_family<0>(F, AP->in[7], 0, WSP(bf16, WS_WOUT0T), 0, nullptr, 0, D, D, 1, 1);
        transpose_family<0>(F, AP->in[9], 0, WSP(bf16, WS_WOUT1T), 0, nullptr, 0, C_OUT, D, 1, 1);
        if (PLE_FP8) transpose_family_f8<0>(F, AP->in[18], (size_t)D * D, ws + WS_WGT, (size_t)D * D * 2, nullptr, 0, D, D, 2, 1);
        else transpose_family<0>(F, AP->in[18], (size_t)D * D, WSP(bf16, WS_WGT), (size_t)D * D, nullptr, 0, D, D, 2, 1);
        transpose_family<0>(F, AP->in[17], (size_t)PLE * D, WSP(bf16, WS_WPT), (size_t)D * PLE, nullptr, 0, PLE, D, 2, 1);
        {
            float* WR = WSP(float, WS_WR); const float* nf = AP->in[10]; const float* rw = AP->in[11];
            for (int i = F.gw * 64 + F.lane; i < 2 * NE * D; i += F.NGW * 64) { const int l = i / (NE * D), e = (i / D) % NE, k = i % D; WR[i] = nf[l * D + k] * rw[((size_t)l * D + k) * NE + e]; }
        }
        {
            float* R1 = WSP(float, WS_ROPE1); float* RA = WSP(float, WS_ROPEA);
            for (int i = F.gw * 64 + F.lane; i < SEQ * 32; i += F.NGW * 64) { const int pos = i >> 5, j = i & 31;
                const float a1 = (float)pos * rope_freq(j, 32); R1[2 * i] = cosf(a1); R1[2 * i + 1] = sinf(a1);
                const float aa = (float)((j < 16) ? (pos >> 6) : (pos & 63)) * rope_freq(j & 15, 16); RA[2 * i] = cosf(aa); RA[2 * i + 1] = sinf(aa); }
        }
        {
            bf16* PBF = WSP(bf16, WS_PBF); const float* p_in = AP->in[1]; const size_t n8 = (size_t)2 * T * PLE / 8;
            for (size_t i = (size_t)F.gw * 64 + F.lane; i < n8; i += (size_t)F.NGW * 64) { const f32x4 a = *(const f32x4*)(p_in + i * 8), b = *(const f32x4*)(p_in + i * 8 + 4);
                v4u w; w.x = pk2(a.x, a.y); w.y = pk2(a.z, a.w); w.z = pk2(b.x, b.y); w.w = pk2(b.z, b.w); *(v4u*)(PBF + i * 8) = w; }
        }
        {
            bf16* X0 = WSP(bf16, WS_X0); float* SS0 = WSP(float, WS_SSP); const float* x_in = AP->in[0];
            for (int m = F.gw; m < T; m += F.NGW) { float s = 0.f;
#pragma unroll
                for (int j = 0; j < 2; ++j) { const size_t co = (size_t)m * D + j * 512 + F.lane * 8; const f32x4 a = *(const f32x4*)(x_in + co), b = *(const f32x4*)(x_in + co + 4);
                    v4u w; w.x = pk2(a.x, a.y); w.y = pk2(a.z, a.w); w.z = pk2(b.x, b.y); w.w = pk2(b.z, b.w); *(v4u*)(X0 + co) = w;
                    s += (bflo(w.x) * bflo(w.x) + bfhi(w.x) * bfhi(w.x)) + (bflo(w.y) * bflo(w.y) + bfhi(w.y) * bfhi(w.y)) + (bflo(w.z) * bflo(w.z) + bfhi(w.z) * bfhi(w.z)) + (bflo(w.w) * bflo(w.w) + bfhi(w.w) * bfhi(w.w)); }
                s = wave_sum(s); if (F.lane < 16) SS0[(size_t)m * 16 + F.lane] = (F.lane == 0) ? s : 0.f; }
        }
        __syncthreads();
        SEAM(0);
    }
#pragma unroll 1
    for (int l = 0; l < 2; ++l) {
        const int pb = 1 + 10 * l;
        if (INL(0)) REP(0) {
            const bf16* hin = (l == 0) ? WSP(bf16, WS_X0) : WSP(bf16, WS_H3);
            const float* ssin = WSP(float, WS_SSP) + (size_t)l * T * 16;
            if (l == 0) { pg8::Gemm g{hin, WSP(bf16, WS_WIN0T), T, AB_IN, D}; pg8::StaticOrder S; S.init(T, AB_IN, F.G, F.bx);
                EpiQKV<0> E{ssin, AP->in[4], AP->in[5], WSP(float, WS_ROPE1), WSP(float, WS_ROPEA), WSP(bf16, WS_Q3), WSP(bf16, WS_K3), WSP(bf16, WS_V3)};
                pg8::gemm_phase<EpiQKV<0>, pg8::StaticOrder, true, true>(F.lds + RING_OFF, g, S, E); }
            else { pg8::Gemm g{hin, WSP(bf16, WS_WIN1T), T, C_IN, D}; pg8::StaticOrder S; S.init(T, C_IN, F.G, F.bx);
                EpiQKV<1> E{ssin, nullptr, nullptr, WSP(float, WS_ROPE1), WSP(float, WS_ROPEA), WSP(bf16, WS_Q3), WSP(bf16, WS_K3), WSP(bf16, WS_V3)};
                pg8::gemm_phase<EpiQKV<1>, pg8::StaticOrder, true, true>(F.lds + RING_OFF, g, S, E); }
            if (l == 0) { int Kp = PLE; asm volatile("" : "+s"(Kp)); pg8::Gemm g{WSP(bf16, WS_PBF), WSP(bf16, WS_WPT), 2 * T, 2 * D, Kp}; PPOrder S{(int)F.G, F.bx};
                EpiPP E{WSP(bf16, WS_PP)};
                pg8::gemm_phase<EpiPP, PPOrder, true, true>(F.lds + RING_OFF, g, S, E); }
            SEAM(pb + 0);
        }
        if (INL(1)) REP(1) {
            if (l == 0) attn_phase_l0(F, WSP(bf16, WS_Q3), WSP(bf16, WS_K3), WSP(bf16, WS_V3), WSP(bf16, WS_OCAT), AP->in[6]);
            else attn_phase_l1(F, WSP(bf16, WS_Q3), WSP(bf16, WS_K3), WSP(bf16, WS_V3), WSP(bf16, WS_OGB), WSP(float, WS_LSE));
            SEAM(pb + 1);
        }
        if (INL(2)) REP(2) { if (l == 1) merge_phase(F, WSP(bf16, WS_OGB), WSP(float, WS_LSE), WSP(bf16, WS_OCAT)); SEAM(pb + 2); }
        if (INL(3)) REP(3) {
            const bf16* hin = (l == 0) ? WSP(bf16, WS_X0) : WSP(bf16, WS_H3);
            pg8::Gemm g{WSP(bf16, WS_OCAT), (const bf16*)(ws + (l == 0 ? WS_WOUT0T : WS_WOUT1T)), T, D, (l == 0) ? D : C_OUT}; pg8::StaticOrder S; S.init(T, D, F.G, F.bx); EpiResBf16 E{hin, WSP(bf16, WS_HM)};
            pg8::gemm_phase<EpiResBf16, pg8::StaticOrder, true, true>(F.lds + RING_OFF, g, S, E);
            SEAM(pb + 3);
        }
        if (INL(4)) REP(4) { route_phase(F, WSP(bf16, WS_HM), WSP(float, WS_WR) + (size_t)l * NE * D, AP->in[12] + l * NE, WSP(int, WS_CNTTAB), WSP(int, WS_TOPE), WSP(float, WS_TOPG), WSP(int, WS_TOPPOS), WSP(float, WS_RSTD));
#ifdef PROBE_ROUTE
            route_phase(F, WSP(bf16, WS_HM), WSP(float, WS_WR) + (size_t)l * NE * D, AP->in[12] + l * NE, WSP(int, WS_OGB) + 16 * T, WSP(int, WS_OGB), WSP(float, WS_OGB) + 4 * T, WSP(int, WS_OGB) + 8 * T, WSP(float, WS_OGB) + 12 * T);
#endif
            SEAM(pb + 4); }
        if (INL(5)) REP(5) { slot_phase(F, WSP(bf16, WS_HM), WSP(int, WS_CNTTAB), WSP(int, WS_TOPE), WSP(float, WS_TOPG), WSP(int, WS_TOPPOS), WSP(float, WS_RSTD), WSP(int, WS_TOKSLOT), WSP(float, WS_SLOTGATE), WSP(float, WS_SLOTRS), WSP(bf16, WS_XG), WSP(int, WS_XTAB), ((MOE_FP8_MASK >> l) & 1) != 0); SEAM(pb + 5); }
        if (INL(6)) REP(6) {
            XcdOrder<3> S{WSP(int, WS_XTAB) + (F.bx & 7) * 136, F.bx >> 3, (int)F.G >> 3};
#if MOE_FP8_MASK != 0
            if ((MOE_FP8_MASK >> l) & 1) { pg8::Gemm g{WSP(bf16, WS_XG), WSP(bf16, WS_WUPT) + (size_t)l * NE * 2 * DE * D, NSLOT, NE * 2 * DE, D / 2};
                EpiSwiglu<true> E{WSP(void, WS_ACT), AP->in[14] + (size_t)l * NE * 2 * DE, nullptr};
                pg8::gemm_phase<EpiSwiglu<true>, XcdOrder<3>, true, true, F8_DIAG ? 1000 : 127 - F8_WSC>(F.lds + RING_OFF, g, S, E); }
#ifdef PROBE_UPNULL
            if ((MOE_FP8_MASK >> l) & 1) { pg8::Gemm g{WSP(bf16, WS_XG), WSP(bf16, WS_WUPT) + (size_t)l * NE * 2 * DE * D, NSLOT, NE * 2 * DE, D / 2};
                EpiNull E{WSP(float, WS_OGB)};
                pg8::gemm_phase<EpiNull, XcdOrder<3>, true, true, 127 - F8_WSC>(F.lds + RING_OFF, g, S, E); }
#endif
#endif
#if MOE_FP8_MASK != 3
            if (!((MOE_FP8_MASK >> l) & 1)) { pg8::Gemm g{WSP(bf16, WS_XG), WSP(bf16, WS_WUPT) + (size_t)l * NE * 2 * DE * D, NSLOT, NE * 2 * DE, D};
                EpiSwiglu<false> E{WSP(void, WS_ACT), AP->in[14] + (size_t)l * NE * 2 * DE, WSP(float, WS_SLOTRS)};
                pg8::gemm_phase<EpiSwiglu<false>, XcdOrder<3>, true, true>(F.lds + RING_OFF, g, S, E); }
#endif
            SEAM(pb + 6);
        }
        if (INL(7)) REP(7) {
            XcdOrder<2> S{WSP(int, WS_XTAB) + (F.bx & 7) * 136, F.bx >> 3, (int)F.G >> 3};
            EpiDown<Y_FP8 != 0> E{WSP(void, WS_Y), AP->in[16] + (size_t)l * NE * D, WSP(float, WS_SLOTGATE), ((MOE_FP8_MASK >> l) & 1) ? F8_EPI_SC : 1.f};
#if MOE_FP8_MASK != 0
            if ((MOE_FP8_MASK >> l) & 1) { pg8::Gemm g{WSP(bf16, WS_ACT), WSP(bf16, WS_WDNT) + (size_t)l * NE * D * DE, NSLOT, NE * D, DE / 2};
                pg8::gemm_phase<EpiDown<Y_FP8 != 0>, XcdOrder<2>, true, true, F8_DIAG ? 1000 : 127 - F8_WSC>(F.lds + RING_OFF, g, S, E); }
#ifdef PROBE_DNNULL
            if ((MOE_FP8_MASK >> l) & 1) { pg8::Gemm g{WSP(bf16, WS_ACT), WSP(bf16, WS_WDNT) + (size_t)l * NE * D * DE, NSLOT, NE * D, DE / 2};
                EpiNull E2{WSP(float, WS_OGB)};
                pg8::gemm_phase<EpiNull, XcdOrder<2>, true, true, 127 - F8_WSC>(F.lds + RING_OFF, g, S, E2); }
#endif
#endif
#if MOE_FP8_MASK != 3
            if (!((MOE_FP8_MASK >> l) & 1)) { pg8::Gemm g{WSP(bf16, WS_ACT), WSP(bf16, WS_WDNT) + (size_t)l * NE * D * DE, NSLOT, NE * D, DE};
                pg8::gemm_phase<EpiDown<Y_FP8 != 0>, XcdOrder<2>, true, true>(F.lds + RING_OFF, g, S, E); }
#endif
            SEAM(pb + 7);
        }
        if (INL(8)) REP(8) { combine_phase(F, WSP(bf16, WS_HM), WSP(void, WS_Y), WSP(int, WS_TOKSLOT), WSP(bf16, WS_H2), ws + WS_H2F8); SEAM(pb + 8); }
        if (INL(9)) REP(9) {
            pg8::StaticOrder S; S.init(T, D, F.G, F.bx);
            EpiPle E{WSP(bf16, WS_H2), WSP(bf16, WS_PP) + (size_t)l * T * D, WSP(bf16, WS_H3), WSP(float, WS_SSP) + (size_t)(l + 1) * T * 16};
            if (PLE_FP8) { pg8::Gemm g{WSP(bf16, WS_H2F8), WSP(bf16, WS_WGT) + (size_t)l * D * D, T, D, D / 2};
                pg8::gemm_phase<EpiPle, pg8::StaticOrder, true, true, 127 - F8_WSC>(F.lds + RING_OFF, g, S, E); }
            else { pg8::Gemm g{WSP(bf16, WS_H2), WSP(bf16, WS_WGT) + (size_t)l * D * D, T, D, D};
                pg8::gemm_phase<EpiPle, pg8::StaticOrder, true, true>(F.lds + RING_OFF, g, S, E); }
            SEAM(pb + 9);
        }
    }
    if (((MK_MASK >> 13) & 1) && IN(21) && refresh(F)) final_norm_phase(F, WSP(bf16, WS_H3), WSP(float, WS_SSP) + (size_t)2 * T * 16, AP->in[19], AP->out);
#undef IN
#undef INL
#undef REP
#undef SEAM
#undef ws
#undef WSP
}

#ifndef MK_ONE_LAUNCH
#define MK_ONE_LAUNCH 1
#endif
extern "C" void kernel_launch(void* const* d_in, const int* in_sizes, int n_in, void* d_out, int out_size, void* d_ws, size_t ws_size, hipStream_t stream) {
    static int grid = 0;
    if (grid == 0) {
        if (n_in != 20 || in_sizes[0] != T * D || out_size != T * D || ws_size < WS_END) { fprintf(stderr, "kernel_launch: unexpected shapes: n_in %d in0 %d out %d ws %zu (need %zu)\n", n_in, n_in > 0 ? in_sizes[0] : -1, out_size, ws_size, (size_t)WS_END); grid = -1; return; }
        int dev = 0, cus = 0, per_cu = 0;
        if (hipGetDevice(&dev) != hipSuccess || hipDeviceGetAttribute(&cus, hipDeviceAttributeMultiprocessorCount, dev) != hipSuccess) { grid = -1; return; }
        if (hipFuncSetAttribute((const void*)fwd_kernel, hipFuncAttributeMaxDynamicSharedMemorySize, LDS_BYTES) != hipSuccess) { fprintf(stderr, "kernel_launch: hipFuncSetAttribute failed\n"); grid = -1; return; }
        if (hipOccupancyMaxActiveBlocksPerMultiprocessor(&per_cu, (const void*)fwd_kernel, NWAVES * 64, LDS_BYTES) != hipSuccess || per_cu < 1) fprintf(stderr, "kernel_launch: occupancy query says %d\n", per_cu);
        (void)hipGetLastError();
        grid = cus;
        if (grid != 256) fprintf(stderr, "kernel_launch: %d CUs (built for 256)\n", grid);
    }
    if (grid < 0) return;
    if (hipMemsetAsync((char*)d_ws + WS_CTL, 0, CTL_ZERO_BYTES, stream) != hipSuccess) return;
    Args a{};
    for (int i = 0; i < 20; ++i) a.in[i] = (const float*)d_in[i];
    a.out = (float*)d_out; a.ws = (unsigned char*)d_ws;
#if MK_ONE_LAUNCH
    a.ph_lo = 0; a.ph_hi = N_PHASES; a.li = 0;
    hipLaunchKernelGGL(fwd_kernel, dim3(grid), dim3(NWAVES * 64), LDS_BYTES, stream, a);
#else
    for (int ph = 0; ph < N_PHASES; ++ph) {
        if (ph == 3) continue;
        a.ph_lo = ph; a.ph_hi = ph + 1; a.li = ph;
        hipLaunchKernelGGL(fwd_kernel, dim3(grid), dim3(NWAVES * 64), LDS_BYTES, stream, a);
    }
#endif
}
```

```cpp
#include <hip/hip_runtime.h>
#include <hip/hip_bf16.h>
#include <cstdio>
#include <cstdint>
#include <cmath>
namespace pg8 {
#define PG8_LAS __attribute__((address_space(3)))
typedef unsigned short bf16_t;
typedef short bf16x8 __attribute__((ext_vector_type(8)));
typedef float f32x4 __attribute__((ext_vector_type(4)));
typedef unsigned u32x4 __attribute__((ext_vector_type(4)));
typedef int pg8_v4i __attribute__((ext_vector_type(4)));
typedef long pg8_v2l __attribute__((ext_vector_type(2)));
constexpr int BM = 256, BK = 64, HALF = 128, HTB = HALF * BK * 2  , STAGE_BYTES = 8 * HTB, NXCD = 8, WGM = 8;

__host__ __device__ __forceinline__ int lds_byte(int r, int c) { const int st = (r >> 4) * 2 + (c >> 5), rr = r & 15, cc = c & 31, ob = rr * 64 + cc * 2; return st * 1024 + (ob ^ (((ob >> 9) & 1) << 5)); }
__host__ __device__ __forceinline__ void stage_rc(int b, int& R, int& C) { const int st = b / 1024, sb = b % 1024, swz = sb ^ (((sb >> 9) & 1) << 5); R = (st >> 1) * 16 + swz / 64; C = (st & 1) * 32 + (swz % 64) / 2; }
__host__ __device__ __forceinline__ int perm32(int rho) { const int n = rho >> 4, i = rho & 15; return 8 * (i >> 2) + 4 * n + (i & 3); }

struct Unit { int pm, pn; };
struct Gemm { const bf16_t* A; const bf16_t* Bt; int M, N, K; };

struct StaticOrder {
    int nM, nN, nwg, G, c;
    __host__ __device__ void init(int M, int N, int G_, int c_) { nM = M / BM; nN = N / BM; nwg = nM * nN; G = G_; c = c_; }
    __host__ __device__ bool next(int i, Unit& u) const {
        const long L = (long)i * G + c; if (L >= nwg) return false;
        int wgid = (int)L; { const int q = nwg / NXCD, r = nwg % NXCD, xcd = wgid % NXCD, off = wgid / NXCD; wgid = (xcd < r ? xcd * (q + 1) : r * (q + 1) + (xcd - r) * q) + off; }
        const int nig = WGM * nN, gid = wgid / nig, fm = gid * WGM, gsz = (nM - fm) < WGM ? (nM - fm) : WGM;
        u.pm = fm + ((wgid % nig) % gsz); u.pn = (wgid % nig) / gsz; return true;
    }
    __device__ __forceinline__ void a_ready(const Unit&) const {}
    __device__ __forceinline__ void done(const Unit&) const {}
};

__device__ __forceinline__ unsigned cvt_pk_bf16(float lo, float hi) { unsigned r; asm volatile("v_cvt_pk_bf16_f32 %0, %1, %2" : "=v"(r) : "v"(lo), "v"(hi)); return r; }
typedef float f32x2 __attribute__((ext_vector_type(2)));
__device__ __forceinline__ f32x2 gelu_pk(f32x2 v) {
    const f32x2 av = __builtin_elementwise_abs(v), d = av * 0.2316418882f + 1.0f;
    f32x2 t; t.x = __builtin_amdgcn_rcpf(d.x); t.y = __builtin_amdgcn_rcpf(d.y);
    f32x2 q = t * 0.5307027145f + (-0.7265760135f); q = q * t + 0.7107068705f; q = q * t + (-0.142248368f); q = q * t + 0.127414796f; q = q * t;
    const f32x2 s = (v * v) * (-0.72134752044f);
    f32x2 e; e.x = __builtin_amdgcn_exp2f(s.x); e.y = __builtin_amdgcn_exp2f(s.y);
    const f32x2 m = v * (q * e), r = v - m;
    f32x2 o; o.x = v.x < 0.f ? m.x : r.x; o.y = v.y < 0.f ? m.y : r.y; return o;
}

template <int ACT  > struct EpiBf16 {
    static constexpr bool PERM = true, AFTER_DRAIN = false; static_assert(ACT == 0 || ACT == 1, "EpiBf16: ACT is 0 (none) or 1 (gelu_pk)");
    bf16_t* O; int ldc; const float* bias; int split_cols; size_t split_stride; float scale0;
    __device__ __forceinline__ void operator()(const f32x4 (&acc)[2][2][4][2], const Unit& u, int wr, int wc, int fr, int fq) const {
        const int row0 = u.pm * BM + wr * 64 + fr; int colt = u.pn * BM; bf16_t* base = O;
        float sc = 1.f; if (split_cols) { const int t = colt / split_cols; base += (size_t)t * split_stride; colt -= t * split_cols; if (t == 0) sc = scale0; }
        const int col0 = colt + wc * 32 + 8 * fq, bcol0 = u.pn * BM + wc * 32 + 8 * fq;
        f32x4 bv[2][2];
#pragma unroll
        for (int bj = 0; bj < 2; ++bj)
#pragma unroll
            for (int n = 0; n < 2; ++n) bv[bj][n] = bias ? *(const f32x4*)(bias + bcol0 + bj * HALF + 4 * n) : (f32x4){0.f, 0.f, 0.f, 0.f};
#pragma unroll
        for (int ai = 0; ai < 2; ++ai)
#pragma unroll
            for (int m = 0; m < 4; ++m) { bf16_t* rowp = base + (size_t)(row0 + ai * HALF + m * 16) * ldc + col0;
#pragma unroll
                for (int bj = 0; bj < 2; ++bj) { f32x4 v0 = acc[ai][bj][m][0] + bv[bj][0], v1 = acc[ai][bj][m][1] + bv[bj][1];
                    if (ACT == 1) { f32x2 a = gelu_pk((f32x2){v0[0], v0[1]}), b = gelu_pk((f32x2){v0[2], v0[3]}), c = gelu_pk((f32x2){v1[0], v1[1]}), d = gelu_pk((f32x2){v1[2], v1[3]});
                        v0 = (f32x4){a.x, a.y, b.x, b.y}; v1 = (f32x4){c.x, c.y, d.x, d.y}; }
                    v0 = v0 * sc; v1 = v1 * sc; u32x4 w; w.x = cvt_pk_bf16(v0[0], v0[1]); w.y = cvt_pk_bf16(v0[2], v0[3]); w.z = cvt_pk_bf16(v1[0], v1[1]); w.w = cvt_pk_bf16(v1[2], v1[3]);
                    *(u32x4*)(rowp + bj * HALF) = w; } }
    }
};
template <class Epi, class Sched, bool ALIGN_EPI = false, bool SP2 = false, int FP8SC = -1>
__device__ __forceinline__ void gemm_phase(PG8_LAS unsigned char* lds, const Gemm g, const Sched& S, const Epi& E) {
    int tid_ = threadIdx.x; asm volatile("" : "+v"(tid_));
    const int tid = tid_, wid = __builtin_amdgcn_readfirstlane(tid >> 6), lane = tid & 63, wr = wid >> 2, wc = wid & 3, fr = lane & 15, fq = lane >> 4;
    const int K = g.K, nt = K / BK;
    unsigned voffA[2], voffB[2];
#pragma unroll
    for (int i = 0; i < 2; ++i) { int R, C; stage_rc(tid * 16 + i * 8192, R, C); const int Rb = Epi::PERM ? ((R & ~31) + perm32(R & 31)) : R;
        voffA[i] = (unsigned)(R * K + C) * 2u; voffB[i] = (unsigned)(Rb * K + C) * 2u; }
    const size_t kstep = (size_t)(BK * 2);
    const size_t hstep = (size_t)HALF * K * 2;
    const size_t tstep = 2 * hstep;
    const unsigned ldsw = (unsigned)wid * 1024u;
    const int aoff = lds_byte(wr * 64 + fr, fq * 8), boff = lds_byte(wc * 32 + fr, fq * 8);
#define PG8_SA(b, h) (((b) * 2 + (h)) * HTB)
#define PG8_SB(b, h) ((4 + (b) * 2 + (h)) * HTB)
#define PG8_STAGE(bufoff, gbase, voff) do { _Pragma("unroll") for (int _i = 0; _i < 2; ++_i) \
        __builtin_amdgcn_global_load_lds((const unsigned*)((const char*)(gbase) + (voff)[_i]), (PG8_LAS unsigned*)(lds + (bufoff) + ldsw + _i * 8192), 16, 0, 0); } while (0)
#define PG8_LDA(dst, b, h) do { _Pragma("unroll") for (int m = 0; m < 4; ++m) _Pragma("unroll") for (int k = 0; k < 2; ++k) dst[m][k] = *(const PG8_LAS bf16x8*)(lds + PG8_SA(b, h) + aoff + m * 2048 + k * 1024); } while (0)
#define PG8_LDB(dst, b, h) do { _Pragma("unroll") for (int n = 0; n < 2; ++n) _Pragma("unroll") for (int k = 0; k < 2; ++k) dst[n][k] = *(const PG8_LAS bf16x8*)(lds + PG8_SB(b, h) + boff + n * 2048 + k * 1024); } while (0)
#define PG8_CAT8(x0, x1) __builtin_shufflevector(__builtin_bit_cast(pg8_v4i, x0), __builtin_bit_cast(pg8_v4i, x1), 0, 1, 2, 3, 4, 5, 6, 7)
#define PG8_MMA(ai, bj, At, Bt) do { __builtin_amdgcn_s_setprio(1); \
        if constexpr (FP8SC < 0) { _Pragma("unroll") for (int m = 0; m < 4; ++m) _Pragma("unroll") for (int n = 0; n < 2; ++n) _Pragma("unroll") for (int k = 0; k < 2; ++k) \
            acc[ai][bj][m][n] = __builtin_amdgcn_mfma_f32_16x16x32_bf16(Bt[n][k], At[m][k], acc[ai][bj][m][n], 0, 0, 0); } \
        else if constexpr (FP8SC >= 1000) { _Pragma("unroll") for (int m = 0; m < 4; ++m) _Pragma("unroll") for (int n = 0; n < 2; ++n) _Pragma("unroll") for (int k = 0; k < 2; ++k) { \
            const pg8_v2l bq = __builtin_bit_cast(pg8_v2l, Bt[n][k]), aq = __builtin_bit_cast(pg8_v2l, At[m][k]); \
            acc[ai][bj][m][n] = __builtin_amdgcn_mfma_f32_16x16x32_fp8_fp8(bq[0], aq[0], acc[ai][bj][m][n], 0, 0, 0); acc[ai][bj][m][n] = __builtin_amdgcn_mfma_f32_16x16x32_fp8_fp8(bq[1], aq[1], acc[ai][bj][m][n], 0, 0, 0); } } \
        else { _Pragma("unroll") for (int m = 0; m < 4; ++m) _Pragma("unroll") for (int n = 0; n < 2; ++n) \
            acc[ai][bj][m][n] = __builtin_amdgcn_mfma_scale_f32_16x16x128_f8f6f4(PG8_CAT8(Bt[n][0], Bt[n][1]), PG8_CAT8(At[m][0], At[m][1]), acc[ai][bj][m][n], 0, 0, 0, (FP8SC < 0 ? 127 : FP8SC) * 0x01010101, 0, 0x7f7f7f7f); \
            _Pragma("unroll") for (int m = 0; m < 4; ++m) _Pragma("unroll") for (int n = 0; n < 2; ++n) asm volatile("" : "+v"(acc[ai][bj][m][n])); }     \
        __builtin_amdgcn_s_setprio(0); } while (0)
#define PG8_WAIT_V(n) asm volatile("s_waitcnt vmcnt(" #n ")" ::: "memory")
#define PG8_WAIT_L(n) asm volatile("s_waitcnt lgkmcnt(" #n ")" ::: "memory")
#define PG8_BAR __builtin_amdgcn_s_barrier()
#define PG8_SCHED __builtin_amdgcn_sched_barrier(0)
    Unit cur, nxt; int ui = 0;
    if (!S.next(0, cur)) return;
    f32x4 acc[2][2][4][2];
#pragma unroll
    for (int a = 0; a < 2; ++a)
#pragma unroll
        for (int b = 0; b < 2; ++b)
#pragma unroll
            for (int m = 0; m < 4; ++m)
#pragma unroll
                for (int n = 0; n < 2; ++n) acc[a][b][m][n] = (f32x4){0.f, 0.f, 0.f, 0.f};
    bf16x8 At[4][2], B0[2][2], B1[2][2];
    const char* cA = (const char*)g.A + (size_t)cur.pm * tstep; const char* cB = (const char*)g.Bt + (size_t)cur.pn * tstep;
    S.a_ready(cur);
    if constexpr (SP2) {
        PG8_STAGE(PG8_SB(0, 0), cB, voffB); PG8_STAGE(PG8_SB(0, 1), cB + hstep, voffB); PG8_STAGE(PG8_SA(0, 0), cA, voffA); PG8_STAGE(PG8_SA(0, 1), cA + hstep, voffA);
        if (wr == 1) PG8_BAR;
        PG8_WAIT_V(2); PG8_BAR;
        PG8_STAGE(PG8_SB(1, 0), cB + kstep, voffB); PG8_STAGE(PG8_SA(1, 0), cA + kstep, voffA); PG8_STAGE(PG8_SB(1, 1), cB + hstep + kstep, voffB);
        PG8_WAIT_V(6); PG8_BAR;
    } else {
        PG8_STAGE(PG8_SB(0, 0), cB, voffB); PG8_STAGE(PG8_SA(0, 0), cA, voffA); PG8_STAGE(PG8_SB(0, 1), cB + hstep, voffB); PG8_STAGE(PG8_SA(0, 1), cA + hstep, voffA);
        if (wr == 1) PG8_BAR;
        PG8_WAIT_V(4); PG8_BAR;
        PG8_STAGE(PG8_SB(1, 0), cB + kstep, voffB); PG8_STAGE(PG8_SA(1, 0), cA + kstep, voffA); PG8_STAGE(PG8_SB(1, 1), cB + hstep + kstep, voffB);
        PG8_WAIT_V(6); PG8_BAR;
    }
    for (;;) {
        const bool has_next = S.next(ui + 1, nxt);
        const char* nA = has_next ? (const char*)g.A + (size_t)nxt.pm * tstep : cA; const char* nB = has_next ? (const char*)g.Bt + (size_t)nxt.pn * tstep : cB;
        for (int t = 0; t < nt; t += 2) {
            const bool last = (t == nt - 2);
            const char* a1 = cA + (size_t)(t + 1) * kstep;
            const char* a2 = last ? nA : cA + (size_t)(t + 2) * kstep; const char* b2 = last ? nB : cB + (size_t)(t + 2) * kstep;
            const char* a3 = a2 + kstep; const char* b3 = b2 + kstep;
            if (last && has_next) S.a_ready(nxt);
            if constexpr (SP2) {
            PG8_LDB(B0, 0, 0); PG8_LDB(B1, 0, 1); PG8_SCHED; PG8_LDA(At, 0, 0); PG8_STAGE(PG8_SA(1, 1), a1 + hstep, voffA);
            PG8_WAIT_V(8); PG8_WAIT_L(0); PG8_BAR; PG8_MMA(0, 0, At, B0); PG8_MMA(0, 1, At, B1); PG8_BAR; PG8_SCHED;
            PG8_LDA(At, 0, 1); PG8_STAGE(PG8_SB(0, 0), b2, voffB); PG8_STAGE(PG8_SB(0, 1), b2 + hstep, voffB); PG8_STAGE(PG8_SA(0, 0), a2, voffA);
            PG8_WAIT_V(8); PG8_WAIT_L(0); PG8_BAR; PG8_MMA(1, 0, At, B0); PG8_MMA(1, 1, At, B1); PG8_BAR; PG8_SCHED;
            PG8_LDB(B0, 1, 0); PG8_LDB(B1, 1, 1); PG8_SCHED; PG8_LDA(At, 1, 0); PG8_STAGE(PG8_SA(0, 1), a2 + hstep, voffA);
            PG8_WAIT_V(8); PG8_WAIT_L(0); PG8_BAR; PG8_MMA(0, 0, At, B0); PG8_MMA(0, 1, At, B1); PG8_BAR; PG8_SCHED;
            PG8_LDA(At, 1, 1); PG8_STAGE(PG8_SB(1, 0), b3, voffB); PG8_STAGE(PG8_SB(1, 1), b3 + hstep, voffB); PG8_STAGE(PG8_SA(1, 0), a3, voffA);
            PG8_WAIT_V(8); PG8_WAIT_L(0); PG8_BAR; PG8_MMA(1, 0, At, B0); PG8_MMA(1, 1, At, B1); PG8_BAR; PG8_SCHED;
            } else {
            PG8_LDB(B0, 0, 0); PG8_SCHED; PG8_LDA(At, 0, 0); PG8_STAGE(PG8_SA(1, 1), a1 + hstep, voffA);
            PG8_WAIT_L(8); PG8_BAR; PG8_WAIT_L(0); PG8_MMA(0, 0, At, B0); PG8_BAR; PG8_SCHED;
            PG8_LDB(B1, 0, 1); PG8_STAGE(PG8_SB(0, 0), b2, voffB);
            PG8_BAR; PG8_WAIT_L(0); PG8_MMA(0, 1, At, B1); PG8_BAR;
            PG8_LDA(At, 0, 1); PG8_STAGE(PG8_SA(0, 0), a2, voffA);
            PG8_BAR; PG8_WAIT_L(0); PG8_MMA(1, 0, At, B0); PG8_BAR; PG8_SCHED;
            PG8_STAGE(PG8_SB(0, 1), b2 + hstep, voffB);
            PG8_WAIT_V(6); PG8_BAR; PG8_MMA(1, 1, At, B1); PG8_BAR;
            PG8_LDB(B0, 1, 0); PG8_SCHED; PG8_LDA(At, 1, 0); PG8_STAGE(PG8_SA(0, 1), a2 + hstep, voffA);
            PG8_WAIT_L(8); PG8_BAR; PG8_WAIT_L(0); PG8_MMA(0, 0, At, B0); PG8_BAR; PG8_SCHED;
            PG8_LDB(B1, 1, 1); PG8_STAGE(PG8_SB(1, 0), b3, voffB);
            PG8_BAR; PG8_WAIT_L(0); PG8_MMA(0, 1, At, B1); PG8_BAR;
            PG8_LDA(At, 1, 1); PG8_STAGE(PG8_SA(1, 0), a3, voffA);
            PG8_BAR; PG8_WAIT_L(0); PG8_MMA(1, 0, At, B0); PG8_BAR; PG8_SCHED;
            PG8_STAGE(PG8_SB(1, 1), b3 + hstep, voffB);
            PG8_WAIT_V(6); PG8_BAR; PG8_MMA(1, 1, At, B1); PG8_BAR;
            }
        }
        if constexpr (ALIGN_EPI) { if (wr == 0) PG8_BAR; }
        if constexpr (!Epi::AFTER_DRAIN) { E(acc, cur, wr, wc, fr, fq); S.done(cur); }
        if (!has_next) break;
#pragma unroll
        for (int a = 0; a < 2; ++a)
#pragma unroll
            for (int b = 0; b < 2; ++b)
#pragma unroll
                for (int m = 0; m < 4; ++m)
#pragma unroll
                    for (int n = 0; n < 2; ++n) acc[a][b][m][n] = (f32x4){0.f, 0.f, 0.f, 0.f};
        cur = nxt; cA = nA; cB = nB; ++ui;
        if constexpr (ALIGN_EPI) { if (wr == 1) PG8_BAR; }
    }
    PG8_WAIT_V(0);
    if constexpr (!ALIGN_EPI) { if (wr == 0) PG8_BAR; }
    PG8_BAR;
    if constexpr (Epi::AFTER_DRAIN) { E.fused(acc, cur, wr, wc, fr, fq, lds, wid, lane); S.done(cur); }
#undef PG8_SA
#undef PG8_SB
#undef PG8_STAGE
#undef PG8_LDA
#undef PG8_LDB
#undef PG8_MMA
#undef PG8_CAT8
#undef PG8_WAIT_V
#undef PG8_WAIT_L
#undef PG8_BAR
#undef PG8_SCHED
}
}

constexpr int NWAVES = 8;
constexpr int BATCH = 2, SEQ = 8192, T = BATCH * SEQ, D = 1024;
constexpr int AB_IN = 1536, C_IN = 2304, C_OUT = 512;
constexpr int NE = 32, DE = 1024, PLE = 256;
constexpr int NSLOT = 73728;
constexpr float NORM_EPS = 1e-6f;
constexpr float LOG2_THETA = 13.287712379549449f;
constexpr float ATT_C2 = 0.125f * 1.4426950408889634f;

#define GAS __attribute__((address_space(1)))
#define LAS __attribute__((address_space(3)))
typedef unsigned short bf16;
typedef unsigned v4u __attribute__((ext_vector_type(4)));
typedef unsigned v2u __attribute__((ext_vector_type(2)));
typedef float f32x4 __attribute__((ext_vector_type(4)));
typedef GAS unsigned gu32;
#define RLX_AGENT __ATOMIC_RELAXED, __HIP_MEMORY_SCOPE_AGENT
#define LDS_WAIT() asm volatile("s_waitcnt lgkmcnt(0)" ::: "memory")
#define VM_WAIT() asm volatile("s_waitcnt vmcnt(0)" ::: "memory")

__device__ __forceinline__ int lane_opaque() { unsigned m = ~0u; asm volatile("" : "+s"(m)); return (int)__builtin_amdgcn_mbcnt_hi(m, __builtin_amdgcn_mbcnt_lo(m, 0u)); }
__device__ __forceinline__ int shx(int v, int m) { return __builtin_amdgcn_ds_bpermute((lane_opaque() ^ m) << 2, v); }
__device__ __forceinline__ float shx(float v, int m) { return __builtin_bit_cast(float, __builtin_amdgcn_ds_bpermute((lane_opaque() ^ m) << 2, __builtin_bit_cast(int, v))); }
__device__ __forceinline__ int shup(int v, int o) { const int l = lane_opaque(); const int s = (l - o) < 0 ? l : (l - o); return __builtin_amdgcn_ds_bpermute(s << 2, v); }
__device__ __forceinline__ int shl(int v, int src) { return __builtin_amdgcn_ds_bpermute(src << 2, v); }
typedef float f32x2_ __attribute__((ext_vector_type(2))); typedef __bf16 bf16x2_ __attribute__((ext_vector_type(2)));
__device__ __forceinline__ unsigned pk2(float lo, float hi) { f32x2_ v = {lo, hi}; bf16x2_ b = __builtin_convertvector(v, bf16x2_); return __builtin_bit_cast(unsigned, b); }
__device__ __forceinline__ float bflo(unsigned w) { return __builtin_bit_cast(float, w << 16); }
__device__ __forceinline__ float bfhi(unsigned w) { return __builtin_bit_cast(float, w & 0xffff0000u); }
#ifndef MOE_FP8_MASK
#define MOE_FP8_MASK 3
#endif
#ifndef F8_DIAG
#define F8_DIAG 0
#endif
constexpr float F8_EPI_SC = F8_DIAG ? (1.f / 64.f) : 1.f;
#ifndef Y_FP8
#define Y_FP8 1
#endif
#ifndef PLE_FP8
#define PLE_FP8 0
#endif
constexpr float Y_SC = 32.f;
constexpr int F8_WSC = 6;
__device__ __forceinline__ unsigned pk4_fp8(float a, float b, float c, float d) { int w = 0; w = __builtin_amdgcn_cvt_pk_fp8_f32(a, b, w, false); w = __builtin_amdgcn_cvt_pk_fp8_f32(c, d, w, true); return (unsigned)w; }
__device__ __forceinline__ float clamp448(float x) { return fminf(fmaxf(x, -448.f), 448.f); }
__device__ __forceinline__ float rnd_bf(float x) { return bflo(pk2(x, 0.f)); }
__device__ __forceinline__ float ssp_sum(const float* p) { const f32x4 a = *(const f32x4*)p, b = *(const f32x4*)(p + 4), c = *(const f32x4*)(p + 8), d = *(const f32x4*)(p + 12);
    return (((a.x + a.y) + (a.z + a.w)) + ((b.x + b.y) + (b.z + b.w))) + (((c.x + c.y) + (c.z + c.w)) + ((d.x + d.y) + (d.z + d.w))); }

constexpr size_t MiB = 1u << 20;
constexpr size_t al256(size_t x) { return (x + 255) & ~(size_t)255; }
constexpr size_t WS_CTL = 0, CTL_ZERO_BYTES = 1 * MiB;
constexpr size_t WS_WIN0T = 1 * MiB;
constexpr size_t WS_WOUT0T = WS_WIN0T + (size_t)AB_IN * D * 2;
constexpr size_t WS_WIN1T = WS_WOUT0T + (size_t)D * D * 2;
constexpr size_t WS_WOUT1T = WS_WIN1T + (size_t)C_IN * D * 2;
constexpr size_t WS_WGT = WS_WOUT1T + (size_t)D * C_OUT * 2;
constexpr size_t WS_WPT = WS_WGT + 2 * (size_t)D * D * 2;
constexpr size_t WS_WR = WS_WPT + 2 * (size_t)D * PLE * 2;
constexpr size_t WS_ROPE1 = al256(WS_WR + 2 * (size_t)NE * D * 4);
constexpr size_t WS_ROPEA = WS_ROPE1 + (size_t)SEQ * 32 * 8;
constexpr size_t WS_WUPT = WS_ROPEA + (size_t)SEQ * 32 * 8;
constexpr size_t WS_WDNT = WS_WUPT + 2 * (size_t)NE * 2 * DE * D * 2;
constexpr size_t WS_PBF = WS_WDNT + 2 * (size_t)NE * D * DE * 2;
constexpr size_t WS_PP = WS_PBF + 2 * (size_t)T * PLE * 2;
constexpr size_t WS_X0 = WS_PP + 2 * (size_t)T * D * 2;
constexpr size_t WS_HM = WS_X0 + (size_t)T * D * 2;
constexpr size_t WS_H2 = WS_HM + (size_t)T * D * 2;
constexpr size_t WS_H3 = WS_H2 + (size_t)T * D * 2;
constexpr size_t WS_OCAT = WS_H3 + (size_t)T * D * 2;
constexpr size_t WS_SSP = WS_OCAT + (size_t)T * D * 2;
constexpr size_t WS_LSE = WS_SSP + 3 * (size_t)T * 16 * 4;
constexpr size_t WS_TOPE = WS_LSE + 3 * (size_t)T * 8 * 4;
constexpr size_t WS_TOPG = WS_TOPE + (size_t)T * 16;
constexpr size_t WS_TOPPOS = WS_TOPG + (size_t)T * 16;
constexpr size_t WS_RSTD = WS_TOPPOS + (size_t)T * 16;
constexpr size_t WS_TOKSLOT = WS_RSTD + (size_t)T * 4;
constexpr size_t WS_SLOTGATE = WS_TOKSLOT + (size_t)T * 16;
constexpr size_t WS_SLOTRS = WS_SLOTGATE + (size_t)NSLOT * 4;
constexpr size_t WS_XTAB = al256(WS_SLOTRS + (size_t)NSLOT * 4);
constexpr size_t WS_CNTTAB = al256(WS_XTAB + 8 * 136 * 4);
constexpr size_t WS_XG = al256(WS_CNTTAB + 256 * 32 * 4);
constexpr size_t WS_ACT = WS_XG + (size_t)NSLOT * D * 2;
constexpr size_t WS_Y = WS_ACT + (size_t)NSLOT * D * 2;
constexpr size_t WS_Q3 = WS_Y + (size_t)NSLOT * D * 2;
constexpr size_t WS_K3 = WS_Q3 + 3 * (size_t)T * 512 * 2;
constexpr size_t WS_V3 = WS_K3 + 3 * (size_t)T * 128 * 2;
constexpr size_t WS_OGB = WS_V3 + 3 * (size_t)T * 128 * 2;
constexpr size_t WS_H2F8 = WS_OGB + 3 * (size_t)T * 512 * 2;
constexpr size_t WS_END = WS_H2F8 + (size_t)T * D;
constexpr int CW_TMO = 0;
constexpr int CW_CNT = 64;
constexpr int CW_BAR = 4096;

constexpr int LDSCTL_OFF = 0, MISC_OFF = 64;
constexpr int RING_OFF = 512, RING_BYTES = 131072;
constexpr int LDS_BYTES = 147456;

struct PPOrder {
    int G, c;
    __device__ __forceinline__ bool next(int i, pg8::Unit& u) const {
        int L; if (G == 256) { if (c < 128 || i >= 4) return false; L = (c - 128) * 4 + i; } else { L = i * G + c; if (L >= 512) return false; }
        u.pm = L >> 2; u.pn = 4 * (u.pm >> 6) + (L & 3); return true; }
    __device__ __forceinline__ void a_ready(const pg8::Unit&) const {}
    __device__ __forceinline__ void done(const pg8::Unit&) const {}
};
struct EpiPP {
    static constexpr bool PERM = true, AFTER_DRAIN = false;
    bf16* O;
    __device__ __forceinline__ void operator()(const pg8::f32x4 (&acc)[2][2][4][2], const pg8::Unit& u, int wr, int wc, int fr, int fq) const {
        const int row0 = u.pm * 256 + wr * 64 + fr, col0 = (u.pn & 3) * 256 + wc * 32 + 8 * fq;
#pragma unroll
        for (int ai = 0; ai < 2; ++ai)
#pragma unroll
            for (int m = 0; m < 4; ++m) { bf16* rp = O + (size_t)(row0 + ai * 128 + m * 16) * D + col0;
#pragma unroll
                for (int bj = 0; bj < 2; ++bj) { const pg8::f32x4 v0 = acc[ai][bj][m][0], v1 = acc[ai][bj][m][1];
                    pg8::u32x4 w; w.x = pk2(v0[0], v0[1]); w.y = pk2(v0[2], v0[3]); w.z = pk2(v1[0], v1[1]); w.w = pk2(v1[2], v1[3]);
                    *(pg8::u32x4*)(rp + bj * 128) = w; } }
    }
};
template <int LAYER> struct EpiQKV {
    static constexpr bool PERM = true, AFTER_DRAIN = false;
    const float* SS; const float* qg; const float* kg; const float* rope1; const float* ropea; bf16* Q3; bf16* K3; bf16* V3;
    __device__ __forceinline__ void operator()(const pg8::f32x4 (&acc)[2][2][4][2], const pg8::Unit& u, int wr, int wc, int fr, int fq) const {
        int kind, hd, grp;
        bool axial;
        if (LAYER == 0) { const int t3 = u.pn % 3; grp = u.pn / 3; axial = (grp == 0);
            if (t3 < 2) { kind = 0; hd = 4 * t3 + wc; } else if (wc < 2) { kind = 1; hd = wc; } else { kind = 2; hd = wc - 2; } }
        else { const int t3 = u.pn % 3; grp = u.pn / 3; axial = false;
            if (t3 < 2) { kind = 0; hd = 4 * t3 + wc; } else if (wc < 2) { kind = 1; hd = wc; } else { kind = 2; hd = wc - 2; } }
        const bool norm = axial && kind < 2, rope = kind < 2;
        float ga[8], gb[8];
        if (norm) { const float* g = (kind == 0) ? qg : kg;
#pragma unroll
            for (int t = 0; t < 8; ++t) { const int j = 8 * fq + t; const int d0 = (j < 16) ? j : j + 16; ga[t] = g[d0]; gb[t] = g[d0 + 16]; } }
        else {
#pragma unroll
            for (int t = 0; t < 8; ++t) { ga[t] = 1.f; gb[t] = 1.f; } }
        const float qs = (kind == 0) ? ATT_C2 : 1.f;
        const float* rtab = axial ? ropea : rope1;
        bf16* dst; int pitch;
        if (kind == 0) { dst = Q3 + (size_t)grp * T * 512 + hd * 64; pitch = 512; } else if (kind == 1) { dst = K3 + (size_t)grp * T * 128 + hd * 64; pitch = 128; } else { dst = V3 + (size_t)grp * T * 128 + hd * 64; pitch = 128; }
        const int row0 = u.pm * 256 + wr * 64 + fr;
#pragma unroll
        for (int ai = 0; ai < 2; ++ai)
#pragma unroll
            for (int m = 0; m < 4; ++m) {
                const int r = row0 + ai * 128 + m * 16; const int pos = r & (SEQ - 1);
                const float rs = __builtin_amdgcn_rsqf(ssp_sum(SS + (size_t)r * 16) * (1.f / D) + NORM_EPS);
                float a[8], b[8];
#pragma unroll
                for (int n = 0; n < 2; ++n)
#pragma unroll
                    for (int i = 0; i < 4; ++i) { a[4 * n + i] = acc[ai][0][m][n][i] * rs; b[4 * n + i] = acc[ai][1][m][n][i] * rs; }
                if (norm) { float ss = 0.f;
#pragma unroll
                    for (int t = 0; t < 8; ++t) ss += a[t] * a[t] + b[t] * b[t];
                    ss += shx(ss, 16); ss += shx(ss, 32);
                    const float rh = __builtin_amdgcn_rsqf(ss * (1.f / 64.f) + NORM_EPS);
#pragma unroll
                    for (int t = 0; t < 8; ++t) { a[t] *= rh * ga[t]; b[t] *= rh * gb[t]; } }
                if (rope) { const f32x4* cs = (const f32x4*)(rtab + ((size_t)pos * 32 + 8 * fq) * 2);
#pragma unroll
                    for (int t2 = 0; t2 < 4; ++t2) { const f32x4 v = cs[t2];
                        { const float x1 = a[2 * t2], x2 = b[2 * t2]; a[2 * t2] = x1 * v.x - x2 * v.y; b[2 * t2] = x2 * v.x + x1 * v.y; }
                        { const float x1 = a[2 * t2 + 1], x2 = b[2 * t2 + 1]; a[2 * t2 + 1] = x1 * v.z - x2 * v.w; b[2 * t2 + 1] = x2 * v.z + x1 * v.w; } } }
                size_t drow = r;
                if (LAYER == 1) { const int sh = 2 * grp, bb = r >> 13; drow = (size_t)bb * SEQ + (size_t)(pos & ((1 << sh) - 1)) * (SEQ >> sh) + (pos >> sh); }
                bf16* dp = dst + drow * pitch + 8 * fq;
                pg8::u32x4 w0, w1;
                w0.x = pk2(a[0] * qs, a[1] * qs); w0.y = pk2(a[2] * qs, a[3] * qs); w0.z = pk2(a[4] * qs, a[5] * qs); w0.w = pk2(a[6] * qs, a[7] * qs);
                w1.x = pk2(b[0] * qs, b[1] * qs); w1.y = pk2(b[2] * qs, b[3] * qs); w1.z = pk2(b[4] * qs, b[5] * qs); w1.w = pk2(b[6] * qs, b[7] * qs);
                *(pg8::u32x4*)dp = w0; *(pg8::u32x4*)(dp + 32) = w1;
                asm volatile("" ::: "memory");
            }
    }
};
struct EpiResBf16 {
    static constexpr bool PERM = true, AFTER_DRAIN = false;
    const bf16* R; bf16* O;
    __device__ __forceinline__ void operator()(const pg8::f32x4 (&acc)[2][2][4][2], const pg8::Unit& u, int wr, int wc, int fr, int fq) const {
        const int row0 = u.pm * 256 + wr * 64 + fr, col0 = u.pn * 256 + wc * 32 + 8 * fq;
#pragma unroll
        for (int ai = 0; ai < 2; ++ai)
#pragma unroll
            for (int m = 0; m < 4; ++m) { const size_t ro = (size_t)(row0 + ai * 128 + m * 16) * D + col0;
#pragma unroll
                for (int bj = 0; bj < 2; ++bj) { const pg8::f32x4 v0 = acc[ai][bj][m][0], v1 = acc[ai][bj][m][1]; const v4u rr = *(const v4u*)(R + ro + bj * 128);
                    pg8::u32x4 w; w.x = pk2(v0[0] + bflo(rr.x), v0[1] + bfhi(rr.x)); w.y = pk2(v0[2] + bflo(rr.y), v0[3] + bfhi(rr.y)); w.z = pk2(v1[0] + bflo(rr.z), v1[1] + bfhi(rr.z)); w.w = pk2(v1[2] + bflo(rr.w), v1[3] + bfhi(rr.w));
                    *(pg8::u32x4*)(O + ro + bj * 128) = w; }
                asm volatile("" ::: "memory"); }
    }
};
__device__ __forceinline__ float sigmoidf_(float x) { return __builtin_amdgcn_rcpf(1.0f + __builtin_amdgcn_exp2f(-1.4426950408889634f * x)); }
__device__ __forceinline__ float swiglu1(float g, float l) {
    g = fminf(g, 7.0f); l = fminf(fmaxf(l, -7.0f), 7.0f);
    return g * sigmoidf_(1.702f * g) * (l + 1.0f);
}
__device__ __forceinline__ f32x2_ swiglu2(f32x2_ g, f32x2_ l) {
    g = __builtin_elementwise_min(g, (f32x2_){7.0f, 7.0f}); l = __builtin_elementwise_min(__builtin_elementwise_max(l, (f32x2_){-7.0f, -7.0f}), (f32x2_){7.0f, 7.0f});
    const f32x2_ t = g * (-1.702f * 1.4426950408889634f); f32x2_ e; e.x = __builtin_amdgcn_exp2f(t.x); e.y = __builtin_amdgcn_exp2f(t.y);
    const f32x2_ d = e + 1.0f; f32x2_ s; s.x = __builtin_amdgcn_rcpf(d.x); s.y = __builtin_amdgcn_rcpf(d.y);
    return (g * s) * (l + 1.0f);
}
template <bool F8> struct EpiSwiglu {
    static constexpr bool PERM = true, AFTER_DRAIN = false;
    void* ACT; const float* bup; const float* rsl;
    __device__ __forceinline__ void operator()(const pg8::f32x4 (&acc)[2][2][4][2], const pg8::Unit& u, int wr, int wc, int fr, int fq) const {
        const int e = u.pn >> 3, j = u.pn & 7; const int row0 = u.pm * 256 + wr * 64 + fr, a0 = j * 128 + wc * 32 + 8 * fq;
        const float* bp = bup + (size_t)e * 2048 + 2 * a0; pg8::f32x4 b[4];
#pragma unroll
        for (int i = 0; i < 4; ++i) b[i] = *(const pg8::f32x4*)(bp + 4 * i);
#pragma unroll
        for (int ai = 0; ai < 2; ++ai)
#pragma unroll
            for (int m = 0; m < 4; ++m) { const int r = row0 + ai * 128 + m * 16; const float rs = F8 ? F8_EPI_SC : rsl[r];
                const pg8::f32x4 g0 = acc[ai][0][m][0] * rs, g1 = acc[ai][0][m][1] * rs, l0 = acc[ai][1][m][0] * rs, l1 = acc[ai][1][m][1] * rs;
                float o[8];
                { const f32x2_ r0 = swiglu2((f32x2_){g0[0] + b[0][0], g0[1] + b[0][2]}, (f32x2_){l0[0] + b[0][1], l0[1] + b[0][3]}), r1 = swiglu2((f32x2_){g0[2] + b[1][0], g0[3] + b[1][2]}, (f32x2_){l0[2] + b[1][1], l0[3] + b[1][3]});
                  const f32x2_ r2 = swiglu2((f32x2_){g1[0] + b[2][0], g1[1] + b[2][2]}, (f32x2_){l1[0] + b[2][1], l1[1] + b[2][3]}), r3 = swiglu2((f32x2_){g1[2] + b[3][0], g1[3] + b[3][2]}, (f32x2_){l1[2] + b[3][1], l1[3] + b[3][3]});
                  o[0] = r0.x; o[1] = r0.y; o[2] = r1.x; o[3] = r1.y; o[4] = r2.x; o[5] = r2.y; o[6] = r3.x; o[7] = r3.y; }
                if (F8) { v2u w; w.x = pk4_fp8(o[0], o[1], o[2], o[3]); w.y = pk4_fp8(o[4], o[5], o[6], o[7]); *(v2u*)((unsigned char*)ACT + (size_t)r * DE + a0) = w; }
                else { pg8::u32x4 w; w.x = pk2(o[0], o[1]); w.y = pk2(o[2], o[3]); w.z = pk2(o[4], o[5]); w.w = pk2(o[6], o[7]); *(pg8::u32x4*)((bf16*)ACT + (size_t)r * DE + a0) = w; } }
    }
};
struct EpiNull {
    static constexpr bool PERM = true, AFTER_DRAIN = false;
    float* O;
    __device__ __forceinline__ void operator()(const pg8::f32x4 (&acc)[2][2][4][2], const pg8::Unit& u, int wr, int wc, int fr, int fq) const {
        pg8::f32x4 s = {0.f, 0.f, 0.f, 0.f};
#pragma unroll
        for (int ai = 0; ai < 2; ++ai)
#pragma unroll
            for (int bj = 0; bj < 2; ++bj)
#pragma unroll
                for (int m = 0; m < 4; ++m)
#pragma unroll
                    for (int n = 0; n < 2; ++n) s += acc[ai][bj][m][n];
        *(pg8::f32x4*)(O + (size_t)(threadIdx.x + 512 * (u.pm & 63)) * 4) = s;
    }
};
template <bool Y8> struct EpiDown {
    static constexpr bool PERM = true, AFTER_DRAIN = false;
    void* Y; const float* bdn; const float* gate; float asc;
    __device__ __forceinline__ void operator()(const pg8::f32x4 (&acc)[2][2][4][2], const pg8::Unit& u, int wr, int wc, int fr, int fq) const {
        const int e = u.pn >> 2, j = u.pn & 3; const int row0 = u.pm * 256 + wr * 64 + fr, col0 = j * 256 + wc * 32 + 8 * fq;
        pg8::f32x4 bv[2][2];
#pragma unroll
        for (int bj = 0; bj < 2; ++bj)
#pragma unroll
            for (int n = 0; n < 2; ++n) bv[bj][n] = *(const pg8::f32x4*)(bdn + (size_t)e * D + col0 + bj * 128 + 4 * n);
#pragma unroll
        for (int ai = 0; ai < 2; ++ai)
#pragma unroll
            for (int m = 0; m < 4; ++m) { const int r = row0 + ai * 128 + m * 16; const float gt = gate[r] * (Y8 ? Y_SC : 1.f);
#pragma unroll
                for (int bj = 0; bj < 2; ++bj) { const pg8::f32x4 v0 = (acc[ai][bj][m][0] * asc + bv[bj][0]) * gt, v1 = (acc[ai][bj][m][1] * asc + bv[bj][1]) * gt;
                    if (Y8) { v2u w; w.x = pk4_fp8(clamp448(v0[0]), clamp448(v0[1]), clamp448(v0[2]), clamp448(v0[3])); w.y = pk4_fp8(clamp448(v1[0]), clamp448(v1[1]), clamp448(v1[2]), clamp448(v1[3])); *(v2u*)((unsigned char*)Y + (size_t)r * D + col0 + bj * 128) = w; }
                    else { pg8::u32x4 w; w.x = pk2(v0[0], v0[1]); w.y = pk2(v0[2], v0[3]); w.z = pk2(v1[0], v1[1]); w.w = pk2(v1[2], v1[3]); *(pg8::u32x4*)((bf16*)Y + (size_t)r * D + col0 + bj * 128) = w; } } }
    }
};
struct EpiPle {
    static constexpr bool PERM = true, AFTER_DRAIN = false;
    const bf16* H2; const bf16* PP; bf16* H3; float* SS;
    __device__ __forceinline__ void operator()(const pg8::f32x4 (&acc)[2][2][4][2], const pg8::Unit& u, int wr, int wc, int fr, int fq) const {
        const int row0 = u.pm * 256 + wr * 64 + fr, col0 = u.pn * 256 + wc * 32 + 8 * fq;
#pragma unroll
        for (int ai = 0; ai < 2; ++ai)
#pragma unroll
            for (int m = 0; m < 4; ++m) { const int r = row0 + ai * 128 + m * 16; const size_t ro = (size_t)r * D + col0; float ss = 0.f;
#pragma unroll
                for (int bj = 0; bj < 2; ++bj) { const pg8::f32x4 a0 = acc[ai][bj][m][0], a1 = acc[ai][bj][m][1]; const v4u h = *(const v4u*)(H2 + ro + bj * 128), p = *(const v4u*)(PP + ro + bj * 128);
                    pg8::u32x4 w;
                    w.x = pk2(bflo(h.x) + bflo(p.x) * sigmoidf_(a0[0]), bfhi(h.x) + bfhi(p.x) * sigmoidf_(a0[1])); w.y = pk2(bflo(h.y) + bflo(p.y) * sigmoidf_(a0[2]), bfhi(h.y) + bfhi(p.y) * sigmoidf_(a0[3]));
                    w.z = pk2(bflo(h.z) + bflo(p.z) * sigmoidf_(a1[0]), bfhi(h.z) + bfhi(p.z) * sigmoidf_(a1[1])); w.w = pk2(bflo(h.w) + bflo(p.w) * sigmoidf_(a1[2]), bfhi(h.w) + bfhi(p.w) * sigmoidf_(a1[3]));
                    *(pg8::u32x4*)(H3 + ro + bj * 128) = w;
                    ss += (bflo(w.x) * bflo(w.x) + bfhi(w.x) * bfhi(w.x)) + (bflo(w.y) * bflo(w.y) + bfhi(w.y) * bfhi(w.y)) + (bflo(w.z) * bflo(w.z) + bfhi(w.z) * bfhi(w.z)) + (bflo(w.w) * bflo(w.w) + bfhi(w.w) * bfhi(w.w)); }
                ss += shx(ss, 16); ss += shx(ss, 32);
                if (fq == 0) SS[(size_t)r * 16 + u.pn * 4 + wc] = ss;
                asm volatile("" ::: "memory"); }
    }
};
template <int LJ> struct XcdOrder {
    const int* tab; int rank, stride;
    __device__ __forceinline__ bool next(int i, pg8::Unit& u) const {
        const int q = i * stride + rank, p = q >> LJ, j = q & ((1 << LJ) - 1); const int ne = tab[0], tot = tab[1]; if (p >= tot) return false;
        int s = 0; while (s + 1 < ne && tab[4 + 4 * (s + 1) + 3] <= p) ++s;
        u.pm = tab[4 + 4 * s + 1] + (p - tab[4 + 4 * s + 3]); u.pn = (tab[4 + 4 * s] << LJ) + j; return true; }
    __device__ __forceinline__ void a_ready(const pg8::Unit&) const {}
    __device__ __forceinline__ void done(const pg8::Unit&) const {}
};
#include <hip/hip_bf16.h>
#include <cmath>
namespace attn_body {
using bf16=__hip_bfloat16;
using bf16x8=__attribute__((ext_vector_type(8)))short;
using s16x4=__attribute__((ext_vector_type(4)))short;
using f32x16=__attribute__((ext_vector_type(16)))float;
using u32x4=__attribute__((ext_vector_type(4)))unsigned;
constexpr int D=64,QP=512,KVP=128;
constexpr int NW=8,QBLK=32,QB=QBLK*NW,KVBLK=64;
constexpr int ATTN_UNIT_ROWS=QB;
__device__ __forceinline__ int crow(int r,int hi){return (r&3)+8*(r>>2)+4*hi;}
#define SBAR() __builtin_amdgcn_sched_barrier(0)
__device__ __forceinline__ void cmask(f32x16&p0,f32x16&p1,int jb,int qrel,int hi){
  const float NEG=-INFINITY; int kb=64*jb+4*hi;
  #pragma unroll
  for(int r=0;r<16;++r){int kv=kb+(r&3)+8*(r>>2); if(kv>qrel)p0[r]=NEG; if(kv+32>qrel)p1[r]=NEG;}
}

__device__ __forceinline__ void bmask(f32x16&p0,f32x16&p1,int t,int dqb,int W){
  const float NEG=-INFINITY; const int kb=64*t+dqb;
  #pragma unroll
  for(int r=0;r<16;++r){const int d=kb+(r&3)+8*(r>>2); if(d>W||d<-W)p0[r]=NEG; if(d+32>W||d+32<-W)p1[r]=NEG;}
}
constexpr int NSLOT=3, SLOTB=8192;
constexpr int LDS_K=0, LDS_V=NSLOT*SLOTB, LDS_WS=2*NSLOT*SLOTB, LDS_OST=LDS_WS+NW*64*4, LDS_BYTES=LDS_OST+NW*4096;
constexpr float C2=0.125f*1.4426950408889634f;
__device__ __forceinline__ void glds16(const void*gsrc,unsigned lds_dst){unsigned keep;
  asm volatile("s_mov_b32 %0, m0\n\ts_mov_b32 m0, %2\n\ts_nop 0\n\tglobal_load_lds_dwordx4 %1, off\n\ts_mov_b32 m0, %0":"=&s"(keep):"v"(gsrc),"s"(lds_dst):"memory");}
__device__ __forceinline__ float max3f(float a,float b,float c){float r;asm("v_max3_f32 %0, %1, %2, %3":"=v"(r):"v"(a),"v"(b),"v"(c));return r;}
__device__ __forceinline__ float max2f(float a,float b){float r;asm("v_max_f32_e32 %0, %1, %2":"=v"(r):"v"(a),"v"(b));return r;}
__device__ __forceinline__ float fadd_s(float a,float b){float r;asm("v_add_f32_e32 %0, %1, %2":"=v"(r):"v"(a),"v"(b));return r;}
__device__ __forceinline__ float fsub_s(float a,float b){float r;asm("v_sub_f32_e32 %0, %1, %2":"=v"(r):"v"(a),"v"(b));return r;}
typedef float f32x2_t __attribute__((ext_vector_type(2))); typedef __bf16 bf16x2_t __attribute__((ext_vector_type(2)));
__device__ __forceinline__ unsigned cvtpk_s(float lo,float hi){f32x2_t v={lo,hi};bf16x2_t b=__builtin_convertvector(v,bf16x2_t);return __builtin_bit_cast(unsigned,b);}
#define WAIT_BAR(N) asm volatile("s_waitcnt vmcnt(" #N ") lgkmcnt(0)\n\ts_barrier":::"memory")

__device__ __forceinline__ void qkt(f32x16&p0,f32x16&p1,const char*Kslot,const bf16x8*qr,const f32x16&negm,int r32,int hi){
  const char*kb=Kslot+hi*1024+r32*16;
  #pragma unroll
  for(int d0=0;d0<4;++d0){
    const bf16x8 b0=*reinterpret_cast<const bf16x8*>(kb+d0*2048);
    const bf16x8 b1=*reinterpret_cast<const bf16x8*>(kb+d0*2048+512);
    if(d0==0){p0=__builtin_amdgcn_mfma_f32_32x32x16_bf16(b0,qr[0],negm,0,0,0);p1=__builtin_amdgcn_mfma_f32_32x32x16_bf16(b1,qr[0],negm,0,0,0);}
    else{p0=__builtin_amdgcn_mfma_f32_32x32x16_bf16(b0,qr[d0],p0,0,0,0);p1=__builtin_amdgcn_mfma_f32_32x32x16_bf16(b1,qr[d0],p1,0,0,0);}}
}
typedef __attribute__((address_space(3))) const char* lds_cptr;
typedef short v4i16_t __attribute__((ext_vector_type(4)));
__device__ __forceinline__ void kload8(bf16x8*kf,lds_cptr kp){
  kf[0]=*(const __attribute__((address_space(3))) bf16x8*)(kp);      kf[1]=*(const __attribute__((address_space(3))) bf16x8*)(kp+512);
  kf[2]=*(const __attribute__((address_space(3))) bf16x8*)(kp+2048); kf[3]=*(const __attribute__((address_space(3))) bf16x8*)(kp+2560);
  kf[4]=*(const __attribute__((address_space(3))) bf16x8*)(kp+4096); kf[5]=*(const __attribute__((address_space(3))) bf16x8*)(kp+4608);
  kf[6]=*(const __attribute__((address_space(3))) bf16x8*)(kp+6144); kf[7]=*(const __attribute__((address_space(3))) bf16x8*)(kp+6656);
}
__device__ __forceinline__ void kload2(bf16x8*kf,lds_cptr kp,int j){ kf[2*j]=*(const __attribute__((address_space(3))) bf16x8*)(kp+j*2048); kf[2*j+1]=*(const __attribute__((address_space(3))) bf16x8*)(kp+j*2048+512); }
__device__ __forceinline__ s16x4 vtr(lds_cptr p){ return __builtin_bit_cast(s16x4,__builtin_amdgcn_ds_read_tr16_b64_v4i16((__attribute__((address_space(3))) v4i16_t*)p)); }
__device__ __forceinline__ float rowmax(const f32x16&p0,const f32x16&p1){
  float a=max3f(p0[0],p0[1],p1[0]),b=max3f(p0[2],p0[3],p1[1]);a=max3f(a,p1[2],p1[3]);
  #pragma unroll
  for(int r=4;r<16;r+=4){a=max3f(a,p0[r],p0[r+1]);b=max3f(b,p0[r+2],p0[r+3]);a=max3f(a,p1[r],p1[r+1]);b=max3f(b,p1[r+2],p1[r+3]);}
  const float m=max2f(a,b);
  auto rr=__builtin_amdgcn_permlane32_swap(__float_as_uint(m),__float_as_uint(m),false,false);
  return max2f(__uint_as_float(rr[0]),__uint_as_float(rr[1]));
}
__device__ __forceinline__ void pv(f32x16*o,int vb,bf16x8 pa0,bf16x8 pa1,bf16x8 pa2,bf16x8 pa3){
  #pragma unroll
  for(int d0=0;d0<2;++d0){s16x4 lo[4],hi[4];
    #pragma unroll
    for(int ks=0;ks<4;++ks){
      asm volatile("ds_read_b64_tr_b16 %0,%1 offset:%c2":"=&v"(lo[ks]):"v"(vb),"i"(d0*4096+ks*1024):"memory");
      asm volatile("ds_read_b64_tr_b16 %0,%1 offset:%c2":"=&v"(hi[ks]):"v"(vb),"i"(d0*4096+ks*1024+512):"memory");}
    asm volatile("s_waitcnt lgkmcnt(0)":::"memory");SBAR();
    #define PK(k) (bf16x8){lo[k][0],lo[k][1],lo[k][2],lo[k][3],hi[k][0],hi[k][1],hi[k][2],hi[k][3]}
    o[d0]=__builtin_amdgcn_mfma_f32_32x32x16_bf16(pa0,PK(0),o[d0],0,0,0);
    o[d0]=__builtin_amdgcn_mfma_f32_32x32x16_bf16(pa1,PK(1),o[d0],0,0,0);
    o[d0]=__builtin_amdgcn_mfma_f32_32x32x16_bf16(pa2,PK(2),o[d0],0,0,0);
    o[d0]=__builtin_amdgcn_mfma_f32_32x32x16_bf16(pa3,PK(3),o[d0],0,0,0);
    #undef PK
  }
}

#ifndef ATTN_STORE16
#define ATTN_STORE16(p,v) (*(u32x4*)(p)=(v))
#endif
template<int MODE,int OP,int THRL> __device__ __forceinline__ void attn_unit(const bf16*Qu,const bf16*__restrict__ Ku,const bf16*__restrict__ Vu,bf16*Ou,int NT,int dq0,int W,float sinkl2,bool has_sink,float*lse,char*shm){
  int tid_=threadIdx.x; asm volatile("":"+v"(tid_));
  const int tid=tid_,lane=tid&63,r32=lane&31,hi=lane>>5; const int wid=__builtin_amdgcn_readfirstlane(tid>>6);
  const bf16*Qw=Qu+(long)(wid*QBLK)*QP;
  const unsigned lds0=(unsigned)(uintptr_t)shm;
  float*wsf=(float*)(shm+LDS_WS)+wid*64;
  const bf16*ksrc=Ku+(long)lane*KVP+wid*8;
  const bf16*vsrc=Vu+(long)(16*(wid&3)+(lane>>2))*KVP+(wid>>2)*32+(lane&3)*8;
  const unsigned kdst=lds0+LDS_K+wid*1024, vdst=lds0+LDS_V+wid*1024;
  #define DMA_K(t,slot) glds16(ksrc+(long)(t)*KVBLK*KVP,(unsigned)__builtin_amdgcn_readfirstlane(kdst+(slot)))
  #define DMA_V(t,slot) glds16(vsrc+(long)(t)*KVBLK*KVP,(unsigned)__builtin_amdgcn_readfirstlane(vdst+(slot)))
  const int vb0=(int)(lds0+LDS_V)+((lane>>4)&1)*32+(lane&3)*8+(4*hi+((lane&15)>>2))*64;
  const char*Kbase=shm+LDS_K; bf16x8 kf[8];
  const lds_cptr shm3=(lds_cptr)shm; const lds_cptr kp0=shm3+LDS_K+hi*1024+r32*16; const lds_cptr vp0=shm3+LDS_V+((lane>>4)&1)*32+(lane&3)*8+(4*hi+((lane&15)>>2))*64;
  DMA_K(0,0);DMA_V(0,0);DMA_K(1,SLOTB);
  bf16x8 qr[4];
  #pragma unroll
  for(int d0=0;d0<4;++d0)qr[d0]=*reinterpret_cast<const bf16x8*>(&Qw[(long)r32*QP+d0*16+hi*8]);
  float mhat=0.f,l_reg=0.f;f32x16 o[2];o[0]=f32x16{};o[1]=f32x16{};f32x16 negm=f32x16{};asm volatile("":"+v"(negm));
  const int dqb=dq0-(wid*QBLK+r32)+4*hi;
  #define CMASK(P0,P1,t) do{ if(MODE==1) bmask(P0,P1,(t),dqb,W); }while(0)
  bool resc=false;
  #define START(P0,P1) do{ float rm=rowmax(P0,P1); if(MODE==1) rm=fmaxf(rm,-60.f); resc=false; \
    { const float dl=rm; mhat=fadd_s(mhat,dl); \
      _Pragma("unroll") for(int r=0;r<16;++r){P0[r]=fsub_s(P0[r],dl);P1[r]=fsub_s(P1[r],dl);} \
      _Pragma("unroll") for(int r=0;r<16;++r)negm[r]=-mhat; asm volatile("":"+v"(negm)); } \
    _Pragma("unroll") for(int r=0;r<16;++r)P0[r]=__builtin_amdgcn_exp2f(P0[r]); }while(0)
  #define RESC() do{ if(resc){ asm volatile("s_waitcnt lgkmcnt(0)":::"memory"); \
      _Pragma("unroll") for(int d_=0;d_<2;++d_) _Pragma("unroll") for(int r=0;r<16;++r)o[d_][r]*=wsf[crow(r,hi)]; } }while(0)
  f32x16 pA0,pA1,pB0,pB1;
  int sl_prev=0,sl_cur=0,sl_next=SLOTB;
  #define ROT() do{sl_prev=sl_cur;sl_cur=sl_next;sl_next=(sl_next==(NSLOT-1)*SLOTB)?0:sl_next+SLOTB;}while(0)
  DMA_K(2,2*SLOTB);
  WAIT_BAR(3);
  qkt(pA0,pA1,Kbase,qr,negm,r32,hi);asm volatile("s_nop 15\n\ts_nop 7":"+v"(pA0),"+v"(pA1));CMASK(pA0,pA1,0);
  START(pA0,pA1);
  _Pragma("unroll") for(int r=0;r<16;++r)pA1[r]=__builtin_amdgcn_exp2f(pA1[r]);
  WAIT_BAR(0);
  DMA_K(3,0);DMA_V(1,SLOTB);
  ROT();
  kload8(kf,kp0+sl_cur);
  WAIT_BAR(2);
  s16x4 vlo[8],vhi[8]; u32x4 pw0,pw1,pw2,pw3;
  #define PKW(P,B) cvtpk_s(P[B],P[B+1])
  #define PAF(k) __builtin_bit_cast(bf16x8,pw##k)
  #define VFR(i) (bf16x8){vlo[i][0],vlo[i][1],vlo[i][2],vlo[i][3],vhi[i][0],vhi[i][1],vhi[i][2],vhi[i][3]}
  #define PIN(x) asm volatile("":"+v"(x))
  #define MX3(a,b,c) __builtin_fmaxf(__builtin_fmaxf((a),(b)),(c))
  #define GAPA(MF,A0,A1,A2,A3,W0,W1,PW) do{ MF; sacc+=A0; sacc+=A1; sacc+=A2; sacc+=A3; PIN(sacc); W0; W1; PIN(PW); SBAR(); }while(0)
  #define EX(v) __builtin_amdgcn_exp2f(v)
  #define GAPB(MF,X,B) do{ MF; X[B]=EX(X[B]); X[B+1]=EX(X[B+1]); X[B+2]=EX(X[B+2]); X[B+3]=EX(X[B+3]); PIN(X); SBAR(); }while(0)
  #define VRD(i) do{ vlo[i]=vtr(vp_+(((i)>>2)*4096+((i)&3)*1024)); vhi[i]=vtr(vp_+(((i)>>2)*4096+((i)&3)*1024+512)); }while(0)
  #define KRD(G,j) do{ if(G){ kload2(kf,kp0+sl_next,j); SBAR(); } }while(0)
  #define STEP(C0,C1,P0,P1,t,GK,GV,GL) do{ SBAR(); \
    const lds_cptr vp_=vp0+sl_prev; \
    VRD(0); SBAR(); float sacc=(P0[0]+P0[1]); \
    GAPA(C0=__builtin_amdgcn_mfma_f32_32x32x16_bf16(kf[0],qr[0],negm,0,0,0), P0[2],P0[3],P0[4],P0[5],     pw0[0]=PKW(P0,0), pw0[1]=PKW(P0,2), pw0); \
    VRD(4); SBAR(); GAPA(C1=__builtin_amdgcn_mfma_f32_32x32x16_bf16(kf[1],qr[0],negm,0,0,0), P0[6],P0[7],P0[8],P0[9],     pw0[2]=PKW(P0,4), pw0[3]=PKW(P0,6), pw0); \
    VRD(1); SBAR(); GAPA(C0=__builtin_amdgcn_mfma_f32_32x32x16_bf16(kf[2],qr[1],C0,0,0,0),   P0[10],P0[11],P0[12],P0[13], pw1[0]=PKW(P0,8), pw1[1]=PKW(P0,10), pw1); \
    VRD(5); SBAR(); GAPA(C1=__builtin_amdgcn_mfma_f32_32x32x16_bf16(kf[3],qr[1],C1,0,0,0),   P0[14],P0[15],P1[0],P1[1],   pw1[2]=PKW(P0,12),pw1[3]=PKW(P0,14), pw1); \
    VRD(2); SBAR(); GAPA(C0=__builtin_amdgcn_mfma_f32_32x32x16_bf16(kf[4],qr[2],C0,0,0,0),   P1[2],P1[3],P1[4],P1[5],     pw2[0]=PKW(P1,0), pw2[1]=PKW(P1,2), pw2); \
    VRD(6); SBAR(); GAPA(C1=__builtin_amdgcn_mfma_f32_32x32x16_bf16(kf[5],qr[2],C1,0,0,0),   P1[6],P1[7],P1[8],P1[9],     pw2[2]=PKW(P1,4), pw2[3]=PKW(P1,6), pw2); \
    VRD(3); SBAR(); GAPA(C0=__builtin_amdgcn_mfma_f32_32x32x16_bf16(kf[6],qr[3],C0,0,0,0),   P1[10],P1[11],P1[12],P1[13], pw3[0]=PKW(P1,8), pw3[1]=PKW(P1,10), pw3); \
    VRD(7); SBAR(); GAPA(C1=__builtin_amdgcn_mfma_f32_32x32x16_bf16(kf[7],qr[3],C1,0,0,0),   P1[14],P1[15],0.f,0.f,       pw3[2]=PKW(P1,12),pw3[3]=PKW(P1,14), pw3); \
    l_reg+=sacc; \
    if(GK){DMA_K((t)+3,sl_cur);} if(GV){DMA_V((t)+1,sl_next);} \
    CMASK(C0,C1,t); \
    { float a=MX3(C0[0],C0[1],C1[0]),b=MX3(C0[2],C0[3],C1[1]); a=MX3(a,C1[2],C1[3]); \
      _Pragma("unroll") for(int r=4;r<16;r+=4){a=MX3(a,C0[r],C0[r+1]);b=MX3(b,C0[r+2],C0[r+3]);a=MX3(a,C1[r],C1[r+1]);b=MX3(b,C1[r+2],C1[r+3]);} \
      float rm=__builtin_fmaxf(a,b); { auto rr=__builtin_amdgcn_permlane32_swap(__float_as_uint(rm),__float_as_uint(rm),false,false); rm=__builtin_fmaxf(__uint_as_float(rr[0]),__uint_as_float(rr[1])); } \
      resc=false; \
      if(__builtin_expect(__any(rm>(float)THRL),0)){ const float dl=__builtin_fmaxf(rm,0.f); mhat+=dl; \
        _Pragma("unroll") for(int r=0;r<16;++r){C0[r]-=dl;C1[r]-=dl;} \
        _Pragma("unroll") for(int r=0;r<16;++r)negm[r]=-mhat; asm volatile("":"+v"(negm)); \
        const float f=__builtin_amdgcn_exp2f(-dl); l_reg*=f; if(hi==0)wsf[r32]=f; resc=true; } } \
    SBAR(); \
    GAPB(o[0]=__builtin_amdgcn_mfma_f32_32x32x16_bf16(PAF(0),VFR(0),o[0],0,0,0), C0,0); \
    GAPB(o[1]=__builtin_amdgcn_mfma_f32_32x32x16_bf16(PAF(0),VFR(4),o[1],0,0,0), C0,4); \
    KRD(GL,0); GAPB(o[0]=__builtin_amdgcn_mfma_f32_32x32x16_bf16(PAF(1),VFR(1),o[0],0,0,0), C0,8); \
    KRD(GL,1); GAPB(o[1]=__builtin_amdgcn_mfma_f32_32x32x16_bf16(PAF(1),VFR(5),o[1],0,0,0), C0,12); \
    KRD(GL,2); GAPB(o[0]=__builtin_amdgcn_mfma_f32_32x32x16_bf16(PAF(2),VFR(2),o[0],0,0,0), C1,0); \
    KRD(GL,3); GAPB(o[1]=__builtin_amdgcn_mfma_f32_32x32x16_bf16(PAF(2),VFR(6),o[1],0,0,0), C1,4); \
    GAPB(o[0]=__builtin_amdgcn_mfma_f32_32x32x16_bf16(PAF(3),VFR(3),o[0],0,0,0), C1,8); \
    GAPB(o[1]=__builtin_amdgcn_mfma_f32_32x32x16_bf16(PAF(3),VFR(7),o[1],0,0,0), C1,12); \
    }while(0)
  int t=1;
  for(;t+5<NT;t+=2){
    STEP(pB0,pB1,pA0,pA1,t,true,true,true);     WAIT_BAR(2); RESC(); ROT();
    STEP(pA0,pA1,pB0,pB1,t+1,true,true,true);   WAIT_BAR(2); RESC(); ROT();
  }
  #define ENDW(tt) do{ if((tt)+3<NT){WAIT_BAR(2);} else if((tt)+2<NT){WAIT_BAR(1);} else {WAIT_BAR(0);} }while(0)
  for(;t+1<NT;t+=2){
    STEP(pB0,pB1,pA0,pA1,t,(t+3<NT),(t+1<NT),(t+1<NT));       ENDW(t);   RESC(); ROT();
    STEP(pA0,pA1,pB0,pB1,t+1,(t+4<NT),(t+2<NT),(t+2<NT));     ENDW(t+1); RESC(); ROT();
  }
  STEP(pB0,pB1,pA0,pA1,NT-1,false,false,false); RESC();
  { float sacc=pB0[0]+pB0[1]; _Pragma("unroll") for(int r=2;r<16;++r)sacc+=pB0[r]; _Pragma("unroll") for(int r=0;r<16;++r)sacc+=pB1[r]; l_reg+=sacc;
    pw0=(u32x4){PKW(pB0,0),PKW(pB0,2),PKW(pB0,4),PKW(pB0,6)};pw1=(u32x4){PKW(pB0,8),PKW(pB0,10),PKW(pB0,12),PKW(pB0,14)};pw2=(u32x4){PKW(pB1,0),PKW(pB1,2),PKW(pB1,4),PKW(pB1,6)};pw3=(u32x4){PKW(pB1,8),PKW(pB1,10),PKW(pB1,12),PKW(pB1,14)};
    SBAR(); pv(o,vb0+sl_cur,PAF(0),PAF(1),PAF(2),PAF(3)); }
  #undef PKW
  #undef PAF
  #undef VFR
  #undef PIN
  #undef MX3
  #undef GAPA
  #undef GAPB
  #undef EX
  #undef VRD
  #undef KRD
  #undef STEP
  #undef ENDW
  {auto rr=__builtin_amdgcn_permlane32_swap(__float_as_uint(l_reg),__float_as_uint(l_reg),false,false);l_reg=__uint_as_float(rr[0])+__uint_as_float(rr[1]);}
  if(MODE==1){ if(has_sink) l_reg+=__builtin_amdgcn_exp2f(sinkl2-mhat); if(lse!=nullptr&&hi==0) lse[(long)(wid*QBLK+r32)*8]=0.6931471805599453f*(mhat+__builtin_amdgcn_logf(l_reg)); }
  if(hi==0)wsf[32+r32]=l_reg;asm volatile("s_waitcnt lgkmcnt(0)":::"memory");
  float rli[16];
  #pragma unroll
  for(int r=0;r<16;++r)rli[r]=__builtin_amdgcn_rcpf(wsf[32+crow(r,hi)]);
  bf16*Ow=Ou+(long)(wid*QBLK)*OP;
  { bf16*stg=(bf16*)(shm+LDS_OST)+wid*2048;
    #pragma unroll
    for(int r=0;r<16;++r){const int orow=crow(r,hi);
      #pragma unroll
      for(int d0=0;d0<2;++d0)stg[orow*64+d0*32+r32]=__float2bfloat16(o[d0][r]*rli[r]);}
    asm volatile("s_waitcnt lgkmcnt(0)":::"memory");
    #pragma unroll
    for(int i=0;i<4;++i){const int row=i*8+(lane>>3),ch=lane&7; const u32x4 v=*(const u32x4*)(stg+row*64+ch*8); ATTN_STORE16(Ow+(long)row*OP+ch*8,v);} }
  asm volatile("s_waitcnt lgkmcnt(0)\n\ts_barrier":::"memory");
  #undef DMA_K
  #undef DMA_V
  #undef CMASK
  #undef START
  #undef RESC
  #undef ROT
}
constexpr int ATTN_LDS_BYTES=LDS_BYTES;
#undef SBAR
#undef WAIT_BAR
}
#define XB_TMO      128
#define XB_XCNT(j)  (256  + 64 * (j))
#define XB_XSUB(j)  (1280 + 64 * (j))
#define XB_XGEN(j)  (2304 + 64 * (j))
#define XB_TOP      3328
#define XB_TOPGEN   3392
#define XCD_BAR_WORDS 3456
#define XB_SPIN_CAP (1u << 18)

__device__ __forceinline__ unsigned xb_ld(unsigned* p)              { return __hip_atomic_load(p, __ATOMIC_RELAXED, __HIP_MEMORY_SCOPE_AGENT); }
__device__ __forceinline__ unsigned xb_add(unsigned* p, unsigned v) { return __hip_atomic_fetch_add(p, v, __ATOMIC_RELAXED, __HIP_MEMORY_SCOPE_AGENT); }
__device__ __forceinline__ unsigned xb_xcc_id() { return (unsigned)__builtin_amdgcn_s_getreg((3 << 11) | 20) & 0xFu; }
#define XB_SPIN(cond, bar) do { unsigned _sp = 0; while (cond) { __builtin_amdgcn_s_sleep(1); \
    if ((++_sp & 255u) == 0u) { if (xb_ld(&(bar)[XB_TMO])) break; if (_sp > XB_SPIN_CAP) { atomicAdd(&(bar)[XB_TMO], 1u); break; } } } } while (0)

struct XcdBarrier {
    unsigned* bar; unsigned x;
    volatile LAS unsigned* st;
};

__device__ __forceinline__ XcdBarrier xcd_barrier_post(unsigned* bar, volatile LAS unsigned* st) {
    XcdBarrier b; b.bar = bar; b.x = xb_xcc_id(); b.st = st;
    if (threadIdx.x == 0) (void)xb_add(&bar[XB_XCNT(b.x)], 1u);
    return b;
}
__device__ __forceinline__ void xcd_barrier_complete(unsigned* bar, unsigned x, unsigned& nloc, unsigned& nx) {
    const unsigned G = gridDim.x * gridDim.y * gridDim.z;
    unsigned sum, cnt, mine, sp = 0u;
    for (;;) {
        sum = 0u; cnt = 0u; mine = 0u;
#pragma unroll
        for (unsigned j = 0; j < 16; ++j) { const unsigned c = xb_ld(&bar[XB_XCNT(j)]); sum += c; cnt += (c > 0u) ? 1u : 0u; mine = (j == x) ? c : mine; }
        if (sum == G) break;
        __builtin_amdgcn_s_sleep(1);
        if ((++sp & 255u) == 0u) { if (xb_ld(&bar[XB_TMO])) break; if (sp > XB_SPIN_CAP) { atomicAdd(&bar[XB_TMO], 1u); break; } }
    }
    nloc = mine > 0u ? mine : 1u; nx = cnt > 0u ? cnt : 1u;
}

__device__ __forceinline__ void xcd_barrier(const XcdBarrier& b) {
    asm volatile("s_waitcnt vmcnt(0)" ::: "memory");
    __syncthreads();
    if (threadIdx.x == 0) {
        unsigned* bar = b.bar;
        __builtin_amdgcn_s_waitcnt(0);
        unsigned nloc = b.st[0], nx = b.st[1];
        if (nloc == 0u) { xcd_barrier_complete(bar, b.x, nloc, nx); b.st[0] = nloc; b.st[1] = nx; }
        const unsigned old = xb_add(&bar[XB_XSUB(b.x)], 1u);
        const unsigned gen = old / nloc;
        if (old + 1u == (gen + 1u) * nloc) {
            __builtin_amdgcn_fence(__ATOMIC_RELEASE, "agent");
            asm volatile("s_waitcnt vmcnt(0)" ::: "memory");
            const unsigned og = xb_add(&bar[XB_TOP], 1u);
            const unsigned tg = og / nx;
            if (og + 1u == (tg + 1u) * nx) xb_add(&bar[XB_TOPGEN], 1u);
            else XB_SPIN(xb_ld(&bar[XB_TOPGEN]) == tg, bar);
            __builtin_amdgcn_fence(__ATOMIC_ACQUIRE, "agent");
            xb_add(&bar[XB_XGEN(b.x)], 1u);
            asm volatile("s_waitcnt vmcnt(0)" ::: "memory");
        } else {
            XB_SPIN(xb_ld(&bar[XB_XGEN(b.x)]) == gen, bar);
            __builtin_amdgcn_fence(__ATOMIC_ACQUIRE, "agent");
            asm volatile("s_waitcnt vmcnt(0)" ::: "memory");
        }
    }
    __syncthreads();
}

struct Frame {
    LAS unsigned char* lds;
    volatile LAS unsigned* MISC;
    gu32* ctl;
    int tid, lane, wave, vcu, G, bx;
    int gw, NGW;
};
__device__ __forceinline__ bool refresh(Frame& F) {
    int t = threadIdx.x; asm volatile("" : "+v"(t)); F.tid = t; F.lane = t & 63; F.wave = __builtin_amdgcn_readfirstlane(t >> 6);
    int bx = blockIdx.x, G = gridDim.x; asm volatile("" : "+s"(bx), "+s"(G)); F.bx = bx; F.G = G;
    F.vcu = (G % 8 == 0) ? (bx % 8) * (G / 8) + bx / 8 : bx; F.gw = F.vcu * NWAVES + F.wave; F.NGW = G * NWAVES; return true; }
__device__ __forceinline__ float wave_sum(float v) {
#pragma unroll
    for (int o = 1; o < 64; o <<= 1) v += shx(v, o);
    return v;
}
template <int MAP> __device__ __forceinline__ int rowmap(int n) {
    if (MAP == 1) { const int f = n >> 1; return 256 * (f >> 7) + 128 * (n & 1) + (f & 127); }
    if (MAP == 2 || MAP == 3) { const int tl = n >> 8, hh = (n >> 6) & 3, d = n & 63; int bj, j;
        const bool axial = (MAP == 2) && (tl < 2 || (tl == 2 && hh < 2));
        if (axial) { bj = (d >> 4) & 1; j = (d & 15) + ((d >> 5) << 4); } else { bj = d >> 5; j = d & 31; }
        return 256 * tl + 128 * bj + 32 * hh + j; }
    return n; }
struct TrTile { const float* W; bf16* WT; const float* gain; int K, N, k0, n0; };
__device__ __forceinline__ void tr_load(const TrTile& t, f32x4 (&v)[16], int lane) {
    const float* src = t.W + (size_t)(t.k0 + (lane >> 4)) * t.N + t.n0 + 4 * (lane & 15);
#pragma unroll
    for (int i = 0; i < 16; ++i) v[i] = *(const f32x4*)(src + (size_t)(4 * i) * t.N);
}
template <int MAP> __device__ __forceinline__ void tr_store(const TrTile& t, f32x4 (&v)[16], LAS float* scr, int lane) {
    const int lr = lane >> 4, lc = lane & 15;
    if (t.gain) {
#pragma unroll
        for (int i = 0; i < 16; ++i) v[i] *= t.gain[t.k0 + 4 * i + lr]; }
#pragma unroll
    for (int i = 0; i < 16; ++i) { LAS float* p = scr + (4 * i + lr) * 65 + 4 * lc; p[0] = v[i].x; p[1] = v[i].y; p[2] = v[i].z; p[3] = v[i].w; }
    LDS_WAIT(); asm volatile("" ::: "memory");
    const int c = lane & 7;
#pragma unroll
    for (int j = 0; j < 8; ++j) { const int n = 8 * j + (lane >> 3); const LAS float* s = scr + (8 * c) * 65 + n;
        v4u o; o.x = pk2(s[0 * 65], s[1 * 65]); o.y = pk2(s[2 * 65], s[3 * 65]); o.z = pk2(s[4 * 65], s[5 * 65]); o.w = pk2(s[6 * 65], s[7 * 65]);
        *(GAS v4u*)(t.WT + (size_t)rowmap<MAP>(t.n0 + n) * t.K + t.k0 + 8 * c) = o; }
    LDS_WAIT(); asm volatile("" ::: "memory");
}
template <int MAP> __device__ __forceinline__ void transpose_family(Frame& F, const float* W, size_t sW, bf16* WT, size_t sWT, const float* gain, int sG, int K, int N, int nmat, int gdiv) {
    LAS float* scr = (LAS float*)(F.lds + RING_OFF) + F.wave * (128 * 33);
    const int nb = N / 64, per = (K / 64) * nb, total = per * nmat;
    f32x4 va[16], vb[16];
    int it = F.gw; if (it >= total) return;
    TrTile ta, tb;
#define TR_SETUP(tt, item) do { const int mi = (item) / per, r = (item) % per; tt.W = W + (size_t)mi * sW; tt.WT = WT + (size_t)mi * sWT; tt.gain = gain ? gain + (size_t)(mi / gdiv) * sG : nullptr; tt.K = K; tt.N = N; tt.k0 = 64 * (r / nb); tt.n0 = 64 * (r % nb); } while (0)
    TR_SETUP(ta, it); tr_load(ta, va, F.lane);
    for (;;) {
        const int it2 = it + F.NGW; const bool h2 = it2 < total;
        if (h2) { TR_SETUP(tb, it2); tr_load(tb, vb, F.lane); }
        tr_store<MAP>(ta, va, scr, F.lane);
        if (!h2) break;
        const int it3 = it2 + F.NGW; const bool h3 = it3 < total;
        if (h3) { TR_SETUP(ta, it3); tr_load(ta, va, F.lane); }
        tr_store<MAP>(tb, vb, scr, F.lane);
        if (!h3) break;
        it = it3;
    }
#undef TR_SETUP
}
__device__ __forceinline__ void tr8_load(const TrTile& t, f32x4 (&v)[16], int lane) {
    const float* src = t.W + (size_t)(t.k0 + (lane >> 3)) * t.N + t.n0 + 4 * (lane & 7);
#pragma unroll
    for (int i = 0; i < 16; ++i) v[i] = *(const f32x4*)(src + (size_t)(8 * i) * t.N);
}
template <int MAP> __device__ __forceinline__ void tr8_store(const TrTile& t, f32x4 (&v)[16], LAS float* scr, int lane) {
    const int lr = lane >> 3, lc = lane & 7; const float sc = (float)(1 << F8_WSC);
#pragma unroll
    for (int i = 0; i < 16; ++i) { const float g = t.gain ? t.gain[t.k0 + 8 * i + lr] * sc : sc; LAS float* p = scr + (8 * i + lr) * 33 + 4 * lc; p[0] = v[i].x * g; p[1] = v[i].y * g; p[2] = v[i].z * g; p[3] = v[i].w * g; }
    LDS_WAIT(); asm volatile("" ::: "memory");
    const int c = lane & 7;
#pragma unroll
    for (int j = 0; j < 4; ++j) { const int n = 8 * j + (lane >> 3); const LAS float* s = scr + (16 * c) * 33 + n;
        v4u o; o.x = pk4_fp8(s[0 * 33], s[1 * 33], s[2 * 33], s[3 * 33]); o.y = pk4_fp8(s[4 * 33], s[5 * 33], s[6 * 33], s[7 * 33]); o.z = pk4_fp8(s[8 * 33], s[9 * 33], s[10 * 33], s[11 * 33]); o.w = pk4_fp8(s[12 * 33], s[13 * 33], s[14 * 33], s[15 * 33]);
        *(GAS v4u*)((unsigned char*)t.WT + (size_t)rowmap<MAP>(t.n0 + n) * t.K + t.k0 + 16 * c) = o; }
    LDS_WAIT(); asm volatile("" ::: "memory");
}
template <int MAP> __device__ __forceinline__ void transpose_family_f8(Frame& F, const float* W, size_t sW, unsigned char* WT, size_t sWT, const float* gain, int sG, int K, int N, int nmat, int gdiv) {
    LAS float* scr = (LAS float*)(F.lds + RING_OFF) + F.wave * (128 * 33);
    const int nb = N / 32, per = (K / 128) * nb, total = per * nmat;
    f32x4 va[16], vb[16];
    int it = F.gw; if (it >= total) return;
    TrTile ta, tb;
#define TR_SETUP(tt, item) do { const int mi = (item) / per, r = (item) % per; tt.W = W + (size_t)mi * sW; tt.WT = (bf16*)(WT + (size_t)mi * sWT); tt.gain = gain ? gain + (size_t)(mi / gdiv) * sG : nullptr; tt.K = K; tt.N = N; tt.k0 = 128 * (r / nb); tt.n0 = 32 * (r % nb); } while (0)
    TR_SETUP(ta, it); tr8_load(ta, va, F.lane);
    for (;;) {
        const int it2 = it + F.NGW; const bool h2 = it2 < total;
        if (h2) { TR_SETUP(tb, it2); tr8_load(tb, vb, F.lane); }
        tr8_store<MAP>(ta, va, scr, F.lane);
        if (!h2) break;
        const int it3 = it2 + F.NGW; const bool h3 = it3 < total;
        if (h3) { TR_SETUP(ta, it3); tr8_load(ta, va, F.lane); }
        tr8_store<MAP>(tb, vb, scr, F.lane);
        if (!h3) break;
        it = it3;
    }
#undef TR_SETUP
}
__device__ __forceinline__ float rope_freq(int i, int half_dim) { return exp2f(-(float)i / (float)half_dim * LOG2_THETA); }

__device__ __forceinline__ void attn_phase_l0(Frame& F, const bf16* Q3, const bf16* K3, const bf16* V3, bf16* OCAT, const float* sink) {
    char* shm = (char*)(F.lds + RING_OFF);
    const int upc = (512 + F.G - 1) / F.G;
    for (int i = 0; i < upc; ++i) { const int u = F.vcu * upc + i; if (u >= 512) break;
        const int bhk = u >> 7, b = bhk >> 1, hkv = bhk & 1, hq = hkv * 4 + ((u & 127) >> 5), qb = u & 31; const size_t r0 = (size_t)b * SEQ + qb * 256;
        attn_body::attn_unit<0, 1024, 8>((const attn_body::bf16*)(Q3 + r0 * 512 + hq * 64), (const attn_body::bf16*)(K3 + (size_t)b * SEQ * 128 + hkv * 64), (const attn_body::bf16*)(V3 + (size_t)b * SEQ * 128 + hkv * 64),
                                        (attn_body::bf16*)(OCAT + r0 * D + hq * 64), SEQ / 64, 0, 0, 0.f, false, nullptr, shm); }
    const bf16* Qb = Q3 + (size_t)T * 512; const bf16* Kb = K3 + (size_t)T * 128; const bf16* Vb = V3 + (size_t)T * 128;
    for (int i = 0; i < upc; ++i) { const int u = F.vcu * upc + i; if (u >= 512) break;
        const int bhk = u >> 7, b = bhk >> 1, hkv = bhk & 1, hq = hkv * 4 + ((u & 127) >> 5), qb = u & 31; const size_t r0 = (size_t)b * SEQ + qb * 256;
        const int tl = max(qb * 4 - 2, 0), th = min(qb * 4 + 6, SEQ / 64); const size_t k0 = (size_t)b * SEQ + tl * 64;
        attn_body::attn_unit<1, 1024, 8>((const attn_body::bf16*)(Qb + r0 * 512 + hq * 64), (const attn_body::bf16*)(Kb + k0 * 128 + hkv * 64), (const attn_body::bf16*)(Vb + k0 * 128 + hkv * 64),
                                        (attn_body::bf16*)(OCAT + r0 * D + 512 + hq * 64), th - tl, tl * 64 - qb * 256, 128, sink[hq] * 1.4426950408889634f, true, nullptr, shm); }
}
__device__ __forceinline__ void attn_phase_l1(Frame& F, const bf16* Q3, const bf16* K3, const bf16* V3, bf16* OGB, float* LSE) {
    char* shm = (char*)(F.lds + RING_OFF);
    const int upc = (512 + F.G - 1) / F.G;
#pragma unroll 1
    for (int g = 0; g < 3; ++g) { const int Lc = SEQ >> (2 * g);
        for (int i = 0; i < upc; ++i) { const int u = F.vcu * upc + i; if (u >= 512) break;
            const int bhk = u >> 7, b = bhk >> 1, hkv = bhk & 1, hq = hkv * 4 + ((u & 127) >> 5), qb = u & 31; const size_t r0 = (size_t)b * SEQ + qb * 256;
            const int q0 = qb * 256, cbase = q0 & ~(Lc - 1), lq0 = q0 & (Lc - 1); const int tl = min(max(lq0 / 64 - 1, 0), Lc / 64 - 6); const size_t k0 = (size_t)b * SEQ + cbase + tl * 64;
            attn_body::attn_unit<1, 512, 8>((const attn_body::bf16*)(Q3 + (size_t)g * T * 512 + r0 * 512 + hq * 64), (const attn_body::bf16*)(K3 + (size_t)g * T * 128 + k0 * 128 + hkv * 64), (const attn_body::bf16*)(V3 + (size_t)g * T * 128 + k0 * 128 + hkv * 64),
                                           (attn_body::bf16*)(OGB + (size_t)g * T * 512 + r0 * 512 + hq * 64), 6, cbase + tl * 64 - q0, 64, 0.f, false, LSE + (size_t)g * T * 8 + r0 * 8 + hq, shm); }
    }
}
__device__ __forceinline__ void merge_phase(Frame& F, const bf16* OGB, const float* LSE, bf16* OCAT1) {
    for (int m = F.gw; m < T; m += F.NGW) {
        const int h = F.lane >> 3; const int b = m / SEQ, pos = m % SEQ;
        const size_t r0 = m, r1 = (size_t)b * SEQ + (size_t)(pos & 3) * (SEQ / 4) + (pos >> 2), r2 = (size_t)b * SEQ + (size_t)(pos & 15) * (SEQ / 16) + (pos >> 4);
        const float l0 = LSE[r0 * 8 + h], l1 = LSE[(size_t)T * 8 + r1 * 8 + h], l2 = LSE[(size_t)2 * T * 8 + r2 * 8 + h];
        const float mx = fmaxf(l0, fmaxf(l1, l2)); float w0 = __expf(l0 - mx), w1 = __expf(l1 - mx), w2 = __expf(l2 - mx); const float is = 1.f / (w0 + w1 + w2); w0 *= is; w1 *= is; w2 *= is;
        const v4u a = *(const v4u*)(OGB + r0 * 512 + F.lane * 8), bb = *(const v4u*)(OGB + (size_t)T * 512 + r1 * 512 + F.lane * 8), c = *(const v4u*)(OGB + (size_t)2 * T * 512 + r2 * 512 + F.lane * 8);
        v4u w;
        w.x = pk2(w0 * bflo(a.x) + w1 * bflo(bb.x) + w2 * bflo(c.x), w0 * bfhi(a.x) + w1 * bfhi(bb.x) + w2 * bfhi(c.x));
        w.y = pk2(w0 * bflo(a.y) + w1 * bflo(bb.y) + w2 * bflo(c.y), w0 * bfhi(a.y) + w1 * bfhi(bb.y) + w2 * bfhi(c.y));
        w.z = pk2(w0 * bflo(a.z) + w1 * bflo(bb.z) + w2 * bflo(c.z), w0 * bfhi(a.z) + w1 * bfhi(bb.z) + w2 * bfhi(c.z));
        w.w = pk2(w0 * bflo(a.w) + w1 * bflo(bb.w) + w2 * bflo(c.w), w0 * bfhi(a.w) + w1 * bfhi(bb.w) + w2 * bfhi(c.w));
        *(v4u*)(OCAT1 + (size_t)m * C_OUT + F.lane * 8) = w;
    }
}

typedef float f32x4m __attribute__((ext_vector_type(4)));
__device__ __forceinline__ void top4_merge(float (&v)[4], int (&ix)[4], int mask) {
    float ov[4]; int oi[4];
#pragma unroll
    for (int k = 0; k < 4; ++k) { ov[k] = shx(v[k], mask); oi[k] = shx(ix[k], mask); }
    float cv[8]; int ci[8];
#pragma unroll
    for (int k = 0; k < 4; ++k) { cv[k] = v[k]; ci[k] = ix[k]; cv[4 + k] = ov[k]; ci[4 + k] = oi[k]; }
    unsigned used = 0u;
#pragma unroll
    for (int k = 0; k < 4; ++k) { float best = -INFINITY; int bi = 1 << 30, bp = 0;
#pragma unroll
        for (int c = 0; c < 8; ++c) { const bool take = !((used >> c) & 1u) && (cv[c] > best || (cv[c] == best && ci[c] < bi)); best = take ? cv[c] : best; bi = take ? ci[c] : bi; bp = take ? c : bp; }
        used |= 1u << bp; v[k] = best; ix[k] = bi; }
}
__device__ __forceinline__ void route_phase(Frame& F, const bf16* H, const float* WR, const float* rb, int* CNTTAB, int* TOPE, float* TOPG, int* TOPPOS, float* RSTD) {
    LAS float* WL = (LAS float*)(F.lds + RING_OFF);
    LAS unsigned* LC = (LAS unsigned*)(F.lds + RING_OFF + NE * 1028 * 4);
    if (F.tid < NE) LC[F.tid] = 0u;
    for (int i = F.tid; i < NE * D / 4; i += NWAVES * 64) { const int e = i >> 8, k4 = i & 255; *(LAS f32x4*)(WL + e * 1028 + 4 * k4) = *(const f32x4*)(WR + (size_t)e * D + 4 * k4); }
    __syncthreads();
    const int lane = F.lane, c = lane & 15, q = lane >> 4;
    for (int task = F.wave * F.G + F.vcu; task < T / 16; task += F.NGW) {
        const bf16* xr = H + (size_t)(task * 16 + c) * D + 8 * q;
        const LAS float* w0 = WL + c * 1028 + 8 * q; const LAS float* w1 = w0 + 16 * 1028;
        f32x4m a0 = {0.f, 0.f, 0.f, 0.f}, a1 = {0.f, 0.f, 0.f, 0.f}; float ssq = 0.f;
#pragma unroll 4
        for (int ch = 0; ch < 32; ++ch) {
            const v4u xv = *(const v4u*)(xr + 32 * ch);
            float xf[8]; xf[0] = bflo(xv.x); xf[1] = bfhi(xv.x); xf[2] = bflo(xv.y); xf[3] = bfhi(xv.y); xf[4] = bflo(xv.z); xf[5] = bfhi(xv.z); xf[6] = bflo(xv.w); xf[7] = bfhi(xv.w);
            const f32x4 wa0 = *(const LAS f32x4*)(w0 + 32 * ch), wa1 = *(const LAS f32x4*)(w0 + 32 * ch + 4), wb0 = *(const LAS f32x4*)(w1 + 32 * ch), wb1 = *(const LAS f32x4*)(w1 + 32 * ch + 4);
#pragma unroll
            for (int t = 0; t < 8; ++t) ssq += xf[t] * xf[t];
            a0 = __builtin_amdgcn_mfma_f32_16x16x4f32(wa0.x, xf[0], a0, 0, 0, 0); a1 = __builtin_amdgcn_mfma_f32_16x16x4f32(wb0.x, xf[0], a1, 0, 0, 0);
            a0 = __builtin_amdgcn_mfma_f32_16x16x4f32(wa0.y, xf[1], a0, 0, 0, 0); a1 = __builtin_amdgcn_mfma_f32_16x16x4f32(wb0.y, xf[1], a1, 0, 0, 0);
            a0 = __builtin_amdgcn_mfma_f32_16x16x4f32(wa0.z, xf[2], a0, 0, 0, 0); a1 = __builtin_amdgcn_mfma_f32_16x16x4f32(wb0.z, xf[2], a1, 0, 0, 0);
            a0 = __builtin_amdgcn_mfma_f32_16x16x4f32(wa0.w, xf[3], a0, 0, 0, 0); a1 = __builtin_amdgcn_mfma_f32_16x16x4f32(wb0.w, xf[3], a1, 0, 0, 0);
            a0 = __builtin_amdgcn_mfma_f32_16x16x4f32(wa1.x, xf[4], a0, 0, 0, 0); a1 = __builtin_amdgcn_mfma_f32_16x16x4f32(wb1.x, xf[4], a1, 0, 0, 0);
            a0 = __builtin_amdgcn_mfma_f32_16x16x4f32(wa1.y, xf[5], a0, 0, 0, 0); a1 = __builtin_amdgcn_mfma_f32_16x16x4f32(wb1.y, xf[5], a1, 0, 0, 0);
            a0 = __builtin_amdgcn_mfma_f32_16x16x4f32(wa1.z, xf[6], a0, 0, 0, 0); a1 = __builtin_amdgcn_mfma_f32_16x16x4f32(wb1.z, xf[6], a1, 0, 0, 0);
            a0 = __builtin_amdgcn_mfma_f32_16x16x4f32(wa1.w, xf[7], a0, 0, 0, 0); a1 = __builtin_amdgcn_mfma_f32_16x16x4f32(wb1.w, xf[7], a1, 0, 0, 0);
        }
        ssq += shx(ssq, 16); ssq += shx(ssq, 32);
        const float rstd = 1.f / sqrtf(ssq * (1.f / D) + NORM_EPS);
        float cv[8]; int ci[8];
#pragma unroll
        for (int r = 0; r < 4; ++r) { ci[r] = 4 * q + r; ci[4 + r] = 16 + 4 * q + r; cv[r] = a0[r] * rstd + rb[4 * q + r]; cv[4 + r] = a1[r] * rstd + rb[16 + 4 * q + r]; }
        float tv[4]; int ti[4]; unsigned used = 0u;
#pragma unroll
        for (int k = 0; k < 4; ++k) { float best = -INFINITY; int bi = 0, bp = 0;
#pragma unroll
            for (int j = 0; j < 8; ++j) { const bool take = !((used >> j) & 1u) && (cv[j] > best); best = take ? cv[j] : best; bi = take ? ci[j] : bi; bp = take ? j : bp; }
            used |= 1u << bp; tv[k] = best; ti[k] = bi; }
        top4_merge(tv, ti, 16); top4_merge(tv, ti, 32);
        const float e1 = __expf(tv[1] - tv[0]), e2 = __expf(tv[2] - tv[0]), e3 = __expf(tv[3] - tv[0]); const float is = 1.f / (1.f + e1 + e2 + e3);
        const int m = task * 16 + c;
        { const int e = q == 0 ? ti[0] : q == 1 ? ti[1] : q == 2 ? ti[2] : ti[3]; const float g = (q == 0 ? 1.f : q == 1 ? e1 : q == 2 ? e2 : e3) * is;
            const unsigned pos = __hip_atomic_fetch_add(LC + e, 1u, __ATOMIC_RELAXED, __HIP_MEMORY_SCOPE_WORKGROUP);
            TOPE[m * 4 + q] = e; TOPG[m * 4 + q] = g; TOPPOS[m * 4 + q] = (int)pos; }
        if (q == 0) RSTD[m] = rstd;
    }
    __syncthreads();
    if (F.tid < NE) CNTTAB[F.vcu * NE + F.tid] = (int)LC[F.tid];
    __syncthreads();
}
__device__ __forceinline__ void slot_phase(Frame& F, const bf16* H, const int* CNTTAB, const int* TOPE, const float* TOPG, const int* TOPPOS, const float* RSTD, int* TOKSLOT, float* SLOTGATE, float* SLOTRS, bf16* XG, int* XTAB, bool f8) {
    LAS int* L = (LAS int*)(F.lds + RING_OFF);
    LAS int* P = L + 256;
    const int lane = F.lane;
    {
#pragma unroll 1
        for (int ee = 0; ee < 4; ++ee) { const int e = F.wave * 4 + ee;
            int s0 = 0, s1 = 0, s2 = 0, s3 = 0; const int g0 = 4 * lane;
            if (g0 < F.G) s0 = CNTTAB[g0 * NE + e]; if (g0 + 1 < F.G) s1 = CNTTAB[(g0 + 1) * NE + e]; if (g0 + 2 < F.G) s2 = CNTTAB[(g0 + 2) * NE + e]; if (g0 + 3 < F.G) s3 = CNTTAB[(g0 + 3) * NE + e];
            const int t = s0 + s1 + s2 + s3; int inc = t;
#pragma unroll
            for (int o = 1; o < 64; o <<= 1) { const int u = shup(inc, o); if (lane >= o) inc += u; }
            const int base = inc - t;
            P[g0 * NE + e] = base; P[(g0 + 1) * NE + e] = base + s0; P[(g0 + 2) * NE + e] = base + s0 + s1; P[(g0 + 3) * NE + e] = base + s0 + s1 + s2;
            if (lane == 63) L[64 + e] = inc; }
    }
    __syncthreads();
    if (F.wave == 0) {
        const int np = (lane < 32) ? ((L[64 + (lane & 31)] + 255) >> 8) : 0;
        int pre = np;
#pragma unroll
        for (int o = 1; o < 32; o <<= 1) { const int t = shup(pre, o); if (lane >= o) pre += t; }
        const int p0 = pre - np;
        if (lane < 32) { L[lane] = np; L[32 + lane] = p0 * 256; }
        if (F.bx == 0) {
            LDS_WAIT(); asm volatile("" ::: "memory");
            int rank = 0;
#pragma unroll 8
            for (int e2 = 0; e2 < 32; ++e2) { const int v = L[e2]; rank += (v > np || (v == np && e2 < lane)) ? 1 : 0; }
            LAS int* XE = L + 96;
            if (lane < 32) { const int r16 = rank & 15, x = r16 < 8 ? r16 : 15 - r16, pos = (rank >> 4) * 2 + (r16 >= 8 ? 1 : 0); XE[(x * 4 + pos) * 3] = lane; XE[(x * 4 + pos) * 3 + 1] = p0; XE[(x * 4 + pos) * 3 + 2] = np; }
            LDS_WAIT(); asm volatile("" ::: "memory");
            const int lx = lane_opaque();
            if (lx < 8) { int cump = 0; int* tb = XTAB + lx * 136;
#pragma unroll
                for (int s = 0; s < 4; ++s) { const int e = XE[(lx * 4 + s) * 3], q0 = XE[(lx * 4 + s) * 3 + 1], n = XE[(lx * 4 + s) * 3 + 2]; tb[4 + 4 * s] = e; tb[4 + 4 * s + 1] = q0; tb[4 + 4 * s + 2] = n; tb[4 + 4 * s + 3] = cump; cump += n; }
                int four = 4; asm volatile("" : "+v"(four));
                tb[0] = four; tb[1] = cump; }
        }
    }
    __syncthreads();
    if (f8) {
        for (int m0 = F.gw; m0 < T; m0 += 4 * F.NGW) {
            int e[4], ps[4]; float gt[4], rs[4]; v4u ra[4], rb[4];
#pragma unroll
            for (int j = 0; j < 4; ++j) { const int m = m0 + j * F.NGW; const bool ok = m < T; const int mm = ok ? m : 0;
                e[j] = 0; ps[j] = 0; gt[j] = 0.f;
                if (lane < 4) { e[j] = TOPE[mm * 4 + lane]; ps[j] = TOPPOS[mm * 4 + lane]; gt[j] = TOPG[mm * 4 + lane]; }
                rs[j] = RSTD[mm]; const bf16* src = H + (size_t)mm * D + lane * 16; ra[j] = *(const v4u*)src; rb[j] = *(const v4u*)(src + 8); }
#pragma unroll
            for (int j = 0; j < 4; ++j) { const int m = m0 + j * F.NGW; if (m >= T) break;
                int slot = 0;
                if (lane < 4) { const int wg = (m >> 4) % F.G; slot = L[32 + e[j]] + P[wg * NE + e[j]] + ps[j]; TOKSLOT[m * 4 + lane] = slot; SLOTGATE[slot] = gt[j]; SLOTRS[slot] = rs[j]; }
                const int s0 = shl(slot, 0), s1 = shl(slot, 1), s2 = shl(slot, 2), s3 = shl(slot, 3);
                const v4u a = ra[j], b = rb[j]; const float r = rs[j];
                v4u w; w.x = pk4_fp8(clamp448(bflo(a.x) * r), clamp448(bfhi(a.x) * r), clamp448(bflo(a.y) * r), clamp448(bfhi(a.y) * r)); w.y = pk4_fp8(clamp448(bflo(a.z) * r), clamp448(bfhi(a.z) * r), clamp448(bflo(a.w) * r), clamp448(bfhi(a.w) * r));
                w.z = pk4_fp8(clamp448(bflo(b.x) * r), clamp448(bfhi(b.x) * r), clamp448(bflo(b.y) * r), clamp448(bfhi(b.y) * r)); w.w = pk4_fp8(clamp448(bflo(b.z) * r), clamp448(bfhi(b.z) * r), clamp448(bflo(b.w) * r), clamp448(bfhi(b.w) * r));
                unsigned char* X8 = (unsigned char*)XG; const size_t co = (size_t)lane * 16;
                *(v4u*)(X8 + (size_t)s0 * D + co) = w; *(v4u*)(X8 + (size_t)s1 * D + co) = w; *(v4u*)(X8 + (size_t)s2 * D + co) = w; *(v4u*)(X8 + (size_t)s3 * D + co) = w; }
        }
    } else {
    for (int m = F.gw; m < T; m += F.NGW) {
        int slot = 0;
        if (lane < 4) { const int e = TOPE[m * 4 + lane]; const int wg = (m >> 4) % F.G; slot = L[32 + e] + P[wg * NE + e] + TOPPOS[m * 4 + lane]; TOKSLOT[m * 4 + lane] = slot; SLOTGATE[slot] = TOPG[m * 4 + lane]; SLOTRS[slot] = RSTD[m]; }
        const int s0 = shl(slot, 0), s1 = shl(slot, 1), s2 = shl(slot, 2), s3 = shl(slot, 3);
        const bf16* src = H + (size_t)m * D + lane * 8; const v4u a = *(const v4u*)src, b = *(const v4u*)(src + 512);
        const size_t co = (size_t)lane * 8;
        *(v4u*)(XG + (size_t)s0 * D + co) = a; *(v4u*)(XG + (size_t)s0 * D + co + 512) = b;
        *(v4u*)(XG + (size_t)s1 * D + co) = a; *(v4u*)(XG + (size_t)s1 * D + co + 512) = b;
        *(v4u*)(XG + (size_t)s2 * D + co) = a; *(v4u*)(XG + (size_t)s2 * D + co + 512) = b;
        *(v4u*)(XG + (size_t)s3 * D + co) = a; *(v4u*)(XG + (size_t)s3 * D + co + 512) = b;
    }
    }
    __syncthreads();
}
__device__ __forceinline__ void y_add16(float (&a)[16], const void* Yp, size_t row, int lane) {
    if (Y_FP8) { const v4u y = *(const v4u*)((const unsigned char*)Yp + row * D + lane * 16); const float is = 1.f / Y_SC;
        const unsigned w[4] = {y.x, y.y, y.z, y.w};
#pragma unroll
        for (int i = 0; i < 4; ++i) { const f32x2_ lo = __builtin_amdgcn_cvt_pk_f32_fp8((int)w[i], false), hi = __builtin_amdgcn_cvt_pk_f32_fp8((int)w[i], true); a[4 * i] += lo.x * is; a[4 * i + 1] += lo.y * is; a[4 * i + 2] += hi.x * is; a[4 * i + 3] += hi.y * is; } }
    else { const bf16* yp = (const bf16*)Yp + row * D + lane * 16; const v4u y0 = *(const v4u*)yp, y1 = *(const v4u*)(yp + 8);
        a[0] += bflo(y0.x); a[1] += bfhi(y0.x); a[2] += bflo(y0.y); a[3] += bfhi(y0.y); a[4] += bflo(y0.z); a[5] += bfhi(y0.z); a[6] += bflo(y0.w); a[7] += bfhi(y0.w);
        a[8] += bflo(y1.x); a[9] += bfhi(y1.x); a[10] += bflo(y1.y); a[11] += bfhi(y1.y); a[12] += bflo(y1.z); a[13] += bfhi(y1.z); a[14] += bflo(y1.w); a[15] += bfhi(y1.w); }
}
__device__ __forceinline__ void combine_phase(Frame& F, const bf16* HM, const void* Y, const int* TOKSLOT, bf16* H2, unsigned char* H2F8) {
    const int lane = F.lane;
    for (int m = F.gw; m < T; m += F.NGW) {
        const int s0 = TOKSLOT[m * 4], s1 = TOKSLOT[m * 4 + 1], s2 = TOKSLOT[m * 4 + 2], s3 = TOKSLOT[m * 4 + 3];
        float a[16];
#pragma unroll
        for (int i = 0; i < 16; ++i) a[i] = 0.f;
        y_add16(a, Y, (size_t)s0, lane); y_add16(a, Y, (size_t)s1, lane); y_add16(a, Y, (size_t)s2, lane); y_add16(a, Y, (size_t)s3, lane);
        const bf16* hp = HM + (size_t)m * D + lane * 16; const v4u h0 = *(const v4u*)hp, h1 = *(const v4u*)(hp + 8);
        a[0] += bflo(h0.x); a[1] += bfhi(h0.x); a[2] += bflo(h0.y); a[3] += bfhi(h0.y); a[4] += bflo(h0.z); a[5] += bfhi(h0.z); a[6] += bflo(h0.w); a[7] += bfhi(h0.w);
        a[8] += bflo(h1.x); a[9] += bfhi(h1.x); a[10] += bflo(h1.y); a[11] += bfhi(h1.y); a[12] += bflo(h1.z); a[13] += bfhi(h1.z); a[14] += bflo(h1.w); a[15] += bfhi(h1.w);
        v4u w0, w1; w0.x = pk2(a[0], a[1]); w0.y = pk2(a[2], a[3]); w0.z = pk2(a[4], a[5]); w0.w = pk2(a[6], a[7]); w1.x = pk2(a[8], a[9]); w1.y = pk2(a[10], a[11]); w1.z = pk2(a[12], a[13]); w1.w = pk2(a[14], a[15]);
        bf16* op = H2 + (size_t)m * D + lane * 16; *(v4u*)op = w0; *(v4u*)(op + 8) = w1;
        if (PLE_FP8) { v4u q; q.x = pk4_fp8(clamp448(a[0]), clamp448(a[1]), clamp448(a[2]), clamp448(a[3])); q.y = pk4_fp8(clamp448(a[4]), clamp448(a[5]), clamp448(a[6]), clamp448(a[7]));
            q.z = pk4_fp8(clamp448(a[8]), clamp448(a[9]), clamp448(a[10]), clamp448(a[11])); q.w = pk4_fp8(clamp448(a[12]), clamp448(a[13]), clamp448(a[14]), clamp448(a[15])); *(v4u*)(H2F8 + (size_t)m * D + lane * 16) = q; }
    }
}
__device__ __forceinline__ void final_norm_phase(Frame& F, const bf16* H, const float* SS, const float* gain, float* out) {
    const int lane = F.lane;
    for (int m = F.gw; m < T; m += F.NGW) {
        const float rstd = 1.f / sqrtf(ssp_sum(SS + (size_t)m * 16) * (1.f / D) + NORM_EPS);
#pragma unroll
        for (int j = 0; j < 2; ++j) { const size_t co = (size_t)j * 512 + lane * 8; const v4u h = *(const v4u*)(H + (size_t)m * D + co); const f32x4 g0 = *(const f32x4*)(gain + co), g1 = *(const f32x4*)(gain + co + 4);
            f32x4 o0, o1; o0.x = bflo(h.x) * rstd * g0.x; o0.y = bfhi(h.x) * rstd * g0.y; o0.z = bflo(h.y) * rstd * g0.z; o0.w = bfhi(h.y) * rstd * g0.w;
            o1.x = bflo(h.z) * rstd * g1.x; o1.y = bfhi(h.z) * rstd * g1.y; o1.z = bflo(h.w) * rstd * g1.z; o1.w = bfhi(h.w) * rstd * g1.w;
            float* dst = out + (size_t)m * D + co; *(f32x4*)dst = o0; *(f32x4*)(dst + 4) = o1; }
    }
}

constexpr int N_PHASES = 22;
struct Args { const float* in[20]; float* out; unsigned char* ws; int ph_lo, ph_hi, li, pad; };
typedef const __attribute__((address_space(4))) Args* argp_t;
__device__ __forceinline__ argp_t opaque_args() { argp_t p = (argp_t)__builtin_amdgcn_kernarg_segment_ptr(); asm volatile("" : "+s"(p)); return p; }
#define AP (opaque_args())
__global__ void __launch_bounds__(NWAVES * 64, 2) fwd_kernel(Args args_unused) {
    extern __shared__ __attribute__((aligned(16))) unsigned char lds[];
    Frame F;
    F.lds = (LAS unsigned char*)lds;
    F.MISC = (volatile LAS unsigned*)(F.lds + MISC_OFF);
    refresh(F);
    F.ctl = (gu32*)(AP->ws + WS_CTL);
    if (F.tid < 128) ((LAS unsigned*)(F.lds + LDSCTL_OFF))[F.tid] = 0u;
    __syncthreads();
    const bool one_phase = (AP->ph_hi - AP->ph_lo) == 1;
    XcdBarrier bar; bar.bar = (unsigned*)(F.ctl + CW_BAR); bar.x = 0; bar.st = nullptr;
    if (!one_phase) bar = xcd_barrier_post((unsigned*)(F.ctl + CW_BAR), F.MISC + 8);
    const int lo = AP->ph_lo, hi = AP->ph_hi;
#ifndef MK_MASK
#define MK_MASK 0x3fff
#endif
#ifndef PROBE_MASK
#define PROBE_MASK 0
#endif
#define IN(k) (lo <= (k) && (k) < hi)
#define INL(j) (((MK_MASK >> (j)) & 1) && IN(pb + (j)) && refresh(F))
#define REP(j) _Pragma("unroll") for (int rep_ = 0; rep_ < (((PROBE_MASK >> (j)) & 1) ? 2 : 1); ++rep_)
#define SEAM(k) do { if (IN((k) + 1)) xcd_barrier(bar); } while (0)
#define ws (AP->ws)
#define WSP(type, off) ((type*)(ws + (off)))
    if (((MK_MASK >> 12) & 1) && IN(0) && refresh(F)) REP(12) {
#pragma unroll 1
        for (int ll = 0; ll < 2; ++ll) {
            const float* wu = AP->in[13] + (size_t)ll * NE * D * 2 * DE; const float* wd = AP->in[15] + (size_t)ll * NE * DE * D; const float* gf = AP->in[10] + ll * D;
            unsigned char* du = ws + WS_WUPT + (size_t)ll * NE * 2 * DE * D * 2; unsigned char* dd = ws + WS_WDNT + (size_t)ll * NE * D * DE * 2;
#if MOE_FP8_MASK != 0
            if ((MOE_FP8_MASK >> ll) & 1) {
                transpose_family_f8<1>(F, wu, (size_t)D * 2 * DE, du, (size_t)2 * DE * D, gf, 0, D, 2 * DE, NE, 1);
                transpose_family_f8<0>(F, wd, (size_t)DE * D, dd, (size_t)D * DE, nullptr, 0, DE, D, NE, 1);
            }
#endif
#if MOE_FP8_MASK != 3
            if (!((MOE_FP8_MASK >> ll) & 1)) {
                transpose_family<1>(F, wu, (size_t)D * 2 * DE, (bf16*)du, (size_t)2 * DE * D, gf, 0, D, 2 * DE, NE, 1);
                transpose_family<0>(F, wd, (size_t)DE * D, (bf16*)dd, (size_t)D * DE, nullptr, 0, DE, D, NE, 1);
            }
#endif
        }
        transpose_family<2>(F, AP->in[3], 0, WSP(bf16, WS_WIN0T), 0, AP->in[2], 0, D, AB_IN, 1, 1);
        transpose_family<3>(F, AP->in[8], 0, WSP(bf16, WS_WIN1T), 0, AP->in[2] + D, 0, D, C_IN, 1, 1);
        transpose_family<0>(F, AP->in[7], 0, WSP(bf16, WS_WOUT0T), 0, nullptr, 0, D, D, 1, 1);
        transpose_family<0>(F, AP->in[9], 0, WSP(bf16, WS_WOUT1T), 0, nullptr, 0, C_OUT, D, 1, 1);
        if (PLE_FP8) transpose_family_f8<0>(F, AP->in[18], (size_t)D * D, ws + WS_WGT, (size_t)D * D * 2, nullptr, 0, D, D, 2, 1);
        else transpose_family<0>(F, AP->in[18], (size_t)D * D, WSP(bf16, WS_WGT), (size_t)D * D, nullptr, 0, D, D, 2, 1);
        transpose_family<0>(F, AP->in[17], (size_t)PLE * D, WSP(bf16, WS_WPT), (size_t)D * PLE, nullptr, 0, PLE, D, 2, 1);
        {
            float* WR = WSP(float, WS_WR); const float* nf = AP->in[10]; const float* rw = AP->in[11];
            for (int i = F.gw * 64 + F.lane; i < 2 * NE * D; i += F.NGW * 64) { const int l = i / (NE * D), e = (i / D) % NE, k = i % D; WR[i] = nf[l * D + k] * rw[((size_t)l * D + k) * NE + e]; }
        }
        {
            float* R1 = WSP(float, WS_ROPE1); float* RA = WSP(float, WS_ROPEA);
            for (int i = F.gw * 64 + F.lane; i < SEQ * 32; i += F.NGW * 64) { const int pos = i >> 5, j = i & 31;
                const float a1 = (float)pos * rope_freq(j, 32); R1[2 * i] = cosf(a1); R1[2 * i + 1] = sinf(a1);
                const float aa = (float)((j < 16) ? (pos >> 6) : (pos & 63)) * rope_freq(j & 15, 16); RA[2 * i] = cosf(aa); RA[2 * i + 1] = sinf(aa); }
        }
        {
            bf16* PBF = WSP(bf16, WS_PBF); const float* p_in = AP->in[1]; const size_t n8 = (size_t)2 * T * PLE / 8;
            for (size_t i = (size_t)F.gw * 64 + F.lane; i < n8; i += (size_t)F.NGW * 64) { const f32x4 a = *(const f32x4*)(p_in + i * 8), b = *(const f32x4*)(p_in + i * 8 + 4);
                v4u w; w.x = pk2(a.x, a.y); w.y = pk2(a.z, a.w); w.z = pk2(b.x, b.y); w.w = pk2(b.z, b.w); *(v4u*)(PBF + i * 8) = w; }
        }
        {
            bf16* X0 = WSP(bf16, WS_X0); float* SS0 = WSP(float, WS_SSP); const float* x_in = AP->in[0];
            for (int m = F.gw; m < T; m += F.NGW) { float s = 0.f;
#pragma unroll
                for (int j = 0; j < 2; ++j) { const size_t co = (size_t)m * D + j * 512 + F.lane * 8; const f32x4 a = *(const f32x4*)(x_in + co), b = *(const f32x4*)(x_in + co + 4);
                    v4u w; w.x = pk2(a.x, a.y); w.y = pk2(a.z, a.w); w.z = pk2(b.x, b.y); w.w = pk2(b.z, b.w); *(v4u*)(X0 + co) = w;
                    s += (bflo(w.x) * bflo(w.x) + bfhi(w.x) * bfhi(w.x)) + (bflo(w.y) * bflo(w.y) + bfhi(w.y) * bfhi(w.y)) + (bflo(w.z) * bflo(w.z) + bfhi(w.z) * bfhi(w.z)) + (bflo(w.w) * bflo(w.w) + bfhi(w.w) * bfhi(w.w)); }
                s = wave_sum(s); if (F.lane < 16) SS0[(size_t)m * 16 + F.lane] = (F.lane == 0) ? s : 0.f; }
        }
        __syncthreads();
        SEAM(0);
    }
#pragma unroll 1
    for (int l = 0; l < 2; ++l) {
        const int pb = 1 + 10 * l;
        if (INL(0)) REP(0) {
            const bf16* hin = (l == 0) ? WSP(bf16, WS_X0) : WSP(bf16, WS_H3);
            const float* ssin = WSP(float, WS_SSP) + (size_t)l * T * 16;
            if (l == 0) { pg8::Gemm g{hin, WSP(bf16, WS_WIN0T), T, AB_IN, D}; pg8::StaticOrder S; S.init(T, AB_IN, F.G, F.bx);
                EpiQKV<0> E{ssin, AP->in[4], AP->in[5], WSP(float, WS_ROPE1), WSP(float, WS_ROPEA), WSP(bf16, WS_Q3), WSP(bf16, WS_K3), WSP(bf16, WS_V3)};
                pg8::gemm_phase<EpiQKV<0>, pg8::StaticOrder, true, true>(F.lds + RING_OFF, g, S, E); }
            else { pg8::Gemm g{hin, WSP(bf16, WS_WIN1T), T, C_IN, D}; pg8::StaticOrder S; S.init(T, C_IN, F.G, F.bx);
                EpiQKV<1> E{ssin, nullptr, nullptr, WSP(float, WS_ROPE1), WSP(float, WS_ROPEA), WSP(bf16, WS_Q3), WSP(bf16, WS_K3), WSP(bf16, WS_V3)};
                pg8::gemm_phase<EpiQKV<1>, pg8::StaticOrder, true, true>(F.lds + RING_OFF, g, S, E); }
            if (l == 0) { int Kp = PLE; asm volatile("" : "+s"(Kp)); pg8::Gemm g{WSP(bf16, WS_PBF), WSP(bf16, WS_WPT), 2 * T, 2 * D, Kp}; PPOrder S{(int)F.G, F.bx};
                EpiPP E{WSP(bf16, WS_PP)};
                pg8::gemm_phase<EpiPP, PPOrder, true, true>(F.lds + RING_OFF, g, S, E); }
            SEAM(pb + 0);
        }
        if (INL(1)) REP(1) {
            if (l == 0) attn_phase_l0(F, WSP(bf16, WS_Q3), WSP(bf16, WS_K3), WSP(bf16, WS_V3), WSP(bf16, WS_OCAT), AP->in[6]);
            else attn_phase_l1(F, WSP(bf16, WS_Q3), WSP(bf16, WS_K3), WSP(bf16, WS_V3), WSP(bf16, WS_OGB), WSP(float, WS_LSE));
            SEAM(pb + 1);
        }
        if (INL(2)) REP(2) { if (l == 1) merge_phase(F, WSP(bf16, WS_OGB), WSP(float, WS_LSE), WSP(bf16, WS_OCAT)); SEAM(pb + 2); }
        if (INL(3)) REP(3) {
            const bf16* hin = (l == 0) ? WSP(bf16, WS_X0) : WSP(bf16, WS_H3);
            pg8::Gemm g{WSP(bf16, WS_OCAT), (const bf16*)(ws + (l == 0 ? WS_WOUT0T : WS_WOUT1T)), T, D, (l == 0) ? D : C_OUT}; pg8::StaticOrder S; S.init(T, D, F.G, F.bx); EpiResBf16 E{hin, WSP(bf16, WS_HM)};
            pg8::gemm_phase<EpiResBf16, pg8::StaticOrder, true, true>(F.lds + RING_OFF, g, S, E);
            SEAM(pb + 3);
        }
        if (INL(4)) REP(4) { route_phase(F, WSP(bf16, WS_HM), WSP(float, WS_WR) + (size_t)l * NE * D, AP->in[12] + l * NE, WSP(int, WS_CNTTAB), WSP(int, WS_TOPE), WSP(float, WS_TOPG), WSP(int, WS_TOPPOS), WSP(float, WS_RSTD));
#ifdef PROBE_ROUTE
            route_phase(F, WSP(bf16, WS_HM), WSP(float, WS_WR) + (size_t)l * NE * D, AP->in[12] + l * NE, WSP(int, WS_OGB) + 16 * T, WSP(int, WS_OGB), WSP(float, WS_OGB) + 4 * T, WSP(int, WS_OGB) + 8 * T, WSP(float, WS_OGB) + 12 * T);
#endif
            SEAM(pb + 4); }
        if (INL(5)) REP(5) { slot_phase(F, WSP(bf16, WS_HM), WSP(int, WS_CNTTAB), WSP(int, WS_TOPE), WSP(float, WS_TOPG), WSP(int, WS_TOPPOS), WSP(float, WS_RSTD), WSP(int, WS_TOKSLOT), WSP(float, WS_SLOTGATE), WSP(float, WS_SLOTRS), WSP(bf16, WS_XG), WSP(int, WS_XTAB), ((MOE_FP8_MASK >> l) & 1) != 0); SEAM(pb + 5); }
        if (INL(6)) REP(6) {
            XcdOrder<3> S{WSP(int, WS_XTAB) + (F.bx & 7) * 136, F.bx >> 3, (int)F.G >> 3};
#if MOE_FP8_MASK != 0
            if ((MOE_FP8_MASK >> l) & 1) { pg8::Gemm g{WSP(bf16, WS_XG), WSP(bf16, WS_WUPT) + (size_t)l * NE * 2 * DE * D, NSLOT, NE * 2 * DE, D / 2};
                EpiSwiglu<true> E{WSP(void, WS_ACT), AP->in[14] + (size_t)l * NE * 2 * DE, nullptr};
                pg8::gemm_phase<EpiSwiglu<true>, XcdOrder<3>, true, true, F8_DIAG ? 1000 : 127 - F8_WSC>(F.lds + RING_OFF, g, S, E); }
#ifdef PROBE_UPNULL
            if ((MOE_FP8_MASK >> l) & 1) { pg8::Gemm g{WSP(bf16, WS_XG), WSP(bf16, WS_WUPT) + (size_t)l * NE * 2 * DE * D, NSLOT, NE * 2 * DE, D / 2};
                EpiNull E{WSP(float, WS_OGB)};
                pg8::gemm_phase<EpiNull, XcdOrder<3>, true, true, 127 - F8_WSC>(F.lds + RING_OFF, g, S, E); }
#endif
#endif
#if MOE_FP8_MASK != 3
            if (!((MOE_FP8_MASK >> l) & 1)) { pg8::Gemm g{WSP(bf16, WS_XG), WSP(bf16, WS_WUPT) + (size_t)l * NE * 2 * DE * D, NSLOT, NE * 2 * DE, D};
                EpiSwiglu<false> E{WSP(void, WS_ACT), AP->in[14] + (size_t)l * NE * 2 * DE, WSP(float, WS_SLOTRS)};
                pg8::gemm_phase<EpiSwiglu<false>, XcdOrder<3>, true, true>(F.lds + RING_OFF, g, S, E); }
#endif
            SEAM(pb + 6);
        }
        if (INL(7)) REP(7) {
            XcdOrder<2> S{WSP(int, WS_XTAB) + (F.bx & 7) * 136, F.bx >> 3, (int)F.G >> 3};
            EpiDown<Y_FP8 != 0> E{WSP(void, WS_Y), AP->in[16] + (size_t)l * NE * D, WSP(float, WS_SLOTGATE), ((MOE_FP8_MASK >> l) & 1) ? F8_EPI_SC : 1.f};
#if MOE_FP8_MASK != 0
            if ((MOE_FP8_MASK >> l) & 1) { pg8::Gemm g{WSP(bf16, WS_ACT), WSP(bf16, WS_WDNT) + (size_t)l * NE * D * DE, NSLOT, NE * D, DE / 2};
                pg8::gemm_phase<EpiDown<Y_FP8 != 0>, XcdOrder<2>, true, true, F8_DIAG ? 1000 : 127 - F8_WSC>(F.lds + RING_OFF, g, S, E); }
#ifdef PROBE_DNNULL
            if ((MOE_FP8_MASK >> l) & 1) { pg8::Gemm g{WSP(bf16, WS_ACT), WSP(bf16, WS_WDNT) + (size_t)l * NE * D * DE, NSLOT, NE * D, DE / 2};
                EpiNull E2{WSP(float, WS_OGB)};
                pg8::gemm_phase<EpiNull, XcdOrder<2>, true, true, 127 - F8_WSC>(F.lds + RING_OFF, g, S, E2); }
#endif
#endif
#if MOE_FP8_MASK != 3
            if (!((MOE_FP8_MASK >> l) & 1)) { pg8::Gemm g{WSP(bf16, WS_ACT), WSP(bf16, WS_WDNT) + (size_t)l * NE * D * DE, NSLOT, NE * D, DE};
                pg8::gemm_phase<EpiDown<Y_FP8 != 0>, XcdOrder<2>, true, true>(F.lds + RING_OFF, g, S, E); }
#endif
            SEAM(pb + 7);
        }
        if (INL(8)) REP(8) { combine_phase(F, WSP(bf16, WS_HM), WSP(void, WS_Y), WSP(int, WS_TOKSLOT), WSP(bf16, WS_H2), ws + WS_H2F8); SEAM(pb + 8); }
        if (INL(9)) REP(9) {
            pg8::StaticOrder S; S.init(T, D, F.G, F.bx);
            EpiPle E{WSP(bf16, WS_H2), WSP(bf16, WS_PP) + (size_t)l * T * D, WSP(bf16, WS_H3), WSP(float, WS_SSP) + (size_t)(l + 1) * T * 16};
            if (PLE_FP8) { pg8::Gemm g{WSP(bf16, WS_H2F8), WSP(bf16, WS_WGT) + (size_t)l * D * D, T, D, D / 2};
                pg8::gemm_phase<EpiPle, pg8::StaticOrder, true, true, 127 - F8_WSC>(F.lds + RING_OFF, g, S, E); }
            else { pg8::Gemm g{WSP(bf16, WS_H2), WSP(bf16, WS_WGT) + (size_t)l * D * D, T, D, D};
                pg8::gemm_phase<EpiPle, pg8::StaticOrder, true, true>(F.lds + RING_OFF, g, S, E); }
            SEAM(pb + 9);
        }
    }
    if (((MK_MASK >> 13) & 1) && IN(21) && refresh(F)) final_norm_phase(F, WSP(bf16, WS_H3), WSP(float, WS_SSP) + (size_t)2 * T * 16, AP->in[19], AP->out);
#undef IN
#undef INL
#undef REP
#undef SEAM
#undef ws
#undef WSP
}

#ifndef MK_ONE_LAUNCH
#define MK_ONE_LAUNCH 1
#endif
extern "C" void kernel_launch(void* const* d_in, const int* in_sizes, int n_in, void* d_out, int out_size, void* d_ws, size_t ws_size, hipStream_t stream) {
    static int grid = 0;
    if (grid == 0) {
        if (n_in != 20 || in_sizes[0] != T * D || out_size != T * D || ws_size < WS_END) { fprintf(stderr, "kernel_launch: unexpected shapes: n_in %d in0 %d out %d ws %zu (need %zu)\n", n_in, n_in > 0 ? in_sizes[0] : -1, out_size, ws_size, (size_t)WS_END); grid = -1; return; }
        int dev = 0, cus = 0, per_cu = 0;
        if (hipGetDevice(&dev) != hipSuccess || hipDeviceGetAttribute(&cus, hipDeviceAttributeMultiprocessorCount, dev) != hipSuccess) { grid = -1; return; }
        if (hipFuncSetAttribute((const void*)fwd_kernel, hipFuncAttributeMaxDynamicSharedMemorySize, LDS_BYTES) != hipSuccess) { fprintf(stderr, "kernel_launch: hipFuncSetAttribute failed\n"); grid = -1; return; }
        if (hipOccupancyMaxActiveBlocksPerMultiprocessor(&per_cu, (const void*)fwd_kernel, NWAVES * 64, LDS_BYTES) != hipSuccess || per_cu < 1) fprintf(stderr, "kernel_launch: occupancy query says %d\n", per_cu);
        (void)hipGetLastError();
        grid = cus;
        if (grid != 256) fprintf(stderr, "kernel_launch: %d CUs (built for 256)\n", grid);
    }
    if (grid < 0) return;
    if (hipMemsetAsync((char*)d_ws + WS_CTL, 0, CTL_ZERO_BYTES, stream) != hipSuccess) return;
    Args a{};
    for (int i = 0; i < 20; ++i) a.in[i] = (const float*)d_in[i];
    a.out = (float*)d_out; a.ws = (unsigned char*)d_ws;
#if MK_ONE_LAUNCH
    a.ph_lo = 0; a.ph_hi = N_PHASES; a.li = 0;
    hipLaunchKernelGGL(fwd_kernel, dim3(grid), dim3(NWAVES * 64), LDS_BYTES, stream, a);
#else
    for (int ph = 0; ph < N_PHASES; ++ph) {
        if (ph == 3) continue;
        a.ph_lo = ph; a.ph_hi = ph + 1; a.li = ph;
        hipLaunchKernelGGL(fwd_kernel, dim3(grid), dim3(NWAVES * 64), LDS_BYTES, stream, a);
    }
#endif
}
```

```cpp
#include <hip/hip_runtime.h>
#include <hip/hip_bf16.h>
#include <cstdio>
#include <cstdint>
#include <cmath>
namespace pg8 {
#define PG8_LAS __attribute__((address_space(3)))
typedef unsigned short bf16_t;
typedef short bf16x8 __attribute__((ext_vector_type(8)));
typedef float f32x4 __attribute__((ext_vector_type(4)));
typedef unsigned u32x4 __attribute__((ext_vector_type(4)));
typedef int pg8_v4i __attribute__((ext_vector_type(4)));
typedef long pg8_v2l __attribute__((ext_vector_type(2)));
constexpr int BM = 256, BK = 64, HALF = 128, HTB = HALF * BK * 2  , STAGE_BYTES = 8 * HTB, NXCD = 8, WGM = 8;

__host__ __device__ __forceinline__ int lds_byte(int r, int c) { const int st = (r >> 4) * 2 + (c >> 5), rr = r & 15, cc = c & 31, ob = rr * 64 + cc * 2; return st * 1024 + (ob ^ (((ob >> 9) & 1) << 5)); }
__host__ __device__ __forceinline__ void stage_rc(int b, int& R, int& C) { const int st = b / 1024, sb = b % 1024, swz = sb ^ (((sb >> 9) & 1) << 5); R = (st >> 1) * 16 + swz / 64; C = (st & 1) * 32 + (swz % 64) / 2; }
__host__ __device__ __forceinline__ int perm32(int rho) { const int n = rho >> 4, i = rho & 15; return 8 * (i >> 2) + 4 * n + (i & 3); }

struct Unit { int pm, pn; };
struct Gemm { const bf16_t* A; const bf16_t* Bt; int M, N, K; };

struct StaticOrder {
    int nM, nN, nwg, G, c;
    __host__ __device__ void init(int M, int N, int G_, int c_) { nM = M / BM; nN = N / BM; nwg = nM * nN; G = G_; c = c_; }
    __host__ __device__ bool next(int i, Unit& u) const {
        const long L = (long)i * G + c; if (L >= nwg) return false;
        int wgid = (int)L; { const int q = nwg / NXCD, r = nwg % NXCD, xcd = wgid % NXCD, off = wgid / NXCD; wgid = (xcd < r ? xcd * (q + 1) : r * (q + 1) + (xcd - r) * q) + off; }
        const int nig = WGM * nN, gid = wgid / nig, fm = gid * WGM, gsz = (nM - fm) < WGM ? (nM - fm) : WGM;
        u.pm = fm + ((wgid % nig) % gsz); u.pn = (wgid % nig) / gsz; return true;
    }
    __device__ __forceinline__ void a_ready(const Unit&) const {}
    __device__ __forceinline__ void done(const Unit&) const {}
};

__device__ __forceinline__ unsigned cvt_pk_bf16(float lo, float hi) { unsigned r; asm volatile("v_cvt_pk_bf16_f32 %0, %1, %2" : "=v"(r) : "v"(lo), "v"(hi)); return r; }
typedef float f32x2 __attribute__((ext_vector_type(2)));
__device__ __forceinline__ f32x2 gelu_pk(f32x2 v) {
    const f32x2 av = __builtin_elementwise_abs(v), d = av * 0.2316418882f + 1.0f;
    f32x2 t; t.x = __builtin_amdgcn_rcpf(d.x); t.y = __builtin_amdgcn_rcpf(d.y);
    f32x2 q = t * 0.5307027145f + (-0.7265760135f); q = q * t + 0.7107068705f; q = q * t + (-0.142248368f); q = q * t + 0.127414796f; q = q * t;
    const f32x2 s = (v * v) * (-0.72134752044f);
    f32x2 e; e.x = __builtin_amdgcn_exp2f(s.x); e.y = __builtin_amdgcn_exp2f(s.y);
    const f32x2 m = v * (q * e), r = v - m;
    f32x2 o; o.x = v.x < 0.f ? m.x : r.x; o.y = v.y < 0.f ? m.y : r.y; return o;
}

template <int ACT  > struct EpiBf16 {
    static constexpr bool PERM = true, AFTER_DRAIN = false; static_assert(ACT == 0 || ACT == 1, "EpiBf16: ACT is 0 (none) or 1 (gelu_pk)");
    bf16_t* O; int ldc; const float* bias; int split_cols; size_t split_stride; float scale0;
    __device__ __forceinline__ void operator()(const f32x4 (&acc)[2][2][4][2], const Unit& u, int wr, int wc, int fr, int fq) const {
        const int row0 = u.pm * BM + wr * 64 + fr; int colt = u.pn * BM; bf16_t* base = O;
        float sc = 1.f; if (split_cols) { const int t = colt / split_cols; base += (size_t)t * split_stride; colt -= t * split_cols; if (t == 0) sc = scale0; }
        const int col0 = colt + wc * 32 + 8 * fq, bcol0 = u.pn * BM + wc * 32 + 8 * fq;
        f32x4 bv[2][2];
#pragma unroll
        for (int bj = 0; bj < 2; ++bj)
#pragma unroll
            for (int n = 0; n < 2; ++n) bv[bj][n] = bias ? *(const f32x4*)(bias + bcol0 + bj * HALF + 4 * n) : (f32x4){0.f, 0.f, 0.f, 0.f};
#pragma unroll
        for (int ai = 0; ai < 2; ++ai)
#pragma unroll
            for (int m = 0; m < 4; ++m) { bf16_t* rowp = base + (size_t)(row0 + ai * HALF + m * 16) * ldc + col0;
#pragma unroll
                for (int bj = 0; bj < 2; ++bj) { f32x4 v0 = acc[ai][bj][m][0] + bv[bj][0], v1 = acc[ai][bj][m][1] + bv[bj][1];
                    if (ACT == 1) { f32x2 a = gelu_pk((f32x2){v0[0], v0[1]}), b = gelu_pk((f32x2){v0[2], v0[3]}), c = gelu_pk((f32x2){v1[0], v1[1]}), d = gelu_pk((f32x2){v1[2], v1[3]});
                        v0 = (f32x4){a.x, a.y, b.x, b.y}; v1 = (f32x4){c.x, c.y, d.x, d.y}; }
                    v0 = v0 * sc; v1 = v1 * sc; u32x4 w; w.x = cvt_pk_bf16(v0[0], v0[1]); w.y = cvt_pk_bf16(v0[2], v0[3]); w.z = cvt_pk_bf16(v1[0], v1[1]); w.w = cvt_pk_bf16(v1[2], v1[3]);
                    *(u32x4*)(rowp + bj * HALF) = w; } }
    }
};
template <class Epi, class Sched, bool ALIGN_EPI = false, bool SP2 = false, int FP8SC = -1>
__device__ __forceinline__ void gemm_phase(PG8_LAS unsigned char* lds, const Gemm g, const Sched& S, const Epi& E) {
    int tid_ = threadIdx.x; asm volatile("" : "+v"(tid_));
    const int tid = tid_, wid = __builtin_amdgcn_readfirstlane(tid >> 6), lane = tid & 63, wr = wid >> 2, wc = wid & 3, fr = lane & 15, fq = lane >> 4;
    const int K = g.K, nt = K / BK;
    unsigned voffA[2], voffB[2];
#pragma unroll
    for (int i = 0; i < 2; ++i) { int R, C; stage_rc(tid * 16 + i * 8192, R, C); const int Rb = Epi::PERM ? ((R & ~31) + perm32(R & 31)) : R;
        voffA[i] = (unsigned)(R * K + C) * 2u; voffB[i] = (unsigned)(Rb * K + C) * 2u; }
    const size_t kstep = (size_t)(BK * 2);
    const size_t hstep = (size_t)HALF * K * 2;
    const size_t tstep = 2 * hstep;
    const unsigned ldsw = (unsigned)wid * 1024u;
    const int aoff = lds_byte(wr * 64 + fr, fq * 8), boff = lds_byte(wc * 32 + fr, fq * 8);
#define PG8_SA(b, h) (((b) * 2 + (h)) * HTB)
#define PG8_SB(b, h) ((4 + (b) * 2 + (h)) * HTB)
#define PG8_STAGE(bufoff, gbase, voff) do { _Pragma("unroll") for (int _i = 0; _i < 2; ++_i) \
        __builtin_amdgcn_global_load_lds((const unsigned*)((const char*)(gbase) + (voff)[_i]), (PG8_LAS unsigned*)(lds + (bufoff) + ldsw + _i * 8192), 16, 0, 0); } while (0)
#define PG8_LDA(dst, b, h) do { _Pragma("unroll") for (int m = 0; m < 4; ++m) _Pragma("unroll") for (int k = 0; k < 2; ++k) dst[m][k] = *(const PG8_LAS bf16x8*)(lds + PG8_SA(b, h) + aoff + m * 2048 + k * 1024); } while (0)
#define PG8_LDB(dst, b, h) do { _Pragma("unroll") for (int n = 0; n < 2; ++n) _Pragma("unroll") for (int k = 0; k < 2; ++k) dst[n][k] = *(const PG8_LAS bf16x8*)(lds + PG8_SB(b, h) + boff + n * 2048 + k * 1024); } while (0)
#define PG8_CAT8(x0, x1) __builtin_shufflevector(__builtin_bit_cast(pg8_v4i, x0), __builtin_bit_cast(pg8_v4i, x1), 0, 1, 2, 3, 4, 5, 6, 7)
#define PG8_MMA(ai, bj, At, Bt) do { __builtin_amdgcn_s_setprio(1); \
        if constexpr (FP8SC < 0) { _Pragma("unroll") for (int m = 0; m < 4; ++m) _Pragma("unroll") for (int n = 0; n < 2; ++n) _Pragma("unroll") for (int k = 0; k < 2; ++k) \
            acc[ai][bj][m][n] = __builtin_amdgcn_mfma_f32_16x16x32_bf16(Bt[n][k], At[m][k], acc[ai][bj][m][n], 0, 0, 0); } \
        else if constexpr (FP8SC >= 1000) { _Pragma("unroll") for (int m = 0; m < 4; ++m) _Pragma("unroll") for (int n = 0; n < 2; ++n) _Pragma("unroll") for (int k = 0; k < 2; ++k) { \
            const pg8_v2l bq = __builtin_bit_cast(pg8_v2l, Bt[n][k]), aq = __builtin_bit_cast(pg8_v2l, At[m][k]); \
            acc[ai][bj][m][n] = __builtin_amdgcn_mfma_f32_16x16x32_fp8_fp8(bq[0], aq[0], acc[ai][bj][m][n], 0, 0, 0); acc[ai][bj][m][n] = __builtin_amdgcn_mfma_f32_16x16x32_fp8_fp8(bq[1], aq[1], acc[ai][bj][m][n], 0, 0, 0); } } \
        else { _Pragma("unroll") for (int m = 0; m < 4; ++m) _Pragma("unroll") for (int n = 0; n < 2; ++n) \
            acc[ai][bj][m][n] = __builtin_amdgcn_mfma_scale_f32_16x16x128_f8f6f4(PG8_CAT8(Bt[n][0], Bt[n][1]), PG8_CAT8(At[m][0], At[m][1]), acc[ai][bj][m][n], 0, 0, 0, (FP8SC < 0 ? 127 : FP8SC) * 0x01010101, 0, 0x7f7f7f7f); \
            _Pragma("unroll") for (int m = 0; m < 4; ++m) _Pragma("unroll") for (int n = 0; n < 2; ++n) asm volatile("" : "+v"(acc[ai][bj][m][n])); }     \
        __builtin_amdgcn_s_setprio(0); } while (0)
#define PG8_WAIT_V(n) asm volatile("s_waitcnt vmcnt(" #n ")" ::: "memory")
#define PG8_WAIT_L(n) asm volatile("s_waitcnt lgkmcnt(" #n ")" ::: "memory")
#define PG8_BAR __builtin_amdgcn_s_barrier()
#define PG8_SCHED __builtin_amdgcn_sched_barrier(0)
    Unit cur, nxt; int ui = 0;
    if (!S.next(0, cur)) return;
    f32x4 acc[2][2][4][2];
#pragma unroll
    for (int a = 0; a < 2; ++a)
#pragma unroll
        for (int b = 0; b < 2; ++b)
#pragma unroll
            for (int m = 0; m < 4; ++m)
#pragma unroll
                for (int n = 0; n < 2; ++n) acc[a][b][m][n] = (f32x4){0.f, 0.f, 0.f, 0.f};
    bf16x8 At[4][2], B0[2][2], B1[2][2];
    const char* cA = (const char*)g.A + (size_t)cur.pm * tstep; const char* cB = (const char*)g.Bt + (size_t)cur.pn * tstep;
    S.a_ready(cur);
    if constexpr (SP2) {
        PG8_STAGE(PG8_SB(0, 0), cB, voffB); PG8_STAGE(PG8_SB(0, 1), cB + hstep, voffB); PG8_STAGE(PG8_SA(0, 0), cA, voffA); PG8_STAGE(PG8_SA(0, 1), cA + hstep, voffA);
        if (wr == 1) PG8_BAR;
        PG8_WAIT_V(2); PG8_BAR;
        PG8_STAGE(PG8_SB(1, 0), cB + kstep, voffB); PG8_STAGE(PG8_SA(1, 0), cA + kstep, voffA); PG8_STAGE(PG8_SB(1, 1), cB + hstep + kstep, voffB);
        PG8_WAIT_V(6); PG8_BAR;
    } else {
        PG8_STAGE(PG8_SB(0, 0), cB, voffB); PG8_STAGE(PG8_SA(0, 0), cA, voffA); PG8_STAGE(PG8_SB(0, 1), cB + hstep, voffB); PG8_STAGE(PG8_SA(0, 1), cA + hstep, voffA);
        if (wr == 1) PG8_BAR;
        PG8_WAIT_V(4); PG8_BAR;
        PG8_STAGE(PG8_SB(1, 0), cB + kstep, voffB); PG8_STAGE(PG8_SA(1, 0), cA + kstep, voffA); PG8_STAGE(PG8_SB(1, 1), cB + hstep + kstep, voffB);
        PG8_WAIT_V(6); PG8_BAR;
    }
    for (;;) {
        const bool has_next = S.next(ui + 1, nxt);
        const char* nA = has_next ? (const char*)g.A + (size_t)nxt.pm * tstep : cA; const char* nB = has_next ? (const char*)g.Bt + (size_t)nxt.pn * tstep : cB;
        for (int t = 0; t < nt; t += 2) {
            const bool last = (t == nt - 2);
            const char* a1 = cA + (size_t)(t + 1) * kstep;
            const char* a2 = last ? nA : cA + (size_t)(t + 2) * kstep; const char* b2 = last ? nB : cB + (size_t)(t + 2) * kstep;
            const char* a3 = a2 + kstep; const char* b3 = b2 + kstep;
            if (last && has_next) S.a_ready(nxt);
            if constexpr (SP2) {
            PG8_LDB(B0, 0, 0); PG8_LDB(B1, 0, 1); PG8_SCHED; PG8_LDA(At, 0, 0); PG8_STAGE(PG8_SA(1, 1), a1 + hstep, voffA);
            PG8_WAIT_V(8); PG8_WAIT_L(0); PG8_BAR; PG8_MMA(0, 0, At, B0); PG8_MMA(0, 1, At, B1); PG8_BAR; PG8_SCHED;
            PG8_LDA(At, 0, 1); PG8_STAGE(PG8_SB(0, 0), b2, voffB); PG8_STAGE(PG8_SB(0, 1), b2 + hstep, voffB); PG8_STAGE(PG8_SA(0, 0), a2, voffA);
            PG8_WAIT_V(8); PG8_WAIT_L(0); PG8_BAR; PG8_MMA(1, 0, At, B0); PG8_MMA(1, 1, At, B1); PG8_BAR; PG8_SCHED;
            PG8_LDB(B0, 1, 0); PG8_LDB(B1, 1, 1); PG8_SCHED; PG8_LDA(At, 1, 0); PG8_STAGE(PG8_SA(0, 1), a2 + hstep, voffA);
            PG8_WAIT_V(8); PG8_WAIT_L(0); PG8_BAR; PG8_MMA(0, 0, At, B0); PG8_MMA(0, 1, At, B1); PG8_BAR; PG8_SCHED;
            PG8_LDA(At, 1, 1); PG8_STAGE(PG8_SB(1, 0), b3, voffB); PG8_STAGE(PG8_SB(1, 1), b3 + hstep, voffB); PG8_STAGE(PG8_SA(1, 0), a3, voffA);
            PG8_WAIT_V(8); PG8_WAIT_L(0); PG8_BAR; PG8_MMA(1, 0, At, B0); PG8_MMA(1, 1, At, B1); PG8_BAR; PG8_SCHED;
            } else {
            PG8_LDB(B0, 0, 0); PG8_SCHED; PG8_LDA(At, 0, 0); PG8_STAGE(PG8_SA(1, 1), a1 + hstep, voffA);
            PG8_WAIT_L(8); PG8_BAR; PG8_WAIT_L(0); PG8_MMA(0, 0, At, B0); PG8_BAR; PG8_SCHED;
            PG8_LDB(B1, 0, 1); PG8_STAGE(PG8_SB(0, 0), b2, voffB);
            PG8_BAR; PG8_WAIT_L(0); PG8_MMA(0, 1, At, B1); PG8_BAR;
            PG8_LDA(At, 0, 1); PG8_STAGE(PG8_SA(0, 0), a2, voffA);
            PG8_BAR; PG8_WAIT_L(0); PG8_MMA(1, 0, At, B0); PG8_BAR; PG8_SCHED;
            PG8_STAGE(PG8_SB(0, 1), b2 + hstep, voffB);
            PG8_WAIT_V(6); PG8_BAR; PG8_MMA(1, 1, At, B1); PG8_BAR;
            PG8_LDB(B0, 1, 0); PG8_SCHED; PG8_LDA(At, 1, 0); PG8_STAGE(PG8_SA(0, 1), a2 + hstep, voffA);
            PG8_WAIT_L(8); PG8_BAR; PG8_WAIT_L(0); PG8_MMA(0, 0, At, B0); PG8_BAR; PG8_SCHED;
            PG8_LDB(B1, 1, 1); PG8_STAGE(PG8_SB(1, 0), b3, voffB);
            PG8_BAR; PG8_WAIT_L(0); PG8_MMA(0, 1, At, B1); PG8_BAR;
            PG8_LDA(At, 1, 1); PG8_STAGE(PG8_SA(1, 0), a3, voffA);
            PG8_BAR; PG8_WAIT_L(0); PG8_MMA(1, 0, At, B0); PG8_BAR; PG8_SCHED;
            PG8_STAGE(PG8_SB(1, 1), b3 + hstep, voffB);
            PG8_WAIT_V(6); PG8_BAR; PG8_MMA(1, 1, At, B1); PG8_BAR;
            }
        }
        if constexpr (ALIGN_EPI) { if (wr == 0) PG8_BAR; }
        if constexpr (!Epi::AFTER_DRAIN) { E(acc, cur, wr, wc, fr, fq); S.done(cur); }
        if (!has_next) break;
#pragma unroll
        for (int a = 0; a < 2; ++a)
#pragma unroll
            for (int b = 0; b < 2; ++b)
#pragma unroll
                for (int m = 0; m < 4; ++m)
#pragma unroll
                    for (int n = 0; n < 2; ++n) acc[a][b][m][n] = (f32x4){0.f, 0.f, 0.f, 0.f};
        cur = nxt; cA = nA; cB = nB; ++ui;
        if constexpr (ALIGN_EPI) { if (wr == 1) PG8_BAR; }
    }
    PG8_WAIT_V(0);
    if constexpr (!ALIGN_EPI) { if (wr == 0) PG8_BAR; }
    PG8_BAR;
    if constexpr (Epi::AFTER_DRAIN) { E.fused(acc, cur, wr, wc, fr, fq, lds, wid, lane); S.done(cur); }
#undef PG8_SA
#undef PG8_SB
#undef PG8_STAGE
#undef PG8_LDA
#undef PG8_LDB
#undef PG8_MMA
#undef PG8_CAT8
#undef PG8_WAIT_V
#undef PG8_WAIT_L
#undef PG8_BAR
#undef PG8_SCHED
}
}

constexpr int NWAVES = 8;
constexpr int BATCH = 2, SEQ = 8192, T = BATCH * SEQ, D = 1024;
constexpr int AB_IN = 1536, C_IN = 2304, C_OUT = 512;
constexpr int NE = 32, DE = 1024, PLE = 256;
constexpr int NSLOT = 73728;
constexpr float NORM_EPS = 1e-6f;
constexpr float LOG2_THETA = 13.287712379549449f;
constexpr float ATT_C2 = 0.125f * 1.4426950408889634f;

#define GAS __attribute__((address_space(1)))
#define LAS __attribute__((address_space(3)))
typedef unsigned short bf16;
typedef unsigned v4u __attribute__((ext_vector_type(4)));
typedef unsigned v2u __attribute__((ext_vector_type(2)));
typedef float f32x4 __attribute__((ext_vector_type(4)));
typedef GAS unsigned gu32;
#define RLX_AGENT __ATOMIC_RELAXED, __HIP_MEMORY_SCOPE_AGENT
#define LDS_WAIT() asm volatile("s_waitcnt lgkmcnt(0)" ::: "memory")
#define VM_WAIT() asm volatile("s_waitcnt vmcnt(0)" ::: "memory")

__device__ __forceinline__ int lane_opaque() { unsigned m = ~0u; asm volatile("" : "+s"(m)); return (int)__builtin_amdgcn_mbcnt_hi(m, __builtin_amdgcn_mbcnt_lo(m, 0u)); }
__device__ __forceinline__ int shx(int v, int m) { return __builtin_amdgcn_ds_bpermute((lane_opaque() ^ m) << 2, v); }
__device__ __forceinline__ float shx(float v, int m) { return __builtin_bit_cast(float, __builtin_amdgcn_ds_bpermute((lane_opaque() ^ m) << 2, __builtin_bit_cast(int, v))); }
__device__ __forceinline__ int shup(int v, int o) { const int l = lane_opaque(); const int s = (l - o) < 0 ? l : (l - o); return __builtin_amdgcn_ds_bpermute(s << 2, v); }
__device__ __forceinline__ int shl(int v, int src) { return __builtin_amdgcn_ds_bpermute(src << 2, v); }
typedef float f32x2_ __attribute__((ext_vector_type(2))); typedef __bf16 bf16x2_ __attribute__((ext_vector_type(2)));
__device__ __forceinline__ unsigned pk2(float lo, float hi) { f32x2_ v = {lo, hi}; bf16x2_ b = __builtin_convertvector(v, bf16x2_); return __builtin_bit_cast(unsigned, b); }
__device__ __forceinline__ float bflo(unsigned w) { return __builtin_bit_cast(float, w << 16); }
__device__ __forceinline__ float bfhi(unsigned w) { return __builtin_bit_cast(float, w & 0xffff0000u); }
#ifndef MOE_FP8_MASK
#define MOE_FP8_MASK 3
#endif
#ifndef F8_DIAG
#define F8_DIAG 0
#endif
constexpr float F8_EPI_SC = F8_DIAG ? (1.f / 64.f) : 1.f;
#ifndef Y_FP8
#define Y_FP8 1
#endif
#ifndef PLE_FP8
#define PLE_FP8 0
#endif
constexpr float Y_SC = 32.f;
constexpr int F8_WSC = 6;
__device__ __forceinline__ unsigned pk4_fp8(float a, float b, float c, float d) { int w = 0; w = __builtin_amdgcn_cvt_pk_fp8_f32(a, b, w, false); w = __builtin_amdgcn_cvt_pk_fp8_f32(c, d, w, true); return (unsigned)w; }
__device__ __forceinline__ float clamp448(float x) { return fminf(fmaxf(x, -448.f), 448.f); }
__device__ __forceinline__ float rnd_bf(float x) { return bflo(pk2(x, 0.f)); }
__device__ __forceinline__ float ssp_sum(const float* p) { const f32x4 a = *(const f32x4*)p, b = *(const f32x4*)(p + 4), c = *(const f32x4*)(p + 8), d = *(const f32x4*)(p + 12);
    return (((a.x + a.y) + (a.z + a.w)) + ((b.x + b.y) + (b.z + b.w))) + (((c.x + c.y) + (c.z + c.w)) + ((d.x + d.y) + (d.z + d.w))); }

constexpr size_t MiB = 1u << 20;
constexpr size_t al256(size_t x) { return (x + 255) & ~(size_t)255; }
constexpr size_t WS_CTL = 0, CTL_ZERO_BYTES = 1 * MiB;
constexpr size_t WS_WIN0T = 1 * MiB;
constexpr size_t WS_WOUT0T = WS_WIN0T + (size_t)AB_IN * D * 2;
constexpr size_t WS_WIN1T = WS_WOUT0T + (size_t)D * D * 2;
constexpr size_t WS_WOUT1T = WS_WIN1T + (size_t)C_IN * D * 2;
constexpr size_t WS_WGT = WS_WOUT1T + (size_t)D * C_OUT * 2;
constexpr size_t WS_WPT = WS_WGT + 2 * (size_t)D * D * 2;
constexpr size_t WS_WR = WS_WPT + 2 * (size_t)D * PLE * 2;
constexpr size_t WS_ROPE1 = al256(WS_WR + 2 * (size_t)NE * D * 4);
constexpr size_t WS_ROPEA = WS_ROPE1 + (size_t)SEQ * 32 * 8;
constexpr size_t WS_WUPT = WS_ROPEA + (size_t)SEQ * 32 * 8;
constexpr size_t WS_WDNT = WS_WUPT + 2 * (size_t)NE * 2 * DE * D * 2;
constexpr size_t WS_PBF = WS_WDNT + 2 * (size_t)NE * D * DE * 2;
constexpr size_t WS_PP = WS_PBF + 2 * (size_t)T * PLE * 2;
constexpr size_t WS_X0 = WS_PP + 2 * (size_t)T * D * 2;
constexpr size_t WS_HM = WS_X0 + (size_t)T * D * 2;
constexpr size_t WS_H2 = WS_HM + (size_t)T * D * 2;
constexpr size_t WS_H3 = WS_H2 + (size_t)T * D * 2;
constexpr size_t WS_OCAT = WS_H3 + (size_t)T * D * 2;
constexpr size_t WS_SSP = WS_OCAT + (size_t)T * D * 2;
constexpr size_t WS_LSE = WS_SSP + 3 * (size_t)T * 16 * 4;
constexpr size_t WS_TOPE = WS_LSE + 3 * (size_t)T * 8 * 4;
constexpr size_t WS_TOPG = WS_TOPE + (size_t)T * 16;
constexpr size_t WS_TOPPOS = WS_TOPG + (size_t)T * 16;
constexpr size_t WS_RSTD = WS_TOPPOS + (size_t)T * 16;
constexpr size_t WS_TOKSLOT = WS_RSTD + (size_t)T * 4;
constexpr size_t WS_SLOTGATE = WS_TOKSLOT + (size_t)T * 16;
constexpr size_t WS_SLOTRS = WS_SLOTGATE + (size_t)NSLOT * 4;
constexpr size_t WS_XTAB = al256(WS_SLOTRS + (size_t)NSLOT * 4);
constexpr size_t WS_CNTTAB = al256(WS_XTAB + 8 * 136 * 4);
constexpr size_t WS_XG = al256(WS_CNTTAB + 256 * 32 * 4);
constexpr size_t WS_ACT = WS_XG + (size_t)NSLOT * D * 2;
constexpr size_t WS_Y = WS_ACT + (size_t)NSLOT * D * 2;
constexpr size_t WS_Q3 = WS_Y + (size_t)NSLOT * D * 2;
constexpr size_t WS_K3 = WS_Q3 + 3 * (size_t)T * 512 * 2;
constexpr size_t WS_V3 = WS_K3 + 3 * (size_t)T * 128 * 2;
constexpr size_t WS_OGB = WS_V3 + 3 * (size_t)T * 128 * 2;
constexpr size_t WS_H2F8 = WS_OGB + 3 * (size_t)T * 512 * 2;
constexpr size_t WS_END = WS_H2F8 + (size_t)T * D;
constexpr int CW_TMO = 0;
constexpr int CW_CNT = 64;
constexpr int CW_BAR = 4096;

constexpr int LDSCTL_OFF = 0, MISC_OFF = 64;
constexpr int RING_OFF = 512, RING_BYTES = 131072;
constexpr int LDS_BYTES = 147456;

struct PPOrder {
    int G, c;
    __device__ __forceinline__ bool next(int i, pg8::Unit& u) const {
        int L; if (G == 256) { if (c < 128 || i >= 4) return false; L = (c - 128) * 4 + i; } else { L = i * G + c; if (L >= 512) return false; }
        u.pm = L >> 2; u.pn = 4 * (u.pm >> 6) + (L & 3); return true; }
    __device__ __forceinline__ void a_ready(const pg8::Unit&) const {}
    __device__ __forceinline__ void done(const pg8::Unit&) const {}
};
struct EpiPP {
    static constexpr bool PERM = true, AFTER_DRAIN = false;
    bf16* O;
    __device__ __forceinline__ void operator()(const pg8::f32x4 (&acc)[2][2][4][2], const pg8::Unit& u, int wr, int wc, int fr, int fq) const {
        const int row0 = u.pm * 256 + wr * 64 + fr, col0 = (u.pn & 3) * 256 + wc * 32 + 8 * fq;
#pragma unroll
        for (int ai = 0; ai < 2; ++ai)
#pragma unroll
            for (int m = 0; m < 4; ++m) { bf16* rp = O + (size_t)(row0 + ai * 128 + m * 16) * D + col0;
#pragma unroll
                for (int bj = 0; bj < 2; ++bj) { const pg8::f32x4 v0 = acc[ai][bj][m][0], v1 = acc[ai][bj][m][1];
                    pg8::u32x4 w; w.x = pk2(v0[0], v0[1]); w.y = pk2(v0[2], v0[3]); w.z = pk2(v1[0], v1[1]); w.w = pk2(v1[2], v1[3]);
                    *(pg8::u32x4*)(rp + bj * 128) = w; } }
    }
};
template <int LAYER> struct EpiQKV {
    static constexpr bool PERM = true, AFTER_DRAIN = false;
    const float* SS; const float* qg; const float* kg; const float* rope1; const float* ropea; bf16* Q3; bf16* K3; bf16* V3;
    __device__ __forceinline__ void operator()(const pg8::f32x4 (&acc)[2][2][4][2], const pg8::Unit& u, int wr, int wc, int fr, int fq) const {
        int kind, hd, grp;
        bool axial;
        if (LAYER == 0) { const int t3 = u.pn % 3; grp = u.pn / 3; axial = (grp == 0);
            if (t3 < 2) { kind = 0; hd = 4 * t3 + wc; } else if (wc < 2) { kind = 1; hd = wc; } else { kind = 2; hd = wc - 2; } }
        else { const int t3 = u.pn % 3; grp = u.pn / 3; axial = false;
            if (t3 < 2) { kind = 0; hd = 4 * t3 + wc; } else if (wc < 2) { kind = 1; hd = wc; } else { kind = 2; hd = wc - 2; } }
        const bool norm = axial && kind < 2, rope = kind < 2;
        float ga[8], gb[8];
        if (norm) { const float* g = (kind == 0) ? qg : kg;
#pragma unroll
            for (int t = 0; t < 8; ++t) { const int j = 8 * fq + t; const int d0 = (j < 16) ? j : j + 16; ga[t] = g[d0]; gb[t] = g[d0 + 16]; } }
        else {
#pragma unroll
            for (int t = 0; t < 8; ++t) { ga[t] = 1.f; gb[t] = 1.f; } }
        const float qs = (kind == 0) ? ATT_C2 : 1.f;
        const float* rtab = axial ? ropea : rope1;
        bf16* dst; int pitch;
        if (kind == 0) { dst = Q3 + (size_t)grp * T * 512 + hd * 64; pitch = 512; } else if (kind == 1) { dst = K3 + (size_t)grp * T * 128 + hd * 64; pitch = 128; } else { dst = V3 + (size_t)grp * T * 128 + hd * 64; pitch = 128; }
        const int row0 = u.pm * 256 + wr * 64 + fr;
#pragma unroll
        for (int ai = 0; ai < 2; ++ai)
#pragma unroll
            for (int m = 0; m < 4; ++m) {
                const int r = row0 + ai * 128 + m * 16; const int pos = r & (SEQ - 1);
                const float rs = __builtin_amdgcn_rsqf(ssp_sum(SS + (size_t)r * 16) * (1.f / D) + NORM_EPS);
                float a[8], b[8];
#pragma unroll
                for (int n = 0; n < 2; ++n)
#pragma unroll
                    for (int i = 0; i < 4; ++i) { a[4 * n + i] = acc[ai][0][m][n][i] * rs; b[4 * n + i] = acc[ai][1][m][n][i] * rs; }
                if (norm) { float ss = 0.f;
#pragma unroll
                    for (int t = 0; t < 8; ++t) ss += a[t] * a[t] + b[t] * b[t];
                    ss += shx(ss, 16); ss += shx(ss, 32);
                    const float rh = __builtin_amdgcn_rsqf(ss * (1.f / 64.f) + NORM_EPS);
#pragma unroll
                    for (int t = 0; t < 8; ++t) { a[t] *= rh * ga[t]; b[t] *= rh * gb[t]; } }
                if (rope) { const f32x4* cs = (const f32x4*)(rtab + ((size_t)pos * 32 + 8 * fq) * 2);
#pragma unroll
                    for (int t2 = 0; t2 < 4; ++t2) { const f32x4 v = cs[t2];
                        { const float x1 = a[2 * t2], x2 = b[2 * t2]; a[2 * t2] = x1 * v.x - x2 * v.y; b[2 * t2] = x2 * v.x + x1 * v.y; }
                        { const float x1 = a[2 * t2 + 1], x2 = b[2 * t2 + 1]; a[2 * t2 + 1] = x1 * v.z - x2 * v.w; b[2 * t2 + 1] = x2 * v.z + x1 * v.w; } } }
                size_t drow = r;
                if (LAYER == 1) { const int sh = 2 * grp, bb = r >> 13; drow = (size_t)bb * SEQ + (size_t)(pos & ((1 << sh) - 1)) * (SEQ >> sh) + (pos >> sh); }
                bf16* dp = dst + drow * pitch + 8 * fq;
                pg8::u32x4 w0, w1;
                w0.x = pk2(a[0] * qs, a[1] * qs); w0.y = pk2(a[2] * qs, a[3] * qs); w0.z = pk2(a[4] * qs, a[5] * qs); w0.w = pk2(a[6] * qs, a[7] * qs);
                w1.x = pk2(b[0] * qs, b[1] * qs); w1.y = pk2(b[2] * qs, b[3] * qs); w1.z = pk2(b[4] * qs, b[5] * qs); w1.w = pk2(b[6] * qs, b[7] * qs);
                *(pg8::u32x4*)dp = w0; *(pg8::u32x4*)(dp + 32) = w1;
                asm volatile("" ::: "memory");
            }
    }
};
struct EpiResBf16 {
    static constexpr bool PERM = true, AFTER_DRAIN = false;
    const bf16* R; bf16* O;
    __device__ __forceinline__ void operator()(const pg8::f32x4 (&acc)[2][2][4][2], const pg8::Unit& u, int wr, int wc, int fr, int fq) const {
        const int row0 = u.pm * 256 + wr * 64 + fr, col0 = u.pn * 256 + wc * 32 + 8 * fq;
#pragma unroll
        for (int ai = 0; ai < 2; ++ai)
#pragma unroll
            for (int m = 0; m < 4; ++m) { const size_t ro = (size_t)(row0 + ai * 128 + m * 16) * D + col0;
#pragma unroll
                for (int bj = 0; bj < 2; ++bj) { const pg8::f32x4 v0 = acc[ai][bj][m][0], v1 = acc[ai][bj][m][1]; const v4u rr = *(const v4u*)(R + ro + bj * 128);
                    pg8::u32x4 w; w.x = pk2(v0[0] + bflo(rr.x), v0[1] + bfhi(rr.x)); w.y = pk2(v0[2] + bflo(rr.y), v0[3] + bfhi(rr.y)); w.z = pk2(v1[0] + bflo(rr.z), v1[1] + bfhi(rr.z)); w.w = pk2(v1[2] + bflo(rr.w), v1[3] + bfhi(rr.w));
                    *(pg8::u32x4*)(O + ro + bj * 128) = w; }
                asm volatile("" ::: "memory"); }
    }
};
__device__ __forceinline__ float sigmoidf_(float x) { return __builtin_amdgcn_rcpf(1.0f + __builtin_amdgcn_exp2f(-1.4426950408889634f * x)); }
__device__ __forceinline__ float swiglu1(float g, float l) {
    g = fminf(g, 7.0f); l = fminf(fmaxf(l, -7.0f), 7.0f);
    return g * sigmoidf_(1.702f * g) * (l + 1.0f);
}
__device__ __forceinline__ f32x2_ swiglu2(f32x2_ g, f32x2_ l) {
    g = __builtin_elementwise_min(g, (f32x2_){7.0f, 7.0f}); l = __builtin_elementwise_min(__builtin_elementwise_max(l, (f32x2_){-7.0f, -7.0f}), (f32x2_){7.0f, 7.0f});
    const f32x2_ t = g * (-1.702f * 1.4426950408889634f); f32x2_ e; e.x = __builtin_amdgcn_exp2f(t.x); e.y = __builtin_amdgcn_exp2f(t.y);
    const f32x2_ d = e + 1.0f; f32x2_ s; s.x = __builtin_amdgcn_rcpf(d.x); s.y = __builtin_amdgcn_rcpf(d.y);
    return (g * s) * (l + 1.0f);
}
template <bool F8> struct EpiSwiglu {
    static constexpr bool PERM = true, AFTER_DRAIN = false;
    void* ACT; const float* bup; const float* rsl;
    __device__ __forceinline__ void operator()(const pg8::f32x4 (&acc)[2][2][4][2], const pg8::Unit& u, int wr, int wc, int fr, int fq) const {
        const int e = u.pn >> 3, j = u.pn & 7; const int row0 = u.pm * 256 + wr * 64 + fr, a0 = j * 128 + wc * 32 + 8 * fq;
        const float* bp = bup + (size_t)e * 2048 + 2 * a0; pg8::f32x4 b[4];
#pragma unroll
        for (int i = 0; i < 4; ++i) b[i] = *(const pg8::f32x4*)(bp + 4 * i);
#pragma unroll
        for (int ai = 0; ai < 2; ++ai)
#pragma unroll
            for (int m = 0; m < 4; ++m) { const int r = row0 + ai * 128 + m * 16; const float rs = F8 ? F8_EPI_SC : rsl[r];
                const pg8::f32x4 g0 = acc[ai][0][m][0] * rs, g1 = acc[ai][0][m][1] * rs, l0 = acc[ai][1][m][0] * rs, l1 = acc[ai][1][m][1] * rs;
                float o[8];
                { const f32x2_ r0 = swiglu2((f32x2_){g0[0] + b[0][0], g0[1] + b[0][2]}, (f32x2_){l0[0] + b[0][1], l0[1] + b[0][3]}), r1 = swiglu2((f32x2_){g0[2] + b[1][0], g0[3] + b[1][2]}, (f32x2_){l0[2] + b[1][1], l0[3] + b[1][3]});
                  const f32x2_ r2 = swiglu2((f32x2_){g1[0] + b[2][0], g1[1] + b[2][2]}, (f32x2_){l1[0] + b[2][1], l1[1] + b[2][3]}), r3 = swiglu2((f32x2_){g1[2] + b[3][0], g1[3] + b[3][2]}, (f32x2_){l1[2] + b[3][1], l1[3] + b[3][3]});
                  o[0] = r0.x; o[1] = r0.y; o[2] = r1.x; o[3] = r1.y; o[4] = r2.x; o[5] = r2.y; o[6] = r3.x; o[7] = r3.y; }
                if (F8) { v2u w; w.x = pk4_fp8(o[0], o[1], o[2], o[3]); w.y = pk4_fp8(o[4], o[5], o[6], o[7]); *(v2u*)((unsigned char*)ACT + (size_t)r * DE + a0) = w; }
                else { pg8::u32x4 w; w.x = pk2(o[0], o[1]); w.y = pk2(o[2], o[3]); w.z = pk2(o[4], o[5]); w.w = pk2(o[6], o[7]); *(pg8::u32x4*)((bf16*)ACT + (size_t)r * DE + a0) = w; } }
    }
};
struct EpiNull {
    static constexpr bool PERM = true, AFTER_DRAIN = false;
    float* O;
    __device__ __forceinline__ void operator()(const pg8::f32x4 (&acc)[2][2][4][2], const pg8::Unit& u, int wr, int wc, int fr, int fq) const {
        pg8::f32x4 s = {0.f, 0.f, 0.f, 0.f};
#pragma unroll
        for (int ai = 0; ai < 2; ++ai)
#pragma unroll
            for (int bj = 0; bj < 2; ++bj)
#pragma unroll
                for (int m = 0; m < 4; ++m)
#pragma unroll
                    for (int n = 0; n < 2; ++n) s += acc[ai][bj][m][n];
        *(pg8::f32x4*)(O + (size_t)(threadIdx.x + 512 * (u.pm & 63)) * 4) = s;
    }
};
template <bool Y8> struct EpiDown {
    static constexpr bool PERM = true, AFTER_DRAIN = false;
    void* Y; const float* bdn; const float* gate; float asc;
    __device__ __forceinline__ void operator()(const pg8::f32x4 (&acc)[2][2][4][2], const pg8::Unit& u, int wr, int wc, int fr, int fq) const {
        const int e = u.pn >> 2, j = u.pn & 3; const int row0 = u.pm * 256 + wr * 64 + fr, col0 = j * 256 + wc * 32 + 8 * fq;
        pg8::f32x4 bv[2][2];
#pragma unroll
        for (int bj = 0; bj < 2; ++bj)
#pragma unroll
            for (int n = 0; n < 2; ++n) bv[bj][n] = *(const pg8::f32x4*)(bdn + (size_t)e * D + col0 + bj * 128 + 4 * n);
#pragma unroll
        for (int ai = 0; ai < 2; ++ai)
#pragma unroll
            for (int m = 0; m < 4; ++m) { const int r = row0 + ai * 128 + m * 16; const float gt = gate[r] * (Y8 ? Y_SC : 1.f);
#pragma unroll
                for (int bj = 0; bj < 2; ++bj) { const pg8::f32x4 v0 = (acc[ai][bj][m][0] * asc + bv[bj][0]) * gt, v1 = (acc[ai][bj][m][1] * asc + bv[bj][1]) * gt;
                    if (Y8) { v2u w; w.x = pk4_fp8(clamp448(v0[0]), clamp448(v0[1]), clamp448(v0[2]), clamp448(v0[3])); w.y = pk4_fp8(clamp448(v1[0]), clamp448(v1[1]), clamp448(v1[2]), clamp448(v1[3])); *(v2u*)((unsigned char*)Y + (size_t)r * D + col0 + bj * 128) = w; }
                    else { pg8::u32x4 w; w.x = pk2(v0[0], v0[1]); w.y = pk2(v0[2], v0[3]); w.z = pk2(v1[0], v1[1]); w.w = pk2(v1[2], v1[3]); *(pg8::u32x4*)((bf16*)Y + (size_t)r * D + col0 + bj * 128) = w; } } }
    }
};
struct EpiPle {
    static constexpr bool PERM = true, AFTER_DRAIN = false;
    const bf16* H2; const bf16* PP; bf16* H3; float* SS;
    __device__ __forceinline__ void operator()(const pg8::f32x4 (&acc)[2][2][4][2], const pg8::Unit& u, int wr, int wc, int fr, int fq) const {
        const int row0 = u.pm * 256 + wr * 64 + fr, col0 = u.pn * 256 + wc * 32 + 8 * fq;
#pragma unroll
        for (int ai = 0; ai < 2; ++ai)
#pragma unroll
            for (int m = 0; m < 4; ++m) { const int r = row0 + ai * 128 + m * 16; const size_t ro = (size_t)r * D + col0; float ss = 0.f;
#pragma unroll
                for (int bj = 0; bj < 2; ++bj) { const pg8::f32x4 a0 = acc[ai][bj][m][0], a1 = acc[ai][bj][m][1]; const v4u h = *(const v4u*)(H2 + ro + bj * 128), p = *(const v4u*)(PP + ro + bj * 128);
                    pg8::u32x4 w;
                    w.x = pk2(bflo(h.x) + bflo(p.x) * sigmoidf_(a0[0]), bfhi(h.x) + bfhi(p.x) * sigmoidf_(a0[1])); w.y = pk2(bflo(h.y) + bflo(p.y) * sigmoidf_(a0[2]), bfhi(h.y) + bfhi(p.y) * sigmoidf_(a0[3]));
                    w.z = pk2(bflo(h.z) + bflo(p.z) * sigmoidf_(a1[0]), bfhi(h.z) + bfhi(p.z) * sigmoidf_(a1[1])); w.w = pk2(bflo(h.w) + bflo(p.w) * sigmoidf_(a1[2]), bfhi(h.w) + bfhi(p.w) * sigmoidf_(a1[3]));
                    *(pg8::u32x4*)(H3 + ro + bj * 128) = w;
                    ss += (bflo(w.x) * bflo(w.x) + bfhi(w.x) * bfhi(w.x)) + (bflo(w.y) * bflo(w.y) + bfhi(w.y) * bfhi(w.y)) + (bflo(w.z) * bflo(w.z) + bfhi(w.z) * bfhi(w.z)) + (bflo(w.w) * bflo(w.w) + bfhi(w.w) * bfhi(w.w)); }
                ss += shx(ss, 16); ss += shx(ss, 32);
                if (fq == 0) SS[(size_t)r * 16 + u.pn * 4 + wc] = ss;
                asm volatile("" ::: "memory"); }
    }
};
template <int LJ> struct XcdOrder {
    const int* tab; int rank, stride;
    __device__ __forceinline__ bool next(int i, pg8::Unit& u) const {
        const int q = i * stride + rank, p = q >> LJ, j = q & ((1 << LJ) - 1); const int ne = tab[0], tot = tab[1]; if (p >= tot) return false;
        int s = 0; while (s + 1 < ne && tab[4 + 4 * (s + 1) + 3] <= p) ++s;
        u.pm = tab[4 + 4 * s + 1] + (p - tab[4 + 4 * s + 3]); u.pn = (tab[4 + 4 * s] << LJ) + j; return true; }
    __device__ __forceinline__ void a_ready(const pg8::Unit&) const {}
    __device__ __forceinline__ void done(const pg8::Unit&) const {}
};
#include <hip/hip_bf16.h>
#include <cmath>
namespace attn_body {
using bf16=__hip_bfloat16;
using bf16x8=__attribute__((ext_vector_type(8)))short;
using s16x4=__attribute__((ext_vector_type(4)))short;
using f32x16=__attribute__((ext_vector_type(16)))float;
using u32x4=__attribute__((ext_vector_type(4)))unsigned;
constexpr int D=64,QP=512,KVP=128;
constexpr int NW=8,QBLK=32,QB=QBLK*NW,KVBLK=64;
constexpr int ATTN_UNIT_ROWS=QB;
__device__ __forceinline__ int crow(int r,int hi){return (r&3)+8*(r>>2)+4*hi;}
#define SBAR() __builtin_amdgcn_sched_barrier(0)
__device__ __forceinline__ void cmask(f32x16&p0,f32x16&p1,int jb,int qrel,int hi){
  const float NEG=-INFINITY; int kb=64*jb+4*hi;
  #pragma unroll
  for(int r=0;r<16;++r){int kv=kb+(r&3)+8*(r>>2); if(kv>qrel)p0[r]=NEG; if(kv+32>qrel)p1[r]=NEG;}
}

__device__ __forceinline__ void bmask(f32x16&p0,f32x16&p1,int t,int dqb,int W){
  const float NEG=-INFINITY; const int kb=64*t+dqb;
  #pragma unroll
  for(int r=0;r<16;++r){const int d=kb+(r&3)+8*(r>>2); if(d>W||d<-W)p0[r]=NEG; if(d+32>W||d+32<-W)p1[r]=NEG;}
}
constexpr int NSLOT=3, SLOTB=8192;
constexpr int LDS_K=0, LDS_V=NSLOT*SLOTB, LDS_WS=2*NSLOT*SLOTB, LDS_OST=LDS_WS+NW*64*4, LDS_BYTES=LDS_OST+NW*4096;
constexpr float C2=0.125f*1.4426950408889634f;
__device__ __forceinline__ void glds16(const void*gsrc,unsigned lds_dst){unsigned keep;
  asm volatile("s_mov_b32 %0, m0\n\ts_mov_b32 m0, %2\n\ts_nop 0\n\tglobal_load_lds_dwordx4 %1, off\n\ts_mov_b32 m0, %0":"=&s"(keep):"v"(gsrc),"s"(lds_dst):"memory");}
__device__ __forceinline__ float max3f(float a,float b,float c){float r;asm("v_max3_f32 %0, %1, %2, %3":"=v"(r):"v"(a),"v"(b),"v"(c));return r;}
__device__ __forceinline__ float max2f(float a,float b){float r;asm("v_max_f32_e32 %0, %1, %2":"=v"(r):"v"(a),"v"(b));return r;}
__device__ __forceinline__ float fadd_s(float a,float b){float r;asm("v_add_f32_e32 %0, %1, %2":"=v"(r):"v"(a),"v"(b));return r;}
__device__ __forceinline__ float fsub_s(float a,float b){float r;asm("v_sub_f32_e32 %0, %1, %2":"=v"(r):"v"(a),"v"(b));return r;}
typedef float f32x2_t __attribute__((ext_vector_type(2))); typedef __bf16 bf16x2_t __attribute__((ext_vector_type(2)));
__device__ __forceinline__ unsigned cvtpk_s(float lo,float hi){f32x2_t v={lo,hi};bf16x2_t b=__builtin_convertvector(v,bf16x2_t);return __builtin_bit_cast(unsigned,b);}
#define WAIT_BAR(N) asm volatile("s_waitcnt vmcnt(" #N ") lgkmcnt(0)\n\ts_barrier":::"memory")

__device__ __forceinline__ void qkt(f32x16&p0,f32x16&p1,const char*Kslot,const bf16x8*qr,const f32x16&negm,int r32,int hi){
  const char*kb=Kslot+hi*1024+r32*16;
  #pragma unroll
  for(int d0=0;d0<4;++d0){
    const bf16x8 b0=*reinterpret_cast<const bf16x8*>(kb+d0*2048);
    const bf16x8 b1=*reinterpret_cast<const bf16x8*>(kb+d0*2048+512);
    if(d0==0){p0=__builtin_amdgcn_mfma_f32_32x32x16_bf16(b0,qr[0],negm,0,0,0);p1=__builtin_amdgcn_mfma_f32_32x32x16_bf16(b1,qr[0],negm,0,0,0);}
    else{p0=__builtin_amdgcn_mfma_f32_32x32x16_bf16(b0,qr[d0],p0,0,0,0);p1=__builtin_amdgcn_mfma_f32_32x32x16_bf16(b1,qr[d0],p1,0,0,0);}}
}
typedef __attribute__((address_space(3))) const char* lds_cptr;
typedef short v4i16_t __attribute__((ext_vector_type(4)));
__device__ __forceinline__ void kload8(bf16x8*kf,lds_cptr kp){
  kf[0]=*(const __attribute__((address_space(3))) bf16x8*)(kp);      kf[1]=*(const __attribute__((address_space(3))) bf16x8*)(kp+512);
  kf[2]=*(const __attribute__((address_space(3))) bf16x8*)(kp+2048); kf[3]=*(const __attribute__((address_space(3))) bf16x8*)(kp+2560);
  kf[4]=*(const __attribute__((address_space(3))) bf16x8*)(kp+4096); kf[5]=*(const __attribute__((address_space(3))) bf16x8*)(kp+4608);
  kf[6]=*(const __attribute__((address_space(3))) bf16x8*)(kp+6144); kf[7]=*(const __attribute__((address_space(3))) bf16x8*)(kp+6656);
}
__device__ __forceinline__ void kload2(bf16x8*kf,lds_cptr kp,int j){ kf[2*j]=*(const __attribute__((address_space(3))) bf16x8*)(kp+j*2048); kf[2*j+1]=*(const __attribute__((address_space(3))) bf16x8*)(kp+j*2048+512); }
__device__ __forceinline__ s16x4 vtr(lds_cptr p){ return __builtin_bit_cast(s16x4,__builtin_amdgcn_ds_read_tr16_b64_v4i16((__attribute__((address_space(3))) v4i16_t*)p)); }
__device__ __forceinline__ float rowmax(const f32x16&p0,const f32x16&p1){
  float a=max3f(p0[0],p0[1],p1[0]),b=max3f(p0[2],p0[3],p1[1]);a=max3f(a,p1[2],p1[3]);
  #pragma unroll
  for(int r=4;r<16;r+=4){a=max3f(a,p0[r],p0[r+1]);b=max3f(b,p0[r+2],p0[r+3]);a=max3f(a,p1[r],p1[r+1]);b=max3f(b,p1[r+2],p1[r+3]);}
  const float m=max2f(a,b);
  auto rr=__builtin_amdgcn_permlane32_swap(__float_as_uint(m),__float_as_uint(m),false,false);
  return max2f(__uint_as_float(rr[0]),__uint_as_float(rr[1]));
}
__device__ __forceinline__ void pv(f32x16*o,int vb,bf16x8 pa0,bf16x8 pa1,bf16x8 pa2,bf16x8 pa3){
  #pragma unroll
  for(int d0=0;d0<2;++d0){s16x4 lo[4],hi[4];
    #pragma unroll
    for(int ks=0;ks<4;++ks){
      asm volatile("ds_read_b64_tr_b16 %0,%1 offset:%c2":"=&v"(lo[ks]):"v"(vb),"i"(d0*4096+ks*1024):"memory");
      asm volatile("ds_read_b64_tr_b16 %0,%1 offset:%c2":"=&v"(hi[ks]):"v"(vb),"i"(d0*4096+ks*1024+512):"memory");}
    asm volatile("s_waitcnt lgkmcnt(0)":::"memory");SBAR();
    #define PK(k) (bf16x8){lo[k][0],lo[k][1],lo[k][2],lo[k][3],hi[k][0],hi[k][1],hi[k][2],hi[k][3]}
    o[d0]=__builtin_amdgcn_mfma_f32_32x32x16_bf16(pa0,PK(0),o[d0],0,0,0);
    o[d0]=__builtin_amdgcn_mfma_f32_32x32x16_bf16(pa1,PK(1),o[d0],0,0,0);
    o[d0]=__builtin_amdgcn_mfma_f32_32x32x16_bf16(pa2,PK(2),o[d0],0,0,0);
    o[d0]=__builtin_amdgcn_mfma_f32_32x32x16_bf16(pa3,PK(3),o[d0],0,0,0);
    #undef PK
  }
}

#ifndef ATTN_STORE16
#define ATTN_STORE16(p,v) (*(u32x4*)(p)=(v))
#endif
template<int MODE,int OP,int THRL,int HPU=1> __device__ __forceinline__ void attn_unit(const bf16*Qu,const bf16*__restrict__ Ku,const bf16*__restrict__ Vu,bf16*Ou,int NT,int dq0,int W,float sinkl2,bool has_sink,float*lse,char*shm){
  int tid_=threadIdx.x; asm volatile("":"+v"(tid_));
  const int tid=tid_,lane=tid&63,r32=lane&31,hi=lane>>5; const int wid=__builtin_amdgcn_readfirstlane(tid>>6);
  const int wh=(HPU==1)?0:wid/(8/HPU), wrow=(HPU==1)?wid:wid%(8/HPU);
  const bf16*Qw=Qu+(long)(wrow*QBLK)*QP+wh*D;
  const unsigned lds0=(unsigned)(uintptr_t)shm;
  float*wsf=(float*)(shm+LDS_WS)+wid*64;
  const bf16*ksrc=Ku+(long)lane*KVP+wid*8;
  const bf16*vsrc=Vu+(long)(16*(wid&3)+(lane>>2))*KVP+(wid>>2)*32+(lane&3)*8;
  const unsigned kdst=lds0+LDS_K+wid*1024, vdst=lds0+LDS_V+wid*1024;
  #define DMA_K(t,slot) glds16(ksrc+(long)(t)*KVBLK*KVP,(unsigned)__builtin_amdgcn_readfirstlane(kdst+(slot)))
  #define DMA_V(t,slot) glds16(vsrc+(long)(t)*KVBLK*KVP,(unsigned)__builtin_amdgcn_readfirstlane(vdst+(slot)))
  const int vb0=(int)(lds0+LDS_V)+((lane>>4)&1)*32+(lane&3)*8+(4*hi+((lane&15)>>2))*64;
  const char*Kbase=shm+LDS_K; bf16x8 kf[8];
  const lds_cptr shm3=(lds_cptr)shm; const lds_cptr kp0=shm3+LDS_K+hi*1024+r32*16; const lds_cptr vp0=shm3+LDS_V+((lane>>4)&1)*32+(lane&3)*8+(4*hi+((lane&15)>>2))*64;
  DMA_K(0,0);DMA_V(0,0);DMA_K(1,SLOTB);
  bf16x8 qr[4];
  #pragma unroll
  for(int d0=0;d0<4;++d0)qr[d0]=*reinterpret_cast<const bf16x8*>(&Qw[(long)r32*QP+d0*16+hi*8]);
  float mhat=0.f,l_reg=0.f;f32x16 o[2];o[0]=f32x16{};o[1]=f32x16{};f32x16 negm=f32x16{};asm volatile("":"+v"(negm));
  const int dqb=dq0-(wrow*QBLK+r32)+4*hi;
  #define CMASK(P0,P1,t) do{ if(MODE==1) bmask(P0,P1,(t),dqb,W); }while(0)
  bool resc=false;
  #define START(P0,P1) do{ float rm=rowmax(P0,P1); if(MODE==1) rm=fmaxf(rm,-60.f); resc=false; \
    { const float dl=rm; mhat=fadd_s(mhat,dl); \
      _Pragma("unroll") for(int r=0;r<16;++r){P0[r]=fsub_s(P0[r],dl);P1[r]=fsub_s(P1[r],dl);} \
      _Pragma("unroll") for(int r=0;r<16;++r)negm[r]=-mhat; asm volatile("":"+v"(negm)); } \
    _Pragma("unroll") for(int r=0;r<16;++r)P0[r]=__builtin_amdgcn_exp2f(P0[r]); }while(0)
  #define RESC() do{ if(resc){ asm volatile("s_waitcnt lgkmcnt(0)":::"memory"); \
      _Pragma("unroll") for(int d_=0;d_<2;++d_) _Pragma("unroll") for(int r=0;r<16;++r)o[d_][r]*=wsf[crow(r,hi)]; } }while(0)
  f32x16 pA0,pA1,pB0,pB1;
  int sl_prev=0,sl_cur=0,sl_next=SLOTB;
  #define ROT() do{sl_prev=sl_cur;sl_cur=sl_next;sl_next=(sl_next==(NSLOT-1)*SLOTB)?0:sl_next+SLOTB;}while(0)
  DMA_K(2,2*SLOTB);
  WAIT_BAR(3);
  qkt(pA0,pA1,Kbase,qr,negm,r32,hi);asm volatile("s_nop 15\n\ts_nop 7":"+v"(pA0),"+v"(pA1));CMASK(pA0,pA1,0);
  START(pA0,pA1);
  _Pragma("unroll") for(int r=0;r<16;++r)pA1[r]=__builtin_amdgcn_exp2f(pA1[r]);
  WAIT_BAR(0);
  DMA_K(3,0);DMA_V(1,SLOTB);
  ROT();
  kload8(kf,kp0+sl_cur);
  WAIT_BAR(2);
  s16x4 vlo[8],vhi[8]; u32x4 pw0,pw1,pw2,pw3;
  #define PKW(P,B) cvtpk_s(P[B],P[B+1])
  #define PAF(k) __builtin_bit_cast(bf16x8,pw##k)
  #define VFR(i) (bf16x8){vlo[i][0],vlo[i][1],vlo[i][2],vlo[i][3],vhi[i][0],vhi[i][1],vhi[i][2],vhi[i][3]}
  #define PIN(x) asm volatile("":"+v"(x))
  #define MX3(a,b,c) __builtin_fmaxf(__builtin_fmaxf((a),(b)),(c))
  #define GAPA(MF,A0,A1,A2,A3,W0,W1,PW) do{ MF; sacc+=A0; sacc+=A1; sacc+=A2; sacc+=A3; PIN(sacc); W0; W1; PIN(PW); SBAR(); }while(0)
  #define EX(v) __builtin_amdgcn_exp2f(v)
  #define GAPB(MF,X,B) do{ MF; X[B]=EX(X[B]); X[B+1]=EX(X[B+1]); X[B+2]=EX(X[B+2]); X[B+3]=EX(X[B+3]); PIN(X); SBAR(); }while(0)
  #define VRD(i) do{ vlo[i]=vtr(vp_+(((i)>>2)*4096+((i)&3)*1024)); vhi[i]=vtr(vp_+(((i)>>2)*4096+((i)&3)*1024+512)); }while(0)
  #define KRD(G,j) do{ if(G){ kload2(kf,kp0+sl_next,j); SBAR(); } }while(0)
  #define STEP(C0,C1,P0,P1,t,GK,GV,GL) do{ SBAR(); \
    const lds_cptr vp_=vp0+sl_prev; \
    VRD(0); SBAR(); float sacc=(P0[0]+P0[1]); \
    GAPA(C0=__builtin_amdgcn_mfma_f32_32x32x16_bf16(kf[0],qr[0],negm,0,0,0), P0[2],P0[3],P0[4],P0[5],     pw0[0]=PKW(P0,0), pw0[1]=PKW(P0,2), pw0); \
    VRD(4); SBAR(); GAPA(C1=__builtin_amdgcn_mfma_f32_32x32x16_bf16(kf[1],qr[0],negm,0,0,0), P0[6],P0[7],P0[8],P0[9],     pw0[2]=PKW(P0,4), pw0[3]=PKW(P0,6), pw0); \
    VRD(1); SBAR(); GAPA(C0=__builtin_amdgcn_mfma_f32_32x32x16_bf16(kf[2],qr[1],C0,0,0,0),   P0[10],P0[11],P0[12],P0[13], pw1[0]=PKW(P0,8), pw1[1]=PKW(P0,10), pw1); \
    VRD(5); SBAR(); GAPA(C1=__builtin_amdgcn_mfma_f32_32x32x16_bf16(kf[3],qr[1],C1,0,0,0),   P0[14],P0[15],P1[0],P1[1],   pw1[2]=PKW(P0,12),pw1[3]=PKW(P0,14), pw1); \
    VRD(2); SBAR(); GAPA(C0=__builtin_amdgcn_mfma_f32_32x32x16_bf16(kf[4],qr[2],C0,0,0,0),   P1[2],P1[3],P1[4],P1[5],     pw2[0]=PKW(P1,0), pw2[1]=PKW(P1,2), pw2); \
    VRD(6); SBAR(); GAPA(C1=__builtin_amdgcn_mfma_f32_32x32x16_bf16(kf[5],qr[2],C1,0,0,0),   P1[6],P1[7],P1[8],P1[9],     pw2[2]=PKW(P1,4), pw2[3]=PKW(P1,6), pw2); \
    VRD(3); SBAR(); GAPA(C0=__builtin_amdgcn_mfma_f32_32x32x16_bf16(kf[6],qr[3],C0,0,0,0),   P1[10],P1[11],P1[12],P1[13], pw3[0]=PKW(P1,8), pw3[1]=PKW(P1,10), pw3); \
    VRD(7); SBAR(); GAPA(C1=__builtin_amdgcn_mfma_f32_32x32x16_bf16(kf[7],qr[3],C1,0,0,0),   P1[14],P1[15],0.f,0.f,       pw3[2]=PKW(P1,12),pw3[3]=PKW(P1,14), pw3); \
    l_reg+=sacc; \
    if(GK){DMA_K((t)+3,sl_cur);} if(GV){DMA_V((t)+1,sl_next);} \
    CMASK(C0,C1,t); \
    { float a=MX3(C0[0],C0[1],C1[0]),b=MX3(C0[2],C0[3],C1[1]); a=MX3(a,C1[2],C1[3]); \
      _Pragma("unroll") for(int r=4;r<16;r+=4){a=MX3(a,C0[r],C0[r+1]);b=MX3(b,C0[r+2],C0[r+3]);a=MX3(a,C1[r],C1[r+1]);b=MX3(b,C1[r+2],C1[r+3]);} \
      float rm=__builtin_fmaxf(a,b); { auto rr=__builtin_amdgcn_permlane32_swap(__float_as_uint(rm),__float_as_uint(rm),false,false); rm=__builtin_fmaxf(__uint_as_float(rr[0]),__uint_as_float(rr[1])); } \
      resc=false; \
      if(__builtin_expect(__any(rm>(float)THRL),0)){ const float dl=__builtin_fmaxf(rm,0.f); mhat+=dl; \
        _Pragma("unroll") for(int r=0;r<16;++r){C0[r]-=dl;C1[r]-=dl;} \
        _Pragma("unroll") for(int r=0;r<16;++r)negm[r]=-mhat; asm volatile("":"+v"(negm)); \
        const float f=__builtin_amdgcn_exp2f(-dl); l_reg*=f; if(hi==0)wsf[r32]=f; resc=true; } } \
    SBAR(); \
    GAPB(o[0]=__builtin_amdgcn_mfma_f32_32x32x16_bf16(PAF(0),VFR(0),o[0],0,0,0), C0,0); \
    GAPB(o[1]=__builtin_amdgcn_mfma_f32_32x32x16_bf16(PAF(0),VFR(4),o[1],0,0,0), C0,4); \
    KRD(GL,0); GAPB(o[0]=__builtin_amdgcn_mfma_f32_32x32x16_bf16(PAF(1),VFR(1),o[0],0,0,0), C0,8); \
    KRD(GL,1); GAPB(o[1]=__builtin_amdgcn_mfma_f32_32x32x16_bf16(PAF(1),VFR(5),o[1],0,0,0), C0,12); \
    KRD(GL,2); GAPB(o[0]=__builtin_amdgcn_mfma_f32_32x32x16_bf16(PAF(2),VFR(2),o[0],0,0,0), C1,0); \
    KRD(GL,3); GAPB(o[1]=__builtin_amdgcn_mfma_f32_32x32x16_bf16(PAF(2),VFR(6),o[1],0,0,0), C1,4); \
    GAPB(o[0]=__builtin_amdgcn_mfma_f32_32x32x16_bf16(PAF(3),VFR(3),o[0],0,0,0), C1,8); \
    GAPB(o[1]=__builtin_amdgcn_mfma_f32_32x32x16_bf16(PAF(3),VFR(7),o[1],0,0,0), C1,12); \
    }while(0)
  int t=1;
  for(;t+5<NT;t+=2){
    STEP(pB0,pB1,pA0,pA1,t,true,true,true);     WAIT_BAR(2); RESC(); ROT();
    STEP(pA0,pA1,pB0,pB1,t+1,true,true,true);   WAIT_BAR(2); RESC(); ROT();
  }
  #define ENDW(tt) do{ if((tt)+3<NT){WAIT_BAR(2);} else if((tt)+2<NT){WAIT_BAR(1);} else {WAIT_BAR(0);} }while(0)
  for(;t+1<NT;t+=2){
    STEP(pB0,pB1,pA0,pA1,t,(t+3<NT),(t+1<NT),(t+1<NT));       ENDW(t);   RESC(); ROT();
    STEP(pA0,pA1,pB0,pB1,t+1,(t+4<NT),(t+2<NT),(t+2<NT));     ENDW(t+1); RESC(); ROT();
  }
  STEP(pB0,pB1,pA0,pA1,NT-1,false,false,false); RESC();
  { float sacc=pB0[0]+pB0[1]; _Pragma("unroll") for(int r=2;r<16;++r)sacc+=pB0[r]; _Pragma("unroll") for(int r=0;r<16;++r)sacc+=pB1[r]; l_reg+=sacc;
    pw0=(u32x4){PKW(pB0,0),PKW(pB0,2),PKW(pB0,4),PKW(pB0,6)};pw1=(u32x4){PKW(pB0,8),PKW(pB0,10),PKW(pB0,12),PKW(pB0,14)};pw2=(u32x4){PKW(pB1,0),PKW(pB1,2),PKW(pB1,4),PKW(pB1,6)};pw3=(u32x4){PKW(pB1,8),PKW(pB1,10),PKW(pB1,12),PKW(pB1,14)};
    SBAR(); pv(o,vb0+sl_cur,PAF(0),PAF(1),PAF(2),PAF(3)); }
  #undef PKW
  #undef PAF
  #undef VFR
  #undef PIN
  #undef MX3
  #undef GAPA
  #undef GAPB
  #undef EX
  #undef VRD
  #undef KRD
  #undef STEP
  #undef ENDW
  {auto rr=__builtin_amdgcn_permlane32_swap(__float_as_uint(l_reg),__float_as_uint(l_reg),false,false);l_reg=__uint_as_float(rr[0])+__uint_as_float(rr[1]);}
  if(MODE==1){ if(has_sink) l_reg+=__builtin_amdgcn_exp2f(sinkl2-mhat); if(lse!=nullptr&&hi==0) lse[(long)(wrow*QBLK+r32)*8+wh]=0.6931471805599453f*(mhat+__builtin_amdgcn_logf(l_reg)); }
  if(hi==0)wsf[32+r32]=l_reg;asm volatile("s_waitcnt lgkmcnt(0)":::"memory");
  float rli[16];
  #pragma unroll
  for(int r=0;r<16;++r)rli[r]=__builtin_amdgcn_rcpf(wsf[32+crow(r,hi)]);
  bf16*Ow=Ou+(long)(wrow*QBLK)*OP+wh*D;
  { bf16*stg=(bf16*)(shm+LDS_OST)+wid*2048;
    #pragma unroll
    for(int r=0;r<16;++r){const int orow=crow(r,hi);
      #pragma unroll
      for(int d0=0;d0<2;++d0)stg[orow*64+d0*32+r32]=__float2bfloat16(o[d0][r]*rli[r]);}
    asm volatile("s_waitcnt lgkmcnt(0)":::"memory");
    #pragma unroll
    for(int i=0;i<4;++i){const int row=i*8+(lane>>3),ch=lane&7; const u32x4 v=*(const u32x4*)(stg+row*64+ch*8); ATTN_STORE16(Ow+(long)row*OP+ch*8,v);} }
  asm volatile("s_waitcnt lgkmcnt(0)\n\ts_barrier":::"memory");
  #undef DMA_K
  #undef DMA_V
  #undef CMASK
  #undef START
  #undef RESC
  #undef ROT
}
constexpr int ATTN_LDS_BYTES=LDS_BYTES;
#undef SBAR
#undef WAIT_BAR
}
#define XB_TMO      128
#define XB_XCNT(j)  (256  + 64 * (j))
#define XB_XSUB(j)  (1280 + 64 * (j))
#define XB_XGEN(j)  (2304 + 64 * (j))
#define XB_TOP      3328
#define XB_TOPGEN   3392
#define XCD_BAR_WORDS 3456
#define XB_SPIN_CAP (1u << 18)

__device__ __forceinline__ unsigned xb_ld(unsigned* p)              { return __hip_atomic_load(p, __ATOMIC_RELAXED, __HIP_MEMORY_SCOPE_AGENT); }
__device__ __forceinline__ unsigned xb_add(unsigned* p, unsigned v) { return __hip_atomic_fetch_add(p, v, __ATOMIC_RELAXED, __HIP_MEMORY_SCOPE_AGENT); }
__device__ __forceinline__ unsigned xb_xcc_id() { return (unsigned)__builtin_amdgcn_s_getreg((3 << 11) | 20) & 0xFu; }
#define XB_SPIN(cond, bar) do { unsigned _sp = 0; while (cond) { __builtin_amdgcn_s_sleep(1); \
    if ((++_sp & 255u) == 0u) { if (xb_ld(&(bar)[XB_TMO])) break; if (_sp > XB_SPIN_CAP) { atomicAdd(&(bar)[XB_TMO], 1u); break; } } } } while (0)

struct XcdBarrier {
    unsigned* bar; unsigned x;
    volatile LAS unsigned* st;
};

__device__ __forceinline__ XcdBarrier xcd_barrier_post(unsigned* bar, volatile LAS unsigned* st) {
    XcdBarrier b; b.bar = bar; b.x = xb_xcc_id(); b.st = st;
    if (threadIdx.x == 0) (void)xb_add(&bar[XB_XCNT(b.x)], 1u);
    return b;
}
__device__ __forceinline__ void xcd_barrier_complete(unsigned* bar, unsigned x, unsigned& nloc, unsigned& nx) {
    const unsigned G = gridDim.x * gridDim.y * gridDim.z;
    unsigned sum, cnt, mine, sp = 0u;
    for (;;) {
        sum = 0u; cnt = 0u; mine = 0u;
#pragma unroll
        for (unsigned j = 0; j < 16; ++j) { const unsigned c = xb_ld(&bar[XB_XCNT(j)]); sum += c; cnt += (c > 0u) ? 1u : 0u; mine = (j == x) ? c : mine; }
        if (sum == G) break;
        __builtin_amdgcn_s_sleep(1);
        if ((++sp & 255u) == 0u) { if (xb_ld(&bar[XB_TMO])) break; if (sp > XB_SPIN_CAP) { atomicAdd(&bar[XB_TMO], 1u); break; } }
    }
    nloc = mine > 0u ? mine : 1u; nx = cnt > 0u ? cnt : 1u;
}

__device__ __forceinline__ void xcd_barrier(const XcdBarrier& b) {
    asm volatile("s_waitcnt vmcnt(0)" ::: "memory");
    __syncthreads();
    if (threadIdx.x == 0) {
        unsigned* bar = b.bar;
        __builtin_amdgcn_s_waitcnt(0);
        unsigned nloc = b.st[0], nx = b.st[1];
        if (nloc == 0u) { xcd_barrier_complete(bar, b.x, nloc, nx); b.st[0] = nloc; b.st[1] = nx; }
        const unsigned old = xb_add(&bar[XB_XSUB(b.x)], 1u);
        const unsigned gen = old / nloc;
        if (old + 1u == (gen + 1u) * nloc) {
            __builtin_amdgcn_fence(__ATOMIC_RELEASE, "agent");
            asm volatile("s_waitcnt vmcnt(0)" ::: "memory");
            const unsigned og = xb_add(&bar[XB_TOP], 1u);
            const unsigned tg = og / nx;
            if (og + 1u == (tg + 1u) * nx) xb_add(&bar[XB_TOPGEN], 1u);
            else XB_SPIN(xb_ld(&bar[XB_TOPGEN]) == tg, bar);
            __builtin_amdgcn_fence(__ATOMIC_ACQUIRE, "agent");
            xb_add(&bar[XB_XGEN(b.x)], 1u);
            asm volatile("s_waitcnt vmcnt(0)" ::: "memory");
        } else {
            XB_SPIN(xb_ld(&bar[XB_XGEN(b.x)]) == gen, bar);
            __builtin_amdgcn_fence(__ATOMIC_ACQUIRE, "agent");
            asm volatile("s_waitcnt vmcnt(0)" ::: "memory");
        }
    }
    __syncthreads();
}

struct Frame {
    LAS unsigned char* lds;
    volatile LAS unsigned* MISC;
    gu32* ctl;
    int tid, lane, wave, vcu, G, bx;
    int gw, NGW;
};
__device__ __forceinline__ bool refresh(Frame& F) {
    int t = threadIdx.x; asm volatile("" : "+v"(t)); F.tid = t; F.lane = t & 63; F.wave = __builtin_amdgcn_readfirstlane(t >> 6);
    int bx = blockIdx.x, G = gridDim.x; asm volatile("" : "+s"(bx), "+s"(G)); F.bx = bx; F.G = G;
    F.vcu = (G % 8 == 0) ? (bx % 8) * (G / 8) + bx / 8 : bx; F.gw = F.vcu * NWAVES + F.wave; F.NGW = G * NWAVES; return true; }
__device__ __forceinline__ float wave_sum(float v) {
#pragma unroll
    for (int o = 1; o < 64; o <<= 1) v += shx(v, o);
    return v;
}
template <int MAP> __device__ __forceinline__ int rowmap(int n) {
    if (MAP == 1) { const int f = n >> 1; return 256 * (f >> 7) + 128 * (n & 1) + (f & 127); }
    if (MAP == 2 || MAP == 3) { const int tl = n >> 8, hh = (n >> 6) & 3, d = n & 63; int bj, j;
        const bool axial = (MAP == 2) && (tl < 2 || (tl == 2 && hh < 2));
        if (axial) { bj = (d >> 4) & 1; j = (d & 15) + ((d >> 5) << 4); } else { bj = d >> 5; j = d & 31; }
        return 256 * tl + 128 * bj + 32 * hh + j; }
    return n; }
struct TrTile { const float* W; bf16* WT; const float* gain; int K, N, k0, n0; };
__device__ __forceinline__ void tr_load(const TrTile& t, f32x4 (&v)[16], int lane) {
    const float* src = t.W + (size_t)(t.k0 + (lane >> 4)) * t.N + t.n0 + 4 * (lane & 15);
#pragma unroll
    for (int i = 0; i < 16; ++i) v[i] = __builtin_nontemporal_load((const f32x4*)(src + (size_t)(4 * i) * t.N));
}
template <int MAP> __device__ __forceinline__ void tr_store(const TrTile& t, f32x4 (&v)[16], LAS float* scr, int lane) {
    const int lr = lane >> 4, lc = lane & 15;
    if (t.gain) {
#pragma unroll
        for (int i = 0; i < 16; ++i) v[i] *= t.gain[t.k0 + 4 * i + lr]; }
#pragma unroll
    for (int i = 0; i < 16; ++i) { LAS float* p = scr + (4 * i + lr) * 65 + 4 * lc; p[0] = v[i].x; p[1] = v[i].y; p[2] = v[i].z; p[3] = v[i].w; }
    LDS_WAIT(); asm volatile("" ::: "memory");
    const int c = lane & 7;
#pragma unroll
    for (int j = 0; j < 8; ++j) { const int n = 8 * j + (lane >> 3); const LAS float* s = scr + (8 * c) * 65 + n;
        v4u o; o.x = pk2(s[0 * 65], s[1 * 65]); o.y = pk2(s[2 * 65], s[3 * 65]); o.z = pk2(s[4 * 65], s[5 * 65]); o.w = pk2(s[6 * 65], s[7 * 65]);
        *(GAS v4u*)(t.WT + (size_t)rowmap<MAP>(t.n0 + n) * t.K + t.k0 + 8 * c) = o; }
    LDS_WAIT(); asm volatile("" ::: "memory");
}
template <int MAP> __device__ __forceinline__ void transpose_family(Frame& F, const float* W, size_t sW, bf16* WT, size_t sWT, const float* gain, int sG, int K, int N, int nmat, int gdiv) {
    LAS float* scr = (LAS float*)(F.lds + RING_OFF) + F.wave * (128 * 33);
    const int nb = N / 64, per = (K / 64) * nb, total = per * nmat;
    f32x4 va[16], vb[16];
    int it = F.gw; if (it >= total) return;
    TrTile ta, tb;
#define TR_SETUP(tt, item) do { const int mi = (item) / per, r = (item) % per; tt.W = W + (size_t)mi * sW; tt.WT = WT + (size_t)mi * sWT; tt.gain = gain ? gain + (size_t)(mi / gdiv) * sG : nullptr; tt.K = K; tt.N = N; tt.k0 = 64 * (r / nb); tt.n0 = 64 * (r % nb); } while (0)
    TR_SETUP(ta, it); tr_load(ta, va, F.lane);
    for (;;) {
        const int it2 = it + F.NGW; const bool h2 = it2 < total;
        if (h2) { TR_SETUP(tb, it2); tr_load(tb, vb, F.lane); }
        tr_store<MAP>(ta, va, scr, F.lane);
        if (!h2) break;
        const int it3 = it2 + F.NGW; const bool h3 = it3 < total;
        if (h3) { TR_SETUP(ta, it3); tr_load(ta, va, F.lane); }
        tr_store<MAP>(tb, vb, scr, F.lane);
        if (!h3) break;
        it = it3;
    }
#undef TR_SETUP
}
__device__ __forceinline__ void tr8_load(const TrTile& t, f32x4 (&v)[16], int lane) {
    const float* src = t.W + (size_t)(t.k0 + (lane >> 3)) * t.N + t.n0 + 4 * (lane & 7);
#pragma unroll
    for (int i = 0; i < 16; ++i) v[i] = __builtin_nontemporal_load((const f32x4*)(src + (size_t)(8 * i) * t.N));
}
template <int MAP> __device__ __forceinline__ void tr8_store(const TrTile& t, f32x4 (&v)[16], LAS float* scr, int lane) {
    const int lr = lane >> 3, lc = lane & 7; const float sc = (float)(1 << F8_WSC);
#pragma unroll
    for (int i = 0; i < 16; ++i) { const float g = t.gain ? t.gain[t.k0 + 8 * i + lr] * sc : sc; LAS float* p = scr + (8 * i + lr) * 33 + 4 * lc; p[0] = v[i].x * g; p[1] = v[i].y * g; p[2] = v[i].z * g; p[3] = v[i].w * g; }
    LDS_WAIT(); asm volatile("" ::: "memory");
    const int c = lane & 7;
#pragma unroll
    for (int j = 0; j < 4; ++j) { const int n = 8 * j + (lane >> 3); const LAS float* s = scr + (16 * c) * 33 + n;
        v4u o; o.x = pk4_fp8(s[0 * 33], s[1 * 33], s[2 * 33], s[3 * 33]); o.y = pk4_fp8(s[4 * 33], s[5 * 33], s[6 * 33], s[7 * 33]); o.z = pk4_fp8(s[8 * 33], s[9 * 33], s[10 * 33], s[11 * 33]); o.w = pk4_fp8(s[12 * 33], s[13 * 33], s[14 * 33], s[15 * 33]);
        *(GAS v4u*)((unsigned char*)t.WT + (size_t)rowmap<MAP>(t.n0 + n) * t.K + t.k0 + 16 * c) = o; }
    LDS_WAIT(); asm volatile("" ::: "memory");
}
template <int MAP> __device__ __forceinline__ void transpose_family_f8(Frame& F, const float* W, size_t sW, unsigned char* WT, size_t sWT, const float* gain, int sG, int K, int N, int nmat, int gdiv) {
    LAS float* scr = (LAS float*)(F.lds + RING_OFF) + F.wave * (128 * 33);
    const int nb = N / 32, per = (K / 128) * nb, total = per * nmat;
    f32x4 va[16], vb[16];
    int it = F.gw; if (it >= total) return;
    TrTile ta, tb;
#define TR_SETUP(tt, item) do { const int mi = (item) / per, r = (item) % per; tt.W = W + (size_t)mi * sW; tt.WT = (bf16*)(WT + (size_t)mi * sWT); tt.gain = gain ? gain + (size_t)(mi / gdiv) * sG : nullptr; tt.K = K; tt.N = N; tt.k0 = 128 * (r / nb); tt.n0 = 32 * (r % nb); } while (0)
    TR_SETUP(ta, it); tr8_load(ta, va, F.lane);
    for (;;) {
        const int it2 = it + F.NGW; const bool h2 = it2 < total;
        if (h2) { TR_SETUP(tb, it2); tr8_load(tb, vb, F.lane); }
        tr8_store<MAP>(ta, va, scr, F.lane);
        if (!h2) break;
        const int it3 = it2 + F.NGW; const bool h3 = it3 < total;
        if (h3) { TR_SETUP(ta, it3); tr8_load(ta, va, F.lane); }
        tr8_store<MAP>(tb, vb, scr, F.lane);
        if (!h3) break;
        it = it3;
    }
#undef TR_SETUP
}
__device__ __forceinline__ float rope_freq(int i, int half_dim) { return exp2f(-(float)i / (float)half_dim * LOG2_THETA); }

__device__ __forceinline__ void attn_phase_l0(Frame& F, const bf16* Q3, const bf16* K3, const bf16* V3, bf16* OCAT, const float* sink) {
    char* shm = (char*)(F.lds + RING_OFF);
    const int upc = (512 + F.G - 1) / F.G;
    for (int i = 0; i < upc; ++i) { const int u = F.vcu * upc + i; if (u >= 512) break;
        const int bhk = u >> 7, b = bhk >> 1, hkv = bhk & 1, hq = hkv * 4 + ((u & 127) >> 5), qb = u & 31; const size_t r0 = (size_t)b * SEQ + qb * 256;
        attn_body::attn_unit<0, 1024, 8>((const attn_body::bf16*)(Q3 + r0 * 512 + hq * 64), (const attn_body::bf16*)(K3 + (size_t)b * SEQ * 128 + hkv * 64), (const attn_body::bf16*)(V3 + (size_t)b * SEQ * 128 + hkv * 64),
                                        (attn_body::bf16*)(OCAT + r0 * D + hq * 64), SEQ / 64, 0, 0, 0.f, false, nullptr, shm); }
    const bf16* Qb = Q3 + (size_t)T * 512; const bf16* Kb = K3 + (size_t)T * 128; const bf16* Vb = V3 + (size_t)T * 128;
    for (int i = 0; i < upc; ++i) { const int u = F.vcu * upc + i; if (u >= 512) break;
        const int bhk = u >> 7, b = bhk >> 1, hkv = bhk & 1, pr = (u & 127) >> 6, qb = u & 63, hq = hkv * 4 + pr * 2; const size_t r0 = (size_t)b * SEQ + qb * 128;
        const int tl = max(qb * 2 - 2, 0), th = min(qb * 2 + 4, SEQ / 64); const size_t k0 = (size_t)b * SEQ + tl * 64;
        attn_body::attn_unit<1, 1024, 8, 2>((const attn_body::bf16*)(Qb + r0 * 512 + hq * 64), (const attn_body::bf16*)(Kb + k0 * 128 + hkv * 64), (const attn_body::bf16*)(Vb + k0 * 128 + hkv * 64),
                                           (attn_body::bf16*)(OCAT + r0 * D + 512 + hq * 64), th - tl, tl * 64 - qb * 128, 128, sink[hq + (F.wave >> 2)] * 1.4426950408889634f, true, nullptr, shm); }
}
__device__ __forceinline__ void attn_phase_l1(Frame& F, const bf16* Q3, const bf16* K3, const bf16* V3, bf16* OGB, float* LSE) {
    char* shm = (char*)(F.lds + RING_OFF);
    const int upc = (512 + F.G - 1) / F.G;
#pragma unroll 1
    for (int g = 0; g < 3; ++g) { const int Lc = SEQ >> (2 * g);
        for (int i = 0; i < upc; ++i) { const int u = F.vcu * upc + i; if (u >= 512) break;
            const int bhk = u >> 7, b = bhk >> 1, hkv = bhk & 1, hq = hkv * 4, qb = u & 127; const size_t r0 = (size_t)b * SEQ + qb * 64;
            const int q0 = qb * 64, cbase = q0 & ~(Lc - 1), lq0 = q0 & (Lc - 1); const int tl = min(max(lq0 / 64 - 1, 0), Lc / 64 - 4); const size_t k0 = (size_t)b * SEQ + cbase + tl * 64;
            attn_body::attn_unit<1, 512, 8, 4>((const attn_body::bf16*)(Q3 + (size_t)g * T * 512 + r0 * 512 + hq * 64), (const attn_body::bf16*)(K3 + (size_t)g * T * 128 + k0 * 128 + hkv * 64), (const attn_body::bf16*)(V3 + (size_t)g * T * 128 + k0 * 128 + hkv * 64),
                                              (attn_body::bf16*)(OGB + (size_t)g * T * 512 + r0 * 512 + hq * 64), 4, cbase + tl * 64 - q0, 64, 0.f, false, LSE + (size_t)g * T * 8 + r0 * 8 + hq, shm); }
    }
}
__device__ __forceinline__ void merge_phase(Frame& F, const bf16* OGB, const float* LSE, bf16* OCAT1) {
    for (int m = F.gw; m < T; m += F.NGW) {
        const int h = F.lane >> 3; const int b = m / SEQ, pos = m % SEQ;
        const size_t r0 = m, r1 = (size_t)b * SEQ + (size_t)(pos & 3) * (SEQ / 4) + (pos >> 2), r2 = (size_t)b * SEQ + (size_t)(pos & 15) * (SEQ / 16) + (pos >> 4);
        const float l0 = LSE[r0 * 8 + h], l1 = LSE[(size_t)T * 8 + r1 * 8 + h], l2 = LSE[(size_t)2 * T * 8 + r2 * 8 + h];
        const float mx = fmaxf(l0, fmaxf(l1, l2)); float w0 = __expf(l0 - mx), w1 = __expf(l1 - mx), w2 = __expf(l2 - mx); const float is = 1.f / (w0 + w1 + w2); w0 *= is; w1 *= is; w2 *= is;
        const v4u a = *(const v4u*)(OGB + r0 * 512 + F.lane * 8), bb = *(const v4u*)(OGB + (size_t)T * 512 + r1 * 512 + F.lane * 8), c = *(const v4u*)(OGB + (size_t)2 * T * 512 + r2 * 512 + F.lane * 8);
        v4u w;
        w.x = pk2(w0 * bflo(a.x) + w1 * bflo(bb.x) + w2 * bflo(c.x), w0 * bfhi(a.x) + w1 * bfhi(bb.x) + w2 * bfhi(c.x));
        w.y = pk2(w0 * bflo(a.y) + w1 * bflo(bb.y) + w2 * bflo(c.y), w0 * bfhi(a.y) + w1 * bfhi(bb.y) + w2 * bfhi(c.y));
        w.z = pk2(w0 * bflo(a.z) + w1 * bflo(bb.z) + w2 * bflo(c.z), w0 * bfhi(a.z) + w1 * bfhi(bb.z) + w2 * bfhi(c.z));
        w.w = pk2(w0 * bflo(a.w) + w1 * bflo(bb.w) + w2 * bflo(c.w), w0 * bfhi(a.w) + w1 * bfhi(bb.w) + w2 * bfhi(c.w));
        *(v4u*)(OCAT1 + (size_t)m * C_OUT + F.lane * 8) = w;
    }
}

typedef float f32x4m __attribute__((ext_vector_type(4)));
__device__ __forceinline__ void top4_merge(float (&v)[4], int (&ix)[4], int mask) {
    float ov[4]; int oi[4];
#pragma unroll
    for (int k = 0; k < 4; ++k) { ov[k] = shx(v[k], mask); oi[k] = shx(ix[k], mask); }
    float cv[8]; int ci[8];
#pragma unroll
    for (int k = 0; k < 4; ++k) { cv[k] = v[k]; ci[k] = ix[k]; cv[4 + k] = ov[k]; ci[4 + k] = oi[k]; }
    unsigned used = 0u;
#pragma unroll
    for (int k = 0; k < 4; ++k) { float best = -INFINITY; int bi = 1 << 30, bp = 0;
#pragma unroll
        for (int c = 0; c < 8; ++c) { const bool take = !((used >> c) & 1u) && (cv[c] > best || (cv[c] == best && ci[c] < bi)); best = take ? cv[c] : best; bi = take ? ci[c] : bi; bp = take ? c : bp; }
        used |= 1u << bp; v[k] = best; ix[k] = bi; }
}
__device__ __forceinline__ void route_phase(Frame& F, const bf16* H, const float* WR, const float* rb, int* CNTTAB, int* TOPE, float* TOPG, int* TOPPOS, float* RSTD) {
    LAS float* WL = (LAS float*)(F.lds + RING_OFF);
    LAS unsigned* LC = (LAS unsigned*)(F.lds + RING_OFF + NE * 1028 * 4);
    if (F.tid < NE) LC[F.tid] = 0u;
    for (int i = F.tid; i < NE * D / 4; i += NWAVES * 64) { const int e = i >> 8, k4 = i & 255; *(LAS f32x4*)(WL + e * 1028 + 4 * k4) = *(const f32x4*)(WR + (size_t)e * D + 4 * k4); }
    __syncthreads();
    const int lane = F.lane, c = lane & 15, q = lane >> 4;
    for (int task = F.wave * F.G + F.vcu; task < T / 16; task += F.NGW) {
        const bf16* xr = H + (size_t)(task * 16 + c) * D + 8 * q;
        const LAS float* w0 = WL + c * 1028 + 8 * q; const LAS float* w1 = w0 + 16 * 1028;
        f32x4m a0 = {0.f, 0.f, 0.f, 0.f}, a1 = {0.f, 0.f, 0.f, 0.f}; float ssq = 0.f;
#pragma unroll 4
        for (int ch = 0; ch < 32; ++ch) {
            const v4u xv = *(const v4u*)(xr + 32 * ch);
            float xf[8]; xf[0] = bflo(xv.x); xf[1] = bfhi(xv.x); xf[2] = bflo(xv.y); xf[3] = bfhi(xv.y); xf[4] = bflo(xv.z); xf[5] = bfhi(xv.z); xf[6] = bflo(xv.w); xf[7] = bfhi(xv.w);
            const f32x4 wa0 = *(const LAS f32x4*)(w0 + 32 * ch), wa1 = *(const LAS f32x4*)(w0 + 32 * ch + 4), wb0 = *(const LAS f32x4*)(w1 + 32 * ch), wb1 = *(const LAS f32x4*)(w1 + 32 * ch + 4);
#pragma unroll
            for (int t = 0; t < 8; ++t) ssq += xf[t] * xf[t];
            a0 = __builtin_amdgcn_mfma_f32_16x16x4f32(wa0.x, xf[0], a0, 0, 0, 0); a1 = __builtin_amdgcn_mfma_f32_16x16x4f32(wb0.x, xf[0], a1, 0, 0, 0);
            a0 = __builtin_amdgcn_mfma_f32_16x16x4f32(wa0.y, xf[1], a0, 0, 0, 0); a1 = __builtin_amdgcn_mfma_f32_16x16x4f32(wb0.y, xf[1], a1, 0, 0, 0);
            a0 = __builtin_amdgcn_mfma_f32_16x16x4f32(wa0.z, xf[2], a0, 0, 0, 0); a1 = __builtin_amdgcn_mfma_f32_16x16x4f32(wb0.z, xf[2], a1, 0, 0, 0);
            a0 = __builtin_amdgcn_mfma_f32_16x16x4f32(wa0.w, xf[3], a0, 0, 0, 0); a1 = __builtin_amdgcn_mfma_f32_16x16x4f32(wb0.w, xf[3], a1, 0, 0, 0);
            a0 = __builtin_amdgcn_mfma_f32_16x16x4f32(wa1.x, xf[4], a0, 0, 0, 0); a1 = __builtin_amdgcn_mfma_f32_16x16x4f32(wb1.x, xf[4], a1, 0, 0, 0);
            a0 = __builtin_amdgcn_mfma_f32_16x16x4f32(wa1.y, xf[5], a0, 0, 0, 0); a1 = __builtin_amdgcn_mfma_f32_16x16x4f32(wb1.y, xf[5], a1, 0, 0, 0);
            a0 = __builtin_amdgcn_mfma_f32_16x16x4f32(wa1.z, xf[6], a0, 0, 0, 0); a1 = __builtin_amdgcn_mfma_f32_16x16x4f32(wb1.z, xf[6], a1, 0, 0, 0);
            a0 = __builtin_amdgcn_mfma_f32_16x16x4f32(wa1.w, xf[7], a0, 0, 0, 0); a1 = __builtin_amdgcn_mfma_f32_16x16x4f32(wb1.w, xf[7], a1, 0, 0, 0);
        }
        ssq += shx(ssq, 16); ssq += shx(ssq, 32);
        const float rstd = 1.f / sqrtf(ssq * (1.f / D) + NORM_EPS);
        float cv[8]; int ci[8];
#pragma unroll
        for (int r = 0; r < 4; ++r) { ci[r] = 4 * q + r; ci[4 + r] = 16 + 4 * q + r; cv[r] = a0[r] * rstd + rb[4 * q + r]; cv[4 + r] = a1[r] * rstd + rb[16 + 4 * q + r]; }
        float tv[4]; int ti[4]; unsigned used = 0u;
#pragma unroll
        for (int k = 0; k < 4; ++k) { float best = -INFINITY; int bi = 0, bp = 0;
#pragma unroll
            for (int j = 0; j < 8; ++j) { const bool take = !((used >> j) & 1u) && (cv[j] > best); best = take ? cv[j] : best; bi = take ? ci[j] : bi; bp = take ? j : bp; }
            used |= 1u << bp; tv[k] = best; ti[k] = bi; }
        top4_merge(tv, ti, 16); top4_merge(tv, ti, 32);
        const float e1 = __expf(tv[1] - tv[0]), e2 = __expf(tv[2] - tv[0]), e3 = __expf(tv[3] - tv[0]); const float is = 1.f / (1.f + e1 + e2 + e3);
        const int m = task * 16 + c;
        { const int e = q == 0 ? ti[0] : q == 1 ? ti[1] : q == 2 ? ti[2] : ti[3]; const float g = (q == 0 ? 1.f : q == 1 ? e1 : q == 2 ? e2 : e3) * is;
            const unsigned pos = __hip_atomic_fetch_add(LC + e, 1u, __ATOMIC_RELAXED, __HIP_MEMORY_SCOPE_WORKGROUP);
            TOPE[m * 4 + q] = e; TOPG[m * 4 + q] = g; TOPPOS[m * 4 + q] = (int)pos; }
        if (q == 0) RSTD[m] = rstd;
    }
    __syncthreads();
    if (F.tid < NE) CNTTAB[F.vcu * NE + F.tid] = (int)LC[F.tid];
    __syncthreads();
}
__device__ __forceinline__ void slot_phase(Frame& F, const bf16* H, const int* CNTTAB, const int* TOPE, const float* TOPG, const int* TOPPOS, const float* RSTD, int* TOKSLOT, float* SLOTGATE, float* SLOTRS, bf16* XG, int* XTAB, bool f8) {
    LAS int* L = (LAS int*)(F.lds + RING_OFF);
    LAS int* P = L + 256;
    const int lane = F.lane;
    {
#pragma unroll 1
        for (int ee = 0; ee < 4; ++ee) { const int e = F.wave * 4 + ee;
            int s0 = 0, s1 = 0, s2 = 0, s3 = 0; const int g0 = 4 * lane;
            if (g0 < F.G) s0 = CNTTAB[g0 * NE + e]; if (g0 + 1 < F.G) s1 = CNTTAB[(g0 + 1) * NE + e]; if (g0 + 2 < F.G) s2 = CNTTAB[(g0 + 2) * NE + e]; if (g0 + 3 < F.G) s3 = CNTTAB[(g0 + 3) * NE + e];
            const int t = s0 + s1 + s2 + s3; int inc = t;
#pragma unroll
            for (int o = 1; o < 64; o <<= 1) { const int u = shup(inc, o); if (lane >= o) inc += u; }
            const int base = inc - t;
            P[g0 * NE + e] = base; P[(g0 + 1) * NE + e] = base + s0; P[(g0 + 2) * NE + e] = base + s0 + s1; P[(g0 + 3) * NE + e] = base + s0 + s1 + s2;
            if (lane == 63) L[64 + e] = inc; }
    }
    __syncthreads();
    if (F.wave == 0) {
        const int np = (lane < 32) ? ((L[64 + (lane & 31)] + 255) >> 8) : 0;
        int pre = np;
#pragma unroll
        for (int o = 1; o < 32; o <<= 1) { const int t = shup(pre, o); if (lane >= o) pre += t; }
        const int p0 = pre - np;
        if (lane < 32) { L[lane] = np; L[32 + lane] = p0 * 256; }
        if (F.bx == 0) {
            LDS_WAIT(); asm volatile("" ::: "memory");
            int rank = 0;
#pragma unroll 8
            for (int e2 = 0; e2 < 32; ++e2) { const int v = L[e2]; rank += (v > np || (v == np && e2 < lane)) ? 1 : 0; }
            LAS int* XE = L + 96;
            if (lane < 32) { const int r16 = rank & 15, x = r16 < 8 ? r16 : 15 - r16, pos = (rank >> 4) * 2 + (r16 >= 8 ? 1 : 0); XE[(x * 4 + pos) * 3] = lane; XE[(x * 4 + pos) * 3 + 1] = p0; XE[(x * 4 + pos) * 3 + 2] = np; }
            LDS_WAIT(); asm volatile("" ::: "memory");
            const int lx = lane_opaque();
            if (lx < 8) { int cump = 0; int* tb = XTAB + lx * 136;
#pragma unroll
                for (int s = 0; s < 4; ++s) { const int e = XE[(lx * 4 + s) * 3], q0 = XE[(lx * 4 + s) * 3 + 1], n = XE[(lx * 4 + s) * 3 + 2]; tb[4 + 4 * s] = e; tb[4 + 4 * s + 1] = q0; tb[4 + 4 * s + 2] = n; tb[4 + 4 * s + 3] = cump; cump += n; }
                int four = 4; asm volatile("" : "+v"(four));
                tb[0] = four; tb[1] = cump; }
        }
    }
    __syncthreads();
    if (f8) {
        for (int m0 = F.gw; m0 < T; m0 += 4 * F.NGW) {
            int e[4], ps[4]; float gt[4], rs[4]; v4u ra[4], rb[4];
#pragma unroll
            for (int j = 0; j < 4; ++j) { const int m = m0 + j * F.NGW; const bool ok = m < T; const int mm = ok ? m : 0;
                e[j] = 0; ps[j] = 0; gt[j] = 0.f;
                if (lane < 4) { e[j] = TOPE[mm * 4 + lane]; ps[j] = TOPPOS[mm * 4 + lane]; gt[j] = TOPG[mm * 4 + lane]; }
                rs[j] = RSTD[mm]; const bf16* src = H + (size_t)mm * D + lane * 16; ra[j] = *(const v4u*)src; rb[j] = *(const v4u*)(src + 8); }
#pragma unroll
            for (int j = 0; j < 4; ++j) { const int m = m0 + j * F.NGW; if (m >= T) break;
                int slot = 0;
                if (lane < 4) { const int wg = (m >> 4) % F.G; slot = L[32 + e[j]] + P[wg * NE + e[j]] + ps[j]; TOKSLOT[m * 4 + lane] = slot; SLOTGATE[slot] = gt[j]; SLOTRS[slot] = rs[j]; }
                const int s0 = shl(slot, 0), s1 = shl(slot, 1), s2 = shl(slot, 2), s3 = shl(slot, 3);
                const v4u a = ra[j], b = rb[j]; const float r = rs[j];
                v4u w; w.x = pk4_fp8(clamp448(bflo(a.x) * r), clamp448(bfhi(a.x) * r), clamp448(bflo(a.y) * r), clamp448(bfhi(a.y) * r)); w.y = pk4_fp8(clamp448(bflo(a.z) * r), clamp448(bfhi(a.z) * r), clamp448(bflo(a.w) * r), clamp448(bfhi(a.w) * r));
                w.z = pk4_fp8(clamp448(bflo(b.x) * r), clamp448(bfhi(b.x) * r), clamp448(bflo(b.y) * r), clamp448(bfhi(b.y) * r)); w.w = pk4_fp8(clamp448(bflo(b.z) * r), clamp448(bfhi(b.z) * r), clamp448(bflo(b.w) * r), clamp448(bfhi(b.w) * r));
                unsigned char* X8 = (unsigned char*)XG; const size_t co = (size_t)lane * 16;
                *(v4u*)(X8 + (size_t)s0 * D + co) = w; *(v4u*)(X8 + (size_t)s1 * D + co) = w; *(v4u*)(X8 + (size_t)s2 * D + co) = w; *(v4u*)(X8 + (size_t)s3 * D + co) = w; }
        }
    } else {
    for (int m = F.gw; m < T; m += F.NGW) {
        int slot = 0;
        if (lane < 4) { const int e = TOPE[m * 4 + lane]; const int wg = (m >> 4) % F.G; slot = L[32 + e] + P[wg * NE + e] + TOPPOS[m * 4 + lane]; TOKSLOT[m * 4 + lane] = slot; SLOTGATE[slot] = TOPG[m * 4 + lane]; SLOTRS[slot] = RSTD[m]; }
        const int s0 = shl(slot, 0), s1 = shl(slot, 1), s2 = shl(slot, 2), s3 = shl(slot, 3);
        const bf16* src = H + (size_t)m * D + lane * 8; const v4u a = *(const v4u*)src, b = *(const v4u*)(src + 512);
        const size_t co = (size_t)lane * 8;
        *(v4u*)(XG + (size_t)s0 * D + co) = a; *(v4u*)(XG + (size_t)s0 * D + co + 512) = b;
        *(v4u*)(XG + (size_t)s1 * D + co) = a; *(v4u*)(XG + (size_t)s1 * D + co + 512) = b;
        *(v4u*)(XG + (size_t)s2 * D + co) = a; *(v4u*)(XG + (size_t)s2 * D + co + 512) = b;
        *(v4u*)(XG + (size_t)s3 * D + co) = a; *(v4u*)(XG + (size_t)s3 * D + co + 512) = b;
    }
    }
    __syncthreads();
}
__device__ __forceinline__ void y_add16(float (&a)[16], const void* Yp, size_t row, int lane) {
    if (Y_FP8) { const v4u y = *(const v4u*)((const unsigned char*)Yp + row * D + lane * 16); const float is = 1.f / Y_SC;
        const unsigned w[4] = {y.x, y.y, y.z, y.w};
#pragma unroll
        for (int i = 0; i < 4; ++i) { const f32x2_ lo = __builtin_amdgcn_cvt_pk_f32_fp8((int)w[i], false), hi = __builtin_amdgcn_cvt_pk_f32_fp8((int)w[i], true); a[4 * i] += lo.x * is; a[4 * i + 1] += lo.y * is; a[4 * i + 2] += hi.x * is; a[4 * i + 3] += hi.y * is; } }
    else { const bf16* yp = (const bf16*)Yp + row * D + lane * 16; const v4u y0 = *(const v4u*)yp, y1 = *(const v4u*)(yp + 8);
        a[0] += bflo(y0.x); a[1] += bfhi(y0.x); a[2] += bflo(y0.y); a[3] += bfhi(y0.y); a[4] += bflo(y0.z); a[5] += bfhi(y0.z); a[6] += bflo(y0.w); a[7] += bfhi(y0.w);
        a[8] += bflo(y1.x); a[9] += bfhi(y1.x); a[10] += bflo(y1.y); a[11] += bfhi(y1.y); a[12] += bflo(y1.z); a[13] += bfhi(y1.z); a[14] += bflo(y1.w); a[15] += bfhi(y1.w); }
}
__device__ __forceinline__ void combine_phase(Frame& F, const bf16* HM, const void* Y, const int* TOKSLOT, bf16* H2, unsigned char* H2F8) {
    const int lane = F.lane;
    for (int m = F.gw; m < T; m += F.NGW) {
        const int s0 = TOKSLOT[m * 4], s1 = TOKSLOT[m * 4 + 1], s2 = TOKSLOT[m * 4 + 2], s3 = TOKSLOT[m * 4 + 3];
        float a[16];
#pragma unroll
        for (int i = 0; i < 16; ++i) a[i] = 0.f;
        y_add16(a, Y, (size_t)s0, lane); y_add16(a, Y, (size_t)s1, lane); y_add16(a, Y, (size_t)s2, lane); y_add16(a, Y, (size_t)s3, lane);
        const bf16* hp = HM + (size_t)m * D + lane * 16; const v4u h0 = *(const v4u*)hp, h1 = *(const v4u*)(hp + 8);
        a[0] += bflo(h0.x); a[1] += bfhi(h0.x); a[2] += bflo(h0.y); a[3] += bfhi(h0.y); a[4] += bflo(h0.z); a[5] += bfhi(h0.z); a[6] += bflo(h0.w); a[7] += bfhi(h0.w);
        a[8] += bflo(h1.x); a[9] += bfhi(h1.x); a[10] += bflo(h1.y); a[11] += bfhi(h1.y); a[12] += bflo(h1.z); a[13] += bfhi(h1.z); a[14] += bflo(h1.w); a[15] += bfhi(h1.w);
        v4u w0, w1; w0.x = pk2(a[0], a[1]); w0.y = pk2(a[2], a[3]); w0.z = pk2(a[4], a[5]); w0.w = pk2(a[6], a[7]); w1.x = pk2(a[8], a[9]); w1.y = pk2(a[10], a[11]); w1.z = pk2(a[12], a[13]); w1.w = pk2(a[14], a[15]);
        bf16* op = H2 + (size_t)m * D + lane * 16; *(v4u*)op = w0; *(v4u*)(op + 8) = w1;
        if (PLE_FP8) { v4u q; q.x = pk4_fp8(clamp448(a[0]), clamp448(a[1]), clamp448(a[2]), clamp448(a[3])); q.y = pk4_fp8(clamp448(a[4]), clamp448(a[5]), clamp448(a[6]), clamp448(a[7]));
            q.z = pk4_fp8(clamp448(a[8]), clamp448(a[9]), clamp448(a[10]), clamp448(a[11])); q.w = pk4_fp8(clamp448(a[12]), clamp448(a[13]), clamp448(a[14]), clamp448(a[15])); *(v4u*)(H2F8 + (size_t)m * D + lane * 16) = q; }
    }
}
__device__ __forceinline__ void final_norm_phase(Frame& F, const bf16* H, const float* SS, const float* gain, float* out) {
    const int lane = F.lane;
    for (int m = F.gw; m < T; m += F.NGW) {
        const float rstd = 1.f / sqrtf(ssp_sum(SS + (size_t)m * 16) * (1.f / D) + NORM_EPS);
#pragma unroll
        for (int j = 0; j < 2; ++j) { const size_t co = (size_t)j * 512 + lane * 8; const v4u h = *(const v4u*)(H + (size_t)m * D + co); const f32x4 g0 = *(const f32x4*)(gain + co), g1 = *(const f32x4*)(gain + co + 4);
            f32x4 o0, o1; o0.x = bflo(h.x) * rstd * g0.x; o0.y = bfhi(h.x) * rstd * g0.y; o0.z = bflo(h.y) * rstd * g0.z; o0.w = bfhi(h.y) * rstd * g0.w;
            o1.x = bflo(h.z) * rstd * g1.x; o1.y = bfhi(h.z) * rstd * g1.y; o1.z = bflo(h.w) * rstd * g1.z; o1.w = bfhi(h.w) * rstd * g1.w;
            float* dst = out + (size_t)m * D + co; *(f32x4*)dst = o0; *(f32x4*)(dst + 4) = o1; }
    }
}

constexpr int N_PHASES = 22;
struct Args { const float* in[20]; float* out; unsigned char* ws; int ph_lo, ph_hi, li, pad; };
typedef const __attribute__((address_space(4))) Args* argp_t;
__device__ __forceinline__ argp_t opaque_args() { argp_t p = (argp_t)__builtin_amdgcn_kernarg_segment_ptr(); asm volatile("" : "+s"(p)); return p; }
#define AP (opaque_args())
__global__ void __launch_bounds__(NWAVES * 64, 2) fwd_kernel(Args args_unused) {
    extern __shared__ __attribute__((aligned(16))) unsigned char lds[];
    Frame F;
    F.lds = (LAS unsigned char*)lds;
    F.MISC = (volatile LAS unsigned*)(F.lds + MISC_OFF);
    refresh(F);
    F.ctl = (gu32*)(AP->ws + WS_CTL);
    if (F.tid < 128) ((LAS unsigned*)(F.lds + LDSCTL_OFF))[F.tid] = 0u;
    __syncthreads();
    const bool one_phase = (AP->ph_hi - AP->ph_lo) == 1;
    XcdBarrier bar; bar.bar = (unsigned*)(F.ctl + CW_BAR); bar.x = 0; bar.st = nullptr;
    if (!one_phase) bar = xcd_barrier_post((unsigned*)(F.ctl + CW_BAR), F.MISC + 8);
    const int lo = AP->ph_lo, hi = AP->ph_hi;
#ifndef MK_MASK
#define MK_MASK 0x3fff
#endif
#ifndef PROBE_MASK
#define PROBE_MASK 0
#endif
#define IN(k) (lo <= (k) && (k) < hi)
#define INL(j) (((MK_MASK >> (j)) & 1) && IN(pb + (j)) && refresh(F))
#define REP(j) _Pragma("unroll") for (int rep_ = 0; rep_ < (((PROBE_MASK >> (j)) & 1) ? 2 : 1); ++rep_)
#define SEAM(k) do { if (IN((k) + 1)) xcd_barrier(bar); } while (0)
#define ws (AP->ws)
#define WSP(type, off) ((type*)(ws + (off)))
    if (((MK_MASK >> 12) & 1) && IN(0) && refresh(F)) REP(12) {
#pragma unroll 1
        for (int ll = 0; ll < 2; ++ll) {
            const float* wu = AP->in[13] + (size_t)ll * NE * D * 2 * DE; const float* wd = AP->in[15] + (size_t)ll * NE * DE * D; const float* gf = AP->in[10] + ll * D;
            unsigned char* du = ws + WS_WUPT + (size_t)ll * NE * 2 * DE * D * 2; unsigned char* dd = ws + WS_WDNT + (size_t)ll * NE * D * DE * 2;
#if MOE_FP8_MASK != 0
            if ((MOE_FP8_MASK >> ll) & 1) {
                transpose_family_f8<1>(F, wu, (size_t)D * 2 * DE, du, (size_t)2 * DE * D, gf, 0, D, 2 * DE, NE, 1);
                transpose_family_f8<0>(F, wd, (size_t)DE * D, dd, (size_t)D * DE, nullptr, 0, DE, D, NE, 1);
            }
#endif
#if MOE_FP8_MASK != 3
            if (!((MOE_FP8_MASK >> ll) & 1)) {
                transpose_family<1>(F, wu, (size_t)D * 2 * DE, (bf16*)du, (size_t)2 * DE * D, gf, 0, D, 2 * DE, NE, 1);
                transpose_family<0>(F, wd, (size_t)DE * D, (bf16*)dd, (size_t)D * DE, nullptr, 0, DE, D, NE, 1);
            }
#endif
        }
        transpose_family<2>(F, AP->in[3], 0, WSP(bf16, WS_WIN0T), 0, AP->in[2], 0, D, AB_IN, 1, 1);
        transpose_family<3>(F, AP->in[8], 0, WSP(bf16, WS_WIN1T), 0, AP->in[2] + D, 0, D, C_IN, 1, 1);
        transpose_family<0>(F, AP->in[7], 0, WSP(bf16, WS_WOUT0T), 0, nullptr, 0, D, D, 1, 1);
        transpose_family<0>(F, AP->in[9], 0, WSP(bf16, WS_WOUT1T), 0, nullptr, 0, C_OUT, D, 1, 1);
        if (PLE_FP8) transpose_family_f8<0>(F, AP->in[18], (size_t)D * D, ws + WS_WGT, (size_t)D * D * 2, nullptr, 0, D, D, 2, 1);
        else transpose_family<0>(F, AP->in[18], (size_t)D * D, WSP(bf16, WS_WGT), (size_t)D * D, nullptr, 0, D, D, 2, 1);
        transpose_family<0>(F, AP->in[17], (size_t)PLE * D, WSP(bf16, WS_WPT), (size_t)D * PLE, nullptr, 0, PLE, D, 2, 1);
        {
            float* WR = WSP(float, WS_WR); const float* nf = AP->in[10]; const float* rw = AP->in[11];
            for (int i = F.gw * 64 + F.lane; i < 2 * NE * D; i += F.NGW * 64) { const int l = i / (NE * D), e = (i / D) % NE, k = i % D; WR[i] = nf[l * D + k] * rw[((size_t)l * D + k) * NE + e]; }
        }
        {
            float* R1 = WSP(float, WS_ROPE1); float* RA = WSP(float, WS_ROPEA);
            for (int i = F.gw * 64 + F.lane; i < SEQ * 32; i += F.NGW * 64) { const int pos = i >> 5, j = i & 31;
                const float a1 = (float)pos * rope_freq(j, 32); R1[2 * i] = cosf(a1); R1[2 * i + 1] = sinf(a1);
                const float aa = (float)((j < 16) ? (pos >> 6) : (pos & 63)) * rope_freq(j & 15, 16); RA[2 * i] = cosf(aa); RA[2 * i + 1] = sinf(aa); }
        }
        {
            bf16* PBF = WSP(bf16, WS_PBF); const float* p_in = AP->in[1]; const size_t n8 = (size_t)2 * T * PLE / 8;
            for (size_t i = (size_t)F.gw * 64 + F.lane; i < n8; i += (size_t)F.NGW * 64) { const f32x4 a = *(const f32x4*)(p_in + i * 8), b = *(const f32x4*)(p_in + i * 8 + 4);
                v4u w; w.x = pk2(a.x, a.y); w.y = pk2(a.z, a.w); w.z = pk2(b.x, b.y); w.w = pk2(b.z, b.w); *(v4u*)(PBF + i * 8) = w; }
        }
        {
            bf16* X0 = WSP(bf16, WS_X0); float* SS0 = WSP(float, WS_SSP); const float* x_in = AP->in[0];
            for (int m = F.gw; m < T; m += F.NGW) { float s = 0.f;
#pragma unroll
                for (int j = 0; j < 2; ++j) { const size_t co = (size_t)m * D + j * 512 + F.lane * 8; const f32x4 a = *(const f32x4*)(x_in + co), b = *(const f32x4*)(x_in + co + 4);
                    v4u w; w.x = pk2(a.x, a.y); w.y = pk2(a.z, a.w); w.z = pk2(b.x, b.y); w.w = pk2(b.z, b.w); *(v4u*)(X0 + co) = w;
                    s += (bflo(w.x) * bflo(w.x) + bfhi(w.x) * bfhi(w.x)) + (bflo(w.y) * bflo(w.y) + bfhi(w.y) * bfhi(w.y)) + (bflo(w.z) * bflo(w.z) + bfhi(w.z) * bfhi(w.z)) + (bflo(w.w) * bflo(w.w) + bfhi(w.w) * bfhi(w.w)); }
                s = wave_sum(s); if (F.lane < 16) SS0[(size_t)m * 16 + F.lane] = (F.lane == 0) ? s : 0.f; }
        }
        __syncthreads();
        SEAM(0);
    }
#pragma unroll 1
    for (int l = 0; l < 2; ++l) {
        const int pb = 1 + 10 * l;
        if (INL(0)) REP(0) {
            const bf16* hin = (l == 0) ? WSP(bf16, WS_X0) : WSP(bf16, WS_H3);
            const float* ssin = WSP(float, WS_SSP) + (size_t)l * T * 16;
            if (l == 0) { pg8::Gemm g{hin, WSP(bf16, WS_WIN0T), T, AB_IN, D}; pg8::StaticOrder S; S.init(T, AB_IN, F.G, F.bx);
                EpiQKV<0> E{ssin, AP->in[4], AP->in[5], WSP(float, WS_ROPE1), WSP(float, WS_ROPEA), WSP(bf16, WS_Q3), WSP(bf16, WS_K3), WSP(bf16, WS_V3)};
                pg8::gemm_phase<EpiQKV<0>, pg8::StaticOrder, true, true>(F.lds + RING_OFF, g, S, E); }
            else { pg8::Gemm g{hin, WSP(bf16, WS_WIN1T), T, C_IN, D}; pg8::StaticOrder S; S.init(T, C_IN, F.G, F.bx);
                EpiQKV<1> E{ssin, nullptr, nullptr, WSP(float, WS_ROPE1), WSP(float, WS_ROPEA), WSP(bf16, WS_Q3), WSP(bf16, WS_K3), WSP(bf16, WS_V3)};
                pg8::gemm_phase<EpiQKV<1>, pg8::StaticOrder, true, true>(F.lds + RING_OFF, g, S, E); }
            if (l == 0) { int Kp = PLE; asm volatile("" : "+s"(Kp)); pg8::Gemm g{WSP(bf16, WS_PBF), WSP(bf16, WS_WPT), 2 * T, 2 * D, Kp}; PPOrder S{(int)F.G, F.bx};
                EpiPP E{WSP(bf16, WS_PP)};
                pg8::gemm_phase<EpiPP, PPOrder, true, true>(F.lds + RING_OFF, g, S, E); }
            SEAM(pb + 0);
        }
        if (INL(1)) REP(1) {
            if (l == 0) attn_phase_l0(F, WSP(bf16, WS_Q3), WSP(bf16, WS_K3), WSP(bf16, WS_V3), WSP(bf16, WS_OCAT), AP->in[6]);
            else attn_phase_l1(F, WSP(bf16, WS_Q3), WSP(bf16, WS_K3), WSP(bf16, WS_V3), WSP(bf16, WS_OGB), WSP(float, WS_LSE));
            SEAM(pb + 1);
        }
        if (INL(2)) REP(2) { if (l == 1) merge_phase(F, WSP(bf16, WS_OGB), WSP(float, WS_LSE), WSP(bf16, WS_OCAT)); SEAM(pb + 2); }
        if (INL(3)) REP(3) {
            const bf16* hin = (l == 0) ? WSP(bf16, WS_X0) : WSP(bf16, WS_H3);
            pg8::Gemm g{WSP(bf16, WS_OCAT), (const bf16*)(ws + (l == 0 ? WS_WOUT0T : WS_WOUT1T)), T, D, (l == 0) ? D : C_OUT}; pg8::StaticOrder S; S.init(T, D, F.G, F.bx); EpiResBf16 E{hin, WSP(bf16, WS_HM)};
            pg8::gemm_phase<EpiResBf16, pg8::StaticOrder, true, true>(F.lds + RING_OFF, g, S, E);
            SEAM(pb + 3);
        }
        if (INL(4)) REP(4) { route_phase(F, WSP(bf16, WS_HM), WSP(float, WS_WR) + (size_t)l * NE * D, AP->in[12] + l * NE, WSP(int, WS_CNTTAB), WSP(int, WS_TOPE), WSP(float, WS_TOPG), WSP(int, WS_TOPPOS), WSP(float, WS_RSTD));
#ifdef PROBE_ROUTE
            route_phase(F, WSP(bf16, WS_HM), WSP(float, WS_WR) + (size_t)l * NE * D, AP->in[12] + l * NE, WSP(int, WS_OGB) + 16 * T, WSP(int, WS_OGB), WSP(float, WS_OGB) + 4 * T, WSP(int, WS_OGB) + 8 * T, WSP(float, WS_OGB) + 12 * T);
#endif
            SEAM(pb + 4); }
        if (INL(5)) REP(5) { slot_phase(F, WSP(bf16, WS_HM), WSP(int, WS_CNTTAB), WSP(int, WS_TOPE), WSP(float, WS_TOPG), WSP(int, WS_TOPPOS), WSP(float, WS_RSTD), WSP(int, WS_TOKSLOT), WSP(float, WS_SLOTGATE), WSP(float, WS_SLOTRS), WSP(bf16, WS_XG), WSP(int, WS_XTAB), ((MOE_FP8_MASK >> l) & 1) != 0); SEAM(pb + 5); }
        if (INL(6)) REP(6) {
            XcdOrder<3> S{WSP(int, WS_XTAB) + (F.bx & 7) * 136, F.bx >> 3, (int)F.G >> 3};
#if MOE_FP8_MASK != 0
            if ((MOE_FP8_MASK >> l) & 1) { pg8::Gemm g{WSP(bf16, WS_XG), WSP(bf16, WS_WUPT) + (size_t)l * NE * 2 * DE * D, NSLOT, NE * 2 * DE, D / 2};
                EpiSwiglu<true> E{WSP(void, WS_ACT), AP->in[14] + (size_t)l * NE * 2 * DE, nullptr};
                pg8::gemm_phase<EpiSwiglu<true>, XcdOrder<3>, true, true, F8_DIAG ? 1000 : 127 - F8_WSC>(F.lds + RING_OFF, g, S, E); }
#ifdef PROBE_UPNULL
            if ((MOE_FP8_MASK >> l) & 1) { pg8::Gemm g{WSP(bf16, WS_XG), WSP(bf16, WS_WUPT) + (size_t)l * NE * 2 * DE * D, NSLOT, NE * 2 * DE, D / 2};
                EpiNull E{WSP(float, WS_OGB)};
                pg8::gemm_phase<EpiNull, XcdOrder<3>, true, true, 127 - F8_WSC>(F.lds + RING_OFF, g, S, E); }
#endif
#endif
#if MOE_FP8_MASK != 3
            if (!((MOE_FP8_MASK >> l) & 1)) { pg8::Gemm g{WSP(bf16, WS_XG), WSP(bf16, WS_WUPT) + (size_t)l * NE * 2 * DE * D, NSLOT, NE * 2 * DE, D};
                EpiSwiglu<false> E{WSP(void, WS_ACT), AP->in[14] + (size_t)l * NE * 2 * DE, WSP(float, WS_SLOTRS)};
                pg8::gemm_phase<EpiSwiglu<false>, XcdOrder<3>, true, true>(F.lds + RING_OFF, g, S, E); }
#endif
            SEAM(pb + 6);
        }
        if (INL(7)) REP(7) {
            XcdOrder<2> S{WSP(int, WS_XTAB) + (F.bx & 7) * 136, F.bx >> 3, (int)F.G >> 3};
            EpiDown<Y_FP8 != 0> E{WSP(void, WS_Y), AP->in[16] + (size_t)l * NE * D, WSP(float, WS_SLOTGATE), ((MOE_FP8_MASK >> l) & 1) ? F8_EPI_SC : 1.f};
#if MOE_FP8_MASK != 0
            if ((MOE_FP8_MASK >> l) & 1) { pg8::Gemm g{WSP(bf16, WS_ACT), WSP(bf16, WS_WDNT) + (size_t)l * NE * D * DE, NSLOT, NE * D, DE / 2};
                pg8::gemm_phase<EpiDown<Y_FP8 != 0>, XcdOrder<2>, true, true, F8_DIAG ? 1000 : 127 - F8_WSC>(F.lds + RING_OFF, g, S, E); }
#ifdef PROBE_DNNULL
            if ((MOE_FP8_MASK >> l) & 1) { pg8::Gemm g{WSP(bf16, WS_ACT), WSP(bf16, WS_WDNT) + (size_t)l * NE * D * DE, NSLOT, NE * D, DE / 2};
                EpiNull E2{WSP(float, WS_OGB)};
                pg8::gemm_phase<EpiNull, XcdOrder<2>, true, true, 127 - F8_WSC>(F.lds + RING_OFF, g, S, E2); }
#endif
#endif
#if MOE_FP8_MASK != 3
            if (!((MOE_FP8_MASK >> l) & 1)) { pg8::Gemm g{WSP(bf16, WS_ACT), WSP(bf16, WS_WDNT) + (size_t)l * NE * D * DE, NSLOT, NE * D, DE};
                pg8::gemm_phase<EpiDown<Y_FP8 != 0>, XcdOrder<2>, true, true>(F.lds + RING_OFF, g, S, E); }
#endif
            SEAM(pb + 7);
        }
        if (INL(8)) REP(8) { combine_phase(F, WSP(bf16, WS_HM), WSP(void, WS_Y), WSP(int, WS_TOKSLOT), WSP(bf16, WS_H2), ws + WS_H2F8); SEAM(pb + 8); }
        if (INL(9)) REP(9) {
            pg8::StaticOrder S; S.init(T, D, F.G, F.bx);
            EpiPle E{WSP(bf16, WS_H2), WSP(bf16, WS_PP) + (size_t)l * T * D, WSP(bf16, WS_H3), WSP(float, WS_SSP) + (size_t)(l + 1) * T * 16};
            if (PLE_FP8) { pg8::Gemm g{WSP(bf16, WS_H2F8), WSP(bf16, WS_WGT) + (size_t)l * D * D, T, D, D / 2};
                pg8::gemm_phase<EpiPle, pg8::StaticOrder, true, true, 127 - F8_WSC>(F.lds + RING_OFF, g, S, E); }
            else { pg8::Gemm g{WSP(bf16, WS_H2), WSP(bf16, WS_WGT) + (size_t)l * D * D, T, D, D};
                pg8::gemm_phase<EpiPle, pg8::StaticOrder, true, true>(F.lds + RING_OFF, g, S, E); }
            SEAM(pb + 9);
        }
    }
#ifdef PROBE_BARRIERS
    for (int pb_ = 0; pb_ < PROBE_BARRIERS; ++pb_) xcd_barrier(bar);
#endif
    if (((MK_MASK >> 13) & 1) && IN(21) && refresh(F)) final_norm_phase(F, WSP(bf16, WS_H3), WSP(float, WS_SSP) + (size_t)2 * T * 16, AP->in[19], AP->out);
#undef IN
#undef INL
#undef REP
#undef SEAM
#undef ws
#undef WSP
}

#ifndef MK_ONE_LAUNCH
#define MK_ONE_LAUNCH 1
#endif
extern "C" void kernel_launch(void* const* d_in, const int* in_sizes, int n_in, void* d_out, int out_size, void* d_ws, size_t ws_size, hipStream_t stream) {
    static int grid = 0;
    if (grid == 0) {
        if (n_in != 20 || in_sizes[0] != T * D || out_size != T * D || ws_size < WS_END) { fprintf(stderr, "kernel_launch: unexpected shapes: n_in %d in0 %d out %d ws %zu (need %zu)\n", n_in, n_in > 0 ? in_sizes[0] : -1, out_size, ws_size, (size_t)WS_END); grid = -1; return; }
        int dev = 0, cus = 0, per_cu = 0;
        if (hipGetDevice(&dev) != hipSuccess || hipDeviceGetAttribute(&cus, hipDeviceAttributeMultiprocessorCount, dev) != hipSuccess) { grid = -1; return; }
        if (hipFuncSetAttribute((const void*)fwd_kernel, hipFuncAttributeMaxDynamicSharedMemorySize, LDS_BYTES) != hipSuccess) { fprintf(stderr, "kernel_launch: hipFuncSetAttribute failed\n"); grid = -1; return; }
        if (hipOccupancyMaxActiveBlocksPerMultiprocessor(&per_cu, (const void*)fwd_kernel, NWAVES * 64, LDS_BYTES) != hipSuccess || per_cu < 1) fprintf(stderr, "kernel_launch: occupancy query says %d\n", per_cu);
        (void)hipGetLastError();
        grid = cus;
        if (grid != 256) fprintf(stderr, "kernel_launch: %d CUs (built for 256)\n", grid);
    }
    if (grid < 0) return;
    if (hipMemsetAsync((char*)d_ws + WS_CTL, 0, CTL_ZERO_BYTES, stream) != hipSuccess) return;
    Args a{};
    for (int i = 0; i < 20; ++i) a.in[i] = (const float*)d_in[i];
    a.out = (float*)d_out; a.ws = (unsigned char*)d_ws;
#if MK_ONE_LAUNCH
    a.ph_lo = 0; a.ph_hi = N_PHASES; a.li = 0;
    hipLaunchKernelGGL(fwd_kernel, dim3(grid), dim3(NWAVES * 64), LDS_BYTES, stream, a);
#else
    for (int ph = 0; ph < N_PHASES; ++ph) {
        if (ph == 3) continue;
        a.ph_lo = ph; a.ph_hi = ph + 1; a.li = ph;
        hipLaunchKernelGGL(fwd_kernel, dim3(grid), dim3(NWAVES * 64), LDS_BYTES, stream, a);
    }
#endif
}
```

```cpp
#include <hip/hip_runtime.h>
#include <hip/hip_bf16.h>
#include <cstdio>
#include <cstdint>
#include <cmath>
namespace pg8 {
#define PG8_LAS __attribute__((address_space(3)))
typedef unsigned short bf16_t;
typedef short bf16x8 __attribute__((ext_vector_type(8)));
typedef float f32x4 __attribute__((ext_vector_type(4)));
typedef unsigned u32x4 __attribute__((ext_vector_type(4)));
typedef int pg8_v4i __attribute__((ext_vector_type(4)));
typedef long pg8_v2l __attribute__((ext_vector_type(2)));
constexpr int BM = 256, BK = 64, HALF = 128, HTB = HALF * BK * 2  , STAGE_BYTES = 8 * HTB, NXCD = 8, WGM = 8;

__host__ __device__ __forceinline__ int lds_byte(int r, int c) { const int st = (r >> 4) * 2 + (c >> 5), rr = r & 15, cc = c & 31, ob = rr * 64 + cc * 2; return st * 1024 + (ob ^ (((ob >> 9) & 1) << 5)); }
__host__ __device__ __forceinline__ void stage_rc(int b, int& R, int& C) { const int st = b / 1024, sb = b % 1024, swz = sb ^ (((sb >> 9) & 1) << 5); R = (st >> 1) * 16 + swz / 64; C = (st & 1) * 32 + (swz % 64) / 2; }
__host__ __device__ __forceinline__ int perm32(int rho) { const int n = rho >> 4, i = rho & 15; return 8 * (i >> 2) + 4 * n + (i & 3); }

struct Unit { int pm, pn; };
struct Gemm { const bf16_t* A; const bf16_t* Bt; int M, N, K; };

struct StaticOrder {
    int nM, nN, nwg, G, c;
    __host__ __device__ __forceinline__ void init(int M, int N, int G_, int c_) { nM = M / BM; nN = N / BM; nwg = nM * nN; G = G_; c = c_; }
    __host__ __device__ __forceinline__ bool next(int i, Unit& u) const {
        const long L = (long)i * G + c; if (L >= nwg) return false;
        int wgid = (int)L; { const int q = nwg / NXCD, r = nwg % NXCD, xcd = wgid % NXCD, off = wgid / NXCD; wgid = (xcd < r ? xcd * (q + 1) : r * (q + 1) + (xcd - r) * q) + off; }
        const int nig = WGM * nN, gid = wgid / nig, fm = gid * WGM, gsz = (nM - fm) < WGM ? (nM - fm) : WGM;
        u.pm = fm + ((wgid % nig) % gsz); u.pn = (wgid % nig) / gsz; return true;
    }
    __device__ __forceinline__ void a_ready(const Unit&) const {}
    __device__ __forceinline__ void done(const Unit&) const {}
};

__device__ __forceinline__ unsigned cvt_pk_bf16(float lo, float hi) { unsigned r; asm volatile("v_cvt_pk_bf16_f32 %0, %1, %2" : "=v"(r) : "v"(lo), "v"(hi)); return r; }
typedef float f32x2 __attribute__((ext_vector_type(2)));
__device__ __forceinline__ f32x2 gelu_pk(f32x2 v) {
    const f32x2 av = __builtin_elementwise_abs(v), d = av * 0.2316418882f + 1.0f;
    f32x2 t; t.x = __builtin_amdgcn_rcpf(d.x); t.y = __builtin_amdgcn_rcpf(d.y);
    f32x2 q = t * 0.5307027145f + (-0.7265760135f); q = q * t + 0.7107068705f; q = q * t + (-0.142248368f); q = q * t + 0.127414796f; q = q * t;
    const f32x2 s = (v * v) * (-0.72134752044f);
    f32x2 e; e.x = __builtin_amdgcn_exp2f(s.x); e.y = __builtin_amdgcn_exp2f(s.y);
    const f32x2 m = v * (q * e), r = v - m;
    f32x2 o; o.x = v.x < 0.f ? m.x : r.x; o.y = v.y < 0.f ? m.y : r.y; return o;
}

template <int ACT  > struct EpiBf16 {
    static constexpr bool PERM = true, AFTER_DRAIN = false; static_assert(ACT == 0 || ACT == 1, "EpiBf16: ACT is 0 (none) or 1 (gelu_pk)");
    bf16_t* O; int ldc; const float* bias; int split_cols; size_t split_stride; float scale0;
    __device__ __forceinline__ void operator()(const f32x4 (&acc)[2][2][4][2], const Unit& u, int wr, int wc, int fr, int fq) const {
        const int row0 = u.pm * BM + wr * 64 + fr; int colt = u.pn * BM; bf16_t* base = O;
        float sc = 1.f; if (split_cols) { const int t = colt / split_cols; base += (size_t)t * split_stride; colt -= t * split_cols; if (t == 0) sc = scale0; }
        const int col0 = colt + wc * 32 + 8 * fq, bcol0 = u.pn * BM + wc * 32 + 8 * fq;
        f32x4 bv[2][2];
#pragma unroll
        for (int bj = 0; bj < 2; ++bj)
#pragma unroll
            for (int n = 0; n < 2; ++n) bv[bj][n] = bias ? *(const f32x4*)(bias + bcol0 + bj * HALF + 4 * n) : (f32x4){0.f, 0.f, 0.f, 0.f};
#pragma unroll
        for (int ai = 0; ai < 2; ++ai)
#pragma unroll
            for (int m = 0; m < 4; ++m) { bf16_t* rowp = base + (size_t)(row0 + ai * HALF + m * 16) * ldc + col0;
#pragma unroll
                for (int bj = 0; bj < 2; ++bj) { f32x4 v0 = acc[ai][bj][m][0] + bv[bj][0], v1 = acc[ai][bj][m][1] + bv[bj][1];
                    if (ACT == 1) { f32x2 a = gelu_pk((f32x2){v0[0], v0[1]}), b = gelu_pk((f32x2){v0[2], v0[3]}), c = gelu_pk((f32x2){v1[0], v1[1]}), d = gelu_pk((f32x2){v1[2], v1[3]});
                        v0 = (f32x4){a.x, a.y, b.x, b.y}; v1 = (f32x4){c.x, c.y, d.x, d.y}; }
                    v0 = v0 * sc; v1 = v1 * sc; u32x4 w; w.x = cvt_pk_bf16(v0[0], v0[1]); w.y = cvt_pk_bf16(v0[2], v0[3]); w.z = cvt_pk_bf16(v1[0], v1[1]); w.w = cvt_pk_bf16(v1[2], v1[3]);
                    *(u32x4*)(rowp + bj * HALF) = w; } }
    }
};
template <class Epi, class Sched, bool ALIGN_EPI = false, bool SP2 = false, int FP8SC = -1>
__device__ __forceinline__ void gemm_phase(PG8_LAS unsigned char* lds, const Gemm g, const Sched& S, const Epi& E) {
    int tid_ = threadIdx.x; asm volatile("" : "+v"(tid_));
    const int tid = tid_, wid = __builtin_amdgcn_readfirstlane(tid >> 6), lane = tid & 63, wr = wid >> 2, wc = wid & 3, fr = lane & 15, fq = lane >> 4;
    const int K = g.K, nt = K / BK;
    unsigned voffA[2], voffB[2];
#pragma unroll
    for (int i = 0; i < 2; ++i) { int R, C; stage_rc(tid * 16 + i * 8192, R, C); const int Rb = Epi::PERM ? ((R & ~31) + perm32(R & 31)) : R;
        voffA[i] = (unsigned)(R * K + C) * 2u; voffB[i] = (unsigned)(Rb * K + C) * 2u; }
    const size_t kstep = (size_t)(BK * 2);
    const size_t hstep = (size_t)HALF * K * 2;
    const size_t tstep = 2 * hstep;
    const unsigned ldsw = (unsigned)wid * 1024u;
    const int aoff = lds_byte(wr * 64 + fr, fq * 8), boff = lds_byte(wc * 32 + fr, fq * 8);
#define PG8_SA(b, h) (((b) * 2 + (h)) * HTB)
#define PG8_SB(b, h) ((4 + (b) * 2 + (h)) * HTB)
#define PG8_STAGE(bufoff, gbase, voff) do { _Pragma("unroll") for (int _i = 0; _i < 2; ++_i) \
        __builtin_amdgcn_global_load_lds((const unsigned*)((const char*)(gbase) + (voff)[_i]), (PG8_LAS unsigned*)(lds + (bufoff) + ldsw + _i * 8192), 16, 0, 0); } while (0)
#define PG8_LDA(dst, b, h) do { _Pragma("unroll") for (int m = 0; m < 4; ++m) _Pragma("unroll") for (int k = 0; k < 2; ++k) dst[m][k] = *(const PG8_LAS bf16x8*)(lds + PG8_SA(b, h) + aoff + m * 2048 + k * 1024); } while (0)
#define PG8_LDB(dst, b, h) do { _Pragma("unroll") for (int n = 0; n < 2; ++n) _Pragma("unroll") for (int k = 0; k < 2; ++k) dst[n][k] = *(const PG8_LAS bf16x8*)(lds + PG8_SB(b, h) + boff + n * 2048 + k * 1024); } while (0)
#define PG8_CAT8(x0, x1) __builtin_shufflevector(__builtin_bit_cast(pg8_v4i, x0), __builtin_bit_cast(pg8_v4i, x1), 0, 1, 2, 3, 4, 5, 6, 7)
#define PG8_MMA(ai, bj, At, Bt) do { __builtin_amdgcn_s_setprio(1); \
        if constexpr (FP8SC < 0) { _Pragma("unroll") for (int m = 0; m < 4; ++m) _Pragma("unroll") for (int n = 0; n < 2; ++n) _Pragma("unroll") for (int k = 0; k < 2; ++k) \
            acc[ai][bj][m][n] = __builtin_amdgcn_mfma_f32_16x16x32_bf16(Bt[n][k], At[m][k], acc[ai][bj][m][n], 0, 0, 0); } \
        else if constexpr (FP8SC >= 1000) { _Pragma("unroll") for (int m = 0; m < 4; ++m) _Pragma("unroll") for (int n = 0; n < 2; ++n) _Pragma("unroll") for (int k = 0; k < 2; ++k) { \
            const pg8_v2l bq = __builtin_bit_cast(pg8_v2l, Bt[n][k]), aq = __builtin_bit_cast(pg8_v2l, At[m][k]); \
            acc[ai][bj][m][n] = __builtin_amdgcn_mfma_f32_16x16x32_fp8_fp8(bq[0], aq[0], acc[ai][bj][m][n], 0, 0, 0); acc[ai][bj][m][n] = __builtin_amdgcn_mfma_f32_16x16x32_fp8_fp8(bq[1], aq[1], acc[ai][bj][m][n], 0, 0, 0); } } \
        else { _Pragma("unroll") for (int m = 0; m < 4; ++m) _Pragma("unroll") for (int n = 0; n < 2; ++n) \
            acc[ai][bj][m][n] = __builtin_amdgcn_mfma_scale_f32_16x16x128_f8f6f4(PG8_CAT8(Bt[n][0], Bt[n][1]), PG8_CAT8(At[m][0], At[m][1]), acc[ai][bj][m][n], 0, 0, 0, (FP8SC < 0 ? 127 : FP8SC) * 0x01010101, 0, 0x7f7f7f7f); \
            _Pragma("unroll") for (int m = 0; m < 4; ++m) _Pragma("unroll") for (int n = 0; n < 2; ++n) asm volatile("" : "+v"(acc[ai][bj][m][n])); }     \
        __builtin_amdgcn_s_setprio(0); } while (0)
#define PG8_WAIT_V(n) asm volatile("s_waitcnt vmcnt(" #n ")" ::: "memory")
#define PG8_WAIT_L(n) asm volatile("s_waitcnt lgkmcnt(" #n ")" ::: "memory")
#define PG8_BAR __builtin_amdgcn_s_barrier()
#define PG8_SCHED __builtin_amdgcn_sched_barrier(0)
    Unit cur, nxt; int ui = 0;
    if (!S.next(0, cur)) return;
    f32x4 acc[2][2][4][2];
#pragma unroll
    for (int a = 0; a < 2; ++a)
#pragma unroll
        for (int b = 0; b < 2; ++b)
#pragma unroll
            for (int m = 0; m < 4; ++m)
#pragma unroll
                for (int n = 0; n < 2; ++n) acc[a][b][m][n] = (f32x4){0.f, 0.f, 0.f, 0.f};
    bf16x8 At[4][2], B0[2][2], B1[2][2];
    const char* cA = (const char*)g.A + (size_t)cur.pm * tstep; const char* cB = (const char*)g.Bt + (size_t)cur.pn * tstep;
    S.a_ready(cur);
    if constexpr (SP2) {
        PG8_STAGE(PG8_SB(0, 0), cB, voffB); PG8_STAGE(PG8_SB(0, 1), cB + hstep, voffB); PG8_STAGE(PG8_SA(0, 0), cA, voffA); PG8_STAGE(PG8_SA(0, 1), cA + hstep, voffA);
        if (wr == 1) PG8_BAR;
        PG8_WAIT_V(2); PG8_BAR;
        PG8_STAGE(PG8_SB(1, 0), cB + kstep, voffB); PG8_STAGE(PG8_SA(1, 0), cA + kstep, voffA); PG8_STAGE(PG8_SB(1, 1), cB + hstep + kstep, voffB);
        PG8_WAIT_V(6); PG8_BAR;
    } else {
        PG8_STAGE(PG8_SB(0, 0), cB, voffB); PG8_STAGE(PG8_SA(0, 0), cA, voffA); PG8_STAGE(PG8_SB(0, 1), cB + hstep, voffB); PG8_STAGE(PG8_SA(0, 1), cA + hstep, voffA);
        if (wr == 1) PG8_BAR;
        PG8_WAIT_V(4); PG8_BAR;
        PG8_STAGE(PG8_SB(1, 0), cB + kstep, voffB); PG8_STAGE(PG8_SA(1, 0), cA + kstep, voffA); PG8_STAGE(PG8_SB(1, 1), cB + hstep + kstep, voffB);
        PG8_WAIT_V(6); PG8_BAR;
    }
    for (;;) {
        const bool has_next = S.next(ui + 1, nxt);
        const char* nA = has_next ? (const char*)g.A + (size_t)nxt.pm * tstep : cA; const char* nB = has_next ? (const char*)g.Bt + (size_t)nxt.pn * tstep : cB;
        for (int t = 0; t < nt; t += 2) {
            const bool last = (t == nt - 2);
            const char* a1 = cA + (size_t)(t + 1) * kstep;
            const char* a2 = last ? nA : cA + (size_t)(t + 2) * kstep; const char* b2 = last ? nB : cB + (size_t)(t + 2) * kstep;
            const char* a3 = a2 + kstep; const char* b3 = b2 + kstep;
            if (last && has_next) S.a_ready(nxt);
            if constexpr (SP2) {
            PG8_LDB(B0, 0, 0); PG8_LDB(B1, 0, 1); PG8_SCHED; PG8_LDA(At, 0, 0); PG8_STAGE(PG8_SA(1, 1), a1 + hstep, voffA);
            PG8_WAIT_V(8); PG8_WAIT_L(0); PG8_BAR; PG8_MMA(0, 0, At, B0); PG8_MMA(0, 1, At, B1); PG8_BAR; PG8_SCHED;
            PG8_LDA(At, 0, 1); PG8_STAGE(PG8_SB(0, 0), b2, voffB); PG8_STAGE(PG8_SB(0, 1), b2 + hstep, voffB); PG8_STAGE(PG8_SA(0, 0), a2, voffA);
            PG8_WAIT_V(8); PG8_WAIT_L(0); PG8_BAR; PG8_MMA(1, 0, At, B0); PG8_MMA(1, 1, At, B1); PG8_BAR; PG8_SCHED;
            PG8_LDB(B0, 1, 0); PG8_LDB(B1, 1, 1); PG8_SCHED; PG8_LDA(At, 1, 0); PG8_STAGE(PG8_SA(0, 1), a2 + hstep, voffA);
            PG8_WAIT_V(8); PG8_WAIT_L(0); PG8_BAR; PG8_MMA(0, 0, At, B0); PG8_MMA(0, 1, At, B1); PG8_BAR; PG8_SCHED;
            PG8_LDA(At, 1, 1); PG8_STAGE(PG8_SB(1, 0), b3, voffB); PG8_STAGE(PG8_SB(1, 1), b3 + hstep, voffB); PG8_STAGE(PG8_SA(1, 0), a3, voffA);
            PG8_WAIT_V(8); PG8_WAIT_L(0); PG8_BAR; PG8_MMA(1, 0, At, B0); PG8_MMA(1, 1, At, B1); PG8_BAR; PG8_SCHED;
            } else {
            PG8_LDB(B0, 0, 0); PG8_SCHED; PG8_LDA(At, 0, 0); PG8_STAGE(PG8_SA(1, 1), a1 + hstep, voffA);
            PG8_WAIT_L(8); PG8_BAR; PG8_WAIT_L(0); PG8_MMA(0, 0, At, B0); PG8_BAR; PG8_SCHED;
            PG8_LDB(B1, 0, 1); PG8_STAGE(PG8_SB(0, 0), b2, voffB);
            PG8_BAR; PG8_WAIT_L(0); PG8_MMA(0, 1, At, B1); PG8_BAR;
            PG8_LDA(At, 0, 1); PG8_STAGE(PG8_SA(0, 0), a2, voffA);
            PG8_BAR; PG8_WAIT_L(0); PG8_MMA(1, 0, At, B0); PG8_BAR; PG8_SCHED;
            PG8_STAGE(PG8_SB(0, 1), b2 + hstep, voffB);
            PG8_WAIT_V(6); PG8_BAR; PG8_MMA(1, 1, At, B1); PG8_BAR;
            PG8_LDB(B0, 1, 0); PG8_SCHED; PG8_LDA(At, 1, 0); PG8_STAGE(PG8_SA(0, 1), a2 + hstep, voffA);
            PG8_WAIT_L(8); PG8_BAR; PG8_WAIT_L(0); PG8_MMA(0, 0, At, B0); PG8_BAR; PG8_SCHED;
            PG8_LDB(B1, 1, 1); PG8_STAGE(PG8_SB(1, 0), b3, voffB);
            PG8_BAR; PG8_WAIT_L(0); PG8_MMA(0, 1, At, B1); PG8_BAR;
            PG8_LDA(At, 1, 1); PG8_STAGE(PG8_SA(1, 0), a3, voffA);
            PG8_BAR; PG8_WAIT_L(0); PG8_MMA(1, 0, At, B0); PG8_BAR; PG8_SCHED;
            PG8_STAGE(PG8_SB(1, 1), b3 + hstep, voffB);
            PG8_WAIT_V(6); PG8_BAR; PG8_MMA(1, 1, At, B1); PG8_BAR;
            }
        }
        if constexpr (ALIGN_EPI) { if (wr == 0) PG8_BAR; }
        if constexpr (!Epi::AFTER_DRAIN) { int te_ = threadIdx.x; asm volatile("" : "+v"(te_));
            const int le_ = te_ & 63, we_ = __builtin_amdgcn_readfirstlane(te_ >> 6); E(acc, cur, we_ >> 2, we_ & 3, le_ & 15, le_ >> 4); S.done(cur); }
        if (!has_next) break;
#pragma unroll
        for (int a = 0; a < 2; ++a)
#pragma unroll
            for (int b = 0; b < 2; ++b)
#pragma unroll
                for (int m = 0; m < 4; ++m)
#pragma unroll
                    for (int n = 0; n < 2; ++n) acc[a][b][m][n] = (f32x4){0.f, 0.f, 0.f, 0.f};
        cur = nxt; cA = nA; cB = nB; ++ui;
        if constexpr (ALIGN_EPI) { if (wr == 1) PG8_BAR; }
    }
    PG8_WAIT_V(0);
    if constexpr (!ALIGN_EPI) { if (wr == 0) PG8_BAR; }
    PG8_BAR;
    if constexpr (Epi::AFTER_DRAIN) { E.fused(acc, cur, wr, wc, fr, fq, lds, wid, lane); S.done(cur); }
#undef PG8_SA
#undef PG8_SB
#undef PG8_STAGE
#undef PG8_LDA
#undef PG8_LDB
#undef PG8_MMA
#undef PG8_CAT8
#undef PG8_WAIT_V
#undef PG8_WAIT_L
#undef PG8_BAR
#undef PG8_SCHED
}
}

constexpr int NWAVES = 8;
constexpr int BATCH = 2, SEQ = 8192, T = BATCH * SEQ, D = 1024;
constexpr int AB_IN = 1536, C_IN = 2304, C_OUT = 512;
constexpr int NE = 32, DE = 1024, PLE = 256;
constexpr int NSLOT = 73728;
constexpr float NORM_EPS = 1e-6f;
constexpr float LOG2_THETA = 13.287712379549449f;
constexpr float ATT_C2 = 0.125f * 1.4426950408889634f;

#define GAS __attribute__((address_space(1)))
#define LAS __attribute__((address_space(3)))
typedef unsigned short bf16;
typedef unsigned v4u __attribute__((ext_vector_type(4)));
typedef unsigned v2u __attribute__((ext_vector_type(2)));
typedef float f32x4 __attribute__((ext_vector_type(4)));
typedef GAS unsigned gu32;
#define RLX_AGENT __ATOMIC_RELAXED, __HIP_MEMORY_SCOPE_AGENT
#define LDS_WAIT() asm volatile("s_waitcnt lgkmcnt(0)" ::: "memory")
#define VM_WAIT() asm volatile("s_waitcnt vmcnt(0)" ::: "memory")

__device__ __forceinline__ int lane_opaque() { unsigned m = ~0u; asm volatile("" : "+s"(m)); return (int)__builtin_amdgcn_mbcnt_hi(m, __builtin_amdgcn_mbcnt_lo(m, 0u)); }
__device__ __forceinline__ int shx(int v, int m) { return __builtin_amdgcn_ds_bpermute((lane_opaque() ^ m) << 2, v); }
__device__ __forceinline__ float shx(float v, int m) { return __builtin_bit_cast(float, __builtin_amdgcn_ds_bpermute((lane_opaque() ^ m) << 2, __builtin_bit_cast(int, v))); }
__device__ __forceinline__ int shup(int v, int o) { const int l = lane_opaque(); const int s = (l - o) < 0 ? l : (l - o); return __builtin_amdgcn_ds_bpermute(s << 2, v); }
__device__ __forceinline__ int shl(int v, int src) { return __builtin_amdgcn_ds_bpermute(src << 2, v); }
typedef float f32x2_ __attribute__((ext_vector_type(2))); typedef __bf16 bf16x2_ __attribute__((ext_vector_type(2)));
__device__ __forceinline__ unsigned pk2(float lo, float hi) { f32x2_ v = {lo, hi}; bf16x2_ b = __builtin_convertvector(v, bf16x2_); return __builtin_bit_cast(unsigned, b); }
__device__ __forceinline__ float bflo(unsigned w) { return __builtin_bit_cast(float, w << 16); }
__device__ __forceinline__ float bfhi(unsigned w) { return __builtin_bit_cast(float, w & 0xffff0000u); }
#ifndef MOE_FP8_MASK
#define MOE_FP8_MASK 3
#endif
#ifndef F8_DIAG
#define F8_DIAG 0
#endif
constexpr float F8_EPI_SC = F8_DIAG ? (1.f / 64.f) : 1.f;
#ifndef PROJ_FP8
#define PROJ_FP8 1
#endif
#ifndef NG_PROJ
#define NG_PROJ 64
#endif
#ifndef Y_FP8
#define Y_FP8 1
#endif
#ifndef PLE_FP8
#define PLE_FP8 0
#endif
constexpr float Y_SC = 32.f;
constexpr int F8_WSC = 6;
__device__ __forceinline__ unsigned pk4_fp8(float a, float b, float c, float d) { int w = 0; w = __builtin_amdgcn_cvt_pk_fp8_f32(a, b, w, false); w = __builtin_amdgcn_cvt_pk_fp8_f32(c, d, w, true); return (unsigned)w; }
__device__ __forceinline__ float clamp448(float x) { return fminf(fmaxf(x, -448.f), 448.f); }
__device__ __forceinline__ float rnd_bf(float x) { return bflo(pk2(x, 0.f)); }
__device__ __forceinline__ float ssp_sum(const float* p) { const f32x4 a = *(const f32x4*)p, b = *(const f32x4*)(p + 4), c = *(const f32x4*)(p + 8), d = *(const f32x4*)(p + 12);
    return (((a.x + a.y) + (a.z + a.w)) + ((b.x + b.y) + (b.z + b.w))) + (((c.x + c.y) + (c.z + c.w)) + ((d.x + d.y) + (d.z + d.w))); }

constexpr size_t MiB = 1u << 20;
constexpr size_t al256(size_t x) { return (x + 255) & ~(size_t)255; }
constexpr size_t WS_CTL = 0, CTL_ZERO_BYTES = 1 * MiB;
constexpr size_t WS_WIN0T = 1 * MiB;
constexpr size_t WS_WOUT0T = WS_WIN0T + (size_t)AB_IN * D * 2;
constexpr size_t WS_WIN1T = WS_WOUT0T + (size_t)D * D * 2;
constexpr size_t WS_WOUT1T = WS_WIN1T + (size_t)C_IN * D * 2;
constexpr size_t WS_WGT = WS_WOUT1T + (size_t)D * C_OUT * 2;
constexpr size_t WS_WPT = WS_WGT + 2 * (size_t)D * D * 2;
constexpr size_t WS_WR = WS_WPT + 2 * (size_t)D * PLE * 2;
constexpr size_t WS_ROPE1 = al256(WS_WR + 2 * (size_t)NE * D * 4);
constexpr size_t WS_ROPEA = WS_ROPE1 + (size_t)SEQ * 32 * 8;
constexpr size_t WS_WUPT = WS_ROPEA + (size_t)SEQ * 32 * 8;
constexpr size_t WS_WDNT = WS_WUPT + 2 * (size_t)NE * 2 * DE * D * 2;
constexpr size_t WS_PBF = WS_WDNT + 2 * (size_t)NE * D * DE * 2;
constexpr size_t WS_PP = WS_PBF + 2 * (size_t)T * PLE * 2;
constexpr size_t WS_X0 = WS_PP + 2 * (size_t)T * D * 2;
constexpr size_t WS_HM = WS_X0 + (size_t)T * D * 2;
constexpr size_t WS_H2 = WS_HM + (size_t)T * D * 2;
constexpr size_t WS_H3 = WS_H2 + (size_t)T * D * 2;
constexpr size_t WS_OCAT = WS_H3 + (size_t)T * D * 2;
constexpr size_t WS_SSP = WS_OCAT + (size_t)T * D * 2;
constexpr size_t WS_LSE = WS_SSP + 3 * (size_t)T * 16 * 4;
constexpr size_t WS_TOPE = WS_LSE + 3 * (size_t)T * 8 * 4;
constexpr size_t WS_TOPG = WS_TOPE + (size_t)T * 16;
constexpr size_t WS_TOPPOS = WS_TOPG + (size_t)T * 16;
constexpr size_t WS_RSTD = WS_TOPPOS + (size_t)T * 16;
constexpr size_t WS_TOKSLOT = WS_RSTD + (size_t)T * 4;
constexpr size_t WS_SLOTGATE = WS_TOKSLOT + (size_t)T * 16;
constexpr size_t WS_SLOTRS = WS_SLOTGATE + (size_t)NSLOT * 4;
constexpr size_t WS_XTAB = al256(WS_SLOTRS + (size_t)NSLOT * 4);
constexpr size_t WS_CNTTAB = al256(WS_XTAB + 8 * 136 * 4);
constexpr size_t WS_XG = al256(WS_CNTTAB + 256 * 32 * 4);
constexpr size_t WS_ACT = WS_XG + (size_t)NSLOT * D * 2;
constexpr size_t WS_Y = WS_ACT + (size_t)NSLOT * D * 2;
constexpr size_t WS_Q3 = WS_Y + (size_t)NSLOT * D * 2;
constexpr size_t WS_K3 = WS_Q3 + 3 * (size_t)T * 512 * 2;
constexpr size_t WS_V3 = WS_K3 + 3 * (size_t)T * 128 * 2;
constexpr size_t WS_OGB = WS_V3 + 3 * (size_t)T * 128 * 2;
constexpr size_t WS_H2F8 = WS_OGB + 3 * (size_t)T * 512 * 2;
constexpr size_t WS_HF8 = WS_H2F8 + (size_t)T * D;
constexpr size_t WS_END = WS_HF8 + 2 * (size_t)T * D;
constexpr int CW_TMO = 0;
constexpr int CW_CNT = 64;
constexpr int CW_BAR = 4096;

constexpr int LDSCTL_OFF = 0, MISC_OFF = 64;
constexpr int RING_OFF = 512, RING_BYTES = 131072;
constexpr int LDS_BYTES = 147456;

struct PPOrder {
    int G, c;
    __device__ __forceinline__ bool next(int i, pg8::Unit& u) const {
        int L; if (G == 256) { if (PROJ_FP8) { if (c < 128) { if (i >= 1) return false; L = c; } else { if (i >= 3) return false; L = 128 + (c - 128) * 3 + i; } }
                               else { if (c < 128 || i >= 4) return false; L = (c - 128) * 4 + i; } }
        else { L = i * G + c; if (L >= 512) return false; }
        u.pm = L >> 2; u.pn = 4 * (u.pm >> 6) + (L & 3); return true; }
    __device__ __forceinline__ void a_ready(const pg8::Unit&) const {}
    __device__ __forceinline__ void done(const pg8::Unit&) const {}
};
struct EpiPP {
    static constexpr bool PERM = true, AFTER_DRAIN = false;
    bf16* O;
    __device__ __forceinline__ void operator()(const pg8::f32x4 (&acc)[2][2][4][2], const pg8::Unit& u, int wr, int wc, int fr, int fq) const {
        const int row0 = u.pm * 256 + wr * 64 + fr, col0 = (u.pn & 3) * 256 + wc * 32 + 8 * fq;
#pragma unroll
        for (int ai = 0; ai < 2; ++ai)
#pragma unroll
            for (int m = 0; m < 4; ++m) { bf16* rp = O + (size_t)(row0 + ai * 128 + m * 16) * D + col0;
#pragma unroll
                for (int bj = 0; bj < 2; ++bj) { const pg8::f32x4 v0 = acc[ai][bj][m][0], v1 = acc[ai][bj][m][1];
                    pg8::u32x4 w; w.x = pk2(v0[0], v0[1]); w.y = pk2(v0[2], v0[3]); w.z = pk2(v1[0], v1[1]); w.w = pk2(v1[2], v1[3]);
                    *(pg8::u32x4*)(rp + bj * 128) = w; } }
    }
};
template <int LAYER> struct EpiQKV {
    static constexpr bool PERM = true, AFTER_DRAIN = false;
    const LAS float* RSL; const LAS int* PML;
    const float* qg; const float* kg; const float* rope1; const float* ropea; bf16* Q3; bf16* K3; bf16* V3;
    __device__ __forceinline__ void operator()(const pg8::f32x4 (&acc)[2][2][4][2], const pg8::Unit& u, int wr, int wc, int fr, int fq) const {
        int slot = 0;
#pragma unroll
        for (int i = 7; i >= 0; --i) if (PML[i] == u.pm) slot = i;
        const LAS float* rsl = RSL + slot * 256 + wr * 64 + fr;
        int kind, hd, grp;
        bool axial;
        if (LAYER == 0) { const int t3 = u.pn % 3; grp = u.pn / 3; axial = (grp == 0);
            if (t3 < 2) { kind = 0; hd = 4 * t3 + wc; } else if (wc < 2) { kind = 1; hd = wc; } else { kind = 2; hd = wc - 2; } }
        else { const int t3 = u.pn % 3; grp = u.pn / 3; axial = false;
            if (t3 < 2) { kind = 0; hd = 4 * t3 + wc; } else if (wc < 2) { kind = 1; hd = wc; } else { kind = 2; hd = wc - 2; } }
        const bool norm = axial && kind < 2, rope = kind < 2;
        f32x2_ GA[4], GB[4];
        if (norm) { const float* g = (kind == 0) ? qg : kg;
#pragma unroll
            for (int k = 0; k < 4; ++k) { const int j = 8 * fq + 2 * k; const int d0 = (j < 16) ? j : j + 16; GA[k] = (f32x2_){g[d0], g[d0 + 1]}; GB[k] = (f32x2_){g[d0 + 16], g[d0 + 17]}; } }
        else {
#pragma unroll
            for (int k = 0; k < 4; ++k) { GA[k] = (f32x2_){1.f, 1.f}; GB[k] = GA[k]; } }
        const float qs = (kind == 0) ? ATT_C2 : 1.f;
        const float* rtab = axial ? ropea : rope1;
        bf16* dst; int pitch;
        if (kind == 0) { dst = Q3 + (size_t)grp * T * 512 + hd * 64; pitch = 512; } else if (kind == 1) { dst = K3 + (size_t)grp * T * 128 + hd * 64; pitch = 128; } else { dst = V3 + (size_t)grp * T * 128 + hd * 64; pitch = 128; }
        const int row0 = u.pm * 256 + wr * 64 + fr;
#pragma unroll
        for (int ai = 0; ai < 2; ++ai)
#pragma unroll
          for (int mh = 0; mh < 2; ++mh) {
            f32x4 cs[2][4];
            if (rope) {
#pragma unroll
                for (int mm = 0; mm < 2; ++mm) { const int pos = (row0 + ai * 128 + (2 * mh + mm) * 16) & (SEQ - 1); const f32x4* cp = (const f32x4*)(rtab + ((size_t)pos * 32 + 8 * fq) * 2);
#pragma unroll
                    for (int k = 0; k < 4; ++k) cs[mm][k] = cp[k]; } }
#pragma unroll
            for (int mm = 0; mm < 2; ++mm) { const int m = 2 * mh + mm;
                const int r = row0 + ai * 128 + m * 16; const int pos = r & (SEQ - 1);
                const float rs = rsl[ai * 128 + m * 16];
                f32x2_ A[4], B[4];
#pragma unroll
                for (int n = 0; n < 2; ++n)
#pragma unroll
                    for (int p = 0; p < 2; ++p) { A[2 * n + p] = (f32x2_){acc[ai][0][m][n][2 * p], acc[ai][0][m][n][2 * p + 1]}; B[2 * n + p] = (f32x2_){acc[ai][1][m][n][2 * p], acc[ai][1][m][n][2 * p + 1]}; }
                float sc = rs * qs;
                if (norm) { f32x2_ q2 = A[0] * A[0];
#pragma unroll
                    for (int k = 1; k < 4; ++k) q2 = A[k] * A[k] + q2;
#pragma unroll
                    for (int k = 0; k < 4; ++k) q2 = B[k] * B[k] + q2;
                    float ss = q2.x + q2.y; ss += shx(ss, 16); ss += shx(ss, 32);
                    sc *= __builtin_amdgcn_rsqf(ss * (rs * rs) * (1.f / 64.f) + NORM_EPS);
#pragma unroll
                    for (int k = 0; k < 4; ++k) { A[k] = A[k] * GA[k]; B[k] = B[k] * GB[k]; } }
                if (rope) {
#pragma unroll
                    for (int k = 0; k < 4; ++k) { const f32x4 v = cs[mm][k]; const f32x2_ C = (f32x2_){v.x, v.y} * sc, S = (f32x2_){v.z, v.w} * sc;
                        const f32x2_ x1 = A[k], x2 = B[k]; A[k] = x1 * C - x2 * S; B[k] = x2 * C + x1 * S; } }
                else {
#pragma unroll
                    for (int k = 0; k < 4; ++k) { A[k] = A[k] * sc; B[k] = B[k] * sc; } }
                size_t drow = r;
                if (LAYER == 1) { const int sh = 2 * grp, bb = r >> 13; drow = (size_t)bb * SEQ + (size_t)(pos & ((1 << sh) - 1)) * (SEQ >> sh) + (pos >> sh); }
                bf16* dp = dst + drow * pitch + 8 * fq;
                pg8::u32x4 w0, w1;
                w0.x = pk2(A[0].x, A[0].y); w0.y = pk2(A[1].x, A[1].y); w0.z = pk2(A[2].x, A[2].y); w0.w = pk2(A[3].x, A[3].y);
                w1.x = pk2(B[0].x, B[0].y); w1.y = pk2(B[1].x, B[1].y); w1.z = pk2(B[2].x, B[2].y); w1.w = pk2(B[3].x, B[3].y);
                *(pg8::u32x4*)dp = w0; *(pg8::u32x4*)(dp + 32) = w1;
            }
            asm volatile("" ::: "memory");
        }
    }
};
struct EpiResBf16 {
    static constexpr bool PERM = true, AFTER_DRAIN = false;
    const bf16* R; bf16* O;
    __device__ __forceinline__ void operator()(const pg8::f32x4 (&acc)[2][2][4][2], const pg8::Unit& u, int wr, int wc, int fr, int fq) const {
        const int row0 = u.pm * 256 + wr * 64 + fr, col0 = u.pn * 256 + wc * 32 + 8 * fq;
#pragma unroll
        for (int ai = 0; ai < 2; ++ai) {
            v4u rr[4][2];
#pragma unroll
            for (int m = 0; m < 4; ++m)
#pragma unroll
                for (int bj = 0; bj < 2; ++bj) rr[m][bj] = *(const v4u*)(R + (size_t)(row0 + ai * 128 + m * 16) * D + col0 + bj * 128);
#pragma unroll
            for (int m = 0; m < 4; ++m) { const size_t ro = (size_t)(row0 + ai * 128 + m * 16) * D + col0;
#pragma unroll
                for (int bj = 0; bj < 2; ++bj) { const pg8::f32x4 v0 = acc[ai][bj][m][0], v1 = acc[ai][bj][m][1]; const v4u r4 = rr[m][bj];
                    pg8::u32x4 w; w.x = pk2(v0[0] + bflo(r4.x), v0[1] + bfhi(r4.x)); w.y = pk2(v0[2] + bflo(r4.y), v0[3] + bfhi(r4.y)); w.z = pk2(v1[0] + bflo(r4.z), v1[1] + bfhi(r4.z)); w.w = pk2(v1[2] + bflo(r4.w), v1[3] + bfhi(r4.w));
                    *(pg8::u32x4*)(O + ro + bj * 128) = w; } }
            asm volatile("" ::: "memory"); }
    }
};
__device__ __forceinline__ float sigmoidf_(float x) { return __builtin_amdgcn_rcpf(1.0f + __builtin_amdgcn_exp2f(-1.4426950408889634f * x)); }
__device__ __forceinline__ float swiglu1(float g, float l) {
    g = fminf(g, 7.0f); l = fminf(fmaxf(l, -7.0f), 7.0f);
    return g * sigmoidf_(1.702f * g) * (l + 1.0f);
}
__device__ __forceinline__ f32x2_ swiglu2(f32x2_ g, f32x2_ l) {
    g = __builtin_elementwise_min(g, (f32x2_){7.0f, 7.0f}); l = __builtin_elementwise_min(__builtin_elementwise_max(l, (f32x2_){-7.0f, -7.0f}), (f32x2_){7.0f, 7.0f});
    const f32x2_ t = g * (-1.702f * 1.4426950408889634f); f32x2_ e; e.x = __builtin_amdgcn_exp2f(t.x); e.y = __builtin_amdgcn_exp2f(t.y);
    const f32x2_ d = e + 1.0f; f32x2_ s; s.x = __builtin_amdgcn_rcpf(d.x); s.y = __builtin_amdgcn_rcpf(d.y);
    return (g * s) * (l + 1.0f);
}
template <bool F8> struct EpiSwiglu {
    static constexpr bool PERM = true, AFTER_DRAIN = false;
    void* ACT; const float* bup; const float* rsl;
    __device__ __forceinline__ void operator()(const pg8::f32x4 (&acc)[2][2][4][2], const pg8::Unit& u, int wr, int wc, int fr, int fq) const {
        const int e = u.pn >> 3, j = u.pn & 7; const int row0 = u.pm * 256 + wr * 64 + fr, a0 = j * 128 + wc * 32 + 8 * fq;
        const float* bp = bup + (size_t)e * 2048 + 2 * a0; pg8::f32x4 b[4];
#pragma unroll
        for (int i = 0; i < 4; ++i) b[i] = *(const pg8::f32x4*)(bp + 4 * i);
#pragma unroll
        for (int ai = 0; ai < 2; ++ai)
#pragma unroll
            for (int m = 0; m < 4; ++m) { const int r = row0 + ai * 128 + m * 16; const float rs = F8 ? F8_EPI_SC : rsl[r];
                const pg8::f32x4 g0 = acc[ai][0][m][0] * rs, g1 = acc[ai][0][m][1] * rs, l0 = acc[ai][1][m][0] * rs, l1 = acc[ai][1][m][1] * rs;
                float o[8];
                { const f32x2_ r0 = swiglu2((f32x2_){g0[0] + b[0][0], g0[1] + b[0][2]}, (f32x2_){l0[0] + b[0][1], l0[1] + b[0][3]}), r1 = swiglu2((f32x2_){g0[2] + b[1][0], g0[3] + b[1][2]}, (f32x2_){l0[2] + b[1][1], l0[3] + b[1][3]});
                  const f32x2_ r2 = swiglu2((f32x2_){g1[0] + b[2][0], g1[1] + b[2][2]}, (f32x2_){l1[0] + b[2][1], l1[1] + b[2][3]}), r3 = swiglu2((f32x2_){g1[2] + b[3][0], g1[3] + b[3][2]}, (f32x2_){l1[2] + b[3][1], l1[3] + b[3][3]});
                  o[0] = r0.x; o[1] = r0.y; o[2] = r1.x; o[3] = r1.y; o[4] = r2.x; o[5] = r2.y; o[6] = r3.x; o[7] = r3.y; }
                if (F8) { v2u w; w.x = pk4_fp8(o[0], o[1], o[2], o[3]); w.y = pk4_fp8(o[4], o[5], o[6], o[7]); *(v2u*)((unsigned char*)ACT + (size_t)r * DE + a0) = w; }
                else { pg8::u32x4 w; w.x = pk2(o[0], o[1]); w.y = pk2(o[2], o[3]); w.z = pk2(o[4], o[5]); w.w = pk2(o[6], o[7]); *(pg8::u32x4*)((bf16*)ACT + (size_t)r * DE + a0) = w; } }
    }
};
struct EpiNull {
    static constexpr bool PERM = true, AFTER_DRAIN = false;
    float* O;
    __device__ __forceinline__ void operator()(const pg8::f32x4 (&acc)[2][2][4][2], const pg8::Unit& u, int wr, int wc, int fr, int fq) const {
        pg8::f32x4 s = {0.f, 0.f, 0.f, 0.f};
#pragma unroll
        for (int ai = 0; ai < 2; ++ai)
#pragma unroll
            for (int bj = 0; bj < 2; ++bj)
#pragma unroll
                for (int m = 0; m < 4; ++m)
#pragma unroll
                    for (int n = 0; n < 2; ++n) s += acc[ai][bj][m][n];
        *(pg8::f32x4*)(O + (size_t)(threadIdx.x + 512 * (u.pm & 63)) * 4) = s;
    }
};
template <bool Y8> struct EpiDown {
    static constexpr bool PERM = true, AFTER_DRAIN = false;
    void* Y; const float* bdn; const float* gate; float asc;
    __device__ __forceinline__ void operator()(const pg8::f32x4 (&acc)[2][2][4][2], const pg8::Unit& u, int wr, int wc, int fr, int fq) const {
        const int e = u.pn >> 2, j = u.pn & 3; const int row0 = u.pm * 256 + wr * 64 + fr, col0 = j * 256 + wc * 32 + 8 * fq;
        pg8::f32x4 bv[2][2];
#pragma unroll
        for (int bj = 0; bj < 2; ++bj)
#pragma unroll
            for (int n = 0; n < 2; ++n) bv[bj][n] = *(const pg8::f32x4*)(bdn + (size_t)e * D + col0 + bj * 128 + 4 * n);
#pragma unroll
        for (int ai = 0; ai < 2; ++ai)
#pragma unroll
            for (int m = 0; m < 4; ++m) { const int r = row0 + ai * 128 + m * 16; const float gt = gate[r] * (Y8 ? Y_SC : 1.f);
#pragma unroll
                for (int bj = 0; bj < 2; ++bj) { const pg8::f32x4 v0 = (acc[ai][bj][m][0] * asc + bv[bj][0]) * gt, v1 = (acc[ai][bj][m][1] * asc + bv[bj][1]) * gt;
                    if (Y8) { v2u w; w.x = pk4_fp8(clamp448(v0[0]), clamp448(v0[1]), clamp448(v0[2]), clamp448(v0[3])); w.y = pk4_fp8(clamp448(v1[0]), clamp448(v1[1]), clamp448(v1[2]), clamp448(v1[3])); *(v2u*)((unsigned char*)Y + (size_t)r * D + col0 + bj * 128) = w; }
                    else { pg8::u32x4 w; w.x = pk2(v0[0], v0[1]); w.y = pk2(v0[2], v0[3]); w.z = pk2(v1[0], v1[1]); w.w = pk2(v1[2], v1[3]); *(pg8::u32x4*)((bf16*)Y + (size_t)r * D + col0 + bj * 128) = w; } } }
    }
};
struct EpiPle {
    static constexpr bool PERM = true, AFTER_DRAIN = false;
    const bf16* H2; const bf16* PP; bf16* H3; float* SS; unsigned char* H8;
    __device__ __forceinline__ void operator()(const pg8::f32x4 (&acc)[2][2][4][2], const pg8::Unit& u, int wr, int wc, int fr, int fq) const {
        const int row0 = u.pm * 256 + wr * 64 + fr, col0 = u.pn * 256 + wc * 32 + 8 * fq;
#pragma unroll
        for (int ai = 0; ai < 2; ++ai) {
            v4u hh[4][2], pp[4][2];
#pragma unroll
            for (int m = 0; m < 4; ++m)
#pragma unroll
                for (int bj = 0; bj < 2; ++bj) { const size_t o = (size_t)(row0 + ai * 128 + m * 16) * D + col0 + bj * 128; hh[m][bj] = *(const v4u*)(H2 + o); pp[m][bj] = *(const v4u*)(PP + o); }
#pragma unroll
            for (int m = 0; m < 4; ++m) { const int r = row0 + ai * 128 + m * 16; const size_t ro = (size_t)r * D + col0; float ss = 0.f;
#pragma unroll
                for (int bj = 0; bj < 2; ++bj) { const pg8::f32x4 a0 = acc[ai][bj][m][0], a1 = acc[ai][bj][m][1]; const v4u h = hh[m][bj], p = pp[m][bj];
                    pg8::u32x4 w;
                    w.x = pk2(bflo(h.x) + bflo(p.x) * sigmoidf_(a0[0]), bfhi(h.x) + bfhi(p.x) * sigmoidf_(a0[1])); w.y = pk2(bflo(h.y) + bflo(p.y) * sigmoidf_(a0[2]), bfhi(h.y) + bfhi(p.y) * sigmoidf_(a0[3]));
                    w.z = pk2(bflo(h.z) + bflo(p.z) * sigmoidf_(a1[0]), bfhi(h.z) + bfhi(p.z) * sigmoidf_(a1[1])); w.w = pk2(bflo(h.w) + bflo(p.w) * sigmoidf_(a1[2]), bfhi(h.w) + bfhi(p.w) * sigmoidf_(a1[3]));
                    *(pg8::u32x4*)(H3 + ro + bj * 128) = w;
                    if (H8) { v2u q; q.x = pk4_fp8(clamp448(bflo(w.x)), clamp448(bfhi(w.x)), clamp448(bflo(w.y)), clamp448(bfhi(w.y))); q.y = pk4_fp8(clamp448(bflo(w.z)), clamp448(bfhi(w.z)), clamp448(bflo(w.w)), clamp448(bfhi(w.w))); *(v2u*)(H8 + ro + bj * 128) = q; }
                    ss += (bflo(w.x) * bflo(w.x) + bfhi(w.x) * bfhi(w.x)) + (bflo(w.y) * bflo(w.y) + bfhi(w.y) * bfhi(w.y)) + (bflo(w.z) * bflo(w.z) + bfhi(w.z) * bfhi(w.z)) + (bflo(w.w) * bflo(w.w) + bfhi(w.w) * bfhi(w.w)); }
                ss += shx(ss, 16); ss += shx(ss, 32);
                if (fq == 0) SS[(size_t)r * 16 + u.pn * 4 + wc] = ss; }
            asm volatile("" ::: "memory"); }
    }
};
template <int LJ> struct XcdOrder {
    const int* tab; int rank, stride;
    __device__ __forceinline__ bool next(int i, pg8::Unit& u) const {
        const int q = i * stride + rank, p = q >> LJ, j = q & ((1 << LJ) - 1); const int ne = tab[0], tot = tab[1]; if (p >= tot) return false;
        int s = 0; while (s + 1 < ne && tab[4 + 4 * (s + 1) + 3] <= p) ++s;
        u.pm = tab[4 + 4 * s + 1] + (p - tab[4 + 4 * s + 3]); u.pn = (tab[4 + 4 * s] << LJ) + j; return true; }
    __device__ __forceinline__ void a_ready(const pg8::Unit&) const {}
    __device__ __forceinline__ void done(const pg8::Unit&) const {}
};
#include <hip/hip_bf16.h>
#include <cmath>
namespace attn_body {
using bf16=__hip_bfloat16;
using bf16x8=__attribute__((ext_vector_type(8)))short;
using s16x4=__attribute__((ext_vector_type(4)))short;
using f32x16=__attribute__((ext_vector_type(16)))float;
using u32x4=__attribute__((ext_vector_type(4)))unsigned;
constexpr int D=64,QP=512,KVP=128;
constexpr int NW=8,QBLK=32,QB=QBLK*NW,KVBLK=64;
constexpr int ATTN_UNIT_ROWS=QB;
__device__ __forceinline__ int crow(int r,int hi){return (r&3)+8*(r>>2)+4*hi;}
#define SBAR() __builtin_amdgcn_sched_barrier(0)
__device__ __forceinline__ void cmask(f32x16&p0,f32x16&p1,int jb,int qrel,int hi){
  const float NEG=-INFINITY; int kb=64*jb+4*hi;
  #pragma unroll
  for(int r=0;r<16;++r){int kv=kb+(r&3)+8*(r>>2); if(kv>qrel)p0[r]=NEG; if(kv+32>qrel)p1[r]=NEG;}
}

__device__ __forceinline__ void bmask(f32x16&p0,f32x16&p1,int t,int dqb,int W){
  const float NEG=-INFINITY; const int kb=64*t+dqb;
  #pragma unroll
  for(int r=0;r<16;++r){const int d=kb+(r&3)+8*(r>>2); if(d>W||d<-W)p0[r]=NEG; if(d+32>W||d+32<-W)p1[r]=NEG;}
}
constexpr int NSLOT=3, SLOTB=8192;
constexpr int LDS_K=0, LDS_V=NSLOT*SLOTB, LDS_WS=2*NSLOT*SLOTB, LDS_OST=LDS_WS+NW*64*4, LDS_BYTES=LDS_OST+NW*4096;
constexpr float C2=0.125f*1.4426950408889634f;
__device__ __forceinline__ void glds16(const void*gsrc,unsigned lds_dst){unsigned keep;
  asm volatile("s_mov_b32 %0, m0\n\ts_mov_b32 m0, %2\n\ts_nop 0\n\tglobal_load_lds_dwordx4 %1, off\n\ts_mov_b32 m0, %0":"=&s"(keep):"v"(gsrc),"s"(lds_dst):"memory");}
__device__ __forceinline__ float max3f(float a,float b,float c){float r;asm("v_max3_f32 %0, %1, %2, %3":"=v"(r):"v"(a),"v"(b),"v"(c));return r;}
__device__ __forceinline__ float max2f(float a,float b){float r;asm("v_max_f32_e32 %0, %1, %2":"=v"(r):"v"(a),"v"(b));return r;}
__device__ __forceinline__ float fadd_s(float a,float b){float r;asm("v_add_f32_e32 %0, %1, %2":"=v"(r):"v"(a),"v"(b));return r;}
__device__ __forceinline__ float fsub_s(float a,float b){float r;asm("v_sub_f32_e32 %0, %1, %2":"=v"(r):"v"(a),"v"(b));return r;}
typedef float f32x2_t __attribute__((ext_vector_type(2))); typedef __bf16 bf16x2_t __attribute__((ext_vector_type(2)));
__device__ __forceinline__ unsigned cvtpk_s(float lo,float hi){f32x2_t v={lo,hi};bf16x2_t b=__builtin_convertvector(v,bf16x2_t);return __builtin_bit_cast(unsigned,b);}
#define WAIT_BAR(N) asm volatile("s_waitcnt vmcnt(" #N ") lgkmcnt(0)\n\ts_barrier":::"memory")

__device__ __forceinline__ void qkt(f32x16&p0,f32x16&p1,const char*Kslot,const bf16x8*qr,const f32x16&negm,int r32,int hi){
  const char*kb=Kslot+hi*1024+r32*16;
  #pragma unroll
  for(int d0=0;d0<4;++d0){
    const bf16x8 b0=*reinterpret_cast<const bf16x8*>(kb+d0*2048);
    const bf16x8 b1=*reinterpret_cast<const bf16x8*>(kb+d0*2048+512);
    if(d0==0){p0=__builtin_amdgcn_mfma_f32_32x32x16_bf16(b0,qr[0],negm,0,0,0);p1=__builtin_amdgcn_mfma_f32_32x32x16_bf16(b1,qr[0],negm,0,0,0);}
    else{p0=__builtin_amdgcn_mfma_f32_32x32x16_bf16(b0,qr[d0],p0,0,0,0);p1=__builtin_amdgcn_mfma_f32_32x32x16_bf16(b1,qr[d0],p1,0,0,0);}}
}
typedef __attribute__((address_space(3))) const char* lds_cptr;
typedef short v4i16_t __attribute__((ext_vector_type(4)));
__device__ __forceinline__ void kload8(bf16x8*kf,lds_cptr kp){
  kf[0]=*(const __attribute__((address_space(3))) bf16x8*)(kp);      kf[1]=*(const __attribute__((address_space(3))) bf16x8*)(kp+512);
  kf[2]=*(const __attribute__((address_space(3))) bf16x8*)(kp+2048); kf[3]=*(const __attribute__((address_space(3))) bf16x8*)(kp+2560);
  kf[4]=*(const __attribute__((address_space(3))) bf16x8*)(kp+4096); kf[5]=*(const __attribute__((address_space(3))) bf16x8*)(kp+4608);
  kf[6]=*(const __attribute__((address_space(3))) bf16x8*)(kp+6144); kf[7]=*(const __attribute__((address_space(3))) bf16x8*)(kp+6656);
}
__device__ __forceinline__ void kload2(bf16x8*kf,lds_cptr kp,int j){ kf[2*j]=*(const __attribute__((address_space(3))) bf16x8*)(kp+j*2048); kf[2*j+1]=*(const __attribute__((address_space(3))) bf16x8*)(kp+j*2048+512); }
__device__ __forceinline__ s16x4 vtr(lds_cptr p){ return __builtin_bit_cast(s16x4,__builtin_amdgcn_ds_read_tr16_b64_v4i16((__attribute__((address_space(3))) v4i16_t*)p)); }
__device__ __forceinline__ float rowmax(const f32x16&p0,const f32x16&p1){
  float a=max3f(p0[0],p0[1],p1[0]),b=max3f(p0[2],p0[3],p1[1]);a=max3f(a,p1[2],p1[3]);
  #pragma unroll
  for(int r=4;r<16;r+=4){a=max3f(a,p0[r],p0[r+1]);b=max3f(b,p0[r+2],p0[r+3]);a=max3f(a,p1[r],p1[r+1]);b=max3f(b,p1[r+2],p1[r+3]);}
  const float m=max2f(a,b);
  auto rr=__builtin_amdgcn_permlane32_swap(__float_as_uint(m),__float_as_uint(m),false,false);
  return max2f(__uint_as_float(rr[0]),__uint_as_float(rr[1]));
}
__device__ __forceinline__ void pv(f32x16*o,int vb,bf16x8 pa0,bf16x8 pa1,bf16x8 pa2,bf16x8 pa3){
  #pragma unroll
  for(int d0=0;d0<2;++d0){s16x4 lo[4],hi[4];
    #pragma unroll
    for(int ks=0;ks<4;++ks){
      asm volatile("ds_read_b64_tr_b16 %0,%1 offset:%c2":"=&v"(lo[ks]):"v"(vb),"i"(d0*4096+ks*1024):"memory");
      asm volatile("ds_read_b64_tr_b16 %0,%1 offset:%c2":"=&v"(hi[ks]):"v"(vb),"i"(d0*4096+ks*1024+512):"memory");}
    asm volatile("s_waitcnt lgkmcnt(0)":::"memory");SBAR();
    #define PK(k) (bf16x8){lo[k][0],lo[k][1],lo[k][2],lo[k][3],hi[k][0],hi[k][1],hi[k][2],hi[k][3]}
    o[d0]=__builtin_amdgcn_mfma_f32_32x32x16_bf16(pa0,PK(0),o[d0],0,0,0);
    o[d0]=__builtin_amdgcn_mfma_f32_32x32x16_bf16(pa1,PK(1),o[d0],0,0,0);
    o[d0]=__builtin_amdgcn_mfma_f32_32x32x16_bf16(pa2,PK(2),o[d0],0,0,0);
    o[d0]=__builtin_amdgcn_mfma_f32_32x32x16_bf16(pa3,PK(3),o[d0],0,0,0);
    #undef PK
  }
}

#ifndef ATTN_STORE16
#define ATTN_STORE16(p,v) (*(u32x4*)(p)=(v))
#endif
template<int MODE,int OP,int THRL,int HPU=1> __device__ __forceinline__ void attn_unit(const bf16*Qu,const bf16*__restrict__ Ku,const bf16*__restrict__ Vu,bf16*Ou,int NT,int dq0,int W,float sinkl2,bool has_sink,float*lse,char*shm){
  int tid_=threadIdx.x; asm volatile("":"+v"(tid_));
  const int tid=tid_,lane=tid&63,r32=lane&31,hi=lane>>5; const int wid=__builtin_amdgcn_readfirstlane(tid>>6);
  const int wh=(HPU==1)?0:wid/(8/HPU), wrow=(HPU==1)?wid:wid%(8/HPU);
  const bf16*Qw=Qu+(long)(wrow*QBLK)*QP+wh*D;
  const unsigned lds0=(unsigned)(uintptr_t)shm;
  float*wsf=(float*)(shm+LDS_WS)+wid*64;
  const bf16*ksrc=Ku+(long)lane*KVP+wid*8;
  const bf16*vsrc=Vu+(long)(16*(wid&3)+(lane>>2))*KVP+(wid>>2)*32+(lane&3)*8;
  const unsigned kdst=lds0+LDS_K+wid*1024, vdst=lds0+LDS_V+wid*1024;
  #define DMA_K(t,slot) glds16(ksrc+(long)(t)*KVBLK*KVP,(unsigned)__builtin_amdgcn_readfirstlane(kdst+(slot)))
  #define DMA_V(t,slot) glds16(vsrc+(long)(t)*KVBLK*KVP,(unsigned)__builtin_amdgcn_readfirstlane(vdst+(slot)))
  const int vb0=(int)(lds0+LDS_V)+((lane>>4)&1)*32+(lane&3)*8+(4*hi+((lane&15)>>2))*64;
  const char*Kbase=shm+LDS_K; bf16x8 kf[8];
  const lds_cptr shm3=(lds_cptr)shm; const lds_cptr kp0=shm3+LDS_K+hi*1024+r32*16; const lds_cptr vp0=shm3+LDS_V+((lane>>4)&1)*32+(lane&3)*8+(4*hi+((lane&15)>>2))*64;
  DMA_K(0,0);DMA_V(0,0);DMA_K(1,SLOTB);
  bf16x8 qr[4];
  #pragma unroll
  for(int d0=0;d0<4;++d0)qr[d0]=*reinterpret_cast<const bf16x8*>(&Qw[(long)r32*QP+d0*16+hi*8]);
  float mhat=0.f,l_reg=0.f;f32x16 o[2];o[0]=f32x16{};o[1]=f32x16{};f32x16 negm=f32x16{};asm volatile("":"+v"(negm));
  const int dqb=dq0-(wrow*QBLK+r32)+4*hi;
  #define CMASK(P0,P1,t) do{ if(MODE==1) bmask(P0,P1,(t),dqb,W); }while(0)
  bool resc=false;
  #define START(P0,P1) do{ float rm=rowmax(P0,P1); if(MODE==1) rm=fmaxf(rm,-60.f); resc=false; \
    { const float dl=rm; mhat=fadd_s(mhat,dl); \
      _Pragma("unroll") for(int r=0;r<16;++r){P0[r]=fsub_s(P0[r],dl);P1[r]=fsub_s(P1[r],dl);} \
      _Pragma("unroll") for(int r=0;r<16;++r)negm[r]=-mhat; asm volatile("":"+v"(negm)); } \
    _Pragma("unroll") for(int r=0;r<16;++r)P0[r]=__builtin_amdgcn_exp2f(P0[r]); }while(0)
  #define RESC() do{ if(resc){ asm volatile("s_waitcnt lgkmcnt(0)":::"memory"); \
      _Pragma("unroll") for(int d_=0;d_<2;++d_) _Pragma("unroll") for(int r=0;r<16;++r)o[d_][r]*=wsf[crow(r,hi)]; } }while(0)
  f32x16 pA0,pA1,pB0,pB1;
  int sl_prev=0,sl_cur=0,sl_next=SLOTB;
  #define ROT() do{sl_prev=sl_cur;sl_cur=sl_next;sl_next=(sl_next==(NSLOT-1)*SLOTB)?0:sl_next+SLOTB;}while(0)
  DMA_K(2,2*SLOTB);
  WAIT_BAR(3);
  qkt(pA0,pA1,Kbase,qr,negm,r32,hi);asm volatile("s_nop 15\n\ts_nop 7":"+v"(pA0),"+v"(pA1));CMASK(pA0,pA1,0);
  START(pA0,pA1);
  _Pragma("unroll") for(int r=0;r<16;++r)pA1[r]=__builtin_amdgcn_exp2f(pA1[r]);
  WAIT_BAR(0);
  DMA_K(3,0);DMA_V(1,SLOTB);
  ROT();
  kload8(kf,kp0+sl_cur);
  WAIT_BAR(2);
  s16x4 vlo[8],vhi[8]; u32x4 pw0,pw1,pw2,pw3;
  #define PKW(P,B) cvtpk_s(P[B],P[B+1])
  #define PAF(k) __builtin_bit_cast(bf16x8,pw##k)
  #define VFR(i) (bf16x8){vlo[i][0],vlo[i][1],vlo[i][2],vlo[i][3],vhi[i][0],vhi[i][1],vhi[i][2],vhi[i][3]}
  #define PIN(x) asm volatile("":"+v"(x))
  #define MX3(a,b,c) __builtin_fmaxf(__builtin_fmaxf((a),(b)),(c))
  #define GAPA(MF,A0,A1,A2,A3,W0,W1,PW) do{ MF; sacc+=A0; sacc+=A1; sacc+=A2; sacc+=A3; PIN(sacc); W0; W1; PIN(PW); SBAR(); }while(0)
  #define EX(v) __builtin_amdgcn_exp2f(v)
  #define GAPB(MF,X,B) do{ MF; X[B]=EX(X[B]); X[B+1]=EX(X[B+1]); X[B+2]=EX(X[B+2]); X[B+3]=EX(X[B+3]); PIN(X); SBAR(); }while(0)
  #define VRD(i) do{ vlo[i]=vtr(vp_+(((i)>>2)*4096+((i)&3)*1024)); vhi[i]=vtr(vp_+(((i)>>2)*4096+((i)&3)*1024+512)); }while(0)
  #define KRD(G,j) do{ if(G){ kload2(kf,kp0+sl_next,j); SBAR(); } }while(0)
  #define STEP(C0,C1,P0,P1,t,GK,GV,GL) do{ SBAR(); \
    const lds_cptr vp_=vp0+sl_prev; \
    VRD(0); SBAR(); float sacc=(P0[0]+P0[1]); \
    GAPA(C0=__builtin_amdgcn_mfma_f32_32x32x16_bf16(kf[0],qr[0],negm,0,0,0), P0[2],P0[3],P0[4],P0[5],     pw0[0]=PKW(P0,0), pw0[1]=PKW(P0,2), pw0); \
    VRD(4); SBAR(); GAPA(C1=__builtin_amdgcn_mfma_f32_32x32x16_bf16(kf[1],qr[0],negm,0,0,0), P0[6],P0[7],P0[8],P0[9],     pw0[2]=PKW(P0,4), pw0[3]=PKW(P0,6), pw0); \
    VRD(1); SBAR(); GAPA(C0=__builtin_amdgcn_mfma_f32_32x32x16_bf16(kf[2],qr[1],C0,0,0,0),   P0[10],P0[11],P0[12],P0[13], pw1[0]=PKW(P0,8), pw1[1]=PKW(P0,10), pw1); \
    VRD(5); SBAR(); GAPA(C1=__builtin_amdgcn_mfma_f32_32x32x16_bf16(kf[3],qr[1],C1,0,0,0),   P0[14],P0[15],P1[0],P1[1],   pw1[2]=PKW(P0,12),pw1[3]=PKW(P0,14), pw1); \
    VRD(2); SBAR(); GAPA(C0=__builtin_amdgcn_mfma_f32_32x32x16_bf16(kf[4],qr[2],C0,0,0,0),   P1[2],P1[3],P1[4],P1[5],     pw2[0]=PKW(P1,0), pw2[1]=PKW(P1,2), pw2); \
    VRD(6); SBAR(); GAPA(C1=__builtin_amdgcn_mfma_f32_32x32x16_bf16(kf[5],qr[2],C1,0,0,0),   P1[6],P1[7],P1[8],P1[9],     pw2[2]=PKW(P1,4), pw2[3]=PKW(P1,6), pw2); \
    VRD(3); SBAR(); GAPA(C0=__builtin_amdgcn_mfma_f32_32x32x16_bf16(kf[6],qr[3],C0,0,0,0),   P1[10],P1[11],P1[12],P1[13], pw3[0]=PKW(P1,8), pw3[1]=PKW(P1,10), pw3); \
    VRD(7); SBAR(); GAPA(C1=__builtin_amdgcn_mfma_f32_32x32x16_bf16(kf[7],qr[3],C1,0,0,0),   P1[14],P1[15],0.f,0.f,       pw3[2]=PKW(P1,12),pw3[3]=PKW(P1,14), pw3); \
    l_reg+=sacc; \
    if(GK){DMA_K((t)+3,sl_cur);} if(GV){DMA_V((t)+1,sl_next);} \
    CMASK(C0,C1,t); \
    { float a=MX3(C0[0],C0[1],C1[0]),b=MX3(C0[2],C0[3],C1[1]); a=MX3(a,C1[2],C1[3]); \
      _Pragma("unroll") for(int r=4;r<16;r+=4){a=MX3(a,C0[r],C0[r+1]);b=MX3(b,C0[r+2],C0[r+3]);a=MX3(a,C1[r],C1[r+1]);b=MX3(b,C1[r+2],C1[r+3]);} \
      float rm=__builtin_fmaxf(a,b); { auto rr=__builtin_amdgcn_permlane32_swap(__float_as_uint(rm),__float_as_uint(rm),false,false); rm=__builtin_fmaxf(__uint_as_float(rr[0]),__uint_as_float(rr[1])); } \
      resc=false; \
      if(__builtin_expect(__any(rm>(float)THRL),0)){ const float dl=__builtin_fmaxf(rm,0.f); mhat+=dl; \
        _Pragma("unroll") for(int r=0;r<16;++r){C0[r]-=dl;C1[r]-=dl;} \
        _Pragma("unroll") for(int r=0;r<16;++r)negm[r]=-mhat; asm volatile("":"+v"(negm)); \
        const float f=__builtin_amdgcn_exp2f(-dl); l_reg*=f; if(hi==0)wsf[r32]=f; resc=true; } } \
    SBAR(); \
    GAPB(o[0]=__builtin_amdgcn_mfma_f32_32x32x16_bf16(PAF(0),VFR(0),o[0],0,0,0), C0,0); \
    GAPB(o[1]=__builtin_amdgcn_mfma_f32_32x32x16_bf16(PAF(0),VFR(4),o[1],0,0,0), C0,4); \
    KRD(GL,0); GAPB(o[0]=__builtin_amdgcn_mfma_f32_32x32x16_bf16(PAF(1),VFR(1),o[0],0,0,0), C0,8); \
    KRD(GL,1); GAPB(o[1]=__builtin_amdgcn_mfma_f32_32x32x16_bf16(PAF(1),VFR(5),o[1],0,0,0), C0,12); \
    KRD(GL,2); GAPB(o[0]=__builtin_amdgcn_mfma_f32_32x32x16_bf16(PAF(2),VFR(2),o[0],0,0,0), C1,0); \
    KRD(GL,3); GAPB(o[1]=__builtin_amdgcn_mfma_f32_32x32x16_bf16(PAF(2),VFR(6),o[1],0,0,0), C1,4); \
    GAPB(o[0]=__builtin_amdgcn_mfma_f32_32x32x16_bf16(PAF(3),VFR(3),o[0],0,0,0), C1,8); \
    GAPB(o[1]=__builtin_amdgcn_mfma_f32_32x32x16_bf16(PAF(3),VFR(7),o[1],0,0,0), C1,12); \
    }while(0)
  int t=1;
  for(;t+5<NT;t+=2){
    STEP(pB0,pB1,pA0,pA1,t,true,true,true);     WAIT_BAR(2); RESC(); ROT();
    STEP(pA0,pA1,pB0,pB1,t+1,true,true,true);   WAIT_BAR(2); RESC(); ROT();
  }
  #define ENDW(tt) do{ if((tt)+3<NT){WAIT_BAR(2);} else if((tt)+2<NT){WAIT_BAR(1);} else {WAIT_BAR(0);} }while(0)
  for(;t+1<NT;t+=2){
    STEP(pB0,pB1,pA0,pA1,t,(t+3<NT),(t+1<NT),(t+1<NT));       ENDW(t);   RESC(); ROT();
    STEP(pA0,pA1,pB0,pB1,t+1,(t+4<NT),(t+2<NT),(t+2<NT));     ENDW(t+1); RESC(); ROT();
  }
  STEP(pB0,pB1,pA0,pA1,NT-1,false,false,false); RESC();
  { float sacc=pB0[0]+pB0[1]; _Pragma("unroll") for(int r=2;r<16;++r)sacc+=pB0[r]; _Pragma("unroll") for(int r=0;r<16;++r)sacc+=pB1[r]; l_reg+=sacc;
    pw0=(u32x4){PKW(pB0,0),PKW(pB0,2),PKW(pB0,4),PKW(pB0,6)};pw1=(u32x4){PKW(pB0,8),PKW(pB0,10),PKW(pB0,12),PKW(pB0,14)};pw2=(u32x4){PKW(pB1,0),PKW(pB1,2),PKW(pB1,4),PKW(pB1,6)};pw3=(u32x4){PKW(pB1,8),PKW(pB1,10),PKW(pB1,12),PKW(pB1,14)};
    SBAR(); pv(o,vb0+sl_cur,PAF(0),PAF(1),PAF(2),PAF(3)); }
  #undef PKW
  #undef PAF
  #undef VFR
  #undef PIN
  #undef MX3
  #undef GAPA
  #undef GAPB
  #undef EX
  #undef VRD
  #undef KRD
  #undef STEP
  #undef ENDW
  {auto rr=__builtin_amdgcn_permlane32_swap(__float_as_uint(l_reg),__float_as_uint(l_reg),false,false);l_reg=__uint_as_float(rr[0])+__uint_as_float(rr[1]);}
  if(MODE==1){ if(has_sink) l_reg+=__builtin_amdgcn_exp2f(sinkl2-mhat); if(lse!=nullptr&&hi==0) lse[(long)(wrow*QBLK+r32)*8+wh]=0.6931471805599453f*(mhat+__builtin_amdgcn_logf(l_reg)); }
  if(hi==0)wsf[32+r32]=l_reg;asm volatile("s_waitcnt lgkmcnt(0)":::"memory");
  float rli[16];
  #pragma unroll
  for(int r=0;r<16;++r)rli[r]=__builtin_amdgcn_rcpf(wsf[32+crow(r,hi)]);
  bf16*Ow=Ou+(long)(wrow*QBLK)*OP+wh*D;
  { bf16*stg=(bf16*)(shm+LDS_OST)+wid*2048;
    #pragma unroll
    for(int r=0;r<16;++r){const int orow=crow(r,hi);
      #pragma unroll
      for(int d0=0;d0<2;++d0)stg[orow*64+d0*32+r32]=__float2bfloat16(o[d0][r]*rli[r]);}
    asm volatile("s_waitcnt lgkmcnt(0)":::"memory");
    #pragma unroll
    for(int i=0;i<4;++i){const int row=i*8+(lane>>3),ch=lane&7; const u32x4 v=*(const u32x4*)(stg+row*64+ch*8); ATTN_STORE16(Ow+(long)row*OP+ch*8,v);} }
  asm volatile("s_waitcnt lgkmcnt(0)\n\ts_barrier":::"memory");
  #undef DMA_K
  #undef DMA_V
  #undef CMASK
  #undef START
  #undef RESC
  #undef ROT
}
constexpr int ATTN_LDS_BYTES=LDS_BYTES;
#undef SBAR
#undef WAIT_BAR
}
#define XB_TMO      128
#define XB_XCNT(j)  (256  + 64 * (j))
#define XB_XSUB(j)  (1280 + 64 * (j))
#define XB_XGEN(j)  (2304 + 64 * (j))
#define XB_TOP      3328
#define XB_TOPGEN   3392
#define XCD_BAR_WORDS 3456
#define XB_SPIN_CAP (1u << 18)

__device__ __forceinline__ unsigned xb_ld(unsigned* p)              { return __hip_atomic_load(p, __ATOMIC_RELAXED, __HIP_MEMORY_SCOPE_AGENT); }
__device__ __forceinline__ unsigned xb_add(unsigned* p, unsigned v) { return __hip_atomic_fetch_add(p, v, __ATOMIC_RELAXED, __HIP_MEMORY_SCOPE_AGENT); }
__device__ __forceinline__ unsigned xb_xcc_id() { return (unsigned)__builtin_amdgcn_s_getreg((3 << 11) | 20) & 0xFu; }
#define XB_SPIN(cond, bar) do { unsigned _sp = 0; while (cond) { __builtin_amdgcn_s_sleep(1); \
    if ((++_sp & 255u) == 0u) { if (xb_ld(&(bar)[XB_TMO])) break; if (_sp > XB_SPIN_CAP) { atomicAdd(&(bar)[XB_TMO], 1u); break; } } } } while (0)

struct XcdBarrier {
    unsigned* bar; unsigned x;
    volatile LAS unsigned* st;
};

__device__ __forceinline__ XcdBarrier xcd_barrier_post(unsigned* bar, volatile LAS unsigned* st) {
    XcdBarrier b; b.bar = bar; b.x = xb_xcc_id(); b.st = st;
    if (threadIdx.x == 0) (void)xb_add(&bar[XB_XCNT(b.x)], 1u);
    return b;
}
__device__ __forceinline__ void xcd_barrier_complete(unsigned* bar, unsigned x, unsigned& nloc, unsigned& nx) {
    const unsigned G = gridDim.x * gridDim.y * gridDim.z;
    unsigned sum, cnt, mine, sp = 0u;
    for (;;) {
        sum = 0u; cnt = 0u; mine = 0u;
#pragma unroll
        for (unsigned j = 0; j < 16; ++j) { const unsigned c = xb_ld(&bar[XB_XCNT(j)]); sum += c; cnt += (c > 0u) ? 1u : 0u; mine = (j == x) ? c : mine; }
        if (sum == G) break;
        __builtin_amdgcn_s_sleep(1);
        if ((++sp & 255u) == 0u) { if (xb_ld(&bar[XB_TMO])) break; if (sp > XB_SPIN_CAP) { atomicAdd(&bar[XB_TMO], 1u); break; } }
    }
    nloc = mine > 0u ? mine : 1u; nx = cnt > 0u ? cnt : 1u;
}

__device__ __forceinline__ void xcd_barrier(const XcdBarrier& b) {
    asm volatile("s_waitcnt vmcnt(0)" ::: "memory");
    __syncthreads();
    if (threadIdx.x == 0) {
        unsigned* bar = b.bar;
        __builtin_amdgcn_s_waitcnt(0);
        unsigned nloc = b.st[0], nx = b.st[1];
        if (nloc == 0u) { xcd_barrier_complete(bar, b.x, nloc, nx); b.st[0] = nloc; b.st[1] = nx; }
        const unsigned old = xb_add(&bar[XB_XSUB(b.x)], 1u);
        const unsigned gen = old / nloc;
        if (old + 1u == (gen + 1u) * nloc) {
            __builtin_amdgcn_fence(__ATOMIC_RELEASE, "agent");
            asm volatile("s_waitcnt vmcnt(0)" ::: "memory");
            const unsigned og = xb_add(&bar[XB_TOP], 1u);
            const unsigned tg = og / nx;
            if (og + 1u == (tg + 1u) * nx) xb_add(&bar[XB_TOPGEN], 1u);
            else XB_SPIN(xb_ld(&bar[XB_TOPGEN]) == tg, bar);
            __builtin_amdgcn_fence(__ATOMIC_ACQUIRE, "agent");
            xb_add(&bar[XB_XGEN(b.x)], 1u);
            asm volatile("s_waitcnt vmcnt(0)" ::: "memory");
        } else {
            XB_SPIN(xb_ld(&bar[XB_XGEN(b.x)]) == gen, bar);
            __builtin_amdgcn_fence(__ATOMIC_ACQUIRE, "agent");
            asm volatile("s_waitcnt vmcnt(0)" ::: "memory");
        }
    }
    __syncthreads();
}

struct Frame {
    LAS unsigned char* lds;
    volatile LAS unsigned* MISC;
    gu32* ctl;
    int tid, lane, wave, vcu, G, bx;
    int gw, NGW;
};
__device__ __forceinline__ bool refresh(Frame& F) {
    int t = threadIdx.x; asm volatile("" : "+v"(t)); F.tid = t; F.lane = t & 63; F.wave = __builtin_amdgcn_readfirstlane(t >> 6);
    int bx = blockIdx.x, G = gridDim.x; asm volatile("" : "+s"(bx), "+s"(G)); F.bx = bx; F.G = G;
    F.vcu = (G % 8 == 0) ? (bx % 8) * (G / 8) + bx / 8 : bx; F.gw = F.vcu * NWAVES + F.wave; F.NGW = G * NWAVES; return true; }
__device__ __forceinline__ float wave_sum(float v) {
#pragma unroll
    for (int o = 1; o < 64; o <<= 1) v += shx(v, o);
    return v;
}
template <int MAP> __device__ __forceinline__ int rowmap(int n) {
    if (MAP == 1) { const int f = n >> 1; return 256 * (f >> 7) + 128 * (n & 1) + (f & 127); }
    if (MAP == 2 || MAP == 3) { const int tl = n >> 8, hh = (n >> 6) & 3, d = n & 63; int bj, j;
        const bool axial = (MAP == 2) && (tl < 2 || (tl == 2 && hh < 2));
        if (axial) { bj = (d >> 4) & 1; j = (d & 15) + ((d >> 5) << 4); } else { bj = d >> 5; j = d & 31; }
        return 256 * tl + 128 * bj + 32 * hh + j; }
    return n; }
struct TrTile { const float* W; bf16* WT; const float* gain; int K, N, k0, n0; };
__device__ __forceinline__ void tr_load(const TrTile& t, f32x4 (&v)[16], int lane) {
    const float* src = t.W + (size_t)(t.k0 + (lane >> 4)) * t.N + t.n0 + 4 * (lane & 15);
#pragma unroll
    for (int i = 0; i < 16; ++i) v[i] = __builtin_nontemporal_load((const f32x4*)(src + (size_t)(4 * i) * t.N));
}
template <int MAP> __device__ __forceinline__ void tr_store(const TrTile& t, f32x4 (&v)[16], LAS float* scr, int lane) {
    const int lr = lane >> 4, lc = lane & 15;
    if (t.gain) {
#pragma unroll
        for (int i = 0; i < 16; ++i) v[i] *= t.gain[t.k0 + 4 * i + lr]; }
#pragma unroll
    for (int i = 0; i < 16; ++i) { LAS float* p = scr + (4 * i + lr) * 65 + 4 * lc; p[0] = v[i].x; p[1] = v[i].y; p[2] = v[i].z; p[3] = v[i].w; }
    LDS_WAIT(); asm volatile("" ::: "memory");
    const int c = lane & 7;
#pragma unroll
    for (int j = 0; j < 8; ++j) { const int n = 8 * j + (lane >> 3); const LAS float* s = scr + (8 * c) * 65 + n;
        v4u o; o.x = pk2(s[0 * 65], s[1 * 65]); o.y = pk2(s[2 * 65], s[3 * 65]); o.z = pk2(s[4 * 65], s[5 * 65]); o.w = pk2(s[6 * 65], s[7 * 65]);
        *(GAS v4u*)(t.WT + (size_t)rowmap<MAP>(t.n0 + n) * t.K + t.k0 + 8 * c) = o; }
    LDS_WAIT(); asm volatile("" ::: "memory");
}
template <int MAP> __device__ __forceinline__ void transpose_family(Frame& F, const float* W, size_t sW, bf16* WT, size_t sWT, const float* gain, int sG, int K, int N, int nmat, int gdiv) {
    LAS float* scr = (LAS float*)(F.lds + RING_OFF) + F.wave * (128 * 33);
    const int nb = N / 64, per = (K / 64) * nb, total = per * nmat;
    f32x4 va[16], vb[16];
    int it = F.gw; if (it >= total) return;
    TrTile ta, tb;
#define TR_SETUP(tt, item) do { const int mi = (item) / per, r = (item) % per; tt.W = W + (size_t)mi * sW; tt.WT = WT + (size_t)mi * sWT; tt.gain = gain ? gain + (size_t)(mi / gdiv) * sG : nullptr; tt.K = K; tt.N = N; tt.k0 = 64 * (r / nb); tt.n0 = 64 * (r % nb); } while (0)
    TR_SETUP(ta, it); tr_load(ta, va, F.lane);
    for (;;) {
        const int it2 = it + F.NGW; const bool h2 = it2 < total;
        if (h2) { TR_SETUP(tb, it2); tr_load(tb, vb, F.lane); }
        tr_store<MAP>(ta, va, scr, F.lane);
        if (!h2) break;
        const int it3 = it2 + F.NGW; const bool h3 = it3 < total;
        if (h3) { TR_SETUP(ta, it3); tr_load(ta, va, F.lane); }
        tr_store<MAP>(tb, vb, scr, F.lane);
        if (!h3) break;
        it = it3;
    }
#undef TR_SETUP
}
__device__ __forceinline__ void tr8_load(const TrTile& t, f32x4 (&v)[16], int lane) {
    const float* src = t.W + (size_t)(t.k0 + (lane >> 3)) * t.N + t.n0 + 4 * (lane & 7);
#pragma unroll
    for (int i = 0; i < 16; ++i) v[i] = __builtin_nontemporal_load((const f32x4*)(src + (size_t)(8 * i) * t.N));
}
template <int MAP> __device__ __forceinline__ void tr8_store(const TrTile& t, f32x4 (&v)[16], LAS float* scr, int lane) {
    const int lr = lane >> 3, lc = lane & 7; const float sc = (float)(1 << F8_WSC);
#pragma unroll
    for (int i = 0; i < 16; ++i) { const float g = t.gain ? t.gain[t.k0 + 8 * i + lr] * sc : sc; LAS float* p = scr + (8 * i + lr) * 33 + 4 * lc; p[0] = v[i].x * g; p[1] = v[i].y * g; p[2] = v[i].z * g; p[3] = v[i].w * g; }
    LDS_WAIT(); asm volatile("" ::: "memory");
    const int c = lane & 7;
#pragma unroll
    for (int j = 0; j < 4; ++j) { const int n = 8 * j + (lane >> 3); const LAS float* s = scr + (16 * c) * 33 + n;
        v4u o; o.x = pk4_fp8(s[0 * 33], s[1 * 33], s[2 * 33], s[3 * 33]); o.y = pk4_fp8(s[4 * 33], s[5 * 33], s[6 * 33], s[7 * 33]); o.z = pk4_fp8(s[8 * 33], s[9 * 33], s[10 * 33], s[11 * 33]); o.w = pk4_fp8(s[12 * 33], s[13 * 33], s[14 * 33], s[15 * 33]);
        *(GAS v4u*)((unsigned char*)t.WT + (size_t)rowmap<MAP>(t.n0 + n) * t.K + t.k0 + 16 * c) = o; }
    LDS_WAIT(); asm volatile("" ::: "memory");
}
template <int MAP> __device__ __forceinline__ void transpose_family_f8(Frame& F, const float* W, size_t sW, unsigned char* WT, size_t sWT, const float* gain, int sG, int K, int N, int nmat, int gdiv) {
    LAS float* scr = (LAS float*)(F.lds + RING_OFF) + F.wave * (128 * 33);
    const int nb = N / 32, per = (K / 128) * nb, total = per * nmat;
    f32x4 va[16], vb[16];
    int it = F.gw; if (it >= total) return;
    TrTile ta, tb;
#define TR_SETUP(tt, item) do { const int mi = (item) / per, r = (item) % per; tt.W = W + (size_t)mi * sW; tt.WT = (bf16*)(WT + (size_t)mi * sWT); tt.gain = gain ? gain + (size_t)(mi / gdiv) * sG : nullptr; tt.K = K; tt.N = N; tt.k0 = 128 * (r / nb); tt.n0 = 32 * (r % nb); } while (0)
    TR_SETUP(ta, it); tr8_load(ta, va, F.lane);
    for (;;) {
        const int it2 = it + F.NGW; const bool h2 = it2 < total;
        if (h2) { TR_SETUP(tb, it2); tr8_load(tb, vb, F.lane); }
        tr8_store<MAP>(ta, va, scr, F.lane);
        if (!h2) break;
        const int it3 = it2 + F.NGW; const bool h3 = it3 < total;
        if (h3) { TR_SETUP(ta, it3); tr8_load(ta, va, F.lane); }
        tr8_store<MAP>(tb, vb, scr, F.lane);
        if (!h3) break;
        it = it3;
    }
#undef TR_SETUP
}
__device__ __forceinline__ float rope_freq(int i, int half_dim) { return exp2f(-(float)i / (float)half_dim * LOG2_THETA); }

__device__ __forceinline__ void attn_phase_l0(Frame& F, const bf16* Q3, const bf16* K3, const bf16* V3, bf16* OCAT, const float* sink) {
    char* shm = (char*)(F.lds + RING_OFF);
    const int upc = (512 + F.G - 1) / F.G;
    for (int i = 0; i < upc; ++i) { const int u = F.vcu * upc + i; if (u >= 512) break;
        const int bhk = u >> 7, b = bhk >> 1, hkv = bhk & 1, hq = hkv * 4 + ((u & 127) >> 5), qb = u & 31; const size_t r0 = (size_t)b * SEQ + qb * 256;
        attn_body::attn_unit<0, 1024, 8>((const attn_body::bf16*)(Q3 + r0 * 512 + hq * 64), (const attn_body::bf16*)(K3 + (size_t)b * SEQ * 128 + hkv * 64), (const attn_body::bf16*)(V3 + (size_t)b * SEQ * 128 + hkv * 64),
                                        (attn_body::bf16*)(OCAT + r0 * D + hq * 64), SEQ / 64, 0, 0, 0.f, false, nullptr, shm); }
    const bf16* Qb = Q3 + (size_t)T * 512; const bf16* Kb = K3 + (size_t)T * 128; const bf16* Vb = V3 + (size_t)T * 128;
    for (int i = 0; i < upc; ++i) { const int u = F.vcu * upc + i; if (u >= 512) break;
        const int bhk = u >> 7, b = bhk >> 1, hkv = bhk & 1, pr = (u & 127) >> 6, qb = u & 63, hq = hkv * 4 + pr * 2; const size_t r0 = (size_t)b * SEQ + qb * 128;
        const int tl = max(qb * 2 - 2, 0), th = min(qb * 2 + 4, SEQ / 64); const size_t k0 = (size_t)b * SEQ + tl * 64;
        attn_body::attn_unit<1, 1024, 8, 2>((const attn_body::bf16*)(Qb + r0 * 512 + hq * 64), (const attn_body::bf16*)(Kb + k0 * 128 + hkv * 64), (const attn_body::bf16*)(Vb + k0 * 128 + hkv * 64),
                                           (attn_body::bf16*)(OCAT + r0 * D + 512 + hq * 64), th - tl, tl * 64 - qb * 128, 128, sink[hq + (F.wave >> 2)] * 1.4426950408889634f, true, nullptr, shm); }
}
__device__ __forceinline__ void attn_phase_l1(Frame& F, const bf16* Q3, const bf16* K3, const bf16* V3, bf16* OGB, float* LSE) {
    char* shm = (char*)(F.lds + RING_OFF);
    const int upc = (512 + F.G - 1) / F.G;
#pragma unroll 1
    for (int g = 0; g < 3; ++g) { const int Lc = SEQ >> (2 * g);
        for (int i = 0; i < upc; ++i) { const int u = F.vcu * upc + i; if (u >= 512) break;
            const int bhk = u >> 7, b = bhk >> 1, hkv = bhk & 1, hq = hkv * 4, qb = u & 127; const size_t r0 = (size_t)b * SEQ + qb * 64;
            const int q0 = qb * 64, cbase = q0 & ~(Lc - 1), lq0 = q0 & (Lc - 1); const int tl = min(max(lq0 / 64 - 1, 0), Lc / 64 - 4); const size_t k0 = (size_t)b * SEQ + cbase + tl * 64;
            attn_body::attn_unit<1, 512, 8, 4>((const attn_body::bf16*)(Q3 + (size_t)g * T * 512 + r0 * 512 + hq * 64), (const attn_body::bf16*)(K3 + (size_t)g * T * 128 + k0 * 128 + hkv * 64), (const attn_body::bf16*)(V3 + (size_t)g * T * 128 + k0 * 128 + hkv * 64),
                                              (attn_body::bf16*)(OGB + (size_t)g * T * 512 + r0 * 512 + hq * 64), 4, cbase + tl * 64 - q0, 64, 0.f, false, LSE + (size_t)g * T * 8 + r0 * 8 + hq, shm); }
    }
}
__device__ __forceinline__ void merge_phase(Frame& F, const bf16* OGB, const float* LSE, bf16* OCAT1) {
    for (int m = F.gw; m < T; m += F.NGW) {
        const int h = F.lane >> 3; const int b = m / SEQ, pos = m % SEQ;
        const size_t r0 = m, r1 = (size_t)b * SEQ + (size_t)(pos & 3) * (SEQ / 4) + (pos >> 2), r2 = (size_t)b * SEQ + (size_t)(pos & 15) * (SEQ / 16) + (pos >> 4);
        const float l0 = LSE[r0 * 8 + h], l1 = LSE[(size_t)T * 8 + r1 * 8 + h], l2 = LSE[(size_t)2 * T * 8 + r2 * 8 + h];
        const float mx = fmaxf(l0, fmaxf(l1, l2)); float w0 = __expf(l0 - mx), w1 = __expf(l1 - mx), w2 = __expf(l2 - mx); const float is = 1.f / (w0 + w1 + w2); w0 *= is; w1 *= is; w2 *= is;
        const v4u a = *(const v4u*)(OGB + r0 * 512 + F.lane * 8), bb = *(const v4u*)(OGB + (size_t)T * 512 + r1 * 512 + F.lane * 8), c = *(const v4u*)(OGB + (size_t)2 * T * 512 + r2 * 512 + F.lane * 8);
        v4u w;
        w.x = pk2(w0 * bflo(a.x) + w1 * bflo(bb.x) + w2 * bflo(c.x), w0 * bfhi(a.x) + w1 * bfhi(bb.x) + w2 * bfhi(c.x));
        w.y = pk2(w0 * bflo(a.y) + w1 * bflo(bb.y) + w2 * bflo(c.y), w0 * bfhi(a.y) + w1 * bfhi(bb.y) + w2 * bfhi(c.y));
        w.z = pk2(w0 * bflo(a.z) + w1 * bflo(bb.z) + w2 * bflo(c.z), w0 * bfhi(a.z) + w1 * bfhi(bb.z) + w2 * bfhi(c.z));
        w.w = pk2(w0 * bflo(a.w) + w1 * bflo(bb.w) + w2 * bflo(c.w), w0 * bfhi(a.w) + w1 * bfhi(bb.w) + w2 * bfhi(c.w));
        *(v4u*)(OCAT1 + (size_t)m * C_OUT + F.lane * 8) = w;
    }
}

typedef float f32x4m __attribute__((ext_vector_type(4)));
__device__ __forceinline__ void top4_merge(float (&v)[4], int (&ix)[4], int mask) {
    float ov[4]; int oi[4];
#pragma unroll
    for (int k = 0; k < 4; ++k) { ov[k] = shx(v[k], mask); oi[k] = shx(ix[k], mask); }
    float cv[8]; int ci[8];
#pragma unroll
    for (int k = 0; k < 4; ++k) { cv[k] = v[k]; ci[k] = ix[k]; cv[4 + k] = ov[k]; ci[4 + k] = oi[k]; }
    unsigned used = 0u;
#pragma unroll
    for (int k = 0; k < 4; ++k) { float best = -INFINITY; int bi = 1 << 30, bp = 0;
#pragma unroll
        for (int c = 0; c < 8; ++c) { const bool take = !((used >> c) & 1u) && (cv[c] > best || (cv[c] == best && ci[c] < bi)); best = take ? cv[c] : best; bi = take ? ci[c] : bi; bp = take ? c : bp; }
        used |= 1u << bp; v[k] = best; ix[k] = bi; }
}
__device__ __forceinline__ void route_phase(Frame& F, const bf16* H, const float* WR, const float* rb, int* CNTTAB, int* TOPE, float* TOPG, int* TOPPOS, float* RSTD) {
    LAS float* WL = (LAS float*)(F.lds + RING_OFF);
    LAS unsigned* LC = (LAS unsigned*)(F.lds + RING_OFF + NE * 1028 * 4);
    if (F.tid < NE) LC[F.tid] = 0u;
    for (int i = F.tid; i < NE * D / 4; i += NWAVES * 64) { const int e = i >> 8, k4 = i & 255; *(LAS f32x4*)(WL + e * 1028 + 4 * k4) = *(const f32x4*)(WR + (size_t)e * D + 4 * k4); }
    __syncthreads();
    const int lane = F.lane, c = lane & 15, q = lane >> 4;
    for (int task = F.wave * F.G + F.vcu; task < T / 16; task += F.NGW) {
        const bf16* xr = H + (size_t)(task * 16 + c) * D + 8 * q;
        const LAS float* w0 = WL + c * 1028 + 8 * q; const LAS float* w1 = w0 + 16 * 1028;
        f32x4m a0 = {0.f, 0.f, 0.f, 0.f}, a1 = {0.f, 0.f, 0.f, 0.f}; float ssq = 0.f;
#pragma unroll 4
        for (int ch = 0; ch < 32; ++ch) {
            const v4u xv = *(const v4u*)(xr + 32 * ch);
            float xf[8]; xf[0] = bflo(xv.x); xf[1] = bfhi(xv.x); xf[2] = bflo(xv.y); xf[3] = bfhi(xv.y); xf[4] = bflo(xv.z); xf[5] = bfhi(xv.z); xf[6] = bflo(xv.w); xf[7] = bfhi(xv.w);
            const f32x4 wa0 = *(const LAS f32x4*)(w0 + 32 * ch), wa1 = *(const LAS f32x4*)(w0 + 32 * ch + 4), wb0 = *(const LAS f32x4*)(w1 + 32 * ch), wb1 = *(const LAS f32x4*)(w1 + 32 * ch + 4);
#pragma unroll
            for (int t = 0; t < 8; ++t) ssq += xf[t] * xf[t];
            a0 = __builtin_amdgcn_mfma_f32_16x16x4f32(wa0.x, xf[0], a0, 0, 0, 0); a1 = __builtin_amdgcn_mfma_f32_16x16x4f32(wb0.x, xf[0], a1, 0, 0, 0);
            a0 = __builtin_amdgcn_mfma_f32_16x16x4f32(wa0.y, xf[1], a0, 0, 0, 0); a1 = __builtin_amdgcn_mfma_f32_16x16x4f32(wb0.y, xf[1], a1, 0, 0, 0);
            a0 = __builtin_amdgcn_mfma_f32_16x16x4f32(wa0.z, xf[2], a0, 0, 0, 0); a1 = __builtin_amdgcn_mfma_f32_16x16x4f32(wb0.z, xf[2], a1, 0, 0, 0);
            a0 = __builtin_amdgcn_mfma_f32_16x16x4f32(wa0.w, xf[3], a0, 0, 0, 0); a1 = __builtin_amdgcn_mfma_f32_16x16x4f32(wb0.w, xf[3], a1, 0, 0, 0);
            a0 = __builtin_amdgcn_mfma_f32_16x16x4f32(wa1.x, xf[4], a0, 0, 0, 0); a1 = __builtin_amdgcn_mfma_f32_16x16x4f32(wb1.x, xf[4], a1, 0, 0, 0);
            a0 = __builtin_amdgcn_mfma_f32_16x16x4f32(wa1.y, xf[5], a0, 0, 0, 0); a1 = __builtin_amdgcn_mfma_f32_16x16x4f32(wb1.y, xf[5], a1, 0, 0, 0);
            a0 = __builtin_amdgcn_mfma_f32_16x16x4f32(wa1.z, xf[6], a0, 0, 0, 0); a1 = __builtin_amdgcn_mfma_f32_16x16x4f32(wb1.z, xf[6], a1, 0, 0, 0);
            a0 = __builtin_amdgcn_mfma_f32_16x16x4f32(wa1.w, xf[7], a0, 0, 0, 0); a1 = __builtin_amdgcn_mfma_f32_16x16x4f32(wb1.w, xf[7], a1, 0, 0, 0);
        }
        ssq += shx(ssq, 16); ssq += shx(ssq, 32);
        const float rstd = 1.f / sqrtf(ssq * (1.f / D) + NORM_EPS);
        float cv[8]; int ci[8];
#pragma unroll
        for (int r = 0; r < 4; ++r) { ci[r] = 4 * q + r; ci[4 + r] = 16 + 4 * q + r; cv[r] = a0[r] * rstd + rb[4 * q + r]; cv[4 + r] = a1[r] * rstd + rb[16 + 4 * q + r]; }
        float tv[4]; int ti[4]; unsigned used = 0u;
#pragma unroll
        for (int k = 0; k < 4; ++k) { float best = -INFINITY; int bi = 0, bp = 0;
#pragma unroll
            for (int j = 0; j < 8; ++j) { const bool take = !((used >> j) & 1u) && (cv[j] > best); best = take ? cv[j] : best; bi = take ? ci[j] : bi; bp = take ? j : bp; }
            used |= 1u << bp; tv[k] = best; ti[k] = bi; }
        top4_merge(tv, ti, 16); top4_merge(tv, ti, 32);
        const float e1 = __expf(tv[1] - tv[0]), e2 = __expf(tv[2] - tv[0]), e3 = __expf(tv[3] - tv[0]); const float is = 1.f / (1.f + e1 + e2 + e3);
        const int m = task * 16 + c;
        { const int e = q == 0 ? ti[0] : q == 1 ? ti[1] : q == 2 ? ti[2] : ti[3]; const float g = (q == 0 ? 1.f : q == 1 ? e1 : q == 2 ? e2 : e3) * is;
            const unsigned pos = __hip_atomic_fetch_add(LC + e, 1u, __ATOMIC_RELAXED, __HIP_MEMORY_SCOPE_WORKGROUP);
            TOPE[m * 4 + q] = e; TOPG[m * 4 + q] = g; TOPPOS[m * 4 + q] = (int)pos; }
        if (q == 0) RSTD[m] = rstd;
    }
    __syncthreads();
    if (F.tid < NE) CNTTAB[F.vcu * NE + F.tid] = (int)LC[F.tid];
    __syncthreads();
}
__device__ __forceinline__ void slot_phase(Frame& F, const bf16* H, const int* CNTTAB, const int* TOPE, const float* TOPG, const int* TOPPOS, const float* RSTD, int* TOKSLOT, float* SLOTGATE, float* SLOTRS, bf16* XG, int* XTAB, bool f8) {
    LAS int* L = (LAS int*)(F.lds + RING_OFF);
    LAS int* P = L + 256;
    const int lane = F.lane;
    {
#pragma unroll 1
        for (int ee = 0; ee < 4; ++ee) { const int e = F.wave * 4 + ee;
            int s0 = 0, s1 = 0, s2 = 0, s3 = 0; const int g0 = 4 * lane;
            if (g0 < F.G) s0 = CNTTAB[g0 * NE + e]; if (g0 + 1 < F.G) s1 = CNTTAB[(g0 + 1) * NE + e]; if (g0 + 2 < F.G) s2 = CNTTAB[(g0 + 2) * NE + e]; if (g0 + 3 < F.G) s3 = CNTTAB[(g0 + 3) * NE + e];
            const int t = s0 + s1 + s2 + s3; int inc = t;
#pragma unroll
            for (int o = 1; o < 64; o <<= 1) { const int u = shup(inc, o); if (lane >= o) inc += u; }
            const int base = inc - t;
            P[g0 * NE + e] = base; P[(g0 + 1) * NE + e] = base + s0; P[(g0 + 2) * NE + e] = base + s0 + s1; P[(g0 + 3) * NE + e] = base + s0 + s1 + s2;
            if (lane == 63) L[64 + e] = inc; }
    }
    __syncthreads();
    if (F.wave == 0) {
        const int np = (lane < 32) ? ((L[64 + (lane & 31)] + 255) >> 8) : 0;
        int pre = np;
#pragma unroll
        for (int o = 1; o < 32; o <<= 1) { const int t = shup(pre, o); if (lane >= o) pre += t; }
        const int p0 = pre - np;
        if (lane < 32) { L[lane] = np; L[32 + lane] = p0 * 256; }
        if (F.bx == 0) {
            LDS_WAIT(); asm volatile("" ::: "memory");
            int rank = 0;
#pragma unroll 8
            for (int e2 = 0; e2 < 32; ++e2) { const int v = L[e2]; rank += (v > np || (v == np && e2 < lane)) ? 1 : 0; }
            LAS int* XE = L + 96;
            if (lane < 32) { const int r16 = rank & 15, x = r16 < 8 ? r16 : 15 - r16, pos = (rank >> 4) * 2 + (r16 >= 8 ? 1 : 0); XE[(x * 4 + pos) * 3] = lane; XE[(x * 4 + pos) * 3 + 1] = p0; XE[(x * 4 + pos) * 3 + 2] = np; }
            LDS_WAIT(); asm volatile("" ::: "memory");
            const int lx = lane_opaque();
            if (lx < 8) { int cump = 0; int* tb = XTAB + lx * 136;
#pragma unroll
                for (int s = 0; s < 4; ++s) { const int e = XE[(lx * 4 + s) * 3], q0 = XE[(lx * 4 + s) * 3 + 1], n = XE[(lx * 4 + s) * 3 + 2]; tb[4 + 4 * s] = e; tb[4 + 4 * s + 1] = q0; tb[4 + 4 * s + 2] = n; tb[4 + 4 * s + 3] = cump; cump += n; }
                int four = 4; asm volatile("" : "+v"(four));
                tb[0] = four; tb[1] = cump; }
        }
    }
    __syncthreads();
    if (f8) {
        for (int m0 = F.gw; m0 < T; m0 += 4 * F.NGW) {
            int e[4], ps[4]; float gt[4], rs[4]; v4u ra[4], rb[4];
#pragma unroll
            for (int j = 0; j < 4; ++j) { const int m = m0 + j * F.NGW; const bool ok = m < T; const int mm = ok ? m : 0;
                e[j] = 0; ps[j] = 0; gt[j] = 0.f;
                if (lane < 4) { e[j] = TOPE[mm * 4 + lane]; ps[j] = TOPPOS[mm * 4 + lane]; gt[j] = TOPG[mm * 4 + lane]; }
                rs[j] = RSTD[mm]; const bf16* src = H + (size_t)mm * D + lane * 16; ra[j] = *(const v4u*)src; rb[j] = *(const v4u*)(src + 8); }
#pragma unroll
            for (int j = 0; j < 4; ++j) { const int m = m0 + j * F.NGW; if (m >= T) break;
                int slot = 0;
                if (lane < 4) { const int wg = (m >> 4) % F.G; slot = L[32 + e[j]] + P[wg * NE + e[j]] + ps[j]; TOKSLOT[m * 4 + lane] = slot; SLOTGATE[slot] = gt[j]; SLOTRS[slot] = rs[j]; }
                const int s0 = shl(slot, 0), s1 = shl(slot, 1), s2 = shl(slot, 2), s3 = shl(slot, 3);
                const v4u a = ra[j], b = rb[j]; const float r = rs[j];
                v4u w; w.x = pk4_fp8(clamp448(bflo(a.x) * r), clamp448(bfhi(a.x) * r), clamp448(bflo(a.y) * r), clamp448(bfhi(a.y) * r)); w.y = pk4_fp8(clamp448(bflo(a.z) * r), clamp448(bfhi(a.z) * r), clamp448(bflo(a.w) * r), clamp448(bfhi(a.w) * r));
                w.z = pk4_fp8(clamp448(bflo(b.x) * r), clamp448(bfhi(b.x) * r), clamp448(bflo(b.y) * r), clamp448(bfhi(b.y) * r)); w.w = pk4_fp8(clamp448(bflo(b.z) * r), clamp448(bfhi(b.z) * r), clamp448(bflo(b.w) * r), clamp448(bfhi(b.w) * r));
                unsigned char* X8 = (unsigned char*)XG; const size_t co = (size_t)lane * 16;
                *(v4u*)(X8 + (size_t)s0 * D + co) = w; *(v4u*)(X8 + (size_t)s1 * D + co) = w; *(v4u*)(X8 + (size_t)s2 * D + co) = w; *(v4u*)(X8 + (size_t)s3 * D + co) = w; }
        }
    } else {
    for (int m = F.gw; m < T; m += F.NGW) {
        int slot = 0;
        if (lane < 4) { const int e = TOPE[m * 4 + lane]; const int wg = (m >> 4) % F.G; slot = L[32 + e] + P[wg * NE + e] + TOPPOS[m * 4 + lane]; TOKSLOT[m * 4 + lane] = slot; SLOTGATE[slot] = TOPG[m * 4 + lane]; SLOTRS[slot] = RSTD[m]; }
        const int s0 = shl(slot, 0), s1 = shl(slot, 1), s2 = shl(slot, 2), s3 = shl(slot, 3);
        const bf16* src = H + (size_t)m * D + lane * 8; const v4u a = *(const v4u*)src, b = *(const v4u*)(src + 512);
        const size_t co = (size_t)lane * 8;
        *(v4u*)(XG + (size_t)s0 * D + co) = a; *(v4u*)(XG + (size_t)s0 * D + co + 512) = b;
        *(v4u*)(XG + (size_t)s1 * D + co) = a; *(v4u*)(XG + (size_t)s1 * D + co + 512) = b;
        *(v4u*)(XG + (size_t)s2 * D + co) = a; *(v4u*)(XG + (size_t)s2 * D + co + 512) = b;
        *(v4u*)(XG + (size_t)s3 * D + co) = a; *(v4u*)(XG + (size_t)s3 * D + co + 512) = b;
    }
    }
    __syncthreads();
}
__device__ __forceinline__ void y_add16(float (&a)[16], const void* Yp, size_t row, int lane) {
    if (Y_FP8) { const v4u y = *(const v4u*)((const unsigned char*)Yp + row * D + lane * 16); const float is = 1.f / Y_SC;
        const unsigned w[4] = {y.x, y.y, y.z, y.w};
#pragma unroll
        for (int i = 0; i < 4; ++i) { const f32x2_ lo = __builtin_amdgcn_cvt_pk_f32_fp8((int)w[i], false), hi = __builtin_amdgcn_cvt_pk_f32_fp8((int)w[i], true); a[4 * i] += lo.x * is; a[4 * i + 1] += lo.y * is; a[4 * i + 2] += hi.x * is; a[4 * i + 3] += hi.y * is; } }
    else { const bf16* yp = (const bf16*)Yp + row * D + lane * 16; const v4u y0 = *(const v4u*)yp, y1 = *(const v4u*)(yp + 8);
        a[0] += bflo(y0.x); a[1] += bfhi(y0.x); a[2] += bflo(y0.y); a[3] += bfhi(y0.y); a[4] += bflo(y0.z); a[5] += bfhi(y0.z); a[6] += bflo(y0.w); a[7] += bfhi(y0.w);
        a[8] += bflo(y1.x); a[9] += bfhi(y1.x); a[10] += bflo(y1.y); a[11] += bfhi(y1.y); a[12] += bflo(y1.z); a[13] += bfhi(y1.z); a[14] += bflo(y1.w); a[15] += bfhi(y1.w); }
}
__device__ __forceinline__ void combine_phase(Frame& F, const bf16* HM, const void* Y, const int* TOKSLOT, bf16* H2, unsigned char* H2F8) {
    const int lane = F.lane;
    for (int m = F.gw; m < T; m += F.NGW) {
        const int s0 = TOKSLOT[m * 4], s1 = TOKSLOT[m * 4 + 1], s2 = TOKSLOT[m * 4 + 2], s3 = TOKSLOT[m * 4 + 3];
        float a[16];
#pragma unroll
        for (int i = 0; i < 16; ++i) a[i] = 0.f;
        y_add16(a, Y, (size_t)s0, lane); y_add16(a, Y, (size_t)s1, lane); y_add16(a, Y, (size_t)s2, lane); y_add16(a, Y, (size_t)s3, lane);
        const bf16* hp = HM + (size_t)m * D + lane * 16; const v4u h0 = *(const v4u*)hp, h1 = *(const v4u*)(hp + 8);
        a[0] += bflo(h0.x); a[1] += bfhi(h0.x); a[2] += bflo(h0.y); a[3] += bfhi(h0.y); a[4] += bflo(h0.z); a[5] += bfhi(h0.z); a[6] += bflo(h0.w); a[7] += bfhi(h0.w);
        a[8] += bflo(h1.x); a[9] += bfhi(h1.x); a[10] += bflo(h1.y); a[11] += bfhi(h1.y); a[12] += bflo(h1.z); a[13] += bfhi(h1.z); a[14] += bflo(h1.w); a[15] += bfhi(h1.w);
        v4u w0, w1; w0.x = pk2(a[0], a[1]); w0.y = pk2(a[2], a[3]); w0.z = pk2(a[4], a[5]); w0.w = pk2(a[6], a[7]); w1.x = pk2(a[8], a[9]); w1.y = pk2(a[10], a[11]); w1.z = pk2(a[12], a[13]); w1.w = pk2(a[14], a[15]);
        bf16* op = H2 + (size_t)m * D + lane * 16; *(v4u*)op = w0; *(v4u*)(op + 8) = w1;
        if (PLE_FP8) { v4u q; q.x = pk4_fp8(clamp448(a[0]), clamp448(a[1]), clamp448(a[2]), clamp448(a[3])); q.y = pk4_fp8(clamp448(a[4]), clamp448(a[5]), clamp448(a[6]), clamp448(a[7]));
            q.z = pk4_fp8(clamp448(a[8]), clamp448(a[9]), clamp448(a[10]), clamp448(a[11])); q.w = pk4_fp8(clamp448(a[12]), clamp448(a[13]), clamp448(a[14]), clamp448(a[15])); *(v4u*)(H2F8 + (size_t)m * D + lane * 16) = q; }
    }
}
__device__ __forceinline__ void final_norm_phase(Frame& F, const bf16* H, const float* SS, const float* gain, float* out) {
    const int lane = F.lane;
    for (int m = F.gw; m < T; m += F.NGW) {
        const float rstd = 1.f / sqrtf(ssp_sum(SS + (size_t)m * 16) * (1.f / D) + NORM_EPS);
#pragma unroll
        for (int j = 0; j < 2; ++j) { const size_t co = (size_t)j * 512 + lane * 8; const v4u h = *(const v4u*)(H + (size_t)m * D + co); const f32x4 g0 = *(const f32x4*)(gain + co), g1 = *(const f32x4*)(gain + co + 4);
            f32x4 o0, o1; o0.x = bflo(h.x) * rstd * g0.x; o0.y = bfhi(h.x) * rstd * g0.y; o0.z = bflo(h.y) * rstd * g0.z; o0.w = bfhi(h.y) * rstd * g0.w;
            o1.x = bflo(h.z) * rstd * g1.x; o1.y = bfhi(h.z) * rstd * g1.y; o1.z = bflo(h.w) * rstd * g1.z; o1.w = bfhi(h.w) * rstd * g1.w;
            float* dst = out + (size_t)m * D + co; *(f32x4*)dst = o0; *(f32x4*)(dst + 4) = o1; }
    }
}

constexpr int N_PHASES = 22;
struct Args { const float* in[20]; float* out; unsigned char* ws; int ph_lo, ph_hi, li, pad; };
typedef const __attribute__((address_space(4))) Args* argp_t;
__device__ __forceinline__ argp_t opaque_args() { argp_t p = (argp_t)__builtin_amdgcn_kernarg_segment_ptr(); asm volatile("" : "+s"(p)); return p; }
#define AP (opaque_args())
__global__ void __launch_bounds__(NWAVES * 64, 2) fwd_kernel(Args args_unused) {
    extern __shared__ __attribute__((aligned(16))) unsigned char lds[];
    Frame F;
    F.lds = (LAS unsigned char*)lds;
    F.MISC = (volatile LAS unsigned*)(F.lds + MISC_OFF);
    refresh(F);
    F.ctl = (gu32*)(AP->ws + WS_CTL);
    if (F.tid < 128) ((LAS unsigned*)(F.lds + LDSCTL_OFF))[F.tid] = 0u;
    __syncthreads();
    const bool one_phase = (AP->ph_hi - AP->ph_lo) == 1;
    XcdBarrier bar; bar.bar = (unsigned*)(F.ctl + CW_BAR); bar.x = 0; bar.st = nullptr;
    if (!one_phase) bar = xcd_barrier_post((unsigned*)(F.ctl + CW_BAR), F.MISC + 8);
    const int lo = AP->ph_lo, hi = AP->ph_hi;
#ifndef MK_MASK
#define MK_MASK 0x3fff
#endif
#ifndef PROBE_MASK
#define PROBE_MASK 0
#endif
#define IN(k) (lo <= (k) && (k) < hi)
#define INL(j) (((MK_MASK >> (j)) & 1) && IN(pb + (j)) && refresh(F))
#define REP(j) _Pragma("unroll") for (int rep_ = 0; rep_ < (((PROBE_MASK >> (j)) & 1) ? 2 : 1); ++rep_)
#define SEAM(k) do { if (IN((k) + 1)) xcd_barrier(bar); } while (0)
#define ws (AP->ws)
#define WSP(type, off) ((type*)(ws + (off)))
#define BIG_CONVERSIONS(FR) do { \
        _Pragma("unroll 1") for (int ll = 0; ll < 2; ++ll) { \
            const float* wu = AP->in[13] + (size_t)ll * NE * D * 2 * DE; const float* wd = AP->in[15] + (size_t)ll * NE * DE * D; const float* gf = AP->in[10] + ll * D; \
            unsigned char* du = ws + WS_WUPT + (size_t)ll * NE * 2 * DE * D * 2; unsigned char* dd = ws + WS_WDNT + (size_t)ll * NE * D * DE * 2; \
            if ((MOE_FP8_MASK >> ll) & 1) { \
                transpose_family_f8<1>(FR, wu, (size_t)D * 2 * DE, du, (size_t)2 * DE * D, gf, 0, D, 2 * DE, NE, 1); \
                transpose_family_f8<0>(FR, wd, (size_t)DE * D, dd, (size_t)D * DE, nullptr, 0, DE, D, NE, 1); } \
            else { \
                transpose_family<1>(FR, wu, (size_t)D * 2 * DE, (bf16*)du, (size_t)2 * DE * D, gf, 0, D, 2 * DE, NE, 1); \
                transpose_family<0>(FR, wd, (size_t)DE * D, (bf16*)dd, (size_t)D * DE, nullptr, 0, DE, D, NE, 1); } } \
        if (PROJ_FP8) transpose_family_f8<3>(FR, AP->in[8], 0, ws + WS_WIN1T, 0, AP->in[2] + D, 0, D, C_IN, 1, 1); \
        else transpose_family<3>(FR, AP->in[8], 0, WSP(bf16, WS_WIN1T), 0, AP->in[2] + D, 0, D, C_IN, 1, 1); \
        transpose_family<0>(FR, AP->in[7], 0, WSP(bf16, WS_WOUT0T), 0, nullptr, 0, D, D, 1, 1); \
        transpose_family<0>(FR, AP->in[9], 0, WSP(bf16, WS_WOUT1T), 0, nullptr, 0, C_OUT, D, 1, 1); \
        if (PLE_FP8) transpose_family_f8<0>(FR, AP->in[18], (size_t)D * D, ws + WS_WGT, (size_t)D * D * 2, nullptr, 0, D, D, 2, 1); \
        else transpose_family<0>(FR, AP->in[18], (size_t)D * D, WSP(bf16, WS_WGT), (size_t)D * D, nullptr, 0, D, D, 2, 1); \
    } while (0)
    if (((MK_MASK >> 12) & 1) && IN(0) && refresh(F)) REP(12) {
        if (PROJ_FP8) transpose_family_f8<2>(F, AP->in[3], 0, ws + WS_WIN0T, 0, AP->in[2], 0, D, AB_IN, 1, 1);
        else transpose_family<2>(F, AP->in[3], 0, WSP(bf16, WS_WIN0T), 0, AP->in[2], 0, D, AB_IN, 1, 1);
        transpose_family<0>(F, AP->in[17], (size_t)PLE * D, WSP(bf16, WS_WPT), (size_t)D * PLE, nullptr, 0, PLE, D, 2, 1);
        if (NG_PROJ == 0) BIG_CONVERSIONS(F);
        {
            float* WR = WSP(float, WS_WR); const float* nf = AP->in[10]; const float* rw = AP->in[11];
            for (int i = F.gw * 64 + F.lane; i < 2 * NE * D; i += F.NGW * 64) { const int l = i / (NE * D), e = (i / D) % NE, k = i % D; WR[i] = nf[l * D + k] * rw[((size_t)l * D + k) * NE + e]; }
        }
        {
            float* R1 = WSP(float, WS_ROPE1); float* RA = WSP(float, WS_ROPEA);
            for (int i = F.gw * 64 + F.lane; i < SEQ * 32; i += F.NGW * 64) { const int pos = i >> 5, j = i & 31;
                const int o = (pos * 32 + (j & ~1)) * 2 + (j & 1);
                const float a1 = (float)pos * rope_freq(j, 32); R1[o] = cosf(a1); R1[o + 2] = sinf(a1);
                const float aa = (float)((j < 16) ? (pos >> 6) : (pos & 63)) * rope_freq(j & 15, 16); RA[o] = cosf(aa); RA[o + 2] = sinf(aa); }
        }
        {
            bf16* PBF = WSP(bf16, WS_PBF); const float* p_in = AP->in[1]; const size_t n8 = (size_t)2 * T * PLE / 8;
            for (size_t i = (size_t)F.gw * 64 + F.lane; i < n8; i += (size_t)F.NGW * 64) { const f32x4 a = __builtin_nontemporal_load((const f32x4*)(p_in + i * 8)), b = __builtin_nontemporal_load((const f32x4*)(p_in + i * 8 + 4));
                v4u w; w.x = pk2(a.x, a.y); w.y = pk2(a.z, a.w); w.z = pk2(b.x, b.y); w.w = pk2(b.z, b.w); *(v4u*)(PBF + i * 8) = w; }
        }
        {
            bf16* X0 = WSP(bf16, WS_X0); float* SS0 = WSP(float, WS_SSP); const float* x_in = AP->in[0];
            for (int m = F.gw; m < T; m += F.NGW) { float s = 0.f;
#pragma unroll
                for (int j = 0; j < 2; ++j) { const size_t co = (size_t)m * D + j * 512 + F.lane * 8; const f32x4 a = __builtin_nontemporal_load((const f32x4*)(x_in + co)), b = __builtin_nontemporal_load((const f32x4*)(x_in + co + 4));
                    v4u w; w.x = pk2(a.x, a.y); w.y = pk2(a.z, a.w); w.z = pk2(b.x, b.y); w.w = pk2(b.z, b.w); *(v4u*)(X0 + co) = w;
                    if (PROJ_FP8) { v2u q; q.x = pk4_fp8(clamp448(bflo(w.x)), clamp448(bfhi(w.x)), clamp448(bflo(w.y)), clamp448(bfhi(w.y))); q.y = pk4_fp8(clamp448(bflo(w.z)), clamp448(bfhi(w.z)), clamp448(bflo(w.w)), clamp448(bfhi(w.w))); *(v2u*)(ws + WS_HF8 + co) = q; }
                    s += (bflo(w.x) * bflo(w.x) + bfhi(w.x) * bfhi(w.x)) + (bflo(w.y) * bflo(w.y) + bfhi(w.y) * bfhi(w.y)) + (bflo(w.z) * bflo(w.z) + bfhi(w.z) * bfhi(w.z)) + (bflo(w.w) * bflo(w.w) + bfhi(w.w) * bfhi(w.w)); }
                s = wave_sum(s); if (F.lane < 16) SS0[(size_t)m * 16 + F.lane] = (F.lane == 0) ? s : 0.f; }
        }
        __syncthreads();
        SEAM(0);
    }
#pragma unroll 1
    for (int l = 0; l < 2; ++l) {
        const int pb = 1 + 10 * l;
        if (INL(0)) REP(0) {
            const bool split = (NG_PROJ > 0) && (l == 0) && (F.G == 256);
            const bool gemm_role = !split || (F.bx < NG_PROJ);
            if (!gemm_role) { Frame F2 = F; F2.gw = (F.bx - NG_PROJ) * NWAVES + F.wave; F2.NGW = (F.G - NG_PROJ) * NWAVES; BIG_CONVERSIONS(F2); __syncthreads(); }
            else {
            const int Gg = split ? NG_PROJ : F.G;
            const bf16* hin = (l == 0) ? WSP(bf16, WS_X0) : WSP(bf16, WS_H3);
            const float* ssin = WSP(float, WS_SSP) + (size_t)l * T * 16;
            const bf16* ain = PROJ_FP8 ? (const bf16*)(ws + WS_HF8 + (size_t)l * T * D) : hin; const int Kin = PROJ_FP8 ? D / 2 : D;
            LAS int* PML = (LAS int*)(F.lds + RING_OFF + RING_BYTES); LAS float* RSL = (LAS float*)(F.lds + RING_OFF + RING_BYTES + 64);
            { pg8::StaticOrder S0; S0.init(T, l == 0 ? AB_IN : C_IN, Gg, F.bx);
#pragma unroll
              for (int i = 0; i < 8; ++i) { pg8::Unit uu; uu.pm = 0; uu.pn = 0; const bool has = S0.next(i, uu); const int pmv = has ? uu.pm : -1;
                  if (F.tid == 0) PML[i] = pmv;
                  if (has && F.tid < 256) RSL[i * 256 + F.tid] = __builtin_amdgcn_rsqf(ssp_sum(ssin + (size_t)(pmv * 256 + F.tid) * 16) * (1.f / D) + NORM_EPS); }
              __syncthreads(); }
            if (l == 0) { pg8::Gemm g{ain, WSP(bf16, WS_WIN0T), T, AB_IN, Kin}; pg8::StaticOrder S; S.init(T, AB_IN, Gg, F.bx);
                EpiQKV<0> E{RSL, PML, AP->in[4], AP->in[5], WSP(float, WS_ROPE1), WSP(float, WS_ROPEA), WSP(bf16, WS_Q3), WSP(bf16, WS_K3), WSP(bf16, WS_V3)};
                pg8::gemm_phase<EpiQKV<0>, pg8::StaticOrder, true, true, PROJ_FP8 ? 127 - F8_WSC : -1>(F.lds + RING_OFF, g, S, E); }
            else { pg8::Gemm g{ain, WSP(bf16, WS_WIN1T), T, C_IN, Kin}; pg8::StaticOrder S; S.init(T, C_IN, Gg, F.bx);
                EpiQKV<1> E{RSL, PML, nullptr, nullptr, WSP(float, WS_ROPE1), WSP(float, WS_ROPEA), WSP(bf16, WS_Q3), WSP(bf16, WS_K3), WSP(bf16, WS_V3)};
                pg8::gemm_phase<EpiQKV<1>, pg8::StaticOrder, true, true, PROJ_FP8 ? 127 - F8_WSC : -1>(F.lds + RING_OFF, g, S, E); }
            if (l == 0) { int Kp = PLE; asm volatile("" : "+s"(Kp)); pg8::Gemm g{WSP(bf16, WS_PBF), WSP(bf16, WS_WPT), 2 * T, 2 * D, Kp}; PPOrder S{Gg, F.bx};
                EpiPP E{WSP(bf16, WS_PP)};
                pg8::gemm_phase<EpiPP, PPOrder, true, true>(F.lds + RING_OFF, g, S, E); }
            }
            SEAM(pb + 0);
        }
        if (INL(1)) REP(1) {
            if (l == 0) attn_phase_l0(F, WSP(bf16, WS_Q3), WSP(bf16, WS_K3), WSP(bf16, WS_V3), WSP(bf16, WS_OCAT), AP->in[6]);
            else attn_phase_l1(F, WSP(bf16, WS_Q3), WSP(bf16, WS_K3), WSP(bf16, WS_V3), WSP(bf16, WS_OGB), WSP(float, WS_LSE));
            SEAM(pb + 1);
        }
        if (INL(2)) REP(2) { if (l == 1) merge_phase(F, WSP(bf16, WS_OGB), WSP(float, WS_LSE), WSP(bf16, WS_OCAT)); SEAM(pb + 2); }
        if (INL(3)) REP(3) {
            const bf16* hin = (l == 0) ? WSP(bf16, WS_X0) : WSP(bf16, WS_H3);
            pg8::Gemm g{WSP(bf16, WS_OCAT), (const bf16*)(ws + (l == 0 ? WS_WOUT0T : WS_WOUT1T)), T, D, (l == 0) ? D : C_OUT}; pg8::StaticOrder S; S.init(T, D, F.G, F.bx); EpiResBf16 E{hin, WSP(bf16, WS_HM)};
            pg8::gemm_phase<EpiResBf16, pg8::StaticOrder, true, true>(F.lds + RING_OFF, g, S, E);
            SEAM(pb + 3);
        }
        if (INL(4)) REP(4) { route_phase(F, WSP(bf16, WS_HM), WSP(float, WS_WR) + (size_t)l * NE * D, AP->in[12] + l * NE, WSP(int, WS_CNTTAB), WSP(int, WS_TOPE), WSP(float, WS_TOPG), WSP(int, WS_TOPPOS), WSP(float, WS_RSTD));
#ifdef PROBE_ROUTE
            route_phase(F, WSP(bf16, WS_HM), WSP(float, WS_WR) + (size_t)l * NE * D, AP->in[12] + l * NE, WSP(int, WS_OGB) + 16 * T, WSP(int, WS_OGB), WSP(float, WS_OGB) + 4 * T, WSP(int, WS_OGB) + 8 * T, WSP(float, WS_OGB) + 12 * T);
#endif
            SEAM(pb + 4); }
        if (INL(5)) REP(5) { slot_phase(F, WSP(bf16, WS_HM), WSP(int, WS_CNTTAB), WSP(int, WS_TOPE), WSP(float, WS_TOPG), WSP(int, WS_TOPPOS), WSP(float, WS_RSTD), WSP(int, WS_TOKSLOT), WSP(float, WS_SLOTGATE), WSP(float, WS_SLOTRS), WSP(bf16, WS_XG), WSP(int, WS_XTAB), ((MOE_FP8_MASK >> l) & 1) != 0); SEAM(pb + 5); }
        if (INL(6)) REP(6) {
            XcdOrder<3> S{WSP(int, WS_XTAB) + (F.bx & 7) * 136, F.bx >> 3, (int)F.G >> 3};
#if MOE_FP8_MASK != 0
            if ((MOE_FP8_MASK >> l) & 1) { pg8::Gemm g{WSP(bf16, WS_XG), WSP(bf16, WS_WUPT) + (size_t)l * NE * 2 * DE * D, NSLOT, NE * 2 * DE, D / 2};
                EpiSwiglu<true> E{WSP(void, WS_ACT), AP->in[14] + (size_t)l * NE * 2 * DE, nullptr};
                pg8::gemm_phase<EpiSwiglu<true>, XcdOrder<3>, true, true, F8_DIAG ? 1000 : 127 - F8_WSC>(F.lds + RING_OFF, g, S, E); }
#ifdef PROBE_UPNULL
            if ((MOE_FP8_MASK >> l) & 1) { pg8::Gemm g{WSP(bf16, WS_XG), WSP(bf16, WS_WUPT) + (size_t)l * NE * 2 * DE * D, NSLOT, NE * 2 * DE, D / 2};
                EpiNull E{WSP(float, WS_OGB)};
                pg8::gemm_phase<EpiNull, XcdOrder<3>, true, true, 127 - F8_WSC>(F.lds + RING_OFF, g, S, E); }
#endif
#endif
#if MOE_FP8_MASK != 3
            if (!((MOE_FP8_MASK >> l) & 1)) { pg8::Gemm g{WSP(bf16, WS_XG), WSP(bf16, WS_WUPT) + (size_t)l * NE * 2 * DE * D, NSLOT, NE * 2 * DE, D};
                EpiSwiglu<false> E{WSP(void, WS_ACT), AP->in[14] + (size_t)l * NE * 2 * DE, WSP(float, WS_SLOTRS)};
                pg8::gemm_phase<EpiSwiglu<false>, XcdOrder<3>, true, true>(F.lds + RING_OFF, g, S, E); }
#endif
            SEAM(pb + 6);
        }
        if (INL(7)) REP(7) {
            XcdOrder<2> S{WSP(int, WS_XTAB) + (F.bx & 7) * 136, F.bx >> 3, (int)F.G >> 3};
            EpiDown<Y_FP8 != 0> E{WSP(void, WS_Y), AP->in[16] + (size_t)l * NE * D, WSP(float, WS_SLOTGATE), ((MOE_FP8_MASK >> l) & 1) ? F8_EPI_SC : 1.f};
#if MOE_FP8_MASK != 0
            if ((MOE_FP8_MASK >> l) & 1) { pg8::Gemm g{WSP(bf16, WS_ACT), WSP(bf16, WS_WDNT) + (size_t)l * NE * D * DE, NSLOT, NE * D, DE / 2};
                pg8::gemm_phase<EpiDown<Y_FP8 != 0>, XcdOrder<2>, true, true, F8_DIAG ? 1000 : 127 - F8_WSC>(F.lds + RING_OFF, g, S, E); }
#ifdef PROBE_DNNULL
            if ((MOE_FP8_MASK >> l) & 1) { pg8::Gemm g{WSP(bf16, WS_ACT), WSP(bf16, WS_WDNT) + (size_t)l * NE * D * DE, NSLOT, NE * D, DE / 2};
                EpiNull E2{WSP(float, WS_OGB)};
                pg8::gemm_phase<EpiNull, XcdOrder<2>, true, true, 127 - F8_WSC>(F.lds + RING_OFF, g, S, E2); }
#endif
#endif
#if MOE_FP8_MASK != 3
            if (!((MOE_FP8_MASK >> l) & 1)) { pg8::Gemm g{WSP(bf16, WS_ACT), WSP(bf16, WS_WDNT) + (size_t)l * NE * D * DE, NSLOT, NE * D, DE};
                pg8::gemm_phase<EpiDown<Y_FP8 != 0>, XcdOrder<2>, true, true>(F.lds + RING_OFF, g, S, E); }
#endif
            SEAM(pb + 7);
        }
        if (INL(8)) REP(8) { combine_phase(F, WSP(bf16, WS_HM), WSP(void, WS_Y), WSP(int, WS_TOKSLOT), WSP(bf16, WS_H2), ws + WS_H2F8); SEAM(pb + 8); }
        if (INL(9)) REP(9) {
            pg8::StaticOrder S; S.init(T, D, F.G, F.bx);
            EpiPle E{WSP(bf16, WS_H2), WSP(bf16, WS_PP) + (size_t)l * T * D, WSP(bf16, WS_H3), WSP(float, WS_SSP) + (size_t)(l + 1) * T * 16, (PROJ_FP8 && l == 0) ? ws + WS_HF8 + (size_t)T * D : nullptr};
            if (PLE_FP8) { pg8::Gemm g{WSP(bf16, WS_H2F8), WSP(bf16, WS_WGT) + (size_t)l * D * D, T, D, D / 2};
                pg8::gemm_phase<EpiPle, pg8::StaticOrder, true, true, 127 - F8_WSC>(F.lds + RING_OFF, g, S, E); }
            else { pg8::Gemm g{WSP(bf16, WS_H2), WSP(bf16, WS_WGT) + (size_t)l * D * D, T, D, D};
                pg8::gemm_phase<EpiPle, pg8::StaticOrder, true, true>(F.lds + RING_OFF, g, S, E); }
#ifdef PROBE_PLENULL
            { pg8::Gemm g{WSP(bf16, WS_H2), WSP(bf16, WS_WGT) + (size_t)l * D * D, T, D, D}; EpiNull EN{WSP(float, WS_OGB)};
                pg8::gemm_phase<EpiNull, pg8::StaticOrder, true, true>(F.lds + RING_OFF, g, S, EN); }
#endif
            SEAM(pb + 9);
        }
    }
#ifdef PROBE_BARRIERS
    for (int pb_ = 0; pb_ < PROBE_BARRIERS; ++pb_) xcd_barrier(bar);
#endif
    if (((MK_MASK >> 13) & 1) && IN(21) && refresh(F)) final_norm_phase(F, WSP(bf16, WS_H3), WSP(float, WS_SSP) + (size_t)2 * T * 16, AP->in[19], AP->out);
#undef IN
#undef INL
#undef REP
#undef SEAM
#undef ws
#undef WSP
#undef BIG_CONVERSIONS
}

#ifndef MK_ONE_LAUNCH
#define MK_ONE_LAUNCH 1
#endif
extern "C" void kernel_launch(void* const* d_in, const int* in_sizes, int n_in, void* d_out, int out_size, void* d_ws, size_t ws_size, hipStream_t stream) {
    static int grid = 0;
    if (grid == 0) {
        if (n_in != 20 || in_sizes[0] != T * D || out_size != T * D || ws_size < WS_END) { fprintf(stderr, "kernel_launch: unexpected shapes: n_in %d in0 %d out %d ws %zu (need %zu)\n", n_in, n_in > 0 ? in_sizes[0] : -1, out_size, ws_size, (size_t)WS_END); grid = -1; return; }
        int dev = 0, cus = 0, per_cu = 0;
        if (hipGetDevice(&dev) != hipSuccess || hipDeviceGetAttribute(&cus, hipDeviceAttributeMultiprocessorCount, dev) != hipSuccess) { grid = -1; return; }
        if (hipFuncSetAttribute((const void*)fwd_kernel, hipFuncAttributeMaxDynamicSharedMemorySize, LDS_BYTES) != hipSuccess) { fprintf(stderr, "kernel_launch: hipFuncSetAttribute failed\n"); grid = -1; return; }
        if (hipOccupancyMaxActiveBlocksPerMultiprocessor(&per_cu, (const void*)fwd_kernel, NWAVES * 64, LDS_BYTES) != hipSuccess || per_cu < 1) fprintf(stderr, "kernel_launch: occupancy query says %d\n", per_cu);
        (void)hipGetLastError();
        grid = cus;
        if (grid != 256) fprintf(stderr, "kernel_launch: %d CUs (built for 256)\n", grid);
    }
    if (grid < 0) return;
    if (hipMemsetAsync((char*)d_ws + WS_CTL, 0, CTL_ZERO_BYTES, stream) != hipSuccess) return;
    Args a{};
    for (int i = 0; i < 20; ++i) a.in[i] = (const float*)d_in[i];
    a.out = (float*)d_out; a.ws = (unsigned char*)d_ws;
#if MK_ONE_LAUNCH
    a.ph_lo = 0; a.ph_hi = N_PHASES; a.li = 0;
    hipLaunchKernelGGL(fwd_kernel, dim3(grid), dim3(NWAVES * 64), LDS_BYTES, stream, a);
#else
    for (int ph = 0; ph < N_PHASES; ++ph) {
        if (ph == 3) continue;
        a.ph_lo = ph; a.ph_hi = ph + 1; a.li = ph;
        hipLaunchKernelGGL(fwd_kernel, dim3(grid), dim3(NWAVES * 64), LDS_BYTES, stream, a);
    }
#endif
}
```

```cpp
#include <hip/hip_runtime.h>
#include <hip/hip_bf16.h>
#include <cstdio>
#include <cstdint>
#include <cmath>
namespace pg8 {
#define PG8_LAS __attribute__((address_space(3)))
typedef unsigned short bf16_t;
typedef short bf16x8 __attribute__((ext_vector_type(8)));
typedef float f32x4 __attribute__((ext_vector_type(4)));
typedef unsigned u32x4 __attribute__((ext_vector_type(4)));
typedef int pg8_v4i __attribute__((ext_vector_type(4)));
typedef long pg8_v2l __attribute__((ext_vector_type(2)));
constexpr int BM = 256, BK = 64, HALF = 128, HTB = HALF * BK * 2  , STAGE_BYTES = 8 * HTB, NXCD = 8, WGM = 8;

__host__ __device__ __forceinline__ int lds_byte(int r, int c) { const int st = (r >> 4) * 2 + (c >> 5), rr = r & 15, cc = c & 31, ob = rr * 64 + cc * 2; return st * 1024 + (ob ^ (((ob >> 9) & 1) << 5)); }
__host__ __device__ __forceinline__ void stage_rc(int b, int& R, int& C) { const int st = b / 1024, sb = b % 1024, swz = sb ^ (((sb >> 9) & 1) << 5); R = (st >> 1) * 16 + swz / 64; C = (st & 1) * 32 + (swz % 64) / 2; }
__host__ __device__ __forceinline__ int perm32(int rho) { const int n = rho >> 4, i = rho & 15; return 8 * (i >> 2) + 4 * n + (i & 3); }

struct Unit { int pm, pn; };
struct Gemm { const bf16_t* A; const bf16_t* Bt; int M, N, K; };

struct StaticOrder {
    int nM, nN, nwg, G, c;
    __host__ __device__ __forceinline__ void init(int M, int N, int G_, int c_) { nM = M / BM; nN = N / BM; nwg = nM * nN; G = G_; c = c_; }
    __host__ __device__ __forceinline__ bool next(int i, Unit& u) const {
        const long L = (long)i * G + c; if (L >= nwg) return false;
        int wgid = (int)L; { const int q = nwg / NXCD, r = nwg % NXCD, xcd = wgid % NXCD, off = wgid / NXCD; wgid = (xcd < r ? xcd * (q + 1) : r * (q + 1) + (xcd - r) * q) + off; }
        const int nig = WGM * nN, gid = wgid / nig, fm = gid * WGM, gsz = (nM - fm) < WGM ? (nM - fm) : WGM;
        u.pm = fm + ((wgid % nig) % gsz); u.pn = (wgid % nig) / gsz; return true;
    }
    __device__ __forceinline__ void a_ready(const Unit&) const {}
    __device__ __forceinline__ void done(const Unit&) const {}
};

__device__ __forceinline__ unsigned cvt_pk_bf16(float lo, float hi) { unsigned r; asm volatile("v_cvt_pk_bf16_f32 %0, %1, %2" : "=v"(r) : "v"(lo), "v"(hi)); return r; }
typedef float f32x2 __attribute__((ext_vector_type(2)));
__device__ __forceinline__ f32x2 gelu_pk(f32x2 v) {
    const f32x2 av = __builtin_elementwise_abs(v), d = av * 0.2316418882f + 1.0f;
    f32x2 t; t.x = __builtin_amdgcn_rcpf(d.x); t.y = __builtin_amdgcn_rcpf(d.y);
    f32x2 q = t * 0.5307027145f + (-0.7265760135f); q = q * t + 0.7107068705f; q = q * t + (-0.142248368f); q = q * t + 0.127414796f; q = q * t;
    const f32x2 s = (v * v) * (-0.72134752044f);
    f32x2 e; e.x = __builtin_amdgcn_exp2f(s.x); e.y = __builtin_amdgcn_exp2f(s.y);
    const f32x2 m = v * (q * e), r = v - m;
    f32x2 o; o.x = v.x < 0.f ? m.x : r.x; o.y = v.y < 0.f ? m.y : r.y; return o;
}

template <int ACT  > struct EpiBf16 {
    static constexpr bool PERM = true, AFTER_DRAIN = false; static_assert(ACT == 0 || ACT == 1, "EpiBf16: ACT is 0 (none) or 1 (gelu_pk)");
    bf16_t* O; int ldc; const float* bias; int split_cols; size_t split_stride; float scale0;
    __device__ __forceinline__ void operator()(const f32x4 (&acc)[2][2][4][2], const Unit& u, int wr, int wc, int fr, int fq) const {
        const int row0 = u.pm * BM + wr * 64 + fr; int colt = u.pn * BM; bf16_t* base = O;
        float sc = 1.f; if (split_cols) { const int t = colt / split_cols; base += (size_t)t * split_stride; colt -= t * split_cols; if (t == 0) sc = scale0; }
        const int col0 = colt + wc * 32 + 8 * fq, bcol0 = u.pn * BM + wc * 32 + 8 * fq;
        f32x4 bv[2][2];
#pragma unroll
        for (int bj = 0; bj < 2; ++bj)
#pragma unroll
            for (int n = 0; n < 2; ++n) bv[bj][n] = bias ? *(const f32x4*)(bias + bcol0 + bj * HALF + 4 * n) : (f32x4){0.f, 0.f, 0.f, 0.f};
#pragma unroll
        for (int ai = 0; ai < 2; ++ai)
#pragma unroll
            for (int m = 0; m < 4; ++m) { bf16_t* rowp = base + (size_t)(row0 + ai * HALF + m * 16) * ldc + col0;
#pragma unroll
                for (int bj = 0; bj < 2; ++bj) { f32x4 v0 = acc[ai][bj][m][0] + bv[bj][0], v1 = acc[ai][bj][m][1] + bv[bj][1];
                    if (ACT == 1) { f32x2 a = gelu_pk((f32x2){v0[0], v0[1]}), b = gelu_pk((f32x2){v0[2], v0[3]}), c = gelu_pk((f32x2){v1[0], v1[1]}), d = gelu_pk((f32x2){v1[2], v1[3]});
                        v0 = (f32x4){a.x, a.y, b.x, b.y}; v1 = (f32x4){c.x, c.y, d.x, d.y}; }
                    v0 = v0 * sc; v1 = v1 * sc; u32x4 w; w.x = cvt_pk_bf16(v0[0], v0[1]); w.y = cvt_pk_bf16(v0[2], v0[3]); w.z = cvt_pk_bf16(v1[0], v1[1]); w.w = cvt_pk_bf16(v1[2], v1[3]);
                    *(u32x4*)(rowp + bj * HALF) = w; } }
    }
};
template <class Epi, class Sched, bool ALIGN_EPI = false, bool SP2 = false, int FP8SC = -1>
__device__ __forceinline__ void gemm_phase(PG8_LAS unsigned char* lds, const Gemm g, const Sched& S, const Epi& E) {
    int tid_ = threadIdx.x; asm volatile("" : "+v"(tid_));
    const int tid = tid_, wid = __builtin_amdgcn_readfirstlane(tid >> 6), lane = tid & 63, wr = wid >> 2, wc = wid & 3, fr = lane & 15, fq = lane >> 4;
    const int K = g.K, nt = K / BK;
    unsigned voffA[2], voffB[2];
#pragma unroll
    for (int i = 0; i < 2; ++i) { int R, C; stage_rc(tid * 16 + i * 8192, R, C); const int Rb = Epi::PERM ? ((R & ~31) + perm32(R & 31)) : R;
        voffA[i] = (unsigned)(R * K + C) * 2u; voffB[i] = (unsigned)(Rb * K + C) * 2u; }
    const size_t kstep = (size_t)(BK * 2);
    const size_t hstep = (size_t)HALF * K * 2;
    const size_t tstep = 2 * hstep;
    const unsigned ldsw = (unsigned)wid * 1024u;
    const int aoff = lds_byte(wr * 64 + fr, fq * 8), boff = lds_byte(wc * 32 + fr, fq * 8);
#define PG8_SA(b, h) (((b) * 2 + (h)) * HTB)
#define PG8_SB(b, h) ((4 + (b) * 2 + (h)) * HTB)
#define PG8_STAGE(bufoff, gbase, voff) do { _Pragma("unroll") for (int _i = 0; _i < 2; ++_i) \
        __builtin_amdgcn_global_load_lds((const unsigned*)((const char*)(gbase) + (voff)[_i]), (PG8_LAS unsigned*)(lds + (bufoff) + ldsw + _i * 8192), 16, 0, 0); } while (0)
#define PG8_LDA(dst, b, h) do { _Pragma("unroll") for (int m = 0; m < 4; ++m) _Pragma("unroll") for (int k = 0; k < 2; ++k) dst[m][k] = *(const PG8_LAS bf16x8*)(lds + PG8_SA(b, h) + aoff + m * 2048 + k * 1024); } while (0)
#define PG8_LDB(dst, b, h) do { _Pragma("unroll") for (int n = 0; n < 2; ++n) _Pragma("unroll") for (int k = 0; k < 2; ++k) dst[n][k] = *(const PG8_LAS bf16x8*)(lds + PG8_SB(b, h) + boff + n * 2048 + k * 1024); } while (0)
#define PG8_CAT8(x0, x1) __builtin_shufflevector(__builtin_bit_cast(pg8_v4i, x0), __builtin_bit_cast(pg8_v4i, x1), 0, 1, 2, 3, 4, 5, 6, 7)
#define PG8_MMA(ai, bj, At, Bt) do { __builtin_amdgcn_s_setprio(1); \
        if constexpr (FP8SC < 0) { _Pragma("unroll") for (int m = 0; m < 4; ++m) _Pragma("unroll") for (int n = 0; n < 2; ++n) _Pragma("unroll") for (int k = 0; k < 2; ++k) \
            acc[ai][bj][m][n] = __builtin_amdgcn_mfma_f32_16x16x32_bf16(Bt[n][k], At[m][k], acc[ai][bj][m][n], 0, 0, 0); } \
        else if constexpr (FP8SC >= 1000) { _Pragma("unroll") for (int m = 0; m < 4; ++m) _Pragma("unroll") for (int n = 0; n < 2; ++n) _Pragma("unroll") for (int k = 0; k < 2; ++k) { \
            const pg8_v2l bq = __builtin_bit_cast(pg8_v2l, Bt[n][k]), aq = __builtin_bit_cast(pg8_v2l, At[m][k]); \
            acc[ai][bj][m][n] = __builtin_amdgcn_mfma_f32_16x16x32_fp8_fp8(bq[0], aq[0], acc[ai][bj][m][n], 0, 0, 0); acc[ai][bj][m][n] = __builtin_amdgcn_mfma_f32_16x16x32_fp8_fp8(bq[1], aq[1], acc[ai][bj][m][n], 0, 0, 0); } } \
        else { _Pragma("unroll") for (int m = 0; m < 4; ++m) _Pragma("unroll") for (int n = 0; n < 2; ++n) \
            acc[ai][bj][m][n] = __builtin_amdgcn_mfma_scale_f32_16x16x128_f8f6f4(PG8_CAT8(Bt[n][0], Bt[n][1]), PG8_CAT8(At[m][0], At[m][1]), acc[ai][bj][m][n], 0, 0, 0, (FP8SC < 0 ? 127 : FP8SC) * 0x01010101, 0, 0x7f7f7f7f); \
            _Pragma("unroll") for (int m = 0; m < 4; ++m) _Pragma("unroll") for (int n = 0; n < 2; ++n) asm volatile("" : "+v"(acc[ai][bj][m][n])); }     \
        __builtin_amdgcn_s_setprio(0); } while (0)
#define PG8_WAIT_V(n) asm volatile("s_waitcnt vmcnt(" #n ")" ::: "memory")
#define PG8_WAIT_L(n) asm volatile("s_waitcnt lgkmcnt(" #n ")" ::: "memory")
#define PG8_BAR __builtin_amdgcn_s_barrier()
#define PG8_SCHED __builtin_amdgcn_sched_barrier(0)
    Unit cur, nxt; int ui = 0;
    if (!S.next(0, cur)) return;
    f32x4 acc[2][2][4][2];
#pragma unroll
    for (int a = 0; a < 2; ++a)
#pragma unroll
        for (int b = 0; b < 2; ++b)
#pragma unroll
            for (int m = 0; m < 4; ++m)
#pragma unroll
                for (int n = 0; n < 2; ++n) acc[a][b][m][n] = (f32x4){0.f, 0.f, 0.f, 0.f};
    bf16x8 At[4][2], B0[2][2], B1[2][2];
    const char* cA = (const char*)g.A + (size_t)cur.pm * tstep; const char* cB = (const char*)g.Bt + (size_t)cur.pn * tstep;
    S.a_ready(cur);
    if constexpr (SP2) {
        PG8_STAGE(PG8_SB(0, 0), cB, voffB); PG8_STAGE(PG8_SB(0, 1), cB + hstep, voffB); PG8_STAGE(PG8_SA(0, 0), cA, voffA); PG8_STAGE(PG8_SA(0, 1), cA + hstep, voffA);
        if (wr == 1) PG8_BAR;
        PG8_WAIT_V(2); PG8_BAR;
        PG8_STAGE(PG8_SB(1, 0), cB + kstep, voffB); PG8_STAGE(PG8_SA(1, 0), cA + kstep, voffA); PG8_STAGE(PG8_SB(1, 1), cB + hstep + kstep, voffB);
        PG8_WAIT_V(6); PG8_BAR;
    } else {
        PG8_STAGE(PG8_SB(0, 0), cB, voffB); PG8_STAGE(PG8_SA(0, 0), cA, voffA); PG8_STAGE(PG8_SB(0, 1), cB + hstep, voffB); PG8_STAGE(PG8_SA(0, 1), cA + hstep, voffA);
        if (wr == 1) PG8_BAR;
        PG8_WAIT_V(4); PG8_BAR;
        PG8_STAGE(PG8_SB(1, 0), cB + kstep, voffB); PG8_STAGE(PG8_SA(1, 0), cA + kstep, voffA); PG8_STAGE(PG8_SB(1, 1), cB + hstep + kstep, voffB);
        PG8_WAIT_V(6); PG8_BAR;
    }
    for (;;) {
        const bool has_next = S.next(ui + 1, nxt);
        const char* nA = has_next ? (const char*)g.A + (size_t)nxt.pm * tstep : cA; const char* nB = has_next ? (const char*)g.Bt + (size_t)nxt.pn * tstep : cB;
        for (int t = 0; t < nt; t += 2) {
            const bool last = (t == nt - 2);
            const char* a1 = cA + (size_t)(t + 1) * kstep;
            const char* a2 = last ? nA : cA + (size_t)(t + 2) * kstep; const char* b2 = last ? nB : cB + (size_t)(t + 2) * kstep;
            const char* a3 = a2 + kstep; const char* b3 = b2 + kstep;
            if (last && has_next) S.a_ready(nxt);
            if constexpr (SP2) {
            PG8_LDB(B0, 0, 0); PG8_LDB(B1, 0, 1); PG8_SCHED; PG8_LDA(At, 0, 0); PG8_STAGE(PG8_SA(1, 1), a1 + hstep, voffA);
            PG8_WAIT_V(8); PG8_WAIT_L(0); PG8_BAR; PG8_MMA(0, 0, At, B0); PG8_MMA(0, 1, At, B1); PG8_BAR; PG8_SCHED;
            PG8_LDA(At, 0, 1); PG8_STAGE(PG8_SB(0, 0), b2, voffB); PG8_STAGE(PG8_SB(0, 1), b2 + hstep, voffB); PG8_STAGE(PG8_SA(0, 0), a2, voffA);
            PG8_WAIT_V(8); PG8_WAIT_L(0); PG8_BAR; PG8_MMA(1, 0, At, B0); PG8_MMA(1, 1, At, B1); PG8_BAR; PG8_SCHED;
            PG8_LDB(B0, 1, 0); PG8_LDB(B1, 1, 1); PG8_SCHED; PG8_LDA(At, 1, 0); PG8_STAGE(PG8_SA(0, 1), a2 + hstep, voffA);
            PG8_WAIT_V(8); PG8_WAIT_L(0); PG8_BAR; PG8_MMA(0, 0, At, B0); PG8_MMA(0, 1, At, B1); PG8_BAR; PG8_SCHED;
            PG8_LDA(At, 1, 1); PG8_STAGE(PG8_SB(1, 0), b3, voffB); PG8_STAGE(PG8_SB(1, 1), b3 + hstep, voffB); PG8_STAGE(PG8_SA(1, 0), a3, voffA);
            PG8_WAIT_V(8); PG8_WAIT_L(0); PG8_BAR; PG8_MMA(1, 0, At, B0); PG8_MMA(1, 1, At, B1); PG8_BAR; PG8_SCHED;
            } else {
            PG8_LDB(B0, 0, 0); PG8_SCHED; PG8_LDA(At, 0, 0); PG8_STAGE(PG8_SA(1, 1), a1 + hstep, voffA);
            PG8_WAIT_L(8); PG8_BAR; PG8_WAIT_L(0); PG8_MMA(0, 0, At, B0); PG8_BAR; PG8_SCHED;
            PG8_LDB(B1, 0, 1); PG8_STAGE(PG8_SB(0, 0), b2, voffB);
            PG8_BAR; PG8_WAIT_L(0); PG8_MMA(0, 1, At, B1); PG8_BAR;
            PG8_LDA(At, 0, 1); PG8_STAGE(PG8_SA(0, 0), a2, voffA);
            PG8_BAR; PG8_WAIT_L(0); PG8_MMA(1, 0, At, B0); PG8_BAR; PG8_SCHED;
            PG8_STAGE(PG8_SB(0, 1), b2 + hstep, voffB);
            PG8_WAIT_V(6); PG8_BAR; PG8_MMA(1, 1, At, B1); PG8_BAR;
            PG8_LDB(B0, 1, 0); PG8_SCHED; PG8_LDA(At, 1, 0); PG8_STAGE(PG8_SA(0, 1), a2 + hstep, voffA);
            PG8_WAIT_L(8); PG8_BAR; PG8_WAIT_L(0); PG8_MMA(0, 0, At, B0); PG8_BAR; PG8_SCHED;
            PG8_LDB(B1, 1, 1); PG8_STAGE(PG8_SB(1, 0), b3, voffB);
            PG8_BAR; PG8_WAIT_L(0); PG8_MMA(0, 1, At, B1); PG8_BAR;
            PG8_LDA(At, 1, 1); PG8_STAGE(PG8_SA(1, 0), a3, voffA);
            PG8_BAR; PG8_WAIT_L(0); PG8_MMA(1, 0, At, B0); PG8_BAR; PG8_SCHED;
            PG8_STAGE(PG8_SB(1, 1), b3 + hstep, voffB);
            PG8_WAIT_V(6); PG8_BAR; PG8_MMA(1, 1, At, B1); PG8_BAR;
            }
        }
        if constexpr (ALIGN_EPI) { if (wr == 0) PG8_BAR; }
        if constexpr (!Epi::AFTER_DRAIN) { int te_ = threadIdx.x; asm volatile("" : "+v"(te_));
            const int le_ = te_ & 63, we_ = __builtin_amdgcn_readfirstlane(te_ >> 6); E(acc, cur, we_ >> 2, we_ & 3, le_ & 15, le_ >> 4); S.done(cur); }
        if (!has_next) break;
#pragma unroll
        for (int a = 0; a < 2; ++a)
#pragma unroll
            for (int b = 0; b < 2; ++b)
#pragma unroll
                for (int m = 0; m < 4; ++m)
#pragma unroll
                    for (int n = 0; n < 2; ++n) acc[a][b][m][n] = (f32x4){0.f, 0.f, 0.f, 0.f};
        cur = nxt; cA = nA; cB = nB; ++ui;
        if constexpr (ALIGN_EPI) { if (wr == 1) PG8_BAR; }
    }
    PG8_WAIT_V(0);
    if constexpr (!ALIGN_EPI) { if (wr == 0) PG8_BAR; }
    PG8_BAR;
    if constexpr (Epi::AFTER_DRAIN) { E.fused(acc, cur, wr, wc, fr, fq, lds, wid, lane); S.done(cur); }
#undef PG8_SA
#undef PG8_SB
#undef PG8_STAGE
#undef PG8_LDA
#undef PG8_LDB
#undef PG8_MMA
#undef PG8_CAT8
#undef PG8_WAIT_V
#undef PG8_WAIT_L
#undef PG8_BAR
#undef PG8_SCHED
}
}

constexpr int NWAVES = 8;
constexpr int BATCH = 2, SEQ = 8192, T = BATCH * SEQ, D = 1024;
constexpr int AB_IN = 1536, C_IN = 2304, C_OUT = 512;
constexpr int NE = 32, DE = 1024, PLE = 256;
constexpr int NSLOT = 73728;
constexpr float NORM_EPS = 1e-6f;
constexpr float LOG2_THETA = 13.287712379549449f;
constexpr float ATT_C2 = 0.125f * 1.4426950408889634f;

#define GAS __attribute__((address_space(1)))
#define LAS __attribute__((address_space(3)))
typedef unsigned short bf16;
typedef unsigned v4u __attribute__((ext_vector_type(4)));
typedef unsigned v2u __attribute__((ext_vector_type(2)));
typedef float f32x4 __attribute__((ext_vector_type(4)));
typedef GAS unsigned gu32;
#define RLX_AGENT __ATOMIC_RELAXED, __HIP_MEMORY_SCOPE_AGENT
#define LDS_WAIT() asm volatile("s_waitcnt lgkmcnt(0)" ::: "memory")
#define VM_WAIT() asm volatile("s_waitcnt vmcnt(0)" ::: "memory")

__device__ __forceinline__ int lane_opaque() { unsigned m = ~0u; asm volatile("" : "+s"(m)); return (int)__builtin_amdgcn_mbcnt_hi(m, __builtin_amdgcn_mbcnt_lo(m, 0u)); }
__device__ __forceinline__ int shx(int v, int m) { return __builtin_amdgcn_ds_bpermute((lane_opaque() ^ m) << 2, v); }
__device__ __forceinline__ float shx(float v, int m) { return __builtin_bit_cast(float, __builtin_amdgcn_ds_bpermute((lane_opaque() ^ m) << 2, __builtin_bit_cast(int, v))); }
__device__ __forceinline__ int shup(int v, int o) { const int l = lane_opaque(); const int s = (l - o) < 0 ? l : (l - o); return __builtin_amdgcn_ds_bpermute(s << 2, v); }
__device__ __forceinline__ int shl(int v, int src) { return __builtin_amdgcn_ds_bpermute(src << 2, v); }
typedef float f32x2_ __attribute__((ext_vector_type(2))); typedef __bf16 bf16x2_ __attribute__((ext_vector_type(2)));
__device__ __forceinline__ unsigned pk2(float lo, float hi) { f32x2_ v = {lo, hi}; bf16x2_ b = __builtin_convertvector(v, bf16x2_); return __builtin_bit_cast(unsigned, b); }
__device__ __forceinline__ float bflo(unsigned w) { return __builtin_bit_cast(float, w << 16); }
__device__ __forceinline__ float bfhi(unsigned w) { return __builtin_bit_cast(float, w & 0xffff0000u); }
#ifndef MOE_FP8_MASK
#define MOE_FP8_MASK 3
#endif
#ifndef F8_DIAG
#define F8_DIAG 0
#endif
constexpr float F8_EPI_SC = F8_DIAG ? (1.f / 64.f) : 1.f;
#ifndef PROJ_FP8
#define PROJ_FP8 1
#endif
#ifndef NG_PROJ
#define NG_PROJ 64
#endif
#ifndef NE_LATE
#define NE_LATE 6
#endif
#ifndef Y_FP8
#define Y_FP8 1
#endif
#ifndef PLE_FP8
#define PLE_FP8 0
#endif
constexpr float Y_SC = 32.f;
constexpr int F8_WSC = 6;
__device__ __forceinline__ unsigned pk4_fp8(float a, float b, float c, float d) { int w = 0; w = __builtin_amdgcn_cvt_pk_fp8_f32(a, b, w, false); w = __builtin_amdgcn_cvt_pk_fp8_f32(c, d, w, true); return (unsigned)w; }
__device__ __forceinline__ float clamp448(float x) { return fminf(fmaxf(x, -448.f), 448.f); }
__device__ __forceinline__ float rnd_bf(float x) { return bflo(pk2(x, 0.f)); }
__device__ __forceinline__ float ssp_sum(const float* p) { const f32x4 a = *(const f32x4*)p, b = *(const f32x4*)(p + 4), c = *(const f32x4*)(p + 8), d = *(const f32x4*)(p + 12);
    return (((a.x + a.y) + (a.z + a.w)) + ((b.x + b.y) + (b.z + b.w))) + (((c.x + c.y) + (c.z + c.w)) + ((d.x + d.y) + (d.z + d.w))); }

constexpr size_t MiB = 1u << 20;
constexpr size_t al256(size_t x) { return (x + 255) & ~(size_t)255; }
constexpr size_t WS_CTL = 0, CTL_ZERO_BYTES = 1 * MiB;
constexpr size_t WS_WIN0T = 1 * MiB;
constexpr size_t WS_WOUT0T = WS_WIN0T + (size_t)AB_IN * D * 2;
constexpr size_t WS_WIN1T = WS_WOUT0T + (size_t)D * D * 2;
constexpr size_t WS_WOUT1T = WS_WIN1T + (size_t)C_IN * D * 2;
constexpr size_t WS_WGT = WS_WOUT1T + (size_t)D * C_OUT * 2;
constexpr size_t WS_WPT = WS_WGT + 2 * (size_t)D * D * 2;
constexpr size_t WS_WR = WS_WPT + 2 * (size_t)D * PLE * 2;
constexpr size_t WS_ROPE1 = al256(WS_WR + 2 * (size_t)NE * D * 4);
constexpr size_t WS_ROPEA = WS_ROPE1 + (size_t)SEQ * 32 * 8;
constexpr size_t WS_WUPT = WS_ROPEA + (size_t)SEQ * 32 * 8;
constexpr size_t WS_WDNT = WS_WUPT + 2 * (size_t)NE * 2 * DE * D * 2;
constexpr size_t WS_PBF = WS_WDNT + 2 * (size_t)NE * D * DE * 2;
constexpr size_t WS_PP = WS_PBF + 2 * (size_t)T * PLE * 2;
constexpr size_t WS_X0 = WS_PP + 2 * (size_t)T * D * 2;
constexpr size_t WS_HM = WS_X0 + (size_t)T * D * 2;
constexpr size_t WS_H2 = WS_HM + (size_t)T * D * 2;
constexpr size_t WS_H3 = WS_H2 + (size_t)T * D * 2;
constexpr size_t WS_OCAT = WS_H3 + (size_t)T * D * 2;
constexpr size_t WS_SSP = WS_OCAT + (size_t)T * D * 2;
constexpr size_t WS_LSE = WS_SSP + 3 * (size_t)T * 16 * 4;
constexpr size_t WS_TOPE = WS_LSE + 3 * (size_t)T * 8 * 4;
constexpr size_t WS_TOPG = WS_TOPE + (size_t)T * 16;
constexpr size_t WS_TOPPOS = WS_TOPG + (size_t)T * 16;
constexpr size_t WS_RSTD = WS_TOPPOS + (size_t)T * 16;
constexpr size_t WS_TOKSLOT = WS_RSTD + (size_t)T * 4;
constexpr size_t WS_SLOTGATE = WS_TOKSLOT + (size_t)T * 16;
constexpr size_t WS_SLOTRS = WS_SLOTGATE + (size_t)NSLOT * 4;
constexpr size_t WS_XTAB = al256(WS_SLOTRS + (size_t)NSLOT * 4);
constexpr size_t WS_CNTTAB = al256(WS_XTAB + 8 * 136 * 4);
constexpr size_t WS_XG = al256(WS_CNTTAB + 256 * 32 * 4);
constexpr size_t WS_ACT = WS_XG + (size_t)NSLOT * D * 2;
constexpr size_t WS_Y = WS_ACT + (size_t)NSLOT * D * 2;
constexpr size_t WS_Q3 = WS_Y + (size_t)NSLOT * D * 2;
constexpr size_t WS_K3 = WS_Q3 + 3 * (size_t)T * 512 * 2;
constexpr size_t WS_V3 = WS_K3 + 3 * (size_t)T * 128 * 2;
constexpr size_t WS_OGB = WS_V3 + 3 * (size_t)T * 128 * 2;
constexpr size_t WS_H2F8 = WS_OGB + 3 * (size_t)T * 512 * 2;
constexpr size_t WS_HF8 = WS_H2F8 + (size_t)T * D;
constexpr size_t WS_END = WS_HF8 + 2 * (size_t)T * D;
constexpr int CW_TMO = 0;
constexpr int CW_CNT = 64;
constexpr int CW_BAR = 4096;

constexpr int LDSCTL_OFF = 0, MISC_OFF = 64;
constexpr int RING_OFF = 512, RING_BYTES = 131072;
constexpr int LDS_BYTES = 147456;

struct PPOrder {
    int G, c;
    __device__ __forceinline__ bool next(int i, pg8::Unit& u) const {
        int L; if (G == 256) { if (PROJ_FP8) { if (c < 128) { if (i >= 1) return false; L = c; } else { if (i >= 3) return false; L = 128 + (c - 128) * 3 + i; } }
                               else { if (c < 128 || i >= 4) return false; L = (c - 128) * 4 + i; } }
        else { L = i * G + c; if (L >= 512) return false; }
        u.pm = L >> 2; u.pn = 4 * (u.pm >> 6) + (L & 3); return true; }
    __device__ __forceinline__ void a_ready(const pg8::Unit&) const {}
    __device__ __forceinline__ void done(const pg8::Unit&) const {}
};
struct EpiPP {
    static constexpr bool PERM = true, AFTER_DRAIN = false;
    bf16* O;
    __device__ __forceinline__ void operator()(const pg8::f32x4 (&acc)[2][2][4][2], const pg8::Unit& u, int wr, int wc, int fr, int fq) const {
        const int row0 = u.pm * 256 + wr * 64 + fr, col0 = (u.pn & 3) * 256 + wc * 32 + 8 * fq;
#pragma unroll
        for (int ai = 0; ai < 2; ++ai)
#pragma unroll
            for (int m = 0; m < 4; ++m) { bf16* rp = O + (size_t)(row0 + ai * 128 + m * 16) * D + col0;
#pragma unroll
                for (int bj = 0; bj < 2; ++bj) { const pg8::f32x4 v0 = acc[ai][bj][m][0], v1 = acc[ai][bj][m][1];
                    pg8::u32x4 w; w.x = pk2(v0[0], v0[1]); w.y = pk2(v0[2], v0[3]); w.z = pk2(v1[0], v1[1]); w.w = pk2(v1[2], v1[3]);
                    *(pg8::u32x4*)(rp + bj * 128) = w; } }
    }
};
template <int LAYER> struct EpiQKV {
    static constexpr bool PERM = true, AFTER_DRAIN = false;
    const LAS float* RSL; const LAS int* PML;
    const float* qg; const float* kg; const float* rope1; const float* ropea; bf16* Q3; bf16* K3; bf16* V3;
    __device__ __forceinline__ void operator()(const pg8::f32x4 (&acc)[2][2][4][2], const pg8::Unit& u, int wr, int wc, int fr, int fq) const {
        int slot = 0;
#pragma unroll
        for (int i = 7; i >= 0; --i) if (PML[i] == u.pm) slot = i;
        const LAS float* rsl = RSL + slot * 256 + wr * 64 + fr;
        int kind, hd, grp;
        bool axial;
        if (LAYER == 0) { const int t3 = u.pn % 3; grp = u.pn / 3; axial = (grp == 0);
            if (t3 < 2) { kind = 0; hd = 4 * t3 + wc; } else if (wc < 2) { kind = 1; hd = wc; } else { kind = 2; hd = wc - 2; } }
        else { const int t3 = u.pn % 3; grp = u.pn / 3; axial = false;
            if (t3 < 2) { kind = 0; hd = 4 * t3 + wc; } else if (wc < 2) { kind = 1; hd = wc; } else { kind = 2; hd = wc - 2; } }
        const bool norm = axial && kind < 2, rope = kind < 2;
        f32x2_ GA[4], GB[4];
        if (norm) { const float* g = (kind == 0) ? qg : kg;
#pragma unroll
            for (int k = 0; k < 4; ++k) { const int j = 8 * fq + 2 * k; const int d0 = (j < 16) ? j : j + 16; GA[k] = (f32x2_){g[d0], g[d0 + 1]}; GB[k] = (f32x2_){g[d0 + 16], g[d0 + 17]}; } }
        else {
#pragma unroll
            for (int k = 0; k < 4; ++k) { GA[k] = (f32x2_){1.f, 1.f}; GB[k] = GA[k]; } }
        const float qs = (kind == 0) ? ATT_C2 : 1.f;
        const float* rtab = axial ? ropea : rope1;
        bf16* dst; int pitch;
        if (kind == 0) { dst = Q3 + (size_t)grp * T * 512 + hd * 64; pitch = 512; } else if (kind == 1) { dst = K3 + (size_t)grp * T * 128 + hd * 64; pitch = 128; } else { dst = V3 + (size_t)grp * T * 128 + hd * 64; pitch = 128; }
        const int row0 = u.pm * 256 + wr * 64 + fr;
#pragma unroll
        for (int ai = 0; ai < 2; ++ai)
#pragma unroll
          for (int mh = 0; mh < 2; ++mh) {
            f32x4 cs[2][4];
            if (rope) {
#pragma unroll
                for (int mm = 0; mm < 2; ++mm) { const int pos = (row0 + ai * 128 + (2 * mh + mm) * 16) & (SEQ - 1); const f32x4* cp = (const f32x4*)(rtab + ((size_t)pos * 32 + 8 * fq) * 2);
#pragma unroll
                    for (int k = 0; k < 4; ++k) cs[mm][k] = cp[k]; } }
#pragma unroll
            for (int mm = 0; mm < 2; ++mm) { const int m = 2 * mh + mm;
                const int r = row0 + ai * 128 + m * 16; const int pos = r & (SEQ - 1);
                const float rs = rsl[ai * 128 + m * 16];
                f32x2_ A[4], B[4];
#pragma unroll
                for (int n = 0; n < 2; ++n)
#pragma unroll
                    for (int p = 0; p < 2; ++p) { A[2 * n + p] = (f32x2_){acc[ai][0][m][n][2 * p], acc[ai][0][m][n][2 * p + 1]}; B[2 * n + p] = (f32x2_){acc[ai][1][m][n][2 * p], acc[ai][1][m][n][2 * p + 1]}; }
                float sc = rs * qs;
                if (norm) { f32x2_ q2 = A[0] * A[0];
#pragma unroll
                    for (int k = 1; k < 4; ++k) q2 = A[k] * A[k] + q2;
#pragma unroll
                    for (int k = 0; k < 4; ++k) q2 = B[k] * B[k] + q2;
                    float ss = q2.x + q2.y; ss += shx(ss, 16); ss += shx(ss, 32);
                    sc *= __builtin_amdgcn_rsqf(ss * (rs * rs) * (1.f / 64.f) + NORM_EPS);
#pragma unroll
                    for (int k = 0; k < 4; ++k) { A[k] = A[k] * GA[k]; B[k] = B[k] * GB[k]; } }
                if (rope) {
#pragma unroll
                    for (int k = 0; k < 4; ++k) { const f32x4 v = cs[mm][k]; const f32x2_ C = (f32x2_){v.x, v.y} * sc, S = (f32x2_){v.z, v.w} * sc;
                        const f32x2_ x1 = A[k], x2 = B[k]; A[k] = x1 * C - x2 * S; B[k] = x2 * C + x1 * S; } }
                else {
#pragma unroll
                    for (int k = 0; k < 4; ++k) { A[k] = A[k] * sc; B[k] = B[k] * sc; } }
                size_t drow = r;
                if (LAYER == 1) { const int sh = 2 * grp, bb = r >> 13; drow = (size_t)bb * SEQ + (size_t)(pos & ((1 << sh) - 1)) * (SEQ >> sh) + (pos >> sh); }
                bf16* dp = dst + drow * pitch + 8 * fq;
                pg8::u32x4 w0, w1;
                w0.x = pk2(A[0].x, A[0].y); w0.y = pk2(A[1].x, A[1].y); w0.z = pk2(A[2].x, A[2].y); w0.w = pk2(A[3].x, A[3].y);
                w1.x = pk2(B[0].x, B[0].y); w1.y = pk2(B[1].x, B[1].y); w1.z = pk2(B[2].x, B[2].y); w1.w = pk2(B[3].x, B[3].y);
                *(pg8::u32x4*)dp = w0; *(pg8::u32x4*)(dp + 32) = w1;
            }
            asm volatile("" ::: "memory");
        }
    }
};
struct EpiResBf16 {
    static constexpr bool PERM = true, AFTER_DRAIN = false;
    const bf16* R; bf16* O;
    __device__ __forceinline__ void operator()(const pg8::f32x4 (&acc)[2][2][4][2], const pg8::Unit& u, int wr, int wc, int fr, int fq) const {
        const int row0 = u.pm * 256 + wr * 64 + fr, col0 = u.pn * 256 + wc * 32 + 8 * fq;
#pragma unroll
        for (int ai = 0; ai < 2; ++ai) {
            v4u rr[4][2];
#pragma unroll
            for (int m = 0; m < 4; ++m)
#pragma unroll
                for (int bj = 0; bj < 2; ++bj) rr[m][bj] = *(const v4u*)(R + (size_t)(row0 + ai * 128 + m * 16) * D + col0 + bj * 128);
#pragma unroll
            for (int m = 0; m < 4; ++m) { const size_t ro = (size_t)(row0 + ai * 128 + m * 16) * D + col0;
#pragma unroll
                for (int bj = 0; bj < 2; ++bj) { const pg8::f32x4 v0 = acc[ai][bj][m][0], v1 = acc[ai][bj][m][1]; const v4u r4 = rr[m][bj];
                    pg8::u32x4 w; w.x = pk2(v0[0] + bflo(r4.x), v0[1] + bfhi(r4.x)); w.y = pk2(v0[2] + bflo(r4.y), v0[3] + bfhi(r4.y)); w.z = pk2(v1[0] + bflo(r4.z), v1[1] + bfhi(r4.z)); w.w = pk2(v1[2] + bflo(r4.w), v1[3] + bfhi(r4.w));
                    *(pg8::u32x4*)(O + ro + bj * 128) = w; } }
            asm volatile("" ::: "memory"); }
    }
};
__device__ __forceinline__ float sigmoidf_(float x) { return __builtin_amdgcn_rcpf(1.0f + __builtin_amdgcn_exp2f(-1.4426950408889634f * x)); }
__device__ __forceinline__ float swiglu1(float g, float l) {
    g = fminf(g, 7.0f); l = fminf(fmaxf(l, -7.0f), 7.0f);
    return g * sigmoidf_(1.702f * g) * (l + 1.0f);
}
__device__ __forceinline__ f32x2_ swiglu2(f32x2_ g, f32x2_ l) {
    g = __builtin_elementwise_min(g, (f32x2_){7.0f, 7.0f}); l = __builtin_elementwise_min(__builtin_elementwise_max(l, (f32x2_){-7.0f, -7.0f}), (f32x2_){7.0f, 7.0f});
    const f32x2_ t = g * (-1.702f * 1.4426950408889634f); f32x2_ e; e.x = __builtin_amdgcn_exp2f(t.x); e.y = __builtin_amdgcn_exp2f(t.y);
    const f32x2_ d = e + 1.0f; f32x2_ s; s.x = __builtin_amdgcn_rcpf(d.x); s.y = __builtin_amdgcn_rcpf(d.y);
    return (g * s) * (l + 1.0f);
}
template <bool F8> struct EpiSwiglu {
    static constexpr bool PERM = true, AFTER_DRAIN = false;
    void* ACT; const float* bup; const float* rsl;
    __device__ __forceinline__ void operator()(const pg8::f32x4 (&acc)[2][2][4][2], const pg8::Unit& u, int wr, int wc, int fr, int fq) const {
        const int e = u.pn >> 3, j = u.pn & 7; const int row0 = u.pm * 256 + wr * 64 + fr, a0 = j * 128 + wc * 32 + 8 * fq;
        const float* bp = bup + (size_t)e * 2048 + 2 * a0; pg8::f32x4 b[4];
#pragma unroll
        for (int i = 0; i < 4; ++i) b[i] = *(const pg8::f32x4*)(bp + 4 * i);
#pragma unroll
        for (int ai = 0; ai < 2; ++ai)
#pragma unroll
            for (int m = 0; m < 4; ++m) { const int r = row0 + ai * 128 + m * 16; const float rs = F8 ? F8_EPI_SC : rsl[r];
                const pg8::f32x4 g0 = acc[ai][0][m][0] * rs, g1 = acc[ai][0][m][1] * rs, l0 = acc[ai][1][m][0] * rs, l1 = acc[ai][1][m][1] * rs;
                float o[8];
                { const f32x2_ r0 = swiglu2((f32x2_){g0[0] + b[0][0], g0[1] + b[0][2]}, (f32x2_){l0[0] + b[0][1], l0[1] + b[0][3]}), r1 = swiglu2((f32x2_){g0[2] + b[1][0], g0[3] + b[1][2]}, (f32x2_){l0[2] + b[1][1], l0[3] + b[1][3]});
                  const f32x2_ r2 = swiglu2((f32x2_){g1[0] + b[2][0], g1[1] + b[2][2]}, (f32x2_){l1[0] + b[2][1], l1[1] + b[2][3]}), r3 = swiglu2((f32x2_){g1[2] + b[3][0], g1[3] + b[3][2]}, (f32x2_){l1[2] + b[3][1], l1[3] + b[3][3]});
                  o[0] = r0.x; o[1] = r0.y; o[2] = r1.x; o[3] = r1.y; o[4] = r2.x; o[5] = r2.y; o[6] = r3.x; o[7] = r3.y; }
                if (F8) { v2u w; w.x = pk4_fp8(o[0], o[1], o[2], o[3]); w.y = pk4_fp8(o[4], o[5], o[6], o[7]); *(v2u*)((unsigned char*)ACT + (size_t)r * DE + a0) = w; }
                else { pg8::u32x4 w; w.x = pk2(o[0], o[1]); w.y = pk2(o[2], o[3]); w.z = pk2(o[4], o[5]); w.w = pk2(o[6], o[7]); *(pg8::u32x4*)((bf16*)ACT + (size_t)r * DE + a0) = w; } }
    }
};
struct EpiNull {
    static constexpr bool PERM = true, AFTER_DRAIN = false;
    float* O;
    __device__ __forceinline__ void operator()(const pg8::f32x4 (&acc)[2][2][4][2], const pg8::Unit& u, int wr, int wc, int fr, int fq) const {
        pg8::f32x4 s = {0.f, 0.f, 0.f, 0.f};
#pragma unroll
        for (int ai = 0; ai < 2; ++ai)
#pragma unroll
            for (int bj = 0; bj < 2; ++bj)
#pragma unroll
                for (int m = 0; m < 4; ++m)
#pragma unroll
                    for (int n = 0; n < 2; ++n) s += acc[ai][bj][m][n];
        *(pg8::f32x4*)(O + (size_t)(threadIdx.x + 512 * (u.pm & 63)) * 4) = s;
    }
};
template <bool Y8> struct EpiDown {
    static constexpr bool PERM = true, AFTER_DRAIN = false;
    void* Y; const float* bdn; const float* gate; float asc;
    __device__ __forceinline__ void operator()(const pg8::f32x4 (&acc)[2][2][4][2], const pg8::Unit& u, int wr, int wc, int fr, int fq) const {
        const int e = u.pn >> 2, j = u.pn & 3; const int row0 = u.pm * 256 + wr * 64 + fr, col0 = j * 256 + wc * 32 + 8 * fq;
        pg8::f32x4 bv[2][2];
#pragma unroll
        for (int bj = 0; bj < 2; ++bj)
#pragma unroll
            for (int n = 0; n < 2; ++n) bv[bj][n] = *(const pg8::f32x4*)(bdn + (size_t)e * D + col0 + bj * 128 + 4 * n);
#pragma unroll
        for (int ai = 0; ai < 2; ++ai)
#pragma unroll
            for (int m = 0; m < 4; ++m) { const int r = row0 + ai * 128 + m * 16; const float gt = gate[r] * (Y8 ? Y_SC : 1.f);
#pragma unroll
                for (int bj = 0; bj < 2; ++bj) { const pg8::f32x4 v0 = (acc[ai][bj][m][0] * asc + bv[bj][0]) * gt, v1 = (acc[ai][bj][m][1] * asc + bv[bj][1]) * gt;
                    if (Y8) { v2u w; w.x = pk4_fp8(clamp448(v0[0]), clamp448(v0[1]), clamp448(v0[2]), clamp448(v0[3])); w.y = pk4_fp8(clamp448(v1[0]), clamp448(v1[1]), clamp448(v1[2]), clamp448(v1[3])); *(v2u*)((unsigned char*)Y + (size_t)r * D + col0 + bj * 128) = w; }
                    else { pg8::u32x4 w; w.x = pk2(v0[0], v0[1]); w.y = pk2(v0[2], v0[3]); w.z = pk2(v1[0], v1[1]); w.w = pk2(v1[2], v1[3]); *(pg8::u32x4*)((bf16*)Y + (size_t)r * D + col0 + bj * 128) = w; } } }
    }
};
struct EpiPle {
    static constexpr bool PERM = true, AFTER_DRAIN = false;
    const bf16* H2; const bf16* PP; bf16* H3; float* SS; unsigned char* H8;
    __device__ __forceinline__ void operator()(const pg8::f32x4 (&acc)[2][2][4][2], const pg8::Unit& u, int wr, int wc, int fr, int fq) const {
        const int row0 = u.pm * 256 + wr * 64 + fr, col0 = u.pn * 256 + wc * 32 + 8 * fq;
#pragma unroll
        for (int ai = 0; ai < 2; ++ai) {
            v4u hh[4][2], pp[4][2];
#pragma unroll
            for (int m = 0; m < 4; ++m)
#pragma unroll
                for (int bj = 0; bj < 2; ++bj) { const size_t o = (size_t)(row0 + ai * 128 + m * 16) * D + col0 + bj * 128; hh[m][bj] = *(const v4u*)(H2 + o); pp[m][bj] = *(const v4u*)(PP + o); }
#pragma unroll
            for (int m = 0; m < 4; ++m) { const int r = row0 + ai * 128 + m * 16; const size_t ro = (size_t)r * D + col0; float ss = 0.f;
#pragma unroll
                for (int bj = 0; bj < 2; ++bj) { const pg8::f32x4 a0 = acc[ai][bj][m][0], a1 = acc[ai][bj][m][1]; const v4u h = hh[m][bj], p = pp[m][bj];
                    pg8::u32x4 w;
                    w.x = pk2(bflo(h.x) + bflo(p.x) * sigmoidf_(a0[0]), bfhi(h.x) + bfhi(p.x) * sigmoidf_(a0[1])); w.y = pk2(bflo(h.y) + bflo(p.y) * sigmoidf_(a0[2]), bfhi(h.y) + bfhi(p.y) * sigmoidf_(a0[3]));
                    w.z = pk2(bflo(h.z) + bflo(p.z) * sigmoidf_(a1[0]), bfhi(h.z) + bfhi(p.z) * sigmoidf_(a1[1])); w.w = pk2(bflo(h.w) + bflo(p.w) * sigmoidf_(a1[2]), bfhi(h.w) + bfhi(p.w) * sigmoidf_(a1[3]));
                    *(pg8::u32x4*)(H3 + ro + bj * 128) = w;
                    if (H8) { v2u q; q.x = pk4_fp8(clamp448(bflo(w.x)), clamp448(bfhi(w.x)), clamp448(bflo(w.y)), clamp448(bfhi(w.y))); q.y = pk4_fp8(clamp448(bflo(w.z)), clamp448(bfhi(w.z)), clamp448(bflo(w.w)), clamp448(bfhi(w.w))); *(v2u*)(H8 + ro + bj * 128) = q; }
                    ss += (bflo(w.x) * bflo(w.x) + bfhi(w.x) * bfhi(w.x)) + (bflo(w.y) * bflo(w.y) + bfhi(w.y) * bfhi(w.y)) + (bflo(w.z) * bflo(w.z) + bfhi(w.z) * bfhi(w.z)) + (bflo(w.w) * bflo(w.w) + bfhi(w.w) * bfhi(w.w)); }
                ss += shx(ss, 16); ss += shx(ss, 32);
                if (fq == 0) SS[(size_t)r * 16 + u.pn * 4 + wc] = ss; }
            asm volatile("" ::: "memory"); }
    }
};
template <int LJ> struct XcdOrder {
    const int* tab; int rank, stride;
    __device__ __forceinline__ bool next(int i, pg8::Unit& u) const {
        const int q = i * stride + rank, p = q >> LJ, j = q & ((1 << LJ) - 1); const int ne = tab[0], tot = tab[1]; if (p >= tot) return false;
        int s = 0; while (s + 1 < ne && tab[4 + 4 * (s + 1) + 3] <= p) ++s;
        u.pm = tab[4 + 4 * s + 1] + (p - tab[4 + 4 * s + 3]); u.pn = (tab[4 + 4 * s] << LJ) + j; return true; }
    __device__ __forceinline__ void a_ready(const pg8::Unit&) const {}
    __device__ __forceinline__ void done(const pg8::Unit&) const {}
};
#include <hip/hip_bf16.h>
#include <cmath>
namespace attn_body {
using bf16=__hip_bfloat16;
using bf16x8=__attribute__((ext_vector_type(8)))short;
using s16x4=__attribute__((ext_vector_type(4)))short;
using f32x16=__attribute__((ext_vector_type(16)))float;
using u32x4=__attribute__((ext_vector_type(4)))unsigned;
constexpr int D=64,QP=512,KVP=128;
constexpr int NW=8,QBLK=32,QB=QBLK*NW,KVBLK=64;
constexpr int ATTN_UNIT_ROWS=QB;
__device__ __forceinline__ int crow(int r,int hi){return (r&3)+8*(r>>2)+4*hi;}
#define SBAR() __builtin_amdgcn_sched_barrier(0)
__device__ __forceinline__ void cmask(f32x16&p0,f32x16&p1,int jb,int qrel,int hi){
  const float NEG=-INFINITY; int kb=64*jb+4*hi;
  #pragma unroll
  for(int r=0;r<16;++r){int kv=kb+(r&3)+8*(r>>2); if(kv>qrel)p0[r]=NEG; if(kv+32>qrel)p1[r]=NEG;}
}

__device__ __forceinline__ void bmask(f32x16&p0,f32x16&p1,int t,int dqb,int W){
  const float NEG=-INFINITY; const int kb=64*t+dqb;
  #pragma unroll
  for(int r=0;r<16;++r){const int d=kb+(r&3)+8*(r>>2); if(d>W||d<-W)p0[r]=NEG; if(d+32>W||d+32<-W)p1[r]=NEG;}
}
constexpr int NSLOT=3, SLOTB=8192;
constexpr int LDS_K=0, LDS_V=NSLOT*SLOTB, LDS_WS=2*NSLOT*SLOTB, LDS_OST=LDS_WS+NW*64*4, LDS_BYTES=LDS_OST+NW*4096;
constexpr float C2=0.125f*1.4426950408889634f;
__device__ __forceinline__ void glds16(const void*gsrc,unsigned lds_dst){unsigned keep;
  asm volatile("s_mov_b32 %0, m0\n\ts_mov_b32 m0, %2\n\ts_nop 0\n\tglobal_load_lds_dwordx4 %1, off\n\ts_mov_b32 m0, %0":"=&s"(keep):"v"(gsrc),"s"(lds_dst):"memory");}
__device__ __forceinline__ float max3f(float a,float b,float c){float r;asm("v_max3_f32 %0, %1, %2, %3":"=v"(r):"v"(a),"v"(b),"v"(c));return r;}
__device__ __forceinline__ float max2f(float a,float b){float r;asm("v_max_f32_e32 %0, %1, %2":"=v"(r):"v"(a),"v"(b));return r;}
__device__ __forceinline__ float fadd_s(float a,float b){float r;asm("v_add_f32_e32 %0, %1, %2":"=v"(r):"v"(a),"v"(b));return r;}
__device__ __forceinline__ float fsub_s(float a,float b){float r;asm("v_sub_f32_e32 %0, %1, %2":"=v"(r):"v"(a),"v"(b));return r;}
typedef float f32x2_t __attribute__((ext_vector_type(2))); typedef __bf16 bf16x2_t __attribute__((ext_vector_type(2)));
__device__ __forceinline__ unsigned cvtpk_s(float lo,float hi){f32x2_t v={lo,hi};bf16x2_t b=__builtin_convertvector(v,bf16x2_t);return __builtin_bit_cast(unsigned,b);}
#define WAIT_BAR(N) asm volatile("s_waitcnt vmcnt(" #N ") lgkmcnt(0)\n\ts_barrier":::"memory")

__device__ __forceinline__ void qkt(f32x16&p0,f32x16&p1,const char*Kslot,const bf16x8*qr,const f32x16&negm,int r32,int hi){
  const char*kb=Kslot+hi*1024+r32*16;
  #pragma unroll
  for(int d0=0;d0<4;++d0){
    const bf16x8 b0=*reinterpret_cast<const bf16x8*>(kb+d0*2048);
    const bf16x8 b1=*reinterpret_cast<const bf16x8*>(kb+d0*2048+512);
    if(d0==0){p0=__builtin_amdgcn_mfma_f32_32x32x16_bf16(b0,qr[0],negm,0,0,0);p1=__builtin_amdgcn_mfma_f32_32x32x16_bf16(b1,qr[0],negm,0,0,0);}
    else{p0=__builtin_amdgcn_mfma_f32_32x32x16_bf16(b0,qr[d0],p0,0,0,0);p1=__builtin_amdgcn_mfma_f32_32x32x16_bf16(b1,qr[d0],p1,0,0,0);}}
}
typedef __attribute__((address_space(3))) const char* lds_cptr;
typedef short v4i16_t __attribute__((ext_vector_type(4)));
__device__ __forceinline__ void kload8(bf16x8*kf,lds_cptr kp){
  kf[0]=*(const __attribute__((address_space(3))) bf16x8*)(kp);      kf[1]=*(const __attribute__((address_space(3))) bf16x8*)(kp+512);
  kf[2]=*(const __attribute__((address_space(3))) bf16x8*)(kp+2048); kf[3]=*(const __attribute__((address_space(3))) bf16x8*)(kp+2560);
  kf[4]=*(const __attribute__((address_space(3))) bf16x8*)(kp+4096); kf[5]=*(const __attribute__((address_space(3))) bf16x8*)(kp+4608);
  kf[6]=*(const __attribute__((address_space(3))) bf16x8*)(kp+6144); kf[7]=*(const __attribute__((address_space(3))) bf16x8*)(kp+6656);
}
__device__ __forceinline__ void kload2(bf16x8*kf,lds_cptr kp,int j){ kf[2*j]=*(const __attribute__((address_space(3))) bf16x8*)(kp+j*2048); kf[2*j+1]=*(const __attribute__((address_space(3))) bf16x8*)(kp+j*2048+512); }
__device__ __forceinline__ s16x4 vtr(lds_cptr p){ return __builtin_bit_cast(s16x4,__builtin_amdgcn_ds_read_tr16_b64_v4i16((__attribute__((address_space(3))) v4i16_t*)p)); }
__device__ __forceinline__ float rowmax(const f32x16&p0,const f32x16&p1){
  float a=max3f(p0[0],p0[1],p1[0]),b=max3f(p0[2],p0[3],p1[1]);a=max3f(a,p1[2],p1[3]);
  #pragma unroll
  for(int r=4;r<16;r+=4){a=max3f(a,p0[r],p0[r+1]);b=max3f(b,p0[r+2],p0[r+3]);a=max3f(a,p1[r],p1[r+1]);b=max3f(b,p1[r+2],p1[r+3]);}
  const float m=max2f(a,b);
  auto rr=__builtin_amdgcn_permlane32_swap(__float_as_uint(m),__float_as_uint(m),false,false);
  return max2f(__uint_as_float(rr[0]),__uint_as_float(rr[1]));
}
__device__ __forceinline__ void pv(f32x16*o,int vb,bf16x8 pa0,bf16x8 pa1,bf16x8 pa2,bf16x8 pa3){
  #pragma unroll
  for(int d0=0;d0<2;++d0){s16x4 lo[4],hi[4];
    #pragma unroll
    for(int ks=0;ks<4;++ks){
      asm volatile("ds_read_b64_tr_b16 %0,%1 offset:%c2":"=&v"(lo[ks]):"v"(vb),"i"(d0*4096+ks*1024):"memory");
      asm volatile("ds_read_b64_tr_b16 %0,%1 offset:%c2":"=&v"(hi[ks]):"v"(vb),"i"(d0*4096+ks*1024+512):"memory");}
    asm volatile("s_waitcnt lgkmcnt(0)":::"memory");SBAR();
    #define PK(k) (bf16x8){lo[k][0],lo[k][1],lo[k][2],lo[k][3],hi[k][0],hi[k][1],hi[k][2],hi[k][3]}
    o[d0]=__builtin_amdgcn_mfma_f32_32x32x16_bf16(pa0,PK(0),o[d0],0,0,0);
    o[d0]=__builtin_amdgcn_mfma_f32_32x32x16_bf16(pa1,PK(1),o[d0],0,0,0);
    o[d0]=__builtin_amdgcn_mfma_f32_32x32x16_bf16(pa2,PK(2),o[d0],0,0,0);
    o[d0]=__builtin_amdgcn_mfma_f32_32x32x16_bf16(pa3,PK(3),o[d0],0,0,0);
    #undef PK
  }
}

#ifndef ATTN_STORE16
#define ATTN_STORE16(p,v) (*(u32x4*)(p)=(v))
#endif
template<int MODE,int OP,int THRL,int HPU=1> __device__ __forceinline__ void attn_unit(const bf16*Qu,const bf16*__restrict__ Ku,const bf16*__restrict__ Vu,bf16*Ou,int NT,int dq0,int W,float sinkl2,bool has_sink,float*lse,char*shm){
  int tid_=threadIdx.x; asm volatile("":"+v"(tid_));
  const int tid=tid_,lane=tid&63,r32=lane&31,hi=lane>>5; const int wid=__builtin_amdgcn_readfirstlane(tid>>6);
  const int wh=(HPU==1)?0:wid/(8/HPU), wrow=(HPU==1)?wid:wid%(8/HPU);
  const bf16*Qw=Qu+(long)(wrow*QBLK)*QP+wh*D;
  const unsigned lds0=(unsigned)(uintptr_t)shm;
  float*wsf=(float*)(shm+LDS_WS)+wid*64;
  const bf16*ksrc=Ku+(long)lane*KVP+wid*8;
  const bf16*vsrc=Vu+(long)(16*(wid&3)+(lane>>2))*KVP+(wid>>2)*32+(lane&3)*8;
  const unsigned kdst=lds0+LDS_K+wid*1024, vdst=lds0+LDS_V+wid*1024;
  #define DMA_K(t,slot) glds16(ksrc+(long)(t)*KVBLK*KVP,(unsigned)__builtin_amdgcn_readfirstlane(kdst+(slot)))
  #define DMA_V(t,slot) glds16(vsrc+(long)(t)*KVBLK*KVP,(unsigned)__builtin_amdgcn_readfirstlane(vdst+(slot)))
  const int vb0=(int)(lds0+LDS_V)+((lane>>4)&1)*32+(lane&3)*8+(4*hi+((lane&15)>>2))*64;
  const char*Kbase=shm+LDS_K; bf16x8 kf[8];
  const lds_cptr shm3=(lds_cptr)shm; const lds_cptr kp0=shm3+LDS_K+hi*1024+r32*16; const lds_cptr vp0=shm3+LDS_V+((lane>>4)&1)*32+(lane&3)*8+(4*hi+((lane&15)>>2))*64;
  DMA_K(0,0);DMA_V(0,0);DMA_K(1,SLOTB);
  bf16x8 qr[4];
  #pragma unroll
  for(int d0=0;d0<4;++d0)qr[d0]=*reinterpret_cast<const bf16x8*>(&Qw[(long)r32*QP+d0*16+hi*8]);
  float mhat=0.f,l_reg=0.f;f32x16 o[2];o[0]=f32x16{};o[1]=f32x16{};f32x16 negm=f32x16{};asm volatile("":"+v"(negm));
  const int dqb=dq0-(wrow*QBLK+r32)+4*hi;
  #define CMASK(P0,P1,t) do{ if(MODE==1) bmask(P0,P1,(t),dqb,W); }while(0)
  bool resc=false;
  #define START(P0,P1) do{ float rm=rowmax(P0,P1); if(MODE==1) rm=fmaxf(rm,-60.f); resc=false; \
    { const float dl=rm; mhat=fadd_s(mhat,dl); \
      _Pragma("unroll") for(int r=0;r<16;++r){P0[r]=fsub_s(P0[r],dl);P1[r]=fsub_s(P1[r],dl);} \
      _Pragma("unroll") for(int r=0;r<16;++r)negm[r]=-mhat; asm volatile("":"+v"(negm)); } \
    _Pragma("unroll") for(int r=0;r<16;++r)P0[r]=__builtin_amdgcn_exp2f(P0[r]); }while(0)
  #define RESC() do{ if(resc){ asm volatile("s_waitcnt lgkmcnt(0)":::"memory"); \
      _Pragma("unroll") for(int d_=0;d_<2;++d_) _Pragma("unroll") for(int r=0;r<16;++r)o[d_][r]*=wsf[crow(r,hi)]; } }while(0)
  f32x16 pA0,pA1,pB0,pB1;
  int sl_prev=0,sl_cur=0,sl_next=SLOTB;
  #define ROT() do{sl_prev=sl_cur;sl_cur=sl_next;sl_next=(sl_next==(NSLOT-1)*SLOTB)?0:sl_next+SLOTB;}while(0)
  DMA_K(2,2*SLOTB);
  WAIT_BAR(3);
  qkt(pA0,pA1,Kbase,qr,negm,r32,hi);asm volatile("s_nop 15\n\ts_nop 7":"+v"(pA0),"+v"(pA1));CMASK(pA0,pA1,0);
  START(pA0,pA1);
  _Pragma("unroll") for(int r=0;r<16;++r)pA1[r]=__builtin_amdgcn_exp2f(pA1[r]);
  WAIT_BAR(0);
  DMA_K(3,0);DMA_V(1,SLOTB);
  ROT();
  kload8(kf,kp0+sl_cur);
  WAIT_BAR(2);
  s16x4 vlo[8],vhi[8]; u32x4 pw0,pw1,pw2,pw3;
  #define PKW(P,B) cvtpk_s(P[B],P[B+1])
  #define PAF(k) __builtin_bit_cast(bf16x8,pw##k)
  #define VFR(i) (bf16x8){vlo[i][0],vlo[i][1],vlo[i][2],vlo[i][3],vhi[i][0],vhi[i][1],vhi[i][2],vhi[i][3]}
  #define PIN(x) asm volatile("":"+v"(x))
  #define MX3(a,b,c) __builtin_fmaxf(__builtin_fmaxf((a),(b)),(c))
  #define GAPA(MF,A0,A1,A2,A3,W0,W1,PW) do{ MF; sacc+=A0; sacc+=A1; sacc+=A2; sacc+=A3; PIN(sacc); W0; W1; PIN(PW); SBAR(); }while(0)
  #define EX(v) __builtin_amdgcn_exp2f(v)
  #define GAPB(MF,X,B) do{ MF; X[B]=EX(X[B]); X[B+1]=EX(X[B+1]); X[B+2]=EX(X[B+2]); X[B+3]=EX(X[B+3]); PIN(X); SBAR(); }while(0)
  #define VRD(i) do{ vlo[i]=vtr(vp_+(((i)>>2)*4096+((i)&3)*1024)); vhi[i]=vtr(vp_+(((i)>>2)*4096+((i)&3)*1024+512)); }while(0)
  #define KRD(G,j) do{ if(G){ kload2(kf,kp0+sl_next,j); SBAR(); } }while(0)
  #define STEP(C0,C1,P0,P1,t,GK,GV,GL) do{ SBAR(); \
    const lds_cptr vp_=vp0+sl_prev; \
    VRD(0); SBAR(); float sacc=(P0[0]+P0[1]); \
    GAPA(C0=__builtin_amdgcn_mfma_f32_32x32x16_bf16(kf[0],qr[0],negm,0,0,0), P0[2],P0[3],P0[4],P0[5],     pw0[0]=PKW(P0,0), pw0[1]=PKW(P0,2), pw0); \
    VRD(4); SBAR(); GAPA(C1=__builtin_amdgcn_mfma_f32_32x32x16_bf16(kf[1],qr[0],negm,0,0,0), P0[6],P0[7],P0[8],P0[9],     pw0[2]=PKW(P0,4), pw0[3]=PKW(P0,6), pw0); \
    VRD(1); SBAR(); GAPA(C0=__builtin_amdgcn_mfma_f32_32x32x16_bf16(kf[2],qr[1],C0,0,0,0),   P0[10],P0[11],P0[12],P0[13], pw1[0]=PKW(P0,8), pw1[1]=PKW(P0,10), pw1); \
    VRD(5); SBAR(); GAPA(C1=__builtin_amdgcn_mfma_f32_32x32x16_bf16(kf[3],qr[1],C1,0,0,0),   P0[14],P0[15],P1[0],P1[1],   pw1[2]=PKW(P0,12),pw1[3]=PKW(P0,14), pw1); \
    VRD(2); SBAR(); GAPA(C0=__builtin_amdgcn_mfma_f32_32x32x16_bf16(kf[4],qr[2],C0,0,0,0),   P1[2],P1[3],P1[4],P1[5],     pw2[0]=PKW(P1,0), pw2[1]=PKW(P1,2), pw2); \
    VRD(6); SBAR(); GAPA(C1=__builtin_amdgcn_mfma_f32_32x32x16_bf16(kf[5],qr[2],C1,0,0,0),   P1[6],P1[7],P1[8],P1[9],     pw2[2]=PKW(P1,4), pw2[3]=PKW(P1,6), pw2); \
    VRD(3); SBAR(); GAPA(C0=__builtin_amdgcn_mfma_f32_32x32x16_bf16(kf[6],qr[3],C0,0,0,0),   P1[10],P1[11],P1[12],P1[13], pw3[0]=PKW(P1,8), pw3[1]=PKW(P1,10), pw3); \
    VRD(7); SBAR(); GAPA(C1=__builtin_amdgcn_mfma_f32_32x32x16_bf16(kf[7],qr[3],C1,0,0,0),   P1[14],P1[15],0.f,0.f,       pw3[2]=PKW(P1,12),pw3[3]=PKW(P1,14), pw3); \
    l_reg+=sacc; \
    if(GK){DMA_K((t)+3,sl_cur);} if(GV){DMA_V((t)+1,sl_next);} \
    CMASK(C0,C1,t); \
    { float a=MX3(C0[0],C0[1],C1[0]),b=MX3(C0[2],C0[3],C1[1]); a=MX3(a,C1[2],C1[3]); \
      _Pragma("unroll") for(int r=4;r<16;r+=4){a=MX3(a,C0[r],C0[r+1]);b=MX3(b,C0[r+2],C0[r+3]);a=MX3(a,C1[r],C1[r+1]);b=MX3(b,C1[r+2],C1[r+3]);} \
      float rm=__builtin_fmaxf(a,b); { auto rr=__builtin_amdgcn_permlane32_swap(__float_as_uint(rm),__float_as_uint(rm),false,false); rm=__builtin_fmaxf(__uint_as_float(rr[0]),__uint_as_float(rr[1])); } \
      resc=false; \
      if(__builtin_expect(__any(rm>(float)THRL),0)){ const float dl=__builtin_fmaxf(rm,0.f); mhat+=dl; \
        _Pragma("unroll") for(int r=0;r<16;++r){C0[r]-=dl;C1[r]-=dl;} \
        _Pragma("unroll") for(int r=0;r<16;++r)negm[r]=-mhat; asm volatile("":"+v"(negm)); \
        const float f=__builtin_amdgcn_exp2f(-dl); l_reg*=f; if(hi==0)wsf[r32]=f; resc=true; } } \
    SBAR(); \
    GAPB(o[0]=__builtin_amdgcn_mfma_f32_32x32x16_bf16(PAF(0),VFR(0),o[0],0,0,0), C0,0); \
    GAPB(o[1]=__builtin_amdgcn_mfma_f32_32x32x16_bf16(PAF(0),VFR(4),o[1],0,0,0), C0,4); \
    KRD(GL,0); GAPB(o[0]=__builtin_amdgcn_mfma_f32_32x32x16_bf16(PAF(1),VFR(1),o[0],0,0,0), C0,8); \
    KRD(GL,1); GAPB(o[1]=__builtin_amdgcn_mfma_f32_32x32x16_bf16(PAF(1),VFR(5),o[1],0,0,0), C0,12); \
    KRD(GL,2); GAPB(o[0]=__builtin_amdgcn_mfma_f32_32x32x16_bf16(PAF(2),VFR(2),o[0],0,0,0), C1,0); \
    KRD(GL,3); GAPB(o[1]=__builtin_amdgcn_mfma_f32_32x32x16_bf16(PAF(2),VFR(6),o[1],0,0,0), C1,4); \
    GAPB(o[0]=__builtin_amdgcn_mfma_f32_32x32x16_bf16(PAF(3),VFR(3),o[0],0,0,0), C1,8); \
    GAPB(o[1]=__builtin_amdgcn_mfma_f32_32x32x16_bf16(PAF(3),VFR(7),o[1],0,0,0), C1,12); \
    }while(0)
  int t=1;
  for(;t+5<NT;t+=2){
    STEP(pB0,pB1,pA0,pA1,t,true,true,true);     WAIT_BAR(2); RESC(); ROT();
    STEP(pA0,pA1,pB0,pB1,t+1,true,true,true);   WAIT_BAR(2); RESC(); ROT();
  }
  #define ENDW(tt) do{ if((tt)+3<NT){WAIT_BAR(2);} else if((tt)+2<NT){WAIT_BAR(1);} else {WAIT_BAR(0);} }while(0)
  for(;t+1<NT;t+=2){
    STEP(pB0,pB1,pA0,pA1,t,(t+3<NT),(t+1<NT),(t+1<NT));       ENDW(t);   RESC(); ROT();
    STEP(pA0,pA1,pB0,pB1,t+1,(t+4<NT),(t+2<NT),(t+2<NT));     ENDW(t+1); RESC(); ROT();
  }
  STEP(pB0,pB1,pA0,pA1,NT-1,false,false,false); RESC();
  { float sacc=pB0[0]+pB0[1]; _Pragma("unroll") for(int r=2;r<16;++r)sacc+=pB0[r]; _Pragma("unroll") for(int r=0;r<16;++r)sacc+=pB1[r]; l_reg+=sacc;
    pw0=(u32x4){PKW(pB0,0),PKW(pB0,2),PKW(pB0,4),PKW(pB0,6)};pw1=(u32x4){PKW(pB0,8),PKW(pB0,10),PKW(pB0,12),PKW(pB0,14)};pw2=(u32x4){PKW(pB1,0),PKW(pB1,2),PKW(pB1,4),PKW(pB1,6)};pw3=(u32x4){PKW(pB1,8),PKW(pB1,10),PKW(pB1,12),PKW(pB1,14)};
    SBAR(); pv(o,vb0+sl_cur,PAF(0),PAF(1),PAF(2),PAF(3)); }
  #undef PKW
  #undef PAF
  #undef VFR
  #undef PIN
  #undef MX3
  #undef GAPA
  #undef GAPB
  #undef EX
  #undef VRD
  #undef KRD
  #undef STEP
  #undef ENDW
  {auto rr=__builtin_amdgcn_permlane32_swap(__float_as_uint(l_reg),__float_as_uint(l_reg),false,false);l_reg=__uint_as_float(rr[0])+__uint_as_float(rr[1]);}
  if(MODE==1){ if(has_sink) l_reg+=__builtin_amdgcn_exp2f(sinkl2-mhat); if(lse!=nullptr&&hi==0) lse[(long)(wrow*QBLK+r32)*8+wh]=0.6931471805599453f*(mhat+__builtin_amdgcn_logf(l_reg)); }
  if(hi==0)wsf[32+r32]=l_reg;asm volatile("s_waitcnt lgkmcnt(0)":::"memory");
  float rli[16];
  #pragma unroll
  for(int r=0;r<16;++r)rli[r]=__builtin_amdgcn_rcpf(wsf[32+crow(r,hi)]);
  bf16*Ow=Ou+(long)(wrow*QBLK)*OP+wh*D;
  { bf16*stg=(bf16*)(shm+LDS_OST)+wid*2048;
    #pragma unroll
    for(int r=0;r<16;++r){const int orow=crow(r,hi);
      #pragma unroll
      for(int d0=0;d0<2;++d0)stg[orow*64+d0*32+r32]=__float2bfloat16(o[d0][r]*rli[r]);}
    asm volatile("s_waitcnt lgkmcnt(0)":::"memory");
    #pragma unroll
    for(int i=0;i<4;++i){const int row=i*8+(lane>>3),ch=lane&7; const u32x4 v=*(const u32x4*)(stg+row*64+ch*8); ATTN_STORE16(Ow+(long)row*OP+ch*8,v);} }
  asm volatile("s_waitcnt lgkmcnt(0)\n\ts_barrier":::"memory");
  #undef DMA_K
  #undef DMA_V
  #undef CMASK
  #undef START
  #undef RESC
  #undef ROT
}
constexpr int ATTN_LDS_BYTES=LDS_BYTES;
#undef SBAR
#undef WAIT_BAR
}
#define XB_TMO      128
#define XB_XCNT(j)  (256  + 64 * (j))
#define XB_XSUB(j)  (1280 + 64 * (j))
#define XB_XGEN(j)  (2304 + 64 * (j))
#define XB_TOP      3328
#define XB_TOPGEN   3392
#define XCD_BAR_WORDS 3456
#define XB_SPIN_CAP (1u << 18)

__device__ __forceinline__ unsigned xb_ld(unsigned* p)              { return __hip_atomic_load(p, __ATOMIC_RELAXED, __HIP_MEMORY_SCOPE_AGENT); }
__device__ __forceinline__ unsigned xb_add(unsigned* p, unsigned v) { return __hip_atomic_fetch_add(p, v, __ATOMIC_RELAXED, __HIP_MEMORY_SCOPE_AGENT); }
__device__ __forceinline__ unsigned xb_xcc_id() { return (unsigned)__builtin_amdgcn_s_getreg((3 << 11) | 20) & 0xFu; }
#define XB_SPIN(cond, bar) do { unsigned _sp = 0; while (cond) { __builtin_amdgcn_s_sleep(1); \
    if ((++_sp & 255u) == 0u) { if (xb_ld(&(bar)[XB_TMO])) break; if (_sp > XB_SPIN_CAP) { atomicAdd(&(bar)[XB_TMO], 1u); break; } } } } while (0)

struct XcdBarrier {
    unsigned* bar; unsigned x;
    volatile LAS unsigned* st;
};

__device__ __forceinline__ XcdBarrier xcd_barrier_post(unsigned* bar, volatile LAS unsigned* st) {
    XcdBarrier b; b.bar = bar; b.x = xb_xcc_id(); b.st = st;
    if (threadIdx.x == 0) (void)xb_add(&bar[XB_XCNT(b.x)], 1u);
    return b;
}
__device__ __forceinline__ void xcd_barrier_complete(unsigned* bar, unsigned x, unsigned& nloc, unsigned& nx) {
    const unsigned G = gridDim.x * gridDim.y * gridDim.z;
    unsigned sum, cnt, mine, sp = 0u;
    for (;;) {
        sum = 0u; cnt = 0u; mine = 0u;
#pragma unroll
        for (unsigned j = 0; j < 16; ++j) { const unsigned c = xb_ld(&bar[XB_XCNT(j)]); sum += c; cnt += (c > 0u) ? 1u : 0u; mine = (j == x) ? c : mine; }
        if (sum == G) break;
        __builtin_amdgcn_s_sleep(1);
        if ((++sp & 255u) == 0u) { if (xb_ld(&bar[XB_TMO])) break; if (sp > XB_SPIN_CAP) { atomicAdd(&bar[XB_TMO], 1u); break; } }
    }
    nloc = mine > 0u ? mine : 1u; nx = cnt > 0u ? cnt : 1u;
}

__device__ __forceinline__ void xcd_barrier(const XcdBarrier& b) {
    asm volatile("s_waitcnt vmcnt(0)" ::: "memory");
    __syncthreads();
    if (threadIdx.x == 0) {
        unsigned* bar = b.bar;
        __builtin_amdgcn_s_waitcnt(0);
        unsigned nloc = b.st[0], nx = b.st[1];
        if (nloc == 0u) { xcd_barrier_complete(bar, b.x, nloc, nx); b.st[0] = nloc; b.st[1] = nx; }
        const unsigned old = xb_add(&bar[XB_XSUB(b.x)], 1u);
        const unsigned gen = old / nloc;
        if (old + 1u == (gen + 1u) * nloc) {
            __builtin_amdgcn_fence(__ATOMIC_RELEASE, "agent");
            asm volatile("s_waitcnt vmcnt(0)" ::: "memory");
            const unsigned og = xb_add(&bar[XB_TOP], 1u);
            const unsigned tg = og / nx;
            if (og + 1u == (tg + 1u) * nx) xb_add(&bar[XB_TOPGEN], 1u);
            else XB_SPIN(xb_ld(&bar[XB_TOPGEN]) == tg, bar);
            __builtin_amdgcn_fence(__ATOMIC_ACQUIRE, "agent");
            xb_add(&bar[XB_XGEN(b.x)], 1u);
            asm volatile("s_waitcnt vmcnt(0)" ::: "memory");
        } else {
            XB_SPIN(xb_ld(&bar[XB_XGEN(b.x)]) == gen, bar);
            __builtin_amdgcn_fence(__ATOMIC_ACQUIRE, "agent");
            asm volatile("s_waitcnt vmcnt(0)" ::: "memory");
        }
    }
    __syncthreads();
}

struct Frame {
    LAS unsigned char* lds;
    volatile LAS unsigned* MISC;
    gu32* ctl;
    int tid, lane, wave, vcu, G, bx;
    int gw, NGW;
};
__device__ __forceinline__ bool refresh(Frame& F) {
    int t = threadIdx.x; asm volatile("" : "+v"(t)); F.tid = t; F.lane = t & 63; F.wave = __builtin_amdgcn_readfirstlane(t >> 6);
    int bx = blockIdx.x, G = gridDim.x; asm volatile("" : "+s"(bx), "+s"(G)); F.bx = bx; F.G = G;
    F.vcu = (G % 8 == 0) ? (bx % 8) * (G / 8) + bx / 8 : bx; F.gw = F.vcu * NWAVES + F.wave; F.NGW = G * NWAVES; return true; }
__device__ __forceinline__ float wave_sum(float v) {
#pragma unroll
    for (int o = 1; o < 64; o <<= 1) v += shx(v, o);
    return v;
}
template <int MAP> __device__ __forceinline__ int rowmap(int n) {
    if (MAP == 1) { const int f = n >> 1; return 256 * (f >> 7) + 128 * (n & 1) + (f & 127); }
    if (MAP == 2 || MAP == 3) { const int tl = n >> 8, hh = (n >> 6) & 3, d = n & 63; int bj, j;
        const bool axial = (MAP == 2) && (tl < 2 || (tl == 2 && hh < 2));
        if (axial) { bj = (d >> 4) & 1; j = (d & 15) + ((d >> 5) << 4); } else { bj = d >> 5; j = d & 31; }
        return 256 * tl + 128 * bj + 32 * hh + j; }
    return n; }
struct TrTile { const float* W; bf16* WT; const float* gain; int K, N, k0, n0; };
__device__ __forceinline__ void tr_load(const TrTile& t, f32x4 (&v)[16], int lane) {
    const float* src = t.W + (size_t)(t.k0 + (lane >> 4)) * t.N + t.n0 + 4 * (lane & 15);
#pragma unroll
    for (int i = 0; i < 16; ++i) v[i] = __builtin_nontemporal_load((const f32x4*)(src + (size_t)(4 * i) * t.N));
}
template <int MAP> __device__ __forceinline__ void tr_store(const TrTile& t, f32x4 (&v)[16], LAS float* scr, int lane) {
    const int lr = lane >> 4, lc = lane & 15;
    if (t.gain) {
#pragma unroll
        for (int i = 0; i < 16; ++i) v[i] *= t.gain[t.k0 + 4 * i + lr]; }
#pragma unroll
    for (int i = 0; i < 16; ++i) { LAS float* p = scr + (4 * i + lr) * 65 + 4 * lc; p[0] = v[i].x; p[1] = v[i].y; p[2] = v[i].z; p[3] = v[i].w; }
    LDS_WAIT(); asm volatile("" ::: "memory");
    const int c = lane & 7;
#pragma unroll
    for (int j = 0; j < 8; ++j) { const int n = 8 * j + (lane >> 3); const LAS float* s = scr + (8 * c) * 65 + n;
        v4u o; o.x = pk2(s[0 * 65], s[1 * 65]); o.y = pk2(s[2 * 65], s[3 * 65]); o.z = pk2(s[4 * 65], s[5 * 65]); o.w = pk2(s[6 * 65], s[7 * 65]);
        *(GAS v4u*)(t.WT + (size_t)rowmap<MAP>(t.n0 + n) * t.K + t.k0 + 8 * c) = o; }
    LDS_WAIT(); asm volatile("" ::: "memory");
}
template <int MAP> __device__ __forceinline__ void transpose_family(Frame& F, const float* W, size_t sW, bf16* WT, size_t sWT, const float* gain, int sG, int K, int N, int nmat, int gdiv) {
    LAS float* scr = (LAS float*)(F.lds + RING_OFF) + F.wave * (128 * 33);
    const int nb = N / 64, per = (K / 64) * nb, total = per * nmat;
    f32x4 va[16], vb[16];
    int it = F.gw; if (it >= total) return;
    TrTile ta, tb;
#define TR_SETUP(tt, item) do { const int mi = (item) / per, r = (item) % per; tt.W = W + (size_t)mi * sW; tt.WT = WT + (size_t)mi * sWT; tt.gain = gain ? gain + (size_t)(mi / gdiv) * sG : nullptr; tt.K = K; tt.N = N; tt.k0 = 64 * (r / nb); tt.n0 = 64 * (r % nb); } while (0)
    TR_SETUP(ta, it); tr_load(ta, va, F.lane);
    for (;;) {
        const int it2 = it + F.NGW; const bool h2 = it2 < total;
        if (h2) { TR_SETUP(tb, it2); tr_load(tb, vb, F.lane); }
        tr_store<MAP>(ta, va, scr, F.lane);
        if (!h2) break;
        const int it3 = it2 + F.NGW; const bool h3 = it3 < total;
        if (h3) { TR_SETUP(ta, it3); tr_load(ta, va, F.lane); }
        tr_store<MAP>(tb, vb, scr, F.lane);
        if (!h3) break;
        it = it3;
    }
#undef TR_SETUP
}
__device__ __forceinline__ void tr8_load(const TrTile& t, f32x4 (&v)[16], int lane) {
    const float* src = t.W + (size_t)(t.k0 + (lane >> 3)) * t.N + t.n0 + 4 * (lane & 7);
#pragma unroll
    for (int i = 0; i < 16; ++i) v[i] = __builtin_nontemporal_load((const f32x4*)(src + (size_t)(8 * i) * t.N));
}
template <int MAP> __device__ __forceinline__ void tr8_store(const TrTile& t, f32x4 (&v)[16], LAS float* scr, int lane) {
    const int lr = lane >> 3, lc = lane & 7; const float sc = (float)(1 << F8_WSC);
#pragma unroll
    for (int i = 0; i < 16; ++i) { const float g = t.gain ? t.gain[t.k0 + 8 * i + lr] * sc : sc; LAS float* p = scr + (8 * i + lr) * 33 + 4 * lc; p[0] = v[i].x * g; p[1] = v[i].y * g; p[2] = v[i].z * g; p[3] = v[i].w * g; }
    LDS_WAIT(); asm volatile("" ::: "memory");
    const int c = lane & 7;
#pragma unroll
    for (int j = 0; j < 4; ++j) { const int n = 8 * j + (lane >> 3); const LAS float* s = scr + (16 * c) * 33 + n;
        v4u o; o.x = pk4_fp8(s[0 * 33], s[1 * 33], s[2 * 33], s[3 * 33]); o.y = pk4_fp8(s[4 * 33], s[5 * 33], s[6 * 33], s[7 * 33]); o.z = pk4_fp8(s[8 * 33], s[9 * 33], s[10 * 33], s[11 * 33]); o.w = pk4_fp8(s[12 * 33], s[13 * 33], s[14 * 33], s[15 * 33]);
        *(GAS v4u*)((unsigned char*)t.WT + (size_t)rowmap<MAP>(t.n0 + n) * t.K + t.k0 + 16 * c) = o; }
    LDS_WAIT(); asm volatile("" ::: "memory");
}
template <int MAP> __device__ __forceinline__ void transpose_family_f8(Frame& F, const float* W, size_t sW, unsigned char* WT, size_t sWT, const float* gain, int sG, int K, int N, int nmat, int gdiv) {
    LAS float* scr = (LAS float*)(F.lds + RING_OFF) + F.wave * (128 * 33);
    const int nb = N / 32, per = (K / 128) * nb, total = per * nmat;
    f32x4 va[16], vb[16];
    int it = F.gw; if (it >= total) return;
    TrTile ta, tb;
#define TR_SETUP(tt, item) do { const int mi = (item) / per, r = (item) % per; tt.W = W + (size_t)mi * sW; tt.WT = (bf16*)(WT + (size_t)mi * sWT); tt.gain = gain ? gain + (size_t)(mi / gdiv) * sG : nullptr; tt.K = K; tt.N = N; tt.k0 = 128 * (r / nb); tt.n0 = 32 * (r % nb); } while (0)
    TR_SETUP(ta, it); tr8_load(ta, va, F.lane);
    for (;;) {
        const int it2 = it + F.NGW; const bool h2 = it2 < total;
        if (h2) { TR_SETUP(tb, it2); tr8_load(tb, vb, F.lane); }
        tr8_store<MAP>(ta, va, scr, F.lane);
        if (!h2) break;
        const int it3 = it2 + F.NGW; const bool h3 = it3 < total;
        if (h3) { TR_SETUP(ta, it3); tr8_load(ta, va, F.lane); }
        tr8_store<MAP>(tb, vb, scr, F.lane);
        if (!h3) break;
        it = it3;
    }
#undef TR_SETUP
}
__device__ __forceinline__ float rope_freq(int i, int half_dim) { return exp2f(-(float)i / (float)half_dim * LOG2_THETA); }

__device__ __forceinline__ void attn_phase_l0(Frame& F, const bf16* Q3, const bf16* K3, const bf16* V3, bf16* OCAT, const float* sink) {
    char* shm = (char*)(F.lds + RING_OFF);
    const int upc = (512 + F.G - 1) / F.G;
    for (int i = 0; i < upc; ++i) { const int u = F.vcu * upc + i; if (u >= 512) break;
        const int bhk = u >> 7, b = bhk >> 1, hkv = bhk & 1, hq = hkv * 4 + ((u & 127) >> 5), qb = u & 31; const size_t r0 = (size_t)b * SEQ + qb * 256;
        attn_body::attn_unit<0, 1024, 8>((const attn_body::bf16*)(Q3 + r0 * 512 + hq * 64), (const attn_body::bf16*)(K3 + (size_t)b * SEQ * 128 + hkv * 64), (const attn_body::bf16*)(V3 + (size_t)b * SEQ * 128 + hkv * 64),
                                        (attn_body::bf16*)(OCAT + r0 * D + hq * 64), SEQ / 64, 0, 0, 0.f, false, nullptr, shm); }
    const bf16* Qb = Q3 + (size_t)T * 512; const bf16* Kb = K3 + (size_t)T * 128; const bf16* Vb = V3 + (size_t)T * 128;
    for (int i = 0; i < upc; ++i) { const int u = F.vcu * upc + i; if (u >= 512) break;
        const int bhk = u >> 7, b = bhk >> 1, hkv = bhk & 1, pr = (u & 127) >> 6, qb = u & 63, hq = hkv * 4 + pr * 2; const size_t r0 = (size_t)b * SEQ + qb * 128;
        const int tl = max(qb * 2 - 2, 0), th = min(qb * 2 + 4, SEQ / 64); const size_t k0 = (size_t)b * SEQ + tl * 64;
        attn_body::attn_unit<1, 1024, 8, 2>((const attn_body::bf16*)(Qb + r0 * 512 + hq * 64), (const attn_body::bf16*)(Kb + k0 * 128 + hkv * 64), (const attn_body::bf16*)(Vb + k0 * 128 + hkv * 64),
                                           (attn_body::bf16*)(OCAT + r0 * D + 512 + hq * 64), th - tl, tl * 64 - qb * 128, 128, sink[hq + (F.wave >> 2)] * 1.4426950408889634f, true, nullptr, shm); }
}
__device__ __forceinline__ void attn_phase_l1(Frame& F, const bf16* Q3, const bf16* K3, const bf16* V3, bf16* OGB, float* LSE) {
    char* shm = (char*)(F.lds + RING_OFF);
    const int upc = (512 + F.G - 1) / F.G;
#pragma unroll 1
    for (int g = 0; g < 3; ++g) { const int Lc = SEQ >> (2 * g);
        for (int i = 0; i < upc; ++i) { const int u = F.vcu * upc + i; if (u >= 512) break;
            const int bhk = u >> 7, b = bhk >> 1, hkv = bhk & 1, hq = hkv * 4, qb = u & 127; const size_t r0 = (size_t)b * SEQ + qb * 64;
            const int q0 = qb * 64, cbase = q0 & ~(Lc - 1), lq0 = q0 & (Lc - 1); const int tl = min(max(lq0 / 64 - 1, 0), Lc / 64 - 4); const size_t k0 = (size_t)b * SEQ + cbase + tl * 64;
            attn_body::attn_unit<1, 512, 8, 4>((const attn_body::bf16*)(Q3 + (size_t)g * T * 512 + r0 * 512 + hq * 64), (const attn_body::bf16*)(K3 + (size_t)g * T * 128 + k0 * 128 + hkv * 64), (const attn_body::bf16*)(V3 + (size_t)g * T * 128 + k0 * 128 + hkv * 64),
                                              (attn_body::bf16*)(OGB + (size_t)g * T * 512 + r0 * 512 + hq * 64), 4, cbase + tl * 64 - q0, 64, 0.f, false, LSE + (size_t)g * T * 8 + r0 * 8 + hq, shm); }
    }
}
__device__ __forceinline__ void merge_phase(Frame& F, const bf16* OGB, const float* LSE, bf16* OCAT1) {
    for (int m = F.gw; m < T; m += F.NGW) {
        const int h = F.lane >> 3; const int b = m / SEQ, pos = m % SEQ;
        const size_t r0 = m, r1 = (size_t)b * SEQ + (size_t)(pos & 3) * (SEQ / 4) + (pos >> 2), r2 = (size_t)b * SEQ + (size_t)(pos & 15) * (SEQ / 16) + (pos >> 4);
        const float l0 = LSE[r0 * 8 + h], l1 = LSE[(size_t)T * 8 + r1 * 8 + h], l2 = LSE[(size_t)2 * T * 8 + r2 * 8 + h];
        const float mx = fmaxf(l0, fmaxf(l1, l2)); float w0 = __expf(l0 - mx), w1 = __expf(l1 - mx), w2 = __expf(l2 - mx); const float is = 1.f / (w0 + w1 + w2); w0 *= is; w1 *= is; w2 *= is;
        const v4u a = *(const v4u*)(OGB + r0 * 512 + F.lane * 8), bb = *(const v4u*)(OGB + (size_t)T * 512 + r1 * 512 + F.lane * 8), c = *(const v4u*)(OGB + (size_t)2 * T * 512 + r2 * 512 + F.lane * 8);
        v4u w;
        w.x = pk2(w0 * bflo(a.x) + w1 * bflo(bb.x) + w2 * bflo(c.x), w0 * bfhi(a.x) + w1 * bfhi(bb.x) + w2 * bfhi(c.x));
        w.y = pk2(w0 * bflo(a.y) + w1 * bflo(bb.y) + w2 * bflo(c.y), w0 * bfhi(a.y) + w1 * bfhi(bb.y) + w2 * bfhi(c.y));
        w.z = pk2(w0 * bflo(a.z) + w1 * bflo(bb.z) + w2 * bflo(c.z), w0 * bfhi(a.z) + w1 * bfhi(bb.z) + w2 * bfhi(c.z));
        w.w = pk2(w0 * bflo(a.w) + w1 * bflo(bb.w) + w2 * bflo(c.w), w0 * bfhi(a.w) + w1 * bfhi(bb.w) + w2 * bfhi(c.w));
        *(v4u*)(OCAT1 + (size_t)m * C_OUT + F.lane * 8) = w;
    }
}

typedef float f32x4m __attribute__((ext_vector_type(4)));
__device__ __forceinline__ void top4_merge(float (&v)[4], int (&ix)[4], int mask) {
    float ov[4]; int oi[4];
#pragma unroll
    for (int k = 0; k < 4; ++k) { ov[k] = shx(v[k], mask); oi[k] = shx(ix[k], mask); }
    float cv[8]; int ci[8];
#pragma unroll
    for (int k = 0; k < 4; ++k) { cv[k] = v[k]; ci[k] = ix[k]; cv[4 + k] = ov[k]; ci[4 + k] = oi[k]; }
    unsigned used = 0u;
#pragma unroll
    for (int k = 0; k < 4; ++k) { float best = -INFINITY; int bi = 1 << 30, bp = 0;
#pragma unroll
        for (int c = 0; c < 8; ++c) { const bool take = !((used >> c) & 1u) && (cv[c] > best || (cv[c] == best && ci[c] < bi)); best = take ? cv[c] : best; bi = take ? ci[c] : bi; bp = take ? c : bp; }
        used |= 1u << bp; v[k] = best; ix[k] = bi; }
}
__device__ __forceinline__ void route_phase(Frame& F, const bf16* H, const float* WR, const float* rb, int* CNTTAB, int* TOPE, float* TOPG, int* TOPPOS, float* RSTD) {
    LAS float* WL = (LAS float*)(F.lds + RING_OFF);
    LAS unsigned* LC = (LAS unsigned*)(F.lds + RING_OFF + NE * 1028 * 4);
    if (F.tid < NE) LC[F.tid] = 0u;
    for (int i = F.tid; i < NE * D / 4; i += NWAVES * 64) { const int e = i >> 8, k4 = i & 255; *(LAS f32x4*)(WL + e * 1028 + 4 * k4) = *(const f32x4*)(WR + (size_t)e * D + 4 * k4); }
    __syncthreads();
    const int lane = F.lane, c = lane & 15, q = lane >> 4;
    for (int task = F.wave * F.G + F.vcu; task < T / 16; task += F.NGW) {
        const bf16* xr = H + (size_t)(task * 16 + c) * D + 8 * q;
        const LAS float* w0 = WL + c * 1028 + 8 * q; const LAS float* w1 = w0 + 16 * 1028;
        f32x4m a0 = {0.f, 0.f, 0.f, 0.f}, a1 = {0.f, 0.f, 0.f, 0.f}; float ssq = 0.f;
#pragma unroll 4
        for (int ch = 0; ch < 32; ++ch) {
            const v4u xv = *(const v4u*)(xr + 32 * ch);
            float xf[8]; xf[0] = bflo(xv.x); xf[1] = bfhi(xv.x); xf[2] = bflo(xv.y); xf[3] = bfhi(xv.y); xf[4] = bflo(xv.z); xf[5] = bfhi(xv.z); xf[6] = bflo(xv.w); xf[7] = bfhi(xv.w);
            const f32x4 wa0 = *(const LAS f32x4*)(w0 + 32 * ch), wa1 = *(const LAS f32x4*)(w0 + 32 * ch + 4), wb0 = *(const LAS f32x4*)(w1 + 32 * ch), wb1 = *(const LAS f32x4*)(w1 + 32 * ch + 4);
#pragma unroll
            for (int t = 0; t < 8; ++t) ssq += xf[t] * xf[t];
            a0 = __builtin_amdgcn_mfma_f32_16x16x4f32(wa0.x, xf[0], a0, 0, 0, 0); a1 = __builtin_amdgcn_mfma_f32_16x16x4f32(wb0.x, xf[0], a1, 0, 0, 0);
            a0 = __builtin_amdgcn_mfma_f32_16x16x4f32(wa0.y, xf[1], a0, 0, 0, 0); a1 = __builtin_amdgcn_mfma_f32_16x16x4f32(wb0.y, xf[1], a1, 0, 0, 0);
            a0 = __builtin_amdgcn_mfma_f32_16x16x4f32(wa0.z, xf[2], a0, 0, 0, 0); a1 = __builtin_amdgcn_mfma_f32_16x16x4f32(wb0.z, xf[2], a1, 0, 0, 0);
            a0 = __builtin_amdgcn_mfma_f32_16x16x4f32(wa0.w, xf[3], a0, 0, 0, 0); a1 = __builtin_amdgcn_mfma_f32_16x16x4f32(wb0.w, xf[3], a1, 0, 0, 0);
            a0 = __builtin_amdgcn_mfma_f32_16x16x4f32(wa1.x, xf[4], a0, 0, 0, 0); a1 = __builtin_amdgcn_mfma_f32_16x16x4f32(wb1.x, xf[4], a1, 0, 0, 0);
            a0 = __builtin_amdgcn_mfma_f32_16x16x4f32(wa1.y, xf[5], a0, 0, 0, 0); a1 = __builtin_amdgcn_mfma_f32_16x16x4f32(wb1.y, xf[5], a1, 0, 0, 0);
            a0 = __builtin_amdgcn_mfma_f32_16x16x4f32(wa1.z, xf[6], a0, 0, 0, 0); a1 = __builtin_amdgcn_mfma_f32_16x16x4f32(wb1.z, xf[6], a1, 0, 0, 0);
            a0 = __builtin_amdgcn_mfma_f32_16x16x4f32(wa1.w, xf[7], a0, 0, 0, 0); a1 = __builtin_amdgcn_mfma_f32_16x16x4f32(wb1.w, xf[7], a1, 0, 0, 0);
        }
        ssq += shx(ssq, 16); ssq += shx(ssq, 32);
        const float rstd = 1.f / sqrtf(ssq * (1.f / D) + NORM_EPS);
        float cv[8]; int ci[8];
#pragma unroll
        for (int r = 0; r < 4; ++r) { ci[r] = 4 * q + r; ci[4 + r] = 16 + 4 * q + r; cv[r] = a0[r] * rstd + rb[4 * q + r]; cv[4 + r] = a1[r] * rstd + rb[16 + 4 * q + r]; }
        float tv[4]; int ti[4]; unsigned used = 0u;
#pragma unroll
        for (int k = 0; k < 4; ++k) { float best = -INFINITY; int bi = 0, bp = 0;
#pragma unroll
            for (int j = 0; j < 8; ++j) { const bool take = !((used >> j) & 1u) && (cv[j] > best); best = take ? cv[j] : best; bi = take ? ci[j] : bi; bp = take ? j : bp; }
            used |= 1u << bp; tv[k] = best; ti[k] = bi; }
        top4_merge(tv, ti, 16); top4_merge(tv, ti, 32);
        const float e1 = __expf(tv[1] - tv[0]), e2 = __expf(tv[2] - tv[0]), e3 = __expf(tv[3] - tv[0]); const float is = 1.f / (1.f + e1 + e2 + e3);
        const int m = task * 16 + c;
        { const int e = q == 0 ? ti[0] : q == 1 ? ti[1] : q == 2 ? ti[2] : ti[3]; const float g = (q == 0 ? 1.f : q == 1 ? e1 : q == 2 ? e2 : e3) * is;
            const unsigned pos = __hip_atomic_fetch_add(LC + e, 1u, __ATOMIC_RELAXED, __HIP_MEMORY_SCOPE_WORKGROUP);
            TOPE[m * 4 + q] = e; TOPG[m * 4 + q] = g; TOPPOS[m * 4 + q] = (int)pos; }
        if (q == 0) RSTD[m] = rstd;
    }
    __syncthreads();
    if (F.tid < NE) CNTTAB[F.vcu * NE + F.tid] = (int)LC[F.tid];
    __syncthreads();
}
__device__ __forceinline__ void slot_phase(Frame& F, const bf16* H, const int* CNTTAB, const int* TOPE, const float* TOPG, const int* TOPPOS, const float* RSTD, int* TOKSLOT, float* SLOTGATE, float* SLOTRS, bf16* XG, int* XTAB, bool f8) {
    LAS int* L = (LAS int*)(F.lds + RING_OFF);
    LAS int* P = L + 256;
    const int lane = F.lane;
    {
#pragma unroll 1
        for (int ee = 0; ee < 4; ++ee) { const int e = F.wave * 4 + ee;
            int s0 = 0, s1 = 0, s2 = 0, s3 = 0; const int g0 = 4 * lane;
            if (g0 < F.G) s0 = CNTTAB[g0 * NE + e]; if (g0 + 1 < F.G) s1 = CNTTAB[(g0 + 1) * NE + e]; if (g0 + 2 < F.G) s2 = CNTTAB[(g0 + 2) * NE + e]; if (g0 + 3 < F.G) s3 = CNTTAB[(g0 + 3) * NE + e];
            const int t = s0 + s1 + s2 + s3; int inc = t;
#pragma unroll
            for (int o = 1; o < 64; o <<= 1) { const int u = shup(inc, o); if (lane >= o) inc += u; }
            const int base = inc - t;
            P[g0 * NE + e] = base; P[(g0 + 1) * NE + e] = base + s0; P[(g0 + 2) * NE + e] = base + s0 + s1; P[(g0 + 3) * NE + e] = base + s0 + s1 + s2;
            if (lane == 63) L[64 + e] = inc; }
    }
    __syncthreads();
    if (F.wave == 0) {
        const int np = (lane < 32) ? ((L[64 + (lane & 31)] + 255) >> 8) : 0;
        int pre = np;
#pragma unroll
        for (int o = 1; o < 32; o <<= 1) { const int t = shup(pre, o); if (lane >= o) pre += t; }
        const int p0 = pre - np;
        if (lane < 32) { L[lane] = np; L[32 + lane] = p0 * 256; }
        if (F.bx == 0) {
            LDS_WAIT(); asm volatile("" ::: "memory");
            int rank = 0;
#pragma unroll 8
            for (int e2 = 0; e2 < 32; ++e2) { const int v = L[e2]; rank += (v > np || (v == np && e2 < lane)) ? 1 : 0; }
            LAS int* XE = L + 96;
            if (lane < 32) { const int r16 = rank & 15, x = r16 < 8 ? r16 : 15 - r16, pos = (rank >> 4) * 2 + (r16 >= 8 ? 1 : 0); XE[(x * 4 + pos) * 3] = lane; XE[(x * 4 + pos) * 3 + 1] = p0; XE[(x * 4 + pos) * 3 + 2] = np; }
            LDS_WAIT(); asm volatile("" ::: "memory");
            const int lx = lane_opaque();
            if (lx < 8) { int cump = 0; int* tb = XTAB + lx * 136;
#pragma unroll
                for (int s = 0; s < 4; ++s) { const int e = XE[(lx * 4 + s) * 3], q0 = XE[(lx * 4 + s) * 3 + 1], n = XE[(lx * 4 + s) * 3 + 2]; tb[4 + 4 * s] = e; tb[4 + 4 * s + 1] = q0; tb[4 + 4 * s + 2] = n; tb[4 + 4 * s + 3] = cump; cump += n; }
                int four = 4; asm volatile("" : "+v"(four));
                tb[0] = four; tb[1] = cump; }
        }
    }
    __syncthreads();
    if (f8) {
        for (int m0 = F.gw; m0 < T; m0 += 4 * F.NGW) {
            int e[4], ps[4]; float gt[4], rs[4]; v4u ra[4], rb[4];
#pragma unroll
            for (int j = 0; j < 4; ++j) { const int m = m0 + j * F.NGW; const bool ok = m < T; const int mm = ok ? m : 0;
                e[j] = 0; ps[j] = 0; gt[j] = 0.f;
                if (lane < 4) { e[j] = TOPE[mm * 4 + lane]; ps[j] = TOPPOS[mm * 4 + lane]; gt[j] = TOPG[mm * 4 + lane]; }
                rs[j] = RSTD[mm]; const bf16* src = H + (size_t)mm * D + lane * 16; ra[j] = *(const v4u*)src; rb[j] = *(const v4u*)(src + 8); }
#pragma unroll
            for (int j = 0; j < 4; ++j) { const int m = m0 + j * F.NGW; if (m >= T) break;
                int slot = 0;
                if (lane < 4) { const int wg = (m >> 4) % F.G; slot = L[32 + e[j]] + P[wg * NE + e[j]] + ps[j]; TOKSLOT[m * 4 + lane] = slot; SLOTGATE[slot] = gt[j]; SLOTRS[slot] = rs[j]; }
                const int s0 = shl(slot, 0), s1 = shl(slot, 1), s2 = shl(slot, 2), s3 = shl(slot, 3);
                const v4u a = ra[j], b = rb[j]; const float r = rs[j];
                v4u w; w.x = pk4_fp8(clamp448(bflo(a.x) * r), clamp448(bfhi(a.x) * r), clamp448(bflo(a.y) * r), clamp448(bfhi(a.y) * r)); w.y = pk4_fp8(clamp448(bflo(a.z) * r), clamp448(bfhi(a.z) * r), clamp448(bflo(a.w) * r), clamp448(bfhi(a.w) * r));
                w.z = pk4_fp8(clamp448(bflo(b.x) * r), clamp448(bfhi(b.x) * r), clamp448(bflo(b.y) * r), clamp448(bfhi(b.y) * r)); w.w = pk4_fp8(clamp448(bflo(b.z) * r), clamp448(bfhi(b.z) * r), clamp448(bflo(b.w) * r), clamp448(bfhi(b.w) * r));
                unsigned char* X8 = (unsigned char*)XG; const size_t co = (size_t)lane * 16;
                *(v4u*)(X8 + (size_t)s0 * D + co) = w; *(v4u*)(X8 + (size_t)s1 * D + co) = w; *(v4u*)(X8 + (size_t)s2 * D + co) = w; *(v4u*)(X8 + (size_t)s3 * D + co) = w; }
        }
    } else {
    for (int m = F.gw; m < T; m += F.NGW) {
        int slot = 0;
        if (lane < 4) { const int e = TOPE[m * 4 + lane]; const int wg = (m >> 4) % F.G; slot = L[32 + e] + P[wg * NE + e] + TOPPOS[m * 4 + lane]; TOKSLOT[m * 4 + lane] = slot; SLOTGATE[slot] = TOPG[m * 4 + lane]; SLOTRS[slot] = RSTD[m]; }
        const int s0 = shl(slot, 0), s1 = shl(slot, 1), s2 = shl(slot, 2), s3 = shl(slot, 3);
        const bf16* src = H + (size_t)m * D + lane * 8; const v4u a = *(const v4u*)src, b = *(const v4u*)(src + 512);
        const size_t co = (size_t)lane * 8;
        *(v4u*)(XG + (size_t)s0 * D + co) = a; *(v4u*)(XG + (size_t)s0 * D + co + 512) = b;
        *(v4u*)(XG + (size_t)s1 * D + co) = a; *(v4u*)(XG + (size_t)s1 * D + co + 512) = b;
        *(v4u*)(XG + (size_t)s2 * D + co) = a; *(v4u*)(XG + (size_t)s2 * D + co + 512) = b;
        *(v4u*)(XG + (size_t)s3 * D + co) = a; *(v4u*)(XG + (size_t)s3 * D + co + 512) = b;
    }
    }
    __syncthreads();
}
__device__ __forceinline__ void y_add16(float (&a)[16], const void* Yp, size_t row, int lane) {
    if (Y_FP8) { const v4u y = *(const v4u*)((const unsigned char*)Yp + row * D + lane * 16); const float is = 1.f / Y_SC;
        const unsigned w[4] = {y.x, y.y, y.z, y.w};
#pragma unroll
        for (int i = 0; i < 4; ++i) { const f32x2_ lo = __builtin_amdgcn_cvt_pk_f32_fp8((int)w[i], false), hi = __builtin_amdgcn_cvt_pk_f32_fp8((int)w[i], true); a[4 * i] += lo.x * is; a[4 * i + 1] += lo.y * is; a[4 * i + 2] += hi.x * is; a[4 * i + 3] += hi.y * is; } }
    else { const bf16* yp = (const bf16*)Yp + row * D + lane * 16; const v4u y0 = *(const v4u*)yp, y1 = *(const v4u*)(yp + 8);
        a[0] += bflo(y0.x); a[1] += bfhi(y0.x); a[2] += bflo(y0.y); a[3] += bfhi(y0.y); a[4] += bflo(y0.z); a[5] += bfhi(y0.z); a[6] += bflo(y0.w); a[7] += bfhi(y0.w);
        a[8] += bflo(y1.x); a[9] += bfhi(y1.x); a[10] += bflo(y1.y); a[11] += bfhi(y1.y); a[12] += bflo(y1.z); a[13] += bfhi(y1.z); a[14] += bflo(y1.w); a[15] += bfhi(y1.w); }
}
__device__ __forceinline__ void combine_phase(Frame& F, const bf16* HM, const void* Y, const int* TOKSLOT, bf16* H2, unsigned char* H2F8) {
    const int lane = F.lane;
    for (int m = F.gw; m < T; m += F.NGW) {
        const int s0 = TOKSLOT[m * 4], s1 = TOKSLOT[m * 4 + 1], s2 = TOKSLOT[m * 4 + 2], s3 = TOKSLOT[m * 4 + 3];
        float a[16];
#pragma unroll
        for (int i = 0; i < 16; ++i) a[i] = 0.f;
        y_add16(a, Y, (size_t)s0, lane); y_add16(a, Y, (size_t)s1, lane); y_add16(a, Y, (size_t)s2, lane); y_add16(a, Y, (size_t)s3, lane);
        const bf16* hp = HM + (size_t)m * D + lane * 16; const v4u h0 = *(const v4u*)hp, h1 = *(const v4u*)(hp + 8);
        a[0] += bflo(h0.x); a[1] += bfhi(h0.x); a[2] += bflo(h0.y); a[3] += bfhi(h0.y); a[4] += bflo(h0.z); a[5] += bfhi(h0.z); a[6] += bflo(h0.w); a[7] += bfhi(h0.w);
        a[8] += bflo(h1.x); a[9] += bfhi(h1.x); a[10] += bflo(h1.y); a[11] += bfhi(h1.y); a[12] += bflo(h1.z); a[13] += bfhi(h1.z); a[14] += bflo(h1.w); a[15] += bfhi(h1.w);
        v4u w0, w1; w0.x = pk2(a[0], a[1]); w0.y = pk2(a[2], a[3]); w0.z = pk2(a[4], a[5]); w0.w = pk2(a[6], a[7]); w1.x = pk2(a[8], a[9]); w1.y = pk2(a[10], a[11]); w1.z = pk2(a[12], a[13]); w1.w = pk2(a[14], a[15]);
        bf16* op = H2 + (size_t)m * D + lane * 16; *(v4u*)op = w0; *(v4u*)(op + 8) = w1;
        if (PLE_FP8) { v4u q; q.x = pk4_fp8(clamp448(a[0]), clamp448(a[1]), clamp448(a[2]), clamp448(a[3])); q.y = pk4_fp8(clamp448(a[4]), clamp448(a[5]), clamp448(a[6]), clamp448(a[7]));
            q.z = pk4_fp8(clamp448(a[8]), clamp448(a[9]), clamp448(a[10]), clamp448(a[11])); q.w = pk4_fp8(clamp448(a[12]), clamp448(a[13]), clamp448(a[14]), clamp448(a[15])); *(v4u*)(H2F8 + (size_t)m * D + lane * 16) = q; }
    }
}
__device__ __forceinline__ void final_norm_phase(Frame& F, const bf16* H, const float* SS, const float* gain, float* out) {
    const int lane = F.lane;
    for (int m = F.gw; m < T; m += F.NGW) {
        const float rstd = 1.f / sqrtf(ssp_sum(SS + (size_t)m * 16) * (1.f / D) + NORM_EPS);
#pragma unroll
        for (int j = 0; j < 2; ++j) { const size_t co = (size_t)j * 512 + lane * 8; const v4u h = *(const v4u*)(H + (size_t)m * D + co); const f32x4 g0 = *(const f32x4*)(gain + co), g1 = *(const f32x4*)(gain + co + 4);
            f32x4 o0, o1; o0.x = bflo(h.x) * rstd * g0.x; o0.y = bfhi(h.x) * rstd * g0.y; o0.z = bflo(h.y) * rstd * g0.z; o0.w = bfhi(h.y) * rstd * g0.w;
            o1.x = bflo(h.z) * rstd * g1.x; o1.y = bfhi(h.z) * rstd * g1.y; o1.z = bflo(h.w) * rstd * g1.z; o1.w = bfhi(h.w) * rstd * g1.w;
            float* dst = out + (size_t)m * D + co; *(f32x4*)dst = o0; *(f32x4*)(dst + 4) = o1; }
    }
}

constexpr int N_PHASES = 22;
struct Args { const float* in[20]; float* out; unsigned char* ws; int ph_lo, ph_hi, li, pad; };
typedef const __attribute__((address_space(4))) Args* argp_t;
__device__ __forceinline__ argp_t opaque_args() { argp_t p = (argp_t)__builtin_amdgcn_kernarg_segment_ptr(); asm volatile("" : "+s"(p)); return p; }
#define AP (opaque_args())
__global__ void __launch_bounds__(NWAVES * 64, 2) fwd_kernel(Args args_unused) {
    extern __shared__ __attribute__((aligned(16))) unsigned char lds[];
    Frame F;
    F.lds = (LAS unsigned char*)lds;
    F.MISC = (volatile LAS unsigned*)(F.lds + MISC_OFF);
    refresh(F);
    F.ctl = (gu32*)(AP->ws + WS_CTL);
    if (F.tid < 128) ((LAS unsigned*)(F.lds + LDSCTL_OFF))[F.tid] = 0u;
    __syncthreads();
    const bool one_phase = (AP->ph_hi - AP->ph_lo) == 1;
    XcdBarrier bar; bar.bar = (unsigned*)(F.ctl + CW_BAR); bar.x = 0; bar.st = nullptr;
    if (!one_phase) bar = xcd_barrier_post((unsigned*)(F.ctl + CW_BAR), F.MISC + 8);
    const int lo = AP->ph_lo, hi = AP->ph_hi;
#ifndef MK_MASK
#define MK_MASK 0x3fff
#endif
#ifndef PROBE_MASK
#define PROBE_MASK 0
#endif
#define IN(k) (lo <= (k) && (k) < hi)
#define INL(j) (((MK_MASK >> (j)) & 1) && IN(pb + (j)) && refresh(F))
#define REP(j) _Pragma("unroll") for (int rep_ = 0; rep_ < (((PROBE_MASK >> (j)) & 1) ? 2 : 1); ++rep_)
#define SEAM(k) do { if (IN((k) + 1)) xcd_barrier(bar); } while (0)
#define ws (AP->ws)
#define WSP(type, off) ((type*)(ws + (off)))
#define EXPERT_CONVERSIONS(FR, ll, e0, e1) do { if ((e1) > (e0)) { \
            const float* wu = AP->in[13] + ((size_t)(ll) * NE + (e0)) * D * 2 * DE; const float* wd = AP->in[15] + ((size_t)(ll) * NE + (e0)) * DE * D; const float* gf = AP->in[10] + (ll) * D; \
            const size_t eb_ = ((MOE_FP8_MASK >> (ll)) & 1) ? 1 : 2;        \
            unsigned char* du = ws + WS_WUPT + (size_t)(ll) * NE * 2 * DE * D * 2 + (size_t)(e0) * 2 * DE * D * eb_; unsigned char* dd = ws + WS_WDNT + (size_t)(ll) * NE * D * DE * 2 + (size_t)(e0) * D * DE * eb_; \
            if ((MOE_FP8_MASK >> (ll)) & 1) { \
                transpose_family_f8<1>(FR, wu, (size_t)D * 2 * DE, du, (size_t)2 * DE * D, gf, 0, D, 2 * DE, (e1) - (e0), 1); \
                transpose_family_f8<0>(FR, wd, (size_t)DE * D, dd, (size_t)D * DE, nullptr, 0, DE, D, (e1) - (e0), 1); } \
            else { \
                transpose_family<1>(FR, wu, (size_t)D * 2 * DE, (bf16*)du, (size_t)2 * DE * D, gf, 0, D, 2 * DE, (e1) - (e0), 1); \
                transpose_family<0>(FR, wd, (size_t)DE * D, (bf16*)dd, (size_t)D * DE, nullptr, 0, DE, D, (e1) - (e0), 1); } } } while (0)
#define BIG_CONVERSIONS(FR) do { \
        EXPERT_CONVERSIONS(FR, 0, 0, NE); EXPERT_CONVERSIONS(FR, 1, 0, NE - NE_LATE); \
        if (PROJ_FP8) transpose_family_f8<3>(FR, AP->in[8], 0, ws + WS_WIN1T, 0, AP->in[2] + D, 0, D, C_IN, 1, 1); \
        else transpose_family<3>(FR, AP->in[8], 0, WSP(bf16, WS_WIN1T), 0, AP->in[2] + D, 0, D, C_IN, 1, 1); \
        transpose_family<0>(FR, AP->in[7], 0, WSP(bf16, WS_WOUT0T), 0, nullptr, 0, D, D, 1, 1); \
        transpose_family<0>(FR, AP->in[9], 0, WSP(bf16, WS_WOUT1T), 0, nullptr, 0, C_OUT, D, 1, 1); \
        if (PLE_FP8) transpose_family_f8<0>(FR, AP->in[18], (size_t)D * D, ws + WS_WGT, (size_t)D * D * 2, nullptr, 0, D, D, 2, 1); \
        else transpose_family<0>(FR, AP->in[18], (size_t)D * D, WSP(bf16, WS_WGT), (size_t)D * D, nullptr, 0, D, D, 2, 1); \
    } while (0)
    if (((MK_MASK >> 12) & 1) && IN(0) && refresh(F)) REP(12) {
        if (PROJ_FP8) transpose_family_f8<2>(F, AP->in[3], 0, ws + WS_WIN0T, 0, AP->in[2], 0, D, AB_IN, 1, 1);
        else transpose_family<2>(F, AP->in[3], 0, WSP(bf16, WS_WIN0T), 0, AP->in[2], 0, D, AB_IN, 1, 1);
        transpose_family<0>(F, AP->in[17], (size_t)PLE * D, WSP(bf16, WS_WPT), (size_t)D * PLE, nullptr, 0, PLE, D, 2, 1);
        if (NG_PROJ == 0) BIG_CONVERSIONS(F);
        if (NE_LATE > 0 && F.G != 256) EXPERT_CONVERSIONS(F, 1, NE - NE_LATE, NE);
        {
            float* WR = WSP(float, WS_WR); const float* nf = AP->in[10]; const float* rw = AP->in[11];
            for (int i = F.gw * 64 + F.lane; i < 2 * NE * D; i += F.NGW * 64) { const int l = i / (NE * D), e = (i / D) % NE, k = i % D; WR[i] = nf[l * D + k] * rw[((size_t)l * D + k) * NE + e]; }
        }
        {
            float* R1 = WSP(float, WS_ROPE1); float* RA = WSP(float, WS_ROPEA);
            for (int i = F.gw * 64 + F.lane; i < SEQ * 32; i += F.NGW * 64) { const int pos = i >> 5, j = i & 31;
                const int o = (pos * 32 + (j & ~1)) * 2 + (j & 1);
                const float a1 = (float)pos * rope_freq(j, 32); R1[o] = cosf(a1); R1[o + 2] = sinf(a1);
                const float aa = (float)((j < 16) ? (pos >> 6) : (pos & 63)) * rope_freq(j & 15, 16); RA[o] = cosf(aa); RA[o + 2] = sinf(aa); }
        }
        {
            bf16* PBF = WSP(bf16, WS_PBF); const float* p_in = AP->in[1]; const size_t n8 = (size_t)2 * T * PLE / 8;
            for (size_t i = (size_t)F.gw * 64 + F.lane; i < n8; i += (size_t)F.NGW * 64) { const f32x4 a = __builtin_nontemporal_load((const f32x4*)(p_in + i * 8)), b = __builtin_nontemporal_load((const f32x4*)(p_in + i * 8 + 4));
                v4u w; w.x = pk2(a.x, a.y); w.y = pk2(a.z, a.w); w.z = pk2(b.x, b.y); w.w = pk2(b.z, b.w); *(v4u*)(PBF + i * 8) = w; }
        }
        {
            bf16* X0 = WSP(bf16, WS_X0); float* SS0 = WSP(float, WS_SSP); const float* x_in = AP->in[0];
            for (int m = F.gw; m < T; m += F.NGW) { float s = 0.f;
#pragma unroll
                for (int j = 0; j < 2; ++j) { const size_t co = (size_t)m * D + j * 512 + F.lane * 8; const f32x4 a = __builtin_nontemporal_load((const f32x4*)(x_in + co)), b = __builtin_nontemporal_load((const f32x4*)(x_in + co + 4));
                    v4u w; w.x = pk2(a.x, a.y); w.y = pk2(a.z, a.w); w.z = pk2(b.x, b.y); w.w = pk2(b.z, b.w); *(v4u*)(X0 + co) = w;
                    if (PROJ_FP8) { v2u q; q.x = pk4_fp8(clamp448(bflo(w.x)), clamp448(bfhi(w.x)), clamp448(bflo(w.y)), clamp448(bfhi(w.y))); q.y = pk4_fp8(clamp448(bflo(w.z)), clamp448(bfhi(w.z)), clamp448(bflo(w.w)), clamp448(bfhi(w.w))); *(v2u*)(ws + WS_HF8 + co) = q; }
                    s += (bflo(w.x) * bflo(w.x) + bfhi(w.x) * bfhi(w.x)) + (bflo(w.y) * bflo(w.y) + bfhi(w.y) * bfhi(w.y)) + (bflo(w.z) * bflo(w.z) + bfhi(w.z) * bfhi(w.z)) + (bflo(w.w) * bflo(w.w) + bfhi(w.w) * bfhi(w.w)); }
                s = wave_sum(s); if (F.lane < 16) SS0[(size_t)m * 16 + F.lane] = (F.lane == 0) ? s : 0.f; }
        }
        __syncthreads();
        SEAM(0);
    }
#pragma unroll 1
    for (int l = 0; l < 2; ++l) {
        const int pb = 1 + 10 * l;
        if (INL(0)) REP(0) {
            const bool split0 = (NG_PROJ > 0) && (l == 0) && (F.G == 256), split1 = (NE_LATE > 0) && (l == 1) && (F.G == 256);
            const int Gg = split0 ? NG_PROJ : split1 ? 192 : F.G;
            const bool gemm_role = F.bx < Gg;
            if (!gemm_role) { Frame F2 = F; F2.gw = (F.bx - Gg) * NWAVES + F.wave; F2.NGW = (F.G - Gg) * NWAVES;
                if (l == 0) BIG_CONVERSIONS(F2); else EXPERT_CONVERSIONS(F2, 1, NE - NE_LATE, NE);
                __syncthreads(); }
            else {
            const bf16* hin = (l == 0) ? WSP(bf16, WS_X0) : WSP(bf16, WS_H3);
            const float* ssin = WSP(float, WS_SSP) + (size_t)l * T * 16;
            const bf16* ain = PROJ_FP8 ? (const bf16*)(ws + WS_HF8 + (size_t)l * T * D) : hin; const int Kin = PROJ_FP8 ? D / 2 : D;
            LAS int* PML = (LAS int*)(F.lds + RING_OFF + RING_BYTES); LAS float* RSL = (LAS float*)(F.lds + RING_OFF + RING_BYTES + 64);
            { pg8::StaticOrder S0; S0.init(T, l == 0 ? AB_IN : C_IN, Gg, F.bx);
#pragma unroll
              for (int i = 0; i < 8; ++i) { pg8::Unit uu; uu.pm = 0; uu.pn = 0; const bool has = S0.next(i, uu); const int pmv = has ? uu.pm : -1;
                  if (F.tid == 0) PML[i] = pmv;
                  if (has && F.tid < 256) RSL[i * 256 + F.tid] = __builtin_amdgcn_rsqf(ssp_sum(ssin + (size_t)(pmv * 256 + F.tid) * 16) * (1.f / D) + NORM_EPS); }
              __syncthreads(); }
            if (l == 0) { pg8::Gemm g{ain, WSP(bf16, WS_WIN0T), T, AB_IN, Kin}; pg8::StaticOrder S; S.init(T, AB_IN, Gg, F.bx);
                EpiQKV<0> E{RSL, PML, AP->in[4], AP->in[5], WSP(float, WS_ROPE1), WSP(float, WS_ROPEA), WSP(bf16, WS_Q3), WSP(bf16, WS_K3), WSP(bf16, WS_V3)};
                pg8::gemm_phase<EpiQKV<0>, pg8::StaticOrder, true, true, PROJ_FP8 ? 127 - F8_WSC : -1>(F.lds + RING_OFF, g, S, E); }
            else { pg8::Gemm g{ain, WSP(bf16, WS_WIN1T), T, C_IN, Kin}; pg8::StaticOrder S; S.init(T, C_IN, Gg, F.bx);
                EpiQKV<1> E{RSL, PML, nullptr, nullptr, WSP(float, WS_ROPE1), WSP(float, WS_ROPEA), WSP(bf16, WS_Q3), WSP(bf16, WS_K3), WSP(bf16, WS_V3)};
                pg8::gemm_phase<EpiQKV<1>, pg8::StaticOrder, true, true, PROJ_FP8 ? 127 - F8_WSC : -1>(F.lds + RING_OFF, g, S, E); }
            if (l == 0) { int Kp = PLE; asm volatile("" : "+s"(Kp)); pg8::Gemm g{WSP(bf16, WS_PBF), WSP(bf16, WS_WPT), 2 * T, 2 * D, Kp}; PPOrder S{Gg, F.bx};
                EpiPP E{WSP(bf16, WS_PP)};
                pg8::gemm_phase<EpiPP, PPOrder, true, true>(F.lds + RING_OFF, g, S, E); }
            }
            SEAM(pb + 0);
        }
        if (INL(1)) REP(1) {
            if (l == 0) attn_phase_l0(F, WSP(bf16, WS_Q3), WSP(bf16, WS_K3), WSP(bf16, WS_V3), WSP(bf16, WS_OCAT), AP->in[6]);
            else attn_phase_l1(F, WSP(bf16, WS_Q3), WSP(bf16, WS_K3), WSP(bf16, WS_V3), WSP(bf16, WS_OGB), WSP(float, WS_LSE));
            SEAM(pb + 1);
        }
        if (INL(2)) REP(2) { if (l == 1) merge_phase(F, WSP(bf16, WS_OGB), WSP(float, WS_LSE), WSP(bf16, WS_OCAT)); SEAM(pb + 2); }
        if (INL(3)) REP(3) {
            const bf16* hin = (l == 0) ? WSP(bf16, WS_X0) : WSP(bf16, WS_H3);
            pg8::Gemm g{WSP(bf16, WS_OCAT), (const bf16*)(ws + (l == 0 ? WS_WOUT0T : WS_WOUT1T)), T, D, (l == 0) ? D : C_OUT}; pg8::StaticOrder S; S.init(T, D, F.G, F.bx); EpiResBf16 E{hin, WSP(bf16, WS_HM)};
            pg8::gemm_phase<EpiResBf16, pg8::StaticOrder, true, true>(F.lds + RING_OFF, g, S, E);
            SEAM(pb + 3);
        }
        if (INL(4)) REP(4) { route_phase(F, WSP(bf16, WS_HM), WSP(float, WS_WR) + (size_t)l * NE * D, AP->in[12] + l * NE, WSP(int, WS_CNTTAB), WSP(int, WS_TOPE), WSP(float, WS_TOPG), WSP(int, WS_TOPPOS), WSP(float, WS_RSTD));
#ifdef PROBE_ROUTE
            route_phase(F, WSP(bf16, WS_HM), WSP(float, WS_WR) + (size_t)l * NE * D, AP->in[12] + l * NE, WSP(int, WS_OGB) + 16 * T, WSP(int, WS_OGB), WSP(float, WS_OGB) + 4 * T, WSP(int, WS_OGB) + 8 * T, WSP(float, WS_OGB) + 12 * T);
#endif
            SEAM(pb + 4); }
        if (INL(5)) REP(5) { slot_phase(F, WSP(bf16, WS_HM), WSP(int, WS_CNTTAB), WSP(int, WS_TOPE), WSP(float, WS_TOPG), WSP(int, WS_TOPPOS), WSP(float, WS_RSTD), WSP(int, WS_TOKSLOT), WSP(float, WS_SLOTGATE), WSP(float, WS_SLOTRS), WSP(bf16, WS_XG), WSP(int, WS_XTAB), ((MOE_FP8_MASK >> l) & 1) != 0); SEAM(pb + 5); }
        if (INL(6)) REP(6) {
            XcdOrder<3> S{WSP(int, WS_XTAB) + (F.bx & 7) * 136, F.bx >> 3, (int)F.G >> 3};
#if MOE_FP8_MASK != 0
            if ((MOE_FP8_MASK >> l) & 1) { pg8::Gemm g{WSP(bf16, WS_XG), WSP(bf16, WS_WUPT) + (size_t)l * NE * 2 * DE * D, NSLOT, NE * 2 * DE, D / 2};
                EpiSwiglu<true> E{WSP(void, WS_ACT), AP->in[14] + (size_t)l * NE * 2 * DE, nullptr};
                pg8::gemm_phase<EpiSwiglu<true>, XcdOrder<3>, true, true, F8_DIAG ? 1000 : 127 - F8_WSC>(F.lds + RING_OFF, g, S, E); }
#ifdef PROBE_UPNULL
            if ((MOE_FP8_MASK >> l) & 1) { pg8::Gemm g{WSP(bf16, WS_XG), WSP(bf16, WS_WUPT) + (size_t)l * NE * 2 * DE * D, NSLOT, NE * 2 * DE, D / 2};
                EpiNull E{WSP(float, WS_OGB)};
                pg8::gemm_phase<EpiNull, XcdOrder<3>, true, true, 127 - F8_WSC>(F.lds + RING_OFF, g, S, E); }
#endif
#endif
#if MOE_FP8_MASK != 3
            if (!((MOE_FP8_MASK >> l) & 1)) { pg8::Gemm g{WSP(bf16, WS_XG), WSP(bf16, WS_WUPT) + (size_t)l * NE * 2 * DE * D, NSLOT, NE * 2 * DE, D};
                EpiSwiglu<false> E{WSP(void, WS_ACT), AP->in[14] + (size_t)l * NE * 2 * DE, WSP(float, WS_SLOTRS)};
                pg8::gemm_phase<EpiSwiglu<false>, XcdOrder<3>, true, true>(F.lds + RING_OFF, g, S, E); }
#endif
            SEAM(pb + 6);
        }
        if (INL(7)) REP(7) {
            XcdOrder<2> S{WSP(int, WS_XTAB) + (F.bx & 7) * 136, F.bx >> 3, (int)F.G >> 3};
            EpiDown<Y_FP8 != 0> E{WSP(void, WS_Y), AP->in[16] + (size_t)l * NE * D, WSP(float, WS_SLOTGATE), ((MOE_FP8_MASK >> l) & 1) ? F8_EPI_SC : 1.f};
#if MOE_FP8_MASK != 0
            if ((MOE_FP8_MASK >> l) & 1) { pg8::Gemm g{WSP(bf16, WS_ACT), WSP(bf16, WS_WDNT) + (size_t)l * NE * D * DE, NSLOT, NE * D, DE / 2};
                pg8::gemm_phase<EpiDown<Y_FP8 != 0>, XcdOrder<2>, true, true, F8_DIAG ? 1000 : 127 - F8_WSC>(F.lds + RING_OFF, g, S, E); }
#ifdef PROBE_DNNULL
            if ((MOE_FP8_MASK >> l) & 1) { pg8::Gemm g{WSP(bf16, WS_ACT), WSP(bf16, WS_WDNT) + (size_t)l * NE * D * DE, NSLOT, NE * D, DE / 2};
                EpiNull E2{WSP(float, WS_OGB)};
                pg8::gemm_phase<EpiNull, XcdOrder<2>, true, true, 127 - F8_WSC>(F.lds + RING_OFF, g, S, E2); }
#endif
#endif
#if MOE_FP8_MASK != 3
            if (!((MOE_FP8_MASK >> l) & 1)) { pg8::Gemm g{WSP(bf16, WS_ACT), WSP(bf16, WS_WDNT) + (size_t)l * NE * D * DE, NSLOT, NE * D, DE};
                pg8::gemm_phase<EpiDown<Y_FP8 != 0>, XcdOrder<2>, true, true>(F.lds + RING_OFF, g, S, E); }
#endif
            SEAM(pb + 7);
        }
        if (INL(8)) REP(8) { combine_phase(F, WSP(bf16, WS_HM), WSP(void, WS_Y), WSP(int, WS_TOKSLOT), WSP(bf16, WS_H2), ws + WS_H2F8); SEAM(pb + 8); }
        if (INL(9)) REP(9) {
            pg8::StaticOrder S; S.init(T, D, F.G, F.bx);
            EpiPle E{WSP(bf16, WS_H2), WSP(bf16, WS_PP) + (size_t)l * T * D, WSP(bf16, WS_H3), WSP(float, WS_SSP) + (size_t)(l + 1) * T * 16, (PROJ_FP8 && l == 0) ? ws + WS_HF8 + (size_t)T * D : nullptr};
            if (PLE_FP8) { pg8::Gemm g{WSP(bf16, WS_H2F8), WSP(bf16, WS_WGT) + (size_t)l * D * D, T, D, D / 2};
                pg8::gemm_phase<EpiPle, pg8::StaticOrder, true, true, 127 - F8_WSC>(F.lds + RING_OFF, g, S, E); }
            else { pg8::Gemm g{WSP(bf16, WS_H2), WSP(bf16, WS_WGT) + (size_t)l * D * D, T, D, D};
                pg8::gemm_phase<EpiPle, pg8::StaticOrder, true, true>(F.lds + RING_OFF, g, S, E); }
#ifdef PROBE_PLENULL
            { pg8::Gemm g{WSP(bf16, WS_H2), WSP(bf16, WS_WGT) + (size_t)l * D * D, T, D, D}; EpiNull EN{WSP(float, WS_OGB)};
                pg8::gemm_phase<EpiNull, pg8::StaticOrder, true, true>(F.lds + RING_OFF, g, S, EN); }
#endif
            SEAM(pb + 9);
        }
    }
#ifdef PROBE_BARRIERS
    for (int pb_ = 0; pb_ < PROBE_BARRIERS; ++pb_) xcd_barrier(bar);
#endif
    if (((MK_MASK >> 13) & 1) && IN(21) && refresh(F)) final_norm_phase(F, WSP(bf16, WS_H3), WSP(float, WS_SSP) + (size_t)2 * T * 16, AP->in[19], AP->out);
#undef IN
#undef INL
#undef REP
#undef SEAM
#undef ws
#undef WSP
#undef BIG_CONVERSIONS
#undef EXPERT_CONVERSIONS
}

#ifndef MK_ONE_LAUNCH
#define MK_ONE_LAUNCH 1
#endif
extern "C" void kernel_launch(void* const* d_in, const int* in_sizes, int n_in, void* d_out, int out_size, void* d_ws, size_t ws_size, hipStream_t stream) {
    static int grid = 0;
    if (grid == 0) {
        if (n_in != 20 || in_sizes[0] != T * D || out_size != T * D || ws_size < WS_END) { fprintf(stderr, "kernel_launch: unexpected shapes: n_in %d in0 %d out %d ws %zu (need %zu)\n", n_in, n_in > 0 ? in_sizes[0] : -1, out_size, ws_size, (size_t)WS_END); grid = -1; return; }
        int dev = 0, cus = 0, per_cu = 0;
        if (hipGetDevice(&dev) != hipSuccess || hipDeviceGetAttribute(&cus, hipDeviceAttributeMultiprocessorCount, dev) != hipSuccess) { grid = -1; return; }
        if (hipFuncSetAttribute((const void*)fwd_kernel, hipFuncAttributeMaxDynamicSharedMemorySize, LDS_BYTES) != hipSuccess) { fprintf(stderr, "kernel_launch: hipFuncSetAttribute failed\n"); grid = -1; return; }
        if (hipOccupancyMaxActiveBlocksPerMultiprocessor(&per_cu, (const void*)fwd_kernel, NWAVES * 64, LDS_BYTES) != hipSuccess || per_cu < 1) fprintf(stderr, "kernel_launch: occupancy query says %d\n", per_cu);
        (void)hipGetLastError();
        grid = cus;
        if (grid != 256) fprintf(stderr, "kernel_launch: %d CUs (built for 256)\n", grid);
    }
    if (grid < 0) return;
    if (hipMemsetAsync((char*)d_ws + WS_CTL, 0, CTL_ZERO_BYTES, stream) != hipSuccess) return;
    Args a{};
    for (int i = 0; i < 20; ++i) a.in[i] = (const float*)d_in[i];
    a.out = (float*)d_out; a.ws = (unsigned char*)d_ws;
#if MK_ONE_LAUNCH
    a.ph_lo = 0; a.ph_hi = N_PHASES; a.li = 0;
    hipLaunchKernelGGL(fwd_kernel, dim3(grid), dim3(NWAVES * 64), LDS_BYTES, stream, a);
#else
    for (int ph = 0; ph < N_PHASES; ++ph) {
        if (ph == 3) continue;
        a.ph_lo = ph; a.ph_hi = ph + 1; a.li = ph;
        hipLaunchKernelGGL(fwd_kernel, dim3(grid), dim3(NWAVES * 64), LDS_BYTES, stream, a);
    }
#endif
}
```

```cpp
#include <hip/hip_runtime.h>
#include <hip/hip_bf16.h>
#include <cstdio>
#include <cstdint>
#include <cmath>
namespace pg8 {
#define PG8_LAS __attribute__((address_space(3)))
typedef unsigned short bf16_t;
typedef short bf16x8 __attribute__((ext_vector_type(8)));
typedef float f32x4 __attribute__((ext_vector_type(4)));
typedef unsigned u32x4 __attribute__((ext_vector_type(4)));
typedef int pg8_v4i __attribute__((ext_vector_type(4)));
typedef long pg8_v2l __attribute__((ext_vector_type(2)));
constexpr int BM = 256, BK = 64, HALF = 128, HTB = HALF * BK * 2  , STAGE_BYTES = 8 * HTB, NXCD = 8, WGM = 8;

__host__ __device__ __forceinline__ int lds_byte(int r, int c) { const int st = (r >> 4) * 2 + (c >> 5), rr = r & 15, cc = c & 31, ob = rr * 64 + cc * 2; return st * 1024 + (ob ^ (((ob >> 9) & 1) << 5)); }
__host__ __device__ __forceinline__ void stage_rc(int b, int& R, int& C) { const int st = b / 1024, sb = b % 1024, swz = sb ^ (((sb >> 9) & 1) << 5); R = (st >> 1) * 16 + swz / 64; C = (st & 1) * 32 + (swz % 64) / 2; }
__host__ __device__ __forceinline__ int perm32(int rho) { const int n = rho >> 4, i = rho & 15; return 8 * (i >> 2) + 4 * n + (i & 3); }

struct Unit { int pm, pn; };
struct Gemm { const bf16_t* A; const bf16_t* Bt; int M, N, K; };

struct StaticOrder {
    int nM, nN, nwg, G, c;
    __host__ __device__ __forceinline__ void init(int M, int N, int G_, int c_) { nM = M / BM; nN = N / BM; nwg = nM * nN; G = G_; c = c_; }
    __host__ __device__ __forceinline__ bool next(int i, Unit& u) const {
        const long L = (long)i * G + c; if (L >= nwg) return false;
        int wgid = (int)L; { const int q = nwg / NXCD, r = nwg % NXCD, xcd = wgid % NXCD, off = wgid / NXCD; wgid = (xcd < r ? xcd * (q + 1) : r * (q + 1) + (xcd - r) * q) + off; }
        const int nig = WGM * nN, gid = wgid / nig, fm = gid * WGM, gsz = (nM - fm) < WGM ? (nM - fm) : WGM;
        u.pm = fm + ((wgid % nig) % gsz); u.pn = (wgid % nig) / gsz; return true;
    }
    __device__ __forceinline__ void a_ready(const Unit&) const {}
    __device__ __forceinline__ void done(const Unit&) const {}
};

__device__ __forceinline__ unsigned cvt_pk_bf16(float lo, float hi) { unsigned r; asm volatile("v_cvt_pk_bf16_f32 %0, %1, %2" : "=v"(r) : "v"(lo), "v"(hi)); return r; }
typedef float f32x2 __attribute__((ext_vector_type(2)));
__device__ __forceinline__ f32x2 gelu_pk(f32x2 v) {
    const f32x2 av = __builtin_elementwise_abs(v), d = av * 0.2316418882f + 1.0f;
    f32x2 t; t.x = __builtin_amdgcn_rcpf(d.x); t.y = __builtin_amdgcn_rcpf(d.y);
    f32x2 q = t * 0.5307027145f + (-0.7265760135f); q = q * t + 0.7107068705f; q = q * t + (-0.142248368f); q = q * t + 0.127414796f; q = q * t;
    const f32x2 s = (v * v) * (-0.72134752044f);
    f32x2 e; e.x = __builtin_amdgcn_exp2f(s.x); e.y = __builtin_amdgcn_exp2f(s.y);
    const f32x2 m = v * (q * e), r = v - m;
    f32x2 o; o.x = v.x < 0.f ? m.x : r.x; o.y = v.y < 0.f ? m.y : r.y; return o;
}

template <int ACT  > struct EpiBf16 {
    static constexpr bool PERM = true, AFTER_DRAIN = false; static_assert(ACT == 0 || ACT == 1, "EpiBf16: ACT is 0 (none) or 1 (gelu_pk)");
    bf16_t* O; int ldc; const float* bias; int split_cols; size_t split_stride; float scale0;
    __device__ __forceinline__ void operator()(const f32x4 (&acc)[2][2][4][2], const Unit& u, int wr, int wc, int fr, int fq) const {
        const int row0 = u.pm * BM + wr * 64 + fr; int colt = u.pn * BM; bf16_t* base = O;
        float sc = 1.f; if (split_cols) { const int t = colt / split_cols; base += (size_t)t * split_stride; colt -= t * split_cols; if (t == 0) sc = scale0; }
        const int col0 = colt + wc * 32 + 8 * fq, bcol0 = u.pn * BM + wc * 32 + 8 * fq;
        f32x4 bv[2][2];
#pragma unroll
        for (int bj = 0; bj < 2; ++bj)
#pragma unroll
            for (int n = 0; n < 2; ++n) bv[bj][n] = bias ? *(const f32x4*)(bias + bcol0 + bj * HALF + 4 * n) : (f32x4){0.f, 0.f, 0.f, 0.f};
#pragma unroll
        for (int ai = 0; ai < 2; ++ai)
#pragma unroll
            for (int m = 0; m < 4; ++m) { bf16_t* rowp = base + (size_t)(row0 + ai * HALF + m * 16) * ldc + col0;
#pragma unroll
                for (int bj = 0; bj < 2; ++bj) { f32x4 v0 = acc[ai][bj][m][0] + bv[bj][0], v1 = acc[ai][bj][m][1] + bv[bj][1];
                    if (ACT == 1) { f32x2 a = gelu_pk((f32x2){v0[0], v0[1]}), b = gelu_pk((f32x2){v0[2], v0[3]}), c = gelu_pk((f32x2){v1[0], v1[1]}), d = gelu_pk((f32x2){v1[2], v1[3]});
                        v0 = (f32x4){a.x, a.y, b.x, b.y}; v1 = (f32x4){c.x, c.y, d.x, d.y}; }
                    v0 = v0 * sc; v1 = v1 * sc; u32x4 w; w.x = cvt_pk_bf16(v0[0], v0[1]); w.y = cvt_pk_bf16(v0[2], v0[3]); w.z = cvt_pk_bf16(v1[0], v1[1]); w.w = cvt_pk_bf16(v1[2], v1[3]);
                    *(u32x4*)(rowp + bj * HALF) = w; } }
    }
};
template <class Epi, class Sched, bool ALIGN_EPI = false, bool SP2 = false, int FP8SC = -1>
__device__ __forceinline__ void gemm_phase(PG8_LAS unsigned char* lds, const Gemm g, const Sched& S, const Epi& E) {
    int tid_ = threadIdx.x; asm volatile("" : "+v"(tid_));
    const int tid = tid_, wid = __builtin_amdgcn_readfirstlane(tid >> 6), lane = tid & 63, wr = wid >> 2, wc = wid & 3, fr = lane & 15, fq = lane >> 4;
    const int K = g.K, nt = K / BK;
    unsigned voffA[2], voffB[2];
#pragma unroll
    for (int i = 0; i < 2; ++i) { int R, C; stage_rc(tid * 16 + i * 8192, R, C); const int Rb = Epi::PERM ? ((R & ~31) + perm32(R & 31)) : R;
        voffA[i] = (unsigned)(R * K + C) * 2u; voffB[i] = (unsigned)(Rb * K + C) * 2u; }
    const size_t kstep = (size_t)(BK * 2);
    const size_t hstep = (size_t)HALF * K * 2;
    const size_t tstep = 2 * hstep;
    const unsigned ldsw = (unsigned)wid * 1024u;
    const int aoff = lds_byte(wr * 64 + fr, fq * 8), boff = lds_byte(wc * 32 + fr, fq * 8);
#define PG8_SA(b, h) (((b) * 2 + (h)) * HTB)
#define PG8_SB(b, h) ((4 + (b) * 2 + (h)) * HTB)
#define PG8_STAGE(bufoff, gbase, voff) do { _Pragma("unroll") for (int _i = 0; _i < 2; ++_i) \
        __builtin_amdgcn_global_load_lds((const unsigned*)((const char*)(gbase) + (voff)[_i]), (PG8_LAS unsigned*)(lds + (bufoff) + ldsw + _i * 8192), 16, 0, 0); } while (0)
#define PG8_LDA(dst, b, h) do { _Pragma("unroll") for (int m = 0; m < 4; ++m) _Pragma("unroll") for (int k = 0; k < 2; ++k) dst[m][k] = *(const PG8_LAS bf16x8*)(lds + PG8_SA(b, h) + aoff + m * 2048 + k * 1024); } while (0)
#define PG8_LDB(dst, b, h) do { _Pragma("unroll") for (int n = 0; n < 2; ++n) _Pragma("unroll") for (int k = 0; k < 2; ++k) dst[n][k] = *(const PG8_LAS bf16x8*)(lds + PG8_SB(b, h) + boff + n * 2048 + k * 1024); } while (0)
#define PG8_CAT8(x0, x1) __builtin_shufflevector(__builtin_bit_cast(pg8_v4i, x0), __builtin_bit_cast(pg8_v4i, x1), 0, 1, 2, 3, 4, 5, 6, 7)
#define PG8_MMA(ai, bj, At, Bt) do { __builtin_amdgcn_s_setprio(1); \
        if constexpr (FP8SC < 0) { _Pragma("unroll") for (int m = 0; m < 4; ++m) _Pragma("unroll") for (int n = 0; n < 2; ++n) _Pragma("unroll") for (int k = 0; k < 2; ++k) \
            acc[ai][bj][m][n] = __builtin_amdgcn_mfma_f32_16x16x32_bf16(Bt[n][k], At[m][k], acc[ai][bj][m][n], 0, 0, 0); } \
        else if constexpr (FP8SC >= 1000) { _Pragma("unroll") for (int m = 0; m < 4; ++m) _Pragma("unroll") for (int n = 0; n < 2; ++n) _Pragma("unroll") for (int k = 0; k < 2; ++k) { \
            const pg8_v2l bq = __builtin_bit_cast(pg8_v2l, Bt[n][k]), aq = __builtin_bit_cast(pg8_v2l, At[m][k]); \
            acc[ai][bj][m][n] = __builtin_amdgcn_mfma_f32_16x16x32_fp8_fp8(bq[0], aq[0], acc[ai][bj][m][n], 0, 0, 0); acc[ai][bj][m][n] = __builtin_amdgcn_mfma_f32_16x16x32_fp8_fp8(bq[1], aq[1], acc[ai][bj][m][n], 0, 0, 0); } } \
        else { _Pragma("unroll") for (int m = 0; m < 4; ++m) _Pragma("unroll") for (int n = 0; n < 2; ++n) \
            acc[ai][bj][m][n] = __builtin_amdgcn_mfma_scale_f32_16x16x128_f8f6f4(PG8_CAT8(Bt[n][0], Bt[n][1]), PG8_CAT8(At[m][0], At[m][1]), acc[ai][bj][m][n], 0, 0, 0, (FP8SC < 0 ? 127 : FP8SC) * 0x01010101, 0, 0x7f7f7f7f); \
            _Pragma("unroll") for (int m = 0; m < 4; ++m) _Pragma("unroll") for (int n = 0; n < 2; ++n) asm volatile("" : "+v"(acc[ai][bj][m][n])); }     \
        __builtin_amdgcn_s_setprio(0); } while (0)
#define PG8_WAIT_V(n) asm volatile("s_waitcnt vmcnt(" #n ")" ::: "memory")
#define PG8_WAIT_L(n) asm volatile("s_waitcnt lgkmcnt(" #n ")" ::: "memory")
#define PG8_BAR __builtin_amdgcn_s_barrier()
#define PG8_SCHED __builtin_amdgcn_sched_barrier(0)
    Unit cur, nxt; int ui = 0;
    if (!S.next(0, cur)) return;
    f32x4 acc[2][2][4][2];
#pragma unroll
    for (int a = 0; a < 2; ++a)
#pragma unroll
        for (int b = 0; b < 2; ++b)
#pragma unroll
            for (int m = 0; m < 4; ++m)
#pragma unroll
                for (int n = 0; n < 2; ++n) acc[a][b][m][n] = (f32x4){0.f, 0.f, 0.f, 0.f};
    bf16x8 At[4][2], B0[2][2], B1[2][2];
    const char* cA = (const char*)g.A + (size_t)cur.pm * tstep; const char* cB = (const char*)g.Bt + (size_t)cur.pn * tstep;
    S.a_ready(cur);
    if constexpr (SP2) {
        PG8_STAGE(PG8_SB(0, 0), cB, voffB); PG8_STAGE(PG8_SB(0, 1), cB + hstep, voffB); PG8_STAGE(PG8_SA(0, 0), cA, voffA); PG8_STAGE(PG8_SA(0, 1), cA + hstep, voffA);
        if (wr == 1) PG8_BAR;
        PG8_WAIT_V(2); PG8_BAR;
        PG8_STAGE(PG8_SB(1, 0), cB + kstep, voffB); PG8_STAGE(PG8_SA(1, 0), cA + kstep, voffA); PG8_STAGE(PG8_SB(1, 1), cB + hstep + kstep, voffB);
        PG8_WAIT_V(6); PG8_BAR;
    } else {
        PG8_STAGE(PG8_SB(0, 0), cB, voffB); PG8_STAGE(PG8_SA(0, 0), cA, voffA); PG8_STAGE(PG8_SB(0, 1), cB + hstep, voffB); PG8_STAGE(PG8_SA(0, 1), cA + hstep, voffA);
        if (wr == 1) PG8_BAR;
        PG8_WAIT_V(4); PG8_BAR;
        PG8_STAGE(PG8_SB(1, 0), cB + kstep, voffB); PG8_STAGE(PG8_SA(1, 0), cA + kstep, voffA); PG8_STAGE(PG8_SB(1, 1), cB + hstep + kstep, voffB);
        PG8_WAIT_V(6); PG8_BAR;
    }
    for (;;) {
        const bool has_next = S.next(ui + 1, nxt);
        const char* nA = has_next ? (const char*)g.A + (size_t)nxt.pm * tstep : cA; const char* nB = has_next ? (const char*)g.Bt + (size_t)nxt.pn * tstep : cB;
        for (int t = 0; t < nt; t += 2) {
            const bool last = (t == nt - 2);
            const char* a1 = cA + (size_t)(t + 1) * kstep;
            const char* a2 = last ? nA : cA + (size_t)(t + 2) * kstep; const char* b2 = last ? nB : cB + (size_t)(t + 2) * kstep;
            const char* a3 = a2 + kstep; const char* b3 = b2 + kstep;
            if (last && has_next) S.a_ready(nxt);
            if constexpr (SP2) {
            PG8_LDB(B0, 0, 0); PG8_LDB(B1, 0, 1); PG8_SCHED; PG8_LDA(At, 0, 0); PG8_STAGE(PG8_SA(1, 1), a1 + hstep, voffA);
            PG8_WAIT_V(8); PG8_WAIT_L(0); PG8_BAR; PG8_MMA(0, 0, At, B0); PG8_MMA(0, 1, At, B1); PG8_BAR; PG8_SCHED;
            PG8_LDA(At, 0, 1); PG8_STAGE(PG8_SB(0, 0), b2, voffB); PG8_STAGE(PG8_SB(0, 1), b2 + hstep, voffB); PG8_STAGE(PG8_SA(0, 0), a2, voffA);
            PG8_WAIT_V(8); PG8_WAIT_L(0); PG8_BAR; PG8_MMA(1, 0, At, B0); PG8_MMA(1, 1, At, B1); PG8_BAR; PG8_SCHED;
            PG8_LDB(B0, 1, 0); PG8_LDB(B1, 1, 1); PG8_SCHED; PG8_LDA(At, 1, 0); PG8_STAGE(PG8_SA(0, 1), a2 + hstep, voffA);
            PG8_WAIT_V(8); PG8_WAIT_L(0); PG8_BAR; PG8_MMA(0, 0, At, B0); PG8_MMA(0, 1, At, B1); PG8_BAR; PG8_SCHED;
            PG8_LDA(At, 1, 1); PG8_STAGE(PG8_SB(1, 0), b3, voffB); PG8_STAGE(PG8_SB(1, 1), b3 + hstep, voffB); PG8_STAGE(PG8_SA(1, 0), a3, voffA);
            PG8_WAIT_V(8); PG8_WAIT_L(0); PG8_BAR; PG8_MMA(1, 0, At, B0); PG8_MMA(1, 1, At, B1); PG8_BAR; PG8_SCHED;
            } else {
            PG8_LDB(B0, 0, 0); PG8_SCHED; PG8_LDA(At, 0, 0); PG8_STAGE(PG8_SA(1, 1), a1 + hstep, voffA);
            PG8_WAIT_L(8); PG8_BAR; PG8_WAIT_L(0); PG8_MMA(0, 0, At, B0); PG8_BAR; PG8_SCHED;
            PG8_LDB(B1, 0, 1); PG8_STAGE(PG8_SB(0, 0), b2, voffB);
            PG8_BAR; PG8_WAIT_L(0); PG8_MMA(0, 1, At, B1); PG8_BAR;
            PG8_LDA(At, 0, 1); PG8_STAGE(PG8_SA(0, 0), a2, voffA);
            PG8_BAR; PG8_WAIT_L(0); PG8_MMA(1, 0, At, B0); PG8_BAR; PG8_SCHED;
            PG8_STAGE(PG8_SB(0, 1), b2 + hstep, voffB);
            PG8_WAIT_V(6); PG8_BAR; PG8_MMA(1, 1, At, B1); PG8_BAR;
            PG8_LDB(B0, 1, 0); PG8_SCHED; PG8_LDA(At, 1, 0); PG8_STAGE(PG8_SA(0, 1), a2 + hstep, voffA);
            PG8_WAIT_L(8); PG8_BAR; PG8_WAIT_L(0); PG8_MMA(0, 0, At, B0); PG8_BAR; PG8_SCHED;
            PG8_LDB(B1, 1, 1); PG8_STAGE(PG8_SB(1, 0), b3, voffB);
            PG8_BAR; PG8_WAIT_L(0); PG8_MMA(0, 1, At, B1); PG8_BAR;
            PG8_LDA(At, 1, 1); PG8_STAGE(PG8_SA(1, 0), a3, voffA);
            PG8_BAR; PG8_WAIT_L(0); PG8_MMA(1, 0, At, B0); PG8_BAR; PG8_SCHED;
            PG8_STAGE(PG8_SB(1, 1), b3 + hstep, voffB);
            PG8_WAIT_V(6); PG8_BAR; PG8_MMA(1, 1, At, B1); PG8_BAR;
            }
        }
        if constexpr (ALIGN_EPI) { if (wr == 0) PG8_BAR; }
        if constexpr (!Epi::AFTER_DRAIN) { int te_ = threadIdx.x; asm volatile("" : "+v"(te_));
            const int le_ = te_ & 63, we_ = __builtin_amdgcn_readfirstlane(te_ >> 6); E(acc, cur, we_ >> 2, we_ & 3, le_ & 15, le_ >> 4); S.done(cur); }
        if (!has_next) break;
#pragma unroll
        for (int a = 0; a < 2; ++a)
#pragma unroll
            for (int b = 0; b < 2; ++b)
#pragma unroll
                for (int m = 0; m < 4; ++m)
#pragma unroll
                    for (int n = 0; n < 2; ++n) acc[a][b][m][n] = (f32x4){0.f, 0.f, 0.f, 0.f};
        cur = nxt; cA = nA; cB = nB; ++ui;
        if constexpr (ALIGN_EPI) { if (wr == 1) PG8_BAR; }
    }
    PG8_WAIT_V(0);
    if constexpr (!ALIGN_EPI) { if (wr == 0) PG8_BAR; }
    PG8_BAR;
    if constexpr (Epi::AFTER_DRAIN) { E.fused(acc, cur, wr, wc, fr, fq, lds, wid, lane); S.done(cur); }
#undef PG8_SA
#undef PG8_SB
#undef PG8_STAGE
#undef PG8_LDA
#undef PG8_LDB
#undef PG8_MMA
#undef PG8_CAT8
#undef PG8_WAIT_V
#undef PG8_WAIT_L
#undef PG8_BAR
#undef PG8_SCHED
}
}

constexpr int NWAVES = 8;
constexpr int BATCH = 2, SEQ = 8192, T = BATCH * SEQ, D = 1024;
constexpr int AB_IN = 1536, C_IN = 2304, C_OUT = 512;
constexpr int NE = 32, DE = 1024, PLE = 256;
constexpr int NSLOT = 73728;
constexpr float NORM_EPS = 1e-6f;
constexpr float LOG2_THETA = 13.287712379549449f;
constexpr float ATT_C2 = 0.125f * 1.4426950408889634f;

#define GAS __attribute__((address_space(1)))
#define LAS __attribute__((address_space(3)))
typedef unsigned short bf16;
typedef unsigned v4u __attribute__((ext_vector_type(4)));
typedef unsigned v2u __attribute__((ext_vector_type(2)));
typedef float f32x4 __attribute__((ext_vector_type(4)));
typedef GAS unsigned gu32;
#define RLX_AGENT __ATOMIC_RELAXED, __HIP_MEMORY_SCOPE_AGENT
#define LDS_WAIT() asm volatile("s_waitcnt lgkmcnt(0)" ::: "memory")
#define VM_WAIT() asm volatile("s_waitcnt vmcnt(0)" ::: "memory")

__device__ __forceinline__ int lane_opaque() { unsigned m = ~0u; asm volatile("" : "+s"(m)); return (int)__builtin_amdgcn_mbcnt_hi(m, __builtin_amdgcn_mbcnt_lo(m, 0u)); }
__device__ __forceinline__ int shx(int v, int m) { return __builtin_amdgcn_ds_bpermute((lane_opaque() ^ m) << 2, v); }
__device__ __forceinline__ float shx(float v, int m) { return __builtin_bit_cast(float, __builtin_amdgcn_ds_bpermute((lane_opaque() ^ m) << 2, __builtin_bit_cast(int, v))); }
__device__ __forceinline__ int shup(int v, int o) { const int l = lane_opaque(); const int s = (l - o) < 0 ? l : (l - o); return __builtin_amdgcn_ds_bpermute(s << 2, v); }
__device__ __forceinline__ int shl(int v, int src) { return __builtin_amdgcn_ds_bpermute(src << 2, v); }
typedef float f32x2_ __attribute__((ext_vector_type(2))); typedef __bf16 bf16x2_ __attribute__((ext_vector_type(2)));
__device__ __forceinline__ unsigned pk2(float lo, float hi) { f32x2_ v = {lo, hi}; bf16x2_ b = __builtin_convertvector(v, bf16x2_); return __builtin_bit_cast(unsigned, b); }
__device__ __forceinline__ float bflo(unsigned w) { return __builtin_bit_cast(float, w << 16); }
__device__ __forceinline__ float bfhi(unsigned w) { return __builtin_bit_cast(float, w & 0xffff0000u); }
#ifndef MOE_FP8_MASK
#define MOE_FP8_MASK 3
#endif
#ifndef F8_DIAG
#define F8_DIAG 0
#endif
constexpr float F8_EPI_SC = F8_DIAG ? (1.f / 64.f) : 1.f;
#ifndef PROJ_FP8
#define PROJ_FP8 1
#endif
#ifndef NG_PROJ
#define NG_PROJ 64
#endif
#ifndef NE_LATE
#define NE_LATE 6
#endif
#ifndef Y_FP8
#define Y_FP8 1
#endif
#ifndef PLE_FP8
#define PLE_FP8 0
#endif
constexpr float Y_SC = 32.f;
constexpr int F8_WSC = 6;
__device__ __forceinline__ unsigned pk4_fp8(float a, float b, float c, float d) { int w = 0; w = __builtin_amdgcn_cvt_pk_fp8_f32(a, b, w, false); w = __builtin_amdgcn_cvt_pk_fp8_f32(c, d, w, true); return (unsigned)w; }
__device__ __forceinline__ float clamp448(float x) { return fminf(fmaxf(x, -448.f), 448.f); }
__device__ __forceinline__ float rnd_bf(float x) { return bflo(pk2(x, 0.f)); }
__device__ __forceinline__ float ssp_sum(const float* p) { const f32x4 a = *(const f32x4*)p, b = *(const f32x4*)(p + 4), c = *(const f32x4*)(p + 8), d = *(const f32x4*)(p + 12);
    return (((a.x + a.y) + (a.z + a.w)) + ((b.x + b.y) + (b.z + b.w))) + (((c.x + c.y) + (c.z + c.w)) + ((d.x + d.y) + (d.z + d.w))); }

constexpr size_t MiB = 1u << 20;
constexpr size_t al256(size_t x) { return (x + 255) & ~(size_t)255; }
constexpr size_t WS_CTL = 0, CTL_ZERO_BYTES = 1 * MiB;
constexpr size_t WS_WIN0T = 1 * MiB;
constexpr size_t WS_WOUT0T = WS_WIN0T + (size_t)AB_IN * D * 2;
constexpr size_t WS_WIN1T = WS_WOUT0T + (size_t)D * D * 2;
constexpr size_t WS_WOUT1T = WS_WIN1T + (size_t)C_IN * D * 2;
constexpr size_t WS_WGT = WS_WOUT1T + (size_t)D * C_OUT * 2;
constexpr size_t WS_WPT = WS_WGT + 2 * (size_t)D * D * 2;
constexpr size_t WS_WR = WS_WPT + 2 * (size_t)D * PLE * 2;
constexpr size_t WS_ROPE1 = al256(WS_WR + 2 * (size_t)NE * D * 4);
constexpr size_t WS_ROPEA = WS_ROPE1 + (size_t)SEQ * 32 * 8;
constexpr size_t WS_WUPT = WS_ROPEA + (size_t)SEQ * 32 * 8;
constexpr size_t WS_WDNT = WS_WUPT + 2 * (size_t)NE * 2 * DE * D * 2;
constexpr size_t WS_PBF = WS_WDNT + 2 * (size_t)NE * D * DE * 2;
constexpr size_t WS_PP = WS_PBF + 2 * (size_t)T * PLE * 2;
constexpr size_t WS_X0 = WS_PP + 2 * (size_t)T * D * 2;
constexpr size_t WS_HM = WS_X0 + (size_t)T * D * 2;
constexpr size_t WS_H2 = WS_HM + (size_t)T * D * 2;
constexpr size_t WS_H3 = WS_H2 + (size_t)T * D * 2;
constexpr size_t WS_OCAT = WS_H3 + (size_t)T * D * 2;
constexpr size_t WS_SSP = WS_OCAT + (size_t)T * D * 2;
constexpr size_t WS_LSE = WS_SSP + 3 * (size_t)T * 16 * 4;
constexpr size_t WS_TOPE = WS_LSE + 3 * (size_t)T * 8 * 4;
constexpr size_t WS_TOPG = WS_TOPE + (size_t)T * 16;
constexpr size_t WS_TOPPOS = WS_TOPG + (size_t)T * 16;
constexpr size_t WS_RSTD = WS_TOPPOS + (size_t)T * 16;
constexpr size_t WS_TOKSLOT = WS_RSTD + (size_t)T * 4;
constexpr size_t WS_SLOTGATE = WS_TOKSLOT + (size_t)T * 16;
constexpr size_t WS_SLOTRS = WS_SLOTGATE + (size_t)NSLOT * 4;
constexpr size_t WS_XTAB = al256(WS_SLOTRS + (size_t)NSLOT * 4);
constexpr size_t WS_CNTTAB = al256(WS_XTAB + 8 * 136 * 4);
constexpr size_t WS_XG = al256(WS_CNTTAB + 256 * 32 * 4);
constexpr size_t WS_ACT = WS_XG + (size_t)NSLOT * D * 2;
constexpr size_t WS_Y = WS_ACT + (size_t)NSLOT * D * 2;
constexpr size_t WS_Q3 = WS_Y + (size_t)NSLOT * D * 2;
constexpr size_t WS_K3 = WS_Q3 + 3 * (size_t)T * 512 * 2;
constexpr size_t WS_V3 = WS_K3 + 3 * (size_t)T * 128 * 2;
constexpr size_t WS_OGB = WS_V3 + 3 * (size_t)T * 128 * 2;
constexpr size_t WS_H2F8 = WS_OGB + 3 * (size_t)T * 512 * 2;
constexpr size_t WS_HF8 = WS_H2F8 + (size_t)T * D;
constexpr size_t WS_END = WS_HF8 + 2 * (size_t)T * D;
constexpr int CW_TMO = 0;
constexpr int CW_CNT = 64;
constexpr int CW_BAR = 4096;

constexpr int LDSCTL_OFF = 0, MISC_OFF = 64;
constexpr int RING_OFF = 512, RING_BYTES = 131072;
constexpr int LDS_BYTES = 147456;

struct PPOrder {
    int G, c;
    __device__ __forceinline__ bool next(int i, pg8::Unit& u) const {
        int L; if (G == 256) { if (PROJ_FP8) { if (c < 128) { if (i >= 1) return false; L = c; } else { if (i >= 3) return false; L = 128 + (c - 128) * 3 + i; } }
                               else { if (c < 128 || i >= 4) return false; L = (c - 128) * 4 + i; } }
        else { L = i * G + c; if (L >= 512) return false; }
        u.pm = L >> 2; u.pn = 4 * (u.pm >> 6) + (L & 3); return true; }
    __device__ __forceinline__ void a_ready(const pg8::Unit&) const {}
    __device__ __forceinline__ void done(const pg8::Unit&) const {}
};
struct EpiPP {
    static constexpr bool PERM = true, AFTER_DRAIN = false;
    bf16* O;
    __device__ __forceinline__ void operator()(const pg8::f32x4 (&acc)[2][2][4][2], const pg8::Unit& u, int wr, int wc, int fr, int fq) const {
        const int row0 = u.pm * 256 + wr * 64 + fr, col0 = (u.pn & 3) * 256 + wc * 32 + 8 * fq;
#pragma unroll
        for (int ai = 0; ai < 2; ++ai)
#pragma unroll
            for (int m = 0; m < 4; ++m) { bf16* rp = O + (size_t)(row0 + ai * 128 + m * 16) * D + col0;
#pragma unroll
                for (int bj = 0; bj < 2; ++bj) { const pg8::f32x4 v0 = acc[ai][bj][m][0], v1 = acc[ai][bj][m][1];
                    pg8::u32x4 w; w.x = pk2(v0[0], v0[1]); w.y = pk2(v0[2], v0[3]); w.z = pk2(v1[0], v1[1]); w.w = pk2(v1[2], v1[3]);
                    *(pg8::u32x4*)(rp + bj * 128) = w; } }
    }
};
template <int LAYER> struct EpiQKV {
    static constexpr bool PERM = true, AFTER_DRAIN = false;
    const LAS float* RSL; const LAS int* PML;
    const float* qg; const float* kg; const float* rope1; const float* ropea; bf16* Q3; bf16* K3; bf16* V3;
    __device__ __forceinline__ void operator()(const pg8::f32x4 (&acc)[2][2][4][2], const pg8::Unit& u, int wr, int wc, int fr, int fq) const {
        int slot = 0;
#pragma unroll
        for (int i = 7; i >= 0; --i) if (PML[i] == u.pm) slot = i;
        const LAS float* rsl = RSL + slot * 256 + wr * 64 + fr;
        int kind, hd, grp;
        bool axial;
        if (LAYER == 0) { const int t3 = u.pn % 3; grp = u.pn / 3; axial = (grp == 0);
            if (t3 < 2) { kind = 0; hd = 4 * t3 + wc; } else if (wc < 2) { kind = 1; hd = wc; } else { kind = 2; hd = wc - 2; } }
        else { const int t3 = u.pn % 3; grp = u.pn / 3; axial = false;
            if (t3 < 2) { kind = 0; hd = 4 * t3 + wc; } else if (wc < 2) { kind = 1; hd = wc; } else { kind = 2; hd = wc - 2; } }
        const bool norm = axial && kind < 2, rope = kind < 2;
        f32x2_ GA[4], GB[4];
        if (norm) { const float* g = (kind == 0) ? qg : kg;
#pragma unroll
            for (int k = 0; k < 4; ++k) { const int j = 8 * fq + 2 * k; const int d0 = (j < 16) ? j : j + 16; GA[k] = (f32x2_){g[d0], g[d0 + 1]}; GB[k] = (f32x2_){g[d0 + 16], g[d0 + 17]}; } }
        else {
#pragma unroll
            for (int k = 0; k < 4; ++k) { GA[k] = (f32x2_){1.f, 1.f}; GB[k] = GA[k]; } }
        const float qs = (kind == 0) ? ATT_C2 : 1.f;
        const float* rtab = axial ? ropea : rope1;
        bf16* dst; int pitch;
        if (kind == 0) { dst = Q3 + (size_t)grp * T * 512 + hd * 64; pitch = 512; } else if (kind == 1) { dst = K3 + (size_t)grp * T * 128 + hd * 64; pitch = 128; } else { dst = V3 + (size_t)grp * T * 128 + hd * 64; pitch = 128; }
        const int row0 = u.pm * 256 + wr * 64 + fr;
#pragma unroll
        for (int ai = 0; ai < 2; ++ai)
#pragma unroll
          for (int mh = 0; mh < 2; ++mh) {
            f32x4 cs[2][4];
            if (rope) {
#pragma unroll
                for (int mm = 0; mm < 2; ++mm) { const int pos = (row0 + ai * 128 + (2 * mh + mm) * 16) & (SEQ - 1); const f32x4* cp = (const f32x4*)(rtab + ((size_t)pos * 32 + 8 * fq) * 2);
#pragma unroll
                    for (int k = 0; k < 4; ++k) cs[mm][k] = cp[k]; } }
#pragma unroll
            for (int mm = 0; mm < 2; ++mm) { const int m = 2 * mh + mm;
                const int r = row0 + ai * 128 + m * 16; const int pos = r & (SEQ - 1);
                const float rs = rsl[ai * 128 + m * 16];
                f32x2_ A[4], B[4];
#pragma unroll
                for (int n = 0; n < 2; ++n)
#pragma unroll
                    for (int p = 0; p < 2; ++p) { A[2 * n + p] = (f32x2_){acc[ai][0][m][n][2 * p], acc[ai][0][m][n][2 * p + 1]}; B[2 * n + p] = (f32x2_){acc[ai][1][m][n][2 * p], acc[ai][1][m][n][2 * p + 1]}; }
                float sc = rs * qs;
                if (norm) { f32x2_ q2 = A[0] * A[0];
#pragma unroll
                    for (int k = 1; k < 4; ++k) q2 = A[k] * A[k] + q2;
#pragma unroll
                    for (int k = 0; k < 4; ++k) q2 = B[k] * B[k] + q2;
                    float ss = q2.x + q2.y; ss += shx(ss, 16); ss += shx(ss, 32);
                    sc *= __builtin_amdgcn_rsqf(ss * (rs * rs) * (1.f / 64.f) + NORM_EPS);
#pragma unroll
                    for (int k = 0; k < 4; ++k) { A[k] = A[k] * GA[k]; B[k] = B[k] * GB[k]; } }
                if (rope) {
#pragma unroll
                    for (int k = 0; k < 4; ++k) { const f32x4 v = cs[mm][k]; const f32x2_ C = (f32x2_){v.x, v.y} * sc, S = (f32x2_){v.z, v.w} * sc;
                        const f32x2_ x1 = A[k], x2 = B[k]; A[k] = x1 * C - x2 * S; B[k] = x2 * C + x1 * S; } }
                else {
#pragma unroll
                    for (int k = 0; k < 4; ++k) { A[k] = A[k] * sc; B[k] = B[k] * sc; } }
                size_t drow = r;
                if (LAYER == 1) { const int sh = 2 * grp, bb = r >> 13; drow = (size_t)bb * SEQ + (size_t)(pos & ((1 << sh) - 1)) * (SEQ >> sh) + (pos >> sh); }
                bf16* dp = dst + drow * pitch + 8 * fq;
                pg8::u32x4 w0, w1;
                w0.x = pk2(A[0].x, A[0].y); w0.y = pk2(A[1].x, A[1].y); w0.z = pk2(A[2].x, A[2].y); w0.w = pk2(A[3].x, A[3].y);
                w1.x = pk2(B[0].x, B[0].y); w1.y = pk2(B[1].x, B[1].y); w1.z = pk2(B[2].x, B[2].y); w1.w = pk2(B[3].x, B[3].y);
                *(pg8::u32x4*)dp = w0; *(pg8::u32x4*)(dp + 32) = w1;
            }
            asm volatile("" ::: "memory");
        }
    }
};
struct EpiResBf16 {
    static constexpr bool PERM = true, AFTER_DRAIN = false;
    const bf16* R; bf16* O;
    __device__ __forceinline__ void operator()(const pg8::f32x4 (&acc)[2][2][4][2], const pg8::Unit& u, int wr, int wc, int fr, int fq) const {
        const int row0 = u.pm * 256 + wr * 64 + fr, col0 = u.pn * 256 + wc * 32 + 8 * fq;
#pragma unroll
        for (int ai = 0; ai < 2; ++ai) {
            v4u rr[4][2];
#pragma unroll
            for (int m = 0; m < 4; ++m)
#pragma unroll
                for (int bj = 0; bj < 2; ++bj) rr[m][bj] = *(const v4u*)(R + (size_t)(row0 + ai * 128 + m * 16) * D + col0 + bj * 128);
#pragma unroll
            for (int m = 0; m < 4; ++m) { const size_t ro = (size_t)(row0 + ai * 128 + m * 16) * D + col0;
#pragma unroll
                for (int bj = 0; bj < 2; ++bj) { const pg8::f32x4 v0 = acc[ai][bj][m][0], v1 = acc[ai][bj][m][1]; const v4u r4 = rr[m][bj];
                    pg8::u32x4 w; w.x = pk2(v0[0] + bflo(r4.x), v0[1] + bfhi(r4.x)); w.y = pk2(v0[2] + bflo(r4.y), v0[3] + bfhi(r4.y)); w.z = pk2(v1[0] + bflo(r4.z), v1[1] + bfhi(r4.z)); w.w = pk2(v1[2] + bflo(r4.w), v1[3] + bfhi(r4.w));
                    *(pg8::u32x4*)(O + ro + bj * 128) = w; } }
            asm volatile("" ::: "memory"); }
    }
};
__device__ __forceinline__ float sigmoidf_(float x) { return __builtin_amdgcn_rcpf(1.0f + __builtin_amdgcn_exp2f(-1.4426950408889634f * x)); }
__device__ __forceinline__ float swiglu1(float g, float l) {
    g = fminf(g, 7.0f); l = fminf(fmaxf(l, -7.0f), 7.0f);
    return g * sigmoidf_(1.702f * g) * (l + 1.0f);
}
__device__ __forceinline__ f32x2_ swiglu2(f32x2_ g, f32x2_ l) {
    g = __builtin_elementwise_min(g, (f32x2_){7.0f, 7.0f}); l = __builtin_elementwise_min(__builtin_elementwise_max(l, (f32x2_){-7.0f, -7.0f}), (f32x2_){7.0f, 7.0f});
    const f32x2_ t = g * (-1.702f * 1.4426950408889634f); f32x2_ e; e.x = __builtin_amdgcn_exp2f(t.x); e.y = __builtin_amdgcn_exp2f(t.y);
    const f32x2_ d = e + 1.0f; f32x2_ s; s.x = __builtin_amdgcn_rcpf(d.x); s.y = __builtin_amdgcn_rcpf(d.y);
    return (g * s) * (l + 1.0f);
}
template <bool F8> struct EpiSwiglu {
    static constexpr bool PERM = true, AFTER_DRAIN = false;
    void* ACT; const float* bup; const float* rsl;
    __device__ __forceinline__ void operator()(const pg8::f32x4 (&acc)[2][2][4][2], const pg8::Unit& u, int wr, int wc, int fr, int fq) const {
        const int e = u.pn >> 3, j = u.pn & 7; const int row0 = u.pm * 256 + wr * 64 + fr, a0 = j * 128 + wc * 32 + 8 * fq;
        const float* bp = bup + (size_t)e * 2048 + 2 * a0; pg8::f32x4 b[4];
#pragma unroll
        for (int i = 0; i < 4; ++i) b[i] = *(const pg8::f32x4*)(bp + 4 * i);
#pragma unroll
        for (int ai = 0; ai < 2; ++ai)
#pragma unroll
            for (int m = 0; m < 4; ++m) { const int r = row0 + ai * 128 + m * 16; const float rs = F8 ? F8_EPI_SC : rsl[r];
                const pg8::f32x4 g0 = acc[ai][0][m][0] * rs, g1 = acc[ai][0][m][1] * rs, l0 = acc[ai][1][m][0] * rs, l1 = acc[ai][1][m][1] * rs;
                float o[8];
                { const f32x2_ r0 = swiglu2((f32x2_){g0[0] + b[0][0], g0[1] + b[0][2]}, (f32x2_){l0[0] + b[0][1], l0[1] + b[0][3]}), r1 = swiglu2((f32x2_){g0[2] + b[1][0], g0[3] + b[1][2]}, (f32x2_){l0[2] + b[1][1], l0[3] + b[1][3]});
                  const f32x2_ r2 = swiglu2((f32x2_){g1[0] + b[2][0], g1[1] + b[2][2]}, (f32x2_){l1[0] + b[2][1], l1[1] + b[2][3]}), r3 = swiglu2((f32x2_){g1[2] + b[3][0], g1[3] + b[3][2]}, (f32x2_){l1[2] + b[3][1], l1[3] + b[3][3]});
                  o[0] = r0.x; o[1] = r0.y; o[2] = r1.x; o[3] = r1.y; o[4] = r2.x; o[5] = r2.y; o[6] = r3.x; o[7] = r3.y; }
                if (F8) { v2u w; w.x = pk4_fp8(o[0], o[1], o[2], o[3]); w.y = pk4_fp8(o[4], o[5], o[6], o[7]); *(v2u*)((unsigned char*)ACT + (size_t)r * DE + a0) = w; }
                else { pg8::u32x4 w; w.x = pk2(o[0], o[1]); w.y = pk2(o[2], o[3]); w.z = pk2(o[4], o[5]); w.w = pk2(o[6], o[7]); *(pg8::u32x4*)((bf16*)ACT + (size_t)r * DE + a0) = w; } }
    }
};
struct EpiNull {
    static constexpr bool PERM = true, AFTER_DRAIN = false;
    float* O;
    __device__ __forceinline__ void operator()(const pg8::f32x4 (&acc)[2][2][4][2], const pg8::Unit& u, int wr, int wc, int fr, int fq) const {
        pg8::f32x4 s = {0.f, 0.f, 0.f, 0.f};
#pragma unroll
        for (int ai = 0; ai < 2; ++ai)
#pragma unroll
            for (int bj = 0; bj < 2; ++bj)
#pragma unroll
                for (int m = 0; m < 4; ++m)
#pragma unroll
                    for (int n = 0; n < 2; ++n) s += acc[ai][bj][m][n];
        *(pg8::f32x4*)(O + (size_t)(threadIdx.x + 512 * (u.pm & 63)) * 4) = s;
    }
};
template <bool Y8> struct EpiDown {
    static constexpr bool PERM = true, AFTER_DRAIN = false;
    void* Y; const float* bdn; const float* gate; float asc;
    __device__ __forceinline__ void operator()(const pg8::f32x4 (&acc)[2][2][4][2], const pg8::Unit& u, int wr, int wc, int fr, int fq) const {
        const int e = u.pn >> 2, j = u.pn & 3; const int row0 = u.pm * 256 + wr * 64 + fr, col0 = j * 256 + wc * 32 + 8 * fq;
        pg8::f32x4 bv[2][2];
#pragma unroll
        for (int bj = 0; bj < 2; ++bj)
#pragma unroll
            for (int n = 0; n < 2; ++n) bv[bj][n] = *(const pg8::f32x4*)(bdn + (size_t)e * D + col0 + bj * 128 + 4 * n);
#pragma unroll
        for (int ai = 0; ai < 2; ++ai)
#pragma unroll
            for (int m = 0; m < 4; ++m) { const int r = row0 + ai * 128 + m * 16; const float gt = gate[r] * (Y8 ? Y_SC : 1.f);
#pragma unroll
                for (int bj = 0; bj < 2; ++bj) { const pg8::f32x4 v0 = (acc[ai][bj][m][0] * asc + bv[bj][0]) * gt, v1 = (acc[ai][bj][m][1] * asc + bv[bj][1]) * gt;
                    if (Y8) { v2u w; w.x = pk4_fp8(clamp448(v0[0]), clamp448(v0[1]), clamp448(v0[2]), clamp448(v0[3])); w.y = pk4_fp8(clamp448(v1[0]), clamp448(v1[1]), clamp448(v1[2]), clamp448(v1[3])); *(v2u*)((unsigned char*)Y + (size_t)r * D + col0 + bj * 128) = w; }
                    else { pg8::u32x4 w; w.x = pk2(v0[0], v0[1]); w.y = pk2(v0[2], v0[3]); w.z = pk2(v1[0], v1[1]); w.w = pk2(v1[2], v1[3]); *(pg8::u32x4*)((bf16*)Y + (size_t)r * D + col0 + bj * 128) = w; } } }
    }
};
struct EpiPle {
    static constexpr bool PERM = true, AFTER_DRAIN = false;
    const bf16* H2; const bf16* PP; bf16* H3; float* SS; unsigned char* H8;
    __device__ __forceinline__ void operator()(const pg8::f32x4 (&acc)[2][2][4][2], const pg8::Unit& u, int wr, int wc, int fr, int fq) const {
        const int row0 = u.pm * 256 + wr * 64 + fr, col0 = u.pn * 256 + wc * 32 + 8 * fq;
#pragma unroll
        for (int ai = 0; ai < 2; ++ai) {
            v4u hh[4][2], pp[4][2];
#pragma unroll
            for (int m = 0; m < 4; ++m)
#pragma unroll
                for (int bj = 0; bj < 2; ++bj) { const size_t o = (size_t)(row0 + ai * 128 + m * 16) * D + col0 + bj * 128; hh[m][bj] = *(const v4u*)(H2 + o); pp[m][bj] = *(const v4u*)(PP + o); }
#pragma unroll
            for (int m = 0; m < 4; ++m) { const int r = row0 + ai * 128 + m * 16; const size_t ro = (size_t)r * D + col0; float ss = 0.f;
#pragma unroll
                for (int bj = 0; bj < 2; ++bj) { const pg8::f32x4 a0 = acc[ai][bj][m][0], a1 = acc[ai][bj][m][1]; const v4u h = hh[m][bj], p = pp[m][bj];
                    pg8::u32x4 w;
                    w.x = pk2(bflo(h.x) + bflo(p.x) * sigmoidf_(a0[0]), bfhi(h.x) + bfhi(p.x) * sigmoidf_(a0[1])); w.y = pk2(bflo(h.y) + bflo(p.y) * sigmoidf_(a0[2]), bfhi(h.y) + bfhi(p.y) * sigmoidf_(a0[3]));
                    w.z = pk2(bflo(h.z) + bflo(p.z) * sigmoidf_(a1[0]), bfhi(h.z) + bfhi(p.z) * sigmoidf_(a1[1])); w.w = pk2(bflo(h.w) + bflo(p.w) * sigmoidf_(a1[2]), bfhi(h.w) + bfhi(p.w) * sigmoidf_(a1[3]));
                    *(pg8::u32x4*)(H3 + ro + bj * 128) = w;
                    if (H8) { v2u q; q.x = pk4_fp8(clamp448(bflo(w.x)), clamp448(bfhi(w.x)), clamp448(bflo(w.y)), clamp448(bfhi(w.y))); q.y = pk4_fp8(clamp448(bflo(w.z)), clamp448(bfhi(w.z)), clamp448(bflo(w.w)), clamp448(bfhi(w.w))); *(v2u*)(H8 + ro + bj * 128) = q; }
                    ss += (bflo(w.x) * bflo(w.x) + bfhi(w.x) * bfhi(w.x)) + (bflo(w.y) * bflo(w.y) + bfhi(w.y) * bfhi(w.y)) + (bflo(w.z) * bflo(w.z) + bfhi(w.z) * bfhi(w.z)) + (bflo(w.w) * bflo(w.w) + bfhi(w.w) * bfhi(w.w)); }
                ss += shx(ss, 16); ss += shx(ss, 32);
                if (fq == 0) SS[(size_t)r * 16 + u.pn * 4 + wc] = ss; }
            asm volatile("" ::: "memory"); }
    }
};
template <int LJ> struct XcdOrder {
    const int* tab; int rank, stride;
    __device__ __forceinline__ bool next(int i, pg8::Unit& u) const {
        const int q = i * stride + rank, p = q >> LJ, j = q & ((1 << LJ) - 1); const int ne = tab[0], tot = tab[1]; if (p >= tot) return false;
        int s = 0; while (s + 1 < ne && tab[4 + 4 * (s + 1) + 3] <= p) ++s;
        u.pm = tab[4 + 4 * s + 1] + (p - tab[4 + 4 * s + 3]); u.pn = (tab[4 + 4 * s] << LJ) + j; return true; }
    __device__ __forceinline__ void a_ready(const pg8::Unit&) const {}
    __device__ __forceinline__ void done(const pg8::Unit&) const {}
};
#include <hip/hip_bf16.h>
#include <cmath>
namespace attn_body {
using bf16=__hip_bfloat16;
using bf16x8=__attribute__((ext_vector_type(8)))short;
using s16x4=__attribute__((ext_vector_type(4)))short;
using f32x16=__attribute__((ext_vector_type(16)))float;
using u32x4=__attribute__((ext_vector_type(4)))unsigned;
constexpr int D=64,QP=512,KVP=128;
constexpr int NW=8,QBLK=32,QB=QBLK*NW,KVBLK=64;
constexpr int ATTN_UNIT_ROWS=QB;
__device__ __forceinline__ int crow(int r,int hi){return (r&3)+8*(r>>2)+4*hi;}
#define SBAR() __builtin_amdgcn_sched_barrier(0)
__device__ __forceinline__ void cmask(f32x16&p0,f32x16&p1,int jb,int qrel,int hi){
  const float NEG=-INFINITY; int kb=64*jb+4*hi;
  #pragma unroll
  for(int r=0;r<16;++r){int kv=kb+(r&3)+8*(r>>2); if(kv>qrel)p0[r]=NEG; if(kv+32>qrel)p1[r]=NEG;}
}

__device__ __forceinline__ void bmask(f32x16&p0,f32x16&p1,int t,int dqb,int W){
  const float NEG=-INFINITY; const int kb=64*t+dqb;
  #pragma unroll
  for(int r=0;r<16;++r){const int d=kb+(r&3)+8*(r>>2); if(d>W||d<-W)p0[r]=NEG; if(d+32>W||d+32<-W)p1[r]=NEG;}
}
constexpr int NSLOT=3, SLOTB=8192;
constexpr int LDS_K=0, LDS_V=NSLOT*SLOTB, LDS_WS=2*NSLOT*SLOTB, LDS_OST=LDS_WS+NW*64*4, LDS_BYTES=LDS_OST+NW*4096;
constexpr float C2=0.125f*1.4426950408889634f;
__device__ __forceinline__ void glds16(const void*gsrc,unsigned lds_dst){unsigned keep;
  asm volatile("s_mov_b32 %0, m0\n\ts_mov_b32 m0, %2\n\ts_nop 0\n\tglobal_load_lds_dwordx4 %1, off\n\ts_mov_b32 m0, %0":"=&s"(keep):"v"(gsrc),"s"(lds_dst):"memory");}
__device__ __forceinline__ float max3f(float a,float b,float c){float r;asm("v_max3_f32 %0, %1, %2, %3":"=v"(r):"v"(a),"v"(b),"v"(c));return r;}
__device__ __forceinline__ float max2f(float a,float b){float r;asm("v_max_f32_e32 %0, %1, %2":"=v"(r):"v"(a),"v"(b));return r;}
__device__ __forceinline__ float fadd_s(float a,float b){float r;asm("v_add_f32_e32 %0, %1, %2":"=v"(r):"v"(a),"v"(b));return r;}
__device__ __forceinline__ float fsub_s(float a,float b){float r;asm("v_sub_f32_e32 %0, %1, %2":"=v"(r):"v"(a),"v"(b));return r;}
typedef float f32x2_t __attribute__((ext_vector_type(2))); typedef __bf16 bf16x2_t __attribute__((ext_vector_type(2)));
__device__ __forceinline__ unsigned cvtpk_s(float lo,float hi){f32x2_t v={lo,hi};bf16x2_t b=__builtin_convertvector(v,bf16x2_t);return __builtin_bit_cast(unsigned,b);}
#define WAIT_BAR(N) asm volatile("s_waitcnt vmcnt(" #N ") lgkmcnt(0)\n\ts_barrier":::"memory")

__device__ __forceinline__ void qkt(f32x16&p0,f32x16&p1,const char*Kslot,const bf16x8*qr,const f32x16&negm,int r32,int hi){
  const char*kb=Kslot+hi*1024+r32*16;
  #pragma unroll
  for(int d0=0;d0<4;++d0){
    const bf16x8 b0=*reinterpret_cast<const bf16x8*>(kb+d0*2048);
    const bf16x8 b1=*reinterpret_cast<const bf16x8*>(kb+d0*2048+512);
    if(d0==0){p0=__builtin_amdgcn_mfma_f32_32x32x16_bf16(b0,qr[0],negm,0,0,0);p1=__builtin_amdgcn_mfma_f32_32x32x16_bf16(b1,qr[0],negm,0,0,0);}
    else{p0=__builtin_amdgcn_mfma_f32_32x32x16_bf16(b0,qr[d0],p0,0,0,0);p1=__builtin_amdgcn_mfma_f32_32x32x16_bf16(b1,qr[d0],p1,0,0,0);}}
}
typedef __attribute__((address_space(3))) const char* lds_cptr;
typedef short v4i16_t __attribute__((ext_vector_type(4)));
__device__ __forceinline__ void kload8(bf16x8*kf,lds_cptr kp){
  kf[0]=*(const __attribute__((address_space(3))) bf16x8*)(kp);      kf[1]=*(const __attribute__((address_space(3))) bf16x8*)(kp+512);
  kf[2]=*(const __attribute__((address_space(3))) bf16x8*)(kp+2048); kf[3]=*(const __attribute__((address_space(3))) bf16x8*)(kp+2560);
  kf[4]=*(const __attribute__((address_space(3))) bf16x8*)(kp+4096); kf[5]=*(const __attribute__((address_space(3))) bf16x8*)(kp+4608);
  kf[6]=*(const __attribute__((address_space(3))) bf16x8*)(kp+6144); kf[7]=*(const __attribute__((address_space(3))) bf16x8*)(kp+6656);
}
__device__ __forceinline__ void kload2(bf16x8*kf,lds_cptr kp,int j){ kf[2*j]=*(const __attribute__((address_space(3))) bf16x8*)(kp+j*2048); kf[2*j+1]=*(const __attribute__((address_space(3))) bf16x8*)(kp+j*2048+512); }
__device__ __forceinline__ s16x4 vtr(lds_cptr p){ return __builtin_bit_cast(s16x4,__builtin_amdgcn_ds_read_tr16_b64_v4i16((__attribute__((address_space(3))) v4i16_t*)p)); }
__device__ __forceinline__ float rowmax(const f32x16&p0,const f32x16&p1){
  float a=max3f(p0[0],p0[1],p1[0]),b=max3f(p0[2],p0[3],p1[1]);a=max3f(a,p1[2],p1[3]);
  #pragma unroll
  for(int r=4;r<16;r+=4){a=max3f(a,p0[r],p0[r+1]);b=max3f(b,p0[r+2],p0[r+3]);a=max3f(a,p1[r],p1[r+1]);b=max3f(b,p1[r+2],p1[r+3]);}
  const float m=max2f(a,b);
  auto rr=__builtin_amdgcn_permlane32_swap(__float_as_uint(m),__float_as_uint(m),false,false);
  return max2f(__uint_as_float(rr[0]),__uint_as_float(rr[1]));
}
__device__ __forceinline__ void pv(f32x16*o,int vb,bf16x8 pa0,bf16x8 pa1,bf16x8 pa2,bf16x8 pa3){
  #pragma unroll
  for(int d0=0;d0<2;++d0){s16x4 lo[4],hi[4];
    #pragma unroll
    for(int ks=0;ks<4;++ks){
      asm volatile("ds_read_b64_tr_b16 %0,%1 offset:%c2":"=&v"(lo[ks]):"v"(vb),"i"(d0*4096+ks*1024):"memory");
      asm volatile("ds_read_b64_tr_b16 %0,%1 offset:%c2":"=&v"(hi[ks]):"v"(vb),"i"(d0*4096+ks*1024+512):"memory");}
    asm volatile("s_waitcnt lgkmcnt(0)":::"memory");SBAR();
    #define PK(k) (bf16x8){lo[k][0],lo[k][1],lo[k][2],lo[k][3],hi[k][0],hi[k][1],hi[k][2],hi[k][3]}
    o[d0]=__builtin_amdgcn_mfma_f32_32x32x16_bf16(pa0,PK(0),o[d0],0,0,0);
    o[d0]=__builtin_amdgcn_mfma_f32_32x32x16_bf16(pa1,PK(1),o[d0],0,0,0);
    o[d0]=__builtin_amdgcn_mfma_f32_32x32x16_bf16(pa2,PK(2),o[d0],0,0,0);
    o[d0]=__builtin_amdgcn_mfma_f32_32x32x16_bf16(pa3,PK(3),o[d0],0,0,0);
    #undef PK
  }
}

#ifndef ATTN_STORE16
#define ATTN_STORE16(p,v) (*(u32x4*)(p)=(v))
#endif
template<int MODE,int OP,int THRL,int HPU=1> __device__ __forceinline__ void attn_unit(const bf16*Qu,const bf16*__restrict__ Ku,const bf16*__restrict__ Vu,bf16*Ou,int NT,int dq0,int W,float sinkl2,bool has_sink,float*lse,char*shm){
  int tid_=threadIdx.x; asm volatile("":"+v"(tid_));
  const int tid=tid_,lane=tid&63,r32=lane&31,hi=lane>>5; const int wid=__builtin_amdgcn_readfirstlane(tid>>6);
  const int wh=(HPU==1)?0:wid/(8/HPU), wrow=(HPU==1)?wid:wid%(8/HPU);
  const bf16*Qw=Qu+(long)(wrow*QBLK)*QP+wh*D;
  const unsigned lds0=(unsigned)(uintptr_t)shm;
  float*wsf=(float*)(shm+LDS_WS)+wid*64;
  const bf16*ksrc=Ku+(long)lane*KVP+wid*8;
  const bf16*vsrc=Vu+(long)(16*(wid&3)+(lane>>2))*KVP+(wid>>2)*32+(lane&3)*8;
  const unsigned kdst=lds0+LDS_K+wid*1024, vdst=lds0+LDS_V+wid*1024;
  #define DMA_K(t,slot) glds16(ksrc+(long)(t)*KVBLK*KVP,(unsigned)__builtin_amdgcn_readfirstlane(kdst+(slot)))
  #define DMA_V(t,slot) glds16(vsrc+(long)(t)*KVBLK*KVP,(unsigned)__builtin_amdgcn_readfirstlane(vdst+(slot)))
  const int vb0=(int)(lds0+LDS_V)+((lane>>4)&1)*32+(lane&3)*8+(4*hi+((lane&15)>>2))*64;
  const char*Kbase=shm+LDS_K; bf16x8 kf[8];
  const lds_cptr shm3=(lds_cptr)shm; const lds_cptr kp0=shm3+LDS_K+hi*1024+r32*16; const lds_cptr vp0=shm3+LDS_V+((lane>>4)&1)*32+(lane&3)*8+(4*hi+((lane&15)>>2))*64;
  DMA_K(0,0);DMA_V(0,0);DMA_K(1,SLOTB);
  bf16x8 qr[4];
  #pragma unroll
  for(int d0=0;d0<4;++d0)qr[d0]=*reinterpret_cast<const bf16x8*>(&Qw[(long)r32*QP+d0*16+hi*8]);
  float mhat=(MODE==2)?sinkl2:0.f,l_reg=0.f;f32x16 o[2];o[0]=f32x16{};o[1]=f32x16{};f32x16 negm=f32x16{};
  if(MODE==2){ _Pragma("unroll") for(int r=0;r<16;++r)negm[r]=-mhat; }
  asm volatile("":"+v"(negm));
  const int dqb=dq0-(wrow*QBLK+r32)+4*hi;
  #define CMASK(P0,P1,t) do{ if(MODE==1) bmask(P0,P1,(t),dqb,W); }while(0)
  bool resc=false;
  #define START(P0,P1) do{ resc=false; if(MODE!=2){ float rm=rowmax(P0,P1); if(MODE==1) rm=fmaxf(rm,-60.f); \
      const float dl=rm; mhat=fadd_s(mhat,dl); \
      _Pragma("unroll") for(int r=0;r<16;++r){P0[r]=fsub_s(P0[r],dl);P1[r]=fsub_s(P1[r],dl);} \
      _Pragma("unroll") for(int r=0;r<16;++r)negm[r]=-mhat; asm volatile("":"+v"(negm)); } \
    _Pragma("unroll") for(int r=0;r<16;++r)P0[r]=__builtin_amdgcn_exp2f(P0[r]); }while(0)
  #define RESC() do{ if(resc){ asm volatile("s_waitcnt lgkmcnt(0)":::"memory"); \
      _Pragma("unroll") for(int d_=0;d_<2;++d_) _Pragma("unroll") for(int r=0;r<16;++r)o[d_][r]*=wsf[crow(r,hi)]; } }while(0)
  f32x16 pA0,pA1,pB0,pB1;
  int sl_prev=0,sl_cur=0,sl_next=SLOTB;
  #define ROT() do{sl_prev=sl_cur;sl_cur=sl_next;sl_next=(sl_next==(NSLOT-1)*SLOTB)?0:sl_next+SLOTB;}while(0)
  DMA_K(2,2*SLOTB);
  WAIT_BAR(3);
  qkt(pA0,pA1,Kbase,qr,negm,r32,hi);asm volatile("s_nop 15\n\ts_nop 7":"+v"(pA0),"+v"(pA1));CMASK(pA0,pA1,0);
  START(pA0,pA1);
  _Pragma("unroll") for(int r=0;r<16;++r)pA1[r]=__builtin_amdgcn_exp2f(pA1[r]);
  WAIT_BAR(0);
  DMA_K(3,0);DMA_V(1,SLOTB);
  ROT();
  kload8(kf,kp0+sl_cur);
  WAIT_BAR(2);
  s16x4 vlo[8],vhi[8]; u32x4 pw0,pw1,pw2,pw3;
  #define PKW(P,B) cvtpk_s(P[B],P[B+1])
  #define PAF(k) __builtin_bit_cast(bf16x8,pw##k)
  #define VFR(i) (bf16x8){vlo[i][0],vlo[i][1],vlo[i][2],vlo[i][3],vhi[i][0],vhi[i][1],vhi[i][2],vhi[i][3]}
  #define PIN(x) asm volatile("":"+v"(x))
  #define MX3(a,b,c) __builtin_fmaxf(__builtin_fmaxf((a),(b)),(c))
  #define GAPA(MF,A0,A1,A2,A3,W0,W1,PW) do{ MF; sacc+=A0; sacc+=A1; sacc+=A2; sacc+=A3; PIN(sacc); W0; W1; PIN(PW); SBAR(); }while(0)
  #define EX(v) __builtin_amdgcn_exp2f(v)
  #define GAPB(MF,X,B) do{ MF; X[B]=EX(X[B]); X[B+1]=EX(X[B+1]); X[B+2]=EX(X[B+2]); X[B+3]=EX(X[B+3]); PIN(X); SBAR(); }while(0)
  #define VRD(i) do{ vlo[i]=vtr(vp_+(((i)>>2)*4096+((i)&3)*1024)); vhi[i]=vtr(vp_+(((i)>>2)*4096+((i)&3)*1024+512)); }while(0)
  #define KRD(G,j) do{ if(G){ kload2(kf,kp0+sl_next,j); SBAR(); } }while(0)
  #define STEP(C0,C1,P0,P1,t,GK,GV,GL) do{ SBAR(); \
    const lds_cptr vp_=vp0+sl_prev; \
    VRD(0); SBAR(); float sacc=(P0[0]+P0[1]); \
    GAPA(C0=__builtin_amdgcn_mfma_f32_32x32x16_bf16(kf[0],qr[0],negm,0,0,0), P0[2],P0[3],P0[4],P0[5],     pw0[0]=PKW(P0,0), pw0[1]=PKW(P0,2), pw0); \
    VRD(4); SBAR(); GAPA(C1=__builtin_amdgcn_mfma_f32_32x32x16_bf16(kf[1],qr[0],negm,0,0,0), P0[6],P0[7],P0[8],P0[9],     pw0[2]=PKW(P0,4), pw0[3]=PKW(P0,6), pw0); \
    VRD(1); SBAR(); GAPA(C0=__builtin_amdgcn_mfma_f32_32x32x16_bf16(kf[2],qr[1],C0,0,0,0),   P0[10],P0[11],P0[12],P0[13], pw1[0]=PKW(P0,8), pw1[1]=PKW(P0,10), pw1); \
    VRD(5); SBAR(); GAPA(C1=__builtin_amdgcn_mfma_f32_32x32x16_bf16(kf[3],qr[1],C1,0,0,0),   P0[14],P0[15],P1[0],P1[1],   pw1[2]=PKW(P0,12),pw1[3]=PKW(P0,14), pw1); \
    VRD(2); SBAR(); GAPA(C0=__builtin_amdgcn_mfma_f32_32x32x16_bf16(kf[4],qr[2],C0,0,0,0),   P1[2],P1[3],P1[4],P1[5],     pw2[0]=PKW(P1,0), pw2[1]=PKW(P1,2), pw2); \
    VRD(6); SBAR(); GAPA(C1=__builtin_amdgcn_mfma_f32_32x32x16_bf16(kf[5],qr[2],C1,0,0,0),   P1[6],P1[7],P1[8],P1[9],     pw2[2]=PKW(P1,4), pw2[3]=PKW(P1,6), pw2); \
    VRD(3); SBAR(); GAPA(C0=__builtin_amdgcn_mfma_f32_32x32x16_bf16(kf[6],qr[3],C0,0,0,0),   P1[10],P1[11],P1[12],P1[13], pw3[0]=PKW(P1,8), pw3[1]=PKW(P1,10), pw3); \
    VRD(7); SBAR(); GAPA(C1=__builtin_amdgcn_mfma_f32_32x32x16_bf16(kf[7],qr[3],C1,0,0,0),   P1[14],P1[15],0.f,0.f,       pw3[2]=PKW(P1,12),pw3[3]=PKW(P1,14), pw3); \
    l_reg+=sacc; \
    if(GK){DMA_K((t)+3,sl_cur);} if(GV){DMA_V((t)+1,sl_next);} \
    CMASK(C0,C1,t); \
    if(MODE!=2){ float a=MX3(C0[0],C0[1],C1[0]),b=MX3(C0[2],C0[3],C1[1]); a=MX3(a,C1[2],C1[3]); \
      _Pragma("unroll") for(int r=4;r<16;r+=4){a=MX3(a,C0[r],C0[r+1]);b=MX3(b,C0[r+2],C0[r+3]);a=MX3(a,C1[r],C1[r+1]);b=MX3(b,C1[r+2],C1[r+3]);} \
      float rm=__builtin_fmaxf(a,b); { auto rr=__builtin_amdgcn_permlane32_swap(__float_as_uint(rm),__float_as_uint(rm),false,false); rm=__builtin_fmaxf(__uint_as_float(rr[0]),__uint_as_float(rr[1])); } \
      resc=false; \
      if(__builtin_expect(__any(rm>(float)THRL),0)){ const float dl=__builtin_fmaxf(rm,0.f); mhat+=dl; \
        _Pragma("unroll") for(int r=0;r<16;++r){C0[r]-=dl;C1[r]-=dl;} \
        _Pragma("unroll") for(int r=0;r<16;++r)negm[r]=-mhat; asm volatile("":"+v"(negm)); \
        const float f=__builtin_amdgcn_exp2f(-dl); l_reg*=f; if(hi==0)wsf[r32]=f; resc=true; } } \
    SBAR(); \
    GAPB(o[0]=__builtin_amdgcn_mfma_f32_32x32x16_bf16(PAF(0),VFR(0),o[0],0,0,0), C0,0); \
    GAPB(o[1]=__builtin_amdgcn_mfma_f32_32x32x16_bf16(PAF(0),VFR(4),o[1],0,0,0), C0,4); \
    KRD(GL,0); GAPB(o[0]=__builtin_amdgcn_mfma_f32_32x32x16_bf16(PAF(1),VFR(1),o[0],0,0,0), C0,8); \
    KRD(GL,1); GAPB(o[1]=__builtin_amdgcn_mfma_f32_32x32x16_bf16(PAF(1),VFR(5),o[1],0,0,0), C0,12); \
    KRD(GL,2); GAPB(o[0]=__builtin_amdgcn_mfma_f32_32x32x16_bf16(PAF(2),VFR(2),o[0],0,0,0), C1,0); \
    KRD(GL,3); GAPB(o[1]=__builtin_amdgcn_mfma_f32_32x32x16_bf16(PAF(2),VFR(6),o[1],0,0,0), C1,4); \
    GAPB(o[0]=__builtin_amdgcn_mfma_f32_32x32x16_bf16(PAF(3),VFR(3),o[0],0,0,0), C1,8); \
    GAPB(o[1]=__builtin_amdgcn_mfma_f32_32x32x16_bf16(PAF(3),VFR(7),o[1],0,0,0), C1,12); \
    }while(0)
  int t=1;
  for(;t+5<NT;t+=2){
    STEP(pB0,pB1,pA0,pA1,t,true,true,true);     WAIT_BAR(2); RESC(); ROT();
    STEP(pA0,pA1,pB0,pB1,t+1,true,true,true);   WAIT_BAR(2); RESC(); ROT();
  }
  #define ENDW(tt) do{ if((tt)+3<NT){WAIT_BAR(2);} else if((tt)+2<NT){WAIT_BAR(1);} else {WAIT_BAR(0);} }while(0)
  for(;t+1<NT;t+=2){
    STEP(pB0,pB1,pA0,pA1,t,(t+3<NT),(t+1<NT),(t+1<NT));       ENDW(t);   RESC(); ROT();
    STEP(pA0,pA1,pB0,pB1,t+1,(t+4<NT),(t+2<NT),(t+2<NT));     ENDW(t+1); RESC(); ROT();
  }
  STEP(pB0,pB1,pA0,pA1,NT-1,false,false,false); RESC();
  { float sacc=pB0[0]+pB0[1]; _Pragma("unroll") for(int r=2;r<16;++r)sacc+=pB0[r]; _Pragma("unroll") for(int r=0;r<16;++r)sacc+=pB1[r]; l_reg+=sacc;
    pw0=(u32x4){PKW(pB0,0),PKW(pB0,2),PKW(pB0,4),PKW(pB0,6)};pw1=(u32x4){PKW(pB0,8),PKW(pB0,10),PKW(pB0,12),PKW(pB0,14)};pw2=(u32x4){PKW(pB1,0),PKW(pB1,2),PKW(pB1,4),PKW(pB1,6)};pw3=(u32x4){PKW(pB1,8),PKW(pB1,10),PKW(pB1,12),PKW(pB1,14)};
    SBAR(); pv(o,vb0+sl_cur,PAF(0),PAF(1),PAF(2),PAF(3)); }
  #undef PKW
  #undef PAF
  #undef VFR
  #undef PIN
  #undef MX3
  #undef GAPA
  #undef GAPB
  #undef EX
  #undef VRD
  #undef KRD
  #undef STEP
  #undef ENDW
  {auto rr=__builtin_amdgcn_permlane32_swap(__float_as_uint(l_reg),__float_as_uint(l_reg),false,false);l_reg=__uint_as_float(rr[0])+__uint_as_float(rr[1]);}
  if(MODE==1){ if(has_sink) l_reg+=__builtin_amdgcn_exp2f(sinkl2-mhat); if(lse!=nullptr&&hi==0) lse[(long)(wrow*QBLK+r32)*8+wh]=0.6931471805599453f*(mhat+__builtin_amdgcn_logf(l_reg)); }
  if(hi==0)wsf[32+r32]=l_reg;asm volatile("s_waitcnt lgkmcnt(0)":::"memory");
  float rli[16];
  #pragma unroll
  for(int r=0;r<16;++r)rli[r]=__builtin_amdgcn_rcpf(wsf[32+crow(r,hi)]);
  bf16*Ow=Ou+(long)(wrow*QBLK)*OP+wh*D;
  { bf16*stg=(bf16*)(shm+LDS_OST)+wid*2048;
    #pragma unroll
    for(int r=0;r<16;++r){const int orow=crow(r,hi);
      #pragma unroll
      for(int d0=0;d0<2;++d0)stg[orow*64+d0*32+r32]=__float2bfloat16(o[d0][r]*rli[r]);}
    asm volatile("s_waitcnt lgkmcnt(0)":::"memory");
    #pragma unroll
    for(int i=0;i<4;++i){const int row=i*8+(lane>>3),ch=lane&7; const u32x4 v=*(const u32x4*)(stg+row*64+ch*8); ATTN_STORE16(Ow+(long)row*OP+ch*8,v);} }
  asm volatile("s_waitcnt lgkmcnt(0)\n\ts_barrier":::"memory");
  #undef DMA_K
  #undef DMA_V
  #undef CMASK
  #undef START
  #undef RESC
  #undef ROT
}
constexpr int ATTN_LDS_BYTES=LDS_BYTES;
#undef SBAR
#undef WAIT_BAR
}
#define XB_TMO      128
#define XB_XCNT(j)  (256  + 64 * (j))
#define XB_XSUB(j)  (1280 + 64 * (j))
#define XB_XGEN(j)  (2304 + 64 * (j))
#define XB_TOP      3328
#define XB_TOPGEN   3392
#define XCD_BAR_WORDS 3456
#define XB_SPIN_CAP (1u << 18)

__device__ __forceinline__ unsigned xb_ld(unsigned* p)              { return __hip_atomic_load(p, __ATOMIC_RELAXED, __HIP_MEMORY_SCOPE_AGENT); }
__device__ __forceinline__ unsigned xb_add(unsigned* p, unsigned v) { return __hip_atomic_fetch_add(p, v, __ATOMIC_RELAXED, __HIP_MEMORY_SCOPE_AGENT); }
__device__ __forceinline__ unsigned xb_xcc_id() { return (unsigned)__builtin_amdgcn_s_getreg((3 << 11) | 20) & 0xFu; }
#define XB_SPIN(cond, bar) do { unsigned _sp = 0; while (cond) { __builtin_amdgcn_s_sleep(1); \
    if ((++_sp & 255u) == 0u) { if (xb_ld(&(bar)[XB_TMO])) break; if (_sp > XB_SPIN_CAP) { atomicAdd(&(bar)[XB_TMO], 1u); break; } } } } while (0)

struct XcdBarrier {
    unsigned* bar; unsigned x;
    volatile LAS unsigned* st;
};

__device__ __forceinline__ XcdBarrier xcd_barrier_post(unsigned* bar, volatile LAS unsigned* st) {
    XcdBarrier b; b.bar = bar; b.x = xb_xcc_id(); b.st = st;
    if (threadIdx.x == 0) (void)xb_add(&bar[XB_XCNT(b.x)], 1u);
    return b;
}
__device__ __forceinline__ void xcd_barrier_complete(unsigned* bar, unsigned x, unsigned& nloc, unsigned& nx) {
    const unsigned G = gridDim.x * gridDim.y * gridDim.z;
    unsigned sum, cnt, mine, sp = 0u;
    for (;;) {
        sum = 0u; cnt = 0u; mine = 0u;
#pragma unroll
        for (unsigned j = 0; j < 16; ++j) { const unsigned c = xb_ld(&bar[XB_XCNT(j)]); sum += c; cnt += (c > 0u) ? 1u : 0u; mine = (j == x) ? c : mine; }
        if (sum == G) break;
        __builtin_amdgcn_s_sleep(1);
        if ((++sp & 255u) == 0u) { if (xb_ld(&bar[XB_TMO])) break; if (sp > XB_SPIN_CAP) { atomicAdd(&bar[XB_TMO], 1u); break; } }
    }
    nloc = mine > 0u ? mine : 1u; nx = cnt > 0u ? cnt : 1u;
}

__device__ __forceinline__ void xcd_barrier(const XcdBarrier& b) {
    asm volatile("s_waitcnt vmcnt(0)" ::: "memory");
    __syncthreads();
    if (threadIdx.x == 0) {
        unsigned* bar = b.bar;
        __builtin_amdgcn_s_waitcnt(0);
        unsigned nloc = b.st[0], nx = b.st[1];
        if (nloc == 0u) { xcd_barrier_complete(bar, b.x, nloc, nx); b.st[0] = nloc; b.st[1] = nx; }
        const unsigned old = xb_add(&bar[XB_XSUB(b.x)], 1u);
        const unsigned gen = old / nloc;
        if (old + 1u == (gen + 1u) * nloc) {
            __builtin_amdgcn_fence(__ATOMIC_RELEASE, "agent");
            asm volatile("s_waitcnt vmcnt(0)" ::: "memory");
            const unsigned og = xb_add(&bar[XB_TOP], 1u);
            const unsigned tg = og / nx;
            if (og + 1u == (tg + 1u) * nx) xb_add(&bar[XB_TOPGEN], 1u);
            else XB_SPIN(xb_ld(&bar[XB_TOPGEN]) == tg, bar);
            __builtin_amdgcn_fence(__ATOMIC_ACQUIRE, "agent");
            xb_add(&bar[XB_XGEN(b.x)], 1u);
            asm volatile("s_waitcnt vmcnt(0)" ::: "memory");
        } else {
            XB_SPIN(xb_ld(&bar[XB_XGEN(b.x)]) == gen, bar);
            __builtin_amdgcn_fence(__ATOMIC_ACQUIRE, "agent");
            asm volatile("s_waitcnt vmcnt(0)" ::: "memory");
        }
    }
    __syncthreads();
}

struct Frame {
    LAS unsigned char* lds;
    volatile LAS unsigned* MISC;
    gu32* ctl;
    int tid, lane, wave, vcu, G, bx;
    int gw, NGW;
};
__device__ __forceinline__ bool refresh(Frame& F) {
    int t = threadIdx.x; asm volatile("" : "+v"(t)); F.tid = t; F.lane = t & 63; F.wave = __builtin_amdgcn_readfirstlane(t >> 6);
    int bx = blockIdx.x, G = gridDim.x; asm volatile("" : "+s"(bx), "+s"(G)); F.bx = bx; F.G = G;
    F.vcu = (G % 8 == 0) ? (bx % 8) * (G / 8) + bx / 8 : bx; F.gw = F.vcu * NWAVES + F.wave; F.NGW = G * NWAVES; return true; }
__device__ __forceinline__ float wave_sum(float v) {
#pragma unroll
    for (int o = 1; o < 64; o <<= 1) v += shx(v, o);
    return v;
}
template <int MAP> __device__ __forceinline__ int rowmap(int n) {
    if (MAP == 1) { const int f = n >> 1; return 256 * (f >> 7) + 128 * (n & 1) + (f & 127); }
    if (MAP == 2 || MAP == 3) { const int tl = n >> 8, hh = (n >> 6) & 3, d = n & 63; int bj, j;
        const bool axial = (MAP == 2) && (tl < 2 || (tl == 2 && hh < 2));
        if (axial) { bj = (d >> 4) & 1; j = (d & 15) + ((d >> 5) << 4); } else { bj = d >> 5; j = d & 31; }
        return 256 * tl + 128 * bj + 32 * hh + j; }
    return n; }
struct TrTile { const float* W; bf16* WT; const float* gain; int K, N, k0, n0; };
__device__ __forceinline__ void tr_load(const TrTile& t, f32x4 (&v)[16], int lane) {
    const float* src = t.W + (size_t)(t.k0 + (lane >> 4)) * t.N + t.n0 + 4 * (lane & 15);
#pragma unroll
    for (int i = 0; i < 16; ++i) v[i] = __builtin_nontemporal_load((const f32x4*)(src + (size_t)(4 * i) * t.N));
}
template <int MAP> __device__ __forceinline__ void tr_store(const TrTile& t, f32x4 (&v)[16], LAS float* scr, int lane) {
    const int lr = lane >> 4, lc = lane & 15;
    if (t.gain) {
#pragma unroll
        for (int i = 0; i < 16; ++i) v[i] *= t.gain[t.k0 + 4 * i + lr]; }
#pragma unroll
    for (int i = 0; i < 16; ++i) { LAS float* p = scr + (4 * i + lr) * 65 + 4 * lc; p[0] = v[i].x; p[1] = v[i].y; p[2] = v[i].z; p[3] = v[i].w; }
    LDS_WAIT(); asm volatile("" ::: "memory");
    const int c = lane & 7;
#pragma unroll
    for (int j = 0; j < 8; ++j) { const int n = 8 * j + (lane >> 3); const LAS float* s = scr + (8 * c) * 65 + n;
        v4u o; o.x = pk2(s[0 * 65], s[1 * 65]); o.y = pk2(s[2 * 65], s[3 * 65]); o.z = pk2(s[4 * 65], s[5 * 65]); o.w = pk2(s[6 * 65], s[7 * 65]);
        *(GAS v4u*)(t.WT + (size_t)rowmap<MAP>(t.n0 + n) * t.K + t.k0 + 8 * c) = o; }
    LDS_WAIT(); asm volatile("" ::: "memory");
}
template <int MAP> __device__ __forceinline__ void transpose_family(Frame& F, const float* W, size_t sW, bf16* WT, size_t sWT, const float* gain, int sG, int K, int N, int nmat, int gdiv) {
    LAS float* scr = (LAS float*)(F.lds + RING_OFF) + F.wave * (128 * 33);
    const int nb = N / 64, per = (K / 64) * nb, total = per * nmat;
    f32x4 va[16], vb[16];
    int it = F.gw; if (it >= total) return;
    TrTile ta, tb;
#define TR_SETUP(tt, item) do { const int mi = (item) / per, r = (item) % per; tt.W = W + (size_t)mi * sW; tt.WT = WT + (size_t)mi * sWT; tt.gain = gain ? gain + (size_t)(mi / gdiv) * sG : nullptr; tt.K = K; tt.N = N; tt.k0 = 64 * (r / nb); tt.n0 = 64 * (r % nb); } while (0)
    TR_SETUP(ta, it); tr_load(ta, va, F.lane);
    for (;;) {
        const int it2 = it + F.NGW; const bool h2 = it2 < total;
        if (h2) { TR_SETUP(tb, it2); tr_load(tb, vb, F.lane); }
        tr_store<MAP>(ta, va, scr, F.lane);
        if (!h2) break;
        const int it3 = it2 + F.NGW; const bool h3 = it3 < total;
        if (h3) { TR_SETUP(ta, it3); tr_load(ta, va, F.lane); }
        tr_store<MAP>(tb, vb, scr, F.lane);
        if (!h3) break;
        it = it3;
    }
#undef TR_SETUP
}
__device__ __forceinline__ void tr8_load(const TrTile& t, f32x4 (&v)[16], int lane) {
    const float* src = t.W + (size_t)(t.k0 + (lane >> 3)) * t.N + t.n0 + 4 * (lane & 7);
#pragma unroll
    for (int i = 0; i < 16; ++i) v[i] = __builtin_nontemporal_load((const f32x4*)(src + (size_t)(8 * i) * t.N));
}
template <int MAP> __device__ __forceinline__ void tr8_store(const TrTile& t, f32x4 (&v)[16], LAS float* scr, int lane) {
    const int lr = lane >> 3, lc = lane & 7; const float sc = (float)(1 << F8_WSC);
#pragma unroll
    for (int i = 0; i < 16; ++i) { const float g = t.gain ? t.gain[t.k0 + 8 * i + lr] * sc : sc;
        *(LAS f32x4*)(scr + (8 * i + lr) * 32 + ((lc ^ ((i >> 1) & 7)) << 2)) = v[i] * g; }
    LDS_WAIT(); asm volatile("" ::: "memory");
    const int c = lane & 7, nr = lane >> 3;
#pragma unroll
    for (int j = 0; j < 4; ++j) { const int n = 8 * j + nr; const LAS float* s = scr + (16 * c) * 32 + ((((n >> 2) ^ c) & 7) << 2) + (n & 3);
        v4u o; o.x = pk4_fp8(s[0 * 32], s[1 * 32], s[2 * 32], s[3 * 32]); o.y = pk4_fp8(s[4 * 32], s[5 * 32], s[6 * 32], s[7 * 32]); o.z = pk4_fp8(s[8 * 32], s[9 * 32], s[10 * 32], s[11 * 32]); o.w = pk4_fp8(s[12 * 32], s[13 * 32], s[14 * 32], s[15 * 32]);
        *(GAS v4u*)((unsigned char*)t.WT + (size_t)rowmap<MAP>(t.n0 + n) * t.K + t.k0 + 16 * c) = o; }
    LDS_WAIT(); asm volatile("" ::: "memory");
}
template <int MAP> __device__ __forceinline__ void transpose_family_f8(Frame& F, const float* W, size_t sW, unsigned char* WT, size_t sWT, const float* gain, int sG, int K, int N, int nmat, int gdiv) {
    LAS float* scr = (LAS float*)(F.lds + RING_OFF) + F.wave * (128 * 33);
    const int nb = N / 32, per = (K / 128) * nb, total = per * nmat;
    f32x4 va[16], vb[16];
    int it = F.gw; if (it >= total) return;
    TrTile ta, tb;
#define TR_SETUP(tt, item) do { const int mi = (item) / per, r = (item) % per; tt.W = W + (size_t)mi * sW; tt.WT = (bf16*)(WT + (size_t)mi * sWT); tt.gain = gain ? gain + (size_t)(mi / gdiv) * sG : nullptr; tt.K = K; tt.N = N; tt.k0 = 128 * (r / nb); tt.n0 = 32 * (r % nb); } while (0)
    TR_SETUP(ta, it); tr8_load(ta, va, F.lane);
    for (;;) {
        const int it2 = it + F.NGW; const bool h2 = it2 < total;
        if (h2) { TR_SETUP(tb, it2); tr8_load(tb, vb, F.lane); }
        tr8_store<MAP>(ta, va, scr, F.lane);
        if (!h2) break;
        const int it3 = it2 + F.NGW; const bool h3 = it3 < total;
        if (h3) { TR_SETUP(ta, it3); tr8_load(ta, va, F.lane); }
        tr8_store<MAP>(tb, vb, scr, F.lane);
        if (!h3) break;
        it = it3;
    }
#undef TR_SETUP
}
__device__ __forceinline__ float rope_freq(int i, int half_dim) { return exp2f(-(float)i / (float)half_dim * LOG2_THETA); }

__device__ __forceinline__ void attn_phase_l0(Frame& F, const bf16* Q3, const bf16* K3, const bf16* V3, bf16* OCAT, const float* sink, const float* qg, const float* kg) {
    char* shm = (char*)(F.lds + RING_OFF);
    const int upc = (512 + F.G - 1) / F.G;
    float gq = 0.f, gk = 0.f;
    for (int d = 0; d < 64; ++d) { gq = fmaxf(gq, fabsf(qg[d])); gk = fmaxf(gk, fabsf(kg[d])); }
    const float bound = 64.f * gq * gk * ATT_C2 * 1.0001f;
    const bool fixed_ref = bound < 40.f;
    for (int i = 0; i < upc; ++i) { const int u = F.vcu * upc + i; if (u >= 512) break;
        const int bhk = u >> 7, b = bhk >> 1, hkv = bhk & 1, hq = hkv * 4 + ((u & 127) >> 5), qb = u & 31; const size_t r0 = (size_t)b * SEQ + qb * 256;
        if (fixed_ref) attn_body::attn_unit<2, 1024, 8>((const attn_body::bf16*)(Q3 + r0 * 512 + hq * 64), (const attn_body::bf16*)(K3 + (size_t)b * SEQ * 128 + hkv * 64), (const attn_body::bf16*)(V3 + (size_t)b * SEQ * 128 + hkv * 64),
                                        (attn_body::bf16*)(OCAT + r0 * D + hq * 64), SEQ / 64, 0, 0, bound, false, nullptr, shm);
        else attn_body::attn_unit<0, 1024, 8>((const attn_body::bf16*)(Q3 + r0 * 512 + hq * 64), (const attn_body::bf16*)(K3 + (size_t)b * SEQ * 128 + hkv * 64), (const attn_body::bf16*)(V3 + (size_t)b * SEQ * 128 + hkv * 64),
                                        (attn_body::bf16*)(OCAT + r0 * D + hq * 64), SEQ / 64, 0, 0, 0.f, false, nullptr, shm); }
    const bf16* Qb = Q3 + (size_t)T * 512; const bf16* Kb = K3 + (size_t)T * 128; const bf16* Vb = V3 + (size_t)T * 128;
    for (int i = 0; i < upc; ++i) { const int u = F.vcu * upc + i; if (u >= 512) break;
        const int bhk = u >> 7, b = bhk >> 1, hkv = bhk & 1, pr = (u & 127) >> 6, qb = u & 63, hq = hkv * 4 + pr * 2; const size_t r0 = (size_t)b * SEQ + qb * 128;
        const int tl = max(qb * 2 - 2, 0), th = min(qb * 2 + 4, SEQ / 64); const size_t k0 = (size_t)b * SEQ + tl * 64;
        attn_body::attn_unit<1, 1024, 8, 2>((const attn_body::bf16*)(Qb + r0 * 512 + hq * 64), (const attn_body::bf16*)(Kb + k0 * 128 + hkv * 64), (const attn_body::bf16*)(Vb + k0 * 128 + hkv * 64),
                                           (attn_body::bf16*)(OCAT + r0 * D + 512 + hq * 64), th - tl, tl * 64 - qb * 128, 128, sink[hq + (F.wave >> 2)] * 1.4426950408889634f, true, nullptr, shm); }
}
__device__ __forceinline__ void attn_phase_l1(Frame& F, const bf16* Q3, const bf16* K3, const bf16* V3, bf16* OGB, float* LSE) {
    char* shm = (char*)(F.lds + RING_OFF);
    const int upc = (512 + F.G - 1) / F.G;
#pragma unroll 1
    for (int g = 0; g < 3; ++g) { const int Lc = SEQ >> (2 * g);
        for (int i = 0; i < upc; ++i) { const int u = F.vcu * upc + i; if (u >= 512) break;
            const int bhk = u >> 7, b = bhk >> 1, hkv = bhk & 1, hq = hkv * 4, qb = u & 127; const size_t r0 = (size_t)b * SEQ + qb * 64;
            const int q0 = qb * 64, cbase = q0 & ~(Lc - 1), lq0 = q0 & (Lc - 1); const int tl = min(max(lq0 / 64 - 1, 0), Lc / 64 - 4); const size_t k0 = (size_t)b * SEQ + cbase + tl * 64;
            attn_body::attn_unit<1, 512, 8, 4>((const attn_body::bf16*)(Q3 + (size_t)g * T * 512 + r0 * 512 + hq * 64), (const attn_body::bf16*)(K3 + (size_t)g * T * 128 + k0 * 128 + hkv * 64), (const attn_body::bf16*)(V3 + (size_t)g * T * 128 + k0 * 128 + hkv * 64),
                                              (attn_body::bf16*)(OGB + (size_t)g * T * 512 + r0 * 512 + hq * 64), 4, cbase + tl * 64 - q0, 64, 0.f, false, LSE + (size_t)g * T * 8 + r0 * 8 + hq, shm); }
    }
}
__device__ __forceinline__ void merge_phase(Frame& F, const bf16* OGB, const float* LSE, bf16* OCAT1) {
    for (int m = F.gw; m < T; m += F.NGW) {
        const int h = F.lane >> 3; const int b = m / SEQ, pos = m % SEQ;
        const size_t r0 = m, r1 = (size_t)b * SEQ + (size_t)(pos & 3) * (SEQ / 4) + (pos >> 2), r2 = (size_t)b * SEQ + (size_t)(pos & 15) * (SEQ / 16) + (pos >> 4);
        const float l0 = LSE[r0 * 8 + h], l1 = LSE[(size_t)T * 8 + r1 * 8 + h], l2 = LSE[(size_t)2 * T * 8 + r2 * 8 + h];
        const float mx = fmaxf(l0, fmaxf(l1, l2)); float w0 = __expf(l0 - mx), w1 = __expf(l1 - mx), w2 = __expf(l2 - mx); const float is = 1.f / (w0 + w1 + w2); w0 *= is; w1 *= is; w2 *= is;
        const v4u a = *(const v4u*)(OGB + r0 * 512 + F.lane * 8), bb = *(const v4u*)(OGB + (size_t)T * 512 + r1 * 512 + F.lane * 8), c = *(const v4u*)(OGB + (size_t)2 * T * 512 + r2 * 512 + F.lane * 8);
        v4u w;
        w.x = pk2(w0 * bflo(a.x) + w1 * bflo(bb.x) + w2 * bflo(c.x), w0 * bfhi(a.x) + w1 * bfhi(bb.x) + w2 * bfhi(c.x));
        w.y = pk2(w0 * bflo(a.y) + w1 * bflo(bb.y) + w2 * bflo(c.y), w0 * bfhi(a.y) + w1 * bfhi(bb.y) + w2 * bfhi(c.y));
        w.z = pk2(w0 * bflo(a.z) + w1 * bflo(bb.z) + w2 * bflo(c.z), w0 * bfhi(a.z) + w1 * bfhi(bb.z) + w2 * bfhi(c.z));
        w.w = pk2(w0 * bflo(a.w) + w1 * bflo(bb.w) + w2 * bflo(c.w), w0 * bfhi(a.w) + w1 * bfhi(bb.w) + w2 * bfhi(c.w));
        *(v4u*)(OCAT1 + (size_t)m * C_OUT + F.lane * 8) = w;
    }
}

typedef float f32x4m __attribute__((ext_vector_type(4)));
__device__ __forceinline__ void top4_merge(float (&v)[4], int (&ix)[4], int mask) {
    float ov[4]; int oi[4];
#pragma unroll
    for (int k = 0; k < 4; ++k) { ov[k] = shx(v[k], mask); oi[k] = shx(ix[k], mask); }
    float cv[8]; int ci[8];
#pragma unroll
    for (int k = 0; k < 4; ++k) { cv[k] = v[k]; ci[k] = ix[k]; cv[4 + k] = ov[k]; ci[4 + k] = oi[k]; }
    unsigned used = 0u;
#pragma unroll
    for (int k = 0; k < 4; ++k) { float best = -INFINITY; int bi = 1 << 30, bp = 0;
#pragma unroll
        for (int c = 0; c < 8; ++c) { const bool take = !((used >> c) & 1u) && (cv[c] > best || (cv[c] == best && ci[c] < bi)); best = take ? cv[c] : best; bi = take ? ci[c] : bi; bp = take ? c : bp; }
        used |= 1u << bp; v[k] = best; ix[k] = bi; }
}
__device__ __forceinline__ void route_phase(Frame& F, const bf16* H, const float* WR, const float* rb, int* CNTTAB, int* TOPE, float* TOPG, int* TOPPOS, float* RSTD) {
    LAS float* WL = (LAS float*)(F.lds + RING_OFF);
    LAS unsigned* LC = (LAS unsigned*)(F.lds + RING_OFF + NE * 1028 * 4);
    if (F.tid < NE) LC[F.tid] = 0u;
    for (int i = F.tid; i < NE * D / 4; i += NWAVES * 64) { const int e = i >> 8, k4 = i & 255; *(LAS f32x4*)(WL + e * 1028 + 4 * k4) = *(const f32x4*)(WR + (size_t)e * D + 4 * k4); }
    __syncthreads();
    const int lane = F.lane, c = lane & 15, q = lane >> 4;
    for (int task = F.wave * F.G + F.vcu; task < T / 16; task += F.NGW) {
        const bf16* xr = H + (size_t)(task * 16 + c) * D + 8 * q;
        const LAS float* w0 = WL + c * 1028 + 8 * q; const LAS float* w1 = w0 + 16 * 1028;
        f32x4m a0 = {0.f, 0.f, 0.f, 0.f}, a1 = {0.f, 0.f, 0.f, 0.f}; float ssq = 0.f;
#pragma unroll 4
        for (int ch = 0; ch < 32; ++ch) {
            const v4u xv = *(const v4u*)(xr + 32 * ch);
            float xf[8]; xf[0] = bflo(xv.x); xf[1] = bfhi(xv.x); xf[2] = bflo(xv.y); xf[3] = bfhi(xv.y); xf[4] = bflo(xv.z); xf[5] = bfhi(xv.z); xf[6] = bflo(xv.w); xf[7] = bfhi(xv.w);
            const f32x4 wa0 = *(const LAS f32x4*)(w0 + 32 * ch), wa1 = *(const LAS f32x4*)(w0 + 32 * ch + 4), wb0 = *(const LAS f32x4*)(w1 + 32 * ch), wb1 = *(const LAS f32x4*)(w1 + 32 * ch + 4);
#pragma unroll
            for (int t = 0; t < 8; ++t) ssq += xf[t] * xf[t];
            a0 = __builtin_amdgcn_mfma_f32_16x16x4f32(wa0.x, xf[0], a0, 0, 0, 0); a1 = __builtin_amdgcn_mfma_f32_16x16x4f32(wb0.x, xf[0], a1, 0, 0, 0);
            a0 = __builtin_amdgcn_mfma_f32_16x16x4f32(wa0.y, xf[1], a0, 0, 0, 0); a1 = __builtin_amdgcn_mfma_f32_16x16x4f32(wb0.y, xf[1], a1, 0, 0, 0);
            a0 = __builtin_amdgcn_mfma_f32_16x16x4f32(wa0.z, xf[2], a0, 0, 0, 0); a1 = __builtin_amdgcn_mfma_f32_16x16x4f32(wb0.z, xf[2], a1, 0, 0, 0);
            a0 = __builtin_amdgcn_mfma_f32_16x16x4f32(wa0.w, xf[3], a0, 0, 0, 0); a1 = __builtin_amdgcn_mfma_f32_16x16x4f32(wb0.w, xf[3], a1, 0, 0, 0);
            a0 = __builtin_amdgcn_mfma_f32_16x16x4f32(wa1.x, xf[4], a0, 0, 0, 0); a1 = __builtin_amdgcn_mfma_f32_16x16x4f32(wb1.x, xf[4], a1, 0, 0, 0);
            a0 = __builtin_amdgcn_mfma_f32_16x16x4f32(wa1.y, xf[5], a0, 0, 0, 0); a1 = __builtin_amdgcn_mfma_f32_16x16x4f32(wb1.y, xf[5], a1, 0, 0, 0);
            a0 = __builtin_amdgcn_mfma_f32_16x16x4f32(wa1.z, xf[6], a0, 0, 0, 0); a1 = __builtin_amdgcn_mfma_f32_16x16x4f32(wb1.z, xf[6], a1, 0, 0, 0);
            a0 = __builtin_amdgcn_mfma_f32_16x16x4f32(wa1.w, xf[7], a0, 0, 0, 0); a1 = __builtin_amdgcn_mfma_f32_16x16x4f32(wb1.w, xf[7], a1, 0, 0, 0);
        }
        ssq += shx(ssq, 16); ssq += shx(ssq, 32);
        const float rstd = 1.f / sqrtf(ssq * (1.f / D) + NORM_EPS);
        float cv[8]; int ci[8];
#pragma unroll
        for (int r = 0; r < 4; ++r) { ci[r] = 4 * q + r; ci[4 + r] = 16 + 4 * q + r; cv[r] = a0[r] * rstd + rb[4 * q + r]; cv[4 + r] = a1[r] * rstd + rb[16 + 4 * q + r]; }
        float tv[4]; int ti[4]; unsigned used = 0u;
#pragma unroll
        for (int k = 0; k < 4; ++k) { float best = -INFINITY; int bi = 0, bp = 0;
#pragma unroll
            for (int j = 0; j < 8; ++j) { const bool take = !((used >> j) & 1u) && (cv[j] > best); best = take ? cv[j] : best; bi = take ? ci[j] : bi; bp = take ? j : bp; }
            used |= 1u << bp; tv[k] = best; ti[k] = bi; }
        top4_merge(tv, ti, 16); top4_merge(tv, ti, 32);
        const float e1 = __expf(tv[1] - tv[0]), e2 = __expf(tv[2] - tv[0]), e3 = __expf(tv[3] - tv[0]); const float is = 1.f / (1.f + e1 + e2 + e3);
        const int m = task * 16 + c;
        { const int e = q == 0 ? ti[0] : q == 1 ? ti[1] : q == 2 ? ti[2] : ti[3]; const float g = (q == 0 ? 1.f : q == 1 ? e1 : q == 2 ? e2 : e3) * is;
            const unsigned pos = __hip_atomic_fetch_add(LC + e, 1u, __ATOMIC_RELAXED, __HIP_MEMORY_SCOPE_WORKGROUP);
            TOPE[m * 4 + q] = e; TOPG[m * 4 + q] = g; TOPPOS[m * 4 + q] = (int)pos; }
        if (q == 0) RSTD[m] = rstd;
    }
    __syncthreads();
    if (F.tid < NE) CNTTAB[F.vcu * NE + F.tid] = (int)LC[F.tid];
    __syncthreads();
}
__device__ __forceinline__ void slot_phase(Frame& F, const bf16* H, const int* CNTTAB, const int* TOPE, const float* TOPG, const int* TOPPOS, const float* RSTD, int* TOKSLOT, float* SLOTGATE, float* SLOTRS, bf16* XG, int* XTAB, bool f8) {
    LAS int* L = (LAS int*)(F.lds + RING_OFF);
    LAS int* P = L + 256;
    const int lane = F.lane;
    {
#pragma unroll 1
        for (int ee = 0; ee < 4; ++ee) { const int e = F.wave * 4 + ee;
            int s0 = 0, s1 = 0, s2 = 0, s3 = 0; const int g0 = 4 * lane;
            if (g0 < F.G) s0 = CNTTAB[g0 * NE + e]; if (g0 + 1 < F.G) s1 = CNTTAB[(g0 + 1) * NE + e]; if (g0 + 2 < F.G) s2 = CNTTAB[(g0 + 2) * NE + e]; if (g0 + 3 < F.G) s3 = CNTTAB[(g0 + 3) * NE + e];
            const int t = s0 + s1 + s2 + s3; int inc = t;
#pragma unroll
            for (int o = 1; o < 64; o <<= 1) { const int u = shup(inc, o); if (lane >= o) inc += u; }
            const int base = inc - t;
            P[g0 * NE + e] = base; P[(g0 + 1) * NE + e] = base + s0; P[(g0 + 2) * NE + e] = base + s0 + s1; P[(g0 + 3) * NE + e] = base + s0 + s1 + s2;
            if (lane == 63) L[64 + e] = inc; }
    }
    __syncthreads();
    if (F.wave == 0) {
        const int np = (lane < 32) ? ((L[64 + (lane & 31)] + 255) >> 8) : 0;
        int pre = np;
#pragma unroll
        for (int o = 1; o < 32; o <<= 1) { const int t = shup(pre, o); if (lane >= o) pre += t; }
        const int p0 = pre - np;
        if (lane < 32) { L[lane] = np; L[32 + lane] = p0 * 256; }
        if (F.bx == 0) {
            LDS_WAIT(); asm volatile("" ::: "memory");
            int rank = 0;
#pragma unroll 8
            for (int e2 = 0; e2 < 32; ++e2) { const int v = L[e2]; rank += (v > np || (v == np && e2 < lane)) ? 1 : 0; }
            LAS int* XE = L + 96;
            if (lane < 32) { const int r16 = rank & 15, x = r16 < 8 ? r16 : 15 - r16, pos = (rank >> 4) * 2 + (r16 >= 8 ? 1 : 0); XE[(x * 4 + pos) * 3] = lane; XE[(x * 4 + pos) * 3 + 1] = p0; XE[(x * 4 + pos) * 3 + 2] = np; }
            LDS_WAIT(); asm volatile("" ::: "memory");
            const int lx = lane_opaque();
            if (lx < 8) { int cump = 0; int* tb = XTAB + lx * 136;
#pragma unroll
                for (int s = 0; s < 4; ++s) { const int e = XE[(lx * 4 + s) * 3], q0 = XE[(lx * 4 + s) * 3 + 1], n = XE[(lx * 4 + s) * 3 + 2]; tb[4 + 4 * s] = e; tb[4 + 4 * s + 1] = q0; tb[4 + 4 * s + 2] = n; tb[4 + 4 * s + 3] = cump; cump += n; }
                int four = 4; asm volatile("" : "+v"(four));
                tb[0] = four; tb[1] = cump; }
        }
    }
    __syncthreads();
    if (f8) {
        for (int m0 = F.gw; m0 < T; m0 += 4 * F.NGW) {
            int e[4], ps[4]; float gt[4], rs[4]; v4u ra[4], rb[4];
#pragma unroll
            for (int j = 0; j < 4; ++j) { const int m = m0 + j * F.NGW; const bool ok = m < T; const int mm = ok ? m : 0;
                e[j] = 0; ps[j] = 0; gt[j] = 0.f;
                if (lane < 4) { e[j] = TOPE[mm * 4 + lane]; ps[j] = TOPPOS[mm * 4 + lane]; gt[j] = TOPG[mm * 4 + lane]; }
                rs[j] = RSTD[mm]; const bf16* src = H + (size_t)mm * D + lane * 16; ra[j] = *(const v4u*)src; rb[j] = *(const v4u*)(src + 8); }
#pragma unroll
            for (int j = 0; j < 4; ++j) { const int m = m0 + j * F.NGW; if (m >= T) break;
                int slot = 0;
                if (lane < 4) { const int wg = (m >> 4) % F.G; slot = L[32 + e[j]] + P[wg * NE + e[j]] + ps[j]; TOKSLOT[m * 4 + lane] = slot; SLOTGATE[slot] = gt[j]; SLOTRS[slot] = rs[j]; }
                const int s0 = shl(slot, 0), s1 = shl(slot, 1), s2 = shl(slot, 2), s3 = shl(slot, 3);
                const v4u a = ra[j], b = rb[j]; const float r = rs[j];
                v4u w; w.x = pk4_fp8(clamp448(bflo(a.x) * r), clamp448(bfhi(a.x) * r), clamp448(bflo(a.y) * r), clamp448(bfhi(a.y) * r)); w.y = pk4_fp8(clamp448(bflo(a.z) * r), clamp448(bfhi(a.z) * r), clamp448(bflo(a.w) * r), clamp448(bfhi(a.w) * r));
                w.z = pk4_fp8(clamp448(bflo(b.x) * r), clamp448(bfhi(b.x) * r), clamp448(bflo(b.y) * r), clamp448(bfhi(b.y) * r)); w.w = pk4_fp8(clamp448(bflo(b.z) * r), clamp448(bfhi(b.z) * r), clamp448(bflo(b.w) * r), clamp448(bfhi(b.w) * r));
                unsigned char* X8 = (unsigned char*)XG; const size_t co = (size_t)lane * 16;
                *(v4u*)(X8 + (size_t)s0 * D + co) = w; *(v4u*)(X8 + (size_t)s1 * D + co) = w; *(v4u*)(X8 + (size_t)s2 * D + co) = w; *(v4u*)(X8 + (size_t)s3 * D + co) = w; }
        }
    } else {
    for (int m = F.gw; m < T; m += F.NGW) {
        int slot = 0;
        if (lane < 4) { const int e = TOPE[m * 4 + lane]; const int wg = (m >> 4) % F.G; slot = L[32 + e] + P[wg * NE + e] + TOPPOS[m * 4 + lane]; TOKSLOT[m * 4 + lane] = slot; SLOTGATE[slot] = TOPG[m * 4 + lane]; SLOTRS[slot] = RSTD[m]; }
        const int s0 = shl(slot, 0), s1 = shl(slot, 1), s2 = shl(slot, 2), s3 = shl(slot, 3);
        const bf16* src = H + (size_t)m * D + lane * 8; const v4u a = *(const v4u*)src, b = *(const v4u*)(src + 512);
        const size_t co = (size_t)lane * 8;
        *(v4u*)(XG + (size_t)s0 * D + co) = a; *(v4u*)(XG + (size_t)s0 * D + co + 512) = b;
        *(v4u*)(XG + (size_t)s1 * D + co) = a; *(v4u*)(XG + (size_t)s1 * D + co + 512) = b;
        *(v4u*)(XG + (size_t)s2 * D + co) = a; *(v4u*)(XG + (size_t)s2 * D + co + 512) = b;
        *(v4u*)(XG + (size_t)s3 * D + co) = a; *(v4u*)(XG + (size_t)s3 * D + co + 512) = b;
    }
    }
    __syncthreads();
}
__device__ __forceinline__ void y_add16(float (&a)[16], const void* Yp, size_t row, int lane) {
    if (Y_FP8) { const v4u y = *(const v4u*)((const unsigned char*)Yp + row * D + lane * 16); const float is = 1.f / Y_SC;
        const unsigned w[4] = {y.x, y.y, y.z, y.w};
#pragma unroll
        for (int i = 0; i < 4; ++i) { const f32x2_ lo = __builtin_amdgcn_cvt_pk_f32_fp8((int)w[i], false), hi = __builtin_amdgcn_cvt_pk_f32_fp8((int)w[i], true); a[4 * i] += lo.x * is; a[4 * i + 1] += lo.y * is; a[4 * i + 2] += hi.x * is; a[4 * i + 3] += hi.y * is; } }
    else { const bf16* yp = (const bf16*)Yp + row * D + lane * 16; const v4u y0 = *(const v4u*)yp, y1 = *(const v4u*)(yp + 8);
        a[0] += bflo(y0.x); a[1] += bfhi(y0.x); a[2] += bflo(y0.y); a[3] += bfhi(y0.y); a[4] += bflo(y0.z); a[5] += bfhi(y0.z); a[6] += bflo(y0.w); a[7] += bfhi(y0.w);
        a[8] += bflo(y1.x); a[9] += bfhi(y1.x); a[10] += bflo(y1.y); a[11] += bfhi(y1.y); a[12] += bflo(y1.z); a[13] += bfhi(y1.z); a[14] += bflo(y1.w); a[15] += bfhi(y1.w); }
}
__device__ __forceinline__ void combine_phase(Frame& F, const bf16* HM, const void* Y, const int* TOKSLOT, bf16* H2, unsigned char* H2F8) {
    const int lane = F.lane;
    for (int m = F.gw; m < T; m += F.NGW) {
        const int s0 = TOKSLOT[m * 4], s1 = TOKSLOT[m * 4 + 1], s2 = TOKSLOT[m * 4 + 2], s3 = TOKSLOT[m * 4 + 3];
        float a[16];
#pragma unroll
        for (int i = 0; i < 16; ++i) a[i] = 0.f;
        y_add16(a, Y, (size_t)s0, lane); y_add16(a, Y, (size_t)s1, lane); y_add16(a, Y, (size_t)s2, lane); y_add16(a, Y, (size_t)s3, lane);
        const bf16* hp = HM + (size_t)m * D + lane * 16; const v4u h0 = *(const v4u*)hp, h1 = *(const v4u*)(hp + 8);
        a[0] += bflo(h0.x); a[1] += bfhi(h0.x); a[2] += bflo(h0.y); a[3] += bfhi(h0.y); a[4] += bflo(h0.z); a[5] += bfhi(h0.z); a[6] += bflo(h0.w); a[7] += bfhi(h0.w);
        a[8] += bflo(h1.x); a[9] += bfhi(h1.x); a[10] += bflo(h1.y); a[11] += bfhi(h1.y); a[12] += bflo(h1.z); a[13] += bfhi(h1.z); a[14] += bflo(h1.w); a[15] += bfhi(h1.w);
        v4u w0, w1; w0.x = pk2(a[0], a[1]); w0.y = pk2(a[2], a[3]); w0.z = pk2(a[4], a[5]); w0.w = pk2(a[6], a[7]); w1.x = pk2(a[8], a[9]); w1.y = pk2(a[10], a[11]); w1.z = pk2(a[12], a[13]); w1.w = pk2(a[14], a[15]);
        bf16* op = H2 + (size_t)m * D + lane * 16; *(v4u*)op = w0; *(v4u*)(op + 8) = w1;
        if (PLE_FP8) { v4u q; q.x = pk4_fp8(clamp448(a[0]), clamp448(a[1]), clamp448(a[2]), clamp448(a[3])); q.y = pk4_fp8(clamp448(a[4]), clamp448(a[5]), clamp448(a[6]), clamp448(a[7]));
            q.z = pk4_fp8(clamp448(a[8]), clamp448(a[9]), clamp448(a[10]), clamp448(a[11])); q.w = pk4_fp8(clamp448(a[12]), clamp448(a[13]), clamp448(a[14]), clamp448(a[15])); *(v4u*)(H2F8 + (size_t)m * D + lane * 16) = q; }
    }
}
__device__ __forceinline__ void final_norm_phase(Frame& F, const bf16* H, const float* SS, const float* gain, float* out) {
    const int lane = F.lane;
    for (int m = F.gw; m < T; m += F.NGW) {
        const float rstd = 1.f / sqrtf(ssp_sum(SS + (size_t)m * 16) * (1.f / D) + NORM_EPS);
#pragma unroll
        for (int j = 0; j < 2; ++j) { const size_t co = (size_t)j * 512 + lane * 8; const v4u h = *(const v4u*)(H + (size_t)m * D + co); const f32x4 g0 = *(const f32x4*)(gain + co), g1 = *(const f32x4*)(gain + co + 4);
            f32x4 o0, o1; o0.x = bflo(h.x) * rstd * g0.x; o0.y = bfhi(h.x) * rstd * g0.y; o0.z = bflo(h.y) * rstd * g0.z; o0.w = bfhi(h.y) * rstd * g0.w;
            o1.x = bflo(h.z) * rstd * g1.x; o1.y = bfhi(h.z) * rstd * g1.y; o1.z = bflo(h.w) * rstd * g1.z; o1.w = bfhi(h.w) * rstd * g1.w;
            float* dst = out + (size_t)m * D + co; *(f32x4*)dst = o0; *(f32x4*)(dst + 4) = o1; }
    }
}

constexpr int N_PHASES = 22;
struct Args { const float* in[20]; float* out; unsigned char* ws; int ph_lo, ph_hi, li, pad; };
typedef const __attribute__((address_space(4))) Args* argp_t;
__device__ __forceinline__ argp_t opaque_args() { argp_t p = (argp_t)__builtin_amdgcn_kernarg_segment_ptr(); asm volatile("" : "+s"(p)); return p; }
#define AP (opaque_args())
__global__ void __launch_bounds__(NWAVES * 64, 2) fwd_kernel(Args args_unused) {
    extern __shared__ __attribute__((aligned(16))) unsigned char lds[];
    Frame F;
    F.lds = (LAS unsigned char*)lds;
    F.MISC = (volatile LAS unsigned*)(F.lds + MISC_OFF);
    refresh(F);
    F.ctl = (gu32*)(AP->ws + WS_CTL);
    if (F.tid < 128) ((LAS unsigned*)(F.lds + LDSCTL_OFF))[F.tid] = 0u;
    __syncthreads();
    const bool one_phase = (AP->ph_hi - AP->ph_lo) == 1;
    XcdBarrier bar; bar.bar = (unsigned*)(F.ctl + CW_BAR); bar.x = 0; bar.st = nullptr;
    if (!one_phase) bar = xcd_barrier_post((unsigned*)(F.ctl + CW_BAR), F.MISC + 8);
    const int lo = AP->ph_lo, hi = AP->ph_hi;
#ifndef MK_MASK
#define MK_MASK 0x3fff
#endif
#ifndef PROBE_MASK
#define PROBE_MASK 0
#endif
#define IN(k) (lo <= (k) && (k) < hi)
#define INL(j) (((MK_MASK >> (j)) & 1) && IN(pb + (j)) && refresh(F))
#define REP(j) _Pragma("unroll") for (int rep_ = 0; rep_ < (((PROBE_MASK >> (j)) & 1) ? 2 : 1); ++rep_)
#define SEAM(k) do { if (IN((k) + 1)) xcd_barrier(bar); } while (0)
#define ws (AP->ws)
#define WSP(type, off) ((type*)(ws + (off)))
#define EXPERT_CONVERSIONS(FR, ll, e0, e1) do { if ((e1) > (e0)) { \
            const float* wu = AP->in[13] + ((size_t)(ll) * NE + (e0)) * D * 2 * DE; const float* wd = AP->in[15] + ((size_t)(ll) * NE + (e0)) * DE * D; const float* gf = AP->in[10] + (ll) * D; \
            const size_t eb_ = ((MOE_FP8_MASK >> (ll)) & 1) ? 1 : 2;        \
            unsigned char* du = ws + WS_WUPT + (size_t)(ll) * NE * 2 * DE * D * 2 + (size_t)(e0) * 2 * DE * D * eb_; unsigned char* dd = ws + WS_WDNT + (size_t)(ll) * NE * D * DE * 2 + (size_t)(e0) * D * DE * eb_; \
            if ((MOE_FP8_MASK >> (ll)) & 1) { \
                transpose_family_f8<1>(FR, wu, (size_t)D * 2 * DE, du, (size_t)2 * DE * D, gf, 0, D, 2 * DE, (e1) - (e0), 1); \
                transpose_family_f8<0>(FR, wd, (size_t)DE * D, dd, (size_t)D * DE, nullptr, 0, DE, D, (e1) - (e0), 1); } \
            else { \
                transpose_family<1>(FR, wu, (size_t)D * 2 * DE, (bf16*)du, (size_t)2 * DE * D, gf, 0, D, 2 * DE, (e1) - (e0), 1); \
                transpose_family<0>(FR, wd, (size_t)DE * D, (bf16*)dd, (size_t)D * DE, nullptr, 0, DE, D, (e1) - (e0), 1); } } } while (0)
#define BIG_CONVERSIONS(FR) do { \
        EXPERT_CONVERSIONS(FR, 0, 0, NE); EXPERT_CONVERSIONS(FR, 1, 0, NE - NE_LATE); \
        if (PROJ_FP8) transpose_family_f8<3>(FR, AP->in[8], 0, ws + WS_WIN1T, 0, AP->in[2] + D, 0, D, C_IN, 1, 1); \
        else transpose_family<3>(FR, AP->in[8], 0, WSP(bf16, WS_WIN1T), 0, AP->in[2] + D, 0, D, C_IN, 1, 1); \
        transpose_family<0>(FR, AP->in[7], 0, WSP(bf16, WS_WOUT0T), 0, nullptr, 0, D, D, 1, 1); \
        transpose_family<0>(FR, AP->in[9], 0, WSP(bf16, WS_WOUT1T), 0, nullptr, 0, C_OUT, D, 1, 1); \
        if (PLE_FP8) transpose_family_f8<0>(FR, AP->in[18], (size_t)D * D, ws + WS_WGT, (size_t)D * D * 2, nullptr, 0, D, D, 2, 1); \
        else transpose_family<0>(FR, AP->in[18], (size_t)D * D, WSP(bf16, WS_WGT), (size_t)D * D, nullptr, 0, D, D, 2, 1); \
    } while (0)
    if (((MK_MASK >> 12) & 1) && IN(0) && refresh(F)) REP(12) {
        if (PROJ_FP8) transpose_family_f8<2>(F, AP->in[3], 0, ws + WS_WIN0T, 0, AP->in[2], 0, D, AB_IN, 1, 1);
        else transpose_family<2>(F, AP->in[3], 0, WSP(bf16, WS_WIN0T), 0, AP->in[2], 0, D, AB_IN, 1, 1);
        transpose_family<0>(F, AP->in[17], (size_t)PLE * D, WSP(bf16, WS_WPT), (size_t)D * PLE, nullptr, 0, PLE, D, 2, 1);
        if (NG_PROJ == 0) BIG_CONVERSIONS(F);
        if (NE_LATE > 0 && F.G != 256) EXPERT_CONVERSIONS(F, 1, NE - NE_LATE, NE);
        {
            float* WR = WSP(float, WS_WR); const float* nf = AP->in[10]; const float* rw = AP->in[11];
            for (int i = F.gw * 64 + F.lane; i < 2 * NE * D; i += F.NGW * 64) { const int l = i / (NE * D), e = (i / D) % NE, k = i % D; WR[i] = nf[l * D + k] * rw[((size_t)l * D + k) * NE + e]; }
        }
        {
            float* R1 = WSP(float, WS_ROPE1); float* RA = WSP(float, WS_ROPEA);
            for (int i = F.gw * 64 + F.lane; i < SEQ * 32; i += F.NGW * 64) { const int pos = i >> 5, j = i & 31;
                const int o = (pos * 32 + (j & ~1)) * 2 + (j & 1);
                const float a1 = (float)pos * rope_freq(j, 32); R1[o] = cosf(a1); R1[o + 2] = sinf(a1);
                const float aa = (float)((j < 16) ? (pos >> 6) : (pos & 63)) * rope_freq(j & 15, 16); RA[o] = cosf(aa); RA[o + 2] = sinf(aa); }
        }
        {
            bf16* PBF = WSP(bf16, WS_PBF); const float* p_in = AP->in[1]; const size_t n8 = (size_t)2 * T * PLE / 8;
            for (size_t i = (size_t)F.gw * 64 + F.lane; i < n8; i += (size_t)F.NGW * 64) { const f32x4 a = __builtin_nontemporal_load((const f32x4*)(p_in + i * 8)), b = __builtin_nontemporal_load((const f32x4*)(p_in + i * 8 + 4));
                v4u w; w.x = pk2(a.x, a.y); w.y = pk2(a.z, a.w); w.z = pk2(b.x, b.y); w.w = pk2(b.z, b.w); *(v4u*)(PBF + i * 8) = w; }
        }
        {
            bf16* X0 = WSP(bf16, WS_X0); float* SS0 = WSP(float, WS_SSP); const float* x_in = AP->in[0];
            for (int m = F.gw; m < T; m += F.NGW) { float s = 0.f;
#pragma unroll
                for (int j = 0; j < 2; ++j) { const size_t co = (size_t)m * D + j * 512 + F.lane * 8; const f32x4 a = __builtin_nontemporal_load((const f32x4*)(x_in + co)), b = __builtin_nontemporal_load((const f32x4*)(x_in + co + 4));
                    v4u w; w.x = pk2(a.x, a.y); w.y = pk2(a.z, a.w); w.z = pk2(b.x, b.y); w.w = pk2(b.z, b.w); *(v4u*)(X0 + co) = w;
                    if (PROJ_FP8) { v2u q; q.x = pk4_fp8(clamp448(bflo(w.x)), clamp448(bfhi(w.x)), clamp448(bflo(w.y)), clamp448(bfhi(w.y))); q.y = pk4_fp8(clamp448(bflo(w.z)), clamp448(bfhi(w.z)), clamp448(bflo(w.w)), clamp448(bfhi(w.w))); *(v2u*)(ws + WS_HF8 + co) = q; }
                    s += (bflo(w.x) * bflo(w.x) + bfhi(w.x) * bfhi(w.x)) + (bflo(w.y) * bflo(w.y) + bfhi(w.y) * bfhi(w.y)) + (bflo(w.z) * bflo(w.z) + bfhi(w.z) * bfhi(w.z)) + (bflo(w.w) * bflo(w.w) + bfhi(w.w) * bfhi(w.w)); }
                s = wave_sum(s); if (F.lane < 16) SS0[(size_t)m * 16 + F.lane] = (F.lane == 0) ? s : 0.f; }
        }
        __syncthreads();
        SEAM(0);
    }
#pragma unroll 1
    for (int l = 0; l < 2; ++l) {
        const int pb = 1 + 10 * l;
        if (INL(0)) REP(0) {
            const bool split0 = (NG_PROJ > 0) && (l == 0) && (F.G == 256), split1 = (NE_LATE > 0) && (l == 1) && (F.G == 256);
            const int Gg = split0 ? NG_PROJ : split1 ? 192 : F.G;
            const bool gemm_role = F.bx < Gg;
            if (!gemm_role) { Frame F2 = F; F2.gw = (F.bx - Gg) * NWAVES + F.wave; F2.NGW = (F.G - Gg) * NWAVES;
                if (l == 0) BIG_CONVERSIONS(F2); else EXPERT_CONVERSIONS(F2, 1, NE - NE_LATE, NE);
                __syncthreads(); }
            else {
            const bf16* hin = (l == 0) ? WSP(bf16, WS_X0) : WSP(bf16, WS_H3);
            const float* ssin = WSP(float, WS_SSP) + (size_t)l * T * 16;
            const bf16* ain = PROJ_FP8 ? (const bf16*)(ws + WS_HF8 + (size_t)l * T * D) : hin; const int Kin = PROJ_FP8 ? D / 2 : D;
            LAS int* PML = (LAS int*)(F.lds + RING_OFF + RING_BYTES); LAS float* RSL = (LAS float*)(F.lds + RING_OFF + RING_BYTES + 64);
            { pg8::StaticOrder S0; S0.init(T, l == 0 ? AB_IN : C_IN, Gg, F.bx);
#pragma unroll
              for (int i = 0; i < 8; ++i) { pg8::Unit uu; uu.pm = 0; uu.pn = 0; const bool has = S0.next(i, uu); const int pmv = has ? uu.pm : -1;
                  if (F.tid == 0) PML[i] = pmv;
                  if (has && F.tid < 256) RSL[i * 256 + F.tid] = __builtin_amdgcn_rsqf(ssp_sum(ssin + (size_t)(pmv * 256 + F.tid) * 16) * (1.f / D) + NORM_EPS); }
              __syncthreads(); }
            if (l == 0) { pg8::Gemm g{ain, WSP(bf16, WS_WIN0T), T, AB_IN, Kin}; pg8::StaticOrder S; S.init(T, AB_IN, Gg, F.bx);
                EpiQKV<0> E{RSL, PML, AP->in[4], AP->in[5], WSP(float, WS_ROPE1), WSP(float, WS_ROPEA), WSP(bf16, WS_Q3), WSP(bf16, WS_K3), WSP(bf16, WS_V3)};
                pg8::gemm_phase<EpiQKV<0>, pg8::StaticOrder, true, true, PROJ_FP8 ? 127 - F8_WSC : -1>(F.lds + RING_OFF, g, S, E); }
            else { pg8::Gemm g{ain, WSP(bf16, WS_WIN1T), T, C_IN, Kin}; pg8::StaticOrder S; S.init(T, C_IN, Gg, F.bx);
                EpiQKV<1> E{RSL, PML, nullptr, nullptr, WSP(float, WS_ROPE1), WSP(float, WS_ROPEA), WSP(bf16, WS_Q3), WSP(bf16, WS_K3), WSP(bf16, WS_V3)};
                pg8::gemm_phase<EpiQKV<1>, pg8::StaticOrder, true, true, PROJ_FP8 ? 127 - F8_WSC : -1>(F.lds + RING_OFF, g, S, E); }
            if (l == 0) { int Kp = PLE; asm volatile("" : "+s"(Kp)); pg8::Gemm g{WSP(bf16, WS_PBF), WSP(bf16, WS_WPT), 2 * T, 2 * D, Kp}; PPOrder S{Gg, F.bx};
                EpiPP E{WSP(bf16, WS_PP)};
                pg8::gemm_phase<EpiPP, PPOrder, true, true>(F.lds + RING_OFF, g, S, E); }
            }
            SEAM(pb + 0);
        }
        if (INL(1)) REP(1) {
            if (l == 0) attn_phase_l0(F, WSP(bf16, WS_Q3), WSP(bf16, WS_K3), WSP(bf16, WS_V3), WSP(bf16, WS_OCAT), AP->in[6], AP->in[4], AP->in[5]);
            else attn_phase_l1(F, WSP(bf16, WS_Q3), WSP(bf16, WS_K3), WSP(bf16, WS_V3), WSP(bf16, WS_OGB), WSP(float, WS_LSE));
            SEAM(pb + 1);
        }
        if (INL(2)) REP(2) { if (l == 1) merge_phase(F, WSP(bf16, WS_OGB), WSP(float, WS_LSE), WSP(bf16, WS_OCAT)); SEAM(pb + 2); }
        if (INL(3)) REP(3) {
            const bf16* hin = (l == 0) ? WSP(bf16, WS_X0) : WSP(bf16, WS_H3);
            pg8::Gemm g{WSP(bf16, WS_OCAT), (const bf16*)(ws + (l == 0 ? WS_WOUT0T : WS_WOUT1T)), T, D, (l == 0) ? D : C_OUT}; pg8::StaticOrder S; S.init(T, D, F.G, F.bx); EpiResBf16 E{hin, WSP(bf16, WS_HM)};
            pg8::gemm_phase<EpiResBf16, pg8::StaticOrder, true, true>(F.lds + RING_OFF, g, S, E);
            SEAM(pb + 3);
        }
        if (INL(4)) REP(4) { route_phase(F, WSP(bf16, WS_HM), WSP(float, WS_WR) + (size_t)l * NE * D, AP->in[12] + l * NE, WSP(int, WS_CNTTAB), WSP(int, WS_TOPE), WSP(float, WS_TOPG), WSP(int, WS_TOPPOS), WSP(float, WS_RSTD));
#ifdef PROBE_ROUTE
            route_phase(F, WSP(bf16, WS_HM), WSP(float, WS_WR) + (size_t)l * NE * D, AP->in[12] + l * NE, WSP(int, WS_OGB) + 16 * T, WSP(int, WS_OGB), WSP(float, WS_OGB) + 4 * T, WSP(int, WS_OGB) + 8 * T, WSP(float, WS_OGB) + 12 * T);
#endif
            SEAM(pb + 4); }
        if (INL(5)) REP(5) { slot_phase(F, WSP(bf16, WS_HM), WSP(int, WS_CNTTAB), WSP(int, WS_TOPE), WSP(float, WS_TOPG), WSP(int, WS_TOPPOS), WSP(float, WS_RSTD), WSP(int, WS_TOKSLOT), WSP(float, WS_SLOTGATE), WSP(float, WS_SLOTRS), WSP(bf16, WS_XG), WSP(int, WS_XTAB), ((MOE_FP8_MASK >> l) & 1) != 0); SEAM(pb + 5); }
        if (INL(6)) REP(6) {
            XcdOrder<3> S{WSP(int, WS_XTAB) + (F.bx & 7) * 136, F.bx >> 3, (int)F.G >> 3};
#if MOE_FP8_MASK != 0
            if ((MOE_FP8_MASK >> l) & 1) { pg8::Gemm g{WSP(bf16, WS_XG), WSP(bf16, WS_WUPT) + (size_t)l * NE * 2 * DE * D, NSLOT, NE * 2 * DE, D / 2};
                EpiSwiglu<true> E{WSP(void, WS_ACT), AP->in[14] + (size_t)l * NE * 2 * DE, nullptr};
                pg8::gemm_phase<EpiSwiglu<true>, XcdOrder<3>, true, true, F8_DIAG ? 1000 : 127 - F8_WSC>(F.lds + RING_OFF, g, S, E); }
#ifdef PROBE_UPNULL
            if ((MOE_FP8_MASK >> l) & 1) { pg8::Gemm g{WSP(bf16, WS_XG), WSP(bf16, WS_WUPT) + (size_t)l * NE * 2 * DE * D, NSLOT, NE * 2 * DE, D / 2};
                EpiNull E{WSP(float, WS_OGB)};
                pg8::gemm_phase<EpiNull, XcdOrder<3>, true, true, 127 - F8_WSC>(F.lds + RING_OFF, g, S, E); }
#endif
#endif
#if MOE_FP8_MASK != 3
            if (!((MOE_FP8_MASK >> l) & 1)) { pg8::Gemm g{WSP(bf16, WS_XG), WSP(bf16, WS_WUPT) + (size_t)l * NE * 2 * DE * D, NSLOT, NE * 2 * DE, D};
                EpiSwiglu<false> E{WSP(void, WS_ACT), AP->in[14] + (size_t)l * NE * 2 * DE, WSP(float, WS_SLOTRS)};
                pg8::gemm_phase<EpiSwiglu<false>, XcdOrder<3>, true, true>(F.lds + RING_OFF, g, S, E); }
#endif
            SEAM(pb + 6);
        }
        if (INL(7)) REP(7) {
            XcdOrder<2> S{WSP(int, WS_XTAB) + (F.bx & 7) * 136, F.bx >> 3, (int)F.G >> 3};
            EpiDown<Y_FP8 != 0> E{WSP(void, WS_Y), AP->in[16] + (size_t)l * NE * D, WSP(float, WS_SLOTGATE), ((MOE_FP8_MASK >> l) & 1) ? F8_EPI_SC : 1.f};
#if MOE_FP8_MASK != 0
            if ((MOE_FP8_MASK >> l) & 1) { pg8::Gemm g{WSP(bf16, WS_ACT), WSP(bf16, WS_WDNT) + (size_t)l * NE * D * DE, NSLOT, NE * D, DE / 2};
                pg8::gemm_phase<EpiDown<Y_FP8 != 0>, XcdOrder<2>, true, true, F8_DIAG ? 1000 : 127 - F8_WSC>(F.lds + RING_OFF, g, S, E); }
#ifdef PROBE_DNNULL
            if ((MOE_FP8_MASK >> l) & 1) { pg8::Gemm g{WSP(bf16, WS_ACT), WSP(bf16, WS_WDNT) + (size_t)l * NE * D * DE, NSLOT, NE * D, DE / 2};
                EpiNull E2{WSP(float, WS_OGB)};
                pg8::gemm_phase<EpiNull, XcdOrder<2>, true, true, 127 - F8_WSC>(F.lds + RING_OFF, g, S, E2); }
#endif
#endif
#if MOE_FP8_MASK != 3
            if (!((MOE_FP8_MASK >> l) & 1)) { pg8::Gemm g{WSP(bf16, WS_ACT), WSP(bf16, WS_WDNT) + (size_t)l * NE * D * DE, NSLOT, NE * D, DE};
                pg8::gemm_phase<EpiDown<Y_FP8 != 0>, XcdOrder<2>, true, true>(F.lds + RING_OFF, g, S, E); }
#endif
            SEAM(pb + 7);
        }
        if (INL(8)) REP(8) { combine_phase(F, WSP(bf16, WS_HM), WSP(void, WS_Y), WSP(int, WS_TOKSLOT), WSP(bf16, WS_H2), ws + WS_H2F8); SEAM(pb + 8); }
        if (INL(9)) REP(9) {
            pg8::StaticOrder S; S.init(T, D, F.G, F.bx);
            EpiPle E{WSP(bf16, WS_H2), WSP(bf16, WS_PP) + (size_t)l * T * D, WSP(bf16, WS_H3), WSP(float, WS_SSP) + (size_t)(l + 1) * T * 16, (PROJ_FP8 && l == 0) ? ws + WS_HF8 + (size_t)T * D : nullptr};
            if (PLE_FP8) { pg8::Gemm g{WSP(bf16, WS_H2F8), WSP(bf16, WS_WGT) + (size_t)l * D * D, T, D, D / 2};
                pg8::gemm_phase<EpiPle, pg8::StaticOrder, true, true, 127 - F8_WSC>(F.lds + RING_OFF, g, S, E); }
            else { pg8::Gemm g{WSP(bf16, WS_H2), WSP(bf16, WS_WGT) + (size_t)l * D * D, T, D, D};
                pg8::gemm_phase<EpiPle, pg8::StaticOrder, true, true>(F.lds + RING_OFF, g, S, E); }
#ifdef PROBE_PLENULL
            { pg8::Gemm g{WSP(bf16, WS_H2), WSP(bf16, WS_WGT) + (size_t)l * D * D, T, D, D}; EpiNull EN{WSP(float, WS_OGB)};
                pg8::gemm_phase<EpiNull, pg8::StaticOrder, true, true>(F.lds + RING_OFF, g, S, EN); }
#endif
            SEAM(pb + 9);
        }
    }
#ifdef PROBE_BARRIERS
    for (int pb_ = 0; pb_ < PROBE_BARRIERS; ++pb_) xcd_barrier(bar);
#endif
    if (((MK_MASK >> 13) & 1) && IN(21) && refresh(F)) final_norm_phase(F, WSP(bf16, WS_H3), WSP(float, WS_SSP) + (size_t)2 * T * 16, AP->in[19], AP->out);
#undef IN
#undef INL
#undef REP
#undef SEAM
#undef ws
#undef WSP
#undef BIG_CONVERSIONS
#undef EXPERT_CONVERSIONS
}

#ifndef MK_ONE_LAUNCH
#define MK_ONE_LAUNCH 1
#endif
extern "C" void kernel_launch(void* const* d_in, const int* in_sizes, int n_in, void* d_out, int out_size, void* d_ws, size_t ws_size, hipStream_t stream) {
    static int grid = 0;
    if (grid == 0) {
        if (n_in != 20 || in_sizes[0] != T * D || out_size != T * D || ws_size < WS_END) { fprintf(stderr, "kernel_launch: unexpected shapes: n_in %d in0 %d out %d ws %zu (need %zu)\n", n_in, n_in > 0 ? in_sizes[0] : -1, out_size, ws_size, (size_t)WS_END); grid = -1; return; }
        int dev = 0, cus = 0, per_cu = 0;
        if (hipGetDevice(&dev) != hipSuccess || hipDeviceGetAttribute(&cus, hipDeviceAttributeMultiprocessorCount, dev) != hipSuccess) { grid = -1; return; }
        if (hipFuncSetAttribute((const void*)fwd_kernel, hipFuncAttributeMaxDynamicSharedMemorySize, LDS_BYTES) != hipSuccess) { fprintf(stderr, "kernel_launch: hipFuncSetAttribute failed\n"); grid = -1; return; }
        if (hipOccupancyMaxActiveBlocksPerMultiprocessor(&per_cu, (const void*)fwd_kernel, NWAVES * 64, LDS_BYTES) != hipSuccess || per_cu < 1) fprintf(stderr, "kernel_launch: occupancy query says %d\n", per_cu);
        (void)hipGetLastError();
        grid = cus;
        if (grid != 256) fprintf(stderr, "kernel_launch: %d CUs (built for 256)\n", grid);
    }
    if (grid < 0) return;
    if (hipMemsetAsync((char*)d_ws + WS_CTL, 0, CTL_ZERO_BYTES, stream) != hipSuccess) return;
    Args a{};
    for (int i = 0; i < 20; ++i) a.in[i] = (const float*)d_in[i];
    a.out = (float*)d_out; a.ws = (unsigned char*)d_ws;
#if MK_ONE_LAUNCH
    a.ph_lo = 0; a.ph_hi = N_PHASES; a.li = 0;
    hipLaunchKernelGGL(fwd_kernel, dim3(grid), dim3(NWAVES * 64), LDS_BYTES, stream, a);
#else
    for (int ph = 0; ph < N_PHASES; ++ph) {
        if (ph == 3) continue;
        a.ph_lo = ph; a.ph_hi = ph + 1; a.li = ph;
        hipLaunchKernelGGL(fwd_kernel, dim3(grid), dim3(NWAVES * 64), LDS_BYTES, stream, a);
    }
#endif
}
```
